# Optimizing an MI355X kernel written in HIP

```python
import math
import jax, jax.numpy as jnp
from jax import lax
import numpy as np

D_MODEL = 1024
BATCH = 8
SEQ = 4096
DEPTH = 1

HEAD_DIM = 64
N_ATTN_HEADS = 12
ATTN_WIDTH = N_ATTN_HEADS * HEAD_DIM
N_FOURIER_GROUPS = 4
FOURIER_GROUP_DIM = 64
FOURIER_WIDTH = N_FOURIER_GROUPS * FOURIER_GROUP_DIM
MIX_WIDTH = ATTN_WIDTH + FOURIER_WIDTH
IN_PROJ_WIDTH = 3 * ATTN_WIDTH + FOURIER_WIDTH
DILATED_PATTERNS = ((128, 1), (512, 4), (2048, 16))
N_REL_BUCKETS = 32
REL_MAX_DISTANCE = 1024
D_FF = 2816
CONV_WIDTH = 3
EPS = 1e-6
NEG_INF = -1e30

kernel_name = "hymba_dilated_fnet_convglu_block"


def _rms_norm(x, g):
    xf = x.astype(jnp.float32)
    y = xf * lax.rsqrt(jnp.mean(xf * xf, axis=-1, keepdims=True) + EPS)
    return (y * g.astype(jnp.float32)).astype(x.dtype)


def _t5_bucket(rel):
    nb = N_REL_BUCKETS // 2
    max_exact = nb // 2
    ret = jnp.where(rel > 0, nb, 0)
    n = jnp.abs(rel)
    nf = jnp.maximum(n, 1).astype(jnp.float32)
    large = max_exact + (jnp.log(nf / max_exact) / math.log(REL_MAX_DISTANCE / max_exact)
                         * (nb - max_exact)).astype(jnp.int32)
    large = jnp.minimum(large, nb - 1)
    return ret + jnp.where(n < max_exact, n, large)


def _dilated_branch(q, k, v, rel_table, window, dilation):
    B, S, H, hd = q.shape
    half = window // (2 * dilation)
    L = S // dilation
    nb = -(-L // half)
    Lp = nb * half

    def to_sub(t, extra):
        t = t.reshape(B, L, dilation, H, hd).transpose(0, 2, 1, 3, 4)
        return jnp.pad(t, ((0, 0), (0, 0), (extra, Lp - L + extra), (0, 0), (0, 0)))

    def windows(t):
        blk = to_sub(t, half).reshape(B, dilation, nb + 2, half, H, hd)
        return jnp.concatenate([blk[:, :, :-2], blk[:, :, 1:-1], blk[:, :, 2:]], axis=3)

    qb = to_sub(q, 0).reshape(B, dilation, nb, half, H, hd)
    kw, vw = windows(k), windows(v)

    qi = jnp.arange(half)
    kj = jnp.arange(3 * half)
    rel = kj[None, :] - half - qi[:, None]
    kidx = (jnp.arange(nb)[:, None] - 1) * half + kj[None, :]
    mask = (jnp.abs(rel) <= half)[None] & ((kidx >= 0) & (kidx < L))[:, None, :]
    bias = rel_table[_t5_bucket(rel * dilation)].astype(jnp.float32).transpose(2, 0, 1)

    s = jnp.einsum('brnqhd,brnkhd->brnhqk', qb, kw) * (hd ** -0.5) + bias
    s = jnp.where(mask[:, None], s, NEG_INF)
    m = jnp.max(s, axis=-1, keepdims=True)
    p = jnp.exp(s - m)
    l = jnp.sum(p, axis=-1)
    o = jnp.einsum('brnhqk,brnkhd->brnqhd', p, vw) / l.transpose(0, 1, 2, 4, 3)[..., None]
    lse = (m[..., 0] + jnp.log(l)).transpose(0, 1, 2, 4, 3)

    o = o.reshape(B, dilation, Lp, H, hd)[:, :, :L].transpose(0, 2, 1, 3, 4).reshape(B, S, H, hd)
    lse = lse.reshape(B, dilation, Lp, H)[:, :, :L].transpose(0, 2, 1, 3).reshape(B, S, H)
    return o, lse


def _dilated_attention(q, k, v, rel_table):
    outs, lses = [], []
    for window, dilation in DILATED_PATTERNS:
        o, lse = _dilated_branch(q, k, v, rel_table, window, dilation)
        outs.append(o)
        lses.append(lse)
    w = jax.nn.softmax(jnp.stack(lses, axis=0), axis=0)
    return jnp.sum(w[..., None] * jnp.stack(outs, axis=0), axis=0)


def _fourier_mix(u, w, b):
    f = jnp.fft.fft2(u.astype(jnp.float32), axes=(1, 3), norm="ortho").real
    return jnp.einsum('bsgc,gcd->bsgd', f, w.astype(jnp.float32)) + b.astype(jnp.float32)


def _conv_glu_ffn(h, w_gate, w_val, conv_w, conv_b, w_down):
    g = h @ w_gate
    val = h @ w_val
    pad = CONV_WIDTH // 2
    g = lax.conv_general_dilated(
        g, conv_w.astype(g.dtype)[:, None, :], window_strides=(1,), padding=((pad, pad),),
        dimension_numbers=('NWC', 'WIO', 'NWC'), feature_group_count=D_FF) + conv_b
    return (jax.nn.silu(g) * val) @ w_down


def setup_inputs(seed: int = 0) -> dict:
    key = jax.random.key(seed)
    ks = jax.random.split(key, 20)
    nrm = lambda k, shape, scale: jax.random.normal(k, shape, jnp.float32) * scale
    gain = lambda k, shape: 1.0 + 0.01 * jax.random.normal(k, shape, jnp.float32)
    return {
        "x": nrm(ks[0], (BATCH, SEQ, D_MODEL), 1.0),
        "norm_mix_gain": gain(ks[1], (DEPTH, D_MODEL)),
        "w_in": nrm(ks[2], (DEPTH, D_MODEL, IN_PROJ_WIDTH), D_MODEL ** -0.5),
        "attn_out_gain": gain(ks[3], (DEPTH, ATTN_WIDTH)),
        "rel_bias_table": nrm(ks[4], (N_REL_BUCKETS, N_ATTN_HEADS), 0.5),
        "fourier_w": nrm(ks[5], (DEPTH, N_FOURIER_GROUPS, FOURIER_GROUP_DIM, FOURIER_GROUP_DIM), FOURIER_GROUP_DIM ** -0.5),
        "fourier_b": nrm(ks[6], (DEPTH, N_FOURIER_GROUPS, FOURIER_GROUP_DIM), 0.01),
        "fourier_out_gain": gain(ks[7], (DEPTH, FOURIER_WIDTH)),
        "w_out": nrm(ks[8], (DEPTH, MIX_WIDTH, D_MODEL), MIX_WIDTH ** -0.5),
        "norm_ffn_gain": gain(ks[9], (DEPTH, D_MODEL)),
        "w_gate": nrm(ks[10], (DEPTH, D_MODEL, D_FF), D_MODEL ** -0.5),
        "w_val": nrm(ks[11], (DEPTH, D_MODEL, D_FF), D_MODEL ** -0.5),
        "conv_w": nrm(ks[12], (DEPTH, CONV_WIDTH, D_FF), CONV_WIDTH ** -0.5),
        "conv_b": nrm(ks[13], (DEPTH, D_FF), 0.01),
        "w_down": nrm(ks[14], (DEPTH, D_FF, D_MODEL), D_FF ** -0.5),
        "final_norm_gain": gain(ks[15], (D_MODEL,)),
    }


def reference(x, norm_mix_gain, w_in, attn_out_gain, rel_bias_table, fourier_w, fourier_b,
              fourier_out_gain, w_out, norm_ffn_gain, w_gate, w_val, conv_w, conv_b, w_down,
              final_norm_gain):
    B, S, _ = x.shape
    for layer in range(DEPTH):
        h = _rms_norm(x, norm_mix_gain[layer])
        proj = h @ w_in[layer]
        q = proj[..., :ATTN_WIDTH].reshape(B, S, N_ATTN_HEADS, HEAD_DIM).astype(jnp.float32)
        k = proj[..., ATTN_WIDTH:2 * ATTN_WIDTH].reshape(B, S, N_ATTN_HEADS, HEAD_DIM).astype(jnp.float32)
        v = proj[..., 2 * ATTN_WIDTH:3 * ATTN_WIDTH].reshape(B, S, N_ATTN_HEADS, HEAD_DIM).astype(jnp.float32)
        u = proj[..., 3 * ATTN_WIDTH:].reshape(B, S, N_FOURIER_GROUPS, FOURIER_GROUP_DIM)

        attn = _dilated_attention(q, k, v, rel_bias_table).reshape(B, S, ATTN_WIDTH).astype(x.dtype)
        four = _fourier_mix(u, fourier_w[layer], fourier_b[layer]).reshape(B, S, FOURIER_WIDTH).astype(x.dtype)
        mixed = jnp.concatenate([_rms_norm(attn, attn_out_gain[layer]),
                                 _rms_norm(four, fourier_out_gain[layer])], axis=-1)
        x = x + mixed @ w_out[layer]

        h = _rms_norm(x, norm_ffn_gain[layer])
        x = x + _conv_glu_ffn(h, w_gate[layer], w_val[layer], conv_w[layer], conv_b[layer], w_down[layer])
    return _rms_norm(x, final_norm_gain)
```

```cpp
#include <hip/hip_runtime.h>
#include <cstdio>
#include <cstdint>

namespace pg8 {
#define PG8_LAS __attribute__((address_space(3)))
typedef unsigned short bf16_t;
typedef short bf16x8 __attribute__((ext_vector_type(8)));
typedef float f32x4 __attribute__((ext_vector_type(4)));
typedef unsigned u32x4 __attribute__((ext_vector_type(4)));
typedef int i32x4 __attribute__((ext_vector_type(4)));
template <bool I8> struct AccT { typedef f32x4 type; };
template <> struct AccT<true> { typedef i32x4 type; };
constexpr int BM = 256, BK = 64, HALF = 128, HTB = HALF * BK * 2, STAGE_BYTES = 8 * HTB, NXCD = 8, WGM = 8;

__host__ __device__ __forceinline__ int lds_byte(int r, int c) { const int st = (r >> 4) * 2 + (c >> 5), rr = r & 15, cc = c & 31, ob = rr * 64 + cc * 2; return st * 1024 + (ob ^ (((ob >> 9) & 1) << 5)); }
__host__ __device__ __forceinline__ void stage_rc(int b, int& R, int& C) { const int st = b / 1024, sb = b % 1024, swz = sb ^ (((sb >> 9) & 1) << 5); R = (st >> 1) * 16 + swz / 64; C = (st & 1) * 32 + (swz % 64) / 2; }
__host__ __device__ __forceinline__ int perm32(int rho) { const int n = rho >> 4, i = rho & 15; return 8 * (i >> 2) + 4 * n + (i & 3); }

struct Unit { int pm, pn; };
struct Gemm { const bf16_t* A; const bf16_t* Bt; int M, N, K, lda; int ovl; };
__host__ __device__ __forceinline__ int ovl_row_base(int pm) { const int b = pm / 17, k = pm - 17 * b; return b * 4096 + (k ? 254 * k - 1 : 0); }

struct StaticOrder {
    int nM, nN, nwg, G, c;
    __host__ __device__ void init(int M, int N, int G_, int c_) { nM = M / BM; nN = N / BM; nwg = nM * nN; G = G_; c = c_; }
    __host__ __device__ bool next(int i, Unit& u) const {
        const long L = (long)i * G + c; if (L >= nwg) return false;
        int wgid = (int)L; { const int q = nwg / NXCD, r = nwg % NXCD, xcd = wgid % NXCD, off = wgid / NXCD; wgid = (xcd < r ? xcd * (q + 1) : r * (q + 1) + (xcd - r) * q) + off; }
        const int nig = WGM * nN, gid = wgid / nig, fm = gid * WGM, gsz = (nM - fm) < WGM ? (nM - fm) : WGM;
        u.pm = fm + ((wgid % nig) % gsz); u.pn = (wgid % nig) / gsz; return true;
    }
    __device__ __forceinline__ void a_ready(const Unit&) const {}
    __device__ __forceinline__ void done(const Unit&) const {}
};

__device__ __forceinline__ unsigned cvt_pk_bf16(float lo, float hi) { unsigned r; asm volatile("v_cvt_pk_bf16_f32 %0, %1, %2" : "=v"(r) : "v"(lo), "v"(hi)); return r; }

struct EpiBf16 {
    static constexpr bool PERM = true, AFTER_DRAIN = false, MIDK = false, PREFETCH = false;
    bf16_t* O; int ldc;
    __device__ __forceinline__ void operator()(const f32x4 (&acc)[2][2][4][2], const Unit& u, int wr, int wc, int fr, int fq) const {
        const int row0 = u.pm * BM + wr * 64 + fr; const int col0 = u.pn * BM + wc * 32 + 8 * fq;
#pragma unroll
        for (int ai = 0; ai < 2; ++ai)
#pragma unroll
            for (int m = 0; m < 4; ++m) { bf16_t* rowp = O + (size_t)(row0 + ai * HALF + m * 16) * ldc + col0;
#pragma unroll
                for (int bj = 0; bj < 2; ++bj) { const f32x4 v0 = acc[ai][bj][m][0], v1 = acc[ai][bj][m][1];
                    u32x4 w; w.x = cvt_pk_bf16(v0[0], v0[1]); w.y = cvt_pk_bf16(v0[2], v0[3]); w.z = cvt_pk_bf16(v1[0], v1[1]); w.w = cvt_pk_bf16(v1[2], v1[3]);
                    *(u32x4*)(rowp + bj * HALF) = w; } }
    }
};

struct EpiBf16Row {
    static constexpr bool PERM = true, AFTER_DRAIN = false, MIDK = false, PREFETCH = false;
    bf16_t* O; int ldc; const float* rs;
    __device__ __forceinline__ void operator()(const f32x4 (&acc)[2][2][4][2], const Unit& u, int wr, int wc, int fr, int fq) const {
        const int row0 = u.pm * BM + wr * 64 + fr; const int col0 = u.pn * BM + wc * 32 + 8 * fq;
#pragma unroll
        for (int ai = 0; ai < 2; ++ai)
#pragma unroll
            for (int m = 0; m < 4; ++m) { const int row = row0 + ai * HALF + m * 16; const float r = rs[row]; bf16_t* rowp = O + (size_t)row * ldc + col0;
#pragma unroll
                for (int bj = 0; bj < 2; ++bj) { const f32x4 v0 = acc[ai][bj][m][0] * r, v1 = acc[ai][bj][m][1] * r;
                    u32x4 w; w.x = cvt_pk_bf16(v0[0], v0[1]); w.y = cvt_pk_bf16(v0[2], v0[3]); w.z = cvt_pk_bf16(v1[0], v1[1]); w.w = cvt_pk_bf16(v1[2], v1[3]);
                    *(u32x4*)(rowp + bj * HALF) = w; } }
    }
};
struct EpiResF32 {
    static constexpr bool PERM = false, AFTER_DRAIN = false, MIDK = false, PREFETCH = false;
    const float* base; float* out; int ldc;
    __device__ __forceinline__ void operator()(const f32x4 (&acc)[2][2][4][2], const Unit& u, int wr, int wc, int fr, int fq) const {
        const int col0 = u.pn * BM + wc * 32 + 4 * fq;
#pragma unroll
        for (int ai = 0; ai < 2; ++ai)
#pragma unroll
            for (int m = 0; m < 4; ++m) { const int r = u.pm * BM + ai * HALF + wr * 64 + m * 16 + fr; const size_t off = (size_t)r * ldc + col0;
#pragma unroll
                for (int bj = 0; bj < 2; ++bj)
#pragma unroll
                    for (int n = 0; n < 2; ++n) { const f32x4 bs = *(const f32x4*)(base + off + bj * HALF + n * 16); *(f32x4*)(out + off + bj * HALF + n * 16) = bs + acc[ai][bj][m][n]; } }
    }
};


struct EpiX1 {
    static constexpr bool PERM = true, AFTER_DRAIN = false, MIDK = false, PREFETCH = false;
    const float* base; bf16_t* O; int ldc; float* ss;
    __device__ __forceinline__ void operator()(const f32x4 (&acc)[2][2][4][2], const Unit& u, int wr, int wc, int fr, int fq) const {
        const int row0 = u.pm * BM + wr * 64 + fr; const int col0 = u.pn * BM + wc * 32 + 8 * fq;
#pragma unroll
        for (int ai = 0; ai < 2; ++ai)
#pragma unroll
            for (int m = 0; m < 4; ++m) { const int row = row0 + ai * HALF + m * 16; const size_t off = (size_t)row * ldc + col0; float q = 0.f;
#pragma unroll
                for (int bj = 0; bj < 2; ++bj) { const f32x4 v0 = *(const f32x4*)(base + off + bj * HALF) + acc[ai][bj][m][0], v1 = *(const f32x4*)(base + off + bj * HALF + 4) + acc[ai][bj][m][1];
                    q += (v0[0] * v0[0] + v0[1] * v0[1]) + (v0[2] * v0[2] + v0[3] * v0[3]) + (v1[0] * v1[0] + v1[1] * v1[1]) + (v1[2] * v1[2] + v1[3] * v1[3]);
                    u32x4 w; w.x = cvt_pk_bf16(v0[0], v0[1]); w.y = cvt_pk_bf16(v0[2], v0[3]); w.z = cvt_pk_bf16(v1[0], v1[1]); w.w = cvt_pk_bf16(v1[2], v1[3]);
                    *(u32x4*)(O + off + bj * HALF) = w; }
                q += __shfl_xor(q, 16); q += __shfl_xor(q, 32);
                if (fq == 0) ss[(size_t)row * 16 + u.pn * 4 + wc] = q; }
    }
};
struct EpiX2 {
    static constexpr bool PERM = true, AFTER_DRAIN = false, MIDK = false, PREFETCH = false;
    bf16_t* X; int ldc; float* ss;
    __device__ __forceinline__ void operator()(const f32x4 (&acc)[2][2][4][2], const Unit& u, int wr, int wc, int fr, int fq) const {
        const int row0 = u.pm * BM + wr * 64 + fr; const int col0 = u.pn * BM + wc * 32 + 8 * fq;
#pragma unroll
        for (int ai = 0; ai < 2; ++ai)
#pragma unroll
            for (int m = 0; m < 4; ++m) { const int row = row0 + ai * HALF + m * 16; const size_t off = (size_t)row * ldc + col0; float q = 0.f;
#pragma unroll
                for (int bj = 0; bj < 2; ++bj) { const u32x4 xb = *(const u32x4*)(X + off + bj * HALF);
                    f32x4 v0, v1; v0[0] = __builtin_bit_cast(float, xb.x << 16); v0[1] = __builtin_bit_cast(float, xb.x & 0xffff0000u); v0[2] = __builtin_bit_cast(float, xb.y << 16); v0[3] = __builtin_bit_cast(float, xb.y & 0xffff0000u);
                    v1[0] = __builtin_bit_cast(float, xb.z << 16); v1[1] = __builtin_bit_cast(float, xb.z & 0xffff0000u); v1[2] = __builtin_bit_cast(float, xb.w << 16); v1[3] = __builtin_bit_cast(float, xb.w & 0xffff0000u);
                    v0 = v0 + acc[ai][bj][m][0]; v1 = v1 + acc[ai][bj][m][1];
                    q += (v0[0] * v0[0] + v0[1] * v0[1]) + (v0[2] * v0[2] + v0[3] * v0[3]) + (v1[0] * v1[0] + v1[1] * v1[1]) + (v1[2] * v1[2] + v1[3] * v1[3]);
                    u32x4 w; w.x = cvt_pk_bf16(v0[0], v0[1]); w.y = cvt_pk_bf16(v0[2], v0[3]); w.z = cvt_pk_bf16(v1[0], v1[1]); w.w = cvt_pk_bf16(v1[2], v1[3]);
                    *(u32x4*)(X + off + bj * HALF) = w; }
                q += __shfl_xor(q, 16); q += __shfl_xor(q, 32);
                if (fq == 0) ss[(size_t)row * 16 + u.pn * 4 + wc] = q; }
    }
};
struct EpiBf16Rs {
    static constexpr bool PERM = true, AFTER_DRAIN = false, MIDK = false, PREFETCH = false;
    bf16_t* O; int ldc; const float* ss; float inv_n, eps;
    __device__ __forceinline__ void operator()(const f32x4 (&acc)[2][2][4][2], const Unit& u, int wr, int wc, int fr, int fq) const {
        const int row0 = u.pm * BM + wr * 64 + fr; const int col0 = u.pn * BM + wc * 32 + 8 * fq;
#pragma unroll
        for (int ai = 0; ai < 2; ++ai)
#pragma unroll
            for (int m = 0; m < 4; ++m) { const int row = row0 + ai * HALF + m * 16; const f32x4* sp = (const f32x4*)(ss + (size_t)row * 16);
                const f32x4 s4 = (sp[0] + sp[1]) + (sp[2] + sp[3]); const float rs = 1.0f / sqrtf(((s4[0] + s4[1]) + (s4[2] + s4[3])) * inv_n + eps);
                bf16_t* rowp = O + (size_t)row * ldc + col0;
#pragma unroll
                for (int bj = 0; bj < 2; ++bj) { const f32x4 v0 = acc[ai][bj][m][0] * rs, v1 = acc[ai][bj][m][1] * rs;
                    u32x4 w; w.x = cvt_pk_bf16(v0[0], v0[1]); w.y = cvt_pk_bf16(v0[2], v0[3]); w.z = cvt_pk_bf16(v1[0], v1[1]); w.w = cvt_pk_bf16(v1[2], v1[3]);
                    *(u32x4*)(rowp + bj * HALF) = w; } }
    }
};


template <int CTRL> __device__ __forceinline__ float dppk(float keep, float x) { return __builtin_bit_cast(float, __builtin_amdgcn_update_dpp(__builtin_bit_cast(int, keep), __builtin_bit_cast(int, x), CTRL, 0xf, 0xf, false)); }
template <int CTRL> __device__ __forceinline__ float dppf(float x) { return __builtin_bit_cast(float, __builtin_amdgcn_mov_dpp(__builtin_bit_cast(int, x), CTRL, 0xf, 0xf, true)); }
struct EpiConvGlu {
    static constexpr bool PERM = true, AFTER_DRAIN = false, MIDK = false, PREFETCH = true;
    bf16_t* O; int ldc; const float* ss; const float* cw; const float* cb; PG8_LAS float* ex; int mrows; float* halo; const float* cw4;
    __device__ __forceinline__ void prefetch(const Unit& u, int wid, int lane) const {
        const int base = u.pm * BM; asm volatile("" : "+v"(lane));
        if (wid == 0) __builtin_amdgcn_global_load_lds((const unsigned*)(ss + base + lane * 4), (PG8_LAS unsigned*)(ex + 1024), 16, 0, 0);
        else if (wid < 4) __builtin_amdgcn_global_load_lds((const unsigned*)(cw4 + u.pn * 768 + (wid - 1) * 256 + lane * 4), (PG8_LAS unsigned*)(ex + 1024 + 4096 + (wid - 1) * 256), 16, 0, 0);
    }
    __device__ __forceinline__ void operator()(i32x4 (&iacc)[2][2][4][2], const Unit& u, int wr, int wc, int fr, int fq) const {
        f32x4 acc[2][2][4][2];
        const int kt = u.pm & 15, base = u.pm * BM, rend = 256;
        const int ch0 = u.pn * 128 + wc * 32 + 8 * fq;
        const bool top_open = kt != 0, bot_open = kt != 15;
        f32x4 w0[2], w1[2], w2[2], cbv[2];
        f32x4 sg[2], sv[2];
#pragma unroll
        for (int n = 0; n < 2; ++n) { const PG8_LAS float* wl = ex + 1024 + 4096 + wc * 32 + 8 * fq + 4 * n; w0[n] = *(const PG8_LAS f32x4*)wl; w1[n] = *(const PG8_LAS f32x4*)(wl + 128); w2[n] = *(const PG8_LAS f32x4*)(wl + 256); cbv[n] = *(const PG8_LAS f32x4*)(wl + 384); sg[n] = *(const PG8_LAS f32x4*)(wl + 512); sv[n] = *(const PG8_LAS f32x4*)(wl + 640); }
#pragma unroll
        for (int ai = 0; ai < 2; ++ai)
#pragma unroll
            for (int m = 0; m < 4; ++m) { const int r = ai * HALF + wr * 64 + m * 16 + fr; const float rs = ex[1024 + r];
#pragma unroll
                for (int n = 0; n < 2; ++n) { const i32x4 ig = iacc[ai][0][m][n], iv = iacc[ai][1][m][n];
                    acc[ai][0][m][n] = (f32x4){(float)ig[0], (float)ig[1], (float)ig[2], (float)ig[3]} * rs * sg[n]; acc[ai][1][m][n] = (f32x4){(float)iv[0], (float)iv[1], (float)iv[2], (float)iv[3]} * rs * sv[n]; } }
        const int exi = (wc * 4 + fq) * 8;
        if (fr == 0) {
#pragma unroll
            for (int ai = 0; ai < 2; ++ai) { PG8_LAS f32x4* p = (PG8_LAS f32x4*)(ex + ((ai * 2 + wr) * 2 + 0) * 128 + exi); p[0] = acc[ai][0][0][0]; p[1] = acc[ai][0][0][1]; } }
        if (fr == 15) {
#pragma unroll
            for (int ai = 0; ai < 2; ++ai) { PG8_LAS f32x4* p = (PG8_LAS f32x4*)(ex + ((ai * 2 + wr) * 2 + 1) * 128 + exi); p[0] = acc[ai][0][3][0]; p[1] = acc[ai][0][3][1]; } }
        asm volatile("s_waitcnt lgkmcnt(0)\n\ts_barrier" ::: "memory");
#pragma unroll
        for (int ai = 0; ai < 2; ++ai) {
#pragma unroll
            for (int m = 0; m < 4; ++m) { const int r = ai * HALF + wr * 64 + m * 16 + fr; u32x4 w; unsigned wv[4]; float zz[8];
                f32x4 edge[2] = {(f32x4){0.f, 0.f, 0.f, 0.f}, (f32x4){0.f, 0.f, 0.f, 0.f}};
                if (m == 0) { const bool hz = (wr == 0 && ai == 0); const int sai = wr == 1 ? ai : 0, swr = wr == 1 ? 0 : 1; const PG8_LAS f32x4* p = (const PG8_LAS f32x4*)(ex + ((sai * 2 + swr) * 2 + 1) * 128 + exi);
                    if (!hz) { edge[0] = p[0]; edge[1] = p[1]; } }
                if (m == 3) { const bool hz = (wr == 1 && ai == 1); const int sai = wr == 0 ? ai : 1, swr = wr == 0 ? 1 : 0; const PG8_LAS f32x4* p = (const PG8_LAS f32x4*)(ex + ((sai * 2 + swr) * 2 + 0) * 128 + exi);
                    if (!hz) { edge[0] = p[0]; edge[1] = p[1]; } }
#pragma unroll
                for (int n = 0; n < 2; ++n) { float a[4];
#pragma unroll
                    for (int i = 0; i < 4; ++i) { const float gc = acc[ai][0][m][n][i];
                        const float rp = m > 0 ? dppf<0x121>(acc[ai][0][m > 0 ? m - 1 : 0][n][i]) : edge[n][i];
                        const float ln = m < 3 ? dppf<0x12F>(acc[ai][0][m < 3 ? m + 1 : 3][n][i]) : edge[n][i];
                        const float gu = dppk<0x111>(rp, gc), gd = dppk<0x101>(ln, gc);
                        const float z = __builtin_fmaf(w2[n][i], gd, __builtin_fmaf(w1[n][i], gc, __builtin_fmaf(w0[n][i], gu, cbv[n][i])));
                        if ((ai == 0 && m == 0) || (ai == 1 && m == 3)) zz[4 * n + i] = z;
                        a[i] = z * __builtin_amdgcn_rcpf(1.0f + __builtin_amdgcn_exp2f(-1.4426950408889634f * z)) * acc[ai][1][m][n][i]; }
                    wv[2 * n] = cvt_pk_bf16(a[0], a[1]); wv[2 * n + 1] = cvt_pk_bf16(a[2], a[3]); }
                w.x = wv[0]; w.y = wv[1]; w.z = wv[2]; w.w = wv[3];
                bool open = false;
                if (ai == 0 && m == 0) open = (r == 0) && top_open;
                if (ai == 1 && m == 3) open = (r == 255) && bot_open;
                if (!open) *(u32x4*)(O + (size_t)(base + r) * ldc + ch0) = w;
                if ((ai == 0 && m == 0) || (ai == 1 && m == 3)) { if (open) { float* hp = halo + ((size_t)(u.pm * 2 + (ai == 0 ? 0 : 1)) * 3) * ldc + ch0;
                        *(f32x4*)hp = acc[ai][0][m][0]; *(f32x4*)(hp + 4) = acc[ai][0][m][1];
                        *(f32x4*)(hp + ldc) = (f32x4){zz[0], zz[1], zz[2], zz[3]}; *(f32x4*)(hp + ldc + 4) = (f32x4){zz[4], zz[5], zz[6], zz[7]};
                        *(f32x4*)(hp + 2 * ldc) = acc[ai][1][m][0]; *(f32x4*)(hp + 2 * ldc + 4) = acc[ai][1][m][1]; } }
                asm volatile("" ::: "memory"); } }
        asm volatile("s_waitcnt lgkmcnt(0)\n\ts_barrier" ::: "memory");
    }
};


struct EpiX1N {
    static constexpr bool PERM = true, AFTER_DRAIN = false, MIDK = true, PREFETCH = true; static constexpr int MIDK_T = 12;
    const bf16_t* base; bf16_t* O; int ldc; float* ss; const float* sa; PG8_LAS float* st;
    __device__ __forceinline__ void prefetch(const Unit& u, int wid, int lane) const {
        asm volatile("" : "+v"(lane));
#pragma unroll
        for (int i = 0; i < 2; ++i) { const int piece = wid * 2 + i;
            __builtin_amdgcn_global_load_lds((const unsigned*)(sa + (size_t)u.pm * BM * 16 + piece * 256 + lane * 4), (PG8_LAS unsigned*)(st + piece * 256), 16, 0, 0); }
    }
    __device__ __forceinline__ void row_stats(int rl, int fq, float& ra, float& rf) const {
        const f32x4 s4 = *(const PG8_LAS f32x4*)(st + rl * 16 + 4 * fq); float a = fq < 3 ? (s4[0] + s4[1]) + (s4[2] + s4[3]) : 0.f, f = fq == 3 ? s4[0] : 0.f;
        a += __shfl_xor(a, 16); a += __shfl_xor(a, 32); f += __shfl_xor(f, 16); f += __shfl_xor(f, 32);
        ra = __builtin_amdgcn_rsqf(a * (1.0f / 768.0f) + 1e-6f); rf = __builtin_amdgcn_rsqf(f * (1.0f / 256.0f) + 1e-6f);
    }
    __device__ __forceinline__ void midk(f32x4 (&acc)[2][2][4][2], const Unit& u, int wr, int fr, int fq) const {
#pragma unroll
        for (int ai = 0; ai < 2; ++ai)
#pragma unroll
            for (int m = 0; m < 4; ++m) { float ra, rf; row_stats(ai * HALF + wr * 64 + m * 16 + fr, fq, ra, rf); const float ratio = ra * __builtin_amdgcn_rcpf(rf);
#pragma unroll
                for (int bj = 0; bj < 2; ++bj) { acc[ai][bj][m][0] = acc[ai][bj][m][0] * ratio; acc[ai][bj][m][1] = acc[ai][bj][m][1] * ratio; } }
    }
    __device__ __forceinline__ void operator()(const f32x4 (&acc)[2][2][4][2], const Unit& u, int wr, int wc, int fr, int fq) const {
        const int row0 = u.pm * BM + wr * 64 + fr; const int col0 = u.pn * BM + wc * 32 + 8 * fq;
#pragma unroll
        for (int ai = 0; ai < 2; ++ai)
#pragma unroll
            for (int m = 0; m < 4; ++m) { const int row = row0 + ai * HALF + m * 16; const size_t off = (size_t)row * ldc + col0; float ra, rf; row_stats(row - u.pm * BM, fq, ra, rf);
#pragma unroll
                for (int bj = 0; bj < 2; ++bj) { const u32x4 xb = *(const u32x4*)(base + off + bj * HALF); f32x4 v0, v1;
                    v0[0] = __builtin_bit_cast(float, xb.x << 16); v0[1] = __builtin_bit_cast(float, xb.x & 0xffff0000u); v0[2] = __builtin_bit_cast(float, xb.y << 16); v0[3] = __builtin_bit_cast(float, xb.y & 0xffff0000u);
                    v1[0] = __builtin_bit_cast(float, xb.z << 16); v1[1] = __builtin_bit_cast(float, xb.z & 0xffff0000u); v1[2] = __builtin_bit_cast(float, xb.w << 16); v1[3] = __builtin_bit_cast(float, xb.w & 0xffff0000u);
                    v0 = v0 + acc[ai][bj][m][0] * rf; v1 = v1 + acc[ai][bj][m][1] * rf;
                    u32x4 w; w.x = cvt_pk_bf16(v0[0], v0[1]); w.y = cvt_pk_bf16(v0[2], v0[3]); w.z = cvt_pk_bf16(v1[0], v1[1]); w.w = cvt_pk_bf16(v1[2], v1[3]);
                    *(u32x4*)(O + off + bj * HALF) = w; }
                }
        asm volatile("s_waitcnt lgkmcnt(0)\n\ts_barrier" ::: "memory");
    }
};


struct EpiFinal {
    static constexpr bool PERM = true, AFTER_DRAIN = false, MIDK = false, PREFETCH = false;
    const bf16_t* X1; float* out; int ldc; const float* gain; float* xbuf; unsigned* cnt; PG8_LAS unsigned char* lx;
    __device__ __forceinline__ void operator()(f32x4 (&acc)[2][2][4][2], const Unit& u, int wr, int wc, int fr, int fq) const {
        PG8_LAS float* P = (PG8_LAS float*)lx; PG8_LAS float* S = (PG8_LAS float*)(lx + 4096);
        int tid = (wr * 4 + wc) * 64 + fq * 16 + fr; asm volatile("" : "+v"(tid)); const int col0 = u.pn * BM + wc * 32 + 8 * fq;
#pragma unroll
        for (int ai = 0; ai < 2; ++ai)
#pragma unroll
            for (int m = 0; m < 4; ++m) { const int rl = ai * HALF + wr * 64 + m * 16 + fr; const size_t off = (size_t)(u.pm * BM + rl) * ldc + col0; float q = 0.f;
#pragma unroll
                for (int bj = 0; bj < 2; ++bj) { const u32x4 xb = *(const u32x4*)(X1 + off + bj * HALF); f32x4 v0, v1;
                    v0[0] = __builtin_bit_cast(float, xb.x << 16); v0[1] = __builtin_bit_cast(float, xb.x & 0xffff0000u); v0[2] = __builtin_bit_cast(float, xb.y << 16); v0[3] = __builtin_bit_cast(float, xb.y & 0xffff0000u);
                    v1[0] = __builtin_bit_cast(float, xb.z << 16); v1[1] = __builtin_bit_cast(float, xb.z & 0xffff0000u); v1[2] = __builtin_bit_cast(float, xb.w << 16); v1[3] = __builtin_bit_cast(float, xb.w & 0xffff0000u);
                    v0 = v0 + acc[ai][bj][m][0]; v1 = v1 + acc[ai][bj][m][1]; acc[ai][bj][m][0] = v0; acc[ai][bj][m][1] = v1;
                    q += ((v0[0] * v0[0] + v0[1] * v0[1]) + (v0[2] * v0[2] + v0[3] * v0[3])) + ((v1[0] * v1[0] + v1[1] * v1[1]) + (v1[2] * v1[2] + v1[3] * v1[3])); }
                q += __shfl_xor(q, 16); q += __shfl_xor(q, 32);
                if (fq == 0) P[rl * 4 + wc] = q; }
        asm volatile("s_waitcnt lgkmcnt(0)\n\ts_barrier" ::: "memory");
        if (tid < 256) { const float s = (P[tid * 4] + P[tid * 4 + 1]) + (P[tid * 4 + 2] + P[tid * 4 + 3]);
            __hip_atomic_store(xbuf + ((size_t)(u.pm * BM + tid) * 4 + u.pn), s, __ATOMIC_RELAXED, __HIP_MEMORY_SCOPE_AGENT);
            asm volatile("s_waitcnt vmcnt(0)" ::: "memory");
            if ((tid & 63) == 0) __hip_atomic_fetch_add(cnt + 64 * u.pm, 1u, __ATOMIC_RELAXED, __HIP_MEMORY_SCOPE_AGENT); }
        if (tid < 64) { unsigned spins = 0;
            while ((unsigned)__builtin_amdgcn_readfirstlane(__hip_atomic_load(cnt + 64 * u.pm, __ATOMIC_RELAXED, __HIP_MEMORY_SCOPE_AGENT)) < 16u) { __builtin_amdgcn_s_sleep(2); if (++spins > 400000u) break; }
            __builtin_amdgcn_fence(__ATOMIC_ACQUIRE, "agent"); }
        asm volatile("s_waitcnt vmcnt(0) lgkmcnt(0)\n\ts_barrier" ::: "memory");
        if (tid < 256) { const float* xp = xbuf + (size_t)(u.pm * BM + tid) * 4; float t = 0.f;
#pragma unroll
            for (int k = 0; k < 4; ++k) t += __hip_atomic_load(xp + k, __ATOMIC_RELAXED, __HIP_MEMORY_SCOPE_AGENT);
            S[tid] = 1.0f / sqrtf(t * (1.0f / 1024.0f) + 1e-6f); }
        asm volatile("s_waitcnt vmcnt(0) lgkmcnt(0)\n\ts_barrier" ::: "memory");
        f32x4 gv[2][2];
#pragma unroll
        for (int bj = 0; bj < 2; ++bj)
#pragma unroll
            for (int n = 0; n < 2; ++n) gv[bj][n] = *(const f32x4*)(gain + col0 + bj * HALF + n * 4);
#pragma unroll
        for (int ai = 0; ai < 2; ++ai)
#pragma unroll
            for (int m = 0; m < 4; ++m) { const int rl = ai * HALF + wr * 64 + m * 16 + fr; const float rs = S[rl]; const size_t off = (size_t)(u.pm * BM + rl) * ldc + col0;
#pragma unroll
                for (int bj = 0; bj < 2; ++bj)
#pragma unroll
                    for (int n = 0; n < 2; ++n) *(f32x4*)(out + off + bj * HALF + n * 4) = acc[ai][bj][m][n] * rs * gv[bj][n]; }
    }
};

template <bool I8> __device__ __forceinline__ typename AccT<I8>::type mma16(bf16x8 a, bf16x8 b, typename AccT<I8>::type c) {
    if constexpr (I8) return __builtin_amdgcn_mfma_i32_16x16x64_i8(__builtin_bit_cast(i32x4, a), __builtin_bit_cast(i32x4, b), c, 0, 0, 0);
    else return __builtin_amdgcn_mfma_f32_16x16x32_bf16(a, b, c, 0, 0, 0);
}
template <class Epi, class Sched, bool ALIGN_EPI = false, bool SP2 = false, bool I8 = false>
__device__ __forceinline__ void gemm_phase(PG8_LAS unsigned char* lds, const Gemm g, const Sched& S, const Epi& E) {
    int tid = threadIdx.x; asm volatile("" : "+v"(tid));
    const int wid = __builtin_amdgcn_readfirstlane(tid >> 6), lane = tid & 63, wr = wid >> 2, wc = wid & 3, fr = lane & 15, fq = lane >> 4;
    const int K = g.K, nt = K / BK, lda = g.lda;
    unsigned voffA[2], voffB[2];
#pragma unroll
    for (int i = 0; i < 2; ++i) { int R, C; stage_rc(tid * 16 + i * 8192, R, C); const int Rb = Epi::PERM ? ((R & ~31) + perm32(R & 31)) : R;
        voffA[i] = (unsigned)(R * lda + C) * 2u; voffB[i] = (unsigned)(Rb * K + C) * 2u; }
    const size_t kstep = (size_t)(BK * 2);
    const size_t hstepA = (size_t)HALF * lda * 2, hstepB = (size_t)HALF * K * 2;
    const size_t tstepA = 2 * hstepA, tstepB = 2 * hstepB;
    const unsigned ldsw = (unsigned)wid * 1024u;
    const int aoff = lds_byte(wr * 64 + fr, fq * 8), boff = lds_byte(wc * 32 + fr, fq * 8);
#define PG8_SA(b, h) (((b) * 2 + (h)) * HTB)
#define PG8_SB(b, h) ((4 + (b) * 2 + (h)) * HTB)
#define PG8_STAGE(bufoff, gbase, voff) do { _Pragma("unroll") for (int _i = 0; _i < 2; ++_i) \
        __builtin_amdgcn_global_load_lds((const unsigned*)((const char*)(gbase) + (voff)[_i]), (PG8_LAS unsigned*)(lds + (bufoff) + ldsw + _i * 8192), 16, 0, 0); } while (0)
#define PG8_LDA(dst, b, h) do { _Pragma("unroll") for (int m = 0; m < 4; ++m) _Pragma("unroll") for (int k = 0; k < 2; ++k) dst[m][k] = *(const PG8_LAS bf16x8*)(lds + PG8_SA(b, h) + aoff + m * 2048 + k * 1024); } while (0)
#define PG8_LDB(dst, b, h) do { _Pragma("unroll") for (int n = 0; n < 2; ++n) _Pragma("unroll") for (int k = 0; k < 2; ++k) dst[n][k] = *(const PG8_LAS bf16x8*)(lds + PG8_SB(b, h) + boff + n * 2048 + k * 1024); } while (0)
#define PG8_MMA(ai, bj, At, Bt) do { __builtin_amdgcn_s_setprio(1); _Pragma("unroll") for (int m = 0; m < 4; ++m) _Pragma("unroll") for (int n = 0; n < 2; ++n) _Pragma("unroll") for (int k = 0; k < 2; ++k) \
        acc[ai][bj][m][n] = mma16<I8>(Bt[n][k], At[m][k], acc[ai][bj][m][n]); __builtin_amdgcn_s_setprio(0); } while (0)
#define PG8_WAIT_V(n) asm volatile("s_waitcnt vmcnt(" #n ")" ::: "memory")
#define PG8_WAIT_L(n) asm volatile("s_waitcnt lgkmcnt(" #n ")" ::: "memory")
#define PG8_BAR __builtin_amdgcn_s_barrier()
#define PG8_SCHED __builtin_amdgcn_sched_barrier(0)
    Unit cur, nxt; int ui = 0;
    if (!S.next(0, cur)) return;
    typedef typename AccT<I8>::type acc_t; acc_t acc[2][2][4][2];
#pragma unroll
    for (int a = 0; a < 2; ++a)
#pragma unroll
        for (int b = 0; b < 2; ++b)
#pragma unroll
            for (int m = 0; m < 4; ++m)
#pragma unroll
                for (int n = 0; n < 2; ++n) acc[a][b][m][n] = (acc_t){0, 0, 0, 0};
    bf16x8 At[4][2], B0[2][2], B1[2][2];
    const char* cA = (const char*)g.A + (g.ovl ? (size_t)ovl_row_base(cur.pm) * lda * 2 : (size_t)cur.pm * tstepA); const char* cB = (const char*)g.Bt + (size_t)cur.pn * tstepB;
    S.a_ready(cur);
    if constexpr (Epi::PREFETCH) E.prefetch(cur, wid, lane);
    if constexpr (SP2) {
        PG8_STAGE(PG8_SB(0, 0), cB, voffB); PG8_STAGE(PG8_SB(0, 1), cB + hstepB, voffB); PG8_STAGE(PG8_SA(0, 0), cA, voffA); PG8_STAGE(PG8_SA(0, 1), cA + hstepA, voffA);
        if (wr == 1) PG8_BAR;
        PG8_WAIT_V(2); PG8_BAR;
        PG8_STAGE(PG8_SB(1, 0), cB + kstep, voffB); PG8_STAGE(PG8_SA(1, 0), cA + kstep, voffA); PG8_STAGE(PG8_SB(1, 1), cB + hstepB + kstep, voffB);
        PG8_WAIT_V(6); PG8_BAR;
    } else {
        PG8_STAGE(PG8_SB(0, 0), cB, voffB); PG8_STAGE(PG8_SA(0, 0), cA, voffA); PG8_STAGE(PG8_SB(0, 1), cB + hstepB, voffB); PG8_STAGE(PG8_SA(0, 1), cA + hstepA, voffA);
        if (wr == 1) PG8_BAR;
        PG8_WAIT_V(4); PG8_BAR;
        PG8_STAGE(PG8_SB(1, 0), cB + kstep, voffB); PG8_STAGE(PG8_SA(1, 0), cA + kstep, voffA); PG8_STAGE(PG8_SB(1, 1), cB + hstepB + kstep, voffB);
        PG8_WAIT_V(6); PG8_BAR;
    }
    for (;;) {
        const bool has_next = S.next(ui + 1, nxt);
        const char* nA = has_next ? (const char*)g.A + (g.ovl ? (size_t)ovl_row_base(nxt.pm) * lda * 2 : (size_t)nxt.pm * tstepA) : cA; const char* nB = has_next ? (const char*)g.Bt + (size_t)nxt.pn * tstepB : cB;
        for (int t = 0; t < nt; t += 2) {
            const bool last = (t == nt - 2);
            const char* a1 = cA + (size_t)(t + 1) * kstep;
            const char* a2 = last ? nA : cA + (size_t)(t + 2) * kstep; const char* b2 = last ? nB : cB + (size_t)(t + 2) * kstep;
            const char* a3 = a2 + kstep; const char* b3 = b2 + kstep;
            if (last && has_next) S.a_ready(nxt);
            if constexpr (Epi::MIDK) { if (t == Epi::MIDK_T) E.midk(acc, cur, wr, fr, fq); }
            if constexpr (SP2) {
            PG8_LDB(B0, 0, 0); PG8_LDB(B1, 0, 1); PG8_SCHED; PG8_LDA(At, 0, 0); PG8_STAGE(PG8_SA(1, 1), a1 + hstepA, voffA);
            PG8_WAIT_V(8); PG8_WAIT_L(0); PG8_BAR; PG8_MMA(0, 0, At, B0); PG8_MMA(0, 1, At, B1); PG8_BAR; PG8_SCHED;
            PG8_LDA(At, 0, 1); PG8_STAGE(PG8_SB(0, 0), b2, voffB); PG8_STAGE(PG8_SB(0, 1), b2 + hstepB, voffB); PG8_STAGE(PG8_SA(0, 0), a2, voffA);
            PG8_WAIT_V(8); PG8_WAIT_L(0); PG8_BAR; PG8_MMA(1, 0, At, B0); PG8_MMA(1, 1, At, B1); PG8_BAR; PG8_SCHED;
            PG8_LDB(B0, 1, 0); PG8_LDB(B1, 1, 1); PG8_SCHED; PG8_LDA(At, 1, 0); PG8_STAGE(PG8_SA(0, 1), a2 + hstepA, voffA);
            PG8_WAIT_V(8); PG8_WAIT_L(0); PG8_BAR; PG8_MMA(0, 0, At, B0); PG8_MMA(0, 1, At, B1); PG8_BAR; PG8_SCHED;
            PG8_LDA(At, 1, 1); PG8_STAGE(PG8_SB(1, 0), b3, voffB); PG8_STAGE(PG8_SB(1, 1), b3 + hstepB, voffB); PG8_STAGE(PG8_SA(1, 0), a3, voffA);
            PG8_WAIT_V(8); PG8_WAIT_L(0); PG8_BAR; PG8_MMA(1, 0, At, B0); PG8_MMA(1, 1, At, B1); PG8_BAR; PG8_SCHED;
            } else {
            PG8_LDB(B0, 0, 0); PG8_SCHED; PG8_LDA(At, 0, 0); PG8_STAGE(PG8_SA(1, 1), a1 + hstepA, voffA);
            PG8_WAIT_L(8); PG8_BAR; PG8_WAIT_L(0); PG8_MMA(0, 0, At, B0); PG8_BAR; PG8_SCHED;
            PG8_LDB(B1, 0, 1); PG8_STAGE(PG8_SB(0, 0), b2, voffB);
            PG8_BAR; PG8_WAIT_L(0); PG8_MMA(0, 1, At, B1); PG8_BAR;
            PG8_LDA(At, 0, 1); PG8_STAGE(PG8_SA(0, 0), a2, voffA);
            PG8_BAR; PG8_WAIT_L(0); PG8_MMA(1, 0, At, B0); PG8_BAR; PG8_SCHED;
            PG8_STAGE(PG8_SB(0, 1), b2 + hstepB, voffB);
            PG8_WAIT_V(6); PG8_BAR; PG8_MMA(1, 1, At, B1); PG8_BAR;
            PG8_LDB(B0, 1, 0); PG8_SCHED; PG8_LDA(At, 1, 0); PG8_STAGE(PG8_SA(0, 1), a2 + hstepA, voffA);
            PG8_WAIT_L(8); PG8_BAR; PG8_WAIT_L(0); PG8_MMA(0, 0, At, B0); PG8_BAR; PG8_SCHED;
            PG8_LDB(B1, 1, 1); PG8_STAGE(PG8_SB(1, 0), b3, voffB);
            PG8_BAR; PG8_WAIT_L(0); PG8_MMA(0, 1, At, B1); PG8_BAR;
            PG8_LDA(At, 1, 1); PG8_STAGE(PG8_SA(1, 0), a3, voffA);
            PG8_BAR; PG8_WAIT_L(0); PG8_MMA(1, 0, At, B0); PG8_BAR; PG8_SCHED;
            PG8_STAGE(PG8_SB(1, 1), b3 + hstepB, voffB);
            PG8_WAIT_V(6); PG8_BAR; PG8_MMA(1, 1, At, B1); PG8_BAR;
            }
        }
        if constexpr (ALIGN_EPI) { if (wr == 0) PG8_BAR; }
        if constexpr (!Epi::AFTER_DRAIN) { E(acc, cur, wr, wc, fr, fq); S.done(cur); }
        if constexpr (Epi::PREFETCH) { if (has_next) E.prefetch(nxt, wid, lane); }
        if (!has_next) break;
#pragma unroll
        for (int a = 0; a < 2; ++a)
#pragma unroll
            for (int b = 0; b < 2; ++b)
#pragma unroll
                for (int m = 0; m < 4; ++m)
#pragma unroll
                    for (int n = 0; n < 2; ++n) acc[a][b][m][n] = (acc_t){0, 0, 0, 0};
        cur = nxt; cA = nA; cB = nB; ++ui;
        if constexpr (ALIGN_EPI) { if (wr == 1) PG8_BAR; }
    }
    PG8_WAIT_V(0);
    if constexpr (!ALIGN_EPI) { if (wr == 0) PG8_BAR; }
    PG8_BAR;
#undef PG8_SA
#undef PG8_SB
#undef PG8_STAGE
#undef PG8_LDA
#undef PG8_LDB
#undef PG8_MMA
#undef PG8_WAIT_V
#undef PG8_WAIT_L
#undef PG8_BAR
#undef PG8_SCHED
}
}

constexpr int NWAVES = 8;
#ifndef MK_ONE_LAUNCH
#define MK_ONE_LAUNCH 1
#endif
constexpr int N_PHASES = 11;

constexpr int BATCH = 8, SEQ = 4096, D = 1024, NH = 12, HD = 64, AW = 768, NG = 4, GD = 64, FW = 256, MIXW = 1024, NPROJ = 2560, FF = 2816;
constexpr int M = BATCH * SEQ;
constexpr float EPS = 1e-6f;

constexpr size_t MiB = 1u << 20;
constexpr size_t WS_CTL = 0, CTL_ZERO_BYTES = 96 * 1024;
constexpr size_t WS_TAB = 1 * MiB;
constexpr size_t TAB_BIAS = 0;
constexpr size_t TAB_MG = 32 * 1024;
constexpr size_t TAB_TW = 192 * 1024;
constexpr size_t TAB_CW4 = 256 * 1024;
constexpr size_t WS_WIN = 2 * MiB;
constexpr size_t WS_WOUT = 7 * MiB;
constexpr size_t WS_WGV = 9 * MiB;
constexpr size_t WS_WD = 20 * MiB;
constexpr size_t WS_XN = 26 * MiB;
constexpr size_t WS_PROJ = 90 * MiB;
constexpr size_t WS_A2 = 250 * MiB;
constexpr size_t WS_PQ = 314 * MiB;
constexpr size_t WS_ML = 380 * MiB;
constexpr size_t WS_A8 = 314 * MiB;
constexpr size_t WS_HALO = 400 * MiB;
constexpr size_t WS_RS0 = 441 * MiB;
constexpr size_t WS_XBUF = 440 * MiB;
constexpr size_t WS_SSA = 446 * MiB;
constexpr size_t WS_SS1 = 442 * MiB;
constexpr size_t WS_SS2 = 444 * MiB;
constexpr size_t WS_GV = 90 * MiB;
constexpr size_t WS_END = 448 * MiB;
constexpr int CW_BAR = 1024, CW_PANEL = 8192, CW_CMAX = 16384;

constexpr int RING_OFF = 0, RING_BYTES = 131072;
constexpr int LDSCTL_OFF = RING_BYTES, MISC_OFF = LDSCTL_OFF + 320;
constexpr int LDS_BYTES = 163840;

#define GAS __attribute__((address_space(1)))
#define LAS __attribute__((address_space(3)))
typedef unsigned short bf16;
typedef unsigned v4u __attribute__((ext_vector_type(4)));
typedef unsigned v2u __attribute__((ext_vector_type(2)));
typedef float f32x4 __attribute__((ext_vector_type(4)));
typedef GAS unsigned gu32;
#define RLX_AGENT __ATOMIC_RELAXED, __HIP_MEMORY_SCOPE_AGENT
#define LDS_WAIT() asm volatile("s_waitcnt lgkmcnt(0)" ::: "memory")
#define VM_WAIT() asm volatile("s_waitcnt vmcnt(0)" ::: "memory")
__device__ __forceinline__ unsigned f2bf(float f) { unsigned u = __builtin_bit_cast(unsigned, f); return (u + 0x7fffu + ((u >> 16) & 1u)) >> 16; }
__device__ __forceinline__ unsigned pk2(float lo, float hi) { return f2bf(lo) | (f2bf(hi) << 16); }
__device__ __forceinline__ float bflo(unsigned w) { return __builtin_bit_cast(float, w << 16); }
__device__ __forceinline__ float bfhi(unsigned w) { return __builtin_bit_cast(float, w & 0xffff0000u); }
__device__ __forceinline__ float bf2f(bf16 h) { return __builtin_bit_cast(float, (unsigned)h << 16); }

#define XB_TMO      128
#define XB_XCNT(j)  (256  + 64 * (j))
#define XB_XSUB(j)  (1280 + 64 * (j))
#define XB_XGEN(j)  (2304 + 64 * (j))
#define XB_TOP      3328
#define XB_TOPGEN   3392
#define XCD_BAR_WORDS 3456
#define XB_SPIN_CAP (1u << 18)
__device__ __forceinline__ unsigned xb_ld(unsigned* p)              { return __hip_atomic_load(p, __ATOMIC_RELAXED, __HIP_MEMORY_SCOPE_AGENT); }
__device__ __forceinline__ unsigned xb_add(unsigned* p, unsigned v) { return __hip_atomic_fetch_add(p, v, __ATOMIC_RELAXED, __HIP_MEMORY_SCOPE_AGENT); }
__device__ __forceinline__ unsigned xb_xcc_id() { return (unsigned)__builtin_amdgcn_s_getreg((3 << 11) | 20) & 0xFu; }
#define XB_SPIN(cond, bar) do { unsigned _sp = 0; while (cond) { __builtin_amdgcn_s_sleep(1); \
    if ((++_sp & 255u) == 0u) { if (xb_ld(&(bar)[XB_TMO])) break; if (_sp > XB_SPIN_CAP) { atomicAdd(&(bar)[XB_TMO], 1u); break; } } } } while (0)
struct XcdBarrier { unsigned* bar; unsigned x; volatile LAS unsigned* st; };
__device__ __forceinline__ XcdBarrier xcd_barrier_post(unsigned* bar, volatile LAS unsigned* st) {
    XcdBarrier b; b.bar = bar; b.x = xb_xcc_id(); b.st = st;
    if (threadIdx.x == 0) (void)xb_add(&bar[XB_XCNT(b.x)], 1u);
    return b;
}
__device__ __forceinline__ void xcd_barrier_complete(unsigned* bar, unsigned x, unsigned& nloc, unsigned& nx) {
    const unsigned G = gridDim.x * gridDim.y * gridDim.z;
    unsigned sum, cnt, mine, sp = 0u;
    for (;;) {
        sum = 0u; cnt = 0u; mine = 0u;
#pragma unroll
        for (unsigned j = 0; j < 16; ++j) { const unsigned c = xb_ld(&bar[XB_XCNT(j)]); sum += c; cnt += (c > 0u) ? 1u : 0u; mine = (j == x) ? c : mine; }
        if (sum == G) break;
        __builtin_amdgcn_s_sleep(1);
        if ((++sp & 255u) == 0u) { if (xb_ld(&bar[XB_TMO])) break; if (sp > XB_SPIN_CAP) { atomicAdd(&bar[XB_TMO], 1u); break; } }
    }
    nloc = mine > 0u ? mine : 1u; nx = cnt > 0u ? cnt : 1u;
}
__device__ __forceinline__ void xcd_barrier(const XcdBarrier& b) {
    asm volatile("s_waitcnt vmcnt(0)" ::: "memory");
    __syncthreads();
    if (threadIdx.x == 0) {
        unsigned* bar = b.bar;
        __builtin_amdgcn_s_waitcnt(0);
        unsigned nloc = b.st[0], nx = b.st[1];
        if (nloc == 0u) { xcd_barrier_complete(bar, b.x, nloc, nx); b.st[0] = nloc; b.st[1] = nx; }
        const unsigned old = xb_add(&bar[XB_XSUB(b.x)], 1u);
        const unsigned gen = old / nloc;
        if (old + 1u == (gen + 1u) * nloc) {
            __builtin_amdgcn_fence(__ATOMIC_RELEASE, "agent");
            asm volatile("s_waitcnt vmcnt(0)" ::: "memory");
            const unsigned og = xb_add(&bar[XB_TOP], 1u);
            const unsigned tg = og / nx;
            if (og + 1u == (tg + 1u) * nx) xb_add(&bar[XB_TOPGEN], 1u);
            else XB_SPIN(xb_ld(&bar[XB_TOPGEN]) == tg, bar);
            __builtin_amdgcn_fence(__ATOMIC_ACQUIRE, "agent");
            xb_add(&bar[XB_XGEN(b.x)], 1u);
            asm volatile("s_waitcnt vmcnt(0)" ::: "memory");
        } else {
            XB_SPIN(xb_ld(&bar[XB_XGEN(b.x)]) == gen, bar);
            __builtin_amdgcn_fence(__ATOMIC_ACQUIRE, "agent");
            asm volatile("s_waitcnt vmcnt(0)" ::: "memory");
        }
    }
    __syncthreads();
}

struct Frame {
    LAS unsigned char* lds;
    volatile LAS unsigned* MISC;
    gu32* ctl;
    int tid, lane, wave;
    int vcu, G;
    const float *x, *g_mix, *w_in, *g_attn, *rel_tab, *f_w, *f_b, *g_four, *w_out, *g_ffn, *w_gate, *w_val, *conv_w, *conv_b, *w_down, *g_fin;
    float* out;
    unsigned char* ws;
};

__device__ __forceinline__ float wave_sum(float v) {
#pragma unroll
    for (int o = 1; o < 64; o <<= 1) v += __shfl_xor(v, o);
    return v;
}
__device__ __forceinline__ void p0_transpose_item(const float* W, int K, int N, bf16* WT, int row_off, LAS float* scr, int item, int lane, const float* gain = nullptr, bool il = false) {
    const int nblk = N / 32, kb = item / nblk, nb = item % nblk, k0 = 64 * kb, n0 = 32 * nb; if (il) row_off += 128 * (n0 >> 7);
    {   f32x4 v[8]; const int c4 = 4 * (lane & 7);
#pragma unroll
        for (int i = 0; i < 8; ++i) v[i] = *(const GAS f32x4*)(W + (size_t)(k0 + (lane >> 3) + 8 * i) * N + n0 + c4);
#pragma unroll
        for (int i = 0; i < 8; ++i) { const int kk = (lane >> 3) + 8 * i; const float gsc = gain ? gain[k0 + kk] : 1.0f; LAS float* sp = scr + kk * 33 + c4;
            sp[0] = v[i].x * gsc; sp[1] = v[i].y * gsc; sp[2] = v[i].z * gsc; sp[3] = v[i].w * gsc; } }
    LDS_WAIT(); asm volatile("" ::: "memory");
    const int c = lane & 7;
#pragma unroll
    for (int j = 0; j < 4; ++j) { const int n = (lane >> 3) + 8 * j; const LAS float* s = scr + (8 * c) * 33 + n;
        v4u o; o.x = pk2(s[0 * 33], s[1 * 33]); o.y = pk2(s[2 * 33], s[3 * 33]); o.z = pk2(s[4 * 33], s[5 * 33]); o.w = pk2(s[6 * 33], s[7 * 33]);
        *(GAS v4u*)(WT + (size_t)(row_off + n0 + n) * K + k0 + 8 * c) = o; }
    LDS_WAIT(); asm volatile("" ::: "memory");
}

__device__ __forceinline__ void p0_colmax_item(const float* W, int K, int N, unsigned* cmax, int row_off, int item, int lane, const float* gain) {
    const int nblk = N / 32, kb = item / nblk, nb = item % nblk, k0 = 64 * kb, n0 = 32 * nb, c4 = 4 * (lane & 7); row_off += 128 * (n0 >> 7);
    f32x4 mx = (f32x4){0.f, 0.f, 0.f, 0.f};
#pragma unroll
    for (int i = 0; i < 8; ++i) { const int kk = (lane >> 3) + 8 * i; const f32x4 v = *(const GAS f32x4*)(W + (size_t)(k0 + kk) * N + n0 + c4) * gain[k0 + kk];
        mx[0] = fmaxf(mx[0], fabsf(v[0])); mx[1] = fmaxf(mx[1], fabsf(v[1])); mx[2] = fmaxf(mx[2], fabsf(v[2])); mx[3] = fmaxf(mx[3], fabsf(v[3])); }
#pragma unroll
    for (int j = 0; j < 4; ++j) { float t = mx[j]; t = fmaxf(t, __shfl_xor(t, 8)); t = fmaxf(t, __shfl_xor(t, 16)); t = fmaxf(t, __shfl_xor(t, 32)); mx[j] = t; }
    if (lane < 8) {
#pragma unroll
        for (int j = 0; j < 4; ++j) atomicMax(cmax + row_off + n0 + c4 + j, __float_as_uint(mx[j])); }
}
__device__ __forceinline__ void p6_quant_item(const float* W, int K, int N, unsigned char* WT, int row_off, LAS float* scr, int item, int lane, const float* gain, const unsigned* cmax) {
    const int nblk = N / 32, kb = item / nblk, nb = item % nblk, k0 = 64 * kb, n0 = 32 * nb; row_off += 128 * (n0 >> 7);
    {   f32x4 v[8]; const int c4 = 4 * (lane & 7);
#pragma unroll
        for (int i = 0; i < 8; ++i) v[i] = *(const GAS f32x4*)(W + (size_t)(k0 + (lane >> 3) + 8 * i) * N + n0 + c4);
#pragma unroll
        for (int i = 0; i < 8; ++i) { const int kk = (lane >> 3) + 8 * i; const float gsc = gain[k0 + kk]; LAS float* sp = scr + kk * 33 + c4;
            sp[0] = v[i].x * gsc; sp[1] = v[i].y * gsc; sp[2] = v[i].z * gsc; sp[3] = v[i].w * gsc; } }
    LDS_WAIT(); asm volatile("" ::: "memory");
    const int c = lane & 7;
#pragma unroll
    for (int j = 0; j < 4; ++j) { const int n = (lane >> 3) + 8 * j; const LAS float* s = scr + (8 * c) * 33 + n; const float cm = __uint_as_float(cmax[row_off + n0 + n]); const float inv = cm > 0.f ? 127.0f / cm : 0.f;
        unsigned lo = 0, hi = 0;
#pragma unroll
        for (int t = 0; t < 4; ++t) { lo |= ((unsigned)(int)__builtin_rintf(s[t * 33] * inv) & 255u) << (8 * t); hi |= ((unsigned)(int)__builtin_rintf(s[(4 + t) * 33] * inv) & 255u) << (8 * t); }
        v2u o; o.x = lo; o.y = hi; *(GAS v2u*)(WT + (size_t)(row_off + n0 + n) * K + k0 + 8 * c) = o; }
    LDS_WAIT(); asm volatile("" ::: "memory");
}
__device__ __forceinline__ void rms_row_to_bf16(const float* xrow, const float* gain, bf16* orow, int lane) {
    const GAS f32x4* xr = (const GAS f32x4*)xrow + lane; const GAS f32x4* gr = (const GAS f32x4*)gain + lane;
    f32x4 v[4]; float s = 0.f;
#pragma unroll
    for (int j = 0; j < 4; ++j) { v[j] = xr[64 * j]; s += (v[j].x * v[j].x + v[j].y * v[j].y) + (v[j].z * v[j].z + v[j].w * v[j].w); }
    const float rstd = 1.0f / sqrtf(wave_sum(s) * (1.f / D) + EPS);
    GAS unsigned long long* o8 = (GAS unsigned long long*)orow + lane;
#pragma unroll
    for (int j = 0; j < 4; ++j) { const f32x4 gg = gr[64 * j]; o8[64 * j] = (unsigned long long)pk2(v[j].x * rstd * gg.x, v[j].y * rstd * gg.y) | ((unsigned long long)pk2(v[j].z * rstd * gg.z, v[j].w * rstd * gg.w) << 32); }
}
__device__ __forceinline__ int t5_bucket(int rel) {
    const int ret = rel > 0 ? 16 : 0; const int n = rel < 0 ? -rel : rel;
    const float nf = (float)(n > 1 ? n : 1);
    int large = 8 + (int)(logf(nf / 8.0f) / logf(128.0f) * 8.0f);
    large = large < 15 ? large : 15;
    return ret + (n < 8 ? n : large);
}

__device__ __forceinline__ void p0_prologue(Frame& F) {
    LAS float* scr = (LAS float*)(F.lds + RING_OFF + F.wave * 16384);
    const int gw = F.vcu * NWAVES + F.wave, NGW = F.G * NWAVES;
    bf16* WinT = (bf16*)(F.ws + WS_WIN); bf16* WoutT = (bf16*)(F.ws + WS_WOUT); bf16* WgvT = (bf16*)(F.ws + WS_WGV); bf16* WdT = (bf16*)(F.ws + WS_WD);
    constexpr int I_IN = (D / 64) * (NPROJ / 32), I_OUT = (MIXW / 64) * (D / 32), I_G = (D / 64) * (FF / 32), I_D = (FF / 64) * (D / 32);
    constexpr int NITEMS = I_IN + I_OUT + 2 * I_G + I_D;
    for (int it = gw; it < NITEMS; it += NGW) {
        int r = it;
        if (r < I_IN) { p0_transpose_item(F.w_in, D, NPROJ, WinT, 0, scr, r, F.lane, F.g_mix); continue; } r -= I_IN;
        if (r < I_OUT) { const int k0 = 64 * (r / (D / 32)); p0_transpose_item(F.w_out, MIXW, D, WoutT, 0, scr, r, F.lane, k0 < AW ? F.g_attn : F.g_four - AW); continue; } r -= I_OUT;
        if (r < 2 * I_G) { const bool isv = r >= I_G; p0_colmax_item(isv ? F.w_val : F.w_gate, D, FF, (unsigned*)(F.ctl + CW_CMAX), isv ? 128 : 0, isv ? r - I_G : r, F.lane, F.g_ffn); continue; } r -= 2 * I_G;
        p0_transpose_item(F.w_down, FF, D, WdT, 0, scr, r, F.lane);
    }
    float* tabBias = (float*)(F.ws + WS_TAB + TAB_BIAS); float* tabMg = (float*)(F.ws + WS_TAB + TAB_MG); float* tabTw = (float*)(F.ws + WS_TAB + TAB_TW);
    const int gt = F.vcu * (NWAVES * 64) + F.tid, NGT = F.G * NWAVES * 64;
    for (int i = gt; i < 3 * 129 * 12; i += NGT) { const int h = i % 12, jj = (i / 12) % 129, br = i / (12 * 129); const int dil = br == 0 ? 1 : (br == 1 ? 4 : 16);
        tabBias[i] = F.rel_tab[t5_bucket((jj - 64) * dil) * 12 + h]; }
    for (int i = gt; i < 4 * 64 * 128; i += NGT) { const int col = i & 127, c = (i >> 7) & 63, g = i >> 13; const int e = col & 63; float acc = 0.f;
        for (int d = 0; d < 64; ++d) { const float rev = (float)((c * d) & 63) * (1.0f / 64.0f); const float t = col < 64 ? __builtin_amdgcn_cosf(rev) : -__builtin_amdgcn_sinf(rev); acc += t * F.f_w[(g * 64 + d) * 64 + e]; }
        tabMg[i] = acc; }
    for (int i = gt; i < 4096; i += NGT) { float sv, cv; sincospif((float)i * (1.0f / 2048.0f), &sv, &cv); tabTw[2 * i] = cv; tabTw[2 * i + 1] = sv; }
    bf16* XN = (bf16*)(F.ws + WS_XN);
    {   float* RS0 = (float*)(F.ws + WS_RS0);
        for (int m0 = gw; m0 < M; m0 += 4 * NGW) { f32x4 v[4][4];
#pragma unroll
            for (int r = 0; r < 4; ++r) { const int m = m0 + r * NGW; const GAS f32x4* xr = (const GAS f32x4*)(F.x + (size_t)(m < M ? m : 0) * D) + F.lane;
#pragma unroll
                for (int j = 0; j < 4; ++j) v[r][j] = xr[64 * j]; }
#pragma unroll
            for (int r = 0; r < 4; ++r) { const int m = m0 + r * NGW; float s = 0.f;
#pragma unroll
                for (int j = 0; j < 4; ++j) s += (v[r][j].x * v[r][j].x + v[r][j].y * v[r][j].y) + (v[r][j].z * v[r][j].z + v[r][j].w * v[r][j].w);
                const float rstd = 1.0f / sqrtf(wave_sum(s) * (1.f / D) + EPS);
                if (m < M) { GAS unsigned long long* o8 = (GAS unsigned long long*)(XN + (size_t)m * D) + F.lane; if (F.lane == 0) RS0[m] = rstd;
#pragma unroll
                    for (int j = 0; j < 4; ++j) { const f32x4 t = v[r][j]; o8[64 * j] = (unsigned long long)pk2(t.x, t.y) | ((unsigned long long)pk2(t.z, t.w) << 32); } } } } }
}

namespace att {
typedef short bf16x8 __attribute__((ext_vector_type(8)));
typedef short v4i16 __attribute__((ext_vector_type(4)));
constexpr float LOG2E = 1.4426950408889634f;
constexpr int TABN = 512, TPAD0 = 128;
constexpr int LDS_K = 0, LDS_V = 49152, LDS_T0 = 98304, LDS_T1 = 98304 + 8192;
struct QT { bf16x8 q[2]; f32x4 o[4]; float m, l; };
__device__ __forceinline__ v4i16 vtr(const LAS unsigned char* p) { return __builtin_amdgcn_ds_read_tr16_b64_v4i16((LAS v4i16*)p); }

__device__ __forceinline__ void build_table(Frame& F, int ldsoff, int br, int h) {
    const float* tabBias = (const float*)(F.ws + WS_TAB + TAB_BIAS);
    LAS float* T = (LAS float*)(F.lds + ldsoff);
    for (int e = F.tid; e < 4 * TABN; e += NWAVES * 64) { const int s = e / TABN, n = e % TABN; const int r64 = n + s - TPAD0;
        T[e] = (r64 >= 0 && r64 <= 128) ? tabBias[(br * 129 + r64) * 12 + h] * LOG2E : -INFINITY; }
}
__device__ __forceinline__ const LAS float* table_ptr(Frame& F, int ldsoff, int idx0) { const int s = idx0 & 3; return (const LAS float*)(F.lds + ldsoff) + s * TABN + (idx0 - s); }

__device__ __forceinline__ int pass_tok(int mode, int a, int row) {
    if (mode == 0) { const int t = a - 64 + row; return (t >= 0 && t < SEQ) ? t : -1; }
    if (mode == 3) return a + 16 * row;
    const int hi = row >= 192 ? 1 : 0, u = a + (hi ? row - 192 : row), c = 2 * (mode - 1) + hi; return (u >= 0 && u < SEQ / 4) ? c + 4 * u : -1;
}
struct Pre { v4u k[6], v[6]; };
template <int NIT> __device__ __forceinline__ void prefetch(Frame& F, Pre& R, const bf16* P, int h, int mode, int a) {
#pragma unroll
    for (int it = 0; it < NIT; ++it) { const int idx = F.tid + it * (NWAVES * 64), row = idx >> 3, ph = idx & 7; const int t = pass_tok(mode, a, row);
        const int ck = ph ^ ((row >> 1) & 7), cv = ph ^ (((row >> 1) & 3) << 1);
        R.k[it] = (v4u){0u, 0u, 0u, 0u}; R.v[it] = (v4u){0u, 0u, 0u, 0u};
        if (t >= 0) { const bf16* rp = P + (size_t)t * NPROJ + h * 64; R.k[it] = *(const GAS v4u*)(rp + AW + ck * 8); R.v[it] = *(const GAS v4u*)(rp + 2 * AW + cv * 8); } }
}
template <int NIT> __device__ __forceinline__ void commit(Frame& F, const Pre& R) {
#pragma unroll
    for (int it = 0; it < NIT; ++it) { const int idx = F.tid + it * (NWAVES * 64);
        *(LAS v4u*)(F.lds + LDS_K + idx * 16) = R.k[it]; *(LAS v4u*)(F.lds + LDS_V + idx * 16) = R.v[it]; }
}
__device__ __forceinline__ float xmax4(float v) {
    auto a = __builtin_amdgcn_permlane16_swap(__float_as_uint(v), __float_as_uint(v), false, false); v = fmaxf(__uint_as_float(a[0]), __uint_as_float(a[1]));
    auto b = __builtin_amdgcn_permlane32_swap(__float_as_uint(v), __float_as_uint(v), false, false); return fmaxf(__uint_as_float(b[0]), __uint_as_float(b[1]));
}
__device__ __forceinline__ float xsum4(float v) {
    auto a = __builtin_amdgcn_permlane16_swap(__float_as_uint(v), __float_as_uint(v), false, false); v = __uint_as_float(a[0]) + __uint_as_float(a[1]);
    auto b = __builtin_amdgcn_permlane32_swap(__float_as_uint(v), __float_as_uint(v), false, false); return __uint_as_float(b[0]) + __uint_as_float(b[1]);
}
__device__ __forceinline__ void load_q(QT& T, const bf16* qrow  , int g) {
#pragma unroll
    for (int ks = 0; ks < 2; ++ks) { const v4u w = *(const GAS v4u*)(qrow + 8 * g + 32 * ks); const float sc = 0.125f * LOG2E; v4u o;
        o.x = pk2(bflo(w.x) * sc, bfhi(w.x) * sc); o.y = pk2(bflo(w.y) * sc, bfhi(w.y) * sc); o.z = pk2(bflo(w.z) * sc, bfhi(w.z) * sc); o.w = pk2(bflo(w.w) * sc, bfhi(w.w) * sc);
        T.q[ks] = __builtin_bit_cast(bf16x8, o); }
#pragma unroll
    for (int db = 0; db < 4; ++db) T.o[db] = (f32x4){0.f, 0.f, 0.f, 0.f};
    T.m = -1e30f; T.l = 0.f;
}
typedef float f32x2_t __attribute__((ext_vector_type(2))); typedef __bf16 bf16x2_t __attribute__((ext_vector_type(2)));
__device__ __forceinline__ unsigned cvtpk(float lo, float hi) { f32x2_t v = {lo, hi}; bf16x2_t b = __builtin_convertvector(v, bf16x2_t); return __builtin_bit_cast(unsigned, b); }
constexpr float THR = 8.0f;
template <int NQ, int NP> __device__ __forceinline__ void attn_step(QT (&T)[NQ], const LAS unsigned char* kp, const LAS unsigned char* vp, const LAS float* const (&tp)[NQ], int p, int koff0, int koff1, const int (&voff)[4], int klo, int khi, bool edge, int g) {
    bf16x8 kf[NP][4]; v4i16 vlo[NP][4], vhi[NP][4];
#pragma unroll
    for (int c = 0; c < NP; ++c) { kf[c][0] = *(const LAS bf16x8*)(kp + c * 4096 + koff0); kf[c][1] = *(const LAS bf16x8*)(kp + c * 4096 + koff1); kf[c][2] = *(const LAS bf16x8*)(kp + c * 4096 + 2048 + koff0); kf[c][3] = *(const LAS bf16x8*)(kp + c * 4096 + 2048 + koff1);
#pragma unroll
        for (int db = 0; db < 4; ++db) { vlo[c][db] = vtr(vp + c * 4096 + voff[db]); vhi[c][db] = vtr(vp + c * 4096 + 2048 + voff[db]); } }
#pragma unroll
    for (int n = 0; n < NQ; ++n) {
        f32x4 s[NP][2];
#pragma unroll
        for (int c = 0; c < NP; ++c) {
            s[c][0] = *(const LAS f32x4*)(tp[n] + (p + c) * 32); s[c][1] = *(const LAS f32x4*)(tp[n] + (p + c) * 32 + 16);
            s[c][0] = __builtin_amdgcn_mfma_f32_16x16x32_bf16(kf[c][0], T[n].q[0], s[c][0], 0, 0, 0); s[c][0] = __builtin_amdgcn_mfma_f32_16x16x32_bf16(kf[c][1], T[n].q[1], s[c][0], 0, 0, 0);
            s[c][1] = __builtin_amdgcn_mfma_f32_16x16x32_bf16(kf[c][2], T[n].q[0], s[c][1], 0, 0, 0); s[c][1] = __builtin_amdgcn_mfma_f32_16x16x32_bf16(kf[c][3], T[n].q[1], s[c][1], 0, 0, 0);
            if (edge) { const int kk = (p + c) * 32 + 4 * g;
#pragma unroll
                for (int r = 0; r < 4; ++r) { if (kk + r < klo || kk + r >= khi) s[c][0][r] = -INFINITY; if (kk + 16 + r < klo || kk + 16 + r >= khi) s[c][1][r] = -INFINITY; } } }
        float tm = fmaxf(fmaxf(fmaxf(s[0][0][0], s[0][0][1]), fmaxf(s[0][0][2], s[0][0][3])), fmaxf(fmaxf(s[0][1][0], s[0][1][1]), fmaxf(s[0][1][2], s[0][1][3])));
        if (NP == 2) tm = fmaxf(tm, fmaxf(fmaxf(fmaxf(s[NP - 1][0][0], s[NP - 1][0][1]), fmaxf(s[NP - 1][0][2], s[NP - 1][0][3])), fmaxf(fmaxf(s[NP - 1][1][0], s[NP - 1][1][1]), fmaxf(s[NP - 1][1][2], s[NP - 1][1][3]))));
        tm = xmax4(tm);
        if (__any(tm > T[n].m + THR)) { const float mn = fmaxf(T[n].m, tm), al = __builtin_amdgcn_exp2f(T[n].m - mn); T[n].m = mn; T[n].l *= al;
#pragma unroll
            for (int db = 0; db < 4; ++db) T[n].o[db] = T[n].o[db] * al; }
        const float mref = T[n].m; float ls = 0.f;
#pragma unroll
        for (int c = 0; c < NP; ++c) {
#pragma unroll
            for (int r = 0; r < 4; ++r) { s[c][0][r] = __builtin_amdgcn_exp2f(s[c][0][r] - mref); s[c][1][r] = __builtin_amdgcn_exp2f(s[c][1][r] - mref); }
            ls += ((s[c][0][0] + s[c][0][1]) + (s[c][0][2] + s[c][0][3])) + ((s[c][1][0] + s[c][1][1]) + (s[c][1][2] + s[c][1][3])); }
        T[n].l += ls;
#pragma unroll
        for (int c = 0; c < NP; ++c) {
            v4u pw; pw.x = cvtpk(s[c][0][0], s[c][0][1]); pw.y = cvtpk(s[c][0][2], s[c][0][3]); pw.z = cvtpk(s[c][1][0], s[c][1][1]); pw.w = cvtpk(s[c][1][2], s[c][1][3]);
            const bf16x8 pf = __builtin_bit_cast(bf16x8, pw);
#pragma unroll
            for (int db = 0; db < 4; ++db) { const bf16x8 vf = (bf16x8){vlo[c][db][0], vlo[c][db][1], vlo[c][db][2], vlo[c][db][3], vhi[c][db][0], vhi[c][db][1], vhi[c][db][2], vhi[c][db][3]};
                T[n].o[db] = __builtin_amdgcn_mfma_f32_16x16x32_bf16(vf, pf, T[n].o[db], 0, 0, 0); } }
    }
}
template <int NQ> __device__ __forceinline__ void attn_job(QT (&T)[NQ], const LAS unsigned char* Kw, const LAS unsigned char* Vw, int npairs, const LAS float* const (&tp)[NQ], int klo, int khi, bool edge, int lane) {
    const int i = lane & 15, g = lane >> 4;
    const int koff0 = i * 128 + (((g) ^ (i >> 1)) << 4), koff1 = i * 128 + (((g + 4) ^ (i >> 1)) << 4);
    const int qq = i >> 2, pp = i & 3, vr = 4 * g + qq, fv = (vr >> 1) & 3;
    int voff[4];
#pragma unroll
    for (int db = 0; db < 4; ++db) voff[db] = vr * 128 + ((((db ^ fv) << 1) + (pp >> 1)) << 4) + (pp & 1) * 8;
    int p = 0;
    if (NQ == 1) {
#pragma unroll 1
        for (; p + 2 <= npairs; p += 2) attn_step<NQ, 2>(T, Kw + p * 4096, Vw + p * 4096, tp, p, koff0, koff1, voff, klo, khi, edge, g);
    }
#pragma unroll 1
    for (; p < npairs; ++p) attn_step<NQ, 1>(T, Kw + p * 4096, Vw + p * 4096, tp, p, koff0, koff1, voff, klo, khi, edge, g);
}
__device__ __forceinline__ void four_ssq(Frame& F) {
    const bf16* A2 = (const bf16*)(F.ws + WS_A2); float* SSA = (float*)(F.ws + WS_SSA);
    const int gw = F.vcu * NWAVES + F.wave, NGW = F.G * NWAVES;
    for (int m0 = gw; m0 < M; m0 += 4 * NGW) { v2u w[4];
#pragma unroll
        for (int r = 0; r < 4; ++r) { const int m = (m0 + r * NGW) < M ? (m0 + r * NGW) : 0; w[r] = *(const GAS v2u*)(A2 + (size_t)m * MIXW + AW + 4 * F.lane); }
#pragma unroll
        for (int r = 0; r < 4; ++r) { const int m = m0 + r * NGW; const float a = bflo(w[r].x), b2 = bfhi(w[r].x), c = bflo(w[r].y), d = bfhi(w[r].y);
            const float s = wave_sum((a * a + b2 * b2) + (c * c + d * d));
            if (m < M && F.lane == 0) *(GAS f32x4*)(SSA + (size_t)m * 16 + 12) = (f32x4){s, 0.f, 0.f, 0.f}; } }
}
__device__ __forceinline__ void phase_local(Frame& F) {
    constexpr int NU = BATCH * NH * 16; const int per = (NU + F.G - 1) / F.G, ub = F.vcu * per, ue = (ub + per) < NU ? (ub + per) : NU;
    const bf16* PROJ = (const bf16*)(F.ws + WS_PROJ); const int lane = F.lane, w = F.wave, i = lane & 15, g = lane >> 4;
    const int idx4 = w >> 1, rA = w & 1, rB = 2 + (w & 1);
    Pre R; int hprev = -1;
    __syncthreads();
    if (ub < ue) { const int bh = ub >> 4; prefetch<6>(F, R, PROJ + (size_t)(bh / NH) * SEQ * NPROJ, bh % NH, 0, (ub & 15) * 256); }
    for (int u = ub; u < ue; ++u) {
        const int bh = u >> 4, b = bh / NH, h = bh % NH, s0 = (u & 15) * 256;
        const bf16* P = PROJ + (size_t)b * SEQ * NPROJ; bf16* A2 = (bf16*)(F.ws + WS_A2) + (size_t)b * SEQ * MIXW; float* ML = (float*)(F.ws + WS_ML) + (size_t)b * SEQ * NH * 2;
        __syncthreads();
        commit<6>(F, R);
        if (h != hprev) { build_table(F, LDS_T0, 0, h); build_table(F, LDS_T1, 1, h); hprev = h; }
        __syncthreads();
        const int u0 = s0 / 4 - 64;
        QT T[2];
        const int tokA = s0 + rA + 4 * (16 * idx4 + i), tokB = s0 + rB + 4 * (16 * idx4 + i);
        load_q(T[0], P + (size_t)tokA * NPROJ + h * 64, g); load_q(T[1], P + (size_t)tokB * NPROJ + h * 64, g);
        asm volatile("" ::: "memory");
        prefetch<6>(F, R, P, h, 1, u0);
        {
            const LAS float* tp[2] = { table_ptr(F, LDS_T0, 4 * g - 4 * i - rA + TPAD0), table_ptr(F, LDS_T0, 4 * g - 4 * i - rB + TPAD0) };
            int klo = 64 - s0 - 64 * idx4; klo = klo > 0 ? klo : 0; int khi = SEQ + 64 - s0 - 64 * idx4; khi = khi < 192 ? khi : 192;
            attn_job<2>(T, F.lds + LDS_K + 64 * idx4 * 128, F.lds + LDS_V + 64 * idx4 * 128, 6, tp, klo, khi, (klo > 0 || khi < 192), lane);
        }
#pragma unroll
        for (int pass = 0; pass < 2; ++pass) {
            __syncthreads();
            commit<6>(F, R);
            __syncthreads();
            if (pass == 0) prefetch<6>(F, R, P, h, 2, u0);
            else if (u + 1 < ue) { const int bh2 = (u + 1) >> 4; prefetch<6>(F, R, PROJ + (size_t)(bh2 / NH) * SEQ * NPROJ, bh2 % NH, 0, ((u + 1) & 15) * 256); }
            const int cl = w & 1, lo = idx4 < 2 ? idx4 : 2;
            const LAS float* tp[1] = { table_ptr(F, LDS_T1, 4 * g - i + 16 * (lo - idx4) + TPAD0) };
            int klo = -(u0 + 16 * lo); klo = klo > 0 ? klo : 0; int khi = SEQ / 4 - (u0 + 16 * lo); khi = khi < 160 ? khi : 160;
            QT (&Tp)[1] = *(QT (*)[1])(&T[pass]);
            attn_job<1>(Tp, F.lds + LDS_K + (192 * cl + 16 * lo) * 128, F.lds + LDS_V + (192 * cl + 16 * lo) * 128, 5, tp, klo, khi, (klo > 0 || khi < 160), lane);
        }
#pragma unroll
        for (int n = 0; n < 2; ++n) {
            const float l = xsum4(T[n].l); const float inv = 1.0f / l; const int tok = n == 0 ? tokA : tokB;
#pragma unroll
            for (int db = 0; db < 4; ++db) { v2u o; o.x = pk2(T[n].o[db][0] * inv, T[n].o[db][1] * inv); o.y = pk2(T[n].o[db][2] * inv, T[n].o[db][3] * inv);
                *(GAS v2u*)(A2 + (size_t)tok * MIXW + h * 64 + 16 * db + 4 * g) = o; }
            if (g == 0) { float* mlp = ML + ((size_t)tok * NH + h) * 2; mlp[0] = T[n].m; mlp[1] = l; }
        }
    }
    __syncthreads();
}
__device__ __forceinline__ void phase_class(Frame& F) {
    four_ssq(F);
    constexpr int NU = BATCH * NH * 16; const int per = (NU + F.G - 1) / F.G, ub = F.vcu * per, ue = (ub + per) < NU ? (ub + per) : NU;
    const bf16* PROJ = (const bf16*)(F.ws + WS_PROJ); const int lane = F.lane, w = F.wave, i = lane & 15, g = lane >> 4; float* SSA = (float*)(F.ws + WS_SSA);
    Pre R; int hprev = -1;
    __syncthreads();
    if (ub < ue) { const int bh = ub >> 4; prefetch<4>(F, R, PROJ + (size_t)(bh / NH) * SEQ * NPROJ, bh % NH, 3, ub & 15); }
    for (int u = ub; u < ue; ++u) {
        const int bh = u >> 4, b = bh / NH, h = bh % NH, r = u & 15;
        const bf16* P = PROJ + (size_t)b * SEQ * NPROJ; bf16* A2 = (bf16*)(F.ws + WS_A2) + (size_t)b * SEQ * MIXW; const float* ML = (const float*)(F.ws + WS_ML) + (size_t)b * SEQ * NH * 2;
        __syncthreads();
        commit<4>(F, R);
        if (h != hprev) { build_table(F, LDS_T0, 2, h); hprev = h; }
        __syncthreads();
        QT T2[2]; float mlv[2], llv[2]; v2u pvv[2][4];
#pragma unroll
        for (int n = 0; n < 2; ++n) { const int qt = n == 0 ? (w < 7 ? w : 11) : (w < 4 ? w + 7 : (w < 7 ? w + 8 : 15)); const int tok = r + 16 * (16 * qt + i);
            load_q(T2[n], P + (size_t)tok * NPROJ + h * 64, g);
            const float* mlp = ML + ((size_t)tok * NH + h) * 2; mlv[n] = mlp[0]; llv[n] = mlp[1];
#pragma unroll
            for (int db = 0; db < 4; ++db) pvv[n][db] = *(const GAS v2u*)(A2 + (size_t)tok * MIXW + h * 64 + 16 * db + 4 * g); }
        asm volatile("" ::: "memory");
        if (u + 1 < ue) { const int bh2 = (u + 1) >> 4; prefetch<4>(F, R, PROJ + (size_t)(bh2 / NH) * SEQ * NPROJ, bh2 % NH, 3, (u + 1) & 15); }
#pragma unroll
        for (int n = 0; n < 2; ++n) {
            const int qt = n == 0 ? (w < 7 ? w : 11) : (w < 4 ? w + 7 : (w < 7 ? w + 8 : 15));
            int lo = qt - 4 > 0 ? qt - 4 : 0, hi = qt + 4 < 15 ? qt + 4 : 15; if (((hi - lo + 1) & 1) != 0) { if (hi < 15) ++hi; else --lo; }
            const int tok = r + 16 * (16 * qt + i);
            QT (&T)[1] = *(QT (*)[1])(&T2[n]);
            const LAS float* tp[1] = { table_ptr(F, LDS_T0, 4 * g - i + 16 * (lo - qt) + 64 + TPAD0) };
            attn_job<1>(T, F.lds + LDS_K + 16 * lo * 128, F.lds + LDS_V + 16 * lo * 128, (hi - lo + 1) >> 1, tp, 0, 1 << 20, false, lane);
            const float l16 = xsum4(T[0].l);
            const float ml = mlv[n], ll = llv[n];
            const float mm = fmaxf(ml, T[0].m), a = __builtin_amdgcn_exp2f(ml - mm) * ll, bb = __builtin_amdgcn_exp2f(T[0].m - mm), inv = 1.0f / (a + bb * l16); float sq = 0.f;
#pragma unroll
            for (int db = 0; db < 4; ++db) { GAS v2u* op = (GAS v2u*)(A2 + (size_t)tok * MIXW + h * 64 + 16 * db + 4 * g); const v2u pv = pvv[n][db]; v2u o;
                const float f0 = (bflo(pv.x) * a + T[0].o[db][0] * bb) * inv, f1 = (bfhi(pv.x) * a + T[0].o[db][1] * bb) * inv, f2 = (bflo(pv.y) * a + T[0].o[db][2] * bb) * inv, f3 = (bfhi(pv.y) * a + T[0].o[db][3] * bb) * inv;
                sq += (f0 * f0 + f1 * f1) + (f2 * f2 + f3 * f3); o.x = pk2(f0, f1); o.y = pk2(f2, f3);
                *op = o; }
            sq = xsum4(sq);
            if (g == 0) SSA[((size_t)b * SEQ + tok) * 16 + h] = sq;
        }
    }
    __syncthreads();
}
}


namespace fou {
typedef short bf16x8 __attribute__((ext_vector_type(8)));
typedef short v4i16 __attribute__((ext_vector_type(4)));
constexpr int LX = 0, LC = LDSCTL_OFF + 8192, LS = LDSCTL_OFF + 16384;
__device__ __forceinline__ int gsw(int s2) { const int pr = (s2 >> 1) & 7; return (pr & 4) | ((pr & 1) << 1) | ((pr >> 1) & 1); }
__device__ __forceinline__ int xaddr(int pe, int s2, int chunk) { return LX + pe * 8192 + s2 * 128 + (((chunk ^ gsw(s2) ^ pe) & 7) << 4); }
__device__ __forceinline__ int maddr(int base, int k, int chunk) { return base + k * 128 + (((chunk ^ (k >> 1)) & 7) << 4); }
__device__ __forceinline__ v4i16 vtr(const LAS unsigned char* p) { return __builtin_amdgcn_ds_read_tr16_b64_v4i16((LAS v4i16*)p); }
__device__ __forceinline__ bf16x8 neg8(bf16x8 v) { v4u w = __builtin_bit_cast(v4u, v); w.x ^= 0x80008000u; w.y ^= 0x80008000u; w.z ^= 0x80008000u; w.w ^= 0x80008000u; return __builtin_bit_cast(bf16x8, w); }

__device__ __forceinline__ void fourier_unit(Frame& F, int b, int g, int ec) {
    const bf16* PROJ = (const bf16*)(F.ws + WS_PROJ); bf16* A2 = (bf16*)(F.ws + WS_A2); const float* tabMg = (const float*)(F.ws + WS_TAB + TAB_MG);
    const int lane = F.lane, w = F.wave, li = lane & 15, gq = lane >> 4, e0 = 8 * ec;
    LAS unsigned char* L = F.lds;
    __syncthreads();
    bf16x8 mb[2];
#pragma unroll
    for (int ks = 0; ks < 2; ++ks) { float v[8];
#pragma unroll
        for (int j = 0; j < 8; ++j) { const int c = 8 * gq + j + 32 * ks; const int col = li < 8 ? e0 + li : 64 + e0 + (li & 7); v[j] = tabMg[(g * 64 + c) * 128 + col]; }
        v4u o; o.x = pk2(v[0], v[1]); o.y = pk2(v[2], v[3]); o.z = pk2(v[4], v[5]); o.w = pk2(v[6], v[7]); mb[ks] = __builtin_bit_cast(bf16x8, o); }
    const bf16* ub = PROJ + (size_t)(b * SEQ) * NPROJ + 3 * AW + g * 64 + 8 * gq;
#pragma unroll 8
    for (int it = 0; it < 32; ++it) { const int tile = w + 8 * it, s2 = tile & 63, tq = tile >> 6;
        const bf16* up = ub + (size_t)(64 * (16 * tq + li) + s2) * NPROJ;
        const bf16x8 a0 = __builtin_bit_cast(bf16x8, *(const GAS v4u*)up), a1 = __builtin_bit_cast(bf16x8, *(const GAS v4u*)(up + 32));
        f32x4 d = (f32x4){0.f, 0.f, 0.f, 0.f};
        d = __builtin_amdgcn_mfma_f32_16x16x32_bf16(a0, mb[0], d, 0, 0, 0); d = __builtin_amdgcn_mfma_f32_16x16x32_bf16(a1, mb[1], d, 0, 0, 0);
        v2u o; o.x = pk2(d[0], d[1]); o.y = pk2(d[2], d[3]); *(LAS v2u*)(L + xaddr(li, s2, 2 * tq + (gq >> 1)) + (gq & 1) * 8) = o; }
    __syncthreads();
    const int e = w;
#pragma unroll 1
    for (int mt = 0; mt < 4; ++mt) { const int s2 = 16 * mt + li;
        bf16x8 yr[2], yi[2], nyr[2];
#pragma unroll
        for (int kh = 0; kh < 2; ++kh) { yr[kh] = *(const LAS bf16x8*)(L + xaddr(e, s2, gq + 4 * kh)); yi[kh] = *(const LAS bf16x8*)(L + xaddr(8 + e, s2, gq + 4 * kh)); nyr[kh] = neg8(yr[kh]); }
#pragma unroll
        for (int nt = 0; nt < 4; ++nt) { const int k = 16 * nt + li;
            const bf16x8 c0 = *(const LAS bf16x8*)(L + maddr(LC, k, gq)), c1 = *(const LAS bf16x8*)(L + maddr(LC, k, gq + 4)), s0 = *(const LAS bf16x8*)(L + maddr(LS, k, gq)), s1 = *(const LAS bf16x8*)(L + maddr(LS, k, gq + 4));
            f32x4 tr = (f32x4){0.f, 0.f, 0.f, 0.f}, ti = (f32x4){0.f, 0.f, 0.f, 0.f};
            tr = __builtin_amdgcn_mfma_f32_16x16x32_bf16(c0, yr[0], tr, 0, 0, 0); tr = __builtin_amdgcn_mfma_f32_16x16x32_bf16(c1, yr[1], tr, 0, 0, 0);
            tr = __builtin_amdgcn_mfma_f32_16x16x32_bf16(s0, yi[0], tr, 0, 0, 0); tr = __builtin_amdgcn_mfma_f32_16x16x32_bf16(s1, yi[1], tr, 0, 0, 0);
            ti = __builtin_amdgcn_mfma_f32_16x16x32_bf16(c0, yi[0], ti, 0, 0, 0); ti = __builtin_amdgcn_mfma_f32_16x16x32_bf16(c1, yi[1], ti, 0, 0, 0);
            ti = __builtin_amdgcn_mfma_f32_16x16x32_bf16(s0, nyr[0], ti, 0, 0, 0); ti = __builtin_amdgcn_mfma_f32_16x16x32_bf16(s1, nyr[1], ti, 0, 0, 0);
            float orr[4], oii[4];
#pragma unroll
            for (int r = 0; r < 4; ++r) { const int k1 = 16 * nt + 4 * gq + r; const float rev = (float)((k1 * s2) & 4095) * (1.0f / 4096.0f); const float cv = __builtin_amdgcn_cosf(rev), sv = __builtin_amdgcn_sinf(rev);
                orr[r] = tr[r] * cv + ti[r] * sv; oii[r] = ti[r] * cv - tr[r] * sv; }
            v2u o; o.x = pk2(orr[0], orr[1]); o.y = pk2(orr[2], orr[3]); *(LAS v2u*)(L + xaddr(e, s2, 2 * nt + (gq >> 1)) + (gq & 1) * 8) = o;
            o.x = pk2(oii[0], oii[1]); o.y = pk2(oii[2], oii[3]); *(LAS v2u*)(L + xaddr(8 + e, s2, 2 * nt + (gq >> 1)) + (gq & 1) * 8) = o; } }
    asm volatile("s_waitcnt lgkmcnt(0)" ::: "memory");
    bf16x8 af[4][4];
    { const int q = li >> 2, p = li & 3;
#pragma unroll
      for (int mt = 0; mt < 4; ++mt)
#pragma unroll
        for (int ks = 0; ks < 4; ++ks) { const int pe = (ks >> 1) * 8 + e, s2b = 8 * gq + 32 * (ks & 1) + q;
            const v4i16 lo = vtr(L + xaddr(pe, s2b, 2 * mt + (p >> 1)) + (p & 1) * 8), hi = vtr(L + xaddr(pe, s2b + 4, 2 * mt + (p >> 1)) + (p & 1) * 8);
            af[mt][ks] = (bf16x8){lo[0], lo[1], lo[2], lo[3], hi[0], hi[1], hi[2], hi[3]}; } }
    asm volatile("s_waitcnt lgkmcnt(0)" ::: "memory");
    __syncthreads();
    const float bias = F.f_b[g * 64 + e0 + e];
#pragma unroll 1
    for (int nt = 0; nt < 4; ++nt) { const int k2 = 16 * nt + li;
        const bf16x8 c0 = *(const LAS bf16x8*)(L + maddr(LC, k2, gq)), c1 = *(const LAS bf16x8*)(L + maddr(LC, k2, gq + 4)), s0 = *(const LAS bf16x8*)(L + maddr(LS, k2, gq)), s1 = *(const LAS bf16x8*)(L + maddr(LS, k2, gq + 4));
#pragma unroll
        for (int mt = 0; mt < 4; ++mt) { f32x4 d = (f32x4){0.f, 0.f, 0.f, 0.f};
            d = __builtin_amdgcn_mfma_f32_16x16x32_bf16(af[mt][0], c0, d, 0, 0, 0); d = __builtin_amdgcn_mfma_f32_16x16x32_bf16(af[mt][1], c1, d, 0, 0, 0);
            d = __builtin_amdgcn_mfma_f32_16x16x32_bf16(af[mt][2], s0, d, 0, 0, 0); d = __builtin_amdgcn_mfma_f32_16x16x32_bf16(af[mt][3], s1, d, 0, 0, 0);
#pragma unroll
            for (int r = 0; r < 4; ++r) { const int k1 = 16 * mt + 4 * gq + r; *(LAS bf16*)(L + LX + (k1 * 64 + k2) * 16 + e * 2) = (bf16)f2bf(d[r] * (1.0f / 512.0f) + bias); } } }
    __syncthreads();
    bf16* ob = A2 + (size_t)(b * SEQ) * MIXW + AW + g * 64 + e0;
#pragma unroll
    for (int j = 0; j < 8; ++j) { const int sl = F.tid + 512 * j, k1 = sl >> 6, k2 = sl & 63; const v4u v = *(const LAS v4u*)(L + LX + sl * 16); *(GAS v4u*)(ob + (size_t)(k1 + 64 * k2) * MIXW) = v; }
}
__device__ __forceinline__ void phase_fourier(Frame& F) {
    const float* tabTw = (const float*)(F.ws + WS_TAB + TAB_TW);
    __syncthreads();
    for (int idx = F.tid; idx < 4096; idx += NWAVES * 64) { const int k = idx >> 6, s = idx & 63, n = ((k * s) & 63) * 64;
        *(LAS bf16*)(F.lds + maddr(LC, k, s >> 3) + (s & 7) * 2) = (bf16)f2bf(tabTw[2 * n]); *(LAS bf16*)(F.lds + maddr(LS, k, s >> 3) + (s & 7) * 2) = (bf16)f2bf(tabTw[2 * n + 1]); }
    __syncthreads();
    for (int u = F.vcu; u < BATCH * NG * 8; u += F.G) fourier_unit(F, u >> 5, (u >> 3) & 3, u & 7);
    __syncthreads();
}
}

__device__ __forceinline__ void p10_final(Frame& F) {
    const bf16* X2 = (const bf16*)(F.ws + WS_XN); const float* SS2 = (const float*)(F.ws + WS_SS2);
    const int gw = F.vcu * NWAVES + F.wave, NGW = F.G * NWAVES; const int lane = F.lane;
    const GAS f32x4* gr = (const GAS f32x4*)(F.g_fin + 16 * lane); const f32x4 g0 = gr[0], g1 = gr[1], g2 = gr[2], g3 = gr[3];
    for (int m0 = gw; m0 < M; m0 += 4 * NGW) { v4u w0[4], w1[4]; float part[4];
#pragma unroll
        for (int r = 0; r < 4; ++r) { const int m = (m0 + r * NGW) < M ? (m0 + r * NGW) : 0; const GAS v4u* rp = (const GAS v4u*)(X2 + (size_t)m * D + 16 * lane); w0[r] = rp[0]; w1[r] = rp[1];
            part[r] = lane < 16 ? SS2[(size_t)m * 16 + lane] : 0.f; }
#pragma unroll
        for (int r = 0; r < 4; ++r) { const int m = m0 + r * NGW; const float rstd = 1.0f / sqrtf(wave_sum(part[r]) * (1.f / D) + EPS);
            if (m < M) { GAS f32x4* op = (GAS f32x4*)(F.out + (size_t)m * D + 16 * lane);
                op[0] = (f32x4){bflo(w0[r].x), bfhi(w0[r].x), bflo(w0[r].y), bfhi(w0[r].y)} * rstd * g0; op[1] = (f32x4){bflo(w0[r].z), bfhi(w0[r].z), bflo(w0[r].w), bfhi(w0[r].w)} * rstd * g1;
                op[2] = (f32x4){bflo(w1[r].x), bfhi(w1[r].x), bflo(w1[r].y), bfhi(w1[r].y)} * rstd * g2; op[3] = (f32x4){bflo(w1[r].z), bfhi(w1[r].z), bflo(w1[r].w), bfhi(w1[r].w)} * rstd * g3; } } }
}


__device__ __forceinline__ void p8_halo_fix(Frame& F, int pm) {
    const float* H = (const float*)(F.ws + WS_HALO); bf16* ACT = (bf16*)(F.ws + WS_GV); const int kt = pm & 15;
    for (int it = F.tid; it < 2 * (FF / 4); it += NWAVES * 64) { const int c4 = (it % (FF / 4)) * 4, side = it / (FF / 4);
        if ((side == 0 && kt == 0) || (side == 1 && kt == 15)) continue;
        const float* own = H + (size_t)(pm * 2 + side) * 3 * FF + c4; const float* nb = H + (size_t)((side == 0 ? (pm - 1) * 2 + 1 : (pm + 1) * 2)) * 3 * FF + c4;
        const f32x4 gn = *(const GAS f32x4*)nb, zp = *(const GAS f32x4*)(own + FF), vv = *(const GAS f32x4*)(own + 2 * FF), wt = *(const GAS f32x4*)(F.conv_w + (side == 0 ? 0 : 2 * FF) + c4);
        float a[4];
#pragma unroll
        for (int i = 0; i < 4; ++i) { const float z = zp[i] + wt[i] * gn[i]; a[i] = z * __builtin_amdgcn_rcpf(1.0f + __builtin_amdgcn_exp2f(-1.4426950408889634f * z)) * vv[i]; }
        const unsigned long long o = (unsigned long long)pk2(a[0], a[1]) | ((unsigned long long)pk2(a[2], a[3]) << 32);
        __hip_atomic_store((unsigned long long*)(ACT + (size_t)(pm * 256 + (side ? 255 : 0)) * FF + c4), o, __ATOMIC_RELAXED, __HIP_MEMORY_SCOPE_AGENT); }
}


__device__ __forceinline__ void p6_quant(Frame& F) {
    const bf16* X1 = (const bf16*)(F.ws + WS_XN); unsigned char* A8 = F.ws + WS_A8; float* SROW = (float*)(F.ws + WS_SS1); const unsigned* cmax = (const unsigned*)(F.ctl + CW_CMAX);
    const int gw = F.vcu * NWAVES + F.wave, NGW = F.G * NWAVES, lane = F.lane;
    {   LAS float* scr = (LAS float*)(F.lds + RING_OFF + F.wave * 16384); constexpr int I_G = (D / 64) * (FF / 32);
        for (int it = gw; it < 2 * I_G; it += NGW) { const bool isv = it >= I_G; p6_quant_item(isv ? F.w_val : F.w_gate, D, FF, F.ws + WS_WGV, isv ? 128 : 0, scr, isv ? it - I_G : it, lane, F.g_ffn, cmax); } }
    {   float* cw6 = (float*)(F.ws + WS_TAB + TAB_CW4); const int gt = F.vcu * (NWAVES * 64) + F.tid, NGT = F.G * NWAVES * 64;
        for (int i = gt; i < (FF / 128) * 768; i += NGT) { const int pn = i / 768, k = (i % 768) >> 7, c = i & 127, ch = 128 * pn + c;
            cw6[i] = k < 3 ? F.conv_w[k * FF + ch] : (k == 3 ? F.conv_b[ch] : __uint_as_float(cmax[256 * pn + (k == 5 ? 128 : 0) + c]) * (1.0f / 127.0f)); } }
    for (int m0 = gw; m0 < M; m0 += 4 * NGW) { v4u w0[4], w1[4];
#pragma unroll
        for (int r = 0; r < 4; ++r) { const int m = (m0 + r * NGW) < M ? (m0 + r * NGW) : 0; const GAS v4u* rp = (const GAS v4u*)(X1 + (size_t)m * D + 16 * lane); w0[r] = rp[0]; w1[r] = rp[1]; }
#pragma unroll
        for (int r = 0; r < 4; ++r) { const int m = m0 + r * NGW; float v[16];
            v[0] = bflo(w0[r].x); v[1] = bfhi(w0[r].x); v[2] = bflo(w0[r].y); v[3] = bfhi(w0[r].y); v[4] = bflo(w0[r].z); v[5] = bfhi(w0[r].z); v[6] = bflo(w0[r].w); v[7] = bfhi(w0[r].w);
            v[8] = bflo(w1[r].x); v[9] = bfhi(w1[r].x); v[10] = bflo(w1[r].y); v[11] = bfhi(w1[r].y); v[12] = bflo(w1[r].z); v[13] = bfhi(w1[r].z); v[14] = bflo(w1[r].w); v[15] = bfhi(w1[r].w);
            float ss = 0.f, mx = 0.f;
#pragma unroll
            for (int i = 0; i < 16; ++i) { ss += v[i] * v[i]; mx = fmaxf(mx, fabsf(v[i])); }
            ss = wave_sum(ss);
#pragma unroll
            for (int o = 1; o < 64; o <<= 1) mx = fmaxf(mx, __shfl_xor(mx, o));
            const float inv = mx > 0.f ? 127.0f / mx : 0.f; unsigned q[4];
#pragma unroll
            for (int j = 0; j < 4; ++j) { q[j] = 0;
#pragma unroll
                for (int t = 0; t < 4; ++t) q[j] |= ((unsigned)(int)__builtin_rintf(v[4 * j + t] * inv) & 255u) << (8 * t); }
            if (m < M) { *(GAS v4u*)(A8 + (size_t)m * D + 16 * lane) = (v4u){q[0], q[1], q[2], q[3]};
                if (lane == 0) SROW[m] = mx * (1.0f / 127.0f) * (1.0f / sqrtf(ss * (1.f / D) + EPS)); } } }
}

struct Args { const float* in[16]; float* out; unsigned char* ws; int ph_lo, ph_hi; };
__global__ void __launch_bounds__(NWAVES * 64, 2) hymba_fwd(Args args) {
    extern __shared__ __attribute__((aligned(16))) unsigned char lds[];
    Frame F;
    F.lds = (LAS unsigned char*)lds;
    F.MISC = (volatile LAS unsigned*)(F.lds + MISC_OFF);
    F.tid = threadIdx.x; F.lane = F.tid & 63; F.wave = __builtin_amdgcn_readfirstlane(F.tid >> 6);
    F.G = gridDim.x; { const int bx = blockIdx.x; F.vcu = (F.G % 8 == 0) ? (bx % 8) * (F.G / 8) + bx / 8 : bx; }
    F.ws = args.ws; F.ctl = (gu32*)(args.ws + WS_CTL);
    F.x = args.in[0]; F.g_mix = args.in[1]; F.w_in = args.in[2]; F.g_attn = args.in[3]; F.rel_tab = args.in[4]; F.f_w = args.in[5]; F.f_b = args.in[6]; F.g_four = args.in[7];
    F.w_out = args.in[8]; F.g_ffn = args.in[9]; F.w_gate = args.in[10]; F.w_val = args.in[11]; F.conv_w = args.in[12]; F.conv_b = args.in[13]; F.w_down = args.in[14]; F.g_fin = args.in[15];
    F.out = args.out;
    for (int u = F.tid; u < (LDS_BYTES - LDSCTL_OFF) / 4; u += NWAVES * 64) ((LAS unsigned*)(F.lds + LDSCTL_OFF))[u] = 0u;
    __syncthreads();
    XcdBarrier bar; bar.bar = (unsigned*)(F.ctl + CW_BAR); bar.x = 0; bar.st = nullptr;
    if (MK_ONE_LAUNCH) bar = xcd_barrier_post((unsigned*)(F.ctl + CW_BAR), F.MISC + 8);
#define GRID_BAR() do { if (MK_ONE_LAUNCH) xcd_barrier(bar); } while (0)
    const int lo = args.ph_lo, hi = args.ph_hi;
#define IN(k) (lo <= (k) && (k) < hi)
#define BOTH(k) (IN(k) && IN((k) + 1))
    if (IN(0)) { p0_prologue(F); if (BOTH(0)) GRID_BAR(); }
    if (IN(1)) {
        pg8::Gemm g{(const bf16*)(F.ws + WS_XN), (const bf16*)(F.ws + WS_WIN), M, NPROJ, D, D, 0}; pg8::StaticOrder S; S.init(M, NPROJ, F.G, (int)blockIdx.x);
        pg8::EpiBf16Row E{(bf16*)(F.ws + WS_PROJ), NPROJ, (const float*)(F.ws + WS_RS0)};
        pg8::gemm_phase<pg8::EpiBf16Row, pg8::StaticOrder, true, true>(F.lds + RING_OFF, g, S, E);
        if (BOTH(1)) GRID_BAR();
    }
    if (IN(2)) { att::phase_local(F); fou::phase_fourier(F); if (BOTH(2)) GRID_BAR(); }
    if (IN(3)) { att::phase_class(F); if (IN(3) && IN(5)) GRID_BAR(); }
    if (IN(5)) {
        pg8::Gemm g{(const bf16*)(F.ws + WS_A2), (const bf16*)(F.ws + WS_WOUT), M, D, MIXW, MIXW, 0}; pg8::StaticOrder S; S.init(M, D, F.G, (int)blockIdx.x);
        pg8::EpiX1N E{(const bf16*)(F.ws + WS_XN), (bf16*)(F.ws + WS_XN), D, (float*)(F.ws + WS_SS1), (const float*)(F.ws + WS_SSA), (LAS float*)(F.lds + LDSCTL_OFF + 8192)};
        pg8::gemm_phase<pg8::EpiX1N, pg8::StaticOrder, true, true>(F.lds + RING_OFF, g, S, E);
        if (IN(5) && IN(6)) GRID_BAR();
    }
    if (IN(6)) { p6_quant(F); if (IN(6) && IN(7)) GRID_BAR(); }
    if (IN(7)) {
        pg8::Gemm g{(const bf16*)(F.ws + WS_A8), (const bf16*)(F.ws + WS_WGV), M, 2 * FF, D / 2, D / 2, 0}; pg8::StaticOrder S; S.init(M, 2 * FF, F.G, (int)blockIdx.x);
        pg8::EpiConvGlu E{(bf16*)(F.ws + WS_GV), FF, (const float*)(F.ws + WS_SS1), F.conv_w, F.conv_b, (LAS float*)(F.lds + LDSCTL_OFF + 4096), M, (float*)(F.ws + WS_HALO), (const float*)(F.ws + WS_TAB + TAB_CW4)};
        pg8::gemm_phase<pg8::EpiConvGlu, pg8::StaticOrder, true, true, true>(F.lds + RING_OFF, g, S, E);
        if (IN(7) && IN(9)) GRID_BAR();
    }
    if (IN(9)) {
        pg8::Gemm g{(const bf16*)(F.ws + WS_GV), (const bf16*)(F.ws + WS_WD), M, D, FF, FF, 0}; pg8::StaticOrder S; S.init(M, D, F.G, (int)blockIdx.x);
        { pg8::Unit uu; for (int i = 0; S.next(i, uu); ++i) p8_halo_fix(F, uu.pm); }
        asm volatile("s_waitcnt vmcnt(0)" ::: "memory"); __syncthreads();
        if (F.G == 256) {
            pg8::EpiFinal E{(const bf16*)(F.ws + WS_XN), F.out, D, F.g_fin, (float*)(F.ws + WS_XBUF), (unsigned*)(F.ctl + CW_PANEL), F.lds + LDSCTL_OFF + 4096};
            pg8::gemm_phase<pg8::EpiFinal, pg8::StaticOrder, true, true>(F.lds + RING_OFF, g, S, E);
        } else {
            pg8::EpiX2 E{(bf16*)(F.ws + WS_XN), D, (float*)(F.ws + WS_SS2)};
            pg8::gemm_phase<pg8::EpiX2, pg8::StaticOrder, true, true>(F.lds + RING_OFF, g, S, E);
            if (BOTH(9)) GRID_BAR();
        }
    }
    if (IN(10) && F.G != 256) { p10_final(F); }
#undef IN
#undef BOTH
}

extern "C" void kernel_launch(void* const* d_in, const int* in_sizes, int n_in, void* d_out, int out_size, void* d_ws, size_t ws_size, hipStream_t stream) {
    static int grid = 0;
    if (grid == 0) {
        if (n_in != 16 || in_sizes[0] != M * D || out_size != M * D || ws_size < WS_END) { fprintf(stderr, "kernel_launch: shape/workspace mismatch: n_in %d in0 %d out %d ws %zu (need %zu)\n", n_in, n_in > 0 ? in_sizes[0] : -1, out_size, ws_size, (size_t)WS_END); grid = -1; return; }
        int dev = 0, cus = 0, per_cu = 0;
        if (hipGetDevice(&dev) != hipSuccess || hipDeviceGetAttribute(&cus, hipDeviceAttributeMultiprocessorCount, dev) != hipSuccess) { grid = -1; return; }
        if (hipFuncSetAttribute((const void*)hymba_fwd, hipFuncAttributeMaxDynamicSharedMemorySize, LDS_BYTES) != hipSuccess) { fprintf(stderr, "kernel_launch: hipFuncSetAttribute failed\n"); grid = -1; return; }
        if (hipOccupancyMaxActiveBlocksPerMultiprocessor(&per_cu, (const void*)hymba_fwd, NWAVES * 64, LDS_BYTES) != hipSuccess || per_cu < 1) { fprintf(stderr, "kernel_launch: occupancy query says %d blocks/CU\n", per_cu); (void)hipGetLastError(); grid = -1; return; }
        grid = cus;
    }
    if (grid < 0) return;
    (void)hipMemsetAsync((char*)d_ws + WS_CTL, 0, CTL_ZERO_BYTES, stream);
    Args a{};
    for (int i = 0; i < 16; ++i) a.in[i] = (const float*)d_in[i];
    a.out = (float*)d_out; a.ws = (unsigned char*)d_ws;
#if MK_ONE_LAUNCH
    a.ph_lo = 0; a.ph_hi = N_PHASES;
    hipLaunchKernelGGL(hymba_fwd, dim3(grid), dim3(NWAVES * 64), LDS_BYTES, stream, a);
#else
    for (int p = 0; p < N_PHASES; ++p) { a.ph_lo = p; a.ph_hi = p + 1; hipLaunchKernelGGL(hymba_fwd, dim3(grid), dim3(NWAVES * 64), LDS_BYTES, stream, a); }
#endif
}
```

```cpp
#include <hip/hip_runtime.h>
#include <cstdio>
#include <cstdint>

namespace pg8 {
#define PG8_LAS __attribute__((address_space(3)))
typedef unsigned short bf16_t;
typedef short bf16x8 __attribute__((ext_vector_type(8)));
typedef float f32x4 __attribute__((ext_vector_type(4)));
typedef unsigned u32x4 __attribute__((ext_vector_type(4)));
typedef int i32x4 __attribute__((ext_vector_type(4)));
template <bool I8> struct AccT { typedef f32x4 type; };
template <> struct AccT<true> { typedef i32x4 type; };
constexpr int BM = 256, BK = 64, HALF = 128, HTB = HALF * BK * 2, STAGE_BYTES = 8 * HTB, NXCD = 8, WGM = 8;

__host__ __device__ __forceinline__ int lds_byte(int r, int c) { const int st = (r >> 4) * 2 + (c >> 5), rr = r & 15, cc = c & 31, ob = rr * 64 + cc * 2; return st * 1024 + (ob ^ (((ob >> 9) & 1) << 5)); }
__host__ __device__ __forceinline__ void stage_rc(int b, int& R, int& C) { const int st = b / 1024, sb = b % 1024, swz = sb ^ (((sb >> 9) & 1) << 5); R = (st >> 1) * 16 + swz / 64; C = (st & 1) * 32 + (swz % 64) / 2; }
__host__ __device__ __forceinline__ int perm32(int rho) { const int n = rho >> 4, i = rho & 15; return 8 * (i >> 2) + 4 * n + (i & 3); }

struct Unit { int pm, pn; };
struct Gemm { const bf16_t* A; const bf16_t* Bt; int M, N, K, lda; int ovl; };
__host__ __device__ __forceinline__ int ovl_row_base(int pm) { const int b = pm / 17, k = pm - 17 * b; return b * 4096 + (k ? 254 * k - 1 : 0); }

struct StaticOrder {
    int nM, nN, nwg, G, c;
    __host__ __device__ void init(int M, int N, int G_, int c_) { nM = M / BM; nN = N / BM; nwg = nM * nN; G = G_; c = c_; }
    __host__ __device__ bool next(int i, Unit& u) const {
        const long L = (long)i * G + c; if (L >= nwg) return false;
        int wgid = (int)L; { const int q = nwg / NXCD, r = nwg % NXCD, xcd = wgid % NXCD, off = wgid / NXCD; wgid = (xcd < r ? xcd * (q + 1) : r * (q + 1) + (xcd - r) * q) + off; }
        const int nig = WGM * nN, gid = wgid / nig, fm = gid * WGM, gsz = (nM - fm) < WGM ? (nM - fm) : WGM;
        u.pm = fm + ((wgid % nig) % gsz); u.pn = (wgid % nig) / gsz; return true;
    }
    __device__ __forceinline__ void a_ready(const Unit&) const {}
    __device__ __forceinline__ void done(const Unit&) const {}
};

typedef float f32x2v_t __attribute__((ext_vector_type(2))); typedef __bf16 bf16x2v_t __attribute__((ext_vector_type(2)));
__device__ __forceinline__ unsigned cvt_pk_bf16(float lo, float hi) { f32x2v_t v = {lo, hi}; bf16x2v_t b = __builtin_convertvector(v, bf16x2v_t); return __builtin_bit_cast(unsigned, b); }

struct EpiBf16 {
    static constexpr bool PERM = true, AFTER_DRAIN = false, MIDK = false, PREFETCH = false;
    bf16_t* O; int ldc;
    __device__ __forceinline__ void operator()(const f32x4 (&acc)[2][2][4][2], const Unit& u, int wr, int wc, int fr, int fq) const {
        const int row0 = u.pm * BM + wr * 64 + fr; const int col0 = u.pn * BM + wc * 32 + 8 * fq;
#pragma unroll
        for (int ai = 0; ai < 2; ++ai)
#pragma unroll
            for (int m = 0; m < 4; ++m) { bf16_t* rowp = O + (size_t)(row0 + ai * HALF + m * 16) * ldc + col0;
#pragma unroll
                for (int bj = 0; bj < 2; ++bj) { const f32x4 v0 = acc[ai][bj][m][0], v1 = acc[ai][bj][m][1];
                    u32x4 w; w.x = cvt_pk_bf16(v0[0], v0[1]); w.y = cvt_pk_bf16(v0[2], v0[3]); w.z = cvt_pk_bf16(v1[0], v1[1]); w.w = cvt_pk_bf16(v1[2], v1[3]);
                    *(u32x4*)(rowp + bj * HALF) = w; } }
    }
};

struct EpiBf16Row {
    static constexpr bool PERM = true, AFTER_DRAIN = false, MIDK = false, PREFETCH = false;
    bf16_t* O; int ldc; const float* rs;
    __device__ __forceinline__ void operator()(const f32x4 (&acc)[2][2][4][2], const Unit& u, int wr, int wc, int fr, int fq) const {
        const int row0 = u.pm * BM + wr * 64 + fr; const int col0 = u.pn * BM + wc * 32 + 8 * fq;
#pragma unroll
        for (int ai = 0; ai < 2; ++ai)
#pragma unroll
            for (int m = 0; m < 4; ++m) { const int row = row0 + ai * HALF + m * 16; const float r = rs[row]; bf16_t* rowp = O + (size_t)row * ldc + col0;
#pragma unroll
                for (int bj = 0; bj < 2; ++bj) { const f32x4 v0 = acc[ai][bj][m][0] * r, v1 = acc[ai][bj][m][1] * r;
                    u32x4 w; w.x = cvt_pk_bf16(v0[0], v0[1]); w.y = cvt_pk_bf16(v0[2], v0[3]); w.z = cvt_pk_bf16(v1[0], v1[1]); w.w = cvt_pk_bf16(v1[2], v1[3]);
                    *(u32x4*)(rowp + bj * HALF) = w; } }
    }
};
struct EpiResF32 {
    static constexpr bool PERM = false, AFTER_DRAIN = false, MIDK = false, PREFETCH = false;
    const float* base; float* out; int ldc;
    __device__ __forceinline__ void operator()(const f32x4 (&acc)[2][2][4][2], const Unit& u, int wr, int wc, int fr, int fq) const {
        const int col0 = u.pn * BM + wc * 32 + 4 * fq;
#pragma unroll
        for (int ai = 0; ai < 2; ++ai)
#pragma unroll
            for (int m = 0; m < 4; ++m) { const int r = u.pm * BM + ai * HALF + wr * 64 + m * 16 + fr; const size_t off = (size_t)r * ldc + col0;
#pragma unroll
                for (int bj = 0; bj < 2; ++bj)
#pragma unroll
                    for (int n = 0; n < 2; ++n) { const f32x4 bs = *(const f32x4*)(base + off + bj * HALF + n * 16); *(f32x4*)(out + off + bj * HALF + n * 16) = bs + acc[ai][bj][m][n]; } }
    }
};


struct EpiX1 {
    static constexpr bool PERM = true, AFTER_DRAIN = false, MIDK = false, PREFETCH = false;
    const float* base; bf16_t* O; int ldc; float* ss;
    __device__ __forceinline__ void operator()(const f32x4 (&acc)[2][2][4][2], const Unit& u, int wr, int wc, int fr, int fq) const {
        const int row0 = u.pm * BM + wr * 64 + fr; const int col0 = u.pn * BM + wc * 32 + 8 * fq;
#pragma unroll
        for (int ai = 0; ai < 2; ++ai)
#pragma unroll
            for (int m = 0; m < 4; ++m) { const int row = row0 + ai * HALF + m * 16; const size_t off = (size_t)row * ldc + col0; float q = 0.f;
#pragma unroll
                for (int bj = 0; bj < 2; ++bj) { const f32x4 v0 = *(const f32x4*)(base + off + bj * HALF) + acc[ai][bj][m][0], v1 = *(const f32x4*)(base + off + bj * HALF + 4) + acc[ai][bj][m][1];
                    q += (v0[0] * v0[0] + v0[1] * v0[1]) + (v0[2] * v0[2] + v0[3] * v0[3]) + (v1[0] * v1[0] + v1[1] * v1[1]) + (v1[2] * v1[2] + v1[3] * v1[3]);
                    u32x4 w; w.x = cvt_pk_bf16(v0[0], v0[1]); w.y = cvt_pk_bf16(v0[2], v0[3]); w.z = cvt_pk_bf16(v1[0], v1[1]); w.w = cvt_pk_bf16(v1[2], v1[3]);
                    *(u32x4*)(O + off + bj * HALF) = w; }
                q += __shfl_xor(q, 16); q += __shfl_xor(q, 32);
                if (fq == 0) ss[(size_t)row * 16 + u.pn * 4 + wc] = q; }
    }
};
struct EpiX2 {
    static constexpr bool PERM = true, AFTER_DRAIN = false, MIDK = false, PREFETCH = false;
    bf16_t* X; int ldc; float* ss;
    __device__ __forceinline__ void operator()(const f32x4 (&acc)[2][2][4][2], const Unit& u, int wr, int wc, int fr, int fq) const {
        const int row0 = u.pm * BM + wr * 64 + fr; const int col0 = u.pn * BM + wc * 32 + 8 * fq;
#pragma unroll
        for (int ai = 0; ai < 2; ++ai)
#pragma unroll
            for (int m = 0; m < 4; ++m) { const int row = row0 + ai * HALF + m * 16; const size_t off = (size_t)row * ldc + col0; float q = 0.f;
#pragma unroll
                for (int bj = 0; bj < 2; ++bj) { const u32x4 xb = *(const u32x4*)(X + off + bj * HALF);
                    f32x4 v0, v1; v0[0] = __builtin_bit_cast(float, xb.x << 16); v0[1] = __builtin_bit_cast(float, xb.x & 0xffff0000u); v0[2] = __builtin_bit_cast(float, xb.y << 16); v0[3] = __builtin_bit_cast(float, xb.y & 0xffff0000u);
                    v1[0] = __builtin_bit_cast(float, xb.z << 16); v1[1] = __builtin_bit_cast(float, xb.z & 0xffff0000u); v1[2] = __builtin_bit_cast(float, xb.w << 16); v1[3] = __builtin_bit_cast(float, xb.w & 0xffff0000u);
                    v0 = v0 + acc[ai][bj][m][0]; v1 = v1 + acc[ai][bj][m][1];
                    q += (v0[0] * v0[0] + v0[1] * v0[1]) + (v0[2] * v0[2] + v0[3] * v0[3]) + (v1[0] * v1[0] + v1[1] * v1[1]) + (v1[2] * v1[2] + v1[3] * v1[3]);
                    u32x4 w; w.x = cvt_pk_bf16(v0[0], v0[1]); w.y = cvt_pk_bf16(v0[2], v0[3]); w.z = cvt_pk_bf16(v1[0], v1[1]); w.w = cvt_pk_bf16(v1[2], v1[3]);
                    *(u32x4*)(X + off + bj * HALF) = w; }
                q += __shfl_xor(q, 16); q += __shfl_xor(q, 32);
                if (fq == 0) ss[(size_t)row * 16 + u.pn * 4 + wc] = q; }
    }
};
struct EpiBf16Rs {
    static constexpr bool PERM = true, AFTER_DRAIN = false, MIDK = false, PREFETCH = false;
    bf16_t* O; int ldc; const float* ss; float inv_n, eps;
    __device__ __forceinline__ void operator()(const f32x4 (&acc)[2][2][4][2], const Unit& u, int wr, int wc, int fr, int fq) const {
        const int row0 = u.pm * BM + wr * 64 + fr; const int col0 = u.pn * BM + wc * 32 + 8 * fq;
#pragma unroll
        for (int ai = 0; ai < 2; ++ai)
#pragma unroll
            for (int m = 0; m < 4; ++m) { const int row = row0 + ai * HALF + m * 16; const f32x4* sp = (const f32x4*)(ss + (size_t)row * 16);
                const f32x4 s4 = (sp[0] + sp[1]) + (sp[2] + sp[3]); const float rs = 1.0f / sqrtf(((s4[0] + s4[1]) + (s4[2] + s4[3])) * inv_n + eps);
                bf16_t* rowp = O + (size_t)row * ldc + col0;
#pragma unroll
                for (int bj = 0; bj < 2; ++bj) { const f32x4 v0 = acc[ai][bj][m][0] * rs, v1 = acc[ai][bj][m][1] * rs;
                    u32x4 w; w.x = cvt_pk_bf16(v0[0], v0[1]); w.y = cvt_pk_bf16(v0[2], v0[3]); w.z = cvt_pk_bf16(v1[0], v1[1]); w.w = cvt_pk_bf16(v1[2], v1[3]);
                    *(u32x4*)(rowp + bj * HALF) = w; } }
    }
};


template <int CTRL> __device__ __forceinline__ float dppk(float keep, float x) { return __builtin_bit_cast(float, __builtin_amdgcn_update_dpp(__builtin_bit_cast(int, keep), __builtin_bit_cast(int, x), CTRL, 0xf, 0xf, false)); }
template <int CTRL> __device__ __forceinline__ float dppf(float x) { return __builtin_bit_cast(float, __builtin_amdgcn_mov_dpp(__builtin_bit_cast(int, x), CTRL, 0xf, 0xf, true)); }
struct EpiConvGlu {
    static constexpr bool PERM = true, AFTER_DRAIN = false, MIDK = false, PREFETCH = true;
    bf16_t* O; int ldc; const float* ss; const float* cw; const float* cb; PG8_LAS float* ex; int mrows; float* halo; const float* cw4;
    __device__ __forceinline__ void prefetch(const Unit& u, int wid, int lane) const {
        const int base = u.pm * BM; asm volatile("" : "+v"(lane));
        if (wid == 0) __builtin_amdgcn_global_load_lds((const unsigned*)(ss + base + lane * 4), (PG8_LAS unsigned*)(ex + 1024), 16, 0, 0);
        else if (wid < 4) __builtin_amdgcn_global_load_lds((const unsigned*)(cw4 + u.pn * 768 + (wid - 1) * 256 + lane * 4), (PG8_LAS unsigned*)(ex + 1024 + 4096 + (wid - 1) * 256), 16, 0, 0);
    }
    __device__ __forceinline__ void operator()(i32x4 (&iacc)[2][2][4][2], const Unit& u, int wr, int wc, int fr, int fq) const {
        f32x4 acc[2][2][4][2];
        const int kt = u.pm & 15, base = u.pm * BM, rend = 256;
        const int ch0 = u.pn * 128 + wc * 32 + 8 * fq;
        const bool top_open = kt != 0, bot_open = kt != 15;
        f32x4 w0[2], w1[2], w2[2], cbv[2];
        f32x4 sg[2], sv[2];
#pragma unroll
        for (int n = 0; n < 2; ++n) { const PG8_LAS float* wl = ex + 1024 + 4096 + wc * 32 + 8 * fq + 4 * n; w0[n] = *(const PG8_LAS f32x4*)wl; w1[n] = *(const PG8_LAS f32x4*)(wl + 128); w2[n] = *(const PG8_LAS f32x4*)(wl + 256); cbv[n] = *(const PG8_LAS f32x4*)(wl + 384); sg[n] = *(const PG8_LAS f32x4*)(wl + 512); sv[n] = *(const PG8_LAS f32x4*)(wl + 640); }
#pragma unroll
        for (int ai = 0; ai < 2; ++ai)
#pragma unroll
            for (int m = 0; m < 4; ++m) { const int r = ai * HALF + wr * 64 + m * 16 + fr; const float rs = ex[1024 + r];
#pragma unroll
                for (int n = 0; n < 2; ++n) { const i32x4 ig = iacc[ai][0][m][n], iv = iacc[ai][1][m][n];
                    acc[ai][0][m][n] = (f32x4){(float)ig[0], (float)ig[1], (float)ig[2], (float)ig[3]} * rs * sg[n]; acc[ai][1][m][n] = (f32x4){(float)iv[0], (float)iv[1], (float)iv[2], (float)iv[3]} * rs * sv[n]; } }
        const int exi = (wc * 4 + fq) * 8;
        if (fr == 0) {
#pragma unroll
            for (int ai = 0; ai < 2; ++ai) { PG8_LAS f32x4* p = (PG8_LAS f32x4*)(ex + ((ai * 2 + wr) * 2 + 0) * 128 + exi); p[0] = acc[ai][0][0][0]; p[1] = acc[ai][0][0][1]; } }
        if (fr == 15) {
#pragma unroll
            for (int ai = 0; ai < 2; ++ai) { PG8_LAS f32x4* p = (PG8_LAS f32x4*)(ex + ((ai * 2 + wr) * 2 + 1) * 128 + exi); p[0] = acc[ai][0][3][0]; p[1] = acc[ai][0][3][1]; } }
        asm volatile("s_waitcnt lgkmcnt(0)\n\ts_barrier" ::: "memory");
#pragma unroll
        for (int ai = 0; ai < 2; ++ai) {
#pragma unroll
            for (int m = 0; m < 4; ++m) { const int r = ai * HALF + wr * 64 + m * 16 + fr; u32x4 w; unsigned wv[4]; float zz[8];
                f32x4 edge[2] = {(f32x4){0.f, 0.f, 0.f, 0.f}, (f32x4){0.f, 0.f, 0.f, 0.f}};
                if (m == 0) { const bool hz = (wr == 0 && ai == 0); const int sai = wr == 1 ? ai : 0, swr = wr == 1 ? 0 : 1; const PG8_LAS f32x4* p = (const PG8_LAS f32x4*)(ex + ((sai * 2 + swr) * 2 + 1) * 128 + exi);
                    if (!hz) { edge[0] = p[0]; edge[1] = p[1]; } }
                if (m == 3) { const bool hz = (wr == 1 && ai == 1); const int sai = wr == 0 ? ai : 1, swr = wr == 0 ? 1 : 0; const PG8_LAS f32x4* p = (const PG8_LAS f32x4*)(ex + ((sai * 2 + swr) * 2 + 0) * 128 + exi);
                    if (!hz) { edge[0] = p[0]; edge[1] = p[1]; } }
#pragma unroll
                for (int n = 0; n < 2; ++n) { float a[4];
#pragma unroll
                    for (int i = 0; i < 4; ++i) { const float gc = acc[ai][0][m][n][i];
                        const float rp = m > 0 ? dppf<0x121>(acc[ai][0][m > 0 ? m - 1 : 0][n][i]) : edge[n][i];
                        const float ln = m < 3 ? dppf<0x12F>(acc[ai][0][m < 3 ? m + 1 : 3][n][i]) : edge[n][i];
                        const float gu = dppk<0x111>(rp, gc), gd = dppk<0x101>(ln, gc);
                        const float z = __builtin_fmaf(w2[n][i], gd, __builtin_fmaf(w1[n][i], gc, __builtin_fmaf(w0[n][i], gu, cbv[n][i])));
                        if ((ai == 0 && m == 0) || (ai == 1 && m == 3)) zz[4 * n + i] = z;
                        a[i] = z * __builtin_amdgcn_rcpf(1.0f + __builtin_amdgcn_exp2f(-1.4426950408889634f * z)) * acc[ai][1][m][n][i]; }
                    wv[2 * n] = cvt_pk_bf16(a[0], a[1]); wv[2 * n + 1] = cvt_pk_bf16(a[2], a[3]); }
                w.x = wv[0]; w.y = wv[1]; w.z = wv[2]; w.w = wv[3];
                bool open = false;
                if (ai == 0 && m == 0) open = (r == 0) && top_open;
                if (ai == 1 && m == 3) open = (r == 255) && bot_open;
                if (!open) *(u32x4*)(O + (size_t)(base + r) * ldc + ch0) = w;
                if ((ai == 0 && m == 0) || (ai == 1 && m == 3)) { if (open) { float* hp = halo + ((size_t)(u.pm * 2 + (ai == 0 ? 0 : 1)) * 3) * ldc + ch0;
                        *(f32x4*)hp = acc[ai][0][m][0]; *(f32x4*)(hp + 4) = acc[ai][0][m][1];
                        *(f32x4*)(hp + ldc) = (f32x4){zz[0], zz[1], zz[2], zz[3]}; *(f32x4*)(hp + ldc + 4) = (f32x4){zz[4], zz[5], zz[6], zz[7]};
                        *(f32x4*)(hp + 2 * ldc) = acc[ai][1][m][0]; *(f32x4*)(hp + 2 * ldc + 4) = acc[ai][1][m][1]; } }
                asm volatile("" ::: "memory"); } }
        asm volatile("s_waitcnt lgkmcnt(0)\n\ts_barrier" ::: "memory");
    }
};


struct EpiX1N {
    static constexpr bool PERM = true, AFTER_DRAIN = false, MIDK = true, PREFETCH = true; static constexpr int MIDK_T = 12;
    const bf16_t* base; bf16_t* O; int ldc; float* ss; const float* sa; PG8_LAS float* st;
    __device__ __forceinline__ void prefetch(const Unit& u, int wid, int lane) const {
        asm volatile("" : "+v"(lane));
#pragma unroll
        for (int i = 0; i < 2; ++i) { const int piece = wid * 2 + i;
            __builtin_amdgcn_global_load_lds((const unsigned*)(sa + (size_t)u.pm * BM * 16 + piece * 256 + lane * 4), (PG8_LAS unsigned*)(st + piece * 256), 16, 0, 0); }
    }
    __device__ __forceinline__ void row_stats(int rl, int fq, float& ra, float& rf) const {
        const f32x4 s4 = *(const PG8_LAS f32x4*)(st + rl * 16 + 4 * fq); float a = fq < 3 ? (s4[0] + s4[1]) + (s4[2] + s4[3]) : 0.f, f = fq == 3 ? s4[0] : 0.f;
        a += __shfl_xor(a, 16); a += __shfl_xor(a, 32); f += __shfl_xor(f, 16); f += __shfl_xor(f, 32);
        ra = __builtin_amdgcn_rsqf(a * (1.0f / 768.0f) + 1e-6f); rf = __builtin_amdgcn_rsqf(f * (1.0f / 256.0f) + 1e-6f);
    }
    __device__ __forceinline__ void midk(f32x4 (&acc)[2][2][4][2], const Unit& u, int wr, int fr, int fq) const {
#pragma unroll
        for (int ai = 0; ai < 2; ++ai)
#pragma unroll
            for (int m = 0; m < 4; ++m) { float ra, rf; row_stats(ai * HALF + wr * 64 + m * 16 + fr, fq, ra, rf); const float ratio = ra * __builtin_amdgcn_rcpf(rf);
#pragma unroll
                for (int bj = 0; bj < 2; ++bj) { acc[ai][bj][m][0] = acc[ai][bj][m][0] * ratio; acc[ai][bj][m][1] = acc[ai][bj][m][1] * ratio; } }
    }
    __device__ __forceinline__ void operator()(const f32x4 (&acc)[2][2][4][2], const Unit& u, int wr, int wc, int fr, int fq) const {
        const int row0 = u.pm * BM + wr * 64 + fr; const int col0 = u.pn * BM + wc * 32 + 8 * fq;
#pragma unroll
        for (int ai = 0; ai < 2; ++ai)
#pragma unroll
            for (int m = 0; m < 4; ++m) { const int row = row0 + ai * HALF + m * 16; const size_t off = (size_t)row * ldc + col0; float ra, rf; row_stats(row - u.pm * BM, fq, ra, rf);
#pragma unroll
                for (int bj = 0; bj < 2; ++bj) { const u32x4 xb = *(const u32x4*)(base + off + bj * HALF); f32x4 v0, v1;
                    v0[0] = __builtin_bit_cast(float, xb.x << 16); v0[1] = __builtin_bit_cast(float, xb.x & 0xffff0000u); v0[2] = __builtin_bit_cast(float, xb.y << 16); v0[3] = __builtin_bit_cast(float, xb.y & 0xffff0000u);
                    v1[0] = __builtin_bit_cast(float, xb.z << 16); v1[1] = __builtin_bit_cast(float, xb.z & 0xffff0000u); v1[2] = __builtin_bit_cast(float, xb.w << 16); v1[3] = __builtin_bit_cast(float, xb.w & 0xffff0000u);
                    v0 = v0 + acc[ai][bj][m][0] * rf; v1 = v1 + acc[ai][bj][m][1] * rf;
                    u32x4 w; w.x = cvt_pk_bf16(v0[0], v0[1]); w.y = cvt_pk_bf16(v0[2], v0[3]); w.z = cvt_pk_bf16(v1[0], v1[1]); w.w = cvt_pk_bf16(v1[2], v1[3]);
                    *(u32x4*)(O + off + bj * HALF) = w; }
                }
        asm volatile("s_waitcnt lgkmcnt(0)\n\ts_barrier" ::: "memory");
    }
};


struct EpiFinal {
    static constexpr bool PERM = true, AFTER_DRAIN = false, MIDK = false, PREFETCH = false;
    const bf16_t* X1; float* out; int ldc; const float* gain; float* xbuf; unsigned* cnt; PG8_LAS unsigned char* lx;
    __device__ __forceinline__ void operator()(f32x4 (&acc)[2][2][4][2], const Unit& u, int wr, int wc, int fr, int fq) const {
        PG8_LAS float* P = (PG8_LAS float*)lx; PG8_LAS float* S = (PG8_LAS float*)(lx + 4096);
        int tid = (wr * 4 + wc) * 64 + fq * 16 + fr; asm volatile("" : "+v"(tid)); const int col0 = u.pn * BM + wc * 32 + 8 * fq;
#pragma unroll
        for (int ai = 0; ai < 2; ++ai)
#pragma unroll
            for (int m = 0; m < 4; ++m) { const int rl = ai * HALF + wr * 64 + m * 16 + fr; const size_t off = (size_t)(u.pm * BM + rl) * ldc + col0; float q = 0.f;
#pragma unroll
                for (int bj = 0; bj < 2; ++bj) { const u32x4 xb = *(const u32x4*)(X1 + off + bj * HALF); f32x4 v0, v1;
                    v0[0] = __builtin_bit_cast(float, xb.x << 16); v0[1] = __builtin_bit_cast(float, xb.x & 0xffff0000u); v0[2] = __builtin_bit_cast(float, xb.y << 16); v0[3] = __builtin_bit_cast(float, xb.y & 0xffff0000u);
                    v1[0] = __builtin_bit_cast(float, xb.z << 16); v1[1] = __builtin_bit_cast(float, xb.z & 0xffff0000u); v1[2] = __builtin_bit_cast(float, xb.w << 16); v1[3] = __builtin_bit_cast(float, xb.w & 0xffff0000u);
                    v0 = v0 + acc[ai][bj][m][0]; v1 = v1 + acc[ai][bj][m][1]; acc[ai][bj][m][0] = v0; acc[ai][bj][m][1] = v1;
                    q += ((v0[0] * v0[0] + v0[1] * v0[1]) + (v0[2] * v0[2] + v0[3] * v0[3])) + ((v1[0] * v1[0] + v1[1] * v1[1]) + (v1[2] * v1[2] + v1[3] * v1[3])); }
                q += __shfl_xor(q, 16); q += __shfl_xor(q, 32);
                if (fq == 0) P[rl * 4 + wc] = q; }
        asm volatile("s_waitcnt lgkmcnt(0)\n\ts_barrier" ::: "memory");
        if (tid < 256) { const float s = (P[tid * 4] + P[tid * 4 + 1]) + (P[tid * 4 + 2] + P[tid * 4 + 3]);
            __hip_atomic_store(xbuf + ((size_t)(u.pm * BM + tid) * 4 + u.pn), s, __ATOMIC_RELAXED, __HIP_MEMORY_SCOPE_AGENT);
            asm volatile("s_waitcnt vmcnt(0)" ::: "memory");
            if ((tid & 63) == 0) __hip_atomic_fetch_add(cnt + 64 * u.pm, 1u, __ATOMIC_RELAXED, __HIP_MEMORY_SCOPE_AGENT); }
        if (tid < 64) { unsigned spins = 0;
            while ((unsigned)__builtin_amdgcn_readfirstlane(__hip_atomic_load(cnt + 64 * u.pm, __ATOMIC_RELAXED, __HIP_MEMORY_SCOPE_AGENT)) < 16u) { __builtin_amdgcn_s_sleep(2); if (++spins > 400000u) break; }
            __builtin_amdgcn_fence(__ATOMIC_ACQUIRE, "agent"); }
        asm volatile("s_waitcnt vmcnt(0) lgkmcnt(0)\n\ts_barrier" ::: "memory");
        if (tid < 256) { const float* xp = xbuf + (size_t)(u.pm * BM + tid) * 4; float t = 0.f;
#pragma unroll
            for (int k = 0; k < 4; ++k) t += __hip_atomic_load(xp + k, __ATOMIC_RELAXED, __HIP_MEMORY_SCOPE_AGENT);
            S[tid] = 1.0f / sqrtf(t * (1.0f / 1024.0f) + 1e-6f); }
        asm volatile("s_waitcnt vmcnt(0) lgkmcnt(0)\n\ts_barrier" ::: "memory");
        f32x4 gv[2][2];
#pragma unroll
        for (int bj = 0; bj < 2; ++bj)
#pragma unroll
            for (int n = 0; n < 2; ++n) gv[bj][n] = *(const f32x4*)(gain + col0 + bj * HALF + n * 4);
#pragma unroll
        for (int ai = 0; ai < 2; ++ai)
#pragma unroll
            for (int m = 0; m < 4; ++m) { const int rl = ai * HALF + wr * 64 + m * 16 + fr; const float rs = S[rl]; const size_t off = (size_t)(u.pm * BM + rl) * ldc + col0;
#pragma unroll
                for (int bj = 0; bj < 2; ++bj)
#pragma unroll
                    for (int n = 0; n < 2; ++n) *(f32x4*)(out + off + bj * HALF + n * 4) = acc[ai][bj][m][n] * rs * gv[bj][n]; }
    }
};

template <bool I8> __device__ __forceinline__ typename AccT<I8>::type mma16(bf16x8 a, bf16x8 b, typename AccT<I8>::type c) {
    if constexpr (I8) return __builtin_amdgcn_mfma_i32_16x16x64_i8(__builtin_bit_cast(i32x4, a), __builtin_bit_cast(i32x4, b), c, 0, 0, 0);
    else return __builtin_amdgcn_mfma_f32_16x16x32_bf16(a, b, c, 0, 0, 0);
}
template <class Epi, class Sched, bool ALIGN_EPI = false, bool SP2 = false, bool I8 = false>
__device__ __forceinline__ void gemm_phase(PG8_LAS unsigned char* lds, const Gemm g, const Sched& S, const Epi& E) {
    int tid = threadIdx.x; asm volatile("" : "+v"(tid));
    const int wid = __builtin_amdgcn_readfirstlane(tid >> 6), lane = tid & 63, wr = wid >> 2, wc = wid & 3, fr = lane & 15, fq = lane >> 4;
    const int K = g.K, nt = K / BK, lda = g.lda;
    unsigned voffA[2], voffB[2];
#pragma unroll
    for (int i = 0; i < 2; ++i) { int R, C; stage_rc(tid * 16 + i * 8192, R, C); const int Rb = Epi::PERM ? ((R & ~31) + perm32(R & 31)) : R;
        voffA[i] = (unsigned)(R * lda + C) * 2u; voffB[i] = (unsigned)(Rb * K + C) * 2u; }
    const size_t kstep = (size_t)(BK * 2);
    const size_t hstepA = (size_t)HALF * lda * 2, hstepB = (size_t)HALF * K * 2;
    const size_t tstepA = 2 * hstepA, tstepB = 2 * hstepB;
    const unsigned ldsw = (unsigned)wid * 1024u;
    const int aoff = lds_byte(wr * 64 + fr, fq * 8), boff = lds_byte(wc * 32 + fr, fq * 8);
#define PG8_SA(b, h) (((b) * 2 + (h)) * HTB)
#define PG8_SB(b, h) ((4 + (b) * 2 + (h)) * HTB)
#define PG8_STAGE(bufoff, gbase, voff) do { _Pragma("unroll") for (int _i = 0; _i < 2; ++_i) \
        __builtin_amdgcn_global_load_lds((const unsigned*)((const char*)(gbase) + (voff)[_i]), (PG8_LAS unsigned*)(lds + (bufoff) + ldsw + _i * 8192), 16, 0, 0); } while (0)
#define PG8_LDA(dst, b, h) do { _Pragma("unroll") for (int m = 0; m < 4; ++m) _Pragma("unroll") for (int k = 0; k < 2; ++k) dst[m][k] = *(const PG8_LAS bf16x8*)(lds + PG8_SA(b, h) + aoff + m * 2048 + k * 1024); } while (0)
#define PG8_LDB(dst, b, h) do { _Pragma("unroll") for (int n = 0; n < 2; ++n) _Pragma("unroll") for (int k = 0; k < 2; ++k) dst[n][k] = *(const PG8_LAS bf16x8*)(lds + PG8_SB(b, h) + boff + n * 2048 + k * 1024); } while (0)
#define PG8_MMA(ai, bj, At, Bt) do { __builtin_amdgcn_s_setprio(1); _Pragma("unroll") for (int m = 0; m < 4; ++m) _Pragma("unroll") for (int n = 0; n < 2; ++n) _Pragma("unroll") for (int k = 0; k < 2; ++k) \
        acc[ai][bj][m][n] = mma16<I8>(Bt[n][k], At[m][k], acc[ai][bj][m][n]); __builtin_amdgcn_s_setprio(0); } while (0)
#define PG8_WAIT_V(n) asm volatile("s_waitcnt vmcnt(" #n ")" ::: "memory")
#define PG8_WAIT_L(n) asm volatile("s_waitcnt lgkmcnt(" #n ")" ::: "memory")
#define PG8_BAR __builtin_amdgcn_s_barrier()
#define PG8_SCHED __builtin_amdgcn_sched_barrier(0)
    Unit cur, nxt; int ui = 0;
    if (!S.next(0, cur)) return;
    typedef typename AccT<I8>::type acc_t; acc_t acc[2][2][4][2];
#pragma unroll
    for (int a = 0; a < 2; ++a)
#pragma unroll
        for (int b = 0; b < 2; ++b)
#pragma unroll
            for (int m = 0; m < 4; ++m)
#pragma unroll
                for (int n = 0; n < 2; ++n) acc[a][b][m][n] = (acc_t){0, 0, 0, 0};
    bf16x8 At[4][2], B0[2][2], B1[2][2];
    const char* cA = (const char*)g.A + (g.ovl ? (size_t)ovl_row_base(cur.pm) * lda * 2 : (size_t)cur.pm * tstepA); const char* cB = (const char*)g.Bt + (size_t)cur.pn * tstepB;
    S.a_ready(cur);
    if constexpr (Epi::PREFETCH) E.prefetch(cur, wid, lane);
    if constexpr (SP2) {
        PG8_STAGE(PG8_SB(0, 0), cB, voffB); PG8_STAGE(PG8_SB(0, 1), cB + hstepB, voffB); PG8_STAGE(PG8_SA(0, 0), cA, voffA); PG8_STAGE(PG8_SA(0, 1), cA + hstepA, voffA);
        if (wr == 1) PG8_BAR;
        PG8_WAIT_V(2); PG8_BAR;
        PG8_STAGE(PG8_SB(1, 0), cB + kstep, voffB); PG8_STAGE(PG8_SA(1, 0), cA + kstep, voffA); PG8_STAGE(PG8_SB(1, 1), cB + hstepB + kstep, voffB);
        PG8_WAIT_V(6); PG8_BAR;
    } else {
        PG8_STAGE(PG8_SB(0, 0), cB, voffB); PG8_STAGE(PG8_SA(0, 0), cA, voffA); PG8_STAGE(PG8_SB(0, 1), cB + hstepB, voffB); PG8_STAGE(PG8_SA(0, 1), cA + hstepA, voffA);
        if (wr == 1) PG8_BAR;
        PG8_WAIT_V(4); PG8_BAR;
        PG8_STAGE(PG8_SB(1, 0), cB + kstep, voffB); PG8_STAGE(PG8_SA(1, 0), cA + kstep, voffA); PG8_STAGE(PG8_SB(1, 1), cB + hstepB + kstep, voffB);
        PG8_WAIT_V(6); PG8_BAR;
    }
    for (;;) {
        const bool has_next = S.next(ui + 1, nxt);
        const char* nA = has_next ? (const char*)g.A + (g.ovl ? (size_t)ovl_row_base(nxt.pm) * lda * 2 : (size_t)nxt.pm * tstepA) : cA; const char* nB = has_next ? (const char*)g.Bt + (size_t)nxt.pn * tstepB : cB;
        for (int t = 0; t < nt; t += 2) {
            const bool last = (t == nt - 2);
            const char* a1 = cA + (size_t)(t + 1) * kstep;
            const char* a2 = last ? nA : cA + (size_t)(t + 2) * kstep; const char* b2 = last ? nB : cB + (size_t)(t + 2) * kstep;
            const char* a3 = a2 + kstep; const char* b3 = b2 + kstep;
            if (last && has_next) S.a_ready(nxt);
            if constexpr (Epi::MIDK) { if (t == Epi::MIDK_T) E.midk(acc, cur, wr, fr, fq); }
            if constexpr (SP2) {
            PG8_LDB(B0, 0, 0); PG8_LDB(B1, 0, 1); PG8_SCHED; PG8_LDA(At, 0, 0); PG8_STAGE(PG8_SA(1, 1), a1 + hstepA, voffA);
            PG8_WAIT_V(8); PG8_WAIT_L(0); PG8_BAR; PG8_MMA(0, 0, At, B0); PG8_MMA(0, 1, At, B1); PG8_BAR; PG8_SCHED;
            PG8_LDA(At, 0, 1); PG8_STAGE(PG8_SB(0, 0), b2, voffB); PG8_STAGE(PG8_SB(0, 1), b2 + hstepB, voffB); PG8_STAGE(PG8_SA(0, 0), a2, voffA);
            PG8_WAIT_V(8); PG8_WAIT_L(0); PG8_BAR; PG8_MMA(1, 0, At, B0); PG8_MMA(1, 1, At, B1); PG8_BAR; PG8_SCHED;
            PG8_LDB(B0, 1, 0); PG8_LDB(B1, 1, 1); PG8_SCHED; PG8_LDA(At, 1, 0); PG8_STAGE(PG8_SA(0, 1), a2 + hstepA, voffA);
            PG8_WAIT_V(8); PG8_WAIT_L(0); PG8_BAR; PG8_MMA(0, 0, At, B0); PG8_MMA(0, 1, At, B1); PG8_BAR; PG8_SCHED;
            PG8_LDA(At, 1, 1); PG8_STAGE(PG8_SB(1, 0), b3, voffB); PG8_STAGE(PG8_SB(1, 1), b3 + hstepB, voffB); PG8_STAGE(PG8_SA(1, 0), a3, voffA);
            PG8_WAIT_V(8); PG8_WAIT_L(0); PG8_BAR; PG8_MMA(1, 0, At, B0); PG8_MMA(1, 1, At, B1); PG8_BAR; PG8_SCHED;
            } else {
            PG8_LDB(B0, 0, 0); PG8_SCHED; PG8_LDA(At, 0, 0); PG8_STAGE(PG8_SA(1, 1), a1 + hstepA, voffA);
            PG8_WAIT_L(8); PG8_BAR; PG8_WAIT_L(0); PG8_MMA(0, 0, At, B0); PG8_BAR; PG8_SCHED;
            PG8_LDB(B1, 0, 1); PG8_STAGE(PG8_SB(0, 0), b2, voffB);
            PG8_BAR; PG8_WAIT_L(0); PG8_MMA(0, 1, At, B1); PG8_BAR;
            PG8_LDA(At, 0, 1); PG8_STAGE(PG8_SA(0, 0), a2, voffA);
            PG8_BAR; PG8_WAIT_L(0); PG8_MMA(1, 0, At, B0); PG8_BAR; PG8_SCHED;
            PG8_STAGE(PG8_SB(0, 1), b2 + hstepB, voffB);
            PG8_WAIT_V(6); PG8_BAR; PG8_MMA(1, 1, At, B1); PG8_BAR;
            PG8_LDB(B0, 1, 0); PG8_SCHED; PG8_LDA(At, 1, 0); PG8_STAGE(PG8_SA(0, 1), a2 + hstepA, voffA);
            PG8_WAIT_L(8); PG8_BAR; PG8_WAIT_L(0); PG8_MMA(0, 0, At, B0); PG8_BAR; PG8_SCHED;
            PG8_LDB(B1, 1, 1); PG8_STAGE(PG8_SB(1, 0), b3, voffB);
            PG8_BAR; PG8_WAIT_L(0); PG8_MMA(0, 1, At, B1); PG8_BAR;
            PG8_LDA(At, 1, 1); PG8_STAGE(PG8_SA(1, 0), a3, voffA);
            PG8_BAR; PG8_WAIT_L(0); PG8_MMA(1, 0, At, B0); PG8_BAR; PG8_SCHED;
            PG8_STAGE(PG8_SB(1, 1), b3 + hstepB, voffB);
            PG8_WAIT_V(6); PG8_BAR; PG8_MMA(1, 1, At, B1); PG8_BAR;
            }
        }
        if constexpr (ALIGN_EPI) { if (wr == 0) PG8_BAR; }
        if constexpr (!Epi::AFTER_DRAIN) { E(acc, cur, wr, wc, fr, fq); S.done(cur); }
        if constexpr (Epi::PREFETCH) { if (has_next) E.prefetch(nxt, wid, lane); }
        if (!has_next) break;
#pragma unroll
        for (int a = 0; a < 2; ++a)
#pragma unroll
            for (int b = 0; b < 2; ++b)
#pragma unroll
                for (int m = 0; m < 4; ++m)
#pragma unroll
                    for (int n = 0; n < 2; ++n) acc[a][b][m][n] = (acc_t){0, 0, 0, 0};
        cur = nxt; cA = nA; cB = nB; ++ui;
        if constexpr (ALIGN_EPI) { if (wr == 1) PG8_BAR; }
    }
    PG8_WAIT_V(0);
    if constexpr (!ALIGN_EPI) { if (wr == 0) PG8_BAR; }
    PG8_BAR;
#undef PG8_SA
#undef PG8_SB
#undef PG8_STAGE
#undef PG8_LDA
#undef PG8_LDB
#undef PG8_MMA
#undef PG8_WAIT_V
#undef PG8_WAIT_L
#undef PG8_BAR
#undef PG8_SCHED
}
}

constexpr int NWAVES = 8;
#ifndef MK_ONE_LAUNCH
#define MK_ONE_LAUNCH 1
#endif
constexpr int N_PHASES = 11;

constexpr int BATCH = 8, SEQ = 4096, D = 1024, NH = 12, HD = 64, AW = 768, NG = 4, GD = 64, FW = 256, MIXW = 1024, NPROJ = 2560, FF = 2816;
constexpr int M = BATCH * SEQ;
constexpr float EPS = 1e-6f;

constexpr size_t MiB = 1u << 20;
constexpr size_t WS_CTL = 0, CTL_ZERO_BYTES = 96 * 1024;
constexpr size_t WS_TAB = 1 * MiB;
constexpr size_t TAB_BIAS = 0;
constexpr size_t TAB_MG = 32 * 1024;
constexpr size_t TAB_TW = 192 * 1024;
constexpr size_t TAB_CW4 = 256 * 1024;
constexpr size_t WS_WIN = 2 * MiB;
constexpr size_t WS_WOUT = 7 * MiB;
constexpr size_t WS_WGV = 9 * MiB;
constexpr size_t WS_WD = 20 * MiB;
constexpr size_t WS_XN = 26 * MiB;
constexpr size_t WS_PROJ = 90 * MiB;
constexpr size_t WS_A2 = 250 * MiB;
constexpr size_t WS_PQ = 314 * MiB;
constexpr size_t WS_ML = 380 * MiB;
constexpr size_t WS_A8 = 314 * MiB;
constexpr size_t WS_HALO = 400 * MiB;
constexpr size_t WS_RS0 = 441 * MiB;
constexpr size_t WS_XBUF = 440 * MiB;
constexpr size_t WS_SSA = 446 * MiB;
constexpr size_t WS_SS1 = 442 * MiB;
constexpr size_t WS_SS2 = 444 * MiB;
constexpr size_t WS_GV = 90 * MiB;
constexpr size_t WS_END = 448 * MiB;
constexpr int CW_BAR = 1024, CW_PANEL = 8192, CW_CMAX = 16384;

constexpr int RING_OFF = 0, RING_BYTES = 131072;
constexpr int LDSCTL_OFF = RING_BYTES, MISC_OFF = LDSCTL_OFF + 320;
constexpr int LDS_BYTES = 163840;

#define GAS __attribute__((address_space(1)))
#define LAS __attribute__((address_space(3)))
typedef unsigned short bf16;
typedef unsigned v4u __attribute__((ext_vector_type(4)));
typedef unsigned v2u __attribute__((ext_vector_type(2)));
typedef float f32x4 __attribute__((ext_vector_type(4)));
typedef GAS unsigned gu32;
#define RLX_AGENT __ATOMIC_RELAXED, __HIP_MEMORY_SCOPE_AGENT
#define LDS_WAIT() asm volatile("s_waitcnt lgkmcnt(0)" ::: "memory")
#define VM_WAIT() asm volatile("s_waitcnt vmcnt(0)" ::: "memory")
__device__ __forceinline__ unsigned f2bf(float f) { unsigned u = __builtin_bit_cast(unsigned, f); return (u + 0x7fffu + ((u >> 16) & 1u)) >> 16; }
__device__ __forceinline__ unsigned pk2(float lo, float hi) { return f2bf(lo) | (f2bf(hi) << 16); }
__device__ __forceinline__ float bflo(unsigned w) { return __builtin_bit_cast(float, w << 16); }
__device__ __forceinline__ float bfhi(unsigned w) { return __builtin_bit_cast(float, w & 0xffff0000u); }
__device__ __forceinline__ float bf2f(bf16 h) { return __builtin_bit_cast(float, (unsigned)h << 16); }

#define XB_TMO      128
#define XB_XCNT(j)  (256  + 64 * (j))
#define XB_XSUB(j)  (1280 + 64 * (j))
#define XB_XGEN(j)  (2304 + 64 * (j))
#define XB_TOP      3328
#define XB_TOPGEN   3392
#define XCD_BAR_WORDS 3456
#define XB_SPIN_CAP (1u << 18)
__device__ __forceinline__ unsigned xb_ld(unsigned* p)              { return __hip_atomic_load(p, __ATOMIC_RELAXED, __HIP_MEMORY_SCOPE_AGENT); }
__device__ __forceinline__ unsigned xb_add(unsigned* p, unsigned v) { return __hip_atomic_fetch_add(p, v, __ATOMIC_RELAXED, __HIP_MEMORY_SCOPE_AGENT); }
__device__ __forceinline__ unsigned xb_xcc_id() { return (unsigned)__builtin_amdgcn_s_getreg((3 << 11) | 20) & 0xFu; }
#define XB_SPIN(cond, bar) do { unsigned _sp = 0; while (cond) { __builtin_amdgcn_s_sleep(1); \
    if ((++_sp & 255u) == 0u) { if (xb_ld(&(bar)[XB_TMO])) break; if (_sp > XB_SPIN_CAP) { atomicAdd(&(bar)[XB_TMO], 1u); break; } } } } while (0)
struct XcdBarrier { unsigned* bar; unsigned x; volatile LAS unsigned* st; };
__device__ __forceinline__ XcdBarrier xcd_barrier_post(unsigned* bar, volatile LAS unsigned* st) {
    XcdBarrier b; b.bar = bar; b.x = xb_xcc_id(); b.st = st;
    if (threadIdx.x == 0) (void)xb_add(&bar[XB_XCNT(b.x)], 1u);
    return b;
}
__device__ __forceinline__ void xcd_barrier_complete(unsigned* bar, unsigned x, unsigned& nloc, unsigned& nx) {
    const unsigned G = gridDim.x * gridDim.y * gridDim.z;
    unsigned sum, cnt, mine, sp = 0u;
    for (;;) {
        sum = 0u; cnt = 0u; mine = 0u;
#pragma unroll
        for (unsigned j = 0; j < 16; ++j) { const unsigned c = xb_ld(&bar[XB_XCNT(j)]); sum += c; cnt += (c > 0u) ? 1u : 0u; mine = (j == x) ? c : mine; }
        if (sum == G) break;
        __builtin_amdgcn_s_sleep(1);
        if ((++sp & 255u) == 0u) { if (xb_ld(&bar[XB_TMO])) break; if (sp > XB_SPIN_CAP) { atomicAdd(&bar[XB_TMO], 1u); break; } }
    }
    nloc = mine > 0u ? mine : 1u; nx = cnt > 0u ? cnt : 1u;
}
__device__ __forceinline__ void xcd_barrier(const XcdBarrier& b) {
    asm volatile("s_waitcnt vmcnt(0)" ::: "memory");
    __syncthreads();
    if (threadIdx.x == 0) {
        unsigned* bar = b.bar;
        __builtin_amdgcn_s_waitcnt(0);
        unsigned nloc = b.st[0], nx = b.st[1];
        if (nloc == 0u) { xcd_barrier_complete(bar, b.x, nloc, nx); b.st[0] = nloc; b.st[1] = nx; }
        const unsigned old = xb_add(&bar[XB_XSUB(b.x)], 1u);
        const unsigned gen = old / nloc;
        if (old + 1u == (gen + 1u) * nloc) {
            __builtin_amdgcn_fence(__ATOMIC_RELEASE, "agent");
            asm volatile("s_waitcnt vmcnt(0)" ::: "memory");
            const unsigned og = xb_add(&bar[XB_TOP], 1u);
            const unsigned tg = og / nx;
            if (og + 1u == (tg + 1u) * nx) xb_add(&bar[XB_TOPGEN], 1u);
            else XB_SPIN(xb_ld(&bar[XB_TOPGEN]) == tg, bar);
            __builtin_amdgcn_fence(__ATOMIC_ACQUIRE, "agent");
            xb_add(&bar[XB_XGEN(b.x)], 1u);
            asm volatile("s_waitcnt vmcnt(0)" ::: "memory");
        } else {
            XB_SPIN(xb_ld(&bar[XB_XGEN(b.x)]) == gen, bar);
            __builtin_amdgcn_fence(__ATOMIC_ACQUIRE, "agent");
            asm volatile("s_waitcnt vmcnt(0)" ::: "memory");
        }
    }
    __syncthreads();
}

struct Frame {
    LAS unsigned char* lds;
    volatile LAS unsigned* MISC;
    gu32* ctl;
    int tid, lane, wave;
    int vcu, G;
    const float *x, *g_mix, *w_in, *g_attn, *rel_tab, *f_w, *f_b, *g_four, *w_out, *g_ffn, *w_gate, *w_val, *conv_w, *conv_b, *w_down, *g_fin;
    float* out;
    unsigned char* ws;
};

__device__ __forceinline__ float wave_sum(float v) {
#pragma unroll
    for (int o = 1; o < 64; o <<= 1) v += __shfl_xor(v, o);
    return v;
}
__device__ __forceinline__ void p0_transpose_item(const float* W, int K, int N, bf16* WT, int row_off, LAS float* scr, int item, int lane, const float* gain = nullptr, bool il = false) {
    const int nblk = N / 32, kb = item / nblk, nb = item % nblk, k0 = 64 * kb, n0 = 32 * nb; if (il) row_off += 128 * (n0 >> 7);
    {   f32x4 v[8]; const int c4 = 4 * (lane & 7);
#pragma unroll
        for (int i = 0; i < 8; ++i) v[i] = *(const GAS f32x4*)(W + (size_t)(k0 + (lane >> 3) + 8 * i) * N + n0 + c4);
#pragma unroll
        for (int i = 0; i < 8; ++i) { const int kk = (lane >> 3) + 8 * i; const float gsc = gain ? gain[k0 + kk] : 1.0f; LAS float* sp = scr + kk * 33 + c4;
            sp[0] = v[i].x * gsc; sp[1] = v[i].y * gsc; sp[2] = v[i].z * gsc; sp[3] = v[i].w * gsc; } }
    LDS_WAIT(); asm volatile("" ::: "memory");
    const int c = lane & 7;
#pragma unroll
    for (int j = 0; j < 4; ++j) { const int n = (lane >> 3) + 8 * j; const LAS float* s = scr + (8 * c) * 33 + n;
        v4u o; o.x = pk2(s[0 * 33], s[1 * 33]); o.y = pk2(s[2 * 33], s[3 * 33]); o.z = pk2(s[4 * 33], s[5 * 33]); o.w = pk2(s[6 * 33], s[7 * 33]);
        *(GAS v4u*)(WT + (size_t)(row_off + n0 + n) * K + k0 + 8 * c) = o; }
    LDS_WAIT(); asm volatile("" ::: "memory");
}

__device__ __forceinline__ void p0_colmax_item(const float* W, int K, int N, unsigned* cmax, int row_off, int item, int lane, const float* gain) {
    const int nblk = N / 32, kb = item / nblk, nb = item % nblk, k0 = 64 * kb, n0 = 32 * nb, c4 = 4 * (lane & 7); row_off += 128 * (n0 >> 7);
    f32x4 mx = (f32x4){0.f, 0.f, 0.f, 0.f};
#pragma unroll
    for (int i = 0; i < 8; ++i) { const int kk = (lane >> 3) + 8 * i; const f32x4 v = *(const GAS f32x4*)(W + (size_t)(k0 + kk) * N + n0 + c4) * gain[k0 + kk];
        mx[0] = fmaxf(mx[0], fabsf(v[0])); mx[1] = fmaxf(mx[1], fabsf(v[1])); mx[2] = fmaxf(mx[2], fabsf(v[2])); mx[3] = fmaxf(mx[3], fabsf(v[3])); }
#pragma unroll
    for (int j = 0; j < 4; ++j) { float t = mx[j]; t = fmaxf(t, __shfl_xor(t, 8)); t = fmaxf(t, __shfl_xor(t, 16)); t = fmaxf(t, __shfl_xor(t, 32)); mx[j] = t; }
    if (lane < 8) {
#pragma unroll
        for (int j = 0; j < 4; ++j) atomicMax(cmax + row_off + n0 + c4 + j, __float_as_uint(mx[j])); }
}
__device__ __forceinline__ void p6_quant_item(const float* W, int K, int N, unsigned char* WT, int row_off, LAS float* scr, int item, int lane, const float* gain, const unsigned* cmax) {
    const int nblk = N / 32, kb = item / nblk, nb = item % nblk, k0 = 64 * kb, n0 = 32 * nb; row_off += 128 * (n0 >> 7);
    {   f32x4 v[8]; const int c4 = 4 * (lane & 7);
#pragma unroll
        for (int i = 0; i < 8; ++i) v[i] = *(const GAS f32x4*)(W + (size_t)(k0 + (lane >> 3) + 8 * i) * N + n0 + c4);
#pragma unroll
        for (int i = 0; i < 8; ++i) { const int kk = (lane >> 3) + 8 * i; const float gsc = gain[k0 + kk]; LAS float* sp = scr + kk * 33 + c4;
            sp[0] = v[i].x * gsc; sp[1] = v[i].y * gsc; sp[2] = v[i].z * gsc; sp[3] = v[i].w * gsc; } }
    LDS_WAIT(); asm volatile("" ::: "memory");
    const int c = lane & 7;
#pragma unroll
    for (int j = 0; j < 4; ++j) { const int n = (lane >> 3) + 8 * j; const LAS float* s = scr + (8 * c) * 33 + n; const float cm = __uint_as_float(cmax[row_off + n0 + n]); const float inv = cm > 0.f ? 127.0f / cm : 0.f;
        unsigned lo = 0, hi = 0;
#pragma unroll
        for (int t = 0; t < 4; ++t) { lo |= ((unsigned)(int)__builtin_rintf(s[t * 33] * inv) & 255u) << (8 * t); hi |= ((unsigned)(int)__builtin_rintf(s[(4 + t) * 33] * inv) & 255u) << (8 * t); }
        v2u o; o.x = lo; o.y = hi; *(GAS v2u*)(WT + (size_t)(row_off + n0 + n) * K + k0 + 8 * c) = o; }
    LDS_WAIT(); asm volatile("" ::: "memory");
}
__device__ __forceinline__ void rms_row_to_bf16(const float* xrow, const float* gain, bf16* orow, int lane) {
    const GAS f32x4* xr = (const GAS f32x4*)xrow + lane; const GAS f32x4* gr = (const GAS f32x4*)gain + lane;
    f32x4 v[4]; float s = 0.f;
#pragma unroll
    for (int j = 0; j < 4; ++j) { v[j] = xr[64 * j]; s += (v[j].x * v[j].x + v[j].y * v[j].y) + (v[j].z * v[j].z + v[j].w * v[j].w); }
    const float rstd = 1.0f / sqrtf(wave_sum(s) * (1.f / D) + EPS);
    GAS unsigned long long* o8 = (GAS unsigned long long*)orow + lane;
#pragma unroll
    for (int j = 0; j < 4; ++j) { const f32x4 gg = gr[64 * j]; o8[64 * j] = (unsigned long long)pk2(v[j].x * rstd * gg.x, v[j].y * rstd * gg.y) | ((unsigned long long)pk2(v[j].z * rstd * gg.z, v[j].w * rstd * gg.w) << 32); }
}
__device__ __forceinline__ int t5_bucket(int rel) {
    const int ret = rel > 0 ? 16 : 0; const int n = rel < 0 ? -rel : rel;
    const float nf = (float)(n > 1 ? n : 1);
    int large = 8 + (int)(logf(nf / 8.0f) / logf(128.0f) * 8.0f);
    large = large < 15 ? large : 15;
    return ret + (n < 8 ? n : large);
}

__device__ __forceinline__ void p0_prologue(Frame& F) {
    LAS float* scr = (LAS float*)(F.lds + RING_OFF + F.wave * 16384);
    const int gw = F.vcu * NWAVES + F.wave, NGW = F.G * NWAVES;
    bf16* WinT = (bf16*)(F.ws + WS_WIN); bf16* WoutT = (bf16*)(F.ws + WS_WOUT); bf16* WgvT = (bf16*)(F.ws + WS_WGV); bf16* WdT = (bf16*)(F.ws + WS_WD);
    constexpr int I_IN = (D / 64) * (NPROJ / 32), I_OUT = (MIXW / 64) * (D / 32), I_G = (D / 64) * (FF / 32), I_D = (FF / 64) * (D / 32);
    constexpr int NITEMS = I_IN + I_OUT + 2 * I_G + I_D;
    for (int it = gw; it < NITEMS; it += NGW) {
        int r = it;
        if (r < I_IN) { p0_transpose_item(F.w_in, D, NPROJ, WinT, 0, scr, r, F.lane, F.g_mix); continue; } r -= I_IN;
        if (r < I_OUT) { const int k0 = 64 * (r / (D / 32)); p0_transpose_item(F.w_out, MIXW, D, WoutT, 0, scr, r, F.lane, k0 < AW ? F.g_attn : F.g_four - AW); continue; } r -= I_OUT;
        if (r < 2 * I_G) { const bool isv = r >= I_G; p0_colmax_item(isv ? F.w_val : F.w_gate, D, FF, (unsigned*)(F.ctl + CW_CMAX), isv ? 128 : 0, isv ? r - I_G : r, F.lane, F.g_ffn); continue; } r -= 2 * I_G;
        p0_transpose_item(F.w_down, FF, D, WdT, 0, scr, r, F.lane);
    }
    float* tabBias = (float*)(F.ws + WS_TAB + TAB_BIAS); float* tabMg = (float*)(F.ws + WS_TAB + TAB_MG); float* tabTw = (float*)(F.ws + WS_TAB + TAB_TW);
    const int gt = F.vcu * (NWAVES * 64) + F.tid, NGT = F.G * NWAVES * 64;
    for (int i = gt; i < 3 * 129 * 12; i += NGT) { const int h = i % 12, jj = (i / 12) % 129, br = i / (12 * 129); const int dil = br == 0 ? 1 : (br == 1 ? 4 : 16);
        tabBias[i] = F.rel_tab[t5_bucket((jj - 64) * dil) * 12 + h]; }
    for (int i = gt; i < 4 * 64 * 128; i += NGT) { const int col = i & 127, c = (i >> 7) & 63, g = i >> 13; const int e = col & 63; float acc = 0.f;
        for (int d = 0; d < 64; ++d) { const float rev = (float)((c * d) & 63) * (1.0f / 64.0f); const float t = col < 64 ? __builtin_amdgcn_cosf(rev) : -__builtin_amdgcn_sinf(rev); acc += t * F.f_w[(g * 64 + d) * 64 + e]; }
        tabMg[i] = acc; }
    for (int i = gt; i < 4096; i += NGT) { float sv, cv; sincospif((float)i * (1.0f / 2048.0f), &sv, &cv); tabTw[2 * i] = cv; tabTw[2 * i + 1] = sv; }
    bf16* XN = (bf16*)(F.ws + WS_XN);
    {   float* RS0 = (float*)(F.ws + WS_RS0);
        for (int m0 = gw; m0 < M; m0 += 4 * NGW) { f32x4 v[4][4];
#pragma unroll
            for (int r = 0; r < 4; ++r) { const int m = m0 + r * NGW; const GAS f32x4* xr = (const GAS f32x4*)(F.x + (size_t)(m < M ? m : 0) * D) + F.lane;
#pragma unroll
                for (int j = 0; j < 4; ++j) v[r][j] = xr[64 * j]; }
#pragma unroll
            for (int r = 0; r < 4; ++r) { const int m = m0 + r * NGW; float s = 0.f;
#pragma unroll
                for (int j = 0; j < 4; ++j) s += (v[r][j].x * v[r][j].x + v[r][j].y * v[r][j].y) + (v[r][j].z * v[r][j].z + v[r][j].w * v[r][j].w);
                const float rstd = 1.0f / sqrtf(wave_sum(s) * (1.f / D) + EPS);
                if (m < M) { GAS unsigned long long* o8 = (GAS unsigned long long*)(XN + (size_t)m * D) + F.lane; if (F.lane == 0) RS0[m] = rstd;
#pragma unroll
                    for (int j = 0; j < 4; ++j) { const f32x4 t = v[r][j]; o8[64 * j] = (unsigned long long)pk2(t.x, t.y) | ((unsigned long long)pk2(t.z, t.w) << 32); } } } } }
}

namespace att {
typedef short bf16x8 __attribute__((ext_vector_type(8)));
typedef short v4i16 __attribute__((ext_vector_type(4)));
constexpr float LOG2E = 1.4426950408889634f;
constexpr int TABN = 512, TPAD0 = 128;
constexpr int LDS_K = 0, LDS_V = 49152, LDS_T0 = 98304, LDS_T1 = 98304 + 8192;
struct QT { bf16x8 q[2]; f32x4 o[4]; float m, l; };
__device__ __forceinline__ v4i16 vtr(const LAS unsigned char* p) { return __builtin_amdgcn_ds_read_tr16_b64_v4i16((LAS v4i16*)p); }

__device__ __forceinline__ void build_table(Frame& F, int ldsoff, int br, int h) {
    const float* tabBias = (const float*)(F.ws + WS_TAB + TAB_BIAS);
    LAS float* T = (LAS float*)(F.lds + ldsoff);
    for (int e = F.tid; e < 4 * TABN; e += NWAVES * 64) { const int s = e / TABN, n = e % TABN; const int r64 = n + s - TPAD0;
        T[e] = (r64 >= 0 && r64 <= 128) ? tabBias[(br * 129 + r64) * 12 + h] * LOG2E : -INFINITY; }
}
__device__ __forceinline__ const LAS float* table_ptr(Frame& F, int ldsoff, int idx0) { const int s = idx0 & 3; return (const LAS float*)(F.lds + ldsoff) + s * TABN + (idx0 - s); }

__device__ __forceinline__ int pass_tok(int mode, int a, int row) {
    if (mode == 0) { const int t = a - 64 + row; return (t >= 0 && t < SEQ) ? t : -1; }
    if (mode == 3) return a + 16 * row;
    const int hi = row >= 192 ? 1 : 0, u = a + (hi ? row - 192 : row), c = 2 * (mode - 1) + hi; return (u >= 0 && u < SEQ / 4) ? c + 4 * u : -1;
}
struct Pre { v4u k[6], v[6]; };
template <int NIT> __device__ __forceinline__ void prefetch(Frame& F, Pre& R, const bf16* P, int h, int mode, int a) {
#pragma unroll
    for (int it = 0; it < NIT; ++it) { const int idx = F.tid + it * (NWAVES * 64), row = idx >> 3, ph = idx & 7; const int t = pass_tok(mode, a, row);
        const int ck = ph ^ ((row >> 1) & 7), cv = ph ^ (((row >> 1) & 3) << 1);
        R.k[it] = (v4u){0u, 0u, 0u, 0u}; R.v[it] = (v4u){0u, 0u, 0u, 0u};
        if (t >= 0) { const bf16* rp = P + (size_t)t * NPROJ + h * 64; R.k[it] = *(const GAS v4u*)(rp + AW + ck * 8); R.v[it] = *(const GAS v4u*)(rp + 2 * AW + cv * 8); } }
}
template <int NIT> __device__ __forceinline__ void commit(Frame& F, const Pre& R) {
#pragma unroll
    for (int it = 0; it < NIT; ++it) { const int idx = F.tid + it * (NWAVES * 64);
        *(LAS v4u*)(F.lds + LDS_K + idx * 16) = R.k[it]; *(LAS v4u*)(F.lds + LDS_V + idx * 16) = R.v[it]; }
}
__device__ __forceinline__ float xmax4(float v) {
    auto a = __builtin_amdgcn_permlane16_swap(__float_as_uint(v), __float_as_uint(v), false, false); v = fmaxf(__uint_as_float(a[0]), __uint_as_float(a[1]));
    auto b = __builtin_amdgcn_permlane32_swap(__float_as_uint(v), __float_as_uint(v), false, false); return fmaxf(__uint_as_float(b[0]), __uint_as_float(b[1]));
}
__device__ __forceinline__ float xsum4(float v) {
    auto a = __builtin_amdgcn_permlane16_swap(__float_as_uint(v), __float_as_uint(v), false, false); v = __uint_as_float(a[0]) + __uint_as_float(a[1]);
    auto b = __builtin_amdgcn_permlane32_swap(__float_as_uint(v), __float_as_uint(v), false, false); return __uint_as_float(b[0]) + __uint_as_float(b[1]);
}
__device__ __forceinline__ void load_q(QT& T, const bf16* qrow  , int g) {
#pragma unroll
    for (int ks = 0; ks < 2; ++ks) { const v4u w = *(const GAS v4u*)(qrow + 8 * g + 32 * ks); const float sc = 0.125f * LOG2E; v4u o;
        o.x = pk2(bflo(w.x) * sc, bfhi(w.x) * sc); o.y = pk2(bflo(w.y) * sc, bfhi(w.y) * sc); o.z = pk2(bflo(w.z) * sc, bfhi(w.z) * sc); o.w = pk2(bflo(w.w) * sc, bfhi(w.w) * sc);
        T.q[ks] = __builtin_bit_cast(bf16x8, o); }
#pragma unroll
    for (int db = 0; db < 4; ++db) T.o[db] = (f32x4){0.f, 0.f, 0.f, 0.f};
    T.m = -1e30f; T.l = 0.f;
}
typedef float f32x2_t __attribute__((ext_vector_type(2))); typedef __bf16 bf16x2_t __attribute__((ext_vector_type(2)));
__device__ __forceinline__ unsigned cvtpk(float lo, float hi) { f32x2_t v = {lo, hi}; bf16x2_t b = __builtin_convertvector(v, bf16x2_t); return __builtin_bit_cast(unsigned, b); }
constexpr float THR = 8.0f;
template <int NQ, int NP> __device__ __forceinline__ void attn_step(QT (&T)[NQ], const LAS unsigned char* kp, const LAS unsigned char* vp, const LAS float* const (&tp)[NQ], int p, int koff0, int koff1, const int (&voff)[4], int klo, int khi, bool edge, int g) {
    bf16x8 kf[NP][4]; v4i16 vlo[NP][4], vhi[NP][4];
#pragma unroll
    for (int c = 0; c < NP; ++c) { kf[c][0] = *(const LAS bf16x8*)(kp + c * 4096 + koff0); kf[c][1] = *(const LAS bf16x8*)(kp + c * 4096 + koff1); kf[c][2] = *(const LAS bf16x8*)(kp + c * 4096 + 2048 + koff0); kf[c][3] = *(const LAS bf16x8*)(kp + c * 4096 + 2048 + koff1);
#pragma unroll
        for (int db = 0; db < 4; ++db) { vlo[c][db] = vtr(vp + c * 4096 + voff[db]); vhi[c][db] = vtr(vp + c * 4096 + 2048 + voff[db]); } }
#pragma unroll
    for (int n = 0; n < NQ; ++n) {
        f32x4 s[NP][2];
#pragma unroll
        for (int c = 0; c < NP; ++c) {
            s[c][0] = *(const LAS f32x4*)(tp[n] + (p + c) * 32); s[c][1] = *(const LAS f32x4*)(tp[n] + (p + c) * 32 + 16);
            s[c][0] = __builtin_amdgcn_mfma_f32_16x16x32_bf16(kf[c][0], T[n].q[0], s[c][0], 0, 0, 0); s[c][0] = __builtin_amdgcn_mfma_f32_16x16x32_bf16(kf[c][1], T[n].q[1], s[c][0], 0, 0, 0);
            s[c][1] = __builtin_amdgcn_mfma_f32_16x16x32_bf16(kf[c][2], T[n].q[0], s[c][1], 0, 0, 0); s[c][1] = __builtin_amdgcn_mfma_f32_16x16x32_bf16(kf[c][3], T[n].q[1], s[c][1], 0, 0, 0);
            if (edge) { const int kk = (p + c) * 32 + 4 * g;
#pragma unroll
                for (int r = 0; r < 4; ++r) { if (kk + r < klo || kk + r >= khi) s[c][0][r] = -INFINITY; if (kk + 16 + r < klo || kk + 16 + r >= khi) s[c][1][r] = -INFINITY; } } }
        float tm = fmaxf(fmaxf(fmaxf(s[0][0][0], s[0][0][1]), fmaxf(s[0][0][2], s[0][0][3])), fmaxf(fmaxf(s[0][1][0], s[0][1][1]), fmaxf(s[0][1][2], s[0][1][3])));
        if (NP == 2) tm = fmaxf(tm, fmaxf(fmaxf(fmaxf(s[NP - 1][0][0], s[NP - 1][0][1]), fmaxf(s[NP - 1][0][2], s[NP - 1][0][3])), fmaxf(fmaxf(s[NP - 1][1][0], s[NP - 1][1][1]), fmaxf(s[NP - 1][1][2], s[NP - 1][1][3]))));
        tm = xmax4(tm);
        if (__any(tm > T[n].m + THR)) { const float mn = fmaxf(T[n].m, tm), al = __builtin_amdgcn_exp2f(T[n].m - mn); T[n].m = mn; T[n].l *= al;
#pragma unroll
            for (int db = 0; db < 4; ++db) T[n].o[db] = T[n].o[db] * al; }
        const float mref = T[n].m; float ls = 0.f;
#pragma unroll
        for (int c = 0; c < NP; ++c) {
#pragma unroll
            for (int r = 0; r < 4; ++r) { s[c][0][r] = __builtin_amdgcn_exp2f(s[c][0][r] - mref); s[c][1][r] = __builtin_amdgcn_exp2f(s[c][1][r] - mref); }
            ls += ((s[c][0][0] + s[c][0][1]) + (s[c][0][2] + s[c][0][3])) + ((s[c][1][0] + s[c][1][1]) + (s[c][1][2] + s[c][1][3])); }
        T[n].l += ls;
#pragma unroll
        for (int c = 0; c < NP; ++c) {
            v4u pw; pw.x = cvtpk(s[c][0][0], s[c][0][1]); pw.y = cvtpk(s[c][0][2], s[c][0][3]); pw.z = cvtpk(s[c][1][0], s[c][1][1]); pw.w = cvtpk(s[c][1][2], s[c][1][3]);
            const bf16x8 pf = __builtin_bit_cast(bf16x8, pw);
#pragma unroll
            for (int db = 0; db < 4; ++db) { const bf16x8 vf = (bf16x8){vlo[c][db][0], vlo[c][db][1], vlo[c][db][2], vlo[c][db][3], vhi[c][db][0], vhi[c][db][1], vhi[c][db][2], vhi[c][db][3]};
                T[n].o[db] = __builtin_amdgcn_mfma_f32_16x16x32_bf16(vf, pf, T[n].o[db], 0, 0, 0); } }
    }
}
template <int NQ> __device__ __forceinline__ void attn_job(QT (&T)[NQ], const LAS unsigned char* Kw, const LAS unsigned char* Vw, int npairs, const LAS float* const (&tp)[NQ], int klo, int khi, bool edge, int lane) {
    const int i = lane & 15, g = lane >> 4;
    const int koff0 = i * 128 + (((g) ^ (i >> 1)) << 4), koff1 = i * 128 + (((g + 4) ^ (i >> 1)) << 4);
    const int qq = i >> 2, pp = i & 3, vr = 4 * g + qq, fv = (vr >> 1) & 3;
    int voff[4];
#pragma unroll
    for (int db = 0; db < 4; ++db) voff[db] = vr * 128 + ((((db ^ fv) << 1) + (pp >> 1)) << 4) + (pp & 1) * 8;
    int p = 0;
    if (NQ == 1) {
#pragma unroll 1
        for (; p + 2 <= npairs; p += 2) attn_step<NQ, 2>(T, Kw + p * 4096, Vw + p * 4096, tp, p, koff0, koff1, voff, klo, khi, edge, g);
    }
#pragma unroll 1
    for (; p < npairs; ++p) attn_step<NQ, 1>(T, Kw + p * 4096, Vw + p * 4096, tp, p, koff0, koff1, voff, klo, khi, edge, g);
}
__device__ __forceinline__ void four_ssq(Frame& F) {
    const bf16* A2 = (const bf16*)(F.ws + WS_A2); float* SSA = (float*)(F.ws + WS_SSA);
    const int gw = F.vcu * NWAVES + F.wave, NGW = F.G * NWAVES;
    for (int m0 = gw; m0 < M; m0 += 4 * NGW) { v2u w[4];
#pragma unroll
        for (int r = 0; r < 4; ++r) { const int m = (m0 + r * NGW) < M ? (m0 + r * NGW) : 0; w[r] = *(const GAS v2u*)(A2 + (size_t)m * MIXW + AW + 4 * F.lane); }
#pragma unroll
        for (int r = 0; r < 4; ++r) { const int m = m0 + r * NGW; const float a = bflo(w[r].x), b2 = bfhi(w[r].x), c = bflo(w[r].y), d = bfhi(w[r].y);
            const float s = wave_sum((a * a + b2 * b2) + (c * c + d * d));
            if (m < M && F.lane == 0) *(GAS f32x4*)(SSA + (size_t)m * 16 + 12) = (f32x4){s, 0.f, 0.f, 0.f}; } }
}
__device__ __forceinline__ void phase_local(Frame& F) {
    constexpr int NU = BATCH * NH * 16; const int per = (NU + F.G - 1) / F.G, ub = F.vcu * per, ue = (ub + per) < NU ? (ub + per) : NU;
    const bf16* PROJ = (const bf16*)(F.ws + WS_PROJ); const int lane = F.lane, w = F.wave, i = lane & 15, g = lane >> 4;
    const int idx4 = w >> 1, rA = w & 1, rB = 2 + (w & 1);
    Pre R; int hprev = -1;
    __syncthreads();
    if (ub < ue) { const int bh = ub >> 4; prefetch<6>(F, R, PROJ + (size_t)(bh / NH) * SEQ * NPROJ, bh % NH, 0, (ub & 15) * 256); }
    for (int u = ub; u < ue; ++u) {
        const int bh = u >> 4, b = bh / NH, h = bh % NH, s0 = (u & 15) * 256;
        const bf16* P = PROJ + (size_t)b * SEQ * NPROJ; bf16* A2 = (bf16*)(F.ws + WS_A2) + (size_t)b * SEQ * MIXW; float* ML = (float*)(F.ws + WS_ML) + (size_t)b * SEQ * NH * 2;
        __syncthreads();
        commit<6>(F, R);
        if (h != hprev) { build_table(F, LDS_T0, 0, h); build_table(F, LDS_T1, 1, h); hprev = h; }
        __syncthreads();
        const int u0 = s0 / 4 - 64;
        QT T[2];
        const int tokA = s0 + rA + 4 * (16 * idx4 + i), tokB = s0 + rB + 4 * (16 * idx4 + i);
        load_q(T[0], P + (size_t)tokA * NPROJ + h * 64, g); load_q(T[1], P + (size_t)tokB * NPROJ + h * 64, g);
        asm volatile("" ::: "memory");
        prefetch<6>(F, R, P, h, 1, u0);
        {
            const LAS float* tp[2] = { table_ptr(F, LDS_T0, 4 * g - 4 * i - rA + TPAD0), table_ptr(F, LDS_T0, 4 * g - 4 * i - rB + TPAD0) };
            int klo = 64 - s0 - 64 * idx4; klo = klo > 0 ? klo : 0; int khi = SEQ + 64 - s0 - 64 * idx4; khi = khi < 192 ? khi : 192;
            attn_job<2>(T, F.lds + LDS_K + 64 * idx4 * 128, F.lds + LDS_V + 64 * idx4 * 128, 6, tp, klo, khi, (klo > 0 || khi < 192), lane);
        }
#pragma unroll
        for (int pass = 0; pass < 2; ++pass) {
            __syncthreads();
            commit<6>(F, R);
            __syncthreads();
            if (pass == 0) prefetch<6>(F, R, P, h, 2, u0);
            else if (u + 1 < ue) { const int bh2 = (u + 1) >> 4; prefetch<6>(F, R, PROJ + (size_t)(bh2 / NH) * SEQ * NPROJ, bh2 % NH, 0, ((u + 1) & 15) * 256); }
            const int cl = w & 1, lo = idx4 < 2 ? idx4 : 2;
            const LAS float* tp[1] = { table_ptr(F, LDS_T1, 4 * g - i + 16 * (lo - idx4) + TPAD0) };
            int klo = -(u0 + 16 * lo); klo = klo > 0 ? klo : 0; int khi = SEQ / 4 - (u0 + 16 * lo); khi = khi < 160 ? khi : 160;
            QT (&Tp)[1] = *(QT (*)[1])(&T[pass]);
            attn_job<1>(Tp, F.lds + LDS_K + (192 * cl + 16 * lo) * 128, F.lds + LDS_V + (192 * cl + 16 * lo) * 128, 5, tp, klo, khi, (klo > 0 || khi < 160), lane);
        }
#pragma unroll
        for (int n = 0; n < 2; ++n) {
            const float l = xsum4(T[n].l); const float inv = 1.0f / l; const int tok = n == 0 ? tokA : tokB;
#pragma unroll
            for (int db = 0; db < 4; ++db) { v2u o; o.x = pk2(T[n].o[db][0] * inv, T[n].o[db][1] * inv); o.y = pk2(T[n].o[db][2] * inv, T[n].o[db][3] * inv);
                *(GAS v2u*)(A2 + (size_t)tok * MIXW + h * 64 + 16 * db + 4 * g) = o; }
            if (g == 0) { float* mlp = ML + ((size_t)tok * NH + h) * 2; mlp[0] = T[n].m; mlp[1] = l; }
        }
    }
    __syncthreads();
}
__device__ __forceinline__ void phase_class(Frame& F) {
    four_ssq(F);
    constexpr int NU = BATCH * NH * 16; const int per = (NU + F.G - 1) / F.G, ub = F.vcu * per, ue = (ub + per) < NU ? (ub + per) : NU;
    const bf16* PROJ = (const bf16*)(F.ws + WS_PROJ); const int lane = F.lane, w = F.wave, i = lane & 15, g = lane >> 4; float* SSA = (float*)(F.ws + WS_SSA);
    Pre R; int hprev = -1;
    __syncthreads();
    if (ub < ue) { const int bh = ub >> 4; prefetch<4>(F, R, PROJ + (size_t)(bh / NH) * SEQ * NPROJ, bh % NH, 3, ub & 15); }
    for (int u = ub; u < ue; ++u) {
        const int bh = u >> 4, b = bh / NH, h = bh % NH, r = u & 15;
        const bf16* P = PROJ + (size_t)b * SEQ * NPROJ; bf16* A2 = (bf16*)(F.ws + WS_A2) + (size_t)b * SEQ * MIXW; const float* ML = (const float*)(F.ws + WS_ML) + (size_t)b * SEQ * NH * 2;
        __syncthreads();
        commit<4>(F, R);
        if (h != hprev) { build_table(F, LDS_T0, 2, h); hprev = h; }
        __syncthreads();
        QT T2[2]; float mlv[2], llv[2]; v2u pvv[2][4];
#pragma unroll
        for (int n = 0; n < 2; ++n) { const int qt = n == 0 ? (w < 7 ? w : 11) : (w < 4 ? w + 7 : (w < 7 ? w + 8 : 15)); const int tok = r + 16 * (16 * qt + i);
            load_q(T2[n], P + (size_t)tok * NPROJ + h * 64, g);
            const float* mlp = ML + ((size_t)tok * NH + h) * 2; mlv[n] = mlp[0]; llv[n] = mlp[1];
#pragma unroll
            for (int db = 0; db < 4; ++db) pvv[n][db] = *(const GAS v2u*)(A2 + (size_t)tok * MIXW + h * 64 + 16 * db + 4 * g); }
        asm volatile("" ::: "memory");
        if (u + 1 < ue) { const int bh2 = (u + 1) >> 4; prefetch<4>(F, R, PROJ + (size_t)(bh2 / NH) * SEQ * NPROJ, bh2 % NH, 3, (u + 1) & 15); }
#pragma unroll
        for (int n = 0; n < 2; ++n) {
            const int qt = n == 0 ? (w < 7 ? w : 11) : (w < 4 ? w + 7 : (w < 7 ? w + 8 : 15));
            int lo = qt - 4 > 0 ? qt - 4 : 0, hi = qt + 4 < 15 ? qt + 4 : 15; if (((hi - lo + 1) & 1) != 0) { if (hi < 15) ++hi; else --lo; }
            const int tok = r + 16 * (16 * qt + i);
            QT (&T)[1] = *(QT (*)[1])(&T2[n]);
            const LAS float* tp[1] = { table_ptr(F, LDS_T0, 4 * g - i + 16 * (lo - qt) + 64 + TPAD0) };
            attn_job<1>(T, F.lds + LDS_K + 16 * lo * 128, F.lds + LDS_V + 16 * lo * 128, (hi - lo + 1) >> 1, tp, 0, 1 << 20, false, lane);
            const float l16 = xsum4(T[0].l);
            const float ml = mlv[n], ll = llv[n];
            const float mm = fmaxf(ml, T[0].m), a = __builtin_amdgcn_exp2f(ml - mm) * ll, bb = __builtin_amdgcn_exp2f(T[0].m - mm), inv = 1.0f / (a + bb * l16); float sq = 0.f;
#pragma unroll
            for (int db = 0; db < 4; ++db) { GAS v2u* op = (GAS v2u*)(A2 + (size_t)tok * MIXW + h * 64 + 16 * db + 4 * g); const v2u pv = pvv[n][db]; v2u o;
                const float f0 = (bflo(pv.x) * a + T[0].o[db][0] * bb) * inv, f1 = (bfhi(pv.x) * a + T[0].o[db][1] * bb) * inv, f2 = (bflo(pv.y) * a + T[0].o[db][2] * bb) * inv, f3 = (bfhi(pv.y) * a + T[0].o[db][3] * bb) * inv;
                sq += (f0 * f0 + f1 * f1) + (f2 * f2 + f3 * f3); o.x = pk2(f0, f1); o.y = pk2(f2, f3);
                *op = o; }
            sq = xsum4(sq);
            if (g == 0) SSA[((size_t)b * SEQ + tok) * 16 + h] = sq;
        }
    }
    __syncthreads();
}
}


namespace fou {
typedef short bf16x8 __attribute__((ext_vector_type(8)));
typedef short v4i16 __attribute__((ext_vector_type(4)));
constexpr int LX = 0, LC = LDSCTL_OFF + 8192, LS = LDSCTL_OFF + 16384;
__device__ __forceinline__ int gsw(int s2) { const int pr = (s2 >> 1) & 7; return (pr & 4) | ((pr & 1) << 1) | ((pr >> 1) & 1); }
__device__ __forceinline__ int xaddr(int pe, int s2, int chunk) { return LX + pe * 8192 + s2 * 128 + (((chunk ^ gsw(s2) ^ pe) & 7) << 4); }
__device__ __forceinline__ int maddr(int base, int k, int chunk) { return base + k * 128 + (((chunk ^ (k >> 1)) & 7) << 4); }
__device__ __forceinline__ v4i16 vtr(const LAS unsigned char* p) { return __builtin_amdgcn_ds_read_tr16_b64_v4i16((LAS v4i16*)p); }
__device__ __forceinline__ bf16x8 neg8(bf16x8 v) { v4u w = __builtin_bit_cast(v4u, v); w.x ^= 0x80008000u; w.y ^= 0x80008000u; w.z ^= 0x80008000u; w.w ^= 0x80008000u; return __builtin_bit_cast(bf16x8, w); }

__device__ __forceinline__ void fourier_unit(Frame& F, int b, int g, int ec) {
    const bf16* PROJ = (const bf16*)(F.ws + WS_PROJ); bf16* A2 = (bf16*)(F.ws + WS_A2); const float* tabMg = (const float*)(F.ws + WS_TAB + TAB_MG);
    const int lane = F.lane, w = F.wave, li = lane & 15, gq = lane >> 4, e0 = 8 * ec;
    LAS unsigned char* L = F.lds;
    __syncthreads();
    bf16x8 mb[2];
#pragma unroll
    for (int ks = 0; ks < 2; ++ks) { float v[8];
#pragma unroll
        for (int j = 0; j < 8; ++j) { const int c = 8 * gq + j + 32 * ks; const int col = li < 8 ? e0 + li : 64 + e0 + (li & 7); v[j] = tabMg[(g * 64 + c) * 128 + col]; }
        v4u o; o.x = pk2(v[0], v[1]); o.y = pk2(v[2], v[3]); o.z = pk2(v[4], v[5]); o.w = pk2(v[6], v[7]); mb[ks] = __builtin_bit_cast(bf16x8, o); }
    const bf16* ub = PROJ + (size_t)(b * SEQ) * NPROJ + 3 * AW + g * 64 + 8 * gq;
#pragma unroll 8
    for (int it = 0; it < 32; ++it) { const int tile = w + 8 * it, s2 = tile & 63, tq = tile >> 6;
        const bf16* up = ub + (size_t)(64 * (16 * tq + li) + s2) * NPROJ;
        const bf16x8 a0 = __builtin_bit_cast(bf16x8, *(const GAS v4u*)up), a1 = __builtin_bit_cast(bf16x8, *(const GAS v4u*)(up + 32));
        f32x4 d = (f32x4){0.f, 0.f, 0.f, 0.f};
        d = __builtin_amdgcn_mfma_f32_16x16x32_bf16(a0, mb[0], d, 0, 0, 0); d = __builtin_amdgcn_mfma_f32_16x16x32_bf16(a1, mb[1], d, 0, 0, 0);
        v2u o; o.x = pk2(d[0], d[1]); o.y = pk2(d[2], d[3]); *(LAS v2u*)(L + xaddr(li, s2, 2 * tq + (gq >> 1)) + (gq & 1) * 8) = o; }
    __syncthreads();
    const int e = w;
#pragma unroll 1
    for (int mt = 0; mt < 4; ++mt) { const int s2 = 16 * mt + li;
        bf16x8 yr[2], yi[2], nyr[2];
#pragma unroll
        for (int kh = 0; kh < 2; ++kh) { yr[kh] = *(const LAS bf16x8*)(L + xaddr(e, s2, gq + 4 * kh)); yi[kh] = *(const LAS bf16x8*)(L + xaddr(8 + e, s2, gq + 4 * kh)); nyr[kh] = neg8(yr[kh]); }
#pragma unroll
        for (int nt = 0; nt < 4; ++nt) { const int k = 16 * nt + li;
            const bf16x8 c0 = *(const LAS bf16x8*)(L + maddr(LC, k, gq)), c1 = *(const LAS bf16x8*)(L + maddr(LC, k, gq + 4)), s0 = *(const LAS bf16x8*)(L + maddr(LS, k, gq)), s1 = *(const LAS bf16x8*)(L + maddr(LS, k, gq + 4));
            f32x4 tr = (f32x4){0.f, 0.f, 0.f, 0.f}, ti = (f32x4){0.f, 0.f, 0.f, 0.f};
            tr = __builtin_amdgcn_mfma_f32_16x16x32_bf16(c0, yr[0], tr, 0, 0, 0); tr = __builtin_amdgcn_mfma_f32_16x16x32_bf16(c1, yr[1], tr, 0, 0, 0);
            tr = __builtin_amdgcn_mfma_f32_16x16x32_bf16(s0, yi[0], tr, 0, 0, 0); tr = __builtin_amdgcn_mfma_f32_16x16x32_bf16(s1, yi[1], tr, 0, 0, 0);
            ti = __builtin_amdgcn_mfma_f32_16x16x32_bf16(c0, yi[0], ti, 0, 0, 0); ti = __builtin_amdgcn_mfma_f32_16x16x32_bf16(c1, yi[1], ti, 0, 0, 0);
            ti = __builtin_amdgcn_mfma_f32_16x16x32_bf16(s0, nyr[0], ti, 0, 0, 0); ti = __builtin_amdgcn_mfma_f32_16x16x32_bf16(s1, nyr[1], ti, 0, 0, 0);
            float orr[4], oii[4];
#pragma unroll
            for (int r = 0; r < 4; ++r) { const int k1 = 16 * nt + 4 * gq + r; const float rev = (float)((k1 * s2) & 4095) * (1.0f / 4096.0f); const float cv = __builtin_amdgcn_cosf(rev), sv = __builtin_amdgcn_sinf(rev);
                orr[r] = tr[r] * cv + ti[r] * sv; oii[r] = ti[r] * cv - tr[r] * sv; }
            v2u o; o.x = pk2(orr[0], orr[1]); o.y = pk2(orr[2], orr[3]); *(LAS v2u*)(L + xaddr(e, s2, 2 * nt + (gq >> 1)) + (gq & 1) * 8) = o;
            o.x = pk2(oii[0], oii[1]); o.y = pk2(oii[2], oii[3]); *(LAS v2u*)(L + xaddr(8 + e, s2, 2 * nt + (gq >> 1)) + (gq & 1) * 8) = o; } }
    asm volatile("s_waitcnt lgkmcnt(0)" ::: "memory");
    bf16x8 af[4][4];
    { const int q = li >> 2, p = li & 3;
#pragma unroll
      for (int mt = 0; mt < 4; ++mt)
#pragma unroll
        for (int ks = 0; ks < 4; ++ks) { const int pe = (ks >> 1) * 8 + e, s2b = 8 * gq + 32 * (ks & 1) + q;
            const v4i16 lo = vtr(L + xaddr(pe, s2b, 2 * mt + (p >> 1)) + (p & 1) * 8), hi = vtr(L + xaddr(pe, s2b + 4, 2 * mt + (p >> 1)) + (p & 1) * 8);
            af[mt][ks] = (bf16x8){lo[0], lo[1], lo[2], lo[3], hi[0], hi[1], hi[2], hi[3]}; } }
    asm volatile("s_waitcnt lgkmcnt(0)" ::: "memory");
    __syncthreads();
    const float bias = F.f_b[g * 64 + e0 + e];
#pragma unroll 1
    for (int nt = 0; nt < 4; ++nt) { const int k2 = 16 * nt + li;
        const bf16x8 c0 = *(const LAS bf16x8*)(L + maddr(LC, k2, gq)), c1 = *(const LAS bf16x8*)(L + maddr(LC, k2, gq + 4)), s0 = *(const LAS bf16x8*)(L + maddr(LS, k2, gq)), s1 = *(const LAS bf16x8*)(L + maddr(LS, k2, gq + 4));
#pragma unroll
        for (int mt = 0; mt < 4; ++mt) { f32x4 d = (f32x4){0.f, 0.f, 0.f, 0.f};
            d = __builtin_amdgcn_mfma_f32_16x16x32_bf16(af[mt][0], c0, d, 0, 0, 0); d = __builtin_amdgcn_mfma_f32_16x16x32_bf16(af[mt][1], c1, d, 0, 0, 0);
            d = __builtin_amdgcn_mfma_f32_16x16x32_bf16(af[mt][2], s0, d, 0, 0, 0); d = __builtin_amdgcn_mfma_f32_16x16x32_bf16(af[mt][3], s1, d, 0, 0, 0);
#pragma unroll
            for (int r = 0; r < 4; ++r) { const int k1 = 16 * mt + 4 * gq + r; *(LAS bf16*)(L + LX + (k1 * 64 + k2) * 16 + e * 2) = (bf16)f2bf(d[r] * (1.0f / 512.0f) + bias); } } }
    __syncthreads();
    bf16* ob = A2 + (size_t)(b * SEQ) * MIXW + AW + g * 64 + e0;
#pragma unroll
    for (int j = 0; j < 8; ++j) { const int sl = F.tid + 512 * j, k1 = sl >> 6, k2 = sl & 63; const v4u v = *(const LAS v4u*)(L + LX + sl * 16); *(GAS v4u*)(ob + (size_t)(k1 + 64 * k2) * MIXW) = v; }
}
__device__ __forceinline__ void phase_fourier(Frame& F) {
    const float* tabTw = (const float*)(F.ws + WS_TAB + TAB_TW);
    __syncthreads();
    for (int idx = F.tid; idx < 4096; idx += NWAVES * 64) { const int k = idx >> 6, s = idx & 63, n = ((k * s) & 63) * 64;
        *(LAS bf16*)(F.lds + maddr(LC, k, s >> 3) + (s & 7) * 2) = (bf16)f2bf(tabTw[2 * n]); *(LAS bf16*)(F.lds + maddr(LS, k, s >> 3) + (s & 7) * 2) = (bf16)f2bf(tabTw[2 * n + 1]); }
    __syncthreads();
    for (int u = F.vcu; u < BATCH * NG * 8; u += F.G) fourier_unit(F, u >> 5, (u >> 3) & 3, u & 7);
    __syncthreads();
}
}

__device__ __forceinline__ void p10_final(Frame& F) {
    const bf16* X2 = (const bf16*)(F.ws + WS_XN); const float* SS2 = (const float*)(F.ws + WS_SS2);
    const int gw = F.vcu * NWAVES + F.wave, NGW = F.G * NWAVES; const int lane = F.lane;
    const GAS f32x4* gr = (const GAS f32x4*)(F.g_fin + 16 * lane); const f32x4 g0 = gr[0], g1 = gr[1], g2 = gr[2], g3 = gr[3];
    for (int m0 = gw; m0 < M; m0 += 4 * NGW) { v4u w0[4], w1[4]; float part[4];
#pragma unroll
        for (int r = 0; r < 4; ++r) { const int m = (m0 + r * NGW) < M ? (m0 + r * NGW) : 0; const GAS v4u* rp = (const GAS v4u*)(X2 + (size_t)m * D + 16 * lane); w0[r] = rp[0]; w1[r] = rp[1];
            part[r] = lane < 16 ? SS2[(size_t)m * 16 + lane] : 0.f; }
#pragma unroll
        for (int r = 0; r < 4; ++r) { const int m = m0 + r * NGW; const float rstd = 1.0f / sqrtf(wave_sum(part[r]) * (1.f / D) + EPS);
            if (m < M) { GAS f32x4* op = (GAS f32x4*)(F.out + (size_t)m * D + 16 * lane);
                op[0] = (f32x4){bflo(w0[r].x), bfhi(w0[r].x), bflo(w0[r].y), bfhi(w0[r].y)} * rstd * g0; op[1] = (f32x4){bflo(w0[r].z), bfhi(w0[r].z), bflo(w0[r].w), bfhi(w0[r].w)} * rstd * g1;
                op[2] = (f32x4){bflo(w1[r].x), bfhi(w1[r].x), bflo(w1[r].y), bfhi(w1[r].y)} * rstd * g2; op[3] = (f32x4){bflo(w1[r].z), bfhi(w1[r].z), bflo(w1[r].w), bfhi(w1[r].w)} * rstd * g3; } } }
}


__device__ __forceinline__ void p8_halo_fix(Frame& F, int pm) {
    const float* H = (const float*)(F.ws + WS_HALO); bf16* ACT = (bf16*)(F.ws + WS_GV); const int kt = pm & 15;
    for (int it = F.tid; it < 2 * (FF / 4); it += NWAVES * 64) { const int c4 = (it % (FF / 4)) * 4, side = it / (FF / 4);
        if ((side == 0 && kt == 0) || (side == 1 && kt == 15)) continue;
        const float* own = H + (size_t)(pm * 2 + side) * 3 * FF + c4; const float* nb = H + (size_t)((side == 0 ? (pm - 1) * 2 + 1 : (pm + 1) * 2)) * 3 * FF + c4;
        const f32x4 gn = *(const GAS f32x4*)nb, zp = *(const GAS f32x4*)(own + FF), vv = *(const GAS f32x4*)(own + 2 * FF), wt = *(const GAS f32x4*)(F.conv_w + (side == 0 ? 0 : 2 * FF) + c4);
        float a[4];
#pragma unroll
        for (int i = 0; i < 4; ++i) { const float z = zp[i] + wt[i] * gn[i]; a[i] = z * __builtin_amdgcn_rcpf(1.0f + __builtin_amdgcn_exp2f(-1.4426950408889634f * z)) * vv[i]; }
        const unsigned long long o = (unsigned long long)pk2(a[0], a[1]) | ((unsigned long long)pk2(a[2], a[3]) << 32);
        __hip_atomic_store((unsigned long long*)(ACT + (size_t)(pm * 256 + (side ? 255 : 0)) * FF + c4), o, __ATOMIC_RELAXED, __HIP_MEMORY_SCOPE_AGENT); }
}


__device__ __forceinline__ void p6_quant(Frame& F) {
    const bf16* X1 = (const bf16*)(F.ws + WS_XN); unsigned char* A8 = F.ws + WS_A8; float* SROW = (float*)(F.ws + WS_SS1); const unsigned* cmax = (const unsigned*)(F.ctl + CW_CMAX);
    const int gw = F.vcu * NWAVES + F.wave, NGW = F.G * NWAVES, lane = F.lane;
    {   LAS float* scr = (LAS float*)(F.lds + RING_OFF + F.wave * 16384); constexpr int I_G = (D / 64) * (FF / 32);
        for (int it = gw; it < 2 * I_G; it += NGW) { const bool isv = it >= I_G; p6_quant_item(isv ? F.w_val : F.w_gate, D, FF, F.ws + WS_WGV, isv ? 128 : 0, scr, isv ? it - I_G : it, lane, F.g_ffn, cmax); } }
    {   float* cw6 = (float*)(F.ws + WS_TAB + TAB_CW4); const int gt = F.vcu * (NWAVES * 64) + F.tid, NGT = F.G * NWAVES * 64;
        for (int i = gt; i < (FF / 128) * 768; i += NGT) { const int pn = i / 768, k = (i % 768) >> 7, c = i & 127, ch = 128 * pn + c;
            cw6[i] = k < 3 ? F.conv_w[k * FF + ch] : (k == 3 ? F.conv_b[ch] : __uint_as_float(cmax[256 * pn + (k == 5 ? 128 : 0) + c]) * (1.0f / 127.0f)); } }
    for (int m0 = gw; m0 < M; m0 += 4 * NGW) { v4u w0[4], w1[4];
#pragma unroll
        for (int r = 0; r < 4; ++r) { const int m = (m0 + r * NGW) < M ? (m0 + r * NGW) : 0; const GAS v4u* rp = (const GAS v4u*)(X1 + (size_t)m * D + 16 * lane); w0[r] = rp[0]; w1[r] = rp[1]; }
#pragma unroll
        for (int r = 0; r < 4; ++r) { const int m = m0 + r * NGW; float v[16];
            v[0] = bflo(w0[r].x); v[1] = bfhi(w0[r].x); v[2] = bflo(w0[r].y); v[3] = bfhi(w0[r].y); v[4] = bflo(w0[r].z); v[5] = bfhi(w0[r].z); v[6] = bflo(w0[r].w); v[7] = bfhi(w0[r].w);
            v[8] = bflo(w1[r].x); v[9] = bfhi(w1[r].x); v[10] = bflo(w1[r].y); v[11] = bfhi(w1[r].y); v[12] = bflo(w1[r].z); v[13] = bfhi(w1[r].z); v[14] = bflo(w1[r].w); v[15] = bfhi(w1[r].w);
            float ss = 0.f, mx = 0.f;
#pragma unroll
            for (int i = 0; i < 16; ++i) { ss += v[i] * v[i]; mx = fmaxf(mx, fabsf(v[i])); }
            ss = wave_sum(ss);
#pragma unroll
            for (int o = 1; o < 64; o <<= 1) mx = fmaxf(mx, __shfl_xor(mx, o));
            const float inv = mx > 0.f ? 127.0f / mx : 0.f; unsigned q[4];
#pragma unroll
            for (int j = 0; j < 4; ++j) { q[j] = 0;
#pragma unroll
                for (int t = 0; t < 4; ++t) q[j] |= ((unsigned)(int)__builtin_rintf(v[4 * j + t] * inv) & 255u) << (8 * t); }
            if (m < M) { *(GAS v4u*)(A8 + (size_t)m * D + 16 * lane) = (v4u){q[0], q[1], q[2], q[3]};
                if (lane == 0) SROW[m] = mx * (1.0f / 127.0f) * (1.0f / sqrtf(ss * (1.f / D) + EPS)); } } }
}

struct Args { const float* in[16]; float* out; unsigned char* ws; int ph_lo, ph_hi; };
__global__ void __launch_bounds__(NWAVES * 64, 2) hymba_fwd(Args args) {
    extern __shared__ __attribute__((aligned(16))) unsigned char lds[];
    Frame F;
    F.lds = (LAS unsigned char*)lds;
    F.MISC = (volatile LAS unsigned*)(F.lds + MISC_OFF);
    F.tid = threadIdx.x; F.lane = F.tid & 63; F.wave = __builtin_amdgcn_readfirstlane(F.tid >> 6);
    F.G = gridDim.x; { const int bx = blockIdx.x; F.vcu = (F.G % 8 == 0) ? (bx % 8) * (F.G / 8) + bx / 8 : bx; }
    F.ws = args.ws; F.ctl = (gu32*)(args.ws + WS_CTL);
    F.x = args.in[0]; F.g_mix = args.in[1]; F.w_in = args.in[2]; F.g_attn = args.in[3]; F.rel_tab = args.in[4]; F.f_w = args.in[5]; F.f_b = args.in[6]; F.g_four = args.in[7];
    F.w_out = args.in[8]; F.g_ffn = args.in[9]; F.w_gate = args.in[10]; F.w_val = args.in[11]; F.conv_w = args.in[12]; F.conv_b = args.in[13]; F.w_down = args.in[14]; F.g_fin = args.in[15];
    F.out = args.out;
    for (int u = F.tid; u < (LDS_BYTES - LDSCTL_OFF) / 4; u += NWAVES * 64) ((LAS unsigned*)(F.lds + LDSCTL_OFF))[u] = 0u;
    __syncthreads();
    XcdBarrier bar; bar.bar = (unsigned*)(F.ctl + CW_BAR); bar.x = 0; bar.st = nullptr;
    if (MK_ONE_LAUNCH) bar = xcd_barrier_post((unsigned*)(F.ctl + CW_BAR), F.MISC + 8);
#define GRID_BAR() do { if (MK_ONE_LAUNCH) xcd_barrier(bar); } while (0)
    const int lo = args.ph_lo, hi = args.ph_hi;
#define IN(k) (lo <= (k) && (k) < hi)
#define BOTH(k) (IN(k) && IN((k) + 1))
    if (IN(0)) { p0_prologue(F); if (BOTH(0)) GRID_BAR(); }
    if (IN(1)) {
        pg8::Gemm g{(const bf16*)(F.ws + WS_XN), (const bf16*)(F.ws + WS_WIN), M, NPROJ, D, D, 0}; pg8::StaticOrder S; S.init(M, NPROJ, F.G, (int)blockIdx.x);
        pg8::EpiBf16Row E{(bf16*)(F.ws + WS_PROJ), NPROJ, (const float*)(F.ws + WS_RS0)};
        pg8::gemm_phase<pg8::EpiBf16Row, pg8::StaticOrder, true, true>(F.lds + RING_OFF, g, S, E);
        if (BOTH(1)) GRID_BAR();
    }
    if (IN(2)) { att::phase_local(F); fou::phase_fourier(F); if (BOTH(2)) GRID_BAR(); }
    if (IN(3)) { att::phase_class(F); if (IN(3) && IN(5)) GRID_BAR(); }
    if (IN(5)) {
        pg8::Gemm g{(const bf16*)(F.ws + WS_A2), (const bf16*)(F.ws + WS_WOUT), M, D, MIXW, MIXW, 0}; pg8::StaticOrder S; S.init(M, D, F.G, (int)blockIdx.x);
        pg8::EpiX1N E{(const bf16*)(F.ws + WS_XN), (bf16*)(F.ws + WS_XN), D, (float*)(F.ws + WS_SS1), (const float*)(F.ws + WS_SSA), (LAS float*)(F.lds + LDSCTL_OFF + 8192)};
        pg8::gemm_phase<pg8::EpiX1N, pg8::StaticOrder, true, true>(F.lds + RING_OFF, g, S, E);
        if (IN(5) && IN(6)) GRID_BAR();
    }
    if (IN(6)) { p6_quant(F); if (IN(6) && IN(7)) GRID_BAR(); }
    if (IN(7)) {
        pg8::Gemm g{(const bf16*)(F.ws + WS_A8), (const bf16*)(F.ws + WS_WGV), M, 2 * FF, D / 2, D / 2, 0}; pg8::StaticOrder S; S.init(M, 2 * FF, F.G, (int)blockIdx.x);
        pg8::EpiConvGlu E{(bf16*)(F.ws + WS_GV), FF, (const float*)(F.ws + WS_SS1), F.conv_w, F.conv_b, (LAS float*)(F.lds + LDSCTL_OFF + 4096), M, (float*)(F.ws + WS_HALO), (const float*)(F.ws + WS_TAB + TAB_CW4)};
        pg8::gemm_phase<pg8::EpiConvGlu, pg8::StaticOrder, true, true, true>(F.lds + RING_OFF, g, S, E);
        if (IN(7) && IN(9)) GRID_BAR();
    }
    if (IN(9)) {
        pg8::Gemm g{(const bf16*)(F.ws + WS_GV), (const bf16*)(F.ws + WS_WD), M, D, FF, FF, 0}; pg8::StaticOrder S; S.init(M, D, F.G, (int)blockIdx.x);
        { pg8::Unit uu; for (int i = 0; S.next(i, uu); ++i) p8_halo_fix(F, uu.pm); }
        asm volatile("s_waitcnt vmcnt(0)" ::: "memory"); __syncthreads();
        if (F.G == 256) {
            pg8::EpiFinal E{(const bf16*)(F.ws + WS_XN), F.out, D, F.g_fin, (float*)(F.ws + WS_XBUF), (unsigned*)(F.ctl + CW_PANEL), F.lds + LDSCTL_OFF + 4096};
            pg8::gemm_phase<pg8::EpiFinal, pg8::StaticOrder, true, true>(F.lds + RING_OFF, g, S, E);
        } else {
            pg8::EpiX2 E{(bf16*)(F.ws + WS_XN), D, (float*)(F.ws + WS_SS2)};
            pg8::gemm_phase<pg8::EpiX2, pg8::StaticOrder, true, true>(F.lds + RING_OFF, g, S, E);
            if (BOTH(9)) GRID_BAR();
        }
    }
    if (IN(10) && F.G != 256) { p10_final(F); }
#undef IN
#undef BOTH
}

extern "C" void kernel_launch(void* const* d_in, const int* in_sizes, int n_in, void* d_out, int out_size, void* d_ws, size_t ws_size, hipStream_t stream) {
    static int grid = 0;
    if (grid == 0) {
        if (n_in != 16 || in_sizes[0] != M * D || out_size != M * D || ws_size < WS_END) { fprintf(stderr, "kernel_launch: shape/workspace mismatch: n_in %d in0 %d out %d ws %zu (need %zu)\n", n_in, n_in > 0 ? in_sizes[0] : -1, out_size, ws_size, (size_t)WS_END); grid = -1; return; }
        int dev = 0, cus = 0, per_cu = 0;
        if (hipGetDevice(&dev) != hipSuccess || hipDeviceGetAttribute(&cus, hipDeviceAttributeMultiprocessorCount, dev) != hipSuccess) { grid = -1; return; }
        if (hipFuncSetAttribute((const void*)hymba_fwd, hipFuncAttributeMaxDynamicSharedMemorySize, LDS_BYTES) != hipSuccess) { fprintf(stderr, "kernel_launch: hipFuncSetAttribute failed\n"); grid = -1; return; }
        if (hipOccupancyMaxActiveBlocksPerMultiprocessor(&per_cu, (const void*)hymba_fwd, NWAVES * 64, LDS_BYTES) != hipSuccess || per_cu < 1) { fprintf(stderr, "kernel_launch: occupancy query says %d blocks/CU\n", per_cu); (void)hipGetLastError(); grid = -1; return; }
        grid = cus;
    }
    if (grid < 0) return;
    (void)hipMemsetAsync((char*)d_ws + WS_CTL, 0, CTL_ZERO_BYTES, stream);
    Args a{};
    for (int i = 0; i < 16; ++i) a.in[i] = (const float*)d_in[i];
    a.out = (float*)d_out; a.ws = (unsigned char*)d_ws;
#if MK_ONE_LAUNCH
    a.ph_lo = 0; a.ph_hi = N_PHASES;
    hipLaunchKernelGGL(hymba_fwd, dim3(grid), dim3(NWAVES * 64), LDS_BYTES, stream, a);
#else
    for (int p = 0; p < N_PHASES; ++p) { a.ph_lo = p; a.ph_hi = p + 1; hipLaunchKernelGGL(hymba_fwd, dim3(grid), dim3(NWAVES * 64), LDS_BYTES, stream, a); }
#endif
}
```

```cpp
#include <hip/hip_runtime.h>
#include <cstdio>
#include <cstdint>

namespace pg8 {
#define PG8_LAS __attribute__((address_space(3)))
typedef unsigned short bf16_t;
typedef short bf16x8 __attribute__((ext_vector_type(8)));
typedef float f32x4 __attribute__((ext_vector_type(4)));
typedef unsigned u32x4 __attribute__((ext_vector_type(4)));
typedef int i32x4 __attribute__((ext_vector_type(4)));
template <bool I8> struct AccT { typedef f32x4 type; };
template <> struct AccT<true> { typedef i32x4 type; };
constexpr int BM = 256, BK = 64, HALF = 128, HTB = HALF * BK * 2, STAGE_BYTES = 8 * HTB, NXCD = 8, WGM = 8;

__host__ __device__ __forceinline__ int lds_byte(int r, int c) { const int st = (r >> 4) * 2 + (c >> 5), rr = r & 15, cc = c & 31, ob = rr * 64 + cc * 2; return st * 1024 + (ob ^ (((ob >> 9) & 1) << 5)); }
__host__ __device__ __forceinline__ void stage_rc(int b, int& R, int& C) { const int st = b / 1024, sb = b % 1024, swz = sb ^ (((sb >> 9) & 1) << 5); R = (st >> 1) * 16 + swz / 64; C = (st & 1) * 32 + (swz % 64) / 2; }
__host__ __device__ __forceinline__ int perm32(int rho) { const int n = rho >> 4, i = rho & 15; return 8 * (i >> 2) + 4 * n + (i & 3); }

struct Unit { int pm, pn; };
struct Gemm { const bf16_t* A; const bf16_t* Bt; int M, N, K, lda; int ovl; };
__host__ __device__ __forceinline__ int ovl_row_base(int pm) { const int b = pm / 17, k = pm - 17 * b; return b * 4096 + (k ? 254 * k - 1 : 0); }

struct StaticOrder {
    int nM, nN, nwg, G, c;
    __host__ __device__ void init(int M, int N, int G_, int c_) { nM = M / BM; nN = N / BM; nwg = nM * nN; G = G_; c = c_; }
    __host__ __device__ bool next(int i, Unit& u) const {
        const long L = (long)i * G + c; if (L >= nwg) return false;
        int wgid = (int)L; { const int q = nwg / NXCD, r = nwg % NXCD, xcd = wgid % NXCD, off = wgid / NXCD; wgid = (xcd < r ? xcd * (q + 1) : r * (q + 1) + (xcd - r) * q) + off; }
        const int nig = WGM * nN, gid = wgid / nig, fm = gid * WGM, gsz = (nM - fm) < WGM ? (nM - fm) : WGM;
        u.pm = fm + ((wgid % nig) % gsz); u.pn = (wgid % nig) / gsz; return true;
    }
    __device__ __forceinline__ void a_ready(const Unit&) const {}
    __device__ __forceinline__ void done(const Unit&) const {}
};

typedef float f32x2v_t __attribute__((ext_vector_type(2))); typedef __bf16 bf16x2v_t __attribute__((ext_vector_type(2)));
__device__ __forceinline__ unsigned cvt_pk_bf16(float lo, float hi) { f32x2v_t v = {lo, hi}; bf16x2v_t b = __builtin_convertvector(v, bf16x2v_t); return __builtin_bit_cast(unsigned, b); }

struct EpiBf16 {
    static constexpr bool PERM = true, AFTER_DRAIN = false, MIDK = false, PREFETCH = false;
    bf16_t* O; int ldc;
    __device__ __forceinline__ void operator()(const f32x4 (&acc)[2][2][4][2], const Unit& u, int wr, int wc, int fr, int fq) const {
        const int row0 = u.pm * BM + wr * 64 + fr; const int col0 = u.pn * BM + wc * 32 + 8 * fq;
#pragma unroll
        for (int ai = 0; ai < 2; ++ai)
#pragma unroll
            for (int m = 0; m < 4; ++m) { bf16_t* rowp = O + (size_t)(row0 + ai * HALF + m * 16) * ldc + col0;
#pragma unroll
                for (int bj = 0; bj < 2; ++bj) { const f32x4 v0 = acc[ai][bj][m][0], v1 = acc[ai][bj][m][1];
                    u32x4 w; w.x = cvt_pk_bf16(v0[0], v0[1]); w.y = cvt_pk_bf16(v0[2], v0[3]); w.z = cvt_pk_bf16(v1[0], v1[1]); w.w = cvt_pk_bf16(v1[2], v1[3]);
                    *(u32x4*)(rowp + bj * HALF) = w; } }
    }
};

struct EpiBf16Row {
    static constexpr bool PERM = true, AFTER_DRAIN = false, MIDK = false, PREFETCH = false;
    bf16_t* O; int ldc; const float* rs;
    __device__ __forceinline__ void operator()(const f32x4 (&acc)[2][2][4][2], const Unit& u, int wr, int wc, int fr, int fq) const {
        const int row0 = u.pm * BM + wr * 64 + fr; const int col0 = u.pn * BM + wc * 32 + 8 * fq;
#pragma unroll
        for (int ai = 0; ai < 2; ++ai)
#pragma unroll
            for (int m = 0; m < 4; ++m) { const int row = row0 + ai * HALF + m * 16; const float r = rs[row]; bf16_t* rowp = O + (size_t)row * ldc + col0;
#pragma unroll
                for (int bj = 0; bj < 2; ++bj) { const f32x4 v0 = acc[ai][bj][m][0] * r, v1 = acc[ai][bj][m][1] * r;
                    u32x4 w; w.x = cvt_pk_bf16(v0[0], v0[1]); w.y = cvt_pk_bf16(v0[2], v0[3]); w.z = cvt_pk_bf16(v1[0], v1[1]); w.w = cvt_pk_bf16(v1[2], v1[3]);
                    *(u32x4*)(rowp + bj * HALF) = w; } }
    }
};
struct EpiResF32 {
    static constexpr bool PERM = false, AFTER_DRAIN = false, MIDK = false, PREFETCH = false;
    const float* base; float* out; int ldc;
    __device__ __forceinline__ void operator()(const f32x4 (&acc)[2][2][4][2], const Unit& u, int wr, int wc, int fr, int fq) const {
        const int col0 = u.pn * BM + wc * 32 + 4 * fq;
#pragma unroll
        for (int ai = 0; ai < 2; ++ai)
#pragma unroll
            for (int m = 0; m < 4; ++m) { const int r = u.pm * BM + ai * HALF + wr * 64 + m * 16 + fr; const size_t off = (size_t)r * ldc + col0;
#pragma unroll
                for (int bj = 0; bj < 2; ++bj)
#pragma unroll
                    for (int n = 0; n < 2; ++n) { const f32x4 bs = *(const f32x4*)(base + off + bj * HALF + n * 16); *(f32x4*)(out + off + bj * HALF + n * 16) = bs + acc[ai][bj][m][n]; } }
    }
};


struct EpiX1 {
    static constexpr bool PERM = true, AFTER_DRAIN = false, MIDK = false, PREFETCH = false;
    const float* base; bf16_t* O; int ldc; float* ss;
    __device__ __forceinline__ void operator()(const f32x4 (&acc)[2][2][4][2], const Unit& u, int wr, int wc, int fr, int fq) const {
        const int row0 = u.pm * BM + wr * 64 + fr; const int col0 = u.pn * BM + wc * 32 + 8 * fq;
#pragma unroll
        for (int ai = 0; ai < 2; ++ai)
#pragma unroll
            for (int m = 0; m < 4; ++m) { const int row = row0 + ai * HALF + m * 16; const size_t off = (size_t)row * ldc + col0; float q = 0.f;
#pragma unroll
                for (int bj = 0; bj < 2; ++bj) { const f32x4 v0 = *(const f32x4*)(base + off + bj * HALF) + acc[ai][bj][m][0], v1 = *(const f32x4*)(base + off + bj * HALF + 4) + acc[ai][bj][m][1];
                    q += (v0[0] * v0[0] + v0[1] * v0[1]) + (v0[2] * v0[2] + v0[3] * v0[3]) + (v1[0] * v1[0] + v1[1] * v1[1]) + (v1[2] * v1[2] + v1[3] * v1[3]);
                    u32x4 w; w.x = cvt_pk_bf16(v0[0], v0[1]); w.y = cvt_pk_bf16(v0[2], v0[3]); w.z = cvt_pk_bf16(v1[0], v1[1]); w.w = cvt_pk_bf16(v1[2], v1[3]);
                    *(u32x4*)(O + off + bj * HALF) = w; }
                q += __shfl_xor(q, 16); q += __shfl_xor(q, 32);
                if (fq == 0) ss[(size_t)row * 16 + u.pn * 4 + wc] = q; }
    }
};
struct EpiX2 {
    static constexpr bool PERM = true, AFTER_DRAIN = false, MIDK = false, PREFETCH = false;
    bf16_t* X; int ldc; float* ss;
    __device__ __forceinline__ void operator()(const f32x4 (&acc)[2][2][4][2], const Unit& u, int wr, int wc, int fr, int fq) const {
        const int row0 = u.pm * BM + wr * 64 + fr; const int col0 = u.pn * BM + wc * 32 + 8 * fq;
#pragma unroll
        for (int ai = 0; ai < 2; ++ai)
#pragma unroll
            for (int m = 0; m < 4; ++m) { const int row = row0 + ai * HALF + m * 16; const size_t off = (size_t)row * ldc + col0; float q = 0.f;
#pragma unroll
                for (int bj = 0; bj < 2; ++bj) { const u32x4 xb = *(const u32x4*)(X + off + bj * HALF);
                    f32x4 v0, v1; v0[0] = __builtin_bit_cast(float, xb.x << 16); v0[1] = __builtin_bit_cast(float, xb.x & 0xffff0000u); v0[2] = __builtin_bit_cast(float, xb.y << 16); v0[3] = __builtin_bit_cast(float, xb.y & 0xffff0000u);
                    v1[0] = __builtin_bit_cast(float, xb.z << 16); v1[1] = __builtin_bit_cast(float, xb.z & 0xffff0000u); v1[2] = __builtin_bit_cast(float, xb.w << 16); v1[3] = __builtin_bit_cast(float, xb.w & 0xffff0000u);
                    v0 = v0 + acc[ai][bj][m][0]; v1 = v1 + acc[ai][bj][m][1];
                    q += (v0[0] * v0[0] + v0[1] * v0[1]) + (v0[2] * v0[2] + v0[3] * v0[3]) + (v1[0] * v1[0] + v1[1] * v1[1]) + (v1[2] * v1[2] + v1[3] * v1[3]);
                    u32x4 w; w.x = cvt_pk_bf16(v0[0], v0[1]); w.y = cvt_pk_bf16(v0[2], v0[3]); w.z = cvt_pk_bf16(v1[0], v1[1]); w.w = cvt_pk_bf16(v1[2], v1[3]);
                    *(u32x4*)(X + off + bj * HALF) = w; }
                q += __shfl_xor(q, 16); q += __shfl_xor(q, 32);
                if (fq == 0) ss[(size_t)row * 16 + u.pn * 4 + wc] = q; }
    }
};
struct EpiBf16Rs {
    static constexpr bool PERM = true, AFTER_DRAIN = false, MIDK = false, PREFETCH = false;
    bf16_t* O; int ldc; const float* ss; float inv_n, eps;
    __device__ __forceinline__ void operator()(const f32x4 (&acc)[2][2][4][2], const Unit& u, int wr, int wc, int fr, int fq) const {
        const int row0 = u.pm * BM + wr * 64 + fr; const int col0 = u.pn * BM + wc * 32 + 8 * fq;
#pragma unroll
        for (int ai = 0; ai < 2; ++ai)
#pragma unroll
            for (int m = 0; m < 4; ++m) { const int row = row0 + ai * HALF + m * 16; const f32x4* sp = (const f32x4*)(ss + (size_t)row * 16);
                const f32x4 s4 = (sp[0] + sp[1]) + (sp[2] + sp[3]); const float rs = 1.0f / sqrtf(((s4[0] + s4[1]) + (s4[2] + s4[3])) * inv_n + eps);
                bf16_t* rowp = O + (size_t)row * ldc + col0;
#pragma unroll
                for (int bj = 0; bj < 2; ++bj) { const f32x4 v0 = acc[ai][bj][m][0] * rs, v1 = acc[ai][bj][m][1] * rs;
                    u32x4 w; w.x = cvt_pk_bf16(v0[0], v0[1]); w.y = cvt_pk_bf16(v0[2], v0[3]); w.z = cvt_pk_bf16(v1[0], v1[1]); w.w = cvt_pk_bf16(v1[2], v1[3]);
                    *(u32x4*)(rowp + bj * HALF) = w; } }
    }
};


template <int CTRL> __device__ __forceinline__ float dppk(float keep, float x) { return __builtin_bit_cast(float, __builtin_amdgcn_update_dpp(__builtin_bit_cast(int, keep), __builtin_bit_cast(int, x), CTRL, 0xf, 0xf, false)); }
template <int CTRL> __device__ __forceinline__ float dppf(float x) { return __builtin_bit_cast(float, __builtin_amdgcn_mov_dpp(__builtin_bit_cast(int, x), CTRL, 0xf, 0xf, true)); }
struct EpiConvGlu {
    static constexpr bool PERM = true, AFTER_DRAIN = false, MIDK = false, PREFETCH = true;
    bf16_t* O; int ldc; const float* ss; const float* cw; const float* cb; PG8_LAS float* ex; int mrows; float* halo; const float* cw4;
    __device__ __forceinline__ void prefetch(const Unit& u, int wid, int lane) const {
        const int base = u.pm * BM; asm volatile("" : "+v"(lane));
        if (wid == 0) __builtin_amdgcn_global_load_lds((const unsigned*)(ss + base + lane * 4), (PG8_LAS unsigned*)(ex + 1024), 16, 0, 0);
        else if (wid < 4) __builtin_amdgcn_global_load_lds((const unsigned*)(cw4 + u.pn * 768 + (wid - 1) * 256 + lane * 4), (PG8_LAS unsigned*)(ex + 1024 + 4096 + (wid - 1) * 256), 16, 0, 0);
    }
    __device__ __forceinline__ void operator()(i32x4 (&iacc)[2][2][4][2], const Unit& u, int wr, int wc, int fr, int fq) const {
        f32x4 acc[2][2][4][2];
        const int kt = u.pm & 15, base = u.pm * BM, rend = 256;
        const int ch0 = u.pn * 128 + wc * 32 + 8 * fq;
        const bool top_open = kt != 0, bot_open = kt != 15;
        f32x4 w0[2], w1[2], w2[2], cbv[2];
        f32x4 sg[2], sv[2];
#pragma unroll
        for (int n = 0; n < 2; ++n) { const PG8_LAS float* wl = ex + 1024 + 4096 + wc * 32 + 8 * fq + 4 * n; w0[n] = *(const PG8_LAS f32x4*)wl; w1[n] = *(const PG8_LAS f32x4*)(wl + 128); w2[n] = *(const PG8_LAS f32x4*)(wl + 256); cbv[n] = *(const PG8_LAS f32x4*)(wl + 384); sg[n] = *(const PG8_LAS f32x4*)(wl + 512); sv[n] = *(const PG8_LAS f32x4*)(wl + 640); }
#pragma unroll
        for (int ai = 0; ai < 2; ++ai)
#pragma unroll
            for (int m = 0; m < 4; ++m) { const int r = ai * HALF + wr * 64 + m * 16 + fr; const float rs = ex[1024 + r];
#pragma unroll
                for (int n = 0; n < 2; ++n) { const i32x4 ig = iacc[ai][0][m][n], iv = iacc[ai][1][m][n];
                    acc[ai][0][m][n] = (f32x4){(float)ig[0], (float)ig[1], (float)ig[2], (float)ig[3]} * rs * sg[n]; acc[ai][1][m][n] = (f32x4){(float)iv[0], (float)iv[1], (float)iv[2], (float)iv[3]} * rs * sv[n]; } }
        const int exi = (wc * 4 + fq) * 8;
        if (fr == 0) {
#pragma unroll
            for (int ai = 0; ai < 2; ++ai) { PG8_LAS f32x4* p = (PG8_LAS f32x4*)(ex + ((ai * 2 + wr) * 2 + 0) * 128 + exi); p[0] = acc[ai][0][0][0]; p[1] = acc[ai][0][0][1]; } }
        if (fr == 15) {
#pragma unroll
            for (int ai = 0; ai < 2; ++ai) { PG8_LAS f32x4* p = (PG8_LAS f32x4*)(ex + ((ai * 2 + wr) * 2 + 1) * 128 + exi); p[0] = acc[ai][0][3][0]; p[1] = acc[ai][0][3][1]; } }
        asm volatile("s_waitcnt lgkmcnt(0)\n\ts_barrier" ::: "memory");
#pragma unroll
        for (int ai = 0; ai < 2; ++ai) {
#pragma unroll
            for (int m = 0; m < 4; ++m) { const int r = ai * HALF + wr * 64 + m * 16 + fr; u32x4 w; unsigned wv[4]; float zz[8];
                f32x4 edge[2] = {(f32x4){0.f, 0.f, 0.f, 0.f}, (f32x4){0.f, 0.f, 0.f, 0.f}};
                if (m == 0) { const bool hz = (wr == 0 && ai == 0); const int sai = wr == 1 ? ai : 0, swr = wr == 1 ? 0 : 1; const PG8_LAS f32x4* p = (const PG8_LAS f32x4*)(ex + ((sai * 2 + swr) * 2 + 1) * 128 + exi);
                    if (!hz) { edge[0] = p[0]; edge[1] = p[1]; } }
                if (m == 3) { const bool hz = (wr == 1 && ai == 1); const int sai = wr == 0 ? ai : 1, swr = wr == 0 ? 1 : 0; const PG8_LAS f32x4* p = (const PG8_LAS f32x4*)(ex + ((sai * 2 + swr) * 2 + 0) * 128 + exi);
                    if (!hz) { edge[0] = p[0]; edge[1] = p[1]; } }
#pragma unroll
                for (int n = 0; n < 2; ++n) { float a[4];
#pragma unroll
                    for (int i = 0; i < 4; ++i) { const float gc = acc[ai][0][m][n][i];
                        const float rp = m > 0 ? dppf<0x121>(acc[ai][0][m > 0 ? m - 1 : 0][n][i]) : edge[n][i];
                        const float ln = m < 3 ? dppf<0x12F>(acc[ai][0][m < 3 ? m + 1 : 3][n][i]) : edge[n][i];
                        const float gu = dppk<0x111>(rp, gc), gd = dppk<0x101>(ln, gc);
                        const float z = __builtin_fmaf(w2[n][i], gd, __builtin_fmaf(w1[n][i], gc, __builtin_fmaf(w0[n][i], gu, cbv[n][i])));
                        if ((ai == 0 && m == 0) || (ai == 1 && m == 3)) zz[4 * n + i] = z;
                        a[i] = z * __builtin_amdgcn_rcpf(1.0f + __builtin_amdgcn_exp2f(-1.4426950408889634f * z)) * acc[ai][1][m][n][i]; }
                    wv[2 * n] = cvt_pk_bf16(a[0], a[1]); wv[2 * n + 1] = cvt_pk_bf16(a[2], a[3]); }
                w.x = wv[0]; w.y = wv[1]; w.z = wv[2]; w.w = wv[3];
                bool open = false;
                if (ai == 0 && m == 0) open = (r == 0) && top_open;
                if (ai == 1 && m == 3) open = (r == 255) && bot_open;
                if (!open) *(u32x4*)(O + (size_t)(base + r) * ldc + ch0) = w;
                if ((ai == 0 && m == 0) || (ai == 1 && m == 3)) { if (open) { float* hp = halo + ((size_t)(u.pm * 2 + (ai == 0 ? 0 : 1)) * 3) * ldc + ch0;
                        *(f32x4*)hp = acc[ai][0][m][0]; *(f32x4*)(hp + 4) = acc[ai][0][m][1];
                        *(f32x4*)(hp + ldc) = (f32x4){zz[0], zz[1], zz[2], zz[3]}; *(f32x4*)(hp + ldc + 4) = (f32x4){zz[4], zz[5], zz[6], zz[7]};
                        *(f32x4*)(hp + 2 * ldc) = acc[ai][1][m][0]; *(f32x4*)(hp + 2 * ldc + 4) = acc[ai][1][m][1]; } }
                asm volatile("" ::: "memory"); } }
        asm volatile("s_waitcnt lgkmcnt(0)\n\ts_barrier" ::: "memory");
    }
};


struct EpiX1N {
    static constexpr bool PERM = true, AFTER_DRAIN = false, MIDK = true, PREFETCH = true; static constexpr int MIDK_T = 12;
    const bf16_t* base; bf16_t* O; int ldc; float* ss; const float* sa; PG8_LAS float* st;
    __device__ __forceinline__ void prefetch(const Unit& u, int wid, int lane) const {
        asm volatile("" : "+v"(lane));
#pragma unroll
        for (int i = 0; i < 2; ++i) { const int piece = wid * 2 + i;
            __builtin_amdgcn_global_load_lds((const unsigned*)(sa + (size_t)u.pm * BM * 16 + piece * 256 + lane * 4), (PG8_LAS unsigned*)(st + piece * 256), 16, 0, 0); }
    }
    __device__ __forceinline__ void row_stats(int rl, int fq, float& ra, float& rf) const {
        const f32x4 s4 = *(const PG8_LAS f32x4*)(st + rl * 16 + 4 * fq); float a = fq < 3 ? (s4[0] + s4[1]) + (s4[2] + s4[3]) : 0.f, f = fq == 3 ? s4[0] : 0.f;
        a += __shfl_xor(a, 16); a += __shfl_xor(a, 32); f += __shfl_xor(f, 16); f += __shfl_xor(f, 32);
        ra = __builtin_amdgcn_rsqf(a * (1.0f / 768.0f) + 1e-6f); rf = __builtin_amdgcn_rsqf(f * (1.0f / 256.0f) + 1e-6f);
    }
    __device__ __forceinline__ void midk(f32x4 (&acc)[2][2][4][2], const Unit& u, int wr, int fr, int fq) const {
#pragma unroll
        for (int ai = 0; ai < 2; ++ai)
#pragma unroll
            for (int m = 0; m < 4; ++m) { float ra, rf; row_stats(ai * HALF + wr * 64 + m * 16 + fr, fq, ra, rf); const float ratio = ra * __builtin_amdgcn_rcpf(rf);
#pragma unroll
                for (int bj = 0; bj < 2; ++bj) { acc[ai][bj][m][0] = acc[ai][bj][m][0] * ratio; acc[ai][bj][m][1] = acc[ai][bj][m][1] * ratio; } }
    }
    __device__ __forceinline__ void operator()(const f32x4 (&acc)[2][2][4][2], const Unit& u, int wr, int wc, int fr, int fq) const {
        const int row0 = u.pm * BM + wr * 64 + fr; const int col0 = u.pn * BM + wc * 32 + 8 * fq;
#pragma unroll
        for (int ai = 0; ai < 2; ++ai)
#pragma unroll
            for (int m = 0; m < 4; ++m) { const int row = row0 + ai * HALF + m * 16; const size_t off = (size_t)row * ldc + col0; float ra, rf; row_stats(row - u.pm * BM, fq, ra, rf);
#pragma unroll
                for (int bj = 0; bj < 2; ++bj) { const u32x4 xb = *(const u32x4*)(base + off + bj * HALF); f32x4 v0, v1;
                    v0[0] = __builtin_bit_cast(float, xb.x << 16); v0[1] = __builtin_bit_cast(float, xb.x & 0xffff0000u); v0[2] = __builtin_bit_cast(float, xb.y << 16); v0[3] = __builtin_bit_cast(float, xb.y & 0xffff0000u);
                    v1[0] = __builtin_bit_cast(float, xb.z << 16); v1[1] = __builtin_bit_cast(float, xb.z & 0xffff0000u); v1[2] = __builtin_bit_cast(float, xb.w << 16); v1[3] = __builtin_bit_cast(float, xb.w & 0xffff0000u);
                    v0 = v0 + acc[ai][bj][m][0] * rf; v1 = v1 + acc[ai][bj][m][1] * rf;
                    u32x4 w; w.x = cvt_pk_bf16(v0[0], v0[1]); w.y = cvt_pk_bf16(v0[2], v0[3]); w.z = cvt_pk_bf16(v1[0], v1[1]); w.w = cvt_pk_bf16(v1[2], v1[3]);
                    *(u32x4*)(O + off + bj * HALF) = w; }
                }
        asm volatile("s_waitcnt lgkmcnt(0)\n\ts_barrier" ::: "memory");
    }
};


struct EpiFinal {
    static constexpr bool PERM = true, AFTER_DRAIN = false, MIDK = false, PREFETCH = false;
    const bf16_t* X1; float* out; int ldc; const float* gain; float* xbuf; unsigned* cnt; PG8_LAS unsigned char* lx;
    __device__ __forceinline__ void operator()(f32x4 (&acc)[2][2][4][2], const Unit& u, int wr, int wc, int fr, int fq) const {
        PG8_LAS float* P = (PG8_LAS float*)lx; PG8_LAS float* S = (PG8_LAS float*)(lx + 4096);
        int tid = (wr * 4 + wc) * 64 + fq * 16 + fr; asm volatile("" : "+v"(tid)); const int col0 = u.pn * BM + wc * 32 + 8 * fq;
#pragma unroll
        for (int ai = 0; ai < 2; ++ai)
#pragma unroll
            for (int m = 0; m < 4; ++m) { const int rl = ai * HALF + wr * 64 + m * 16 + fr; const size_t off = (size_t)(u.pm * BM + rl) * ldc + col0; float q = 0.f;
#pragma unroll
                for (int bj = 0; bj < 2; ++bj) { const u32x4 xb = *(const u32x4*)(X1 + off + bj * HALF); f32x4 v0, v1;
                    v0[0] = __builtin_bit_cast(float, xb.x << 16); v0[1] = __builtin_bit_cast(float, xb.x & 0xffff0000u); v0[2] = __builtin_bit_cast(float, xb.y << 16); v0[3] = __builtin_bit_cast(float, xb.y & 0xffff0000u);
                    v1[0] = __builtin_bit_cast(float, xb.z << 16); v1[1] = __builtin_bit_cast(float, xb.z & 0xffff0000u); v1[2] = __builtin_bit_cast(float, xb.w << 16); v1[3] = __builtin_bit_cast(float, xb.w & 0xffff0000u);
                    v0 = v0 + acc[ai][bj][m][0]; v1 = v1 + acc[ai][bj][m][1]; acc[ai][bj][m][0] = v0; acc[ai][bj][m][1] = v1;
                    q += ((v0[0] * v0[0] + v0[1] * v0[1]) + (v0[2] * v0[2] + v0[3] * v0[3])) + ((v1[0] * v1[0] + v1[1] * v1[1]) + (v1[2] * v1[2] + v1[3] * v1[3])); }
                q += __shfl_xor(q, 16); q += __shfl_xor(q, 32);
                if (fq == 0) P[rl * 4 + wc] = q; }
        asm volatile("s_waitcnt lgkmcnt(0)\n\ts_barrier" ::: "memory");
        if (tid < 256) { const float s = (P[tid * 4] + P[tid * 4 + 1]) + (P[tid * 4 + 2] + P[tid * 4 + 3]);
            __hip_atomic_store(xbuf + ((size_t)(u.pm * BM + tid) * 4 + u.pn), s, __ATOMIC_RELAXED, __HIP_MEMORY_SCOPE_AGENT);
            asm volatile("s_waitcnt vmcnt(0)" ::: "memory");
            if ((tid & 63) == 0) __hip_atomic_fetch_add(cnt + 64 * u.pm, 1u, __ATOMIC_RELAXED, __HIP_MEMORY_SCOPE_AGENT); }
        if (tid < 64) { unsigned spins = 0;
            while ((unsigned)__builtin_amdgcn_readfirstlane(__hip_atomic_load(cnt + 64 * u.pm, __ATOMIC_RELAXED, __HIP_MEMORY_SCOPE_AGENT)) < 16u) { __builtin_amdgcn_s_sleep(2); if (++spins > 400000u) break; }
            __builtin_amdgcn_fence(__ATOMIC_ACQUIRE, "agent"); }
        asm volatile("s_waitcnt vmcnt(0) lgkmcnt(0)\n\ts_barrier" ::: "memory");
        if (tid < 256) { const float* xp = xbuf + (size_t)(u.pm * BM + tid) * 4; float t = 0.f;
#pragma unroll
            for (int k = 0; k < 4; ++k) t += __hip_atomic_load(xp + k, __ATOMIC_RELAXED, __HIP_MEMORY_SCOPE_AGENT);
            S[tid] = 1.0f / sqrtf(t * (1.0f / 1024.0f) + 1e-6f); }
        asm volatile("s_waitcnt vmcnt(0) lgkmcnt(0)\n\ts_barrier" ::: "memory");
        f32x4 gv[2][2];
#pragma unroll
        for (int bj = 0; bj < 2; ++bj)
#pragma unroll
            for (int n = 0; n < 2; ++n) gv[bj][n] = *(const f32x4*)(gain + col0 + bj * HALF + n * 4);
#pragma unroll
        for (int ai = 0; ai < 2; ++ai)
#pragma unroll
            for (int m = 0; m < 4; ++m) { const int rl = ai * HALF + wr * 64 + m * 16 + fr; const float rs = S[rl]; const size_t off = (size_t)(u.pm * BM + rl) * ldc + col0;
#pragma unroll
                for (int bj = 0; bj < 2; ++bj)
#pragma unroll
                    for (int n = 0; n < 2; ++n) *(f32x4*)(out + off + bj * HALF + n * 4) = acc[ai][bj][m][n] * rs * gv[bj][n]; }
    }
};

template <bool I8> __device__ __forceinline__ typename AccT<I8>::type mma16(bf16x8 a, bf16x8 b, typename AccT<I8>::type c) {
    if constexpr (I8) return __builtin_amdgcn_mfma_i32_16x16x64_i8(__builtin_bit_cast(i32x4, a), __builtin_bit_cast(i32x4, b), c, 0, 0, 0);
    else return __builtin_amdgcn_mfma_f32_16x16x32_bf16(a, b, c, 0, 0, 0);
}
template <class Epi, class Sched, bool ALIGN_EPI = false, bool SP2 = false, bool I8 = false>
__device__ __forceinline__ void gemm_phase(PG8_LAS unsigned char* lds, const Gemm g, const Sched& S, const Epi& E) {
    int tid = threadIdx.x; asm volatile("" : "+v"(tid));
    const int wid = __builtin_amdgcn_readfirstlane(tid >> 6), lane = tid & 63, wr = wid >> 2, wc = wid & 3, fr = lane & 15, fq = lane >> 4;
    const int K = g.K, nt = K / BK, lda = g.lda;
    unsigned voffA[2], voffB[2];
#pragma unroll
    for (int i = 0; i < 2; ++i) { int R, C; stage_rc(tid * 16 + i * 8192, R, C); const int Rb = Epi::PERM ? ((R & ~31) + perm32(R & 31)) : R;
        voffA[i] = (unsigned)(R * lda + C) * 2u; voffB[i] = (unsigned)(Rb * K + C) * 2u; }
    const size_t kstep = (size_t)(BK * 2);
    const size_t hstepA = (size_t)HALF * lda * 2, hstepB = (size_t)HALF * K * 2;
    const size_t tstepA = 2 * hstepA, tstepB = 2 * hstepB;
    const unsigned ldsw = (unsigned)wid * 1024u;
    const int aoff = lds_byte(wr * 64 + fr, fq * 8), boff = lds_byte(wc * 32 + fr, fq * 8);
#define PG8_SA(b, h) (((b) * 2 + (h)) * HTB)
#define PG8_SB(b, h) ((4 + (b) * 2 + (h)) * HTB)
#define PG8_STAGE(bufoff, gbase, voff) do { _Pragma("unroll") for (int _i = 0; _i < 2; ++_i) \
        __builtin_amdgcn_global_load_lds((const unsigned*)((const char*)(gbase) + (voff)[_i]), (PG8_LAS unsigned*)(lds + (bufoff) + ldsw + _i * 8192), 16, 0, 0); } while (0)
#define PG8_LDA(dst, b, h) do { _Pragma("unroll") for (int m = 0; m < 4; ++m) _Pragma("unroll") for (int k = 0; k < 2; ++k) dst[m][k] = *(const PG8_LAS bf16x8*)(lds + PG8_SA(b, h) + aoff + m * 2048 + k * 1024); } while (0)
#define PG8_LDB(dst, b, h) do { _Pragma("unroll") for (int n = 0; n < 2; ++n) _Pragma("unroll") for (int k = 0; k < 2; ++k) dst[n][k] = *(const PG8_LAS bf16x8*)(lds + PG8_SB(b, h) + boff + n * 2048 + k * 1024); } while (0)
#define PG8_MMA(ai, bj, At, Bt) do { __builtin_amdgcn_s_setprio(1); _Pragma("unroll") for (int m = 0; m < 4; ++m) _Pragma("unroll") for (int n = 0; n < 2; ++n) _Pragma("unroll") for (int k = 0; k < 2; ++k) \
        acc[ai][bj][m][n] = mma16<I8>(Bt[n][k], At[m][k], acc[ai][bj][m][n]); __builtin_amdgcn_s_setprio(0); } while (0)
#define PG8_WAIT_V(n) asm volatile("s_waitcnt vmcnt(" #n ")" ::: "memory")
#define PG8_WAIT_L(n) asm volatile("s_waitcnt lgkmcnt(" #n ")" ::: "memory")
#define PG8_BAR __builtin_amdgcn_s_barrier()
#define PG8_SCHED __builtin_amdgcn_sched_barrier(0)
    Unit cur, nxt; int ui = 0;
    if (!S.next(0, cur)) return;
    typedef typename AccT<I8>::type acc_t; acc_t acc[2][2][4][2];
#pragma unroll
    for (int a = 0; a < 2; ++a)
#pragma unroll
        for (int b = 0; b < 2; ++b)
#pragma unroll
            for (int m = 0; m < 4; ++m)
#pragma unroll
                for (int n = 0; n < 2; ++n) acc[a][b][m][n] = (acc_t){0, 0, 0, 0};
    bf16x8 At[4][2], B0[2][2], B1[2][2];
    const char* cA = (const char*)g.A + (g.ovl ? (size_t)ovl_row_base(cur.pm) * lda * 2 : (size_t)cur.pm * tstepA); const char* cB = (const char*)g.Bt + (size_t)cur.pn * tstepB;
    S.a_ready(cur);
    if constexpr (Epi::PREFETCH) E.prefetch(cur, wid, lane);
    if constexpr (SP2) {
        PG8_STAGE(PG8_SB(0, 0), cB, voffB); PG8_STAGE(PG8_SB(0, 1), cB + hstepB, voffB); PG8_STAGE(PG8_SA(0, 0), cA, voffA); PG8_STAGE(PG8_SA(0, 1), cA + hstepA, voffA);
        if (wr == 1) PG8_BAR;
        PG8_WAIT_V(2); PG8_BAR;
        PG8_STAGE(PG8_SB(1, 0), cB + kstep, voffB); PG8_STAGE(PG8_SA(1, 0), cA + kstep, voffA); PG8_STAGE(PG8_SB(1, 1), cB + hstepB + kstep, voffB);
        PG8_WAIT_V(6); PG8_BAR;
    } else {
        PG8_STAGE(PG8_SB(0, 0), cB, voffB); PG8_STAGE(PG8_SA(0, 0), cA, voffA); PG8_STAGE(PG8_SB(0, 1), cB + hstepB, voffB); PG8_STAGE(PG8_SA(0, 1), cA + hstepA, voffA);
        if (wr == 1) PG8_BAR;
        PG8_WAIT_V(4); PG8_BAR;
        PG8_STAGE(PG8_SB(1, 0), cB + kstep, voffB); PG8_STAGE(PG8_SA(1, 0), cA + kstep, voffA); PG8_STAGE(PG8_SB(1, 1), cB + hstepB + kstep, voffB);
        PG8_WAIT_V(6); PG8_BAR;
    }
    for (;;) {
        const bool has_next = S.next(ui + 1, nxt);
        const char* nA = has_next ? (const char*)g.A + (g.ovl ? (size_t)ovl_row_base(nxt.pm) * lda * 2 : (size_t)nxt.pm * tstepA) : cA; const char* nB = has_next ? (const char*)g.Bt + (size_t)nxt.pn * tstepB : cB;
        for (int t = 0; t < nt; t += 2) {
            const bool last = (t == nt - 2);
            const char* a1 = cA + (size_t)(t + 1) * kstep;
            const char* a2 = last ? nA : cA + (size_t)(t + 2) * kstep; const char* b2 = last ? nB : cB + (size_t)(t + 2) * kstep;
            const char* a3 = a2 + kstep; const char* b3 = b2 + kstep;
            if (last && has_next) S.a_ready(nxt);
            if constexpr (Epi::MIDK) { if (t == Epi::MIDK_T) E.midk(acc, cur, wr, fr, fq); }
            if constexpr (SP2) {
            PG8_LDB(B0, 0, 0); PG8_LDB(B1, 0, 1); PG8_SCHED; PG8_LDA(At, 0, 0); PG8_STAGE(PG8_SA(1, 1), a1 + hstepA, voffA);
            PG8_WAIT_V(8); PG8_WAIT_L(0); PG8_BAR; PG8_MMA(0, 0, At, B0); PG8_MMA(0, 1, At, B1); PG8_BAR; PG8_SCHED;
            PG8_LDA(At, 0, 1); PG8_STAGE(PG8_SB(0, 0), b2, voffB); PG8_STAGE(PG8_SB(0, 1), b2 + hstepB, voffB); PG8_STAGE(PG8_SA(0, 0), a2, voffA);
            PG8_WAIT_V(8); PG8_WAIT_L(0); PG8_BAR; PG8_MMA(1, 0, At, B0); PG8_MMA(1, 1, At, B1); PG8_BAR; PG8_SCHED;
            PG8_LDB(B0, 1, 0); PG8_LDB(B1, 1, 1); PG8_SCHED; PG8_LDA(At, 1, 0); PG8_STAGE(PG8_SA(0, 1), a2 + hstepA, voffA);
            PG8_WAIT_V(8); PG8_WAIT_L(0); PG8_BAR; PG8_MMA(0, 0, At, B0); PG8_MMA(0, 1, At, B1); PG8_BAR; PG8_SCHED;
            PG8_LDA(At, 1, 1); PG8_STAGE(PG8_SB(1, 0), b3, voffB); PG8_STAGE(PG8_SB(1, 1), b3 + hstepB, voffB); PG8_STAGE(PG8_SA(1, 0), a3, voffA);
            PG8_WAIT_V(8); PG8_WAIT_L(0); PG8_BAR; PG8_MMA(1, 0, At, B0); PG8_MMA(1, 1, At, B1); PG8_BAR; PG8_SCHED;
            } else {
            PG8_LDB(B0, 0, 0); PG8_SCHED; PG8_LDA(At, 0, 0); PG8_STAGE(PG8_SA(1, 1), a1 + hstepA, voffA);
            PG8_WAIT_L(8); PG8_BAR; PG8_WAIT_L(0); PG8_MMA(0, 0, At, B0); PG8_BAR; PG8_SCHED;
            PG8_LDB(B1, 0, 1); PG8_STAGE(PG8_SB(0, 0), b2, voffB);
            PG8_BAR; PG8_WAIT_L(0); PG8_MMA(0, 1, At, B1); PG8_BAR;
            PG8_LDA(At, 0, 1); PG8_STAGE(PG8_SA(0, 0), a2, voffA);
            PG8_BAR; PG8_WAIT_L(0); PG8_MMA(1, 0, At, B0); PG8_BAR; PG8_SCHED;
            PG8_STAGE(PG8_SB(0, 1), b2 + hstepB, voffB);
            PG8_WAIT_V(6); PG8_BAR; PG8_MMA(1, 1, At, B1); PG8_BAR;
            PG8_LDB(B0, 1, 0); PG8_SCHED; PG8_LDA(At, 1, 0); PG8_STAGE(PG8_SA(0, 1), a2 + hstepA, voffA);
            PG8_WAIT_L(8); PG8_BAR; PG8_WAIT_L(0); PG8_MMA(0, 0, At, B0); PG8_BAR; PG8_SCHED;
            PG8_LDB(B1, 1, 1); PG8_STAGE(PG8_SB(1, 0), b3, voffB);
            PG8_BAR; PG8_WAIT_L(0); PG8_MMA(0, 1, At, B1); PG8_BAR;
            PG8_LDA(At, 1, 1); PG8_STAGE(PG8_SA(1, 0), a3, voffA);
            PG8_BAR; PG8_WAIT_L(0); PG8_MMA(1, 0, At, B0); PG8_BAR; PG8_SCHED;
            PG8_STAGE(PG8_SB(1, 1), b3 + hstepB, voffB);
            PG8_WAIT_V(6); PG8_BAR; PG8_MMA(1, 1, At, B1); PG8_BAR;
            }
        }
        if constexpr (ALIGN_EPI) { if (wr == 0) PG8_BAR; }
        if constexpr (!Epi::AFTER_DRAIN) { E(acc, cur, wr, wc, fr, fq); S.done(cur); }
        if constexpr (Epi::PREFETCH) { if (has_next) E.prefetch(nxt, wid, lane); }
        if (!has_next) break;
#pragma unroll
        for (int a = 0; a < 2; ++a)
#pragma unroll
            for (int b = 0; b < 2; ++b)
#pragma unroll
                for (int m = 0; m < 4; ++m)
#pragma unroll
                    for (int n = 0; n < 2; ++n) acc[a][b][m][n] = (acc_t){0, 0, 0, 0};
        cur = nxt; cA = nA; cB = nB; ++ui;
        if constexpr (ALIGN_EPI) { if (wr == 1) PG8_BAR; }
    }
    PG8_WAIT_V(0);
    if constexpr (!ALIGN_EPI) { if (wr == 0) PG8_BAR; }
    PG8_BAR;
#undef PG8_SA
#undef PG8_SB
#undef PG8_STAGE
#undef PG8_LDA
#undef PG8_LDB
#undef PG8_MMA
#undef PG8_WAIT_V
#undef PG8_WAIT_L
#undef PG8_BAR
#undef PG8_SCHED
}
}

constexpr int NWAVES = 8;
#ifndef MK_ONE_LAUNCH
#define MK_ONE_LAUNCH 1
#endif
constexpr int N_PHASES = 11;

constexpr int BATCH = 8, SEQ = 4096, D = 1024, NH = 12, HD = 64, AW = 768, NG = 4, GD = 64, FW = 256, MIXW = 1024, NPROJ = 2560, FF = 2816;
constexpr int M = BATCH * SEQ;
constexpr float EPS = 1e-6f;

constexpr size_t MiB = 1u << 20;
constexpr size_t WS_CTL = 0, CTL_ZERO_BYTES = 96 * 1024;
constexpr size_t WS_TAB = 1 * MiB;
constexpr size_t TAB_BIAS = 0;
constexpr size_t TAB_MG = 32 * 1024;
constexpr size_t TAB_TW = 192 * 1024;
constexpr size_t TAB_CW4 = 256 * 1024;
constexpr size_t WS_WIN = 2 * MiB;
constexpr size_t WS_WOUT = 7 * MiB;
constexpr size_t WS_WGV = 9 * MiB;
constexpr size_t WS_WD = 20 * MiB;
constexpr size_t WS_XN = 26 * MiB;
constexpr size_t WS_PROJ = 90 * MiB;
constexpr size_t WS_A2 = 250 * MiB;
constexpr size_t WS_PQ = 314 * MiB;
constexpr size_t WS_ML = 380 * MiB;
constexpr size_t WS_A8 = 314 * MiB;
constexpr size_t WS_HALO = 400 * MiB;
constexpr size_t WS_RS0 = 441 * MiB;
constexpr size_t WS_XBUF = 440 * MiB;
constexpr size_t WS_SSA = 446 * MiB;
constexpr size_t WS_SS1 = 442 * MiB;
constexpr size_t WS_SS2 = 444 * MiB;
constexpr size_t WS_GV = 90 * MiB;
constexpr size_t WS_END = 448 * MiB;
constexpr int CW_BAR = 1024, CW_PANEL = 8192, CW_CMAX = 16384;

constexpr int RING_OFF = 0, RING_BYTES = 131072;
constexpr int LDSCTL_OFF = RING_BYTES, MISC_OFF = LDSCTL_OFF + 320;
constexpr int LDS_BYTES = 163840;

#define GAS __attribute__((address_space(1)))
#define LAS __attribute__((address_space(3)))
typedef unsigned short bf16;
typedef unsigned v4u __attribute__((ext_vector_type(4)));
typedef unsigned v2u __attribute__((ext_vector_type(2)));
typedef float f32x4 __attribute__((ext_vector_type(4)));
typedef GAS unsigned gu32;
#define RLX_AGENT __ATOMIC_RELAXED, __HIP_MEMORY_SCOPE_AGENT
#define LDS_WAIT() asm volatile("s_waitcnt lgkmcnt(0)" ::: "memory")
#define VM_WAIT() asm volatile("s_waitcnt vmcnt(0)" ::: "memory")
__device__ __forceinline__ unsigned f2bf(float f) { unsigned u = __builtin_bit_cast(unsigned, f); return (u + 0x7fffu + ((u >> 16) & 1u)) >> 16; }
__device__ __forceinline__ unsigned pk2(float lo, float hi) { typedef float f2_t __attribute__((ext_vector_type(2))); typedef __bf16 b2_t __attribute__((ext_vector_type(2))); f2_t v = {lo, hi}; b2_t b = __builtin_convertvector(v, b2_t); return __builtin_bit_cast(unsigned, b); }
__device__ __forceinline__ float bflo(unsigned w) { return __builtin_bit_cast(float, w << 16); }
__device__ __forceinline__ float bfhi(unsigned w) { return __builtin_bit_cast(float, w & 0xffff0000u); }
__device__ __forceinline__ float bf2f(bf16 h) { return __builtin_bit_cast(float, (unsigned)h << 16); }

#define XB_TMO      128
#define XB_XCNT(j)  (256  + 64 * (j))
#define XB_XSUB(j)  (1280 + 64 * (j))
#define XB_XGEN(j)  (2304 + 64 * (j))
#define XB_TOP      3328
#define XB_TOPGEN   3392
#define XCD_BAR_WORDS 3456
#define XB_SPIN_CAP (1u << 18)
__device__ __forceinline__ unsigned xb_ld(unsigned* p)              { return __hip_atomic_load(p, __ATOMIC_RELAXED, __HIP_MEMORY_SCOPE_AGENT); }
__device__ __forceinline__ unsigned xb_add(unsigned* p, unsigned v) { return __hip_atomic_fetch_add(p, v, __ATOMIC_RELAXED, __HIP_MEMORY_SCOPE_AGENT); }
__device__ __forceinline__ unsigned xb_xcc_id() { return (unsigned)__builtin_amdgcn_s_getreg((3 << 11) | 20) & 0xFu; }
#define XB_SPIN(cond, bar) do { unsigned _sp = 0; while (cond) { __builtin_amdgcn_s_sleep(1); \
    if ((++_sp & 255u) == 0u) { if (xb_ld(&(bar)[XB_TMO])) break; if (_sp > XB_SPIN_CAP) { atomicAdd(&(bar)[XB_TMO], 1u); break; } } } } while (0)
struct XcdBarrier { unsigned* bar; unsigned x; volatile LAS unsigned* st; };
__device__ __forceinline__ XcdBarrier xcd_barrier_post(unsigned* bar, volatile LAS unsigned* st) {
    XcdBarrier b; b.bar = bar; b.x = xb_xcc_id(); b.st = st;
    if (threadIdx.x == 0) (void)xb_add(&bar[XB_XCNT(b.x)], 1u);
    return b;
}
__device__ __forceinline__ void xcd_barrier_complete(unsigned* bar, unsigned x, unsigned& nloc, unsigned& nx) {
    const unsigned G = gridDim.x * gridDim.y * gridDim.z;
    unsigned sum, cnt, mine, sp = 0u;
    for (;;) {
        sum = 0u; cnt = 0u; mine = 0u;
#pragma unroll
        for (unsigned j = 0; j < 16; ++j) { const unsigned c = xb_ld(&bar[XB_XCNT(j)]); sum += c; cnt += (c > 0u) ? 1u : 0u; mine = (j == x) ? c : mine; }
        if (sum == G) break;
        __builtin_amdgcn_s_sleep(1);
        if ((++sp & 255u) == 0u) { if (xb_ld(&bar[XB_TMO])) break; if (sp > XB_SPIN_CAP) { atomicAdd(&bar[XB_TMO], 1u); break; } }
    }
    nloc = mine > 0u ? mine : 1u; nx = cnt > 0u ? cnt : 1u;
}
__device__ __forceinline__ void xcd_barrier(const XcdBarrier& b) {
    asm volatile("s_waitcnt vmcnt(0)" ::: "memory");
    __syncthreads();
    if (threadIdx.x == 0) {
        unsigned* bar = b.bar;
        __builtin_amdgcn_s_waitcnt(0);
        unsigned nloc = b.st[0], nx = b.st[1];
        if (nloc == 0u) { xcd_barrier_complete(bar, b.x, nloc, nx); b.st[0] = nloc; b.st[1] = nx; }
        const unsigned old = xb_add(&bar[XB_XSUB(b.x)], 1u);
        const unsigned gen = old / nloc;
        if (old + 1u == (gen + 1u) * nloc) {
            __builtin_amdgcn_fence(__ATOMIC_RELEASE, "agent");
            asm volatile("s_waitcnt vmcnt(0)" ::: "memory");
            const unsigned og = xb_add(&bar[XB_TOP], 1u);
            const unsigned tg = og / nx;
            if (og + 1u == (tg + 1u) * nx) xb_add(&bar[XB_TOPGEN], 1u);
            else XB_SPIN(xb_ld(&bar[XB_TOPGEN]) == tg, bar);
            __builtin_amdgcn_fence(__ATOMIC_ACQUIRE, "agent");
            xb_add(&bar[XB_XGEN(b.x)], 1u);
            asm volatile("s_waitcnt vmcnt(0)" ::: "memory");
        } else {
            XB_SPIN(xb_ld(&bar[XB_XGEN(b.x)]) == gen, bar);
            __builtin_amdgcn_fence(__ATOMIC_ACQUIRE, "agent");
            asm volatile("s_waitcnt vmcnt(0)" ::: "memory");
        }
    }
    __syncthreads();
}

struct Frame {
    LAS unsigned char* lds;
    volatile LAS unsigned* MISC;
    gu32* ctl;
    int tid, lane, wave;
    int vcu, G;
    const float *x, *g_mix, *w_in, *g_attn, *rel_tab, *f_w, *f_b, *g_four, *w_out, *g_ffn, *w_gate, *w_val, *conv_w, *conv_b, *w_down, *g_fin;
    float* out;
    unsigned char* ws;
};

__device__ __forceinline__ float wave_sum(float v) {
#pragma unroll
    for (int o = 1; o < 64; o <<= 1) v += __shfl_xor(v, o);
    return v;
}
__device__ __forceinline__ void p0_transpose_item(const float* W, int K, int N, bf16* WT, int row_off, LAS float* scr, int item, int lane, const float* gain = nullptr, bool il = false) {
    const int nblk = N / 32, kb = item / nblk, nb = item % nblk, k0 = 64 * kb, n0 = 32 * nb; if (il) row_off += 128 * (n0 >> 7);
    {   f32x4 v[8]; const int c4 = 4 * (lane & 7);
#pragma unroll
        for (int i = 0; i < 8; ++i) v[i] = *(const GAS f32x4*)(W + (size_t)(k0 + (lane >> 3) + 8 * i) * N + n0 + c4);
#pragma unroll
        for (int i = 0; i < 8; ++i) { const int kk = (lane >> 3) + 8 * i; const float gsc = gain ? gain[k0 + kk] : 1.0f; LAS float* sp = scr + kk * 33 + c4;
            sp[0] = v[i].x * gsc; sp[1] = v[i].y * gsc; sp[2] = v[i].z * gsc; sp[3] = v[i].w * gsc; } }
    LDS_WAIT(); asm volatile("" ::: "memory");
    const int c = lane & 7;
#pragma unroll
    for (int j = 0; j < 4; ++j) { const int n = (lane >> 3) + 8 * j; const LAS float* s = scr + (8 * c) * 33 + n;
        v4u o; o.x = pk2(s[0 * 33], s[1 * 33]); o.y = pk2(s[2 * 33], s[3 * 33]); o.z = pk2(s[4 * 33], s[5 * 33]); o.w = pk2(s[6 * 33], s[7 * 33]);
        *(GAS v4u*)(WT + (size_t)(row_off + n0 + n) * K + k0 + 8 * c) = o; }
    LDS_WAIT(); asm volatile("" ::: "memory");
}

__device__ __forceinline__ void p0_colmax_item(const float* W, int K, int N, unsigned* cmax, int row_off, int item, int lane, const float* gain) {
    const int nblk = N / 32, kb = item / nblk, nb = item % nblk, k0 = 64 * kb, n0 = 32 * nb, c4 = 4 * (lane & 7); row_off += 128 * (n0 >> 7);
    f32x4 mx = (f32x4){0.f, 0.f, 0.f, 0.f};
#pragma unroll
    for (int i = 0; i < 8; ++i) { const int kk = (lane >> 3) + 8 * i; const f32x4 v = *(const GAS f32x4*)(W + (size_t)(k0 + kk) * N + n0 + c4) * gain[k0 + kk];
        mx[0] = fmaxf(mx[0], fabsf(v[0])); mx[1] = fmaxf(mx[1], fabsf(v[1])); mx[2] = fmaxf(mx[2], fabsf(v[2])); mx[3] = fmaxf(mx[3], fabsf(v[3])); }
#pragma unroll
    for (int j = 0; j < 4; ++j) { float t = mx[j]; t = fmaxf(t, __shfl_xor(t, 8)); t = fmaxf(t, __shfl_xor(t, 16)); t = fmaxf(t, __shfl_xor(t, 32)); mx[j] = t; }
    if (lane < 8) {
#pragma unroll
        for (int j = 0; j < 4; ++j) atomicMax(cmax + row_off + n0 + c4 + j, __float_as_uint(mx[j])); }
}
__device__ __forceinline__ void p6_quant_item(const float* W, int K, int N, unsigned char* WT, int row_off, LAS float* scr, int item, int lane, const float* gain, const unsigned* cmax) {
    const int nblk = N / 32, kb = item / nblk, nb = item % nblk, k0 = 64 * kb, n0 = 32 * nb; row_off += 128 * (n0 >> 7);
    {   f32x4 v[8]; const int c4 = 4 * (lane & 7);
#pragma unroll
        for (int i = 0; i < 8; ++i) v[i] = *(const GAS f32x4*)(W + (size_t)(k0 + (lane >> 3) + 8 * i) * N + n0 + c4);
#pragma unroll
        for (int i = 0; i < 8; ++i) { const int kk = (lane >> 3) + 8 * i; const float gsc = gain[k0 + kk]; LAS float* sp = scr + kk * 33 + c4;
            sp[0] = v[i].x * gsc; sp[1] = v[i].y * gsc; sp[2] = v[i].z * gsc; sp[3] = v[i].w * gsc; } }
    LDS_WAIT(); asm volatile("" ::: "memory");
    const int c = lane & 7;
#pragma unroll
    for (int j = 0; j < 4; ++j) { const int n = (lane >> 3) + 8 * j; const LAS float* s = scr + (8 * c) * 33 + n; const float cm = __uint_as_float(cmax[row_off + n0 + n]); const float inv = cm > 0.f ? 127.0f / cm : 0.f;
        unsigned lo = 0, hi = 0;
#pragma unroll
        for (int t = 0; t < 4; ++t) { lo |= ((unsigned)(int)__builtin_rintf(s[t * 33] * inv) & 255u) << (8 * t); hi |= ((unsigned)(int)__builtin_rintf(s[(4 + t) * 33] * inv) & 255u) << (8 * t); }
        v2u o; o.x = lo; o.y = hi; *(GAS v2u*)(WT + (size_t)(row_off + n0 + n) * K + k0 + 8 * c) = o; }
    LDS_WAIT(); asm volatile("" ::: "memory");
}
__device__ __forceinline__ void rms_row_to_bf16(const float* xrow, const float* gain, bf16* orow, int lane) {
    const GAS f32x4* xr = (const GAS f32x4*)xrow + lane; const GAS f32x4* gr = (const GAS f32x4*)gain + lane;
    f32x4 v[4]; float s = 0.f;
#pragma unroll
    for (int j = 0; j < 4; ++j) { v[j] = xr[64 * j]; s += (v[j].x * v[j].x + v[j].y * v[j].y) + (v[j].z * v[j].z + v[j].w * v[j].w); }
    const float rstd = 1.0f / sqrtf(wave_sum(s) * (1.f / D) + EPS);
    GAS unsigned long long* o8 = (GAS unsigned long long*)orow + lane;
#pragma unroll
    for (int j = 0; j < 4; ++j) { const f32x4 gg = gr[64 * j]; o8[64 * j] = (unsigned long long)pk2(v[j].x * rstd * gg.x, v[j].y * rstd * gg.y) | ((unsigned long long)pk2(v[j].z * rstd * gg.z, v[j].w * rstd * gg.w) << 32); }
}
__device__ __forceinline__ int t5_bucket(int rel) {
    const int ret = rel > 0 ? 16 : 0; const int n = rel < 0 ? -rel : rel;
    const float nf = (float)(n > 1 ? n : 1);
    int large = 8 + (int)(logf(nf / 8.0f) / logf(128.0f) * 8.0f);
    large = large < 15 ? large : 15;
    return ret + (n < 8 ? n : large);
}

__device__ __forceinline__ void p0_prologue(Frame& F) {
    LAS float* scr = (LAS float*)(F.lds + RING_OFF + F.wave * 16384);
    const int gw = F.vcu * NWAVES + F.wave, NGW = F.G * NWAVES;
    bf16* WinT = (bf16*)(F.ws + WS_WIN); bf16* WoutT = (bf16*)(F.ws + WS_WOUT); bf16* WgvT = (bf16*)(F.ws + WS_WGV); bf16* WdT = (bf16*)(F.ws + WS_WD);
    constexpr int I_IN = (D / 64) * (NPROJ / 32), I_OUT = (MIXW / 64) * (D / 32), I_G = (D / 64) * (FF / 32), I_D = (FF / 64) * (D / 32);
    constexpr int NITEMS = I_IN + I_OUT + 2 * I_G + I_D;
    for (int it = gw; it < NITEMS; it += NGW) {
        int r = it;
        if (r < I_IN) { p0_transpose_item(F.w_in, D, NPROJ, WinT, 0, scr, r, F.lane, F.g_mix); continue; } r -= I_IN;
        if (r < I_OUT) { const int k0 = 64 * (r / (D / 32)); p0_transpose_item(F.w_out, MIXW, D, WoutT, 0, scr, r, F.lane, k0 < AW ? F.g_attn : F.g_four - AW); continue; } r -= I_OUT;
        if (r < 2 * I_G) { const bool isv = r >= I_G; p0_colmax_item(isv ? F.w_val : F.w_gate, D, FF, (unsigned*)(F.ctl + CW_CMAX), isv ? 128 : 0, isv ? r - I_G : r, F.lane, F.g_ffn); continue; } r -= 2 * I_G;
        p0_transpose_item(F.w_down, FF, D, WdT, 0, scr, r, F.lane);
    }
    float* tabBias = (float*)(F.ws + WS_TAB + TAB_BIAS); float* tabMg = (float*)(F.ws + WS_TAB + TAB_MG); float* tabTw = (float*)(F.ws + WS_TAB + TAB_TW);
    const int gt = F.vcu * (NWAVES * 64) + F.tid, NGT = F.G * NWAVES * 64;
    for (int i = gt; i < 3 * 129 * 12; i += NGT) { const int h = i % 12, jj = (i / 12) % 129, br = i / (12 * 129); const int dil = br == 0 ? 1 : (br == 1 ? 4 : 16);
        tabBias[i] = F.rel_tab[t5_bucket((jj - 64) * dil) * 12 + h]; }
    for (int i = gt; i < 4 * 64 * 128; i += NGT) { const int col = i & 127, c = (i >> 7) & 63, g = i >> 13; const int e = col & 63; float acc = 0.f;
        for (int d = 0; d < 64; ++d) { const float rev = (float)((c * d) & 63) * (1.0f / 64.0f); const float t = col < 64 ? __builtin_amdgcn_cosf(rev) : -__builtin_amdgcn_sinf(rev); acc += t * F.f_w[(g * 64 + d) * 64 + e]; }
        tabMg[i] = acc; }
    for (int i = gt; i < 4096; i += NGT) { float sv, cv; sincospif((float)i * (1.0f / 2048.0f), &sv, &cv); tabTw[2 * i] = cv; tabTw[2 * i + 1] = sv; }
    bf16* XN = (bf16*)(F.ws + WS_XN);
    {   float* RS0 = (float*)(F.ws + WS_RS0);
        for (int m0 = gw; m0 < M; m0 += 4 * NGW) { f32x4 v[4][4];
#pragma unroll
            for (int r = 0; r < 4; ++r) { const int m = m0 + r * NGW; const GAS f32x4* xr = (const GAS f32x4*)(F.x + (size_t)(m < M ? m : 0) * D) + F.lane;
#pragma unroll
                for (int j = 0; j < 4; ++j) v[r][j] = xr[64 * j]; }
#pragma unroll
            for (int r = 0; r < 4; ++r) { const int m = m0 + r * NGW; float s = 0.f;
#pragma unroll
                for (int j = 0; j < 4; ++j) s += (v[r][j].x * v[r][j].x + v[r][j].y * v[r][j].y) + (v[r][j].z * v[r][j].z + v[r][j].w * v[r][j].w);
                const float rstd = 1.0f / sqrtf(wave_sum(s) * (1.f / D) + EPS);
                if (m < M) { GAS unsigned long long* o8 = (GAS unsigned long long*)(XN + (size_t)m * D) + F.lane; if (F.lane == 0) RS0[m] = rstd;
#pragma unroll
                    for (int j = 0; j < 4; ++j) { const f32x4 t = v[r][j]; o8[64 * j] = (unsigned long long)pk2(t.x, t.y) | ((unsigned long long)pk2(t.z, t.w) << 32); } } } } }
}

namespace att {
typedef short bf16x8 __attribute__((ext_vector_type(8)));
typedef short v4i16 __attribute__((ext_vector_type(4)));
constexpr float LOG2E = 1.4426950408889634f;
constexpr int TABN = 512, TPAD0 = 128;
constexpr int LDS_K = 0, LDS_V = 49152, LDS_T0 = 98304, LDS_T1 = 98304 + 8192;
struct QT { bf16x8 q[2]; f32x4 o[4]; float m, l; };
__device__ __forceinline__ v4i16 vtr(const LAS unsigned char* p) { return __builtin_amdgcn_ds_read_tr16_b64_v4i16((LAS v4i16*)p); }

__device__ __forceinline__ void build_table(Frame& F, int ldsoff, int br, int h) {
    const float* tabBias = (const float*)(F.ws + WS_TAB + TAB_BIAS);
    LAS float* T = (LAS float*)(F.lds + ldsoff);
    for (int e = F.tid; e < 4 * TABN; e += NWAVES * 64) { const int s = e / TABN, n = e % TABN; const int r64 = n + s - TPAD0;
        T[e] = (r64 >= 0 && r64 <= 128) ? tabBias[(br * 129 + r64) * 12 + h] * LOG2E : -INFINITY; }
}
__device__ __forceinline__ const LAS float* table_ptr(Frame& F, int ldsoff, int idx0) { const int s = idx0 & 3; return (const LAS float*)(F.lds + ldsoff) + s * TABN + (idx0 - s); }

__device__ __forceinline__ int pass_tok(int mode, int a, int row) {
    if (mode == 0) { const int t = a - 64 + row; return (t >= 0 && t < SEQ) ? t : -1; }
    if (mode == 3) return a + 16 * row;
    const int hi = row >= 192 ? 1 : 0, u = a + (hi ? row - 192 : row), c = 2 * (mode - 1) + hi; return (u >= 0 && u < SEQ / 4) ? c + 4 * u : -1;
}
struct Pre { v4u k[6], v[6]; };
template <int NIT> __device__ __forceinline__ void prefetch(Frame& F, Pre& R, const bf16* P, int h, int mode, int a) {
#pragma unroll
    for (int it = 0; it < NIT; ++it) { const int idx = F.tid + it * (NWAVES * 64), row = idx >> 3, ph = idx & 7; const int t = pass_tok(mode, a, row);
        const int ck = ph ^ ((row >> 1) & 7), cv = ph ^ (((row >> 1) & 3) << 1);
        R.k[it] = (v4u){0u, 0u, 0u, 0u}; R.v[it] = (v4u){0u, 0u, 0u, 0u};
        if (t >= 0) { const bf16* rp = P + (size_t)t * NPROJ + h * 64; R.k[it] = *(const GAS v4u*)(rp + AW + ck * 8); R.v[it] = *(const GAS v4u*)(rp + 2 * AW + cv * 8); } }
}
template <int NIT> __device__ __forceinline__ void commit(Frame& F, const Pre& R) {
#pragma unroll
    for (int it = 0; it < NIT; ++it) { const int idx = F.tid + it * (NWAVES * 64);
        *(LAS v4u*)(F.lds + LDS_K + idx * 16) = R.k[it]; *(LAS v4u*)(F.lds + LDS_V + idx * 16) = R.v[it]; }
}
__device__ __forceinline__ float xmax4(float v) {
    auto a = __builtin_amdgcn_permlane16_swap(__float_as_uint(v), __float_as_uint(v), false, false); v = fmaxf(__uint_as_float(a[0]), __uint_as_float(a[1]));
    auto b = __builtin_amdgcn_permlane32_swap(__float_as_uint(v), __float_as_uint(v), false, false); return fmaxf(__uint_as_float(b[0]), __uint_as_float(b[1]));
}
__device__ __forceinline__ float xsum4(float v) {
    auto a = __builtin_amdgcn_permlane16_swap(__float_as_uint(v), __float_as_uint(v), false, false); v = __uint_as_float(a[0]) + __uint_as_float(a[1]);
    auto b = __builtin_amdgcn_permlane32_swap(__float_as_uint(v), __float_as_uint(v), false, false); return __uint_as_float(b[0]) + __uint_as_float(b[1]);
}
__device__ __forceinline__ void load_q(QT& T, const bf16* qrow  , int g) {
#pragma unroll
    for (int ks = 0; ks < 2; ++ks) { const v4u w = *(const GAS v4u*)(qrow + 8 * g + 32 * ks); const float sc = 0.125f * LOG2E; v4u o;
        o.x = pk2(bflo(w.x) * sc, bfhi(w.x) * sc); o.y = pk2(bflo(w.y) * sc, bfhi(w.y) * sc); o.z = pk2(bflo(w.z) * sc, bfhi(w.z) * sc); o.w = pk2(bflo(w.w) * sc, bfhi(w.w) * sc);
        T.q[ks] = __builtin_bit_cast(bf16x8, o); }
#pragma unroll
    for (int db = 0; db < 4; ++db) T.o[db] = (f32x4){0.f, 0.f, 0.f, 0.f};
    T.m = -1e30f; T.l = 0.f;
}
typedef float f32x2_t __attribute__((ext_vector_type(2))); typedef __bf16 bf16x2_t __attribute__((ext_vector_type(2)));
__device__ __forceinline__ unsigned cvtpk(float lo, float hi) { f32x2_t v = {lo, hi}; bf16x2_t b = __builtin_convertvector(v, bf16x2_t); return __builtin_bit_cast(unsigned, b); }
constexpr float THR = 8.0f;
template <int NQ, int NP> __device__ __forceinline__ void attn_step(QT (&T)[NQ], const LAS unsigned char* kp, const LAS unsigned char* vp, const LAS float* const (&tp)[NQ], int p, int koff0, int koff1, const int (&voff)[4], int klo, int khi, bool edge, int g) {
    bf16x8 kf[NP][4]; v4i16 vlo[NP][4], vhi[NP][4];
#pragma unroll
    for (int c = 0; c < NP; ++c) { kf[c][0] = *(const LAS bf16x8*)(kp + c * 4096 + koff0); kf[c][1] = *(const LAS bf16x8*)(kp + c * 4096 + koff1); kf[c][2] = *(const LAS bf16x8*)(kp + c * 4096 + 2048 + koff0); kf[c][3] = *(const LAS bf16x8*)(kp + c * 4096 + 2048 + koff1);
#pragma unroll
        for (int db = 0; db < 4; ++db) { vlo[c][db] = vtr(vp + c * 4096 + voff[db]); vhi[c][db] = vtr(vp + c * 4096 + 2048 + voff[db]); } }
#pragma unroll
    for (int n = 0; n < NQ; ++n) {
        f32x4 s[NP][2];
#pragma unroll
        for (int c = 0; c < NP; ++c) {
            s[c][0] = *(const LAS f32x4*)(tp[n] + (p + c) * 32); s[c][1] = *(const LAS f32x4*)(tp[n] + (p + c) * 32 + 16);
            s[c][0] = __builtin_amdgcn_mfma_f32_16x16x32_bf16(kf[c][0], T[n].q[0], s[c][0], 0, 0, 0); s[c][0] = __builtin_amdgcn_mfma_f32_16x16x32_bf16(kf[c][1], T[n].q[1], s[c][0], 0, 0, 0);
            s[c][1] = __builtin_amdgcn_mfma_f32_16x16x32_bf16(kf[c][2], T[n].q[0], s[c][1], 0, 0, 0); s[c][1] = __builtin_amdgcn_mfma_f32_16x16x32_bf16(kf[c][3], T[n].q[1], s[c][1], 0, 0, 0);
            if (edge) { const int kk = (p + c) * 32 + 4 * g;
#pragma unroll
                for (int r = 0; r < 4; ++r) { if (kk + r < klo || kk + r >= khi) s[c][0][r] = -INFINITY; if (kk + 16 + r < klo || kk + 16 + r >= khi) s[c][1][r] = -INFINITY; } } }
        float tm = fmaxf(fmaxf(fmaxf(s[0][0][0], s[0][0][1]), fmaxf(s[0][0][2], s[0][0][3])), fmaxf(fmaxf(s[0][1][0], s[0][1][1]), fmaxf(s[0][1][2], s[0][1][3])));
        if (NP == 2) tm = fmaxf(tm, fmaxf(fmaxf(fmaxf(s[NP - 1][0][0], s[NP - 1][0][1]), fmaxf(s[NP - 1][0][2], s[NP - 1][0][3])), fmaxf(fmaxf(s[NP - 1][1][0], s[NP - 1][1][1]), fmaxf(s[NP - 1][1][2], s[NP - 1][1][3]))));
        tm = xmax4(tm);
        if (__any(tm > T[n].m + THR)) { const float mn = fmaxf(T[n].m, tm), al = __builtin_amdgcn_exp2f(T[n].m - mn); T[n].m = mn; T[n].l *= al;
#pragma unroll
            for (int db = 0; db < 4; ++db) T[n].o[db] = T[n].o[db] * al; }
        const float mref = T[n].m; float ls = 0.f;
#pragma unroll
        for (int c = 0; c < NP; ++c) {
#pragma unroll
            for (int r = 0; r < 4; ++r) { s[c][0][r] = __builtin_amdgcn_exp2f(s[c][0][r] - mref); s[c][1][r] = __builtin_amdgcn_exp2f(s[c][1][r] - mref); }
            ls += ((s[c][0][0] + s[c][0][1]) + (s[c][0][2] + s[c][0][3])) + ((s[c][1][0] + s[c][1][1]) + (s[c][1][2] + s[c][1][3])); }
        T[n].l += ls;
#pragma unroll
        for (int c = 0; c < NP; ++c) {
            v4u pw; pw.x = cvtpk(s[c][0][0], s[c][0][1]); pw.y = cvtpk(s[c][0][2], s[c][0][3]); pw.z = cvtpk(s[c][1][0], s[c][1][1]); pw.w = cvtpk(s[c][1][2], s[c][1][3]);
            const bf16x8 pf = __builtin_bit_cast(bf16x8, pw);
#pragma unroll
            for (int db = 0; db < 4; ++db) { const bf16x8 vf = (bf16x8){vlo[c][db][0], vlo[c][db][1], vlo[c][db][2], vlo[c][db][3], vhi[c][db][0], vhi[c][db][1], vhi[c][db][2], vhi[c][db][3]};
                T[n].o[db] = __builtin_amdgcn_mfma_f32_16x16x32_bf16(vf, pf, T[n].o[db], 0, 0, 0); } }
    }
}
template <int NQ> __device__ __forceinline__ void attn_job(QT (&T)[NQ], const LAS unsigned char* Kw, const LAS unsigned char* Vw, int npairs, const LAS float* const (&tp)[NQ], int klo, int khi, bool edge, int lane) {
    const int i = lane & 15, g = lane >> 4;
    const int koff0 = i * 128 + (((g) ^ (i >> 1)) << 4), koff1 = i * 128 + (((g + 4) ^ (i >> 1)) << 4);
    const int qq = i >> 2, pp = i & 3, vr = 4 * g + qq, fv = (vr >> 1) & 3;
    int voff[4];
#pragma unroll
    for (int db = 0; db < 4; ++db) voff[db] = vr * 128 + ((((db ^ fv) << 1) + (pp >> 1)) << 4) + (pp & 1) * 8;
    int p = 0;
    if (NQ == 1) {
#pragma unroll 1
        for (; p + 2 <= npairs; p += 2) attn_step<NQ, 2>(T, Kw + p * 4096, Vw + p * 4096, tp, p, koff0, koff1, voff, klo, khi, edge, g);
    }
#pragma unroll 1
    for (; p < npairs; ++p) attn_step<NQ, 1>(T, Kw + p * 4096, Vw + p * 4096, tp, p, koff0, koff1, voff, klo, khi, edge, g);
}
__device__ __forceinline__ void four_ssq(Frame& F) {
    const bf16* A2 = (const bf16*)(F.ws + WS_A2); float* SSA = (float*)(F.ws + WS_SSA);
    const int gw = F.vcu * NWAVES + F.wave, NGW = F.G * NWAVES;
    for (int m0 = gw; m0 < M; m0 += 4 * NGW) { v2u w[4];
#pragma unroll
        for (int r = 0; r < 4; ++r) { const int m = (m0 + r * NGW) < M ? (m0 + r * NGW) : 0; w[r] = *(const GAS v2u*)(A2 + (size_t)m * MIXW + AW + 4 * F.lane); }
#pragma unroll
        for (int r = 0; r < 4; ++r) { const int m = m0 + r * NGW; const float a = bflo(w[r].x), b2 = bfhi(w[r].x), c = bflo(w[r].y), d = bfhi(w[r].y);
            const float s = wave_sum((a * a + b2 * b2) + (c * c + d * d));
            if (m < M && F.lane == 0) *(GAS f32x4*)(SSA + (size_t)m * 16 + 12) = (f32x4){s, 0.f, 0.f, 0.f}; } }
}
__device__ __forceinline__ void phase_local(Frame& F) {
    constexpr int NU = BATCH * NH * 16; const int per = (NU + F.G - 1) / F.G, ub = F.vcu * per, ue = (ub + per) < NU ? (ub + per) : NU;
    const bf16* PROJ = (const bf16*)(F.ws + WS_PROJ); const int lane = F.lane, w = F.wave, i = lane & 15, g = lane >> 4;
    const int idx4 = w >> 1, rA = w & 1, rB = 2 + (w & 1);
    Pre R; int hprev = -1;
    __syncthreads();
    if (ub < ue) { const int bh = ub >> 4; prefetch<6>(F, R, PROJ + (size_t)(bh / NH) * SEQ * NPROJ, bh % NH, 0, (ub & 15) * 256); }
    for (int u = ub; u < ue; ++u) {
        const int bh = u >> 4, b = bh / NH, h = bh % NH, s0 = (u & 15) * 256;
        const bf16* P = PROJ + (size_t)b * SEQ * NPROJ; bf16* A2 = (bf16*)(F.ws + WS_A2) + (size_t)b * SEQ * MIXW; float* ML = (float*)(F.ws + WS_ML) + (size_t)b * SEQ * NH * 2;
        __syncthreads();
        commit<6>(F, R);
        if (h != hprev) { build_table(F, LDS_T0, 0, h); build_table(F, LDS_T1, 1, h); hprev = h; }
        __syncthreads();
        const int u0 = s0 / 4 - 64;
        QT T[2];
        const int tokA = s0 + rA + 4 * (16 * idx4 + i), tokB = s0 + rB + 4 * (16 * idx4 + i);
        load_q(T[0], P + (size_t)tokA * NPROJ + h * 64, g); load_q(T[1], P + (size_t)tokB * NPROJ + h * 64, g);
        asm volatile("" ::: "memory");
        prefetch<6>(F, R, P, h, 1, u0);
        {
            const LAS float* tp[2] = { table_ptr(F, LDS_T0, 4 * g - 4 * i - rA + TPAD0), table_ptr(F, LDS_T0, 4 * g - 4 * i - rB + TPAD0) };
            int klo = 64 - s0 - 64 * idx4; klo = klo > 0 ? klo : 0; int khi = SEQ + 64 - s0 - 64 * idx4; khi = khi < 192 ? khi : 192;
            attn_job<2>(T, F.lds + LDS_K + 64 * idx4 * 128, F.lds + LDS_V + 64 * idx4 * 128, 6, tp, klo, khi, (klo > 0 || khi < 192), lane);
        }
#pragma unroll
        for (int pass = 0; pass < 2; ++pass) {
            __syncthreads();
            commit<6>(F, R);
            __syncthreads();
            if (pass == 0) prefetch<6>(F, R, P, h, 2, u0);
            else if (u + 1 < ue) { const int bh2 = (u + 1) >> 4; prefetch<6>(F, R, PROJ + (size_t)(bh2 / NH) * SEQ * NPROJ, bh2 % NH, 0, ((u + 1) & 15) * 256); }
            const int cl = w & 1, lo = idx4 < 2 ? idx4 : 2;
            const LAS float* tp[1] = { table_ptr(F, LDS_T1, 4 * g - i + 16 * (lo - idx4) + TPAD0) };
            int klo = -(u0 + 16 * lo); klo = klo > 0 ? klo : 0; int khi = SEQ / 4 - (u0 + 16 * lo); khi = khi < 160 ? khi : 160;
            QT (&Tp)[1] = *(QT (*)[1])(&T[pass]);
            attn_job<1>(Tp, F.lds + LDS_K + (192 * cl + 16 * lo) * 128, F.lds + LDS_V + (192 * cl + 16 * lo) * 128, 5, tp, klo, khi, (klo > 0 || khi < 160), lane);
        }
#pragma unroll
        for (int n = 0; n < 2; ++n) {
            const float l = xsum4(T[n].l); const float inv = 1.0f / l; const int tok = n == 0 ? tokA : tokB;
#pragma unroll
            for (int db = 0; db < 4; ++db) { v2u o; o.x = pk2(T[n].o[db][0] * inv, T[n].o[db][1] * inv); o.y = pk2(T[n].o[db][2] * inv, T[n].o[db][3] * inv);
                *(GAS v2u*)(A2 + (size_t)tok * MIXW + h * 64 + 16 * db + 4 * g) = o; }
            if (g == 0) { float* mlp = ML + ((size_t)tok * NH + h) * 2; mlp[0] = T[n].m; mlp[1] = l; }
        }
    }
    __syncthreads();
}
__device__ __forceinline__ void phase_class(Frame& F) {
    four_ssq(F);
    constexpr int NU = BATCH * NH * 16; const int per = (NU + F.G - 1) / F.G, ub = F.vcu * per, ue = (ub + per) < NU ? (ub + per) : NU;
    const bf16* PROJ = (const bf16*)(F.ws + WS_PROJ); const int lane = F.lane, w = F.wave, i = lane & 15, g = lane >> 4; float* SSA = (float*)(F.ws + WS_SSA);
    Pre R; int hprev = -1;
    __syncthreads();
    if (ub < ue) { const int bh = ub >> 4; prefetch<4>(F, R, PROJ + (size_t)(bh / NH) * SEQ * NPROJ, bh % NH, 3, ub & 15); }
    for (int u = ub; u < ue; ++u) {
        const int bh = u >> 4, b = bh / NH, h = bh % NH, r = u & 15;
        const bf16* P = PROJ + (size_t)b * SEQ * NPROJ; bf16* A2 = (bf16*)(F.ws + WS_A2) + (size_t)b * SEQ * MIXW; const float* ML = (const float*)(F.ws + WS_ML) + (size_t)b * SEQ * NH * 2;
        __syncthreads();
        commit<4>(F, R);
        if (h != hprev) { build_table(F, LDS_T0, 2, h); hprev = h; }
        __syncthreads();
        QT T2[2]; float mlv[2], llv[2]; v2u pvv[2][4];
#pragma unroll
        for (int n = 0; n < 2; ++n) { const int qt = n == 0 ? (w < 7 ? w : 11) : (w < 4 ? w + 7 : (w < 7 ? w + 8 : 15)); const int tok = r + 16 * (16 * qt + i);
            load_q(T2[n], P + (size_t)tok * NPROJ + h * 64, g);
            const float* mlp = ML + ((size_t)tok * NH + h) * 2; mlv[n] = mlp[0]; llv[n] = mlp[1];
#pragma unroll
            for (int db = 0; db < 4; ++db) pvv[n][db] = *(const GAS v2u*)(A2 + (size_t)tok * MIXW + h * 64 + 16 * db + 4 * g); }
        asm volatile("" ::: "memory");
        if (u + 1 < ue) { const int bh2 = (u + 1) >> 4; prefetch<4>(F, R, PROJ + (size_t)(bh2 / NH) * SEQ * NPROJ, bh2 % NH, 3, (u + 1) & 15); }
#pragma unroll
        for (int n = 0; n < 2; ++n) {
            const int qt = n == 0 ? (w < 7 ? w : 11) : (w < 4 ? w + 7 : (w < 7 ? w + 8 : 15));
            int lo = qt - 4 > 0 ? qt - 4 : 0, hi = qt + 4 < 15 ? qt + 4 : 15; if (((hi - lo + 1) & 1) != 0) { if (hi < 15) ++hi; else --lo; }
            const int tok = r + 16 * (16 * qt + i);
            QT (&T)[1] = *(QT (*)[1])(&T2[n]);
            const LAS float* tp[1] = { table_ptr(F, LDS_T0, 4 * g - i + 16 * (lo - qt) + 64 + TPAD0) };
            attn_job<1>(T, F.lds + LDS_K + 16 * lo * 128, F.lds + LDS_V + 16 * lo * 128, (hi - lo + 1) >> 1, tp, 0, 1 << 20, false, lane);
            const float l16 = xsum4(T[0].l);
            const float ml = mlv[n], ll = llv[n];
            const float mm = fmaxf(ml, T[0].m), a = __builtin_amdgcn_exp2f(ml - mm) * ll, bb = __builtin_amdgcn_exp2f(T[0].m - mm), inv = 1.0f / (a + bb * l16); float sq = 0.f;
#pragma unroll
            for (int db = 0; db < 4; ++db) { GAS v2u* op = (GAS v2u*)(A2 + (size_t)tok * MIXW + h * 64 + 16 * db + 4 * g); const v2u pv = pvv[n][db]; v2u o;
                const float f0 = (bflo(pv.x) * a + T[0].o[db][0] * bb) * inv, f1 = (bfhi(pv.x) * a + T[0].o[db][1] * bb) * inv, f2 = (bflo(pv.y) * a + T[0].o[db][2] * bb) * inv, f3 = (bfhi(pv.y) * a + T[0].o[db][3] * bb) * inv;
                sq += (f0 * f0 + f1 * f1) + (f2 * f2 + f3 * f3); o.x = pk2(f0, f1); o.y = pk2(f2, f3);
                *op = o; }
            sq = xsum4(sq);
            if (g == 0) SSA[((size_t)b * SEQ + tok) * 16 + h] = sq;
        }
    }
    __syncthreads();
}
}


namespace fou {
typedef short bf16x8 __attribute__((ext_vector_type(8)));
typedef short v4i16 __attribute__((ext_vector_type(4)));
constexpr int LX = 0, LC = LDSCTL_OFF + 8192, LS = LDSCTL_OFF + 16384;
__device__ __forceinline__ int gsw(int s2) { const int pr = (s2 >> 1) & 7; return (pr & 4) | ((pr & 1) << 1) | ((pr >> 1) & 1); }
__device__ __forceinline__ int xaddr(int pe, int s2, int chunk) { return LX + pe * 8192 + s2 * 128 + (((chunk ^ gsw(s2) ^ pe) & 7) << 4); }
__device__ __forceinline__ int maddr(int base, int k, int chunk) { return base + k * 128 + (((chunk ^ (k >> 1)) & 7) << 4); }
__device__ __forceinline__ v4i16 vtr(const LAS unsigned char* p) { return __builtin_amdgcn_ds_read_tr16_b64_v4i16((LAS v4i16*)p); }
__device__ __forceinline__ bf16x8 neg8(bf16x8 v) { v4u w = __builtin_bit_cast(v4u, v); w.x ^= 0x80008000u; w.y ^= 0x80008000u; w.z ^= 0x80008000u; w.w ^= 0x80008000u; return __builtin_bit_cast(bf16x8, w); }

__device__ __forceinline__ void fourier_unit(Frame& F, int b, int g, int ec) {
    const bf16* PROJ = (const bf16*)(F.ws + WS_PROJ); bf16* A2 = (bf16*)(F.ws + WS_A2); const float* tabMg = (const float*)(F.ws + WS_TAB + TAB_MG);
    const int lane = F.lane, w = F.wave, li = lane & 15, gq = lane >> 4, e0 = 8 * ec;
    LAS unsigned char* L = F.lds;
    __syncthreads();
    bf16x8 mb[2];
#pragma unroll
    for (int ks = 0; ks < 2; ++ks) { float v[8];
#pragma unroll
        for (int j = 0; j < 8; ++j) { const int c = 8 * gq + j + 32 * ks; const int col = li < 8 ? e0 + li : 64 + e0 + (li & 7); v[j] = tabMg[(g * 64 + c) * 128 + col]; }
        v4u o; o.x = pk2(v[0], v[1]); o.y = pk2(v[2], v[3]); o.z = pk2(v[4], v[5]); o.w = pk2(v[6], v[7]); mb[ks] = __builtin_bit_cast(bf16x8, o); }
    const bf16* ub = PROJ + (size_t)(b * SEQ) * NPROJ + 3 * AW + g * 64 + 8 * gq;
#pragma unroll 8
    for (int it = 0; it < 32; ++it) { const int tile = w + 8 * it, s2 = tile & 63, tq = tile >> 6;
        const bf16* up = ub + (size_t)(64 * (16 * tq + li) + s2) * NPROJ;
        const bf16x8 a0 = __builtin_bit_cast(bf16x8, *(const GAS v4u*)up), a1 = __builtin_bit_cast(bf16x8, *(const GAS v4u*)(up + 32));
        f32x4 d = (f32x4){0.f, 0.f, 0.f, 0.f};
        d = __builtin_amdgcn_mfma_f32_16x16x32_bf16(a0, mb[0], d, 0, 0, 0); d = __builtin_amdgcn_mfma_f32_16x16x32_bf16(a1, mb[1], d, 0, 0, 0);
        v2u o; o.x = pk2(d[0], d[1]); o.y = pk2(d[2], d[3]); *(LAS v2u*)(L + xaddr(li, s2, 2 * tq + (gq >> 1)) + (gq & 1) * 8) = o; }
    __syncthreads();
    const int e = w;
#pragma unroll 1
    for (int mt = 0; mt < 4; ++mt) { const int s2 = 16 * mt + li;
        bf16x8 yr[2], yi[2], nyr[2];
#pragma unroll
        for (int kh = 0; kh < 2; ++kh) { yr[kh] = *(const LAS bf16x8*)(L + xaddr(e, s2, gq + 4 * kh)); yi[kh] = *(const LAS bf16x8*)(L + xaddr(8 + e, s2, gq + 4 * kh)); nyr[kh] = neg8(yr[kh]); }
#pragma unroll
        for (int nt = 0; nt < 4; ++nt) { const int k = 16 * nt + li;
            const bf16x8 c0 = *(const LAS bf16x8*)(L + maddr(LC, k, gq)), c1 = *(const LAS bf16x8*)(L + maddr(LC, k, gq + 4)), s0 = *(const LAS bf16x8*)(L + maddr(LS, k, gq)), s1 = *(const LAS bf16x8*)(L + maddr(LS, k, gq + 4));
            f32x4 tr = (f32x4){0.f, 0.f, 0.f, 0.f}, ti = (f32x4){0.f, 0.f, 0.f, 0.f};
            tr = __builtin_amdgcn_mfma_f32_16x16x32_bf16(c0, yr[0], tr, 0, 0, 0); tr = __builtin_amdgcn_mfma_f32_16x16x32_bf16(c1, yr[1], tr, 0, 0, 0);
            tr = __builtin_amdgcn_mfma_f32_16x16x32_bf16(s0, yi[0], tr, 0, 0, 0); tr = __builtin_amdgcn_mfma_f32_16x16x32_bf16(s1, yi[1], tr, 0, 0, 0);
            ti = __builtin_amdgcn_mfma_f32_16x16x32_bf16(c0, yi[0], ti, 0, 0, 0); ti = __builtin_amdgcn_mfma_f32_16x16x32_bf16(c1, yi[1], ti, 0, 0, 0);
            ti = __builtin_amdgcn_mfma_f32_16x16x32_bf16(s0, nyr[0], ti, 0, 0, 0); ti = __builtin_amdgcn_mfma_f32_16x16x32_bf16(s1, nyr[1], ti, 0, 0, 0);
            float orr[4], oii[4];
#pragma unroll
            for (int r = 0; r < 4; ++r) { const int k1 = 16 * nt + 4 * gq + r; const float rev = (float)((k1 * s2) & 4095) * (1.0f / 4096.0f); const float cv = __builtin_amdgcn_cosf(rev), sv = __builtin_amdgcn_sinf(rev);
                orr[r] = tr[r] * cv + ti[r] * sv; oii[r] = ti[r] * cv - tr[r] * sv; }
            v2u o; o.x = pk2(orr[0], orr[1]); o.y = pk2(orr[2], orr[3]); *(LAS v2u*)(L + xaddr(e, s2, 2 * nt + (gq >> 1)) + (gq & 1) * 8) = o;
            o.x = pk2(oii[0], oii[1]); o.y = pk2(oii[2], oii[3]); *(LAS v2u*)(L + xaddr(8 + e, s2, 2 * nt + (gq >> 1)) + (gq & 1) * 8) = o; } }
    asm volatile("s_waitcnt lgkmcnt(0)" ::: "memory");
    bf16x8 af[4][4];
    { const int q = li >> 2, p = li & 3;
#pragma unroll
      for (int mt = 0; mt < 4; ++mt)
#pragma unroll
        for (int ks = 0; ks < 4; ++ks) { const int pe = (ks >> 1) * 8 + e, s2b = 8 * gq + 32 * (ks & 1) + q;
            const v4i16 lo = vtr(L + xaddr(pe, s2b, 2 * mt + (p >> 1)) + (p & 1) * 8), hi = vtr(L + xaddr(pe, s2b + 4, 2 * mt + (p >> 1)) + (p & 1) * 8);
            af[mt][ks] = (bf16x8){lo[0], lo[1], lo[2], lo[3], hi[0], hi[1], hi[2], hi[3]}; } }
    asm volatile("s_waitcnt lgkmcnt(0)" ::: "memory");
    __syncthreads();
    const float bias = F.f_b[g * 64 + e0 + e];
#pragma unroll 1
    for (int nt = 0; nt < 4; ++nt) { const int k2 = 16 * nt + li;
        const bf16x8 c0 = *(const LAS bf16x8*)(L + maddr(LC, k2, gq)), c1 = *(const LAS bf16x8*)(L + maddr(LC, k2, gq + 4)), s0 = *(const LAS bf16x8*)(L + maddr(LS, k2, gq)), s1 = *(const LAS bf16x8*)(L + maddr(LS, k2, gq + 4));
#pragma unroll
        for (int mt = 0; mt < 4; ++mt) { f32x4 d = (f32x4){0.f, 0.f, 0.f, 0.f};
            d = __builtin_amdgcn_mfma_f32_16x16x32_bf16(af[mt][0], c0, d, 0, 0, 0); d = __builtin_amdgcn_mfma_f32_16x16x32_bf16(af[mt][1], c1, d, 0, 0, 0);
            d = __builtin_amdgcn_mfma_f32_16x16x32_bf16(af[mt][2], s0, d, 0, 0, 0); d = __builtin_amdgcn_mfma_f32_16x16x32_bf16(af[mt][3], s1, d, 0, 0, 0);
#pragma unroll
            for (int r = 0; r < 4; ++r) { const int k1 = 16 * mt + 4 * gq + r; *(LAS bf16*)(L + LX + (k1 * 64 + k2) * 16 + e * 2) = (bf16)f2bf(d[r] * (1.0f / 512.0f) + bias); } } }
    __syncthreads();
    bf16* ob = A2 + (size_t)(b * SEQ) * MIXW + AW + g * 64 + e0;
#pragma unroll
    for (int j = 0; j < 8; ++j) { const int sl = F.tid + 512 * j, k1 = sl >> 6, k2 = sl & 63; const v4u v = *(const LAS v4u*)(L + LX + sl * 16); *(GAS v4u*)(ob + (size_t)(k1 + 64 * k2) * MIXW) = v; }
}
__device__ __forceinline__ void phase_fourier(Frame& F) {
    const float* tabTw = (const float*)(F.ws + WS_TAB + TAB_TW);
    __syncthreads();
    for (int idx = F.tid; idx < 4096; idx += NWAVES * 64) { const int k = idx >> 6, s = idx & 63, n = ((k * s) & 63) * 64;
        *(LAS bf16*)(F.lds + maddr(LC, k, s >> 3) + (s & 7) * 2) = (bf16)f2bf(tabTw[2 * n]); *(LAS bf16*)(F.lds + maddr(LS, k, s >> 3) + (s & 7) * 2) = (bf16)f2bf(tabTw[2 * n + 1]); }
    __syncthreads();
    for (int u = F.vcu; u < BATCH * NG * 8; u += F.G) fourier_unit(F, u >> 5, (u >> 3) & 3, u & 7);
    __syncthreads();
}
}

__device__ __forceinline__ void p10_final(Frame& F) {
    const bf16* X2 = (const bf16*)(F.ws + WS_XN); const float* SS2 = (const float*)(F.ws + WS_SS2);
    const int gw = F.vcu * NWAVES + F.wave, NGW = F.G * NWAVES; const int lane = F.lane;
    const GAS f32x4* gr = (const GAS f32x4*)(F.g_fin + 16 * lane); const f32x4 g0 = gr[0], g1 = gr[1], g2 = gr[2], g3 = gr[3];
    for (int m0 = gw; m0 < M; m0 += 4 * NGW) { v4u w0[4], w1[4]; float part[4];
#pragma unroll
        for (int r = 0; r < 4; ++r) { const int m = (m0 + r * NGW) < M ? (m0 + r * NGW) : 0; const GAS v4u* rp = (const GAS v4u*)(X2 + (size_t)m * D + 16 * lane); w0[r] = rp[0]; w1[r] = rp[1];
            part[r] = lane < 16 ? SS2[(size_t)m * 16 + lane] : 0.f; }
#pragma unroll
        for (int r = 0; r < 4; ++r) { const int m = m0 + r * NGW; const float rstd = 1.0f / sqrtf(wave_sum(part[r]) * (1.f / D) + EPS);
            if (m < M) { GAS f32x4* op = (GAS f32x4*)(F.out + (size_t)m * D + 16 * lane);
                op[0] = (f32x4){bflo(w0[r].x), bfhi(w0[r].x), bflo(w0[r].y), bfhi(w0[r].y)} * rstd * g0; op[1] = (f32x4){bflo(w0[r].z), bfhi(w0[r].z), bflo(w0[r].w), bfhi(w0[r].w)} * rstd * g1;
                op[2] = (f32x4){bflo(w1[r].x), bfhi(w1[r].x), bflo(w1[r].y), bfhi(w1[r].y)} * rstd * g2; op[3] = (f32x4){bflo(w1[r].z), bfhi(w1[r].z), bflo(w1[r].w), bfhi(w1[r].w)} * rstd * g3; } } }
}


__device__ __forceinline__ void p8_halo_fix(Frame& F, int pm) {
    const float* H = (const float*)(F.ws + WS_HALO); bf16* ACT = (bf16*)(F.ws + WS_GV); const int kt = pm & 15;
    for (int it = F.tid; it < 2 * (FF / 4); it += NWAVES * 64) { const int c4 = (it % (FF / 4)) * 4, side = it / (FF / 4);
        if ((side == 0 && kt == 0) || (side == 1 && kt == 15)) continue;
        const float* own = H + (size_t)(pm * 2 + side) * 3 * FF + c4; const float* nb = H + (size_t)((side == 0 ? (pm - 1) * 2 + 1 : (pm + 1) * 2)) * 3 * FF + c4;
        const f32x4 gn = *(const GAS f32x4*)nb, zp = *(const GAS f32x4*)(own + FF), vv = *(const GAS f32x4*)(own + 2 * FF), wt = *(const GAS f32x4*)(F.conv_w + (side == 0 ? 0 : 2 * FF) + c4);
        float a[4];
#pragma unroll
        for (int i = 0; i < 4; ++i) { const float z = zp[i] + wt[i] * gn[i]; a[i] = z * __builtin_amdgcn_rcpf(1.0f + __builtin_amdgcn_exp2f(-1.4426950408889634f * z)) * vv[i]; }
        const unsigned long long o = (unsigned long long)pk2(a[0], a[1]) | ((unsigned long long)pk2(a[2], a[3]) << 32);
        __hip_atomic_store((unsigned long long*)(ACT + (size_t)(pm * 256 + (side ? 255 : 0)) * FF + c4), o, __ATOMIC_RELAXED, __HIP_MEMORY_SCOPE_AGENT); }
}


__device__ __forceinline__ void p6_quant(Frame& F) {
    const bf16* X1 = (const bf16*)(F.ws + WS_XN); unsigned char* A8 = F.ws + WS_A8; float* SROW = (float*)(F.ws + WS_SS1); const unsigned* cmax = (const unsigned*)(F.ctl + CW_CMAX);
    const int gw = F.vcu * NWAVES + F.wave, NGW = F.G * NWAVES, lane = F.lane;
    {   LAS float* scr = (LAS float*)(F.lds + RING_OFF + F.wave * 16384); constexpr int I_G = (D / 64) * (FF / 32);
        for (int it = gw; it < 2 * I_G; it += NGW) { const bool isv = it >= I_G; p6_quant_item(isv ? F.w_val : F.w_gate, D, FF, F.ws + WS_WGV, isv ? 128 : 0, scr, isv ? it - I_G : it, lane, F.g_ffn, cmax); } }
    {   float* cw6 = (float*)(F.ws + WS_TAB + TAB_CW4); const int gt = F.vcu * (NWAVES * 64) + F.tid, NGT = F.G * NWAVES * 64;
        for (int i = gt; i < (FF / 128) * 768; i += NGT) { const int pn = i / 768, k = (i % 768) >> 7, c = i & 127, ch = 128 * pn + c;
            cw6[i] = k < 3 ? F.conv_w[k * FF + ch] : (k == 3 ? F.conv_b[ch] : __uint_as_float(cmax[256 * pn + (k == 5 ? 128 : 0) + c]) * (1.0f / 127.0f)); } }
    for (int m0 = gw; m0 < M; m0 += 4 * NGW) { v4u w0[4], w1[4];
#pragma unroll
        for (int r = 0; r < 4; ++r) { const int m = (m0 + r * NGW) < M ? (m0 + r * NGW) : 0; const GAS v4u* rp = (const GAS v4u*)(X1 + (size_t)m * D + 16 * lane); w0[r] = rp[0]; w1[r] = rp[1]; }
#pragma unroll
        for (int r = 0; r < 4; ++r) { const int m = m0 + r * NGW; float v[16];
            v[0] = bflo(w0[r].x); v[1] = bfhi(w0[r].x); v[2] = bflo(w0[r].y); v[3] = bfhi(w0[r].y); v[4] = bflo(w0[r].z); v[5] = bfhi(w0[r].z); v[6] = bflo(w0[r].w); v[7] = bfhi(w0[r].w);
            v[8] = bflo(w1[r].x); v[9] = bfhi(w1[r].x); v[10] = bflo(w1[r].y); v[11] = bfhi(w1[r].y); v[12] = bflo(w1[r].z); v[13] = bfhi(w1[r].z); v[14] = bflo(w1[r].w); v[15] = bfhi(w1[r].w);
            float ss = 0.f, mx = 0.f;
#pragma unroll
            for (int i = 0; i < 16; ++i) { ss += v[i] * v[i]; mx = fmaxf(mx, fabsf(v[i])); }
            ss = wave_sum(ss);
#pragma unroll
            for (int o = 1; o < 64; o <<= 1) mx = fmaxf(mx, __shfl_xor(mx, o));
            const float inv = mx > 0.f ? 127.0f / mx : 0.f; unsigned q[4];
#pragma unroll
            for (int j = 0; j < 4; ++j) { q[j] = 0;
#pragma unroll
                for (int t = 0; t < 4; ++t) q[j] |= ((unsigned)(int)__builtin_rintf(v[4 * j + t] * inv) & 255u) << (8 * t); }
            if (m < M) { *(GAS v4u*)(A8 + (size_t)m * D + 16 * lane) = (v4u){q[0], q[1], q[2], q[3]};
                if (lane == 0) SROW[m] = mx * (1.0f / 127.0f) * (1.0f / sqrtf(ss * (1.f / D) + EPS)); } } }
}

struct Args { const float* in[16]; float* out; unsigned char* ws; int ph_lo, ph_hi; };
__global__ void __launch_bounds__(NWAVES * 64, 2) hymba_fwd(Args args) {
    extern __shared__ __attribute__((aligned(16))) unsigned char lds[];
    Frame F;
    F.lds = (LAS unsigned char*)lds;
    F.MISC = (volatile LAS unsigned*)(F.lds + MISC_OFF);
    F.tid = threadIdx.x; F.lane = F.tid & 63; F.wave = __builtin_amdgcn_readfirstlane(F.tid >> 6);
    F.G = gridDim.x; { const int bx = blockIdx.x; F.vcu = (F.G % 8 == 0) ? (bx % 8) * (F.G / 8) + bx / 8 : bx; }
    F.ws = args.ws; F.ctl = (gu32*)(args.ws + WS_CTL);
    F.x = args.in[0]; F.g_mix = args.in[1]; F.w_in = args.in[2]; F.g_attn = args.in[3]; F.rel_tab = args.in[4]; F.f_w = args.in[5]; F.f_b = args.in[6]; F.g_four = args.in[7];
    F.w_out = args.in[8]; F.g_ffn = args.in[9]; F.w_gate = args.in[10]; F.w_val = args.in[11]; F.conv_w = args.in[12]; F.conv_b = args.in[13]; F.w_down = args.in[14]; F.g_fin = args.in[15];
    F.out = args.out;
    for (int u = F.tid; u < (LDS_BYTES - LDSCTL_OFF) / 4; u += NWAVES * 64) ((LAS unsigned*)(F.lds + LDSCTL_OFF))[u] = 0u;
    __syncthreads();
    XcdBarrier bar; bar.bar = (unsigned*)(F.ctl + CW_BAR); bar.x = 0; bar.st = nullptr;
    if (MK_ONE_LAUNCH) bar = xcd_barrier_post((unsigned*)(F.ctl + CW_BAR), F.MISC + 8);
#define GRID_BAR() do { if (MK_ONE_LAUNCH) xcd_barrier(bar); } while (0)
    const int lo = args.ph_lo, hi = args.ph_hi;
#define IN(k) (lo <= (k) && (k) < hi)
#define BOTH(k) (IN(k) && IN((k) + 1))
    if (IN(0)) { p0_prologue(F); if (BOTH(0)) GRID_BAR(); }
    if (IN(1)) {
        pg8::Gemm g{(const bf16*)(F.ws + WS_XN), (const bf16*)(F.ws + WS_WIN), M, NPROJ, D, D, 0}; pg8::StaticOrder S; S.init(M, NPROJ, F.G, (int)blockIdx.x);
        pg8::EpiBf16Row E{(bf16*)(F.ws + WS_PROJ), NPROJ, (const float*)(F.ws + WS_RS0)};
        pg8::gemm_phase<pg8::EpiBf16Row, pg8::StaticOrder, true, true>(F.lds + RING_OFF, g, S, E);
        if (BOTH(1)) GRID_BAR();
    }
    if (IN(2)) { att::phase_local(F); fou::phase_fourier(F); if (BOTH(2)) GRID_BAR(); }
    if (IN(3)) { att::phase_class(F); if (IN(3) && IN(5)) GRID_BAR(); }
    if (IN(5)) {
        pg8::Gemm g{(const bf16*)(F.ws + WS_A2), (const bf16*)(F.ws + WS_WOUT), M, D, MIXW, MIXW, 0}; pg8::StaticOrder S; S.init(M, D, F.G, (int)blockIdx.x);
        pg8::EpiX1N E{(const bf16*)(F.ws + WS_XN), (bf16*)(F.ws + WS_XN), D, (float*)(F.ws + WS_SS1), (const float*)(F.ws + WS_SSA), (LAS float*)(F.lds + LDSCTL_OFF + 8192)};
        pg8::gemm_phase<pg8::EpiX1N, pg8::StaticOrder, true, true>(F.lds + RING_OFF, g, S, E);
        if (IN(5) && IN(6)) GRID_BAR();
    }
    if (IN(6)) { p6_quant(F); if (IN(6) && IN(7)) GRID_BAR(); }
    if (IN(7)) {
        pg8::Gemm g{(const bf16*)(F.ws + WS_A8), (const bf16*)(F.ws + WS_WGV), M, 2 * FF, D / 2, D / 2, 0}; pg8::StaticOrder S; S.init(M, 2 * FF, F.G, (int)blockIdx.x);
        pg8::EpiConvGlu E{(bf16*)(F.ws + WS_GV), FF, (const float*)(F.ws + WS_SS1), F.conv_w, F.conv_b, (LAS float*)(F.lds + LDSCTL_OFF + 4096), M, (float*)(F.ws + WS_HALO), (const float*)(F.ws + WS_TAB + TAB_CW4)};
        pg8::gemm_phase<pg8::EpiConvGlu, pg8::StaticOrder, true, true, true>(F.lds + RING_OFF, g, S, E);
        if (IN(7) && IN(9)) GRID_BAR();
    }
    if (IN(9)) {
        pg8::Gemm g{(const bf16*)(F.ws + WS_GV), (const bf16*)(F.ws + WS_WD), M, D, FF, FF, 0}; pg8::StaticOrder S; S.init(M, D, F.G, (int)blockIdx.x);
        { pg8::Unit uu; for (int i = 0; S.next(i, uu); ++i) p8_halo_fix(F, uu.pm); }
        asm volatile("s_waitcnt vmcnt(0)" ::: "memory"); __syncthreads();
        if (F.G == 256) {
            pg8::EpiFinal E{(const bf16*)(F.ws + WS_XN), F.out, D, F.g_fin, (float*)(F.ws + WS_XBUF), (unsigned*)(F.ctl + CW_PANEL), F.lds + LDSCTL_OFF + 4096};
            pg8::gemm_phase<pg8::EpiFinal, pg8::StaticOrder, true, true>(F.lds + RING_OFF, g, S, E);
        } else {
            pg8::EpiX2 E{(bf16*)(F.ws + WS_XN), D, (float*)(F.ws + WS_SS2)};
            pg8::gemm_phase<pg8::EpiX2, pg8::StaticOrder, true, true>(F.lds + RING_OFF, g, S, E);
            if (BOTH(9)) GRID_BAR();
        }
    }
    if (IN(10) && F.G != 256) { p10_final(F); }
#undef IN
#undef BOTH
}

extern "C" void kernel_launch(void* const* d_in, const int* in_sizes, int n_in, void* d_out, int out_size, void* d_ws, size_t ws_size, hipStream_t stream) {
    static int grid = 0;
    if (grid == 0) {
        if (n_in != 16 || in_sizes[0] != M * D || out_size != M * D || ws_size < WS_END) { fprintf(stderr, "kernel_launch: shape/workspace mismatch: n_in %d in0 %d out %d ws %zu (need %zu)\n", n_in, n_in > 0 ? in_sizes[0] : -1, out_size, ws_size, (size_t)WS_END); grid = -1; return; }
        int dev = 0, cus = 0, per_cu = 0;
        if (hipGetDevice(&dev) != hipSuccess || hipDeviceGetAttribute(&cus, hipDeviceAttributeMultiprocessorCount, dev) != hipSuccess) { grid = -1; return; }
        if (hipFuncSetAttribute((const void*)hymba_fwd, hipFuncAttributeMaxDynamicSharedMemorySize, LDS_BYTES) != hipSuccess) { fprintf(stderr, "kernel_launch: hipFuncSetAttribute failed\n"); grid = -1; return; }
        if (hipOccupancyMaxActiveBlocksPerMultiprocessor(&per_cu, (const void*)hymba_fwd, NWAVES * 64, LDS_BYTES) != hipSuccess || per_cu < 1) { fprintf(stderr, "kernel_launch: occupancy query says %d blocks/CU\n", per_cu); (void)hipGetLastError(); grid = -1; return; }
        grid = cus;
    }
    if (grid < 0) return;
    (void)hipMemsetAsync((char*)d_ws + WS_CTL, 0, CTL_ZERO_BYTES, stream);
    Args a{};
    for (int i = 0; i < 16; ++i) a.in[i] = (const float*)d_in[i];
    a.out = (float*)d_out; a.ws = (unsigned char*)d_ws;
#if MK_ONE_LAUNCH
    a.ph_lo = 0; a.ph_hi = N_PHASES;
    hipLaunchKernelGGL(hymba_fwd, dim3(grid), dim3(NWAVES * 64), LDS_BYTES, stream, a);
#else
    for (int p = 0; p < N_PHASES; ++p) { a.ph_lo = p; a.ph_hi = p + 1; hipLaunchKernelGGL(hymba_fwd, dim3(grid), dim3(NWAVES * 64), LDS_BYTES, stream, a); }
#endif
}
```

```cpp
#include <hip/hip_runtime.h>
#include <cstdio>
#include <cstdint>

namespace pg8 {
#define PG8_LAS __attribute__((address_space(3)))
typedef unsigned short bf16_t;
typedef short bf16x8 __attribute__((ext_vector_type(8)));
typedef float f32x4 __attribute__((ext_vector_type(4)));
typedef unsigned u32x4 __attribute__((ext_vector_type(4)));
typedef int i32x4 __attribute__((ext_vector_type(4)));
template <bool I8> struct AccT { typedef f32x4 type; };
template <> struct AccT<true> { typedef i32x4 type; };
constexpr int BM = 256, BK = 64, HALF = 128, HTB = HALF * BK * 2, STAGE_BYTES = 8 * HTB, NXCD = 8, WGM = 8;

__host__ __device__ __forceinline__ int lds_byte(int r, int c) { const int st = (r >> 4) * 2 + (c >> 5), rr = r & 15, cc = c & 31, ob = rr * 64 + cc * 2; return st * 1024 + (ob ^ (((ob >> 9) & 1) << 5)); }
__host__ __device__ __forceinline__ void stage_rc(int b, int& R, int& C) { const int st = b / 1024, sb = b % 1024, swz = sb ^ (((sb >> 9) & 1) << 5); R = (st >> 1) * 16 + swz / 64; C = (st & 1) * 32 + (swz % 64) / 2; }
__host__ __device__ __forceinline__ int perm32(int rho) { const int n = rho >> 4, i = rho & 15; return 8 * (i >> 2) + 4 * n + (i & 3); }

struct Unit { int pm, pn; };
struct Gemm { const bf16_t* A; const bf16_t* Bt; int M, N, K, lda; int ovl; };
__host__ __device__ __forceinline__ int ovl_row_base(int pm) { const int b = pm / 17, k = pm - 17 * b; return b * 4096 + (k ? 254 * k - 1 : 0); }

struct StaticOrder {
    int nM, nN, nwg, G, c;
    __host__ __device__ void init(int M, int N, int G_, int c_) { nM = M / BM; nN = N / BM; nwg = nM * nN; G = G_; c = c_; }
    __host__ __device__ bool next(int i, Unit& u) const {
        const long L = (long)i * G + c; if (L >= nwg) return false;
        int wgid = (int)L; { const int q = nwg / NXCD, r = nwg % NXCD, xcd = wgid % NXCD, off = wgid / NXCD; wgid = (xcd < r ? xcd * (q + 1) : r * (q + 1) + (xcd - r) * q) + off; }
        const int nig = WGM * nN, gid = wgid / nig, fm = gid * WGM, gsz = (nM - fm) < WGM ? (nM - fm) : WGM;
        u.pm = fm + ((wgid % nig) % gsz); u.pn = (wgid % nig) / gsz; return true;
    }
    __device__ __forceinline__ void a_ready(const Unit&) const {}
    __device__ __forceinline__ void done(const Unit&) const {}
};

typedef float f32x2v_t __attribute__((ext_vector_type(2))); typedef __bf16 bf16x2v_t __attribute__((ext_vector_type(2)));
__device__ __forceinline__ unsigned cvt_pk_bf16(float lo, float hi) { f32x2v_t v = {lo, hi}; bf16x2v_t b = __builtin_convertvector(v, bf16x2v_t); return __builtin_bit_cast(unsigned, b); }

struct EpiBf16 {
    static constexpr bool PERM = true, AFTER_DRAIN = false, MIDK = false, PREFETCH = false;
    bf16_t* O; int ldc;
    __device__ __forceinline__ void operator()(const f32x4 (&acc)[2][2][4][2], const Unit& u, int wr, int wc, int fr, int fq) const {
        const int row0 = u.pm * BM + wr * 64 + fr; const int col0 = u.pn * BM + wc * 32 + 8 * fq;
#pragma unroll
        for (int ai = 0; ai < 2; ++ai)
#pragma unroll
            for (int m = 0; m < 4; ++m) { bf16_t* rowp = O + (size_t)(row0 + ai * HALF + m * 16) * ldc + col0;
#pragma unroll
                for (int bj = 0; bj < 2; ++bj) { const f32x4 v0 = acc[ai][bj][m][0], v1 = acc[ai][bj][m][1];
                    u32x4 w; w.x = cvt_pk_bf16(v0[0], v0[1]); w.y = cvt_pk_bf16(v0[2], v0[3]); w.z = cvt_pk_bf16(v1[0], v1[1]); w.w = cvt_pk_bf16(v1[2], v1[3]);
                    *(u32x4*)(rowp + bj * HALF) = w; } }
    }
};

struct EpiBf16Row {
    static constexpr bool PERM = true, AFTER_DRAIN = false, MIDK = false, PREFETCH = false;
    bf16_t* O; int ldc; const float* rs;
    __device__ __forceinline__ void operator()(const f32x4 (&acc)[2][2][4][2], const Unit& u, int wr, int wc, int fr, int fq) const {
        const int row0 = u.pm * BM + wr * 64 + fr; const int col0 = u.pn * BM + wc * 32 + 8 * fq;
#pragma unroll
        for (int ai = 0; ai < 2; ++ai)
#pragma unroll
            for (int m = 0; m < 4; ++m) { const int row = row0 + ai * HALF + m * 16; const float r = rs[row]; bf16_t* rowp = O + (size_t)row * ldc + col0;
#pragma unroll
                for (int bj = 0; bj < 2; ++bj) { const f32x4 v0 = acc[ai][bj][m][0] * r, v1 = acc[ai][bj][m][1] * r;
                    u32x4 w; w.x = cvt_pk_bf16(v0[0], v0[1]); w.y = cvt_pk_bf16(v0[2], v0[3]); w.z = cvt_pk_bf16(v1[0], v1[1]); w.w = cvt_pk_bf16(v1[2], v1[3]);
                    *(u32x4*)(rowp + bj * HALF) = w; } }
    }
};
struct EpiResF32 {
    static constexpr bool PERM = false, AFTER_DRAIN = false, MIDK = false, PREFETCH = false;
    const float* base; float* out; int ldc;
    __device__ __forceinline__ void operator()(const f32x4 (&acc)[2][2][4][2], const Unit& u, int wr, int wc, int fr, int fq) const {
        const int col0 = u.pn * BM + wc * 32 + 4 * fq;
#pragma unroll
        for (int ai = 0; ai < 2; ++ai)
#pragma unroll
            for (int m = 0; m < 4; ++m) { const int r = u.pm * BM + ai * HALF + wr * 64 + m * 16 + fr; const size_t off = (size_t)r * ldc + col0;
#pragma unroll
                for (int bj = 0; bj < 2; ++bj)
#pragma unroll
                    for (int n = 0; n < 2; ++n) { const f32x4 bs = *(const f32x4*)(base + off + bj * HALF + n * 16); *(f32x4*)(out + off + bj * HALF + n * 16) = bs + acc[ai][bj][m][n]; } }
    }
};


struct EpiX1 {
    static constexpr bool PERM = true, AFTER_DRAIN = false, MIDK = false, PREFETCH = false;
    const float* base; bf16_t* O; int ldc; float* ss;
    __device__ __forceinline__ void operator()(const f32x4 (&acc)[2][2][4][2], const Unit& u, int wr, int wc, int fr, int fq) const {
        const int row0 = u.pm * BM + wr * 64 + fr; const int col0 = u.pn * BM + wc * 32 + 8 * fq;
#pragma unroll
        for (int ai = 0; ai < 2; ++ai)
#pragma unroll
            for (int m = 0; m < 4; ++m) { const int row = row0 + ai * HALF + m * 16; const size_t off = (size_t)row * ldc + col0; float q = 0.f;
#pragma unroll
                for (int bj = 0; bj < 2; ++bj) { const f32x4 v0 = *(const f32x4*)(base + off + bj * HALF) + acc[ai][bj][m][0], v1 = *(const f32x4*)(base + off + bj * HALF + 4) + acc[ai][bj][m][1];
                    q += (v0[0] * v0[0] + v0[1] * v0[1]) + (v0[2] * v0[2] + v0[3] * v0[3]) + (v1[0] * v1[0] + v1[1] * v1[1]) + (v1[2] * v1[2] + v1[3] * v1[3]);
                    u32x4 w; w.x = cvt_pk_bf16(v0[0], v0[1]); w.y = cvt_pk_bf16(v0[2], v0[3]); w.z = cvt_pk_bf16(v1[0], v1[1]); w.w = cvt_pk_bf16(v1[2], v1[3]);
                    *(u32x4*)(O + off + bj * HALF) = w; }
                q += __shfl_xor(q, 16); q += __shfl_xor(q, 32);
                if (fq == 0) ss[(size_t)row * 16 + u.pn * 4 + wc] = q; }
    }
};
struct EpiX2 {
    static constexpr bool PERM = true, AFTER_DRAIN = false, MIDK = false, PREFETCH = false;
    bf16_t* X; int ldc; float* ss;
    __device__ __forceinline__ void operator()(const f32x4 (&acc)[2][2][4][2], const Unit& u, int wr, int wc, int fr, int fq) const {
        const int row0 = u.pm * BM + wr * 64 + fr; const int col0 = u.pn * BM + wc * 32 + 8 * fq;
#pragma unroll
        for (int ai = 0; ai < 2; ++ai)
#pragma unroll
            for (int m = 0; m < 4; ++m) { const int row = row0 + ai * HALF + m * 16; const size_t off = (size_t)row * ldc + col0; float q = 0.f;
#pragma unroll
                for (int bj = 0; bj < 2; ++bj) { const u32x4 xb = *(const u32x4*)(X + off + bj * HALF);
                    f32x4 v0, v1; v0[0] = __builtin_bit_cast(float, xb.x << 16); v0[1] = __builtin_bit_cast(float, xb.x & 0xffff0000u); v0[2] = __builtin_bit_cast(float, xb.y << 16); v0[3] = __builtin_bit_cast(float, xb.y & 0xffff0000u);
                    v1[0] = __builtin_bit_cast(float, xb.z << 16); v1[1] = __builtin_bit_cast(float, xb.z & 0xffff0000u); v1[2] = __builtin_bit_cast(float, xb.w << 16); v1[3] = __builtin_bit_cast(float, xb.w & 0xffff0000u);
                    v0 = v0 + acc[ai][bj][m][0]; v1 = v1 + acc[ai][bj][m][1];
                    q += (v0[0] * v0[0] + v0[1] * v0[1]) + (v0[2] * v0[2] + v0[3] * v0[3]) + (v1[0] * v1[0] + v1[1] * v1[1]) + (v1[2] * v1[2] + v1[3] * v1[3]);
                    u32x4 w; w.x = cvt_pk_bf16(v0[0], v0[1]); w.y = cvt_pk_bf16(v0[2], v0[3]); w.z = cvt_pk_bf16(v1[0], v1[1]); w.w = cvt_pk_bf16(v1[2], v1[3]);
                    *(u32x4*)(X + off + bj * HALF) = w; }
                q += __shfl_xor(q, 16); q += __shfl_xor(q, 32);
                if (fq == 0) ss[(size_t)row * 16 + u.pn * 4 + wc] = q; }
    }
};
struct EpiBf16Rs {
    static constexpr bool PERM = true, AFTER_DRAIN = false, MIDK = false, PREFETCH = false;
    bf16_t* O; int ldc; const float* ss; float inv_n, eps;
    __device__ __forceinline__ void operator()(const f32x4 (&acc)[2][2][4][2], const Unit& u, int wr, int wc, int fr, int fq) const {
        const int row0 = u.pm * BM + wr * 64 + fr; const int col0 = u.pn * BM + wc * 32 + 8 * fq;
#pragma unroll
        for (int ai = 0; ai < 2; ++ai)
#pragma unroll
            for (int m = 0; m < 4; ++m) { const int row = row0 + ai * HALF + m * 16; const f32x4* sp = (const f32x4*)(ss + (size_t)row * 16);
                const f32x4 s4 = (sp[0] + sp[1]) + (sp[2] + sp[3]); const float rs = 1.0f / sqrtf(((s4[0] + s4[1]) + (s4[2] + s4[3])) * inv_n + eps);
                bf16_t* rowp = O + (size_t)row * ldc + col0;
#pragma unroll
                for (int bj = 0; bj < 2; ++bj) { const f32x4 v0 = acc[ai][bj][m][0] * rs, v1 = acc[ai][bj][m][1] * rs;
                    u32x4 w; w.x = cvt_pk_bf16(v0[0], v0[1]); w.y = cvt_pk_bf16(v0[2], v0[3]); w.z = cvt_pk_bf16(v1[0], v1[1]); w.w = cvt_pk_bf16(v1[2], v1[3]);
                    *(u32x4*)(rowp + bj * HALF) = w; } }
    }
};


template <int CTRL> __device__ __forceinline__ float dppk(float keep, float x) { return __builtin_bit_cast(float, __builtin_amdgcn_update_dpp(__builtin_bit_cast(int, keep), __builtin_bit_cast(int, x), CTRL, 0xf, 0xf, false)); }
template <int CTRL> __device__ __forceinline__ float dppf(float x) { return __builtin_bit_cast(float, __builtin_amdgcn_mov_dpp(__builtin_bit_cast(int, x), CTRL, 0xf, 0xf, true)); }
struct EpiConvGlu {
    static constexpr bool PERM = true, AFTER_DRAIN = false, MIDK = false, PREFETCH = true;
    bf16_t* O; int ldc; const float* ss; const float* cw; const float* cb; PG8_LAS float* ex; int mrows; float* halo; const float* cw4;
    __device__ __forceinline__ void prefetch(const Unit& u, int wid, int lane) const {
        const int base = u.pm * BM; asm volatile("" : "+v"(lane));
        if (wid == 0) __builtin_amdgcn_global_load_lds((const unsigned*)(ss + base + lane * 4), (PG8_LAS unsigned*)(ex + 1024), 16, 0, 0);
        else if (wid < 4) __builtin_amdgcn_global_load_lds((const unsigned*)(cw4 + u.pn * 768 + (wid - 1) * 256 + lane * 4), (PG8_LAS unsigned*)(ex + 1024 + 4096 + (wid - 1) * 256), 16, 0, 0);
    }
    __device__ __forceinline__ void operator()(i32x4 (&iacc)[2][2][4][2], const Unit& u, int wr, int wc, int fr, int fq) const {
        f32x4 acc[2][2][4][2];
        const int kt = u.pm & 15, base = u.pm * BM, rend = 256;
        const int ch0 = u.pn * 128 + wc * 32 + 8 * fq;
        const bool top_open = kt != 0, bot_open = kt != 15;
        f32x4 w0[2], w1[2], w2[2], cbv[2];
        f32x4 sg[2], sv[2];
#pragma unroll
        for (int n = 0; n < 2; ++n) { const PG8_LAS float* wl = ex + 1024 + 4096 + wc * 32 + 8 * fq + 4 * n; w0[n] = *(const PG8_LAS f32x4*)wl; w1[n] = *(const PG8_LAS f32x4*)(wl + 128); w2[n] = *(const PG8_LAS f32x4*)(wl + 256); cbv[n] = *(const PG8_LAS f32x4*)(wl + 384); sg[n] = *(const PG8_LAS f32x4*)(wl + 512); sv[n] = *(const PG8_LAS f32x4*)(wl + 640); }
#pragma unroll
        for (int ai = 0; ai < 2; ++ai)
#pragma unroll
            for (int m = 0; m < 4; ++m) { const int r = ai * HALF + wr * 64 + m * 16 + fr; const float rs = ex[1024 + r];
#pragma unroll
                for (int n = 0; n < 2; ++n) { const i32x4 ig = iacc[ai][0][m][n], iv = iacc[ai][1][m][n]; const f32x4 cg = sg[n] * rs, cv = sv[n] * rs;
                    acc[ai][0][m][n] = (f32x4){(float)ig[0], (float)ig[1], (float)ig[2], (float)ig[3]} * cg; acc[ai][1][m][n] = (f32x4){(float)iv[0], (float)iv[1], (float)iv[2], (float)iv[3]} * cv; } }
        const int exi = (wc * 4 + fq) * 8;
        if (fr == 0) {
#pragma unroll
            for (int ai = 0; ai < 2; ++ai) { PG8_LAS f32x4* p = (PG8_LAS f32x4*)(ex + ((ai * 2 + wr) * 2 + 0) * 128 + exi); p[0] = acc[ai][0][0][0]; p[1] = acc[ai][0][0][1]; } }
        if (fr == 15) {
#pragma unroll
            for (int ai = 0; ai < 2; ++ai) { PG8_LAS f32x4* p = (PG8_LAS f32x4*)(ex + ((ai * 2 + wr) * 2 + 1) * 128 + exi); p[0] = acc[ai][0][3][0]; p[1] = acc[ai][0][3][1]; } }
        asm volatile("s_waitcnt lgkmcnt(0)\n\ts_barrier" ::: "memory");
#pragma unroll
        for (int ai = 0; ai < 2; ++ai) {
#pragma unroll
            for (int m = 0; m < 4; ++m) { const int r = ai * HALF + wr * 64 + m * 16 + fr; u32x4 w; unsigned wv[4]; float zz[8];
                f32x4 edge[2] = {(f32x4){0.f, 0.f, 0.f, 0.f}, (f32x4){0.f, 0.f, 0.f, 0.f}};
                if (m == 0) { const bool hz = (wr == 0 && ai == 0); const int sai = wr == 1 ? ai : 0, swr = wr == 1 ? 0 : 1; const PG8_LAS f32x4* p = (const PG8_LAS f32x4*)(ex + ((sai * 2 + swr) * 2 + 1) * 128 + exi);
                    if (!hz) { edge[0] = p[0]; edge[1] = p[1]; } }
                if (m == 3) { const bool hz = (wr == 1 && ai == 1); const int sai = wr == 0 ? ai : 1, swr = wr == 0 ? 1 : 0; const PG8_LAS f32x4* p = (const PG8_LAS f32x4*)(ex + ((sai * 2 + swr) * 2 + 0) * 128 + exi);
                    if (!hz) { edge[0] = p[0]; edge[1] = p[1]; } }
#pragma unroll
                for (int n = 0; n < 2; ++n) { float a[4];
#pragma unroll
                    for (int i = 0; i < 4; ++i) { const float gc = acc[ai][0][m][n][i];
                        const float rp = m > 0 ? dppf<0x121>(acc[ai][0][m > 0 ? m - 1 : 0][n][i]) : edge[n][i];
                        const float ln = m < 3 ? dppf<0x12F>(acc[ai][0][m < 3 ? m + 1 : 3][n][i]) : edge[n][i];
                        const float gu = dppk<0x111>(rp, gc), gd = dppk<0x101>(ln, gc);
                        const float z = __builtin_fmaf(w2[n][i], gd, __builtin_fmaf(w1[n][i], gc, __builtin_fmaf(w0[n][i], gu, cbv[n][i])));
                        if ((ai == 0 && m == 0) || (ai == 1 && m == 3)) zz[4 * n + i] = z;
                        a[i] = z * __builtin_amdgcn_rcpf(1.0f + __builtin_amdgcn_exp2f(-1.4426950408889634f * z)) * acc[ai][1][m][n][i]; }
                    wv[2 * n] = cvt_pk_bf16(a[0], a[1]); wv[2 * n + 1] = cvt_pk_bf16(a[2], a[3]); }
                w.x = wv[0]; w.y = wv[1]; w.z = wv[2]; w.w = wv[3];
                bool open = false;
                if (ai == 0 && m == 0) open = (r == 0) && top_open;
                if (ai == 1 && m == 3) open = (r == 255) && bot_open;
                if (!open) *(u32x4*)(O + (size_t)(base + r) * ldc + ch0) = w;
                if ((ai == 0 && m == 0) || (ai == 1 && m == 3)) { if (open) { float* hp = halo + ((size_t)(u.pm * 2 + (ai == 0 ? 0 : 1)) * 3) * ldc + ch0;
                        *(f32x4*)hp = acc[ai][0][m][0]; *(f32x4*)(hp + 4) = acc[ai][0][m][1];
                        *(f32x4*)(hp + ldc) = (f32x4){zz[0], zz[1], zz[2], zz[3]}; *(f32x4*)(hp + ldc + 4) = (f32x4){zz[4], zz[5], zz[6], zz[7]};
                        *(f32x4*)(hp + 2 * ldc) = acc[ai][1][m][0]; *(f32x4*)(hp + 2 * ldc + 4) = acc[ai][1][m][1]; } }
                asm volatile("" ::: "memory"); } }
        asm volatile("s_waitcnt lgkmcnt(0)\n\ts_barrier" ::: "memory");
    }
};


struct EpiX1N {
    static constexpr bool PERM = true, AFTER_DRAIN = false, MIDK = true, PREFETCH = true; static constexpr int MIDK_T = 12;
    const bf16_t* base; bf16_t* O; int ldc; float* ss; const float* sa; PG8_LAS float* st;
    __device__ __forceinline__ void prefetch(const Unit& u, int wid, int lane) const {
        asm volatile("" : "+v"(lane));
#pragma unroll
        for (int i = 0; i < 2; ++i) { const int piece = wid * 2 + i;
            __builtin_amdgcn_global_load_lds((const unsigned*)(sa + (size_t)u.pm * BM * 16 + piece * 256 + lane * 4), (PG8_LAS unsigned*)(st + piece * 256), 16, 0, 0); }
    }
    __device__ __forceinline__ void row_stats(int rl, int fq, float& ra, float& rf) const {
        const f32x4 s4 = *(const PG8_LAS f32x4*)(st + rl * 16 + 4 * fq); float a = fq < 3 ? (s4[0] + s4[1]) + (s4[2] + s4[3]) : 0.f, f = fq == 3 ? s4[0] : 0.f;
        a += __shfl_xor(a, 16); a += __shfl_xor(a, 32); f += __shfl_xor(f, 16); f += __shfl_xor(f, 32);
        ra = __builtin_amdgcn_rsqf(a * (1.0f / 768.0f) + 1e-6f); rf = __builtin_amdgcn_rsqf(f * (1.0f / 256.0f) + 1e-6f);
    }
    __device__ __forceinline__ void midk(f32x4 (&acc)[2][2][4][2], const Unit& u, int wr, int fr, int fq) const {
#pragma unroll
        for (int ai = 0; ai < 2; ++ai)
#pragma unroll
            for (int m = 0; m < 4; ++m) { float ra, rf; row_stats(ai * HALF + wr * 64 + m * 16 + fr, fq, ra, rf); const float ratio = ra * __builtin_amdgcn_rcpf(rf);
#pragma unroll
                for (int bj = 0; bj < 2; ++bj) { acc[ai][bj][m][0] = acc[ai][bj][m][0] * ratio; acc[ai][bj][m][1] = acc[ai][bj][m][1] * ratio; } }
    }
    __device__ __forceinline__ void operator()(const f32x4 (&acc)[2][2][4][2], const Unit& u, int wr, int wc, int fr, int fq) const {
        const int row0 = u.pm * BM + wr * 64 + fr; const int col0 = u.pn * BM + wc * 32 + 8 * fq;
#pragma unroll
        for (int ai = 0; ai < 2; ++ai)
#pragma unroll
            for (int m = 0; m < 4; ++m) { const int row = row0 + ai * HALF + m * 16; const size_t off = (size_t)row * ldc + col0; float ra, rf; row_stats(row - u.pm * BM, fq, ra, rf);
#pragma unroll
                for (int bj = 0; bj < 2; ++bj) { const u32x4 xb = *(const u32x4*)(base + off + bj * HALF); f32x4 v0, v1;
                    v0[0] = __builtin_bit_cast(float, xb.x << 16); v0[1] = __builtin_bit_cast(float, xb.x & 0xffff0000u); v0[2] = __builtin_bit_cast(float, xb.y << 16); v0[3] = __builtin_bit_cast(float, xb.y & 0xffff0000u);
                    v1[0] = __builtin_bit_cast(float, xb.z << 16); v1[1] = __builtin_bit_cast(float, xb.z & 0xffff0000u); v1[2] = __builtin_bit_cast(float, xb.w << 16); v1[3] = __builtin_bit_cast(float, xb.w & 0xffff0000u);
                    v0 = v0 + acc[ai][bj][m][0] * rf; v1 = v1 + acc[ai][bj][m][1] * rf;
                    u32x4 w; w.x = cvt_pk_bf16(v0[0], v0[1]); w.y = cvt_pk_bf16(v0[2], v0[3]); w.z = cvt_pk_bf16(v1[0], v1[1]); w.w = cvt_pk_bf16(v1[2], v1[3]);
                    *(u32x4*)(O + off + bj * HALF) = w; }
                }
        asm volatile("s_waitcnt lgkmcnt(0)\n\ts_barrier" ::: "memory");
    }
};


struct EpiFinal {
    static constexpr bool PERM = true, AFTER_DRAIN = false, MIDK = false, PREFETCH = false;
    const bf16_t* X1; float* out; int ldc; const float* gain; float* xbuf; unsigned* cnt; PG8_LAS unsigned char* lx;
    __device__ __forceinline__ void operator()(f32x4 (&acc)[2][2][4][2], const Unit& u, int wr, int wc, int fr, int fq) const {
        PG8_LAS float* P = (PG8_LAS float*)lx; PG8_LAS float* S = (PG8_LAS float*)(lx + 4096);
        int tid = (wr * 4 + wc) * 64 + fq * 16 + fr; asm volatile("" : "+v"(tid)); const int col0 = u.pn * BM + wc * 32 + 8 * fq;
#pragma unroll
        for (int ai = 0; ai < 2; ++ai)
#pragma unroll
            for (int m = 0; m < 4; ++m) { const int rl = ai * HALF + wr * 64 + m * 16 + fr; const size_t off = (size_t)(u.pm * BM + rl) * ldc + col0; float q = 0.f;
#pragma unroll
                for (int bj = 0; bj < 2; ++bj) { const u32x4 xb = *(const u32x4*)(X1 + off + bj * HALF); f32x4 v0, v1;
                    v0[0] = __builtin_bit_cast(float, xb.x << 16); v0[1] = __builtin_bit_cast(float, xb.x & 0xffff0000u); v0[2] = __builtin_bit_cast(float, xb.y << 16); v0[3] = __builtin_bit_cast(float, xb.y & 0xffff0000u);
                    v1[0] = __builtin_bit_cast(float, xb.z << 16); v1[1] = __builtin_bit_cast(float, xb.z & 0xffff0000u); v1[2] = __builtin_bit_cast(float, xb.w << 16); v1[3] = __builtin_bit_cast(float, xb.w & 0xffff0000u);
                    v0 = v0 + acc[ai][bj][m][0]; v1 = v1 + acc[ai][bj][m][1]; acc[ai][bj][m][0] = v0; acc[ai][bj][m][1] = v1;
                    q += ((v0[0] * v0[0] + v0[1] * v0[1]) + (v0[2] * v0[2] + v0[3] * v0[3])) + ((v1[0] * v1[0] + v1[1] * v1[1]) + (v1[2] * v1[2] + v1[3] * v1[3])); }
                q += __shfl_xor(q, 16); q += __shfl_xor(q, 32);
                if (fq == 0) P[rl * 4 + wc] = q; }
        asm volatile("s_waitcnt lgkmcnt(0)\n\ts_barrier" ::: "memory");
        if (tid < 256) { const float s = (P[tid * 4] + P[tid * 4 + 1]) + (P[tid * 4 + 2] + P[tid * 4 + 3]);
            __hip_atomic_store(xbuf + ((size_t)(u.pm * BM + tid) * 4 + u.pn), s, __ATOMIC_RELAXED, __HIP_MEMORY_SCOPE_AGENT);
            asm volatile("s_waitcnt vmcnt(0)" ::: "memory");
            if ((tid & 63) == 0) __hip_atomic_fetch_add(cnt + 64 * u.pm, 1u, __ATOMIC_RELAXED, __HIP_MEMORY_SCOPE_AGENT); }
        if (tid < 64) { unsigned spins = 0;
            while ((unsigned)__builtin_amdgcn_readfirstlane(__hip_atomic_load(cnt + 64 * u.pm, __ATOMIC_RELAXED, __HIP_MEMORY_SCOPE_AGENT)) < 16u) { __builtin_amdgcn_s_sleep(2); if (++spins > 400000u) break; }
            __builtin_amdgcn_fence(__ATOMIC_ACQUIRE, "agent"); }
        asm volatile("s_waitcnt vmcnt(0) lgkmcnt(0)\n\ts_barrier" ::: "memory");
        if (tid < 256) { const float* xp = xbuf + (size_t)(u.pm * BM + tid) * 4; float t = 0.f;
#pragma unroll
            for (int k = 0; k < 4; ++k) t += __hip_atomic_load(xp + k, __ATOMIC_RELAXED, __HIP_MEMORY_SCOPE_AGENT);
            S[tid] = 1.0f / sqrtf(t * (1.0f / 1024.0f) + 1e-6f); }
        asm volatile("s_waitcnt vmcnt(0) lgkmcnt(0)\n\ts_barrier" ::: "memory");
        f32x4 gv[2][2];
#pragma unroll
        for (int bj = 0; bj < 2; ++bj)
#pragma unroll
            for (int n = 0; n < 2; ++n) gv[bj][n] = *(const f32x4*)(gain + col0 + bj * HALF + n * 4);
#pragma unroll
        for (int ai = 0; ai < 2; ++ai)
#pragma unroll
            for (int m = 0; m < 4; ++m) { const int rl = ai * HALF + wr * 64 + m * 16 + fr; const float rs = S[rl]; const size_t off = (size_t)(u.pm * BM + rl) * ldc + col0;
#pragma unroll
                for (int bj = 0; bj < 2; ++bj)
#pragma unroll
                    for (int n = 0; n < 2; ++n) *(f32x4*)(out + off + bj * HALF + n * 4) = acc[ai][bj][m][n] * rs * gv[bj][n]; }
    }
};

template <bool I8> __device__ __forceinline__ typename AccT<I8>::type mma16(bf16x8 a, bf16x8 b, typename AccT<I8>::type c) {
    if constexpr (I8) return __builtin_amdgcn_mfma_i32_16x16x64_i8(__builtin_bit_cast(i32x4, a), __builtin_bit_cast(i32x4, b), c, 0, 0, 0);
    else return __builtin_amdgcn_mfma_f32_16x16x32_bf16(a, b, c, 0, 0, 0);
}
template <class Epi, class Sched, bool ALIGN_EPI = false, bool SP2 = false, bool I8 = false>
__device__ __forceinline__ void gemm_phase(PG8_LAS unsigned char* lds, const Gemm g, const Sched& S, const Epi& E) {
    int tid = threadIdx.x; asm volatile("" : "+v"(tid));
    const int wid = __builtin_amdgcn_readfirstlane(tid >> 6), lane = tid & 63, wr = wid >> 2, wc = wid & 3, fr = lane & 15, fq = lane >> 4;
    const int K = g.K, nt = K / BK, lda = g.lda;
    unsigned voffA[2], voffB[2];
#pragma unroll
    for (int i = 0; i < 2; ++i) { int R, C; stage_rc(tid * 16 + i * 8192, R, C); const int Rb = Epi::PERM ? ((R & ~31) + perm32(R & 31)) : R;
        voffA[i] = (unsigned)(R * lda + C) * 2u; voffB[i] = (unsigned)(Rb * K + C) * 2u; }
    const size_t kstep = (size_t)(BK * 2);
    const size_t hstepA = (size_t)HALF * lda * 2, hstepB = (size_t)HALF * K * 2;
    const size_t tstepA = 2 * hstepA, tstepB = 2 * hstepB;
    const unsigned ldsw = (unsigned)wid * 1024u;
    const int aoff = lds_byte(wr * 64 + fr, fq * 8), boff = lds_byte(wc * 32 + fr, fq * 8);
#define PG8_SA(b, h) (((b) * 2 + (h)) * HTB)
#define PG8_SB(b, h) ((4 + (b) * 2 + (h)) * HTB)
#define PG8_STAGE(bufoff, gbase, voff) do { _Pragma("unroll") for (int _i = 0; _i < 2; ++_i) \
        __builtin_amdgcn_global_load_lds((const unsigned*)((const char*)(gbase) + (voff)[_i]), (PG8_LAS unsigned*)(lds + (bufoff) + ldsw + _i * 8192), 16, 0, 0); } while (0)
#define PG8_LDA(dst, b, h) do { _Pragma("unroll") for (int m = 0; m < 4; ++m) _Pragma("unroll") for (int k = 0; k < 2; ++k) dst[m][k] = *(const PG8_LAS bf16x8*)(lds + PG8_SA(b, h) + aoff + m * 2048 + k * 1024); } while (0)
#define PG8_LDB(dst, b, h) do { _Pragma("unroll") for (int n = 0; n < 2; ++n) _Pragma("unroll") for (int k = 0; k < 2; ++k) dst[n][k] = *(const PG8_LAS bf16x8*)(lds + PG8_SB(b, h) + boff + n * 2048 + k * 1024); } while (0)
#define PG8_MMA(ai, bj, At, Bt) do { __builtin_amdgcn_s_setprio(1); _Pragma("unroll") for (int m = 0; m < 4; ++m) _Pragma("unroll") for (int n = 0; n < 2; ++n) _Pragma("unroll") for (int k = 0; k < 2; ++k) \
        acc[ai][bj][m][n] = mma16<I8>(Bt[n][k], At[m][k], acc[ai][bj][m][n]); __builtin_amdgcn_s_setprio(0); } while (0)
#define PG8_WAIT_V(n) asm volatile("s_waitcnt vmcnt(" #n ")" ::: "memory")
#define PG8_WAIT_L(n) asm volatile("s_waitcnt lgkmcnt(" #n ")" ::: "memory")
#define PG8_BAR __builtin_amdgcn_s_barrier()
#define PG8_SCHED __builtin_amdgcn_sched_barrier(0)
    Unit cur, nxt; int ui = 0;
    if (!S.next(0, cur)) return;
    typedef typename AccT<I8>::type acc_t; acc_t acc[2][2][4][2];
#pragma unroll
    for (int a = 0; a < 2; ++a)
#pragma unroll
        for (int b = 0; b < 2; ++b)
#pragma unroll
            for (int m = 0; m < 4; ++m)
#pragma unroll
                for (int n = 0; n < 2; ++n) acc[a][b][m][n] = (acc_t){0, 0, 0, 0};
    bf16x8 At[4][2], B0[2][2], B1[2][2];
    const char* cA = (const char*)g.A + (g.ovl ? (size_t)ovl_row_base(cur.pm) * lda * 2 : (size_t)cur.pm * tstepA); const char* cB = (const char*)g.Bt + (size_t)cur.pn * tstepB;
    S.a_ready(cur);
    if constexpr (Epi::PREFETCH) E.prefetch(cur, wid, lane);
    if constexpr (SP2) {
        PG8_STAGE(PG8_SB(0, 0), cB, voffB); PG8_STAGE(PG8_SB(0, 1), cB + hstepB, voffB); PG8_STAGE(PG8_SA(0, 0), cA, voffA); PG8_STAGE(PG8_SA(0, 1), cA + hstepA, voffA);
        if (wr == 1) PG8_BAR;
        PG8_WAIT_V(2); PG8_BAR;
        PG8_STAGE(PG8_SB(1, 0), cB + kstep, voffB); PG8_STAGE(PG8_SA(1, 0), cA + kstep, voffA); PG8_STAGE(PG8_SB(1, 1), cB + hstepB + kstep, voffB);
        PG8_WAIT_V(6); PG8_BAR;
    } else {
        PG8_STAGE(PG8_SB(0, 0), cB, voffB); PG8_STAGE(PG8_SA(0, 0), cA, voffA); PG8_STAGE(PG8_SB(0, 1), cB + hstepB, voffB); PG8_STAGE(PG8_SA(0, 1), cA + hstepA, voffA);
        if (wr == 1) PG8_BAR;
        PG8_WAIT_V(4); PG8_BAR;
        PG8_STAGE(PG8_SB(1, 0), cB + kstep, voffB); PG8_STAGE(PG8_SA(1, 0), cA + kstep, voffA); PG8_STAGE(PG8_SB(1, 1), cB + hstepB + kstep, voffB);
        PG8_WAIT_V(6); PG8_BAR;
    }
    for (;;) {
        const bool has_next = S.next(ui + 1, nxt);
        const char* nA = has_next ? (const char*)g.A + (g.ovl ? (size_t)ovl_row_base(nxt.pm) * lda * 2 : (size_t)nxt.pm * tstepA) : cA; const char* nB = has_next ? (const char*)g.Bt + (size_t)nxt.pn * tstepB : cB;
        for (int t = 0; t < nt; t += 2) {
            const bool last = (t == nt - 2);
            const char* a1 = cA + (size_t)(t + 1) * kstep;
            const char* a2 = last ? nA : cA + (size_t)(t + 2) * kstep; const char* b2 = last ? nB : cB + (size_t)(t + 2) * kstep;
            const char* a3 = a2 + kstep; const char* b3 = b2 + kstep;
            if (last && has_next) S.a_ready(nxt);
            if constexpr (Epi::MIDK) { if (t == Epi::MIDK_T) E.midk(acc, cur, wr, fr, fq); }
            if constexpr (SP2) {
            PG8_LDB(B0, 0, 0); PG8_LDB(B1, 0, 1); PG8_SCHED; PG8_LDA(At, 0, 0); PG8_STAGE(PG8_SA(1, 1), a1 + hstepA, voffA);
            PG8_WAIT_V(8); PG8_WAIT_L(0); PG8_BAR; PG8_MMA(0, 0, At, B0); PG8_MMA(0, 1, At, B1); PG8_BAR; PG8_SCHED;
            PG8_LDA(At, 0, 1); PG8_STAGE(PG8_SB(0, 0), b2, voffB); PG8_STAGE(PG8_SB(0, 1), b2 + hstepB, voffB); PG8_STAGE(PG8_SA(0, 0), a2, voffA);
            PG8_WAIT_V(8); PG8_WAIT_L(0); PG8_BAR; PG8_MMA(1, 0, At, B0); PG8_MMA(1, 1, At, B1); PG8_BAR; PG8_SCHED;
            PG8_LDB(B0, 1, 0); PG8_LDB(B1, 1, 1); PG8_SCHED; PG8_LDA(At, 1, 0); PG8_STAGE(PG8_SA(0, 1), a2 + hstepA, voffA);
            PG8_WAIT_V(8); PG8_WAIT_L(0); PG8_BAR; PG8_MMA(0, 0, At, B0); PG8_MMA(0, 1, At, B1); PG8_BAR; PG8_SCHED;
            PG8_LDA(At, 1, 1); PG8_STAGE(PG8_SB(1, 0), b3, voffB); PG8_STAGE(PG8_SB(1, 1), b3 + hstepB, voffB); PG8_STAGE(PG8_SA(1, 0), a3, voffA);
            PG8_WAIT_V(8); PG8_WAIT_L(0); PG8_BAR; PG8_MMA(1, 0, At, B0); PG8_MMA(1, 1, At, B1); PG8_BAR; PG8_SCHED;
            } else {
            PG8_LDB(B0, 0, 0); PG8_SCHED; PG8_LDA(At, 0, 0); PG8_STAGE(PG8_SA(1, 1), a1 + hstepA, voffA);
            PG8_WAIT_L(8); PG8_BAR; PG8_WAIT_L(0); PG8_MMA(0, 0, At, B0); PG8_BAR; PG8_SCHED;
            PG8_LDB(B1, 0, 1); PG8_STAGE(PG8_SB(0, 0), b2, voffB);
            PG8_BAR; PG8_WAIT_L(0); PG8_MMA(0, 1, At, B1); PG8_BAR;
            PG8_LDA(At, 0, 1); PG8_STAGE(PG8_SA(0, 0), a2, voffA);
            PG8_BAR; PG8_WAIT_L(0); PG8_MMA(1, 0, At, B0); PG8_BAR; PG8_SCHED;
            PG8_STAGE(PG8_SB(0, 1), b2 + hstepB, voffB);
            PG8_WAIT_V(6); PG8_BAR; PG8_MMA(1, 1, At, B1); PG8_BAR;
            PG8_LDB(B0, 1, 0); PG8_SCHED; PG8_LDA(At, 1, 0); PG8_STAGE(PG8_SA(0, 1), a2 + hstepA, voffA);
            PG8_WAIT_L(8); PG8_BAR; PG8_WAIT_L(0); PG8_MMA(0, 0, At, B0); PG8_BAR; PG8_SCHED;
            PG8_LDB(B1, 1, 1); PG8_STAGE(PG8_SB(1, 0), b3, voffB);
            PG8_BAR; PG8_WAIT_L(0); PG8_MMA(0, 1, At, B1); PG8_BAR;
            PG8_LDA(At, 1, 1); PG8_STAGE(PG8_SA(1, 0), a3, voffA);
            PG8_BAR; PG8_WAIT_L(0); PG8_MMA(1, 0, At, B0); PG8_BAR; PG8_SCHED;
            PG8_STAGE(PG8_SB(1, 1), b3 + hstepB, voffB);
            PG8_WAIT_V(6); PG8_BAR; PG8_MMA(1, 1, At, B1); PG8_BAR;
            }
        }
        if constexpr (ALIGN_EPI) { if (wr == 0) PG8_BAR; }
        if constexpr (!Epi::AFTER_DRAIN) { E(acc, cur, wr, wc, fr, fq); S.done(cur); }
        if constexpr (Epi::PREFETCH) { if (has_next) E.prefetch(nxt, wid, lane); }
        if (!has_next) break;
#pragma unroll
        for (int a = 0; a < 2; ++a)
#pragma unroll
            for (int b = 0; b < 2; ++b)
#pragma unroll
                for (int m = 0; m < 4; ++m)
#pragma unroll
                    for (int n = 0; n < 2; ++n) acc[a][b][m][n] = (acc_t){0, 0, 0, 0};
        cur = nxt; cA = nA; cB = nB; ++ui;
        if constexpr (ALIGN_EPI) { if (wr == 1) PG8_BAR; }
    }
    PG8_WAIT_V(0);
    if constexpr (!ALIGN_EPI) { if (wr == 0) PG8_BAR; }
    PG8_BAR;
#undef PG8_SA
#undef PG8_SB
#undef PG8_STAGE
#undef PG8_LDA
#undef PG8_LDB
#undef PG8_MMA
#undef PG8_WAIT_V
#undef PG8_WAIT_L
#undef PG8_BAR
#undef PG8_SCHED
}
}

constexpr int NWAVES = 8;
#ifndef MK_ONE_LAUNCH
#define MK_ONE_LAUNCH 1
#endif
constexpr int N_PHASES = 11;

constexpr int BATCH = 8, SEQ = 4096, D = 1024, NH = 12, HD = 64, AW = 768, NG = 4, GD = 64, FW = 256, MIXW = 1024, NPROJ = 2560, FF = 2816;
constexpr int M = BATCH * SEQ;
constexpr float EPS = 1e-6f;

constexpr size_t MiB = 1u << 20;
constexpr size_t WS_CTL = 0, CTL_ZERO_BYTES = 96 * 1024;
constexpr size_t WS_TAB = 1 * MiB;
constexpr size_t TAB_BIAS = 0;
constexpr size_t TAB_MG = 32 * 1024;
constexpr size_t TAB_TW = 192 * 1024;
constexpr size_t TAB_CW4 = 256 * 1024;
constexpr size_t WS_WIN = 2 * MiB;
constexpr size_t WS_WOUT = 7 * MiB;
constexpr size_t WS_WGV = 9 * MiB;
constexpr size_t WS_WD = 20 * MiB;
constexpr size_t WS_XN = 26 * MiB;
constexpr size_t WS_PROJ = 90 * MiB;
constexpr size_t WS_A2 = 250 * MiB;
constexpr size_t WS_PQ = 314 * MiB;
constexpr size_t WS_ML = 380 * MiB;
constexpr size_t WS_A8 = 314 * MiB;
constexpr size_t WS_HALO = 400 * MiB;
constexpr size_t WS_RS0 = 441 * MiB;
constexpr size_t WS_XBUF = 440 * MiB;
constexpr size_t WS_SSA = 446 * MiB;
constexpr size_t WS_SS1 = 442 * MiB;
constexpr size_t WS_SS2 = 444 * MiB;
constexpr size_t WS_GV = 90 * MiB;
constexpr size_t WS_END = 448 * MiB;
constexpr int CW_BAR = 1024, CW_PANEL = 8192, CW_CMAX = 16384;

constexpr int RING_OFF = 0, RING_BYTES = 131072;
constexpr int LDSCTL_OFF = RING_BYTES, MISC_OFF = LDSCTL_OFF + 320;
constexpr int LDS_BYTES = 163840;

#define GAS __attribute__((address_space(1)))
#define LAS __attribute__((address_space(3)))
typedef unsigned short bf16;
typedef unsigned v4u __attribute__((ext_vector_type(4)));
typedef unsigned v2u __attribute__((ext_vector_type(2)));
typedef float f32x4 __attribute__((ext_vector_type(4)));
typedef GAS unsigned gu32;
#define RLX_AGENT __ATOMIC_RELAXED, __HIP_MEMORY_SCOPE_AGENT
#define LDS_WAIT() asm volatile("s_waitcnt lgkmcnt(0)" ::: "memory")
#define VM_WAIT() asm volatile("s_waitcnt vmcnt(0)" ::: "memory")
__device__ __forceinline__ unsigned f2bf(float f) { unsigned u = __builtin_bit_cast(unsigned, f); return (u + 0x7fffu + ((u >> 16) & 1u)) >> 16; }
__device__ __forceinline__ unsigned pk2(float lo, float hi) { typedef float f2_t __attribute__((ext_vector_type(2))); typedef __bf16 b2_t __attribute__((ext_vector_type(2))); f2_t v = {lo, hi}; b2_t b = __builtin_convertvector(v, b2_t); return __builtin_bit_cast(unsigned, b); }
__device__ __forceinline__ float bflo(unsigned w) { return __builtin_bit_cast(float, w << 16); }
__device__ __forceinline__ float bfhi(unsigned w) { return __builtin_bit_cast(float, w & 0xffff0000u); }
__device__ __forceinline__ float bf2f(bf16 h) { return __builtin_bit_cast(float, (unsigned)h << 16); }

#define XB_TMO      128
#define XB_XCNT(j)  (256  + 64 * (j))
#define XB_XSUB(j)  (1280 + 64 * (j))
#define XB_XGEN(j)  (2304 + 64 * (j))
#define XB_TOP      3328
#define XB_TOPGEN   3392
#define XCD_BAR_WORDS 3456
#define XB_SPIN_CAP (1u << 18)
__device__ __forceinline__ unsigned xb_ld(unsigned* p)              { return __hip_atomic_load(p, __ATOMIC_RELAXED, __HIP_MEMORY_SCOPE_AGENT); }
__device__ __forceinline__ unsigned xb_add(unsigned* p, unsigned v) { return __hip_atomic_fetch_add(p, v, __ATOMIC_RELAXED, __HIP_MEMORY_SCOPE_AGENT); }
__device__ __forceinline__ unsigned xb_xcc_id() { return (unsigned)__builtin_amdgcn_s_getreg((3 << 11) | 20) & 0xFu; }
#define XB_SPIN(cond, bar) do { unsigned _sp = 0; while (cond) { __builtin_amdgcn_s_sleep(1); \
    if ((++_sp & 255u) == 0u) { if (xb_ld(&(bar)[XB_TMO])) break; if (_sp > XB_SPIN_CAP) { atomicAdd(&(bar)[XB_TMO], 1u); break; } } } } while (0)
struct XcdBarrier { unsigned* bar; unsigned x; volatile LAS unsigned* st; };
__device__ __forceinline__ XcdBarrier xcd_barrier_post(unsigned* bar, volatile LAS unsigned* st) {
    XcdBarrier b; b.bar = bar; b.x = xb_xcc_id(); b.st = st;
    if (threadIdx.x == 0) (void)xb_add(&bar[XB_XCNT(b.x)], 1u);
    return b;
}
__device__ __forceinline__ void xcd_barrier_complete(unsigned* bar, unsigned x, unsigned& nloc, unsigned& nx) {
    const unsigned G = gridDim.x * gridDim.y * gridDim.z;
    unsigned sum, cnt, mine, sp = 0u;
    for (;;) {
        sum = 0u; cnt = 0u; mine = 0u;
#pragma unroll
        for (unsigned j = 0; j < 16; ++j) { const unsigned c = xb_ld(&bar[XB_XCNT(j)]); sum += c; cnt += (c > 0u) ? 1u : 0u; mine = (j == x) ? c : mine; }
        if (sum == G) break;
        __builtin_amdgcn_s_sleep(1);
        if ((++sp & 255u) == 0u) { if (xb_ld(&bar[XB_TMO])) break; if (sp > XB_SPIN_CAP) { atomicAdd(&bar[XB_TMO], 1u); break; } }
    }
    nloc = mine > 0u ? mine : 1u; nx = cnt > 0u ? cnt : 1u;
}
__device__ __forceinline__ void xcd_barrier(const XcdBarrier& b) {
    asm volatile("s_waitcnt vmcnt(0)" ::: "memory");
    __syncthreads();
    if (threadIdx.x == 0) {
        unsigned* bar = b.bar;
        __builtin_amdgcn_s_waitcnt(0);
        unsigned nloc = b.st[0], nx = b.st[1];
        if (nloc == 0u) { xcd_barrier_complete(bar, b.x, nloc, nx); b.st[0] = nloc; b.st[1] = nx; }
        const unsigned old = xb_add(&bar[XB_XSUB(b.x)], 1u);
        const unsigned gen = old / nloc;
        if (old + 1u == (gen + 1u) * nloc) {
            __builtin_amdgcn_fence(__ATOMIC_RELEASE, "agent");
            asm volatile("s_waitcnt vmcnt(0)" ::: "memory");
            const unsigned og = xb_add(&bar[XB_TOP], 1u);
            const unsigned tg = og / nx;
            if (og + 1u == (tg + 1u) * nx) xb_add(&bar[XB_TOPGEN], 1u);
            else XB_SPIN(xb_ld(&bar[XB_TOPGEN]) == tg, bar);
            __builtin_amdgcn_fence(__ATOMIC_ACQUIRE, "agent");
            xb_add(&bar[XB_XGEN(b.x)], 1u);
            asm volatile("s_waitcnt vmcnt(0)" ::: "memory");
        } else {
            XB_SPIN(xb_ld(&bar[XB_XGEN(b.x)]) == gen, bar);
            __builtin_amdgcn_fence(__ATOMIC_ACQUIRE, "agent");
            asm volatile("s_waitcnt vmcnt(0)" ::: "memory");
        }
    }
    __syncthreads();
}

struct Frame {
    LAS unsigned char* lds;
    volatile LAS unsigned* MISC;
    gu32* ctl;
    int tid, lane, wave;
    int vcu, G;
    const float *x, *g_mix, *w_in, *g_attn, *rel_tab, *f_w, *f_b, *g_four, *w_out, *g_ffn, *w_gate, *w_val, *conv_w, *conv_b, *w_down, *g_fin;
    float* out;
    unsigned char* ws;
};

__device__ __forceinline__ float wave_sum(float v) {
#pragma unroll
    for (int o = 1; o < 64; o <<= 1) v += __shfl_xor(v, o);
    return v;
}
__device__ __forceinline__ void p0_transpose_item(const float* W, int K, int N, bf16* WT, int row_off, LAS float* scr, int item, int lane, const float* gain = nullptr, bool il = false) {
    const int nblk = N / 32, kb = item / nblk, nb = item % nblk, k0 = 64 * kb, n0 = 32 * nb; if (il) row_off += 128 * (n0 >> 7);
    {   f32x4 v[8]; const int c4 = 4 * (lane & 7);
#pragma unroll
        for (int i = 0; i < 8; ++i) v[i] = *(const GAS f32x4*)(W + (size_t)(k0 + (lane >> 3) + 8 * i) * N + n0 + c4);
#pragma unroll
        for (int i = 0; i < 8; ++i) { const int kk = (lane >> 3) + 8 * i; const float gsc = gain ? gain[k0 + kk] : 1.0f; LAS float* sp = scr + kk * 33 + c4;
            sp[0] = v[i].x * gsc; sp[1] = v[i].y * gsc; sp[2] = v[i].z * gsc; sp[3] = v[i].w * gsc; } }
    LDS_WAIT(); asm volatile("" ::: "memory");
    const int c = lane & 7;
#pragma unroll
    for (int j = 0; j < 4; ++j) { const int n = (lane >> 3) + 8 * j; const LAS float* s = scr + (8 * c) * 33 + n;
        v4u o; o.x = pk2(s[0 * 33], s[1 * 33]); o.y = pk2(s[2 * 33], s[3 * 33]); o.z = pk2(s[4 * 33], s[5 * 33]); o.w = pk2(s[6 * 33], s[7 * 33]);
        *(GAS v4u*)(WT + (size_t)(row_off + n0 + n) * K + k0 + 8 * c) = o; }
    LDS_WAIT(); asm volatile("" ::: "memory");
}

__device__ __forceinline__ void p0_colmax_item(const float* W, int K, int N, unsigned* cmax, int row_off, int item, int lane, const float* gain) {
    const int nblk = N / 32, kb = item / nblk, nb = item % nblk, k0 = 64 * kb, n0 = 32 * nb, c4 = 4 * (lane & 7); row_off += 128 * (n0 >> 7);
    f32x4 mx = (f32x4){0.f, 0.f, 0.f, 0.f};
#pragma unroll
    for (int i = 0; i < 8; ++i) { const int kk = (lane >> 3) + 8 * i; const f32x4 v = *(const GAS f32x4*)(W + (size_t)(k0 + kk) * N + n0 + c4) * gain[k0 + kk];
        mx[0] = fmaxf(mx[0], fabsf(v[0])); mx[1] = fmaxf(mx[1], fabsf(v[1])); mx[2] = fmaxf(mx[2], fabsf(v[2])); mx[3] = fmaxf(mx[3], fabsf(v[3])); }
#pragma unroll
    for (int j = 0; j < 4; ++j) { float t = mx[j]; t = fmaxf(t, __shfl_xor(t, 8)); t = fmaxf(t, __shfl_xor(t, 16)); t = fmaxf(t, __shfl_xor(t, 32)); mx[j] = t; }
    if (lane < 8) {
#pragma unroll
        for (int j = 0; j < 4; ++j) atomicMax(cmax + row_off + n0 + c4 + j, __float_as_uint(mx[j])); }
}
__device__ __forceinline__ void p6_quant_item(const float* W, int K, int N, unsigned char* WT, int row_off, LAS float* scr, int item, int lane, const float* gain, const unsigned* cmax) {
    const int nblk = N / 32, kb = item / nblk, nb = item % nblk, k0 = 64 * kb, n0 = 32 * nb; row_off += 128 * (n0 >> 7);
    {   f32x4 v[8]; const int c4 = 4 * (lane & 7);
#pragma unroll
        for (int i = 0; i < 8; ++i) v[i] = *(const GAS f32x4*)(W + (size_t)(k0 + (lane >> 3) + 8 * i) * N + n0 + c4);
#pragma unroll
        for (int i = 0; i < 8; ++i) { const int kk = (lane >> 3) + 8 * i; const float gsc = gain[k0 + kk]; LAS float* sp = scr + kk * 33 + c4;
            sp[0] = v[i].x * gsc; sp[1] = v[i].y * gsc; sp[2] = v[i].z * gsc; sp[3] = v[i].w * gsc; } }
    LDS_WAIT(); asm volatile("" ::: "memory");
    const int c = lane & 7;
#pragma unroll
    for (int j = 0; j < 4; ++j) { const int n = (lane >> 3) + 8 * j; const LAS float* s = scr + (8 * c) * 33 + n; const float cm = __uint_as_float(cmax[row_off + n0 + n]); const float inv = cm > 0.f ? 127.0f / cm : 0.f;
        unsigned lo = 0, hi = 0;
#pragma unroll
        for (int t = 0; t < 4; ++t) { lo |= ((unsigned)(int)__builtin_rintf(s[t * 33] * inv) & 255u) << (8 * t); hi |= ((unsigned)(int)__builtin_rintf(s[(4 + t) * 33] * inv) & 255u) << (8 * t); }
        v2u o; o.x = lo; o.y = hi; *(GAS v2u*)(WT + (size_t)(row_off + n0 + n) * K + k0 + 8 * c) = o; }
    LDS_WAIT(); asm volatile("" ::: "memory");
}
__device__ __forceinline__ void rms_row_to_bf16(const float* xrow, const float* gain, bf16* orow, int lane) {
    const GAS f32x4* xr = (const GAS f32x4*)xrow + lane; const GAS f32x4* gr = (const GAS f32x4*)gain + lane;
    f32x4 v[4]; float s = 0.f;
#pragma unroll
    for (int j = 0; j < 4; ++j) { v[j] = xr[64 * j]; s += (v[j].x * v[j].x + v[j].y * v[j].y) + (v[j].z * v[j].z + v[j].w * v[j].w); }
    const float rstd = 1.0f / sqrtf(wave_sum(s) * (1.f / D) + EPS);
    GAS unsigned long long* o8 = (GAS unsigned long long*)orow + lane;
#pragma unroll
    for (int j = 0; j < 4; ++j) { const f32x4 gg = gr[64 * j]; o8[64 * j] = (unsigned long long)pk2(v[j].x * rstd * gg.x, v[j].y * rstd * gg.y) | ((unsigned long long)pk2(v[j].z * rstd * gg.z, v[j].w * rstd * gg.w) << 32); }
}
__device__ __forceinline__ int t5_bucket(int rel) {
    const int ret = rel > 0 ? 16 : 0; const int n = rel < 0 ? -rel : rel;
    const float nf = (float)(n > 1 ? n : 1);
    int large = 8 + (int)(logf(nf / 8.0f) / logf(128.0f) * 8.0f);
    large = large < 15 ? large : 15;
    return ret + (n < 8 ? n : large);
}

__device__ __forceinline__ void p0_prologue(Frame& F) {
    LAS float* scr = (LAS float*)(F.lds + RING_OFF + F.wave * 16384);
    const int gw = F.vcu * NWAVES + F.wave, NGW = F.G * NWAVES;
    bf16* WinT = (bf16*)(F.ws + WS_WIN); bf16* WoutT = (bf16*)(F.ws + WS_WOUT); bf16* WgvT = (bf16*)(F.ws + WS_WGV); bf16* WdT = (bf16*)(F.ws + WS_WD);
    constexpr int I_IN = (D / 64) * (NPROJ / 32), I_OUT = (MIXW / 64) * (D / 32), I_G = (D / 64) * (FF / 32), I_D = (FF / 64) * (D / 32);
    constexpr int NITEMS = I_IN + I_OUT + 2 * I_G + I_D;
    for (int it = gw; it < NITEMS; it += NGW) {
        int r = it;
        if (r < I_IN) { p0_transpose_item(F.w_in, D, NPROJ, WinT, 0, scr, r, F.lane, F.g_mix); continue; } r -= I_IN;
        if (r < I_OUT) { const int k0 = 64 * (r / (D / 32)); p0_transpose_item(F.w_out, MIXW, D, WoutT, 0, scr, r, F.lane, k0 < AW ? F.g_attn : F.g_four - AW); continue; } r -= I_OUT;
        if (r < 2 * I_G) { const bool isv = r >= I_G; p0_colmax_item(isv ? F.w_val : F.w_gate, D, FF, (unsigned*)(F.ctl + CW_CMAX), isv ? 128 : 0, isv ? r - I_G : r, F.lane, F.g_ffn); continue; } r -= 2 * I_G;
        p0_transpose_item(F.w_down, FF, D, WdT, 0, scr, r, F.lane);
    }
    float* tabBias = (float*)(F.ws + WS_TAB + TAB_BIAS); float* tabMg = (float*)(F.ws + WS_TAB + TAB_MG); float* tabTw = (float*)(F.ws + WS_TAB + TAB_TW);
    const int gt = F.vcu * (NWAVES * 64) + F.tid, NGT = F.G * NWAVES * 64;
    for (int i = gt; i < 3 * 129 * 12; i += NGT) { const int h = i % 12, jj = (i / 12) % 129, br = i / (12 * 129); const int dil = br == 0 ? 1 : (br == 1 ? 4 : 16);
        tabBias[i] = F.rel_tab[t5_bucket((jj - 64) * dil) * 12 + h]; }
    for (int i = gt; i < 4 * 64 * 128; i += NGT) { const int col = i & 127, c = (i >> 7) & 63, g = i >> 13; const int e = col & 63; float acc = 0.f;
        for (int d = 0; d < 64; ++d) { const float rev = (float)((c * d) & 63) * (1.0f / 64.0f); const float t = col < 64 ? __builtin_amdgcn_cosf(rev) : -__builtin_amdgcn_sinf(rev); acc += t * F.f_w[(g * 64 + d) * 64 + e]; }
        tabMg[i] = acc; }
    for (int i = gt; i < 4096; i += NGT) { float sv, cv; sincospif((float)i * (1.0f / 2048.0f), &sv, &cv); tabTw[2 * i] = cv; tabTw[2 * i + 1] = sv; }
    bf16* XN = (bf16*)(F.ws + WS_XN);
    {   float* RS0 = (float*)(F.ws + WS_RS0);
        for (int m0 = gw; m0 < M; m0 += 4 * NGW) { f32x4 v[4][4];
#pragma unroll
            for (int r = 0; r < 4; ++r) { const int m = m0 + r * NGW; const GAS f32x4* xr = (const GAS f32x4*)(F.x + (size_t)(m < M ? m : 0) * D) + F.lane;
#pragma unroll
                for (int j = 0; j < 4; ++j) v[r][j] = xr[64 * j]; }
#pragma unroll
            for (int r = 0; r < 4; ++r) { const int m = m0 + r * NGW; float s = 0.f;
#pragma unroll
                for (int j = 0; j < 4; ++j) s += (v[r][j].x * v[r][j].x + v[r][j].y * v[r][j].y) + (v[r][j].z * v[r][j].z + v[r][j].w * v[r][j].w);
                const float rstd = 1.0f / sqrtf(wave_sum(s) * (1.f / D) + EPS);
                if (m < M) { GAS unsigned long long* o8 = (GAS unsigned long long*)(XN + (size_t)m * D) + F.lane; if (F.lane == 0) RS0[m] = rstd;
#pragma unroll
                    for (int j = 0; j < 4; ++j) { const f32x4 t = v[r][j]; o8[64 * j] = (unsigned long long)pk2(t.x, t.y) | ((unsigned long long)pk2(t.z, t.w) << 32); } } } } }
}

namespace att {
typedef short bf16x8 __attribute__((ext_vector_type(8)));
typedef short v4i16 __attribute__((ext_vector_type(4)));
constexpr float LOG2E = 1.4426950408889634f;
constexpr int TABN = 512, TPAD0 = 128;
constexpr int LDS_K = 0, LDS_V = 49152, LDS_T0 = 98304, LDS_T1 = 98304 + 8192;
struct QT { bf16x8 q[2]; f32x4 o[4]; float m, l; };
__device__ __forceinline__ v4i16 vtr(const LAS unsigned char* p) { return __builtin_amdgcn_ds_read_tr16_b64_v4i16((LAS v4i16*)p); }

__device__ __forceinline__ void build_table(Frame& F, int ldsoff, int br, int h) {
    const float* tabBias = (const float*)(F.ws + WS_TAB + TAB_BIAS);
    LAS float* T = (LAS float*)(F.lds + ldsoff);
    for (int e = F.tid; e < 4 * TABN; e += NWAVES * 64) { const int s = e / TABN, n = e % TABN; const int r64 = n + s - TPAD0;
        T[e] = (r64 >= 0 && r64 <= 128) ? tabBias[(br * 129 + r64) * 12 + h] * LOG2E : -INFINITY; }
}
__device__ __forceinline__ const LAS float* table_ptr(Frame& F, int ldsoff, int idx0) { const int s = idx0 & 3; return (const LAS float*)(F.lds + ldsoff) + s * TABN + (idx0 - s); }

__device__ __forceinline__ int pass_tok(int mode, int a, int row) {
    if (mode == 0) { const int t = a - 64 + row; return (t >= 0 && t < SEQ) ? t : -1; }
    if (mode == 3) return a + 16 * row;
    const int hi = row >= 192 ? 1 : 0, u = a + (hi ? row - 192 : row), c = 2 * (mode - 1) + hi; return (u >= 0 && u < SEQ / 4) ? c + 4 * u : -1;
}
struct Pre { v4u k[6], v[6]; };
template <int NIT> __device__ __forceinline__ void prefetch(Frame& F, Pre& R, const bf16* P, int h, int mode, int a) {
#pragma unroll
    for (int it = 0; it < NIT; ++it) { const int idx = F.tid + it * (NWAVES * 64), row = idx >> 3, ph = idx & 7; const int t = pass_tok(mode, a, row);
        const int ck = ph ^ ((row >> 1) & 7), cv = ph ^ (((row >> 1) & 3) << 1);
        R.k[it] = (v4u){0u, 0u, 0u, 0u}; R.v[it] = (v4u){0u, 0u, 0u, 0u};
        if (t >= 0) { const bf16* rp = P + (size_t)t * NPROJ + h * 64; R.k[it] = *(const GAS v4u*)(rp + AW + ck * 8); R.v[it] = *(const GAS v4u*)(rp + 2 * AW + cv * 8); } }
}
template <int NIT> __device__ __forceinline__ void commit(Frame& F, const Pre& R) {
#pragma unroll
    for (int it = 0; it < NIT; ++it) { const int idx = F.tid + it * (NWAVES * 64);
        *(LAS v4u*)(F.lds + LDS_K + idx * 16) = R.k[it]; *(LAS v4u*)(F.lds + LDS_V + idx * 16) = R.v[it]; }
}
__device__ __forceinline__ float xmax4(float v) {
    auto a = __builtin_amdgcn_permlane16_swap(__float_as_uint(v), __float_as_uint(v), false, false); v = fmaxf(__uint_as_float(a[0]), __uint_as_float(a[1]));
    auto b = __builtin_amdgcn_permlane32_swap(__float_as_uint(v), __float_as_uint(v), false, false); return fmaxf(__uint_as_float(b[0]), __uint_as_float(b[1]));
}
__device__ __forceinline__ float xsum4(float v) {
    auto a = __builtin_amdgcn_permlane16_swap(__float_as_uint(v), __float_as_uint(v), false, false); v = __uint_as_float(a[0]) + __uint_as_float(a[1]);
    auto b = __builtin_amdgcn_permlane32_swap(__float_as_uint(v), __float_as_uint(v), false, false); return __uint_as_float(b[0]) + __uint_as_float(b[1]);
}
__device__ __forceinline__ void load_q(QT& T, const bf16* qrow  , int g) {
#pragma unroll
    for (int ks = 0; ks < 2; ++ks) { const v4u w = *(const GAS v4u*)(qrow + 8 * g + 32 * ks); const float sc = 0.125f * LOG2E; v4u o;
        o.x = pk2(bflo(w.x) * sc, bfhi(w.x) * sc); o.y = pk2(bflo(w.y) * sc, bfhi(w.y) * sc); o.z = pk2(bflo(w.z) * sc, bfhi(w.z) * sc); o.w = pk2(bflo(w.w) * sc, bfhi(w.w) * sc);
        T.q[ks] = __builtin_bit_cast(bf16x8, o); }
#pragma unroll
    for (int db = 0; db < 4; ++db) T.o[db] = (f32x4){0.f, 0.f, 0.f, 0.f};
    T.m = -1e30f; T.l = 0.f;
}
typedef float f32x2_t __attribute__((ext_vector_type(2))); typedef __bf16 bf16x2_t __attribute__((ext_vector_type(2)));
__device__ __forceinline__ unsigned cvtpk(float lo, float hi) { f32x2_t v = {lo, hi}; bf16x2_t b = __builtin_convertvector(v, bf16x2_t); return __builtin_bit_cast(unsigned, b); }
constexpr float THR = 8.0f;
template <int NQ, int NP> __device__ __forceinline__ void attn_step(QT (&T)[NQ], const LAS unsigned char* kp, const LAS unsigned char* vp, const LAS float* const (&tp)[NQ], int p, int koff0, int koff1, const int (&voff)[4], int klo, int khi, bool edge, int g) {
    bf16x8 kf[NP][4]; v4i16 vlo[NP][4], vhi[NP][4];
#pragma unroll
    for (int c = 0; c < NP; ++c) { kf[c][0] = *(const LAS bf16x8*)(kp + c * 4096 + koff0); kf[c][1] = *(const LAS bf16x8*)(kp + c * 4096 + koff1); kf[c][2] = *(const LAS bf16x8*)(kp + c * 4096 + 2048 + koff0); kf[c][3] = *(const LAS bf16x8*)(kp + c * 4096 + 2048 + koff1);
#pragma unroll
        for (int db = 0; db < 4; ++db) { vlo[c][db] = vtr(vp + c * 4096 + voff[db]); vhi[c][db] = vtr(vp + c * 4096 + 2048 + voff[db]); } }
#pragma unroll
    for (int n = 0; n < NQ; ++n) {
        f32x4 s[NP][2];
#pragma unroll
        for (int c = 0; c < NP; ++c) {
            s[c][0] = *(const LAS f32x4*)(tp[n] + (p + c) * 32); s[c][1] = *(const LAS f32x4*)(tp[n] + (p + c) * 32 + 16);
            s[c][0] = __builtin_amdgcn_mfma_f32_16x16x32_bf16(kf[c][0], T[n].q[0], s[c][0], 0, 0, 0); s[c][0] = __builtin_amdgcn_mfma_f32_16x16x32_bf16(kf[c][1], T[n].q[1], s[c][0], 0, 0, 0);
            s[c][1] = __builtin_amdgcn_mfma_f32_16x16x32_bf16(kf[c][2], T[n].q[0], s[c][1], 0, 0, 0); s[c][1] = __builtin_amdgcn_mfma_f32_16x16x32_bf16(kf[c][3], T[n].q[1], s[c][1], 0, 0, 0);
            if (edge) { const int kk = (p + c) * 32 + 4 * g;
#pragma unroll
                for (int r = 0; r < 4; ++r) { if (kk + r < klo || kk + r >= khi) s[c][0][r] = -INFINITY; if (kk + 16 + r < klo || kk + 16 + r >= khi) s[c][1][r] = -INFINITY; } } }
        float tm = fmaxf(fmaxf(fmaxf(s[0][0][0], s[0][0][1]), fmaxf(s[0][0][2], s[0][0][3])), fmaxf(fmaxf(s[0][1][0], s[0][1][1]), fmaxf(s[0][1][2], s[0][1][3])));
        if (NP == 2) tm = fmaxf(tm, fmaxf(fmaxf(fmaxf(s[NP - 1][0][0], s[NP - 1][0][1]), fmaxf(s[NP - 1][0][2], s[NP - 1][0][3])), fmaxf(fmaxf(s[NP - 1][1][0], s[NP - 1][1][1]), fmaxf(s[NP - 1][1][2], s[NP - 1][1][3]))));
        tm = xmax4(tm);
        if (__any(tm > T[n].m + THR)) { const float mn = fmaxf(T[n].m, tm), al = __builtin_amdgcn_exp2f(T[n].m - mn); T[n].m = mn; T[n].l *= al;
#pragma unroll
            for (int db = 0; db < 4; ++db) T[n].o[db] = T[n].o[db] * al; }
        const float mref = T[n].m; float ls = 0.f;
#pragma unroll
        for (int c = 0; c < NP; ++c) {
#pragma unroll
            for (int r = 0; r < 4; ++r) { s[c][0][r] = __builtin_amdgcn_exp2f(s[c][0][r] - mref); s[c][1][r] = __builtin_amdgcn_exp2f(s[c][1][r] - mref); }
            ls += ((s[c][0][0] + s[c][0][1]) + (s[c][0][2] + s[c][0][3])) + ((s[c][1][0] + s[c][1][1]) + (s[c][1][2] + s[c][1][3])); }
        T[n].l += ls;
#pragma unroll
        for (int c = 0; c < NP; ++c) {
            v4u pw; pw.x = cvtpk(s[c][0][0], s[c][0][1]); pw.y = cvtpk(s[c][0][2], s[c][0][3]); pw.z = cvtpk(s[c][1][0], s[c][1][1]); pw.w = cvtpk(s[c][1][2], s[c][1][3]);
            const bf16x8 pf = __builtin_bit_cast(bf16x8, pw);
#pragma unroll
            for (int db = 0; db < 4; ++db) { const bf16x8 vf = (bf16x8){vlo[c][db][0], vlo[c][db][1], vlo[c][db][2], vlo[c][db][3], vhi[c][db][0], vhi[c][db][1], vhi[c][db][2], vhi[c][db][3]};
                T[n].o[db] = __builtin_amdgcn_mfma_f32_16x16x32_bf16(vf, pf, T[n].o[db], 0, 0, 0); } }
    }
}
template <int NQ> __device__ __forceinline__ void attn_job(QT (&T)[NQ], const LAS unsigned char* Kw, const LAS unsigned char* Vw, int npairs, const LAS float* const (&tp)[NQ], int klo, int khi, bool edge, int lane) {
    const int i = lane & 15, g = lane >> 4;
    const int koff0 = i * 128 + (((g) ^ (i >> 1)) << 4), koff1 = i * 128 + (((g + 4) ^ (i >> 1)) << 4);
    const int qq = i >> 2, pp = i & 3, vr = 4 * g + qq, fv = (vr >> 1) & 3;
    int voff[4];
#pragma unroll
    for (int db = 0; db < 4; ++db) voff[db] = vr * 128 + ((((db ^ fv) << 1) + (pp >> 1)) << 4) + (pp & 1) * 8;
    int p = 0;
    if (NQ == 1) {
#pragma unroll 1
        for (; p + 2 <= npairs; p += 2) attn_step<NQ, 2>(T, Kw + p * 4096, Vw + p * 4096, tp, p, koff0, koff1, voff, klo, khi, edge, g);
    }
#pragma unroll 1
    for (; p < npairs; ++p) attn_step<NQ, 1>(T, Kw + p * 4096, Vw + p * 4096, tp, p, koff0, koff1, voff, klo, khi, edge, g);
}
__device__ __forceinline__ void four_ssq(Frame& F) {
    const bf16* A2 = (const bf16*)(F.ws + WS_A2); float* SSA = (float*)(F.ws + WS_SSA);
    const int gw = F.vcu * NWAVES + F.wave, NGW = F.G * NWAVES;
    for (int m0 = gw; m0 < M; m0 += 4 * NGW) { v2u w[4];
#pragma unroll
        for (int r = 0; r < 4; ++r) { const int m = (m0 + r * NGW) < M ? (m0 + r * NGW) : 0; w[r] = *(const GAS v2u*)(A2 + (size_t)m * MIXW + AW + 4 * F.lane); }
#pragma unroll
        for (int r = 0; r < 4; ++r) { const int m = m0 + r * NGW; const float a = bflo(w[r].x), b2 = bfhi(w[r].x), c = bflo(w[r].y), d = bfhi(w[r].y);
            const float s = wave_sum((a * a + b2 * b2) + (c * c + d * d));
            if (m < M && F.lane == 0) *(GAS f32x4*)(SSA + (size_t)m * 16 + 12) = (f32x4){s, 0.f, 0.f, 0.f}; } }
}
__device__ __forceinline__ void phase_local(Frame& F) {
    constexpr int NU = BATCH * NH * 16; const int per = (NU + F.G - 1) / F.G, ub = F.vcu * per, ue = (ub + per) < NU ? (ub + per) : NU;
    const bf16* PROJ = (const bf16*)(F.ws + WS_PROJ); const int lane = F.lane, w = F.wave, i = lane & 15, g = lane >> 4;
    const int idx4 = w >> 1, rA = w & 1, rB = 2 + (w & 1);
    Pre R; int hprev = -1;
    __syncthreads();
    if (ub < ue) { const int bh = ub >> 4; prefetch<6>(F, R, PROJ + (size_t)(bh / NH) * SEQ * NPROJ, bh % NH, 0, (ub & 15) * 256); }
    for (int u = ub; u < ue; ++u) {
        const int bh = u >> 4, b = bh / NH, h = bh % NH, s0 = (u & 15) * 256;
        const bf16* P = PROJ + (size_t)b * SEQ * NPROJ; bf16* A2 = (bf16*)(F.ws + WS_A2) + (size_t)b * SEQ * MIXW; float* ML = (float*)(F.ws + WS_ML) + (size_t)b * SEQ * NH * 2;
        __syncthreads();
        commit<6>(F, R);
        if (h != hprev) { build_table(F, LDS_T0, 0, h); build_table(F, LDS_T1, 1, h); hprev = h; }
        __syncthreads();
        const int u0 = s0 / 4 - 64;
        QT T[2];
        const int tokA = s0 + rA + 4 * (16 * idx4 + i), tokB = s0 + rB + 4 * (16 * idx4 + i);
        load_q(T[0], P + (size_t)tokA * NPROJ + h * 64, g); load_q(T[1], P + (size_t)tokB * NPROJ + h * 64, g);
        asm volatile("" ::: "memory");
        prefetch<6>(F, R, P, h, 1, u0);
        {
            const LAS float* tp[2] = { table_ptr(F, LDS_T0, 4 * g - 4 * i - rA + TPAD0), table_ptr(F, LDS_T0, 4 * g - 4 * i - rB + TPAD0) };
            int klo = 64 - s0 - 64 * idx4; klo = klo > 0 ? klo : 0; int khi = SEQ + 64 - s0 - 64 * idx4; khi = khi < 192 ? khi : 192;
            attn_job<2>(T, F.lds + LDS_K + 64 * idx4 * 128, F.lds + LDS_V + 64 * idx4 * 128, 6, tp, klo, khi, (klo > 0 || khi < 192), lane);
        }
#pragma unroll
        for (int pass = 0; pass < 2; ++pass) {
            __syncthreads();
            commit<6>(F, R);
            __syncthreads();
            if (pass == 0) prefetch<6>(F, R, P, h, 2, u0);
            else if (u + 1 < ue) { const int bh2 = (u + 1) >> 4; prefetch<6>(F, R, PROJ + (size_t)(bh2 / NH) * SEQ * NPROJ, bh2 % NH, 0, ((u + 1) & 15) * 256); }
            const int cl = w & 1, lo = idx4 < 2 ? idx4 : 2;
            const LAS float* tp[1] = { table_ptr(F, LDS_T1, 4 * g - i + 16 * (lo - idx4) + TPAD0) };
            int klo = -(u0 + 16 * lo); klo = klo > 0 ? klo : 0; int khi = SEQ / 4 - (u0 + 16 * lo); khi = khi < 160 ? khi : 160;
            QT (&Tp)[1] = *(QT (*)[1])(&T[pass]);
            attn_job<1>(Tp, F.lds + LDS_K + (192 * cl + 16 * lo) * 128, F.lds + LDS_V + (192 * cl + 16 * lo) * 128, 5, tp, klo, khi, (klo > 0 || khi < 160), lane);
        }
#pragma unroll
        for (int n = 0; n < 2; ++n) {
            const float l = xsum4(T[n].l); const float inv = 1.0f / l; const int tok = n == 0 ? tokA : tokB;
#pragma unroll
            for (int db = 0; db < 4; ++db) { v2u o; o.x = pk2(T[n].o[db][0] * inv, T[n].o[db][1] * inv); o.y = pk2(T[n].o[db][2] * inv, T[n].o[db][3] * inv);
                *(GAS v2u*)(A2 + (size_t)tok * MIXW + h * 64 + 16 * db + 4 * g) = o; }
            if (g == 0) { float* mlp = ML + ((size_t)tok * NH + h) * 2; mlp[0] = T[n].m; mlp[1] = l; }
        }
    }
    __syncthreads();
}
__device__ __forceinline__ void phase_class(Frame& F) {
    four_ssq(F);
    constexpr int NU = BATCH * NH * 16; const int per = (NU + F.G - 1) / F.G, ub = F.vcu * per, ue = (ub + per) < NU ? (ub + per) : NU;
    const bf16* PROJ = (const bf16*)(F.ws + WS_PROJ); const int lane = F.lane, w = F.wave, i = lane & 15, g = lane >> 4; float* SSA = (float*)(F.ws + WS_SSA);
    Pre R; int hprev = -1;
    __syncthreads();
    if (ub < ue) { const int bh = ub >> 4; prefetch<4>(F, R, PROJ + (size_t)(bh / NH) * SEQ * NPROJ, bh % NH, 3, ub & 15); }
    for (int u = ub; u < ue; ++u) {
        const int bh = u >> 4, b = bh / NH, h = bh % NH, r = u & 15;
        const bf16* P = PROJ + (size_t)b * SEQ * NPROJ; bf16* A2 = (bf16*)(F.ws + WS_A2) + (size_t)b * SEQ * MIXW; const float* ML = (const float*)(F.ws + WS_ML) + (size_t)b * SEQ * NH * 2;
        __syncthreads();
        commit<4>(F, R);
        if (h != hprev) { build_table(F, LDS_T0, 2, h); hprev = h; }
        __syncthreads();
        QT T2[2]; float mlv[2], llv[2]; v2u pvv[2][4];
#pragma unroll
        for (int n = 0; n < 2; ++n) { const int qt = n == 0 ? (w < 7 ? w : 11) : (w < 4 ? w + 7 : (w < 7 ? w + 8 : 15)); const int tok = r + 16 * (16 * qt + i);
            load_q(T2[n], P + (size_t)tok * NPROJ + h * 64, g);
            const float* mlp = ML + ((size_t)tok * NH + h) * 2; mlv[n] = mlp[0]; llv[n] = mlp[1];
#pragma unroll
            for (int db = 0; db < 4; ++db) pvv[n][db] = *(const GAS v2u*)(A2 + (size_t)tok * MIXW + h * 64 + 16 * db + 4 * g); }
        asm volatile("" ::: "memory");
        if (u + 1 < ue) { const int bh2 = (u + 1) >> 4; prefetch<4>(F, R, PROJ + (size_t)(bh2 / NH) * SEQ * NPROJ, bh2 % NH, 3, (u + 1) & 15); }
#pragma unroll
        for (int n = 0; n < 2; ++n) {
            const int qt = n == 0 ? (w < 7 ? w : 11) : (w < 4 ? w + 7 : (w < 7 ? w + 8 : 15));
            int lo = qt - 4 > 0 ? qt - 4 : 0, hi = qt + 4 < 15 ? qt + 4 : 15; if (((hi - lo + 1) & 1) != 0) { if (hi < 15) ++hi; else --lo; }
            const int tok = r + 16 * (16 * qt + i);
            QT (&T)[1] = *(QT (*)[1])(&T2[n]);
            const LAS float* tp[1] = { table_ptr(F, LDS_T0, 4 * g - i + 16 * (lo - qt) + 64 + TPAD0) };
            attn_job<1>(T, F.lds + LDS_K + 16 * lo * 128, F.lds + LDS_V + 16 * lo * 128, (hi - lo + 1) >> 1, tp, 0, 1 << 20, false, lane);
            const float l16 = xsum4(T[0].l);
            const float ml = mlv[n], ll = llv[n];
            const float mm = fmaxf(ml, T[0].m), a = __builtin_amdgcn_exp2f(ml - mm) * ll, bb = __builtin_amdgcn_exp2f(T[0].m - mm), inv = 1.0f / (a + bb * l16); float sq = 0.f;
#pragma unroll
            for (int db = 0; db < 4; ++db) { GAS v2u* op = (GAS v2u*)(A2 + (size_t)tok * MIXW + h * 64 + 16 * db + 4 * g); const v2u pv = pvv[n][db]; v2u o;
                const float f0 = (bflo(pv.x) * a + T[0].o[db][0] * bb) * inv, f1 = (bfhi(pv.x) * a + T[0].o[db][1] * bb) * inv, f2 = (bflo(pv.y) * a + T[0].o[db][2] * bb) * inv, f3 = (bfhi(pv.y) * a + T[0].o[db][3] * bb) * inv;
                sq += (f0 * f0 + f1 * f1) + (f2 * f2 + f3 * f3); o.x = pk2(f0, f1); o.y = pk2(f2, f3);
                *op = o; }
            sq = xsum4(sq);
            if (g == 0) SSA[((size_t)b * SEQ + tok) * 16 + h] = sq;
        }
    }
    __syncthreads();
}
}


namespace fou {
typedef short bf16x8 __attribute__((ext_vector_type(8)));
typedef short v4i16 __attribute__((ext_vector_type(4)));
constexpr int LX = 0, LC = LDSCTL_OFF + 8192, LS = LDSCTL_OFF + 16384;
__device__ __forceinline__ int gsw(int s2) { const int pr = (s2 >> 1) & 7; return (pr & 4) | ((pr & 1) << 1) | ((pr >> 1) & 1); }
__device__ __forceinline__ int xaddr(int pe, int s2, int chunk) { return LX + pe * 8192 + s2 * 128 + (((chunk ^ gsw(s2) ^ pe) & 7) << 4); }
__device__ __forceinline__ int maddr(int base, int k, int chunk) { return base + k * 128 + (((chunk ^ (k >> 1)) & 7) << 4); }
__device__ __forceinline__ v4i16 vtr(const LAS unsigned char* p) { return __builtin_amdgcn_ds_read_tr16_b64_v4i16((LAS v4i16*)p); }
__device__ __forceinline__ bf16x8 neg8(bf16x8 v) { v4u w = __builtin_bit_cast(v4u, v); w.x ^= 0x80008000u; w.y ^= 0x80008000u; w.z ^= 0x80008000u; w.w ^= 0x80008000u; return __builtin_bit_cast(bf16x8, w); }

__device__ __forceinline__ void fourier_unit(Frame& F, int b, int g, int ec) {
    const bf16* PROJ = (const bf16*)(F.ws + WS_PROJ); bf16* A2 = (bf16*)(F.ws + WS_A2); const float* tabMg = (const float*)(F.ws + WS_TAB + TAB_MG);
    const int lane = F.lane, w = F.wave, li = lane & 15, gq = lane >> 4, e0 = 8 * ec;
    LAS unsigned char* L = F.lds;
    __syncthreads();
    bf16x8 mb[2];
#pragma unroll
    for (int ks = 0; ks < 2; ++ks) { float v[8];
#pragma unroll
        for (int j = 0; j < 8; ++j) { const int c = 8 * gq + j + 32 * ks; const int col = li < 8 ? e0 + li : 64 + e0 + (li & 7); v[j] = tabMg[(g * 64 + c) * 128 + col]; }
        v4u o; o.x = pk2(v[0], v[1]); o.y = pk2(v[2], v[3]); o.z = pk2(v[4], v[5]); o.w = pk2(v[6], v[7]); mb[ks] = __builtin_bit_cast(bf16x8, o); }
    const bf16* ub = PROJ + (size_t)(b * SEQ) * NPROJ + 3 * AW + g * 64 + 8 * gq;
#pragma unroll 8
    for (int it = 0; it < 32; ++it) { const int tile = w + 8 * it, s2 = tile & 63, tq = tile >> 6;
        const bf16* up = ub + (size_t)(64 * (16 * tq + li) + s2) * NPROJ;
        const bf16x8 a0 = __builtin_bit_cast(bf16x8, *(const GAS v4u*)up), a1 = __builtin_bit_cast(bf16x8, *(const GAS v4u*)(up + 32));
        f32x4 d = (f32x4){0.f, 0.f, 0.f, 0.f};
        d = __builtin_amdgcn_mfma_f32_16x16x32_bf16(a0, mb[0], d, 0, 0, 0); d = __builtin_amdgcn_mfma_f32_16x16x32_bf16(a1, mb[1], d, 0, 0, 0);
        v2u o; o.x = pk2(d[0], d[1]); o.y = pk2(d[2], d[3]); *(LAS v2u*)(L + xaddr(li, s2, 2 * tq + (gq >> 1)) + (gq & 1) * 8) = o; }
    __syncthreads();
    const int e = w;
#pragma unroll 1
    for (int mt = 0; mt < 4; ++mt) { const int s2 = 16 * mt + li;
        bf16x8 yr[2], yi[2], nyr[2];
#pragma unroll
        for (int kh = 0; kh < 2; ++kh) { yr[kh] = *(const LAS bf16x8*)(L + xaddr(e, s2, gq + 4 * kh)); yi[kh] = *(const LAS bf16x8*)(L + xaddr(8 + e, s2, gq + 4 * kh)); nyr[kh] = neg8(yr[kh]); }
#pragma unroll
        for (int nt = 0; nt < 4; ++nt) { const int k = 16 * nt + li;
            const bf16x8 c0 = *(const LAS bf16x8*)(L + maddr(LC, k, gq)), c1 = *(const LAS bf16x8*)(L + maddr(LC, k, gq + 4)), s0 = *(const LAS bf16x8*)(L + maddr(LS, k, gq)), s1 = *(const LAS bf16x8*)(L + maddr(LS, k, gq + 4));
            f32x4 tr = (f32x4){0.f, 0.f, 0.f, 0.f}, ti = (f32x4){0.f, 0.f, 0.f, 0.f};
            tr = __builtin_amdgcn_mfma_f32_16x16x32_bf16(c0, yr[0], tr, 0, 0, 0); tr = __builtin_amdgcn_mfma_f32_16x16x32_bf16(c1, yr[1], tr, 0, 0, 0);
            tr = __builtin_amdgcn_mfma_f32_16x16x32_bf16(s0, yi[0], tr, 0, 0, 0); tr = __builtin_amdgcn_mfma_f32_16x16x32_bf16(s1, yi[1], tr, 0, 0, 0);
            ti = __builtin_amdgcn_mfma_f32_16x16x32_bf16(c0, yi[0], ti, 0, 0, 0); ti = __builtin_amdgcn_mfma_f32_16x16x32_bf16(c1, yi[1], ti, 0, 0, 0);
            ti = __builtin_amdgcn_mfma_f32_16x16x32_bf16(s0, nyr[0], ti, 0, 0, 0); ti = __builtin_amdgcn_mfma_f32_16x16x32_bf16(s1, nyr[1], ti, 0, 0, 0);
            float orr[4], oii[4];
#pragma unroll
            for (int r = 0; r < 4; ++r) { const int k1 = 16 * nt + 4 * gq + r; const float rev = (float)((k1 * s2) & 4095) * (1.0f / 4096.0f); const float cv = __builtin_amdgcn_cosf(rev), sv = __builtin_amdgcn_sinf(rev);
                orr[r] = tr[r] * cv + ti[r] * sv; oii[r] = ti[r] * cv - tr[r] * sv; }
            v2u o; o.x = pk2(orr[0], orr[1]); o.y = pk2(orr[2], orr[3]); *(LAS v2u*)(L + xaddr(e, s2, 2 * nt + (gq >> 1)) + (gq & 1) * 8) = o;
            o.x = pk2(oii[0], oii[1]); o.y = pk2(oii[2], oii[3]); *(LAS v2u*)(L + xaddr(8 + e, s2, 2 * nt + (gq >> 1)) + (gq & 1) * 8) = o; } }
    asm volatile("s_waitcnt lgkmcnt(0)" ::: "memory");
    bf16x8 af[4][4];
    { const int q = li >> 2, p = li & 3;
#pragma unroll
      for (int mt = 0; mt < 4; ++mt)
#pragma unroll
        for (int ks = 0; ks < 4; ++ks) { const int pe = (ks >> 1) * 8 + e, s2b = 8 * gq + 32 * (ks & 1) + q;
            const v4i16 lo = vtr(L + xaddr(pe, s2b, 2 * mt + (p >> 1)) + (p & 1) * 8), hi = vtr(L + xaddr(pe, s2b + 4, 2 * mt + (p >> 1)) + (p & 1) * 8);
            af[mt][ks] = (bf16x8){lo[0], lo[1], lo[2], lo[3], hi[0], hi[1], hi[2], hi[3]}; } }
    asm volatile("s_waitcnt lgkmcnt(0)" ::: "memory");
    __syncthreads();
    const float bias = F.f_b[g * 64 + e0 + e];
#pragma unroll 1
    for (int nt = 0; nt < 4; ++nt) { const int k2 = 16 * nt + li;
        const bf16x8 c0 = *(const LAS bf16x8*)(L + maddr(LC, k2, gq)), c1 = *(const LAS bf16x8*)(L + maddr(LC, k2, gq + 4)), s0 = *(const LAS bf16x8*)(L + maddr(LS, k2, gq)), s1 = *(const LAS bf16x8*)(L + maddr(LS, k2, gq + 4));
#pragma unroll
        for (int mt = 0; mt < 4; ++mt) { f32x4 d = (f32x4){0.f, 0.f, 0.f, 0.f};
            d = __builtin_amdgcn_mfma_f32_16x16x32_bf16(af[mt][0], c0, d, 0, 0, 0); d = __builtin_amdgcn_mfma_f32_16x16x32_bf16(af[mt][1], c1, d, 0, 0, 0);
            d = __builtin_amdgcn_mfma_f32_16x16x32_bf16(af[mt][2], s0, d, 0, 0, 0); d = __builtin_amdgcn_mfma_f32_16x16x32_bf16(af[mt][3], s1, d, 0, 0, 0);
#pragma unroll
            for (int r = 0; r < 4; ++r) { const int k1 = 16 * mt + 4 * gq + r; *(LAS bf16*)(L + LX + (k1 * 64 + k2) * 16 + e * 2) = (bf16)f2bf(d[r] * (1.0f / 512.0f) + bias); } } }
    __syncthreads();
    bf16* ob = A2 + (size_t)(b * SEQ) * MIXW + AW + g * 64 + e0;
#pragma unroll
    for (int j = 0; j < 8; ++j) { const int sl = F.tid + 512 * j, k1 = sl >> 6, k2 = sl & 63; const v4u v = *(const LAS v4u*)(L + LX + sl * 16); *(GAS v4u*)(ob + (size_t)(k1 + 64 * k2) * MIXW) = v; }
}
__device__ __forceinline__ void phase_fourier(Frame& F) {
    const float* tabTw = (const float*)(F.ws + WS_TAB + TAB_TW);
    __syncthreads();
    for (int idx = F.tid; idx < 4096; idx += NWAVES * 64) { const int k = idx >> 6, s = idx & 63, n = ((k * s) & 63) * 64;
        *(LAS bf16*)(F.lds + maddr(LC, k, s >> 3) + (s & 7) * 2) = (bf16)f2bf(tabTw[2 * n]); *(LAS bf16*)(F.lds + maddr(LS, k, s >> 3) + (s & 7) * 2) = (bf16)f2bf(tabTw[2 * n + 1]); }
    __syncthreads();
    for (int u = F.vcu; u < BATCH * NG * 8; u += F.G) fourier_unit(F, u >> 5, (u >> 3) & 3, u & 7);
    __syncthreads();
}
}

__device__ __forceinline__ void p10_final(Frame& F) {
    const bf16* X2 = (const bf16*)(F.ws + WS_XN); const float* SS2 = (const float*)(F.ws + WS_SS2);
    const int gw = F.vcu * NWAVES + F.wave, NGW = F.G * NWAVES; const int lane = F.lane;
    const GAS f32x4* gr = (const GAS f32x4*)(F.g_fin + 16 * lane); const f32x4 g0 = gr[0], g1 = gr[1], g2 = gr[2], g3 = gr[3];
    for (int m0 = gw; m0 < M; m0 += 4 * NGW) { v4u w0[4], w1[4]; float part[4];
#pragma unroll
        for (int r = 0; r < 4; ++r) { const int m = (m0 + r * NGW) < M ? (m0 + r * NGW) : 0; const GAS v4u* rp = (const GAS v4u*)(X2 + (size_t)m * D + 16 * lane); w0[r] = rp[0]; w1[r] = rp[1];
            part[r] = lane < 16 ? SS2[(size_t)m * 16 + lane] : 0.f; }
#pragma unroll
        for (int r = 0; r < 4; ++r) { const int m = m0 + r * NGW; const float rstd = 1.0f / sqrtf(wave_sum(part[r]) * (1.f / D) + EPS);
            if (m < M) { GAS f32x4* op = (GAS f32x4*)(F.out + (size_t)m * D + 16 * lane);
                op[0] = (f32x4){bflo(w0[r].x), bfhi(w0[r].x), bflo(w0[r].y), bfhi(w0[r].y)} * rstd * g0; op[1] = (f32x4){bflo(w0[r].z), bfhi(w0[r].z), bflo(w0[r].w), bfhi(w0[r].w)} * rstd * g1;
                op[2] = (f32x4){bflo(w1[r].x), bfhi(w1[r].x), bflo(w1[r].y), bfhi(w1[r].y)} * rstd * g2; op[3] = (f32x4){bflo(w1[r].z), bfhi(w1[r].z), bflo(w1[r].w), bfhi(w1[r].w)} * rstd * g3; } } }
}


__device__ __forceinline__ void p8_halo_fix(Frame& F, int pm) {
    const float* H = (const float*)(F.ws + WS_HALO); bf16* ACT = (bf16*)(F.ws + WS_GV); const int kt = pm & 15;
    for (int it = F.tid; it < 2 * (FF / 4); it += NWAVES * 64) { const int c4 = (it % (FF / 4)) * 4, side = it / (FF / 4);
        if ((side == 0 && kt == 0) || (side == 1 && kt == 15)) continue;
        const float* own = H + (size_t)(pm * 2 + side) * 3 * FF + c4; const float* nb = H + (size_t)((side == 0 ? (pm - 1) * 2 + 1 : (pm + 1) * 2)) * 3 * FF + c4;
        const f32x4 gn = *(const GAS f32x4*)nb, zp = *(const GAS f32x4*)(own + FF), vv = *(const GAS f32x4*)(own + 2 * FF), wt = *(const GAS f32x4*)(F.conv_w + (side == 0 ? 0 : 2 * FF) + c4);
        float a[4];
#pragma unroll
        for (int i = 0; i < 4; ++i) { const float z = zp[i] + wt[i] * gn[i]; a[i] = z * __builtin_amdgcn_rcpf(1.0f + __builtin_amdgcn_exp2f(-1.4426950408889634f * z)) * vv[i]; }
        const unsigned long long o = (unsigned long long)pk2(a[0], a[1]) | ((unsigned long long)pk2(a[2], a[3]) << 32);
        __hip_atomic_store((unsigned long long*)(ACT + (size_t)(pm * 256 + (side ? 255 : 0)) * FF + c4), o, __ATOMIC_RELAXED, __HIP_MEMORY_SCOPE_AGENT); }
}


__device__ __forceinline__ void p6_quant(Frame& F) {
    const bf16* X1 = (const bf16*)(F.ws + WS_XN); unsigned char* A8 = F.ws + WS_A8; float* SROW = (float*)(F.ws + WS_SS1); const unsigned* cmax = (const unsigned*)(F.ctl + CW_CMAX);
    const int gw = F.vcu * NWAVES + F.wave, NGW = F.G * NWAVES, lane = F.lane;
    {   LAS float* scr = (LAS float*)(F.lds + RING_OFF + F.wave * 16384); constexpr int I_G = (D / 64) * (FF / 32);
        for (int it = gw; it < 2 * I_G; it += NGW) { const bool isv = it >= I_G; p6_quant_item(isv ? F.w_val : F.w_gate, D, FF, F.ws + WS_WGV, isv ? 128 : 0, scr, isv ? it - I_G : it, lane, F.g_ffn, cmax); } }
    {   float* cw6 = (float*)(F.ws + WS_TAB + TAB_CW4); const int gt = F.vcu * (NWAVES * 64) + F.tid, NGT = F.G * NWAVES * 64;
        for (int i = gt; i < (FF / 128) * 768; i += NGT) { const int pn = i / 768, k = (i % 768) >> 7, c = i & 127, ch = 128 * pn + c;
            cw6[i] = k < 3 ? F.conv_w[k * FF + ch] : (k == 3 ? F.conv_b[ch] : __uint_as_float(cmax[256 * pn + (k == 5 ? 128 : 0) + c]) * (1.0f / 127.0f)); } }
    for (int m0 = gw; m0 < M; m0 += 4 * NGW) { v4u w0[4], w1[4];
#pragma unroll
        for (int r = 0; r < 4; ++r) { const int m = (m0 + r * NGW) < M ? (m0 + r * NGW) : 0; const GAS v4u* rp = (const GAS v4u*)(X1 + (size_t)m * D + 16 * lane); w0[r] = rp[0]; w1[r] = rp[1]; }
#pragma unroll
        for (int r = 0; r < 4; ++r) { const int m = m0 + r * NGW; float v[16];
            v[0] = bflo(w0[r].x); v[1] = bfhi(w0[r].x); v[2] = bflo(w0[r].y); v[3] = bfhi(w0[r].y); v[4] = bflo(w0[r].z); v[5] = bfhi(w0[r].z); v[6] = bflo(w0[r].w); v[7] = bfhi(w0[r].w);
            v[8] = bflo(w1[r].x); v[9] = bfhi(w1[r].x); v[10] = bflo(w1[r].y); v[11] = bfhi(w1[r].y); v[12] = bflo(w1[r].z); v[13] = bfhi(w1[r].z); v[14] = bflo(w1[r].w); v[15] = bfhi(w1[r].w);
            float ss = 0.f, mx = 0.f;
#pragma unroll
            for (int i = 0; i < 16; ++i) { ss += v[i] * v[i]; mx = fmaxf(mx, fabsf(v[i])); }
            ss = wave_sum(ss);
#pragma unroll
            for (int o = 1; o < 64; o <<= 1) mx = fmaxf(mx, __shfl_xor(mx, o));
            const float inv = mx > 0.f ? 127.0f / mx : 0.f; unsigned q[4];
#pragma unroll
            for (int j = 0; j < 4; ++j) { q[j] = 0;
#pragma unroll
                for (int t = 0; t < 4; ++t) q[j] |= ((unsigned)(int)__builtin_rintf(v[4 * j + t] * inv) & 255u) << (8 * t); }
            if (m < M) { *(GAS v4u*)(A8 + (size_t)m * D + 16 * lane) = (v4u){q[0], q[1], q[2], q[3]};
                if (lane == 0) SROW[m] = mx * (1.0f / 127.0f) * (1.0f / sqrtf(ss * (1.f / D) + EPS)); } } }
}

struct Args { const float* in[16]; float* out; unsigned char* ws; int ph_lo, ph_hi; };
__global__ void __launch_bounds__(NWAVES * 64, 2) hymba_fwd(Args args) {
    extern __shared__ __attribute__((aligned(16))) unsigned char lds[];
    Frame F;
    F.lds = (LAS unsigned char*)lds;
    F.MISC = (volatile LAS unsigned*)(F.lds + MISC_OFF);
    F.tid = threadIdx.x; F.lane = F.tid & 63; F.wave = __builtin_amdgcn_readfirstlane(F.tid >> 6);
    F.G = gridDim.x; { const int bx = blockIdx.x; F.vcu = (F.G % 8 == 0) ? (bx % 8) * (F.G / 8) + bx / 8 : bx; }
    F.ws = args.ws; F.ctl = (gu32*)(args.ws + WS_CTL);
    F.x = args.in[0]; F.g_mix = args.in[1]; F.w_in = args.in[2]; F.g_attn = args.in[3]; F.rel_tab = args.in[4]; F.f_w = args.in[5]; F.f_b = args.in[6]; F.g_four = args.in[7];
    F.w_out = args.in[8]; F.g_ffn = args.in[9]; F.w_gate = args.in[10]; F.w_val = args.in[11]; F.conv_w = args.in[12]; F.conv_b = args.in[13]; F.w_down = args.in[14]; F.g_fin = args.in[15];
    F.out = args.out;
    for (int u = F.tid; u < (LDS_BYTES - LDSCTL_OFF) / 4; u += NWAVES * 64) ((LAS unsigned*)(F.lds + LDSCTL_OFF))[u] = 0u;
    __syncthreads();
    XcdBarrier bar; bar.bar = (unsigned*)(F.ctl + CW_BAR); bar.x = 0; bar.st = nullptr;
    if (MK_ONE_LAUNCH) bar = xcd_barrier_post((unsigned*)(F.ctl + CW_BAR), F.MISC + 8);
#define GRID_BAR() do { if (MK_ONE_LAUNCH) xcd_barrier(bar); } while (0)
    const int lo = args.ph_lo, hi = args.ph_hi;
#define IN(k) (lo <= (k) && (k) < hi)
#define BOTH(k) (IN(k) && IN((k) + 1))
    if (IN(0)) { p0_prologue(F); if (BOTH(0)) GRID_BAR(); }
    if (IN(1)) {
        pg8::Gemm g{(const bf16*)(F.ws + WS_XN), (const bf16*)(F.ws + WS_WIN), M, NPROJ, D, D, 0}; pg8::StaticOrder S; S.init(M, NPROJ, F.G, (int)blockIdx.x);
        pg8::EpiBf16Row E{(bf16*)(F.ws + WS_PROJ), NPROJ, (const float*)(F.ws + WS_RS0)};
        pg8::gemm_phase<pg8::EpiBf16Row, pg8::StaticOrder, true, true>(F.lds + RING_OFF, g, S, E);
        if (BOTH(1)) GRID_BAR();
    }
    if (IN(2)) { att::phase_local(F); fou::phase_fourier(F); if (BOTH(2)) GRID_BAR(); }
    if (IN(3)) { att::phase_class(F); if (IN(3) && IN(5)) GRID_BAR(); }
    if (IN(5)) {
        pg8::Gemm g{(const bf16*)(F.ws + WS_A2), (const bf16*)(F.ws + WS_WOUT), M, D, MIXW, MIXW, 0}; pg8::StaticOrder S; S.init(M, D, F.G, (int)blockIdx.x);
        pg8::EpiX1N E{(const bf16*)(F.ws + WS_XN), (bf16*)(F.ws + WS_XN), D, (float*)(F.ws + WS_SS1), (const float*)(F.ws + WS_SSA), (LAS float*)(F.lds + LDSCTL_OFF + 8192)};
        pg8::gemm_phase<pg8::EpiX1N, pg8::StaticOrder, true, true>(F.lds + RING_OFF, g, S, E);
        if (IN(5) && IN(6)) GRID_BAR();
    }
    if (IN(6)) { p6_quant(F); if (IN(6) && IN(7)) GRID_BAR(); }
    if (IN(7)) {
        pg8::Gemm g{(const bf16*)(F.ws + WS_A8), (const bf16*)(F.ws + WS_WGV), M, 2 * FF, D / 2, D / 2, 0}; pg8::StaticOrder S; S.init(M, 2 * FF, F.G, (int)blockIdx.x);
        pg8::EpiConvGlu E{(bf16*)(F.ws + WS_GV), FF, (const float*)(F.ws + WS_SS1), F.conv_w, F.conv_b, (LAS float*)(F.lds + LDSCTL_OFF + 4096), M, (float*)(F.ws + WS_HALO), (const float*)(F.ws + WS_TAB + TAB_CW4)};
        pg8::gemm_phase<pg8::EpiConvGlu, pg8::StaticOrder, true, true, true>(F.lds + RING_OFF, g, S, E);
        if (IN(7) && IN(9)) GRID_BAR();
    }
    if (IN(9)) {
        pg8::Gemm g{(const bf16*)(F.ws + WS_GV), (const bf16*)(F.ws + WS_WD), M, D, FF, FF, 0}; pg8::StaticOrder S; S.init(M, D, F.G, (int)blockIdx.x);
        { pg8::Unit uu; for (int i = 0; S.next(i, uu); ++i) p8_halo_fix(F, uu.pm); }
        asm volatile("s_waitcnt vmcnt(0)" ::: "memory"); __syncthreads();
        if (F.G == 256) {
            pg8::EpiFinal E{(const bf16*)(F.ws + WS_XN), F.out, D, F.g_fin, (float*)(F.ws + WS_XBUF), (unsigned*)(F.ctl + CW_PANEL), F.lds + LDSCTL_OFF + 4096};
            pg8::gemm_phase<pg8::EpiFinal, pg8::StaticOrder, true, true>(F.lds + RING_OFF, g, S, E);
        } else {
            pg8::EpiX2 E{(bf16*)(F.ws + WS_XN), D, (float*)(F.ws + WS_SS2)};
            pg8::gemm_phase<pg8::EpiX2, pg8::StaticOrder, true, true>(F.lds + RING_OFF, g, S, E);
            if (BOTH(9)) GRID_BAR();
        }
    }
    if (IN(10) && F.G != 256) { p10_final(F); }
#undef IN
#undef BOTH
}

extern "C" void kernel_launch(void* const* d_in, const int* in_sizes, int n_in, void* d_out, int out_size, void* d_ws, size_t ws_size, hipStream_t stream) {
    static int grid = 0;
    if (grid == 0) {
        if (n_in != 16 || in_sizes[0] != M * D || out_size != M * D || ws_size < WS_END) { fprintf(stderr, "kernel_launch: shape/workspace mismatch: n_in %d in0 %d out %d ws %zu (need %zu)\n", n_in, n_in > 0 ? in_sizes[0] : -1, out_size, ws_size, (size_t)WS_END); grid = -1; return; }
        int dev = 0, cus = 0, per_cu = 0;
        if (hipGetDevice(&dev) != hipSuccess || hipDeviceGetAttribute(&cus, hipDeviceAttributeMultiprocessorCount, dev) != hipSuccess) { grid = -1; return; }
        if (hipFuncSetAttribute((const void*)hymba_fwd, hipFuncAttributeMaxDynamicSharedMemorySize, LDS_BYTES) != hipSuccess) { fprintf(stderr, "kernel_launch: hipFuncSetAttribute failed\n"); grid = -1; return; }
        if (hipOccupancyMaxActiveBlocksPerMultiprocessor(&per_cu, (const void*)hymba_fwd, NWAVES * 64, LDS_BYTES) != hipSuccess || per_cu < 1) { fprintf(stderr, "kernel_launch: occupancy query says %d blocks/CU\n", per_cu); (void)hipGetLastError(); grid = -1; return; }
        grid = cus;
    }
    if (grid < 0) return;
    (void)hipMemsetAsync((char*)d_ws + WS_CTL, 0, CTL_ZERO_BYTES, stream);
    Args a{};
    for (int i = 0; i < 16; ++i) a.in[i] = (const float*)d_in[i];
    a.out = (float*)d_out; a.ws = (unsigned char*)d_ws;
#if MK_ONE_LAUNCH
    a.ph_lo = 0; a.ph_hi = N_PHASES;
    hipLaunchKernelGGL(hymba_fwd, dim3(grid), dim3(NWAVES * 64), LDS_BYTES, stream, a);
#else
    for (int p = 0; p < N_PHASES; ++p) { a.ph_lo = p; a.ph_hi = p + 1; hipLaunchKernelGGL(hymba_fwd, dim3(grid), dim3(NWAVES * 64), LDS_BYTES, stream, a); }
#endif
}
```

```cpp
#include <hip/hip_runtime.h>
#include <cstdio>
#include <cstdint>

namespace pg8 {
#define PG8_LAS __attribute__((address_space(3)))
typedef unsigned short bf16_t;
typedef short bf16x8 __attribute__((ext_vector_type(8)));
typedef float f32x4 __attribute__((ext_vector_type(4)));
typedef unsigned u32x4 __attribute__((ext_vector_type(4)));
typedef int i32x4 __attribute__((ext_vector_type(4)));
template <bool I8> struct AccT { typedef f32x4 type; };
template <> struct AccT<true> { typedef i32x4 type; };
constexpr int BM = 256, BK = 64, HALF = 128, HTB = HALF * BK * 2, STAGE_BYTES = 8 * HTB, NXCD = 8, WGM = 8;

__host__ __device__ __forceinline__ int lds_byte(int r, int c) { const int st = (r >> 4) * 2 + (c >> 5), rr = r & 15, cc = c & 31, ob = rr * 64 + cc * 2; return st * 1024 + (ob ^ (((ob >> 9) & 1) << 5)); }
__host__ __device__ __forceinline__ void stage_rc(int b, int& R, int& C) { const int st = b / 1024, sb = b % 1024, swz = sb ^ (((sb >> 9) & 1) << 5); R = (st >> 1) * 16 + swz / 64; C = (st & 1) * 32 + (swz % 64) / 2; }
__host__ __device__ __forceinline__ int perm32(int rho) { const int n = rho >> 4, i = rho & 15; return 8 * (i >> 2) + 4 * n + (i & 3); }

struct Unit { int pm, pn; };
struct Gemm { const bf16_t* A; const bf16_t* Bt; int M, N, K, lda; int ovl; };
__host__ __device__ __forceinline__ int ovl_row_base(int pm) { const int b = pm / 17, k = pm - 17 * b; return b * 4096 + (k ? 254 * k - 1 : 0); }

struct StaticOrder {
    int nM, nN, nwg, G, c;
    __host__ __device__ void init(int M, int N, int G_, int c_) { nM = M / BM; nN = N / BM; nwg = nM * nN; G = G_; c = c_; }
    __host__ __device__ bool next(int i, Unit& u) const {
        const long L = (long)i * G + c; if (L >= nwg) return false;
        int wgid = (int)L; { const int q = nwg / NXCD, r = nwg % NXCD, xcd = wgid % NXCD, off = wgid / NXCD; wgid = (xcd < r ? xcd * (q + 1) : r * (q + 1) + (xcd - r) * q) + off; }
        const int nig = WGM * nN, gid = wgid / nig, fm = gid * WGM, gsz = (nM - fm) < WGM ? (nM - fm) : WGM;
        u.pm = fm + ((wgid % nig) % gsz); u.pn = (wgid % nig) / gsz; return true;
    }
    __device__ __forceinline__ void a_ready(const Unit&) const {}
    __device__ __forceinline__ void done(const Unit&) const {}
};

typedef float f32x2v_t __attribute__((ext_vector_type(2))); typedef __bf16 bf16x2v_t __attribute__((ext_vector_type(2)));
__device__ __forceinline__ unsigned cvt_pk_bf16(float lo, float hi) { f32x2v_t v = {lo, hi}; bf16x2v_t b = __builtin_convertvector(v, bf16x2v_t); return __builtin_bit_cast(unsigned, b); }

struct EpiBf16 {
    static constexpr bool PERM = true, AFTER_DRAIN = false, MIDK = false, PREFETCH = false;
    bf16_t* O; int ldc;
    __device__ __forceinline__ void operator()(const f32x4 (&acc)[2][2][4][2], const Unit& u, int wr, int wc, int fr, int fq) const {
        const int row0 = u.pm * BM + wr * 64 + fr; const int col0 = u.pn * BM + wc * 32 + 8 * fq;
#pragma unroll
        for (int ai = 0; ai < 2; ++ai)
#pragma unroll
            for (int m = 0; m < 4; ++m) { bf16_t* rowp = O + (size_t)(row0 + ai * HALF + m * 16) * ldc + col0;
#pragma unroll
                for (int bj = 0; bj < 2; ++bj) { const f32x4 v0 = acc[ai][bj][m][0], v1 = acc[ai][bj][m][1];
                    u32x4 w; w.x = cvt_pk_bf16(v0[0], v0[1]); w.y = cvt_pk_bf16(v0[2], v0[3]); w.z = cvt_pk_bf16(v1[0], v1[1]); w.w = cvt_pk_bf16(v1[2], v1[3]);
                    *(u32x4*)(rowp + bj * HALF) = w; } }
    }
};

struct EpiBf16Row {
    static constexpr bool PERM = true, AFTER_DRAIN = false, MIDK = false, PREFETCH = false;
    bf16_t* O; int ldc; const float* rs;
    __device__ __forceinline__ void operator()(const f32x4 (&acc)[2][2][4][2], const Unit& u, int wr, int wc, int fr, int fq) const {
        const int row0 = u.pm * BM + wr * 64 + fr; const int col0 = u.pn * BM + wc * 32 + 8 * fq;
#pragma unroll
        for (int ai = 0; ai < 2; ++ai)
#pragma unroll
            for (int m = 0; m < 4; ++m) { const int row = row0 + ai * HALF + m * 16; const float r = rs[row]; bf16_t* rowp = O + (size_t)row * ldc + col0;
#pragma unroll
                for (int bj = 0; bj < 2; ++bj) { const f32x4 v0 = acc[ai][bj][m][0] * r, v1 = acc[ai][bj][m][1] * r;
                    u32x4 w; w.x = cvt_pk_bf16(v0[0], v0[1]); w.y = cvt_pk_bf16(v0[2], v0[3]); w.z = cvt_pk_bf16(v1[0], v1[1]); w.w = cvt_pk_bf16(v1[2], v1[3]);
                    *(u32x4*)(rowp + bj * HALF) = w; } }
    }
};
struct EpiResF32 {
    static constexpr bool PERM = false, AFTER_DRAIN = false, MIDK = false, PREFETCH = false;
    const float* base; float* out; int ldc;
    __device__ __forceinline__ void operator()(const f32x4 (&acc)[2][2][4][2], const Unit& u, int wr, int wc, int fr, int fq) const {
        const int col0 = u.pn * BM + wc * 32 + 4 * fq;
#pragma unroll
        for (int ai = 0; ai < 2; ++ai)
#pragma unroll
            for (int m = 0; m < 4; ++m) { const int r = u.pm * BM + ai * HALF + wr * 64 + m * 16 + fr; const size_t off = (size_t)r * ldc + col0;
#pragma unroll
                for (int bj = 0; bj < 2; ++bj)
#pragma unroll
                    for (int n = 0; n < 2; ++n) { const f32x4 bs = *(const f32x4*)(base + off + bj * HALF + n * 16); *(f32x4*)(out + off + bj * HALF + n * 16) = bs + acc[ai][bj][m][n]; } }
    }
};


struct EpiX1 {
    static constexpr bool PERM = true, AFTER_DRAIN = false, MIDK = false, PREFETCH = false;
    const float* base; bf16_t* O; int ldc; float* ss;
    __device__ __forceinline__ void operator()(const f32x4 (&acc)[2][2][4][2], const Unit& u, int wr, int wc, int fr, int fq) const {
        const int row0 = u.pm * BM + wr * 64 + fr; const int col0 = u.pn * BM + wc * 32 + 8 * fq;
#pragma unroll
        for (int ai = 0; ai < 2; ++ai)
#pragma unroll
            for (int m = 0; m < 4; ++m) { const int row = row0 + ai * HALF + m * 16; const size_t off = (size_t)row * ldc + col0; float q = 0.f;
#pragma unroll
                for (int bj = 0; bj < 2; ++bj) { const f32x4 v0 = *(const f32x4*)(base + off + bj * HALF) + acc[ai][bj][m][0], v1 = *(const f32x4*)(base + off + bj * HALF + 4) + acc[ai][bj][m][1];
                    q += (v0[0] * v0[0] + v0[1] * v0[1]) + (v0[2] * v0[2] + v0[3] * v0[3]) + (v1[0] * v1[0] + v1[1] * v1[1]) + (v1[2] * v1[2] + v1[3] * v1[3]);
                    u32x4 w; w.x = cvt_pk_bf16(v0[0], v0[1]); w.y = cvt_pk_bf16(v0[2], v0[3]); w.z = cvt_pk_bf16(v1[0], v1[1]); w.w = cvt_pk_bf16(v1[2], v1[3]);
                    *(u32x4*)(O + off + bj * HALF) = w; }
                q += __shfl_xor(q, 16); q += __shfl_xor(q, 32);
                if (fq == 0) ss[(size_t)row * 16 + u.pn * 4 + wc] = q; }
    }
};
struct EpiX2 {
    static constexpr bool PERM = true, AFTER_DRAIN = false, MIDK = false, PREFETCH = false;
    bf16_t* X; int ldc; float* ss;
    __device__ __forceinline__ void operator()(const f32x4 (&acc)[2][2][4][2], const Unit& u, int wr, int wc, int fr, int fq) const {
        const int row0 = u.pm * BM + wr * 64 + fr; const int col0 = u.pn * BM + wc * 32 + 8 * fq;
#pragma unroll
        for (int ai = 0; ai < 2; ++ai)
#pragma unroll
            for (int m = 0; m < 4; ++m) { const int row = row0 + ai * HALF + m * 16; const size_t off = (size_t)row * ldc + col0; float q = 0.f;
#pragma unroll
                for (int bj = 0; bj < 2; ++bj) { const u32x4 xb = *(const u32x4*)(X + off + bj * HALF);
                    f32x4 v0, v1; v0[0] = __builtin_bit_cast(float, xb.x << 16); v0[1] = __builtin_bit_cast(float, xb.x & 0xffff0000u); v0[2] = __builtin_bit_cast(float, xb.y << 16); v0[3] = __builtin_bit_cast(float, xb.y & 0xffff0000u);
                    v1[0] = __builtin_bit_cast(float, xb.z << 16); v1[1] = __builtin_bit_cast(float, xb.z & 0xffff0000u); v1[2] = __builtin_bit_cast(float, xb.w << 16); v1[3] = __builtin_bit_cast(float, xb.w & 0xffff0000u);
                    v0 = v0 + acc[ai][bj][m][0]; v1 = v1 + acc[ai][bj][m][1];
                    q += (v0[0] * v0[0] + v0[1] * v0[1]) + (v0[2] * v0[2] + v0[3] * v0[3]) + (v1[0] * v1[0] + v1[1] * v1[1]) + (v1[2] * v1[2] + v1[3] * v1[3]);
                    u32x4 w; w.x = cvt_pk_bf16(v0[0], v0[1]); w.y = cvt_pk_bf16(v0[2], v0[3]); w.z = cvt_pk_bf16(v1[0], v1[1]); w.w = cvt_pk_bf16(v1[2], v1[3]);
                    *(u32x4*)(X + off + bj * HALF) = w; }
                q += __shfl_xor(q, 16); q += __shfl_xor(q, 32);
                if (fq == 0) ss[(size_t)row * 16 + u.pn * 4 + wc] = q; }
    }
};
struct EpiBf16Rs {
    static constexpr bool PERM = true, AFTER_DRAIN = false, MIDK = false, PREFETCH = false;
    bf16_t* O; int ldc; const float* ss; float inv_n, eps;
    __device__ __forceinline__ void operator()(const f32x4 (&acc)[2][2][4][2], const Unit& u, int wr, int wc, int fr, int fq) const {
        const int row0 = u.pm * BM + wr * 64 + fr; const int col0 = u.pn * BM + wc * 32 + 8 * fq;
#pragma unroll
        for (int ai = 0; ai < 2; ++ai)
#pragma unroll
            for (int m = 0; m < 4; ++m) { const int row = row0 + ai * HALF + m * 16; const f32x4* sp = (const f32x4*)(ss + (size_t)row * 16);
                const f32x4 s4 = (sp[0] + sp[1]) + (sp[2] + sp[3]); const float rs = 1.0f / sqrtf(((s4[0] + s4[1]) + (s4[2] + s4[3])) * inv_n + eps);
                bf16_t* rowp = O + (size_t)row * ldc + col0;
#pragma unroll
                for (int bj = 0; bj < 2; ++bj) { const f32x4 v0 = acc[ai][bj][m][0] * rs, v1 = acc[ai][bj][m][1] * rs;
                    u32x4 w; w.x = cvt_pk_bf16(v0[0], v0[1]); w.y = cvt_pk_bf16(v0[2], v0[3]); w.z = cvt_pk_bf16(v1[0], v1[1]); w.w = cvt_pk_bf16(v1[2], v1[3]);
                    *(u32x4*)(rowp + bj * HALF) = w; } }
    }
};


template <int CTRL> __device__ __forceinline__ float dppk(float keep, float x) { return __builtin_bit_cast(float, __builtin_amdgcn_update_dpp(__builtin_bit_cast(int, keep), __builtin_bit_cast(int, x), CTRL, 0xf, 0xf, false)); }
template <int CTRL> __device__ __forceinline__ float dppf(float x) { return __builtin_bit_cast(float, __builtin_amdgcn_mov_dpp(__builtin_bit_cast(int, x), CTRL, 0xf, 0xf, true)); }
struct EpiConvGlu {
    static constexpr bool PERM = true, AFTER_DRAIN = false, MIDK = false, PREFETCH = true, PERMA = true;
    bf16_t* O; int ldc; const float* ss; const float* cw; const float* cb; PG8_LAS float* ex; int mrows; float* halo; const float* cw4;
    __device__ __forceinline__ void prefetch(const Unit& u, int wid, int lane) const {
        const int base = u.pm * BM; asm volatile("" : "+v"(lane));
        if (wid == 0) __builtin_amdgcn_global_load_lds((const unsigned*)(ss + base + lane * 4), (PG8_LAS unsigned*)(ex + 1024), 16, 0, 0);
        else if (wid < 4) __builtin_amdgcn_global_load_lds((const unsigned*)(cw4 + u.pn * 768 + (wid - 1) * 256 + lane * 4), (PG8_LAS unsigned*)(ex + 1024 + 4096 + (wid - 1) * 256), 16, 0, 0);
    }
    __device__ __forceinline__ void operator()(i32x4 (&iacc)[2][2][4][2], const Unit& u, int wr, int wc, int fr, int fq) const {
        f32x4 acc[2][2][4][2];
        const int kt = u.pm & 15, base = u.pm * BM;
        const int ch0 = u.pn * 128 + wc * 32 + 8 * fq;
        const bool top_open = kt != 0, bot_open = kt != 15;
        f32x4 w0[2], w1[2], w2[2], cbv[2], sv[2];
#pragma unroll
        for (int n = 0; n < 2; ++n) { const PG8_LAS float* wl = ex + 1024 + 4096 + wc * 32 + 8 * fq + 4 * n; const f32x4 sg = *(const PG8_LAS f32x4*)(wl + 512);
            w0[n] = *(const PG8_LAS f32x4*)wl * sg; w1[n] = *(const PG8_LAS f32x4*)(wl + 128) * sg; w2[n] = *(const PG8_LAS f32x4*)(wl + 256) * sg; cbv[n] = *(const PG8_LAS f32x4*)(wl + 384); sv[n] = *(const PG8_LAS f32x4*)(wl + 640); }
#pragma unroll
        for (int ai = 0; ai < 2; ++ai) { const f32x4 rs4 = *(const PG8_LAS f32x4*)(ex + 1024 + ai * HALF + wr * 64 + fr * 4);
#pragma unroll
            for (int m = 0; m < 4; ++m) { const float rs = rs4[m];
#pragma unroll
                for (int n = 0; n < 2; ++n) { const i32x4 ig = iacc[ai][0][m][n], iv = iacc[ai][1][m][n]; const f32x4 cv = sv[n] * rs;
                    acc[ai][0][m][n] = (f32x4){(float)ig[0], (float)ig[1], (float)ig[2], (float)ig[3]} * rs; acc[ai][1][m][n] = (f32x4){(float)iv[0], (float)iv[1], (float)iv[2], (float)iv[3]} * cv; } } }
        const int exi = (wc * 4 + fq) * 8;
        if (fr == 0) {
#pragma unroll
            for (int ai = 0; ai < 2; ++ai) { PG8_LAS f32x4* p = (PG8_LAS f32x4*)(ex + ((ai * 2 + wr) * 2 + 0) * 128 + exi); p[0] = acc[ai][0][0][0]; p[1] = acc[ai][0][0][1]; } }
        if (fr == 15) {
#pragma unroll
            for (int ai = 0; ai < 2; ++ai) { PG8_LAS f32x4* p = (PG8_LAS f32x4*)(ex + ((ai * 2 + wr) * 2 + 1) * 128 + exi); p[0] = acc[ai][0][3][0]; p[1] = acc[ai][0][3][1]; } }
        asm volatile("s_waitcnt lgkmcnt(0)\n\ts_barrier" ::: "memory");
#pragma unroll
        for (int ai = 0; ai < 2; ++ai) {
            f32x4 et[2] = {(f32x4){0.f, 0.f, 0.f, 0.f}, (f32x4){0.f, 0.f, 0.f, 0.f}}, eb[2] = {(f32x4){0.f, 0.f, 0.f, 0.f}, (f32x4){0.f, 0.f, 0.f, 0.f}};
            { const bool hz = (wr == 0 && ai == 0); const int sai = wr == 1 ? ai : 0, swr = wr == 1 ? 0 : 1; const PG8_LAS f32x4* p = (const PG8_LAS f32x4*)(ex + ((sai * 2 + swr) * 2 + 1) * 128 + exi);
              if (!hz) { et[0] = p[0]; et[1] = p[1]; } }
            { const bool hz = (wr == 1 && ai == 1); const int sai = wr == 0 ? ai : 1, swr = wr == 0 ? 1 : 0; const PG8_LAS f32x4* p = (const PG8_LAS f32x4*)(ex + ((sai * 2 + swr) * 2 + 0) * 128 + exi);
              if (!hz) { eb[0] = p[0]; eb[1] = p[1]; } }
            float a[4][8], zz[8];
#pragma unroll
            for (int n = 0; n < 2; ++n)
#pragma unroll
                for (int i = 0; i < 4; ++i) { const float g0 = acc[ai][0][0][n][i], g1 = acc[ai][0][1][n][i], g2 = acc[ai][0][2][n][i], g3 = acc[ai][0][3][n][i];
                    const float up = dppk<0x111>(et[n][i], g3), dn = dppk<0x101>(eb[n][i], g0);
                    const float c0 = w0[n][i], c1 = w1[n][i], c2 = w2[n][i], cb0 = cbv[n][i];
                    float z[4];
                    z[0] = __builtin_fmaf(c2, g1, __builtin_fmaf(c1, g0, __builtin_fmaf(c0, up, cb0)));
                    z[1] = __builtin_fmaf(c2, g2, __builtin_fmaf(c1, g1, __builtin_fmaf(c0, g0, cb0)));
                    z[2] = __builtin_fmaf(c2, g3, __builtin_fmaf(c1, g2, __builtin_fmaf(c0, g1, cb0)));
                    z[3] = __builtin_fmaf(c2, dn, __builtin_fmaf(c1, g3, __builtin_fmaf(c0, g2, cb0)));
                    zz[4 * n + i] = ai == 0 ? z[0] : z[3];
#pragma unroll
                    for (int m = 0; m < 4; ++m) a[m][4 * n + i] = z[m] * __builtin_amdgcn_rcpf(1.0f + __builtin_amdgcn_exp2f(-1.4426950408889634f * z[m])) * acc[ai][1][m][n][i]; }
#pragma unroll
            for (int m = 0; m < 4; ++m) { const int r = ai * HALF + wr * 64 + fr * 4 + m; u32x4 w;
                w.x = cvt_pk_bf16(a[m][0], a[m][1]); w.y = cvt_pk_bf16(a[m][2], a[m][3]); w.z = cvt_pk_bf16(a[m][4], a[m][5]); w.w = cvt_pk_bf16(a[m][6], a[m][7]);
                bool open = false;
                if (ai == 0 && m == 0) open = (r == 0) && top_open;
                if (ai == 1 && m == 3) open = (r == 255) && bot_open;
                if (!open) *(u32x4*)(O + (size_t)(base + r) * ldc + ch0) = w;
                if ((ai == 0 && m == 0) || (ai == 1 && m == 3)) { if (open) { float* hp = halo + ((size_t)(u.pm * 2 + (ai == 0 ? 0 : 1)) * 3) * ldc + ch0;
                        const PG8_LAS float* sl = ex + 1024 + 4096 + 512 + wc * 32 + 8 * fq;
                        *(f32x4*)hp = acc[ai][0][m][0] * *(const PG8_LAS f32x4*)sl; *(f32x4*)(hp + 4) = acc[ai][0][m][1] * *(const PG8_LAS f32x4*)(sl + 4);
                        *(f32x4*)(hp + ldc) = (f32x4){zz[0], zz[1], zz[2], zz[3]}; *(f32x4*)(hp + ldc + 4) = (f32x4){zz[4], zz[5], zz[6], zz[7]};
                        *(f32x4*)(hp + 2 * ldc) = acc[ai][1][m][0]; *(f32x4*)(hp + 2 * ldc + 4) = acc[ai][1][m][1]; } }
                asm volatile("" ::: "memory"); } }
        asm volatile("s_waitcnt lgkmcnt(0)\n\ts_barrier" ::: "memory");
    }
};


struct EpiX1N {
    static constexpr bool PERM = true, AFTER_DRAIN = false, MIDK = true, PREFETCH = true; static constexpr int MIDK_T = 12;
    const bf16_t* base; bf16_t* O; int ldc; float* ss; const float* sa; PG8_LAS float* st;
    __device__ __forceinline__ void prefetch(const Unit& u, int wid, int lane) const {
        asm volatile("" : "+v"(lane));
#pragma unroll
        for (int i = 0; i < 2; ++i) { const int piece = wid * 2 + i;
            __builtin_amdgcn_global_load_lds((const unsigned*)(sa + (size_t)u.pm * BM * 16 + piece * 256 + lane * 4), (PG8_LAS unsigned*)(st + piece * 256), 16, 0, 0); }
    }
    __device__ __forceinline__ void row_stats(int rl, int fq, float& ra, float& rf) const {
        const f32x4 s4 = *(const PG8_LAS f32x4*)(st + rl * 16 + 4 * fq); float a = fq < 3 ? (s4[0] + s4[1]) + (s4[2] + s4[3]) : 0.f, f = fq == 3 ? s4[0] : 0.f;
        a += __shfl_xor(a, 16); a += __shfl_xor(a, 32); f += __shfl_xor(f, 16); f += __shfl_xor(f, 32);
        ra = __builtin_amdgcn_rsqf(a * (1.0f / 768.0f) + 1e-6f); rf = __builtin_amdgcn_rsqf(f * (1.0f / 256.0f) + 1e-6f);
    }
    __device__ __forceinline__ void midk(f32x4 (&acc)[2][2][4][2], const Unit& u, int wr, int fr, int fq) const {
#pragma unroll
        for (int ai = 0; ai < 2; ++ai)
#pragma unroll
            for (int m = 0; m < 4; ++m) { float ra, rf; row_stats(ai * HALF + wr * 64 + m * 16 + fr, fq, ra, rf); const float ratio = ra * __builtin_amdgcn_rcpf(rf);
#pragma unroll
                for (int bj = 0; bj < 2; ++bj) { acc[ai][bj][m][0] = acc[ai][bj][m][0] * ratio; acc[ai][bj][m][1] = acc[ai][bj][m][1] * ratio; } }
    }
    __device__ __forceinline__ void operator()(const f32x4 (&acc)[2][2][4][2], const Unit& u, int wr, int wc, int fr, int fq) const {
        const int row0 = u.pm * BM + wr * 64 + fr; const int col0 = u.pn * BM + wc * 32 + 8 * fq;
#pragma unroll
        for (int ai = 0; ai < 2; ++ai)
#pragma unroll
            for (int m = 0; m < 4; ++m) { const int row = row0 + ai * HALF + m * 16; const size_t off = (size_t)row * ldc + col0; float ra, rf; row_stats(row - u.pm * BM, fq, ra, rf);
#pragma unroll
                for (int bj = 0; bj < 2; ++bj) { const u32x4 xb = *(const u32x4*)(base + off + bj * HALF); f32x4 v0, v1;
                    v0[0] = __builtin_bit_cast(float, xb.x << 16); v0[1] = __builtin_bit_cast(float, xb.x & 0xffff0000u); v0[2] = __builtin_bit_cast(float, xb.y << 16); v0[3] = __builtin_bit_cast(float, xb.y & 0xffff0000u);
                    v1[0] = __builtin_bit_cast(float, xb.z << 16); v1[1] = __builtin_bit_cast(float, xb.z & 0xffff0000u); v1[2] = __builtin_bit_cast(float, xb.w << 16); v1[3] = __builtin_bit_cast(float, xb.w & 0xffff0000u);
                    v0 = v0 + acc[ai][bj][m][0] * rf; v1 = v1 + acc[ai][bj][m][1] * rf;
                    u32x4 w; w.x = cvt_pk_bf16(v0[0], v0[1]); w.y = cvt_pk_bf16(v0[2], v0[3]); w.z = cvt_pk_bf16(v1[0], v1[1]); w.w = cvt_pk_bf16(v1[2], v1[3]);
                    *(u32x4*)(O + off + bj * HALF) = w; }
                }
        asm volatile("s_waitcnt lgkmcnt(0)\n\ts_barrier" ::: "memory");
    }
};


struct EpiFinal {
    static constexpr bool PERM = true, AFTER_DRAIN = false, MIDK = false, PREFETCH = false;
    const bf16_t* X1; float* out; int ldc; const float* gain; float* xbuf; unsigned* cnt; PG8_LAS unsigned char* lx;
    __device__ __forceinline__ void operator()(f32x4 (&acc)[2][2][4][2], const Unit& u, int wr, int wc, int fr, int fq) const {
        PG8_LAS float* P = (PG8_LAS float*)lx; PG8_LAS float* S = (PG8_LAS float*)(lx + 4096);
        int tid = (wr * 4 + wc) * 64 + fq * 16 + fr; asm volatile("" : "+v"(tid)); const int col0 = u.pn * BM + wc * 32 + 8 * fq;
#pragma unroll
        for (int ai = 0; ai < 2; ++ai)
#pragma unroll
            for (int m = 0; m < 4; ++m) { const int rl = ai * HALF + wr * 64 + m * 16 + fr; const size_t off = (size_t)(u.pm * BM + rl) * ldc + col0; float q = 0.f;
#pragma unroll
                for (int bj = 0; bj < 2; ++bj) { const u32x4 xb = *(const u32x4*)(X1 + off + bj * HALF); f32x4 v0, v1;
                    v0[0] = __builtin_bit_cast(float, xb.x << 16); v0[1] = __builtin_bit_cast(float, xb.x & 0xffff0000u); v0[2] = __builtin_bit_cast(float, xb.y << 16); v0[3] = __builtin_bit_cast(float, xb.y & 0xffff0000u);
                    v1[0] = __builtin_bit_cast(float, xb.z << 16); v1[1] = __builtin_bit_cast(float, xb.z & 0xffff0000u); v1[2] = __builtin_bit_cast(float, xb.w << 16); v1[3] = __builtin_bit_cast(float, xb.w & 0xffff0000u);
                    v0 = v0 + acc[ai][bj][m][0]; v1 = v1 + acc[ai][bj][m][1]; acc[ai][bj][m][0] = v0; acc[ai][bj][m][1] = v1;
                    q += ((v0[0] * v0[0] + v0[1] * v0[1]) + (v0[2] * v0[2] + v0[3] * v0[3])) + ((v1[0] * v1[0] + v1[1] * v1[1]) + (v1[2] * v1[2] + v1[3] * v1[3])); }
                q += __shfl_xor(q, 16); q += __shfl_xor(q, 32);
                if (fq == 0) P[rl * 4 + wc] = q; }
        asm volatile("s_waitcnt lgkmcnt(0)\n\ts_barrier" ::: "memory");
        if (tid < 256) { const float s = (P[tid * 4] + P[tid * 4 + 1]) + (P[tid * 4 + 2] + P[tid * 4 + 3]);
            __hip_atomic_store(xbuf + ((size_t)(u.pm * BM + tid) * 4 + u.pn), s, __ATOMIC_RELAXED, __HIP_MEMORY_SCOPE_AGENT);
            asm volatile("s_waitcnt vmcnt(0)" ::: "memory");
            if ((tid & 63) == 0) __hip_atomic_fetch_add(cnt + 64 * u.pm, 1u, __ATOMIC_RELAXED, __HIP_MEMORY_SCOPE_AGENT); }
        if (tid < 64) { unsigned spins = 0;
            while ((unsigned)__builtin_amdgcn_readfirstlane(__hip_atomic_load(cnt + 64 * u.pm, __ATOMIC_RELAXED, __HIP_MEMORY_SCOPE_AGENT)) < 16u) { __builtin_amdgcn_s_sleep(2); if (++spins > 400000u) break; }
            __builtin_amdgcn_fence(__ATOMIC_ACQUIRE, "agent"); }
        asm volatile("s_waitcnt vmcnt(0) lgkmcnt(0)\n\ts_barrier" ::: "memory");
        if (tid < 256) { const float* xp = xbuf + (size_t)(u.pm * BM + tid) * 4; float t = 0.f;
#pragma unroll
            for (int k = 0; k < 4; ++k) t += __hip_atomic_load(xp + k, __ATOMIC_RELAXED, __HIP_MEMORY_SCOPE_AGENT);
            S[tid] = 1.0f / sqrtf(t * (1.0f / 1024.0f) + 1e-6f); }
        asm volatile("s_waitcnt vmcnt(0) lgkmcnt(0)\n\ts_barrier" ::: "memory");
        f32x4 gv[2][2];
#pragma unroll
        for (int bj = 0; bj < 2; ++bj)
#pragma unroll
            for (int n = 0; n < 2; ++n) gv[bj][n] = *(const f32x4*)(gain + col0 + bj * HALF + n * 4);
#pragma unroll
        for (int ai = 0; ai < 2; ++ai)
#pragma unroll
            for (int m = 0; m < 4; ++m) { const int rl = ai * HALF + wr * 64 + m * 16 + fr; const float rs = S[rl]; const size_t off = (size_t)(u.pm * BM + rl) * ldc + col0;
#pragma unroll
                for (int bj = 0; bj < 2; ++bj)
#pragma unroll
                    for (int n = 0; n < 2; ++n) *(f32x4*)(out + off + bj * HALF + n * 4) = acc[ai][bj][m][n] * rs * gv[bj][n]; }
    }
};

template <class E, class = void> struct HasPermA { static constexpr bool v = false; };
template <class E> struct HasPermA<E, decltype((void)E::PERMA)> { static constexpr bool v = E::PERMA; };
template <bool I8> __device__ __forceinline__ typename AccT<I8>::type mma16(bf16x8 a, bf16x8 b, typename AccT<I8>::type c) {
    if constexpr (I8) return __builtin_amdgcn_mfma_i32_16x16x64_i8(__builtin_bit_cast(i32x4, a), __builtin_bit_cast(i32x4, b), c, 0, 0, 0);
    else return __builtin_amdgcn_mfma_f32_16x16x32_bf16(a, b, c, 0, 0, 0);
}
template <class Epi, class Sched, bool ALIGN_EPI = false, bool SP2 = false, bool I8 = false>
__device__ __forceinline__ void gemm_phase(PG8_LAS unsigned char* lds, const Gemm g, const Sched& S, const Epi& E) {
    int tid = threadIdx.x; asm volatile("" : "+v"(tid));
    const int wid = __builtin_amdgcn_readfirstlane(tid >> 6), lane = tid & 63, wr = wid >> 2, wc = wid & 3, fr = lane & 15, fq = lane >> 4;
    const int K = g.K, nt = K / BK, lda = g.lda;
    unsigned voffA[2], voffB[2];
#pragma unroll
    for (int i = 0; i < 2; ++i) { int R, C; stage_rc(tid * 16 + i * 8192, R, C); const int Rb = Epi::PERM ? ((R & ~31) + perm32(R & 31)) : R;
        const int Ra = HasPermA<Epi>::v ? ((R & ~63) + (R & 15) * 4 + ((R >> 4) & 3)) : R;
        voffA[i] = (unsigned)(Ra * lda + C) * 2u; voffB[i] = (unsigned)(Rb * K + C) * 2u; }
    const size_t kstep = (size_t)(BK * 2);
    const size_t hstepA = (size_t)HALF * lda * 2, hstepB = (size_t)HALF * K * 2;
    const size_t tstepA = 2 * hstepA, tstepB = 2 * hstepB;
    const unsigned ldsw = (unsigned)wid * 1024u;
    const int aoff = lds_byte(wr * 64 + fr, fq * 8), boff = lds_byte(wc * 32 + fr, fq * 8);
#define PG8_SA(b, h) (((b) * 2 + (h)) * HTB)
#define PG8_SB(b, h) ((4 + (b) * 2 + (h)) * HTB)
#define PG8_STAGE(bufoff, gbase, voff) do { _Pragma("unroll") for (int _i = 0; _i < 2; ++_i) \
        __builtin_amdgcn_global_load_lds((const unsigned*)((const char*)(gbase) + (voff)[_i]), (PG8_LAS unsigned*)(lds + (bufoff) + ldsw + _i * 8192), 16, 0, 0); } while (0)
#define PG8_LDA(dst, b, h) do { _Pragma("unroll") for (int m = 0; m < 4; ++m) _Pragma("unroll") for (int k = 0; k < 2; ++k) dst[m][k] = *(const PG8_LAS bf16x8*)(lds + PG8_SA(b, h) + aoff + m * 2048 + k * 1024); } while (0)
#define PG8_LDB(dst, b, h) do { _Pragma("unroll") for (int n = 0; n < 2; ++n) _Pragma("unroll") for (int k = 0; k < 2; ++k) dst[n][k] = *(const PG8_LAS bf16x8*)(lds + PG8_SB(b, h) + boff + n * 2048 + k * 1024); } while (0)
#define PG8_MMA(ai, bj, At, Bt) do { __builtin_amdgcn_s_setprio(1); _Pragma("unroll") for (int m = 0; m < 4; ++m) _Pragma("unroll") for (int n = 0; n < 2; ++n) _Pragma("unroll") for (int k = 0; k < 2; ++k) \
        acc[ai][bj][m][n] = mma16<I8>(Bt[n][k], At[m][k], acc[ai][bj][m][n]); __builtin_amdgcn_s_setprio(0); } while (0)
#define PG8_WAIT_V(n) asm volatile("s_waitcnt vmcnt(" #n ")" ::: "memory")
#define PG8_WAIT_L(n) asm volatile("s_waitcnt lgkmcnt(" #n ")" ::: "memory")
#define PG8_BAR __builtin_amdgcn_s_barrier()
#define PG8_SCHED __builtin_amdgcn_sched_barrier(0)
    Unit cur, nxt; int ui = 0;
    if (!S.next(0, cur)) return;
    typedef typename AccT<I8>::type acc_t; acc_t acc[2][2][4][2];
#pragma unroll
    for (int a = 0; a < 2; ++a)
#pragma unroll
        for (int b = 0; b < 2; ++b)
#pragma unroll
            for (int m = 0; m < 4; ++m)
#pragma unroll
                for (int n = 0; n < 2; ++n) acc[a][b][m][n] = (acc_t){0, 0, 0, 0};
    bf16x8 At[4][2], B0[2][2], B1[2][2];
    const char* cA = (const char*)g.A + (g.ovl ? (size_t)ovl_row_base(cur.pm) * lda * 2 : (size_t)cur.pm * tstepA); const char* cB = (const char*)g.Bt + (size_t)cur.pn * tstepB;
    S.a_ready(cur);
    if constexpr (Epi::PREFETCH) E.prefetch(cur, wid, lane);
    if constexpr (SP2) {
        PG8_STAGE(PG8_SB(0, 0), cB, voffB); PG8_STAGE(PG8_SB(0, 1), cB + hstepB, voffB); PG8_STAGE(PG8_SA(0, 0), cA, voffA); PG8_STAGE(PG8_SA(0, 1), cA + hstepA, voffA);
        if (wr == 1) PG8_BAR;
        PG8_WAIT_V(2); PG8_BAR;
        PG8_STAGE(PG8_SB(1, 0), cB + kstep, voffB); PG8_STAGE(PG8_SA(1, 0), cA + kstep, voffA); PG8_STAGE(PG8_SB(1, 1), cB + hstepB + kstep, voffB);
        PG8_WAIT_V(6); PG8_BAR;
    } else {
        PG8_STAGE(PG8_SB(0, 0), cB, voffB); PG8_STAGE(PG8_SA(0, 0), cA, voffA); PG8_STAGE(PG8_SB(0, 1), cB + hstepB, voffB); PG8_STAGE(PG8_SA(0, 1), cA + hstepA, voffA);
        if (wr == 1) PG8_BAR;
        PG8_WAIT_V(4); PG8_BAR;
        PG8_STAGE(PG8_SB(1, 0), cB + kstep, voffB); PG8_STAGE(PG8_SA(1, 0), cA + kstep, voffA); PG8_STAGE(PG8_SB(1, 1), cB + hstepB + kstep, voffB);
        PG8_WAIT_V(6); PG8_BAR;
    }
    for (;;) {
        const bool has_next = S.next(ui + 1, nxt);
        const char* nA = has_next ? (const char*)g.A + (g.ovl ? (size_t)ovl_row_base(nxt.pm) * lda * 2 : (size_t)nxt.pm * tstepA) : cA; const char* nB = has_next ? (const char*)g.Bt + (size_t)nxt.pn * tstepB : cB;
        for (int t = 0; t < nt; t += 2) {
            const bool last = (t == nt - 2);
            const char* a1 = cA + (size_t)(t + 1) * kstep;
            const char* a2 = last ? nA : cA + (size_t)(t + 2) * kstep; const char* b2 = last ? nB : cB + (size_t)(t + 2) * kstep;
            const char* a3 = a2 + kstep; const char* b3 = b2 + kstep;
            if (last && has_next) S.a_ready(nxt);
            if constexpr (Epi::MIDK) { if (t == Epi::MIDK_T) E.midk(acc, cur, wr, fr, fq); }
            if constexpr (SP2) {
            PG8_LDB(B0, 0, 0); PG8_LDB(B1, 0, 1); PG8_SCHED; PG8_LDA(At, 0, 0); PG8_STAGE(PG8_SA(1, 1), a1 + hstepA, voffA);
            PG8_WAIT_V(8); PG8_WAIT_L(0); PG8_BAR; PG8_MMA(0, 0, At, B0); PG8_MMA(0, 1, At, B1); PG8_BAR; PG8_SCHED;
            PG8_LDA(At, 0, 1); PG8_STAGE(PG8_SB(0, 0), b2, voffB); PG8_STAGE(PG8_SB(0, 1), b2 + hstepB, voffB); PG8_STAGE(PG8_SA(0, 0), a2, voffA);
            PG8_WAIT_V(8); PG8_WAIT_L(0); PG8_BAR; PG8_MMA(1, 0, At, B0); PG8_MMA(1, 1, At, B1); PG8_BAR; PG8_SCHED;
            PG8_LDB(B0, 1, 0); PG8_LDB(B1, 1, 1); PG8_SCHED; PG8_LDA(At, 1, 0); PG8_STAGE(PG8_SA(0, 1), a2 + hstepA, voffA);
            PG8_WAIT_V(8); PG8_WAIT_L(0); PG8_BAR; PG8_MMA(0, 0, At, B0); PG8_MMA(0, 1, At, B1); PG8_BAR; PG8_SCHED;
            PG8_LDA(At, 1, 1); PG8_STAGE(PG8_SB(1, 0), b3, voffB); PG8_STAGE(PG8_SB(1, 1), b3 + hstepB, voffB); PG8_STAGE(PG8_SA(1, 0), a3, voffA);
            PG8_WAIT_V(8); PG8_WAIT_L(0); PG8_BAR; PG8_MMA(1, 0, At, B0); PG8_MMA(1, 1, At, B1); PG8_BAR; PG8_SCHED;
            } else {
            PG8_LDB(B0, 0, 0); PG8_SCHED; PG8_LDA(At, 0, 0); PG8_STAGE(PG8_SA(1, 1), a1 + hstepA, voffA);
            PG8_WAIT_L(8); PG8_BAR; PG8_WAIT_L(0); PG8_MMA(0, 0, At, B0); PG8_BAR; PG8_SCHED;
            PG8_LDB(B1, 0, 1); PG8_STAGE(PG8_SB(0, 0), b2, voffB);
            PG8_BAR; PG8_WAIT_L(0); PG8_MMA(0, 1, At, B1); PG8_BAR;
            PG8_LDA(At, 0, 1); PG8_STAGE(PG8_SA(0, 0), a2, voffA);
            PG8_BAR; PG8_WAIT_L(0); PG8_MMA(1, 0, At, B0); PG8_BAR; PG8_SCHED;
            PG8_STAGE(PG8_SB(0, 1), b2 + hstepB, voffB);
            PG8_WAIT_V(6); PG8_BAR; PG8_MMA(1, 1, At, B1); PG8_BAR;
            PG8_LDB(B0, 1, 0); PG8_SCHED; PG8_LDA(At, 1, 0); PG8_STAGE(PG8_SA(0, 1), a2 + hstepA, voffA);
            PG8_WAIT_L(8); PG8_BAR; PG8_WAIT_L(0); PG8_MMA(0, 0, At, B0); PG8_BAR; PG8_SCHED;
            PG8_LDB(B1, 1, 1); PG8_STAGE(PG8_SB(1, 0), b3, voffB);
            PG8_BAR; PG8_WAIT_L(0); PG8_MMA(0, 1, At, B1); PG8_BAR;
            PG8_LDA(At, 1, 1); PG8_STAGE(PG8_SA(1, 0), a3, voffA);
            PG8_BAR; PG8_WAIT_L(0); PG8_MMA(1, 0, At, B0); PG8_BAR; PG8_SCHED;
            PG8_STAGE(PG8_SB(1, 1), b3 + hstepB, voffB);
            PG8_WAIT_V(6); PG8_BAR; PG8_MMA(1, 1, At, B1); PG8_BAR;
            }
        }
        if constexpr (ALIGN_EPI) { if (wr == 0) PG8_BAR; }
        if constexpr (!Epi::AFTER_DRAIN) { E(acc, cur, wr, wc, fr, fq); S.done(cur); }
        if constexpr (Epi::PREFETCH) { if (has_next) E.prefetch(nxt, wid, lane); }
        if (!has_next) break;
#pragma unroll
        for (int a = 0; a < 2; ++a)
#pragma unroll
            for (int b = 0; b < 2; ++b)
#pragma unroll
                for (int m = 0; m < 4; ++m)
#pragma unroll
                    for (int n = 0; n < 2; ++n) acc[a][b][m][n] = (acc_t){0, 0, 0, 0};
        cur = nxt; cA = nA; cB = nB; ++ui;
        if constexpr (ALIGN_EPI) { if (wr == 1) PG8_BAR; }
    }
    PG8_WAIT_V(0);
    if constexpr (!ALIGN_EPI) { if (wr == 0) PG8_BAR; }
    PG8_BAR;
#undef PG8_SA
#undef PG8_SB
#undef PG8_STAGE
#undef PG8_LDA
#undef PG8_LDB
#undef PG8_MMA
#undef PG8_WAIT_V
#undef PG8_WAIT_L
#undef PG8_BAR
#undef PG8_SCHED
}
}

constexpr int NWAVES = 8;
#ifndef MK_ONE_LAUNCH
#define MK_ONE_LAUNCH 1
#endif
constexpr int N_PHASES = 11;

constexpr int BATCH = 8, SEQ = 4096, D = 1024, NH = 12, HD = 64, AW = 768, NG = 4, GD = 64, FW = 256, MIXW = 1024, NPROJ = 2560, FF = 2816;
constexpr int M = BATCH * SEQ;
constexpr float EPS = 1e-6f;

constexpr size_t MiB = 1u << 20;
constexpr size_t WS_CTL = 0, CTL_ZERO_BYTES = 96 * 1024;
constexpr size_t WS_TAB = 1 * MiB;
constexpr size_t TAB_BIAS = 0;
constexpr size_t TAB_MG = 32 * 1024;
constexpr size_t TAB_TW = 192 * 1024;
constexpr size_t TAB_CW4 = 256 * 1024;
constexpr size_t WS_WIN = 2 * MiB;
constexpr size_t WS_WOUT = 7 * MiB;
constexpr size_t WS_WGV = 9 * MiB;
constexpr size_t WS_WD = 20 * MiB;
constexpr size_t WS_XN = 26 * MiB;
constexpr size_t WS_PROJ = 90 * MiB;
constexpr size_t WS_A2 = 250 * MiB;
constexpr size_t WS_PQ = 314 * MiB;
constexpr size_t WS_ML = 380 * MiB;
constexpr size_t WS_A8 = 314 * MiB;
constexpr size_t WS_HALO = 400 * MiB;
constexpr size_t WS_RS0 = 441 * MiB;
constexpr size_t WS_XBUF = 440 * MiB;
constexpr size_t WS_SSA = 446 * MiB;
constexpr size_t WS_SS1 = 442 * MiB;
constexpr size_t WS_SS2 = 444 * MiB;
constexpr size_t WS_GV = 90 * MiB;
constexpr size_t WS_END = 448 * MiB;
constexpr int CW_BAR = 1024, CW_PANEL = 8192, CW_CMAX = 16384;

constexpr int RING_OFF = 0, RING_BYTES = 131072;
constexpr int LDSCTL_OFF = RING_BYTES, MISC_OFF = LDSCTL_OFF + 320;
constexpr int LDS_BYTES = 163840;

#define GAS __attribute__((address_space(1)))
#define LAS __attribute__((address_space(3)))
typedef unsigned short bf16;
typedef unsigned v4u __attribute__((ext_vector_type(4)));
typedef unsigned v2u __attribute__((ext_vector_type(2)));
typedef float f32x4 __attribute__((ext_vector_type(4)));
typedef GAS unsigned gu32;
#define RLX_AGENT __ATOMIC_RELAXED, __HIP_MEMORY_SCOPE_AGENT
#define LDS_WAIT() asm volatile("s_waitcnt lgkmcnt(0)" ::: "memory")
#define VM_WAIT() asm volatile("s_waitcnt vmcnt(0)" ::: "memory")
__device__ __forceinline__ unsigned f2bf(float f) { unsigned u = __builtin_bit_cast(unsigned, f); return (u + 0x7fffu + ((u >> 16) & 1u)) >> 16; }
__device__ __forceinline__ unsigned pk2(float lo, float hi) { typedef float f2_t __attribute__((ext_vector_type(2))); typedef __bf16 b2_t __attribute__((ext_vector_type(2))); f2_t v = {lo, hi}; b2_t b = __builtin_convertvector(v, b2_t); return __builtin_bit_cast(unsigned, b); }
__device__ __forceinline__ float bflo(unsigned w) { return __builtin_bit_cast(float, w << 16); }
__device__ __forceinline__ float bfhi(unsigned w) { return __builtin_bit_cast(float, w & 0xffff0000u); }
__device__ __forceinline__ float bf2f(bf16 h) { return __builtin_bit_cast(float, (unsigned)h << 16); }

#define XB_TMO      128
#define XB_XCNT(j)  (256  + 64 * (j))
#define XB_XSUB(j)  (1280 + 64 * (j))
#define XB_XGEN(j)  (2304 + 64 * (j))
#define XB_TOP      3328
#define XB_TOPGEN   3392
#define XCD_BAR_WORDS 3456
#define XB_SPIN_CAP (1u << 18)
__device__ __forceinline__ unsigned xb_ld(unsigned* p)              { return __hip_atomic_load(p, __ATOMIC_RELAXED, __HIP_MEMORY_SCOPE_AGENT); }
__device__ __forceinline__ unsigned xb_add(unsigned* p, unsigned v) { return __hip_atomic_fetch_add(p, v, __ATOMIC_RELAXED, __HIP_MEMORY_SCOPE_AGENT); }
__device__ __forceinline__ unsigned xb_xcc_id() { return (unsigned)__builtin_amdgcn_s_getreg((3 << 11) | 20) & 0xFu; }
#define XB_SPIN(cond, bar) do { unsigned _sp = 0; while (cond) { __builtin_amdgcn_s_sleep(1); \
    if ((++_sp & 255u) == 0u) { if (xb_ld(&(bar)[XB_TMO])) break; if (_sp > XB_SPIN_CAP) { atomicAdd(&(bar)[XB_TMO], 1u); break; } } } } while (0)
struct XcdBarrier { unsigned* bar; unsigned x; volatile LAS unsigned* st; };
__device__ __forceinline__ XcdBarrier xcd_barrier_post(unsigned* bar, volatile LAS unsigned* st) {
    XcdBarrier b; b.bar = bar; b.x = xb_xcc_id(); b.st = st;
    if (threadIdx.x == 0) (void)xb_add(&bar[XB_XCNT(b.x)], 1u);
    return b;
}
__device__ __forceinline__ void xcd_barrier_complete(unsigned* bar, unsigned x, unsigned& nloc, unsigned& nx) {
    const unsigned G = gridDim.x * gridDim.y * gridDim.z;
    unsigned sum, cnt, mine, sp = 0u;
    for (;;) {
        sum = 0u; cnt = 0u; mine = 0u;
#pragma unroll
        for (unsigned j = 0; j < 16; ++j) { const unsigned c = xb_ld(&bar[XB_XCNT(j)]); sum += c; cnt += (c > 0u) ? 1u : 0u; mine = (j == x) ? c : mine; }
        if (sum == G) break;
        __builtin_amdgcn_s_sleep(1);
        if ((++sp & 255u) == 0u) { if (xb_ld(&bar[XB_TMO])) break; if (sp > XB_SPIN_CAP) { atomicAdd(&bar[XB_TMO], 1u); break; } }
    }
    nloc = mine > 0u ? mine : 1u; nx = cnt > 0u ? cnt : 1u;
}
__device__ __forceinline__ void xcd_barrier(const XcdBarrier& b) {
    asm volatile("s_waitcnt vmcnt(0)" ::: "memory");
    __syncthreads();
    if (threadIdx.x == 0) {
        unsigned* bar = b.bar;
        __builtin_amdgcn_s_waitcnt(0);
        unsigned nloc = b.st[0], nx = b.st[1];
        if (nloc == 0u) { xcd_barrier_complete(bar, b.x, nloc, nx); b.st[0] = nloc; b.st[1] = nx; }
        const unsigned old = xb_add(&bar[XB_XSUB(b.x)], 1u);
        const unsigned gen = old / nloc;
        if (old + 1u == (gen + 1u) * nloc) {
            __builtin_amdgcn_fence(__ATOMIC_RELEASE, "agent");
            asm volatile("s_waitcnt vmcnt(0)" ::: "memory");
            const unsigned og = xb_add(&bar[XB_TOP], 1u);
            const unsigned tg = og / nx;
            if (og + 1u == (tg + 1u) * nx) xb_add(&bar[XB_TOPGEN], 1u);
            else XB_SPIN(xb_ld(&bar[XB_TOPGEN]) == tg, bar);
            __builtin_amdgcn_fence(__ATOMIC_ACQUIRE, "agent");
            xb_add(&bar[XB_XGEN(b.x)], 1u);
            asm volatile("s_waitcnt vmcnt(0)" ::: "memory");
        } else {
            XB_SPIN(xb_ld(&bar[XB_XGEN(b.x)]) == gen, bar);
            __builtin_amdgcn_fence(__ATOMIC_ACQUIRE, "agent");
            asm volatile("s_waitcnt vmcnt(0)" ::: "memory");
        }
    }
    __syncthreads();
}

struct Frame {
    LAS unsigned char* lds;
    volatile LAS unsigned* MISC;
    gu32* ctl;
    int tid, lane, wave;
    int vcu, G;
    const float *x, *g_mix, *w_in, *g_attn, *rel_tab, *f_w, *f_b, *g_four, *w_out, *g_ffn, *w_gate, *w_val, *conv_w, *conv_b, *w_down, *g_fin;
    float* out;
    unsigned char* ws;
};

__device__ __forceinline__ float wave_sum(float v) {
#pragma unroll
    for (int o = 1; o < 64; o <<= 1) v += __shfl_xor(v, o);
    return v;
}
__device__ __forceinline__ void p0_transpose_item(const float* W, int K, int N, bf16* WT, int row_off, LAS float* scr, int item, int lane, const float* gain = nullptr, bool il = false) {
    const int nblk = N / 32, kb = item / nblk, nb = item % nblk, k0 = 64 * kb, n0 = 32 * nb; if (il) row_off += 128 * (n0 >> 7);
    {   f32x4 v[8]; const int c4 = 4 * (lane & 7);
#pragma unroll
        for (int i = 0; i < 8; ++i) v[i] = *(const GAS f32x4*)(W + (size_t)(k0 + (lane >> 3) + 8 * i) * N + n0 + c4);
#pragma unroll
        for (int i = 0; i < 8; ++i) { const int kk = (lane >> 3) + 8 * i; const float gsc = gain ? gain[k0 + kk] : 1.0f; LAS float* sp = scr + kk * 33 + c4;
            sp[0] = v[i].x * gsc; sp[1] = v[i].y * gsc; sp[2] = v[i].z * gsc; sp[3] = v[i].w * gsc; } }
    LDS_WAIT(); asm volatile("" ::: "memory");
    const int c = lane & 7;
#pragma unroll
    for (int j = 0; j < 4; ++j) { const int n = (lane >> 3) + 8 * j; const LAS float* s = scr + (8 * c) * 33 + n;
        v4u o; o.x = pk2(s[0 * 33], s[1 * 33]); o.y = pk2(s[2 * 33], s[3 * 33]); o.z = pk2(s[4 * 33], s[5 * 33]); o.w = pk2(s[6 * 33], s[7 * 33]);
        *(GAS v4u*)(WT + (size_t)(row_off + n0 + n) * K + k0 + 8 * c) = o; }
    LDS_WAIT(); asm volatile("" ::: "memory");
}

__device__ __forceinline__ void p0_colmax_item(const float* W, int K, int N, unsigned* cmax, int row_off, int item, int lane, const float* gain) {
    const int nblk = N / 32, kb = item / nblk, nb = item % nblk, k0 = 64 * kb, n0 = 32 * nb, c4 = 4 * (lane & 7); row_off += 128 * (n0 >> 7);
    f32x4 mx = (f32x4){0.f, 0.f, 0.f, 0.f};
#pragma unroll
    for (int i = 0; i < 8; ++i) { const int kk = (lane >> 3) + 8 * i; const f32x4 v = *(const GAS f32x4*)(W + (size_t)(k0 + kk) * N + n0 + c4) * gain[k0 + kk];
        mx[0] = fmaxf(mx[0], fabsf(v[0])); mx[1] = fmaxf(mx[1], fabsf(v[1])); mx[2] = fmaxf(mx[2], fabsf(v[2])); mx[3] = fmaxf(mx[3], fabsf(v[3])); }
#pragma unroll
    for (int j = 0; j < 4; ++j) { float t = mx[j]; t = fmaxf(t, __shfl_xor(t, 8)); t = fmaxf(t, __shfl_xor(t, 16)); t = fmaxf(t, __shfl_xor(t, 32)); mx[j] = t; }
    if (lane < 8) {
#pragma unroll
        for (int j = 0; j < 4; ++j) atomicMax(cmax + row_off + n0 + c4 + j, __float_as_uint(mx[j])); }
}
__device__ __forceinline__ void p6_quant_item(const float* W, int K, int N, unsigned char* WT, int row_off, LAS float* scr, int item, int lane, const float* gain, const unsigned* cmax) {
    const int nblk = N / 32, kb = item / nblk, nb = item % nblk, k0 = 64 * kb, n0 = 32 * nb; row_off += 128 * (n0 >> 7);
    {   f32x4 v[8]; const int c4 = 4 * (lane & 7);
#pragma unroll
        for (int i = 0; i < 8; ++i) v[i] = *(const GAS f32x4*)(W + (size_t)(k0 + (lane >> 3) + 8 * i) * N + n0 + c4);
#pragma unroll
        for (int i = 0; i < 8; ++i) { const int kk = (lane >> 3) + 8 * i; const float gsc = gain[k0 + kk]; LAS float* sp = scr + kk * 33 + c4;
            sp[0] = v[i].x * gsc; sp[1] = v[i].y * gsc; sp[2] = v[i].z * gsc; sp[3] = v[i].w * gsc; } }
    LDS_WAIT(); asm volatile("" ::: "memory");
    const int c = lane & 7;
#pragma unroll
    for (int j = 0; j < 4; ++j) { const int n = (lane >> 3) + 8 * j; const LAS float* s = scr + (8 * c) * 33 + n; const float cm = __uint_as_float(cmax[row_off + n0 + n]); const float inv = cm > 0.f ? 127.0f / cm : 0.f;
        unsigned lo = 0, hi = 0;
#pragma unroll
        for (int t = 0; t < 4; ++t) { lo |= ((unsigned)(int)__builtin_rintf(s[t * 33] * inv) & 255u) << (8 * t); hi |= ((unsigned)(int)__builtin_rintf(s[(4 + t) * 33] * inv) & 255u) << (8 * t); }
        v2u o; o.x = lo; o.y = hi; *(GAS v2u*)(WT + (size_t)(row_off + n0 + n) * K + k0 + 8 * c) = o; }
    LDS_WAIT(); asm volatile("" ::: "memory");
}
__device__ __forceinline__ void rms_row_to_bf16(const float* xrow, const float* gain, bf16* orow, int lane) {
    const GAS f32x4* xr = (const GAS f32x4*)xrow + lane; const GAS f32x4* gr = (const GAS f32x4*)gain + lane;
    f32x4 v[4]; float s = 0.f;
#pragma unroll
    for (int j = 0; j < 4; ++j) { v[j] = xr[64 * j]; s += (v[j].x * v[j].x + v[j].y * v[j].y) + (v[j].z * v[j].z + v[j].w * v[j].w); }
    const float rstd = 1.0f / sqrtf(wave_sum(s) * (1.f / D) + EPS);
    GAS unsigned long long* o8 = (GAS unsigned long long*)orow + lane;
#pragma unroll
    for (int j = 0; j < 4; ++j) { const f32x4 gg = gr[64 * j]; o8[64 * j] = (unsigned long long)pk2(v[j].x * rstd * gg.x, v[j].y * rstd * gg.y) | ((unsigned long long)pk2(v[j].z * rstd * gg.z, v[j].w * rstd * gg.w) << 32); }
}
__device__ __forceinline__ int t5_bucket(int rel) {
    const int ret = rel > 0 ? 16 : 0; const int n = rel < 0 ? -rel : rel;
    const float nf = (float)(n > 1 ? n : 1);
    int large = 8 + (int)(logf(nf / 8.0f) / logf(128.0f) * 8.0f);
    large = large < 15 ? large : 15;
    return ret + (n < 8 ? n : large);
}

__device__ __forceinline__ void p0_prologue(Frame& F) {
    LAS float* scr = (LAS float*)(F.lds + RING_OFF + F.wave * 16384);
    const int gw = F.vcu * NWAVES + F.wave, NGW = F.G * NWAVES;
    bf16* WinT = (bf16*)(F.ws + WS_WIN); bf16* WoutT = (bf16*)(F.ws + WS_WOUT); bf16* WgvT = (bf16*)(F.ws + WS_WGV); bf16* WdT = (bf16*)(F.ws + WS_WD);
    constexpr int I_IN = (D / 64) * (NPROJ / 32), I_OUT = (MIXW / 64) * (D / 32), I_G = (D / 64) * (FF / 32), I_D = (FF / 64) * (D / 32);
    constexpr int NITEMS = I_IN + I_OUT + 2 * I_G + I_D;
    for (int it = gw; it < NITEMS; it += NGW) {
        int r = it;
        if (r < I_IN) { p0_transpose_item(F.w_in, D, NPROJ, WinT, 0, scr, r, F.lane, F.g_mix); continue; } r -= I_IN;
        if (r < I_OUT) { const int k0 = 64 * (r / (D / 32)); p0_transpose_item(F.w_out, MIXW, D, WoutT, 0, scr, r, F.lane, k0 < AW ? F.g_attn : F.g_four - AW); continue; } r -= I_OUT;
        if (r < 2 * I_G) { const bool isv = r >= I_G; p0_colmax_item(isv ? F.w_val : F.w_gate, D, FF, (unsigned*)(F.ctl + CW_CMAX), isv ? 128 : 0, isv ? r - I_G : r, F.lane, F.g_ffn); continue; } r -= 2 * I_G;
        p0_transpose_item(F.w_down, FF, D, WdT, 0, scr, r, F.lane);
    }
    float* tabBias = (float*)(F.ws + WS_TAB + TAB_BIAS); float* tabMg = (float*)(F.ws + WS_TAB + TAB_MG); float* tabTw = (float*)(F.ws + WS_TAB + TAB_TW);
    const int gt = F.vcu * (NWAVES * 64) + F.tid, NGT = F.G * NWAVES * 64;
    for (int i = gt; i < 3 * 129 * 12; i += NGT) { const int h = i % 12, jj = (i / 12) % 129, br = i / (12 * 129); const int dil = br == 0 ? 1 : (br == 1 ? 4 : 16);
        tabBias[i] = F.rel_tab[t5_bucket((jj - 64) * dil) * 12 + h]; }
    for (int i = gt; i < 4 * 64 * 128; i += NGT) { const int col = i & 127, c = (i >> 7) & 63, g = i >> 13; const int e = col & 63; float acc = 0.f;
        for (int d = 0; d < 64; ++d) { const float rev = (float)((c * d) & 63) * (1.0f / 64.0f); const float t = col < 64 ? __builtin_amdgcn_cosf(rev) : -__builtin_amdgcn_sinf(rev); acc += t * F.f_w[(g * 64 + d) * 64 + e]; }
        tabMg[i] = acc; }
    for (int i = gt; i < 4096; i += NGT) { float sv, cv; sincospif((float)i * (1.0f / 2048.0f), &sv, &cv); tabTw[2 * i] = cv; tabTw[2 * i + 1] = sv; }
    bf16* XN = (bf16*)(F.ws + WS_XN);
    {   float* RS0 = (float*)(F.ws + WS_RS0);
        for (int m0 = gw; m0 < M; m0 += 4 * NGW) { f32x4 v[4][4];
#pragma unroll
            for (int r = 0; r < 4; ++r) { const int m = m0 + r * NGW; const GAS f32x4* xr = (const GAS f32x4*)(F.x + (size_t)(m < M ? m : 0) * D) + F.lane;
#pragma unroll
                for (int j = 0; j < 4; ++j) v[r][j] = xr[64 * j]; }
#pragma unroll
            for (int r = 0; r < 4; ++r) { const int m = m0 + r * NGW; float s = 0.f;
#pragma unroll
                for (int j = 0; j < 4; ++j) s += (v[r][j].x * v[r][j].x + v[r][j].y * v[r][j].y) + (v[r][j].z * v[r][j].z + v[r][j].w * v[r][j].w);
                const float rstd = 1.0f / sqrtf(wave_sum(s) * (1.f / D) + EPS);
                if (m < M) { GAS unsigned long long* o8 = (GAS unsigned long long*)(XN + (size_t)m * D) + F.lane; if (F.lane == 0) RS0[m] = rstd;
#pragma unroll
                    for (int j = 0; j < 4; ++j) { const f32x4 t = v[r][j]; o8[64 * j] = (unsigned long long)pk2(t.x, t.y) | ((unsigned long long)pk2(t.z, t.w) << 32); } } } } }
}

namespace att {
typedef short bf16x8 __attribute__((ext_vector_type(8)));
typedef short v4i16 __attribute__((ext_vector_type(4)));
constexpr float LOG2E = 1.4426950408889634f;
constexpr int TABN = 512, TPAD0 = 128;
constexpr int LDS_K = 0, LDS_V = 49152, LDS_T0 = 98304, LDS_T1 = 98304 + 8192;
struct QT { bf16x8 q[2]; f32x4 o[4]; float m, l; };
__device__ __forceinline__ v4i16 vtr(const LAS unsigned char* p) { return __builtin_amdgcn_ds_read_tr16_b64_v4i16((LAS v4i16*)p); }

__device__ __forceinline__ void build_table(Frame& F, int ldsoff, int br, int h) {
    const float* tabBias = (const float*)(F.ws + WS_TAB + TAB_BIAS);
    LAS float* T = (LAS float*)(F.lds + ldsoff);
    for (int e = F.tid; e < 4 * TABN; e += NWAVES * 64) { const int s = e / TABN, n = e % TABN; const int r64 = n + s - TPAD0;
        T[e] = (r64 >= 0 && r64 <= 128) ? tabBias[(br * 129 + r64) * 12 + h] * LOG2E : -INFINITY; }
}
__device__ __forceinline__ const LAS float* table_ptr(Frame& F, int ldsoff, int idx0) { const int s = idx0 & 3; return (const LAS float*)(F.lds + ldsoff) + s * TABN + (idx0 - s); }

__device__ __forceinline__ int pass_tok(int mode, int a, int row) {
    if (mode == 0) { const int t = a - 64 + row; return (t >= 0 && t < SEQ) ? t : -1; }
    if (mode == 3) return a + 16 * row;
    const int hi = row >= 192 ? 1 : 0, u = a + (hi ? row - 192 : row), c = 2 * (mode - 1) + hi; return (u >= 0 && u < SEQ / 4) ? c + 4 * u : -1;
}
struct Pre { v4u k[6], v[6]; };
template <int NIT> __device__ __forceinline__ void prefetch(Frame& F, Pre& R, const bf16* P, int h, int mode, int a) {
#pragma unroll
    for (int it = 0; it < NIT; ++it) { const int idx = F.tid + it * (NWAVES * 64), row = idx >> 3, ph = idx & 7; const int t = pass_tok(mode, a, row);
        const int ck = ph ^ ((row >> 1) & 7), cv = ph ^ (((row >> 1) & 3) << 1);
        R.k[it] = (v4u){0u, 0u, 0u, 0u}; R.v[it] = (v4u){0u, 0u, 0u, 0u};
        if (t >= 0) { const bf16* rp = P + (size_t)t * NPROJ + h * 64; R.k[it] = *(const GAS v4u*)(rp + AW + ck * 8); R.v[it] = *(const GAS v4u*)(rp + 2 * AW + cv * 8); } }
}
template <int NIT> __device__ __forceinline__ void commit(Frame& F, const Pre& R) {
#pragma unroll
    for (int it = 0; it < NIT; ++it) { const int idx = F.tid + it * (NWAVES * 64);
        *(LAS v4u*)(F.lds + LDS_K + idx * 16) = R.k[it]; *(LAS v4u*)(F.lds + LDS_V + idx * 16) = R.v[it]; }
}
__device__ __forceinline__ float xmax4(float v) {
    auto a = __builtin_amdgcn_permlane16_swap(__float_as_uint(v), __float_as_uint(v), false, false); v = fmaxf(__uint_as_float(a[0]), __uint_as_float(a[1]));
    auto b = __builtin_amdgcn_permlane32_swap(__float_as_uint(v), __float_as_uint(v), false, false); return fmaxf(__uint_as_float(b[0]), __uint_as_float(b[1]));
}
__device__ __forceinline__ float xsum4(float v) {
    auto a = __builtin_amdgcn_permlane16_swap(__float_as_uint(v), __float_as_uint(v), false, false); v = __uint_as_float(a[0]) + __uint_as_float(a[1]);
    auto b = __builtin_amdgcn_permlane32_swap(__float_as_uint(v), __float_as_uint(v), false, false); return __uint_as_float(b[0]) + __uint_as_float(b[1]);
}
__device__ __forceinline__ void load_q(QT& T, const bf16* qrow  , int g) {
#pragma unroll
    for (int ks = 0; ks < 2; ++ks) { const v4u w = *(const GAS v4u*)(qrow + 8 * g + 32 * ks); const float sc = 0.125f * LOG2E; v4u o;
        o.x = pk2(bflo(w.x) * sc, bfhi(w.x) * sc); o.y = pk2(bflo(w.y) * sc, bfhi(w.y) * sc); o.z = pk2(bflo(w.z) * sc, bfhi(w.z) * sc); o.w = pk2(bflo(w.w) * sc, bfhi(w.w) * sc);
        T.q[ks] = __builtin_bit_cast(bf16x8, o); }
#pragma unroll
    for (int db = 0; db < 4; ++db) T.o[db] = (f32x4){0.f, 0.f, 0.f, 0.f};
    T.m = -1e30f; T.l = 0.f;
}
typedef float f32x2_t __attribute__((ext_vector_type(2))); typedef __bf16 bf16x2_t __attribute__((ext_vector_type(2)));
__device__ __forceinline__ unsigned cvtpk(float lo, float hi) { f32x2_t v = {lo, hi}; bf16x2_t b = __builtin_convertvector(v, bf16x2_t); return __builtin_bit_cast(unsigned, b); }
constexpr float THR = 8.0f;
template <int NQ, int NP> __device__ __forceinline__ void attn_step(QT (&T)[NQ], const LAS unsigned char* kp, const LAS unsigned char* vp, const LAS float* const (&tp)[NQ], int p, int koff0, int koff1, const int (&voff)[4], int klo, int khi, bool edge, int g) {
    bf16x8 kf[NP][4]; v4i16 vlo[NP][4], vhi[NP][4];
#pragma unroll
    for (int c = 0; c < NP; ++c) { kf[c][0] = *(const LAS bf16x8*)(kp + c * 4096 + koff0); kf[c][1] = *(const LAS bf16x8*)(kp + c * 4096 + koff1); kf[c][2] = *(const LAS bf16x8*)(kp + c * 4096 + 2048 + koff0); kf[c][3] = *(const LAS bf16x8*)(kp + c * 4096 + 2048 + koff1);
#pragma unroll
        for (int db = 0; db < 4; ++db) { vlo[c][db] = vtr(vp + c * 4096 + voff[db]); vhi[c][db] = vtr(vp + c * 4096 + 2048 + voff[db]); } }
#pragma unroll
    for (int n = 0; n < NQ; ++n) {
        f32x4 s[NP][2];
#pragma unroll
        for (int c = 0; c < NP; ++c) {
            s[c][0] = *(const LAS f32x4*)(tp[n] + (p + c) * 32); s[c][1] = *(const LAS f32x4*)(tp[n] + (p + c) * 32 + 16);
            s[c][0] = __builtin_amdgcn_mfma_f32_16x16x32_bf16(kf[c][0], T[n].q[0], s[c][0], 0, 0, 0); s[c][0] = __builtin_amdgcn_mfma_f32_16x16x32_bf16(kf[c][1], T[n].q[1], s[c][0], 0, 0, 0);
            s[c][1] = __builtin_amdgcn_mfma_f32_16x16x32_bf16(kf[c][2], T[n].q[0], s[c][1], 0, 0, 0); s[c][1] = __builtin_amdgcn_mfma_f32_16x16x32_bf16(kf[c][3], T[n].q[1], s[c][1], 0, 0, 0);
            if (edge) { const int kk = (p + c) * 32 + 4 * g;
#pragma unroll
                for (int r = 0; r < 4; ++r) { if (kk + r < klo || kk + r >= khi) s[c][0][r] = -INFINITY; if (kk + 16 + r < klo || kk + 16 + r >= khi) s[c][1][r] = -INFINITY; } } }
        float tm = fmaxf(fmaxf(fmaxf(s[0][0][0], s[0][0][1]), fmaxf(s[0][0][2], s[0][0][3])), fmaxf(fmaxf(s[0][1][0], s[0][1][1]), fmaxf(s[0][1][2], s[0][1][3])));
        if (NP == 2) tm = fmaxf(tm, fmaxf(fmaxf(fmaxf(s[NP - 1][0][0], s[NP - 1][0][1]), fmaxf(s[NP - 1][0][2], s[NP - 1][0][3])), fmaxf(fmaxf(s[NP - 1][1][0], s[NP - 1][1][1]), fmaxf(s[NP - 1][1][2], s[NP - 1][1][3]))));
        tm = xmax4(tm);
        if (__any(tm > T[n].m + THR)) { const float mn = fmaxf(T[n].m, tm), al = __builtin_amdgcn_exp2f(T[n].m - mn); T[n].m = mn; T[n].l *= al;
#pragma unroll
            for (int db = 0; db < 4; ++db) T[n].o[db] = T[n].o[db] * al; }
        const float mref = T[n].m; float ls = 0.f;
#pragma unroll
        for (int c = 0; c < NP; ++c) {
#pragma unroll
            for (int r = 0; r < 4; ++r) { s[c][0][r] = __builtin_amdgcn_exp2f(s[c][0][r] - mref); s[c][1][r] = __builtin_amdgcn_exp2f(s[c][1][r] - mref); }
            ls += ((s[c][0][0] + s[c][0][1]) + (s[c][0][2] + s[c][0][3])) + ((s[c][1][0] + s[c][1][1]) + (s[c][1][2] + s[c][1][3])); }
        T[n].l += ls;
#pragma unroll
        for (int c = 0; c < NP; ++c) {
            v4u pw; pw.x = cvtpk(s[c][0][0], s[c][0][1]); pw.y = cvtpk(s[c][0][2], s[c][0][3]); pw.z = cvtpk(s[c][1][0], s[c][1][1]); pw.w = cvtpk(s[c][1][2], s[c][1][3]);
            const bf16x8 pf = __builtin_bit_cast(bf16x8, pw);
#pragma unroll
            for (int db = 0; db < 4; ++db) { const bf16x8 vf = (bf16x8){vlo[c][db][0], vlo[c][db][1], vlo[c][db][2], vlo[c][db][3], vhi[c][db][0], vhi[c][db][1], vhi[c][db][2], vhi[c][db][3]};
                T[n].o[db] = __builtin_amdgcn_mfma_f32_16x16x32_bf16(vf, pf, T[n].o[db], 0, 0, 0); } }
    }
}
template <int NQ> __device__ __forceinline__ void attn_job(QT (&T)[NQ], const LAS unsigned char* Kw, const LAS unsigned char* Vw, int npairs, const LAS float* const (&tp)[NQ], int klo, int khi, bool edge, int lane) {
    const int i = lane & 15, g = lane >> 4;
    const int koff0 = i * 128 + (((g) ^ (i >> 1)) << 4), koff1 = i * 128 + (((g + 4) ^ (i >> 1)) << 4);
    const int qq = i >> 2, pp = i & 3, vr = 4 * g + qq, fv = (vr >> 1) & 3;
    int voff[4];
#pragma unroll
    for (int db = 0; db < 4; ++db) voff[db] = vr * 128 + ((((db ^ fv) << 1) + (pp >> 1)) << 4) + (pp & 1) * 8;
    int p = 0;
    if (NQ == 1) {
#pragma unroll 1
        for (; p + 2 <= npairs; p += 2) attn_step<NQ, 2>(T, Kw + p * 4096, Vw + p * 4096, tp, p, koff0, koff1, voff, klo, khi, edge, g);
    }
#pragma unroll 1
    for (; p < npairs; ++p) attn_step<NQ, 1>(T, Kw + p * 4096, Vw + p * 4096, tp, p, koff0, koff1, voff, klo, khi, edge, g);
}
__device__ __forceinline__ void four_ssq(Frame& F) {
    const bf16* A2 = (const bf16*)(F.ws + WS_A2); float* SSA = (float*)(F.ws + WS_SSA);
    const int gw = F.vcu * NWAVES + F.wave, NGW = F.G * NWAVES;
    for (int m0 = gw; m0 < M; m0 += 4 * NGW) { v2u w[4];
#pragma unroll
        for (int r = 0; r < 4; ++r) { const int m = (m0 + r * NGW) < M ? (m0 + r * NGW) : 0; w[r] = *(const GAS v2u*)(A2 + (size_t)m * MIXW + AW + 4 * F.lane); }
#pragma unroll
        for (int r = 0; r < 4; ++r) { const int m = m0 + r * NGW; const float a = bflo(w[r].x), b2 = bfhi(w[r].x), c = bflo(w[r].y), d = bfhi(w[r].y);
            const float s = wave_sum((a * a + b2 * b2) + (c * c + d * d));
            if (m < M && F.lane == 0) *(GAS f32x4*)(SSA + (size_t)m * 16 + 12) = (f32x4){s, 0.f, 0.f, 0.f}; } }
}
__device__ __forceinline__ void phase_local(Frame& F) {
    constexpr int NU = BATCH * NH * 16; const int per = (NU + F.G - 1) / F.G, ub = F.vcu * per, ue = (ub + per) < NU ? (ub + per) : NU;
    const bf16* PROJ = (const bf16*)(F.ws + WS_PROJ); const int lane = F.lane, w = F.wave, i = lane & 15, g = lane >> 4;
    const int idx4 = w >> 1, rA = w & 1, rB = 2 + (w & 1);
    Pre R; int hprev = -1;
    __syncthreads();
    if (ub < ue) { const int bh = ub >> 4; prefetch<6>(F, R, PROJ + (size_t)(bh / NH) * SEQ * NPROJ, bh % NH, 0, (ub & 15) * 256); }
    for (int u = ub; u < ue; ++u) {
        const int bh = u >> 4, b = bh / NH, h = bh % NH, s0 = (u & 15) * 256;
        const bf16* P = PROJ + (size_t)b * SEQ * NPROJ; bf16* A2 = (bf16*)(F.ws + WS_A2) + (size_t)b * SEQ * MIXW; float* ML = (float*)(F.ws + WS_ML) + (size_t)b * SEQ * NH * 2;
        __syncthreads();
        commit<6>(F, R);
        if (h != hprev) { build_table(F, LDS_T0, 0, h); build_table(F, LDS_T1, 1, h); hprev = h; }
        __syncthreads();
        const int u0 = s0 / 4 - 64;
        QT T[2];
        const int tokA = s0 + rA + 4 * (16 * idx4 + i), tokB = s0 + rB + 4 * (16 * idx4 + i);
        load_q(T[0], P + (size_t)tokA * NPROJ + h * 64, g); load_q(T[1], P + (size_t)tokB * NPROJ + h * 64, g);
        asm volatile("" ::: "memory");
        prefetch<6>(F, R, P, h, 1, u0);
        {
            const LAS float* tp[2] = { table_ptr(F, LDS_T0, 4 * g - 4 * i - rA + TPAD0), table_ptr(F, LDS_T0, 4 * g - 4 * i - rB + TPAD0) };
            int klo = 64 - s0 - 64 * idx4; klo = klo > 0 ? klo : 0; int khi = SEQ + 64 - s0 - 64 * idx4; khi = khi < 192 ? khi : 192;
            attn_job<2>(T, F.lds + LDS_K + 64 * idx4 * 128, F.lds + LDS_V + 64 * idx4 * 128, 6, tp, klo, khi, (klo > 0 || khi < 192), lane);
        }
#pragma unroll
        for (int pass = 0; pass < 2; ++pass) {
            __syncthreads();
            commit<6>(F, R);
            __syncthreads();
            if (pass == 0) prefetch<6>(F, R, P, h, 2, u0);
            else if (u + 1 < ue) { const int bh2 = (u + 1) >> 4; prefetch<6>(F, R, PROJ + (size_t)(bh2 / NH) * SEQ * NPROJ, bh2 % NH, 0, ((u + 1) & 15) * 256); }
            const int cl = w & 1, lo = idx4 < 2 ? idx4 : 2;
            const LAS float* tp[1] = { table_ptr(F, LDS_T1, 4 * g - i + 16 * (lo - idx4) + TPAD0) };
            int klo = -(u0 + 16 * lo); klo = klo > 0 ? klo : 0; int khi = SEQ / 4 - (u0 + 16 * lo); khi = khi < 160 ? khi : 160;
            QT (&Tp)[1] = *(QT (*)[1])(&T[pass]);
            attn_job<1>(Tp, F.lds + LDS_K + (192 * cl + 16 * lo) * 128, F.lds + LDS_V + (192 * cl + 16 * lo) * 128, 5, tp, klo, khi, (klo > 0 || khi < 160), lane);
        }
#pragma unroll
        for (int n = 0; n < 2; ++n) {
            const float l = xsum4(T[n].l); const float inv = 1.0f / l; const int tok = n == 0 ? tokA : tokB;
#pragma unroll
            for (int db = 0; db < 4; ++db) { v2u o; o.x = pk2(T[n].o[db][0] * inv, T[n].o[db][1] * inv); o.y = pk2(T[n].o[db][2] * inv, T[n].o[db][3] * inv);
                *(GAS v2u*)(A2 + (size_t)tok * MIXW + h * 64 + 16 * db + 4 * g) = o; }
            if (g == 0) { float* mlp = ML + ((size_t)tok * NH + h) * 2; mlp[0] = T[n].m; mlp[1] = l; }
        }
    }
    __syncthreads();
}
__device__ __forceinline__ void phase_class(Frame& F) {
    four_ssq(F);
    constexpr int NU = BATCH * NH * 16; const int per = (NU + F.G - 1) / F.G, ub = F.vcu * per, ue = (ub + per) < NU ? (ub + per) : NU;
    const bf16* PROJ = (const bf16*)(F.ws + WS_PROJ); const int lane = F.lane, w = F.wave, i = lane & 15, g = lane >> 4; float* SSA = (float*)(F.ws + WS_SSA);
    Pre R; int hprev = -1;
    __syncthreads();
    if (ub < ue) { const int bh = ub >> 4; prefetch<4>(F, R, PROJ + (size_t)(bh / NH) * SEQ * NPROJ, bh % NH, 3, ub & 15); }
    for (int u = ub; u < ue; ++u) {
        const int bh = u >> 4, b = bh / NH, h = bh % NH, r = u & 15;
        const bf16* P = PROJ + (size_t)b * SEQ * NPROJ; bf16* A2 = (bf16*)(F.ws + WS_A2) + (size_t)b * SEQ * MIXW; const float* ML = (const float*)(F.ws + WS_ML) + (size_t)b * SEQ * NH * 2;
        __syncthreads();
        commit<4>(F, R);
        if (h != hprev) { build_table(F, LDS_T0, 2, h); hprev = h; }
        __syncthreads();
        QT T2[2]; float mlv[2], llv[2]; v2u pvv[2][4];
#pragma unroll
        for (int n = 0; n < 2; ++n) { const int qt = n == 0 ? (w < 7 ? w : 11) : (w < 4 ? w + 7 : (w < 7 ? w + 8 : 15)); const int tok = r + 16 * (16 * qt + i);
            load_q(T2[n], P + (size_t)tok * NPROJ + h * 64, g);
            const float* mlp = ML + ((size_t)tok * NH + h) * 2; mlv[n] = mlp[0]; llv[n] = mlp[1];
#pragma unroll
            for (int db = 0; db < 4; ++db) pvv[n][db] = *(const GAS v2u*)(A2 + (size_t)tok * MIXW + h * 64 + 16 * db + 4 * g); }
        asm volatile("" ::: "memory");
        if (u + 1 < ue) { const int bh2 = (u + 1) >> 4; prefetch<4>(F, R, PROJ + (size_t)(bh2 / NH) * SEQ * NPROJ, bh2 % NH, 3, (u + 1) & 15); }
#pragma unroll
        for (int n = 0; n < 2; ++n) {
            const int qt = n == 0 ? (w < 7 ? w : 11) : (w < 4 ? w + 7 : (w < 7 ? w + 8 : 15));
            int lo = qt - 4 > 0 ? qt - 4 : 0, hi = qt + 4 < 15 ? qt + 4 : 15; if (((hi - lo + 1) & 1) != 0) { if (hi < 15) ++hi; else --lo; }
            const int tok = r + 16 * (16 * qt + i);
            QT (&T)[1] = *(QT (*)[1])(&T2[n]);
            const LAS float* tp[1] = { table_ptr(F, LDS_T0, 4 * g - i + 16 * (lo - qt) + 64 + TPAD0) };
            attn_job<1>(T, F.lds + LDS_K + 16 * lo * 128, F.lds + LDS_V + 16 * lo * 128, (hi - lo + 1) >> 1, tp, 0, 1 << 20, false, lane);
            const float l16 = xsum4(T[0].l);
            const float ml = mlv[n], ll = llv[n];
            const float mm = fmaxf(ml, T[0].m), a = __builtin_amdgcn_exp2f(ml - mm) * ll, bb = __builtin_amdgcn_exp2f(T[0].m - mm), inv = 1.0f / (a + bb * l16); float sq = 0.f;
#pragma unroll
            for (int db = 0; db < 4; ++db) { GAS v2u* op = (GAS v2u*)(A2 + (size_t)tok * MIXW + h * 64 + 16 * db + 4 * g); const v2u pv = pvv[n][db]; v2u o;
                const float f0 = (bflo(pv.x) * a + T[0].o[db][0] * bb) * inv, f1 = (bfhi(pv.x) * a + T[0].o[db][1] * bb) * inv, f2 = (bflo(pv.y) * a + T[0].o[db][2] * bb) * inv, f3 = (bfhi(pv.y) * a + T[0].o[db][3] * bb) * inv;
                sq += (f0 * f0 + f1 * f1) + (f2 * f2 + f3 * f3); o.x = pk2(f0, f1); o.y = pk2(f2, f3);
                *op = o; }
            sq = xsum4(sq);
            if (g == 0) SSA[((size_t)b * SEQ + tok) * 16 + h] = sq;
        }
    }
    __syncthreads();
}
}


namespace fou {
typedef short bf16x8 __attribute__((ext_vector_type(8)));
typedef short v4i16 __attribute__((ext_vector_type(4)));
constexpr int LX = 0, LC = LDSCTL_OFF + 8192, LS = LDSCTL_OFF + 16384;
__device__ __forceinline__ int gsw(int s2) { const int pr = (s2 >> 1) & 7; return (pr & 4) | ((pr & 1) << 1) | ((pr >> 1) & 1); }
__device__ __forceinline__ int xaddr(int pe, int s2, int chunk) { return LX + pe * 8192 + s2 * 128 + (((chunk ^ gsw(s2) ^ pe) & 7) << 4); }
__device__ __forceinline__ int maddr(int base, int k, int chunk) { return base + k * 128 + (((chunk ^ (k >> 1)) & 7) << 4); }
__device__ __forceinline__ v4i16 vtr(const LAS unsigned char* p) { return __builtin_amdgcn_ds_read_tr16_b64_v4i16((LAS v4i16*)p); }
__device__ __forceinline__ bf16x8 neg8(bf16x8 v) { v4u w = __builtin_bit_cast(v4u, v); w.x ^= 0x80008000u; w.y ^= 0x80008000u; w.z ^= 0x80008000u; w.w ^= 0x80008000u; return __builtin_bit_cast(bf16x8, w); }

__device__ __forceinline__ void fourier_unit(Frame& F, int b, int g, int ec) {
    const bf16* PROJ = (const bf16*)(F.ws + WS_PROJ); bf16* A2 = (bf16*)(F.ws + WS_A2); const float* tabMg = (const float*)(F.ws + WS_TAB + TAB_MG);
    const int lane = F.lane, w = F.wave, li = lane & 15, gq = lane >> 4, e0 = 8 * ec;
    LAS unsigned char* L = F.lds;
    __syncthreads();
    bf16x8 mb[2];
#pragma unroll
    for (int ks = 0; ks < 2; ++ks) { float v[8];
#pragma unroll
        for (int j = 0; j < 8; ++j) { const int c = 8 * gq + j + 32 * ks; const int col = li < 8 ? e0 + li : 64 + e0 + (li & 7); v[j] = tabMg[(g * 64 + c) * 128 + col]; }
        v4u o; o.x = pk2(v[0], v[1]); o.y = pk2(v[2], v[3]); o.z = pk2(v[4], v[5]); o.w = pk2(v[6], v[7]); mb[ks] = __builtin_bit_cast(bf16x8, o); }
    const bf16* ub = PROJ + (size_t)(b * SEQ) * NPROJ + 3 * AW + g * 64 + 8 * gq;
#pragma unroll 8
    for (int it = 0; it < 32; ++it) { const int tile = w + 8 * it, s2 = tile & 63, tq = tile >> 6;
        const bf16* up = ub + (size_t)(64 * (16 * tq + li) + s2) * NPROJ;
        const bf16x8 a0 = __builtin_bit_cast(bf16x8, *(const GAS v4u*)up), a1 = __builtin_bit_cast(bf16x8, *(const GAS v4u*)(up + 32));
        f32x4 d = (f32x4){0.f, 0.f, 0.f, 0.f};
        d = __builtin_amdgcn_mfma_f32_16x16x32_bf16(a0, mb[0], d, 0, 0, 0); d = __builtin_amdgcn_mfma_f32_16x16x32_bf16(a1, mb[1], d, 0, 0, 0);
        v2u o; o.x = pk2(d[0], d[1]); o.y = pk2(d[2], d[3]); *(LAS v2u*)(L + xaddr(li, s2, 2 * tq + (gq >> 1)) + (gq & 1) * 8) = o; }
    __syncthreads();
    const int e = w;
#pragma unroll 1
    for (int mt = 0; mt < 4; ++mt) { const int s2 = 16 * mt + li;
        bf16x8 yr[2], yi[2], nyr[2];
#pragma unroll
        for (int kh = 0; kh < 2; ++kh) { yr[kh] = *(const LAS bf16x8*)(L + xaddr(e, s2, gq + 4 * kh)); yi[kh] = *(const LAS bf16x8*)(L + xaddr(8 + e, s2, gq + 4 * kh)); nyr[kh] = neg8(yr[kh]); }
#pragma unroll
        for (int nt = 0; nt < 4; ++nt) { const int k = 16 * nt + li;
            const bf16x8 c0 = *(const LAS bf16x8*)(L + maddr(LC, k, gq)), c1 = *(const LAS bf16x8*)(L + maddr(LC, k, gq + 4)), s0 = *(const LAS bf16x8*)(L + maddr(LS, k, gq)), s1 = *(const LAS bf16x8*)(L + maddr(LS, k, gq + 4));
            f32x4 tr = (f32x4){0.f, 0.f, 0.f, 0.f}, ti = (f32x4){0.f, 0.f, 0.f, 0.f};
            tr = __builtin_amdgcn_mfma_f32_16x16x32_bf16(c0, yr[0], tr, 0, 0, 0); tr = __builtin_amdgcn_mfma_f32_16x16x32_bf16(c1, yr[1], tr, 0, 0, 0);
            tr = __builtin_amdgcn_mfma_f32_16x16x32_bf16(s0, yi[0], tr, 0, 0, 0); tr = __builtin_amdgcn_mfma_f32_16x16x32_bf16(s1, yi[1], tr, 0, 0, 0);
            ti = __builtin_amdgcn_mfma_f32_16x16x32_bf16(c0, yi[0], ti, 0, 0, 0); ti = __builtin_amdgcn_mfma_f32_16x16x32_bf16(c1, yi[1], ti, 0, 0, 0);
            ti = __builtin_amdgcn_mfma_f32_16x16x32_bf16(s0, nyr[0], ti, 0, 0, 0); ti = __builtin_amdgcn_mfma_f32_16x16x32_bf16(s1, nyr[1], ti, 0, 0, 0);
            float orr[4], oii[4];
#pragma unroll
            for (int r = 0; r < 4; ++r) { const int k1 = 16 * nt + 4 * gq + r; const float rev = (float)((k1 * s2) & 4095) * (1.0f / 4096.0f); const float cv = __builtin_amdgcn_cosf(rev), sv = __builtin_amdgcn_sinf(rev);
                orr[r] = tr[r] * cv + ti[r] * sv; oii[r] = ti[r] * cv - tr[r] * sv; }
            v2u o; o.x = pk2(orr[0], orr[1]); o.y = pk2(orr[2], orr[3]); *(LAS v2u*)(L + xaddr(e, s2, 2 * nt + (gq >> 1)) + (gq & 1) * 8) = o;
            o.x = pk2(oii[0], oii[1]); o.y = pk2(oii[2], oii[3]); *(LAS v2u*)(L + xaddr(8 + e, s2, 2 * nt + (gq >> 1)) + (gq & 1) * 8) = o; } }
    asm volatile("s_waitcnt lgkmcnt(0)" ::: "memory");
    bf16x8 af[4][4];
    { const int q = li >> 2, p = li & 3;
#pragma unroll
      for (int mt = 0; mt < 4; ++mt)
#pragma unroll
        for (int ks = 0; ks < 4; ++ks) { const int pe = (ks >> 1) * 8 + e, s2b = 8 * gq + 32 * (ks & 1) + q;
            const v4i16 lo = vtr(L + xaddr(pe, s2b, 2 * mt + (p >> 1)) + (p & 1) * 8), hi = vtr(L + xaddr(pe, s2b + 4, 2 * mt + (p >> 1)) + (p & 1) * 8);
            af[mt][ks] = (bf16x8){lo[0], lo[1], lo[2], lo[3], hi[0], hi[1], hi[2], hi[3]}; } }
    asm volatile("s_waitcnt lgkmcnt(0)" ::: "memory");
    __syncthreads();
    const float bias = F.f_b[g * 64 + e0 + e];
#pragma unroll 1
    for (int nt = 0; nt < 4; ++nt) { const int k2 = 16 * nt + li;
        const bf16x8 c0 = *(const LAS bf16x8*)(L + maddr(LC, k2, gq)), c1 = *(const LAS bf16x8*)(L + maddr(LC, k2, gq + 4)), s0 = *(const LAS bf16x8*)(L + maddr(LS, k2, gq)), s1 = *(const LAS bf16x8*)(L + maddr(LS, k2, gq + 4));
#pragma unroll
        for (int mt = 0; mt < 4; ++mt) { f32x4 d = (f32x4){0.f, 0.f, 0.f, 0.f};
            d = __builtin_amdgcn_mfma_f32_16x16x32_bf16(af[mt][0], c0, d, 0, 0, 0); d = __builtin_amdgcn_mfma_f32_16x16x32_bf16(af[mt][1], c1, d, 0, 0, 0);
            d = __builtin_amdgcn_mfma_f32_16x16x32_bf16(af[mt][2], s0, d, 0, 0, 0); d = __builtin_amdgcn_mfma_f32_16x16x32_bf16(af[mt][3], s1, d, 0, 0, 0);
#pragma unroll
            for (int r = 0; r < 4; ++r) { const int k1 = 16 * mt + 4 * gq + r; *(LAS bf16*)(L + LX + (k1 * 64 + k2) * 16 + e * 2) = (bf16)f2bf(d[r] * (1.0f / 512.0f) + bias); } } }
    __syncthreads();
    bf16* ob = A2 + (size_t)(b * SEQ) * MIXW + AW + g * 64 + e0;
#pragma unroll
    for (int j = 0; j < 8; ++j) { const int sl = F.tid + 512 * j, k1 = sl >> 6, k2 = sl & 63; const v4u v = *(const LAS v4u*)(L + LX + sl * 16); *(GAS v4u*)(ob + (size_t)(k1 + 64 * k2) * MIXW) = v; }
}
__device__ __forceinline__ void phase_fourier(Frame& F) {
    const float* tabTw = (const float*)(F.ws + WS_TAB + TAB_TW);
    __syncthreads();
    for (int idx = F.tid; idx < 4096; idx += NWAVES * 64) { const int k = idx >> 6, s = idx & 63, n = ((k * s) & 63) * 64;
        *(LAS bf16*)(F.lds + maddr(LC, k, s >> 3) + (s & 7) * 2) = (bf16)f2bf(tabTw[2 * n]); *(LAS bf16*)(F.lds + maddr(LS, k, s >> 3) + (s & 7) * 2) = (bf16)f2bf(tabTw[2 * n + 1]); }
    __syncthreads();
    for (int u = F.vcu; u < BATCH * NG * 8; u += F.G) fourier_unit(F, u >> 5, (u >> 3) & 3, u & 7);
    __syncthreads();
}
}

__device__ __forceinline__ void p10_final(Frame& F) {
    const bf16* X2 = (const bf16*)(F.ws + WS_XN); const float* SS2 = (const float*)(F.ws + WS_SS2);
    const int gw = F.vcu * NWAVES + F.wave, NGW = F.G * NWAVES; const int lane = F.lane;
    const GAS f32x4* gr = (const GAS f32x4*)(F.g_fin + 16 * lane); const f32x4 g0 = gr[0], g1 = gr[1], g2 = gr[2], g3 = gr[3];
    for (int m0 = gw; m0 < M; m0 += 4 * NGW) { v4u w0[4], w1[4]; float part[4];
#pragma unroll
        for (int r = 0; r < 4; ++r) { const int m = (m0 + r * NGW) < M ? (m0 + r * NGW) : 0; const GAS v4u* rp = (const GAS v4u*)(X2 + (size_t)m * D + 16 * lane); w0[r] = rp[0]; w1[r] = rp[1];
            part[r] = lane < 16 ? SS2[(size_t)m * 16 + lane] : 0.f; }
#pragma unroll
        for (int r = 0; r < 4; ++r) { const int m = m0 + r * NGW; const float rstd = 1.0f / sqrtf(wave_sum(part[r]) * (1.f / D) + EPS);
            if (m < M) { GAS f32x4* op = (GAS f32x4*)(F.out + (size_t)m * D + 16 * lane);
                op[0] = (f32x4){bflo(w0[r].x), bfhi(w0[r].x), bflo(w0[r].y), bfhi(w0[r].y)} * rstd * g0; op[1] = (f32x4){bflo(w0[r].z), bfhi(w0[r].z), bflo(w0[r].w), bfhi(w0[r].w)} * rstd * g1;
                op[2] = (f32x4){bflo(w1[r].x), bfhi(w1[r].x), bflo(w1[r].y), bfhi(w1[r].y)} * rstd * g2; op[3] = (f32x4){bflo(w1[r].z), bfhi(w1[r].z), bflo(w1[r].w), bfhi(w1[r].w)} * rstd * g3; } } }
}


__device__ __forceinline__ void p8_halo_fix(Frame& F, int pm) {
    const float* H = (const float*)(F.ws + WS_HALO); bf16* ACT = (bf16*)(F.ws + WS_GV); const int kt = pm & 15;
    for (int it = F.tid; it < 2 * (FF / 4); it += NWAVES * 64) { const int c4 = (it % (FF / 4)) * 4, side = it / (FF / 4);
        if ((side == 0 && kt == 0) || (side == 1 && kt == 15)) continue;
        const float* own = H + (size_t)(pm * 2 + side) * 3 * FF + c4; const float* nb = H + (size_t)((side == 0 ? (pm - 1) * 2 + 1 : (pm + 1) * 2)) * 3 * FF + c4;
        const f32x4 gn = *(const GAS f32x4*)nb, zp = *(const GAS f32x4*)(own + FF), vv = *(const GAS f32x4*)(own + 2 * FF), wt = *(const GAS f32x4*)(F.conv_w + (side == 0 ? 0 : 2 * FF) + c4);
        float a[4];
#pragma unroll
        for (int i = 0; i < 4; ++i) { const float z = zp[i] + wt[i] * gn[i]; a[i] = z * __builtin_amdgcn_rcpf(1.0f + __builtin_amdgcn_exp2f(-1.4426950408889634f * z)) * vv[i]; }
        const unsigned long long o = (unsigned long long)pk2(a[0], a[1]) | ((unsigned long long)pk2(a[2], a[3]) << 32);
        __hip_atomic_store((unsigned long long*)(ACT + (size_t)(pm * 256 + (side ? 255 : 0)) * FF + c4), o, __ATOMIC_RELAXED, __HIP_MEMORY_SCOPE_AGENT); }
}


__device__ __forceinline__ void p6_quant(Frame& F) {
    const bf16* X1 = (const bf16*)(F.ws + WS_XN); unsigned char* A8 = F.ws + WS_A8; float* SROW = (float*)(F.ws + WS_SS1); const unsigned* cmax = (const unsigned*)(F.ctl + CW_CMAX);
    const int gw = F.vcu * NWAVES + F.wave, NGW = F.G * NWAVES, lane = F.lane;
    {   LAS float* scr = (LAS float*)(F.lds + RING_OFF + F.wave * 16384); constexpr int I_G = (D / 64) * (FF / 32);
        for (int it = gw; it < 2 * I_G; it += NGW) { const bool isv = it >= I_G; p6_quant_item(isv ? F.w_val : F.w_gate, D, FF, F.ws + WS_WGV, isv ? 128 : 0, scr, isv ? it - I_G : it, lane, F.g_ffn, cmax); } }
    {   float* cw6 = (float*)(F.ws + WS_TAB + TAB_CW4); const int gt = F.vcu * (NWAVES * 64) + F.tid, NGT = F.G * NWAVES * 64;
        for (int i = gt; i < (FF / 128) * 768; i += NGT) { const int pn = i / 768, k = (i % 768) >> 7, c = i & 127, ch = 128 * pn + c;
            cw6[i] = k < 3 ? F.conv_w[k * FF + ch] : (k == 3 ? F.conv_b[ch] : __uint_as_float(cmax[256 * pn + (k == 5 ? 128 : 0) + c]) * (1.0f / 127.0f)); } }
    for (int m0 = gw; m0 < M; m0 += 4 * NGW) { v4u w0[4], w1[4];
#pragma unroll
        for (int r = 0; r < 4; ++r) { const int m = (m0 + r * NGW) < M ? (m0 + r * NGW) : 0; const GAS v4u* rp = (const GAS v4u*)(X1 + (size_t)m * D + 16 * lane); w0[r] = rp[0]; w1[r] = rp[1]; }
#pragma unroll
        for (int r = 0; r < 4; ++r) { const int m = m0 + r * NGW; float v[16];
            v[0] = bflo(w0[r].x); v[1] = bfhi(w0[r].x); v[2] = bflo(w0[r].y); v[3] = bfhi(w0[r].y); v[4] = bflo(w0[r].z); v[5] = bfhi(w0[r].z); v[6] = bflo(w0[r].w); v[7] = bfhi(w0[r].w);
            v[8] = bflo(w1[r].x); v[9] = bfhi(w1[r].x); v[10] = bflo(w1[r].y); v[11] = bfhi(w1[r].y); v[12] = bflo(w1[r].z); v[13] = bfhi(w1[r].z); v[14] = bflo(w1[r].w); v[15] = bfhi(w1[r].w);
            float ss = 0.f, mx = 0.f;
#pragma unroll
            for (int i = 0; i < 16; ++i) { ss += v[i] * v[i]; mx = fmaxf(mx, fabsf(v[i])); }
            ss = wave_sum(ss);
#pragma unroll
            for (int o = 1; o < 64; o <<= 1) mx = fmaxf(mx, __shfl_xor(mx, o));
            const float inv = mx > 0.f ? 127.0f / mx : 0.f; unsigned q[4];
#pragma unroll
            for (int j = 0; j < 4; ++j) { q[j] = 0;
#pragma unroll
                for (int t = 0; t < 4; ++t) q[j] |= ((unsigned)(int)__builtin_rintf(v[4 * j + t] * inv) & 255u) << (8 * t); }
            if (m < M) { *(GAS v4u*)(A8 + (size_t)m * D + 16 * lane) = (v4u){q[0], q[1], q[2], q[3]};
                if (lane == 0) SROW[m] = mx * (1.0f / 127.0f) * (1.0f / sqrtf(ss * (1.f / D) + EPS)); } } }
}

struct Args { const float* in[16]; float* out; unsigned char* ws; int ph_lo, ph_hi; };
__global__ void __launch_bounds__(NWAVES * 64, 2) hymba_fwd(Args args) {
    extern __shared__ __attribute__((aligned(16))) unsigned char lds[];
    Frame F;
    F.lds = (LAS unsigned char*)lds;
    F.MISC = (volatile LAS unsigned*)(F.lds + MISC_OFF);
    F.tid = threadIdx.x; F.lane = F.tid & 63; F.wave = __builtin_amdgcn_readfirstlane(F.tid >> 6);
    F.G = gridDim.x; { const int bx = blockIdx.x; F.vcu = (F.G % 8 == 0) ? (bx % 8) * (F.G / 8) + bx / 8 : bx; }
    F.ws = args.ws; F.ctl = (gu32*)(args.ws + WS_CTL);
    F.x = args.in[0]; F.g_mix = args.in[1]; F.w_in = args.in[2]; F.g_attn = args.in[3]; F.rel_tab = args.in[4]; F.f_w = args.in[5]; F.f_b = args.in[6]; F.g_four = args.in[7];
    F.w_out = args.in[8]; F.g_ffn = args.in[9]; F.w_gate = args.in[10]; F.w_val = args.in[11]; F.conv_w = args.in[12]; F.conv_b = args.in[13]; F.w_down = args.in[14]; F.g_fin = args.in[15];
    F.out = args.out;
    for (int u = F.tid; u < (LDS_BYTES - LDSCTL_OFF) / 4; u += NWAVES * 64) ((LAS unsigned*)(F.lds + LDSCTL_OFF))[u] = 0u;
    __syncthreads();
    XcdBarrier bar; bar.bar = (unsigned*)(F.ctl + CW_BAR); bar.x = 0; bar.st = nullptr;
    if (MK_ONE_LAUNCH) bar = xcd_barrier_post((unsigned*)(F.ctl + CW_BAR), F.MISC + 8);
#define GRID_BAR() do { if (MK_ONE_LAUNCH) xcd_barrier(bar); } while (0)
    const int lo = args.ph_lo, hi = args.ph_hi;
#define IN(k) (lo <= (k) && (k) < hi)
#define BOTH(k) (IN(k) && IN((k) + 1))
    if (IN(0)) { p0_prologue(F); if (BOTH(0)) GRID_BAR(); }
    if (IN(1)) {
        pg8::Gemm g{(const bf16*)(F.ws + WS_XN), (const bf16*)(F.ws + WS_WIN), M, NPROJ, D, D, 0}; pg8::StaticOrder S; S.init(M, NPROJ, F.G, (int)blockIdx.x);
        pg8::EpiBf16Row E{(bf16*)(F.ws + WS_PROJ), NPROJ, (const float*)(F.ws + WS_RS0)};
        pg8::gemm_phase<pg8::EpiBf16Row, pg8::StaticOrder, true, true>(F.lds + RING_OFF, g, S, E);
        if (BOTH(1)) GRID_BAR();
    }
    if (IN(2)) { att::phase_local(F); fou::phase_fourier(F); if (BOTH(2)) GRID_BAR(); }
    if (IN(3)) { att::phase_class(F); if (IN(3) && IN(5)) GRID_BAR(); }
    if (IN(5)) {
        pg8::Gemm g{(const bf16*)(F.ws + WS_A2), (const bf16*)(F.ws + WS_WOUT), M, D, MIXW, MIXW, 0}; pg8::StaticOrder S; S.init(M, D, F.G, (int)blockIdx.x);
        pg8::EpiX1N E{(const bf16*)(F.ws + WS_XN), (bf16*)(F.ws + WS_XN), D, (float*)(F.ws + WS_SS1), (const float*)(F.ws + WS_SSA), (LAS float*)(F.lds + LDSCTL_OFF + 8192)};
        pg8::gemm_phase<pg8::EpiX1N, pg8::StaticOrder, true, true>(F.lds + RING_OFF, g, S, E);
        if (IN(5) && IN(6)) GRID_BAR();
    }
    if (IN(6)) { p6_quant(F); if (IN(6) && IN(7)) GRID_BAR(); }
    if (IN(7)) {
        pg8::Gemm g{(const bf16*)(F.ws + WS_A8), (const bf16*)(F.ws + WS_WGV), M, 2 * FF, D / 2, D / 2, 0}; pg8::StaticOrder S; S.init(M, 2 * FF, F.G, (int)blockIdx.x);
        pg8::EpiConvGlu E{(bf16*)(F.ws + WS_GV), FF, (const float*)(F.ws + WS_SS1), F.conv_w, F.conv_b, (LAS float*)(F.lds + LDSCTL_OFF + 4096), M, (float*)(F.ws + WS_HALO), (const float*)(F.ws + WS_TAB + TAB_CW4)};
        pg8::gemm_phase<pg8::EpiConvGlu, pg8::StaticOrder, true, true, true>(F.lds + RING_OFF, g, S, E);
        if (IN(7) && IN(9)) GRID_BAR();
    }
    if (IN(9)) {
        pg8::Gemm g{(const bf16*)(F.ws + WS_GV), (const bf16*)(F.ws + WS_WD), M, D, FF, FF, 0}; pg8::StaticOrder S; S.init(M, D, F.G, (int)blockIdx.x);
        { pg8::Unit uu; for (int i = 0; S.next(i, uu); ++i) p8_halo_fix(F, uu.pm); }
        asm volatile("s_waitcnt vmcnt(0)" ::: "memory"); __syncthreads();
        if (F.G == 256) {
            pg8::EpiFinal E{(const bf16*)(F.ws + WS_XN), F.out, D, F.g_fin, (float*)(F.ws + WS_XBUF), (unsigned*)(F.ctl + CW_PANEL), F.lds + LDSCTL_OFF + 4096};
            pg8::gemm_phase<pg8::EpiFinal, pg8::StaticOrder, true, true>(F.lds + RING_OFF, g, S, E);
        } else {
            pg8::EpiX2 E{(bf16*)(F.ws + WS_XN), D, (float*)(F.ws + WS_SS2)};
            pg8::gemm_phase<pg8::EpiX2, pg8::StaticOrder, true, true>(F.lds + RING_OFF, g, S, E);
            if (BOTH(9)) GRID_BAR();
        }
    }
    if (IN(10) && F.G != 256) { p10_final(F); }
#undef IN
#undef BOTH
}

extern "C" void kernel_launch(void* const* d_in, const int* in_sizes, int n_in, void* d_out, int out_size, void* d_ws, size_t ws_size, hipStream_t stream) {
    static int grid = 0;
    if (grid == 0) {
        if (n_in != 16 || in_sizes[0] != M * D || out_size != M * D || ws_size < WS_END) { fprintf(stderr, "kernel_launch: shape/workspace mismatch: n_in %d in0 %d out %d ws %zu (need %zu)\n", n_in, n_in > 0 ? in_sizes[0] : -1, out_size, ws_size, (size_t)WS_END); grid = -1; return; }
        int dev = 0, cus = 0, per_cu = 0;
        if (hipGetDevice(&dev) != hipSuccess || hipDeviceGetAttribute(&cus, hipDeviceAttributeMultiprocessorCount, dev) != hipSuccess) { grid = -1; return; }
        if (hipFuncSetAttribute((const void*)hymba_fwd, hipFuncAttributeMaxDynamicSharedMemorySize, LDS_BYTES) != hipSuccess) { fprintf(stderr, "kernel_launch: hipFuncSetAttribute failed\n"); grid = -1; return; }
        if (hipOccupancyMaxActiveBlocksPerMultiprocessor(&per_cu, (const void*)hymba_fwd, NWAVES * 64, LDS_BYTES) != hipSuccess || per_cu < 1) { fprintf(stderr, "kernel_launch: occupancy query says %d blocks/CU\n", per_cu); (void)hipGetLastError(); grid = -1; return; }
        grid = cus;
    }
    if (grid < 0) return;
    (void)hipMemsetAsync((char*)d_ws + WS_CTL, 0, CTL_ZERO_BYTES, stream);
    Args a{};
    for (int i = 0; i < 16; ++i) a.in[i] = (const float*)d_in[i];
    a.out = (float*)d_out; a.ws = (unsigned char*)d_ws;
#if MK_ONE_LAUNCH
    a.ph_lo = 0; a.ph_hi = N_PHASES;
    hipLaunchKernelGGL(hymba_fwd, dim3(grid), dim3(NWAVES * 64), LDS_BYTES, stream, a);
#else
    for (int p = 0; p < N_PHASES; ++p) { a.ph_lo = p; a.ph_hi = p + 1; hipLaunchKernelGGL(hymba_fwd, dim3(grid), dim3(NWAVES * 64), LDS_BYTES, stream, a); }
#endif
}
```

```cpp
#include <hip/hip_runtime.h>
#include <cstdio>
#include <cstdint>

namespace pg8 {
#define PG8_LAS __attribute__((address_space(3)))
typedef unsigned short bf16_t;
typedef short bf16x8 __attribute__((ext_vector_type(8)));
typedef float f32x4 __attribute__((ext_vector_type(4)));
typedef unsigned u32x4 __attribute__((ext_vector_type(4)));
typedef int i32x4 __attribute__((ext_vector_type(4)));
template <bool I8> struct AccT { typedef f32x4 type; };
template <> struct AccT<true> { typedef i32x4 type; };
constexpr int BM = 256, BK = 64, HALF = 128, HTB = HALF * BK * 2, STAGE_BYTES = 8 * HTB, NXCD = 8, WGM = 8;

__host__ __device__ __forceinline__ int lds_byte(int r, int c) { const int st = (r >> 4) * 2 + (c >> 5), rr = r & 15, cc = c & 31, ob = rr * 64 + cc * 2; return st * 1024 + (ob ^ (((ob >> 9) & 1) << 5)); }
__host__ __device__ __forceinline__ void stage_rc(int b, int& R, int& C) { const int st = b / 1024, sb = b % 1024, swz = sb ^ (((sb >> 9) & 1) << 5); R = (st >> 1) * 16 + swz / 64; C = (st & 1) * 32 + (swz % 64) / 2; }
__host__ __device__ __forceinline__ int perm32(int rho) { const int n = rho >> 4, i = rho & 15; return 8 * (i >> 2) + 4 * n + (i & 3); }

struct Unit { int pm, pn; };
struct Gemm { const bf16_t* A; const bf16_t* Bt; int M, N, K, lda; int ovl; };
__host__ __device__ __forceinline__ int ovl_row_base(int pm) { const int b = pm / 17, k = pm - 17 * b; return b * 4096 + (k ? 254 * k - 1 : 0); }

struct StaticOrder {
    int nM, nN, nwg, G, c;
    __host__ __device__ void init(int M, int N, int G_, int c_) { nM = M / BM; nN = N / BM; nwg = nM * nN; G = G_; c = c_; }
    __host__ __device__ bool next(int i, Unit& u) const {
        const long L = (long)i * G + c; if (L >= nwg) return false;
        int wgid = (int)L; { const int q = nwg / NXCD, r = nwg % NXCD, xcd = wgid % NXCD, off = wgid / NXCD; wgid = (xcd < r ? xcd * (q + 1) : r * (q + 1) + (xcd - r) * q) + off; }
        const int nig = WGM * nN, gid = wgid / nig, fm = gid * WGM, gsz = (nM - fm) < WGM ? (nM - fm) : WGM;
        u.pm = fm + ((wgid % nig) % gsz); u.pn = (wgid % nig) / gsz; return true;
    }
    __device__ __forceinline__ void a_ready(const Unit&) const {}
    __device__ __forceinline__ void done(const Unit&) const {}
};

typedef float f32x2v_t __attribute__((ext_vector_type(2))); typedef __bf16 bf16x2v_t __attribute__((ext_vector_type(2)));
__device__ __forceinline__ unsigned cvt_pk_bf16(float lo, float hi) { f32x2v_t v = {lo, hi}; bf16x2v_t b = __builtin_convertvector(v, bf16x2v_t); return __builtin_bit_cast(unsigned, b); }

struct EpiBf16 {
    static constexpr bool PERM = true, AFTER_DRAIN = false, MIDK = false, PREFETCH = false;
    bf16_t* O; int ldc;
    __device__ __forceinline__ void operator()(const f32x4 (&acc)[2][2][4][2], const Unit& u, int wr, int wc, int fr, int fq) const {
        const int row0 = u.pm * BM + wr * 64 + fr; const int col0 = u.pn * BM + wc * 32 + 8 * fq;
#pragma unroll
        for (int ai = 0; ai < 2; ++ai)
#pragma unroll
            for (int m = 0; m < 4; ++m) { bf16_t* rowp = O + (size_t)(row0 + ai * HALF + m * 16) * ldc + col0;
#pragma unroll
                for (int bj = 0; bj < 2; ++bj) { const f32x4 v0 = acc[ai][bj][m][0], v1 = acc[ai][bj][m][1];
                    u32x4 w; w.x = cvt_pk_bf16(v0[0], v0[1]); w.y = cvt_pk_bf16(v0[2], v0[3]); w.z = cvt_pk_bf16(v1[0], v1[1]); w.w = cvt_pk_bf16(v1[2], v1[3]);
                    *(u32x4*)(rowp + bj * HALF) = w; } }
    }
};

struct EpiBf16Row {
    static constexpr bool PERM = true, AFTER_DRAIN = false, MIDK = false, PREFETCH = false;
    bf16_t* O; int ldc; const float* rs;
    __device__ __forceinline__ void operator()(const f32x4 (&acc)[2][2][4][2], const Unit& u, int wr, int wc, int fr, int fq) const {
        const int row0 = u.pm * BM + wr * 64 + fr; const int col0 = u.pn * BM + wc * 32 + 8 * fq;
#pragma unroll
        for (int ai = 0; ai < 2; ++ai)
#pragma unroll
            for (int m = 0; m < 4; ++m) { const int row = row0 + ai * HALF + m * 16; const float r = rs[row]; bf16_t* rowp = O + (size_t)row * ldc + col0;
#pragma unroll
                for (int bj = 0; bj < 2; ++bj) { const f32x4 v0 = acc[ai][bj][m][0] * r, v1 = acc[ai][bj][m][1] * r;
                    u32x4 w; w.x = cvt_pk_bf16(v0[0], v0[1]); w.y = cvt_pk_bf16(v0[2], v0[3]); w.z = cvt_pk_bf16(v1[0], v1[1]); w.w = cvt_pk_bf16(v1[2], v1[3]);
                    *(u32x4*)(rowp + bj * HALF) = w; } }
    }
};
struct EpiResF32 {
    static constexpr bool PERM = false, AFTER_DRAIN = false, MIDK = false, PREFETCH = false;
    const float* base; float* out; int ldc;
    __device__ __forceinline__ void operator()(const f32x4 (&acc)[2][2][4][2], const Unit& u, int wr, int wc, int fr, int fq) const {
        const int col0 = u.pn * BM + wc * 32 + 4 * fq;
#pragma unroll
        for (int ai = 0; ai < 2; ++ai)
#pragma unroll
            for (int m = 0; m < 4; ++m) { const int r = u.pm * BM + ai * HALF + wr * 64 + m * 16 + fr; const size_t off = (size_t)r * ldc + col0;
#pragma unroll
                for (int bj = 0; bj < 2; ++bj)
#pragma unroll
                    for (int n = 0; n < 2; ++n) { const f32x4 bs = *(const f32x4*)(base + off + bj * HALF + n * 16); *(f32x4*)(out + off + bj * HALF + n * 16) = bs + acc[ai][bj][m][n]; } }
    }
};


struct EpiX1 {
    static constexpr bool PERM = true, AFTER_DRAIN = false, MIDK = false, PREFETCH = false;
    const float* base; bf16_t* O; int ldc; float* ss;
    __device__ __forceinline__ void operator()(const f32x4 (&acc)[2][2][4][2], const Unit& u, int wr, int wc, int fr, int fq) const {
        const int row0 = u.pm * BM + wr * 64 + fr; const int col0 = u.pn * BM + wc * 32 + 8 * fq;
#pragma unroll
        for (int ai = 0; ai < 2; ++ai)
#pragma unroll
            for (int m = 0; m < 4; ++m) { const int row = row0 + ai * HALF + m * 16; const size_t off = (size_t)row * ldc + col0; float q = 0.f;
#pragma unroll
                for (int bj = 0; bj < 2; ++bj) { const f32x4 v0 = *(const f32x4*)(base + off + bj * HALF) + acc[ai][bj][m][0], v1 = *(const f32x4*)(base + off + bj * HALF + 4) + acc[ai][bj][m][1];
                    q += (v0[0] * v0[0] + v0[1] * v0[1]) + (v0[2] * v0[2] + v0[3] * v0[3]) + (v1[0] * v1[0] + v1[1] * v1[1]) + (v1[2] * v1[2] + v1[3] * v1[3]);
                    u32x4 w; w.x = cvt_pk_bf16(v0[0], v0[1]); w.y = cvt_pk_bf16(v0[2], v0[3]); w.z = cvt_pk_bf16(v1[0], v1[1]); w.w = cvt_pk_bf16(v1[2], v1[3]);
                    *(u32x4*)(O + off + bj * HALF) = w; }
                q += __shfl_xor(q, 16); q += __shfl_xor(q, 32);
                if (fq == 0) ss[(size_t)row * 16 + u.pn * 4 + wc] = q; }
    }
};
struct EpiX2 {
    static constexpr bool PERM = true, AFTER_DRAIN = false, MIDK = false, PREFETCH = false;
    bf16_t* X; int ldc; float* ss;
    __device__ __forceinline__ void operator()(const f32x4 (&acc)[2][2][4][2], const Unit& u, int wr, int wc, int fr, int fq) const {
        const int row0 = u.pm * BM + wr * 64 + fr; const int col0 = u.pn * BM + wc * 32 + 8 * fq;
#pragma unroll
        for (int ai = 0; ai < 2; ++ai)
#pragma unroll
            for (int m = 0; m < 4; ++m) { const int row = row0 + ai * HALF + m * 16; const size_t off = (size_t)row * ldc + col0; float q = 0.f;
#pragma unroll
                for (int bj = 0; bj < 2; ++bj) { const u32x4 xb = *(const u32x4*)(X + off + bj * HALF);
                    f32x4 v0, v1; v0[0] = __builtin_bit_cast(float, xb.x << 16); v0[1] = __builtin_bit_cast(float, xb.x & 0xffff0000u); v0[2] = __builtin_bit_cast(float, xb.y << 16); v0[3] = __builtin_bit_cast(float, xb.y & 0xffff0000u);
                    v1[0] = __builtin_bit_cast(float, xb.z << 16); v1[1] = __builtin_bit_cast(float, xb.z & 0xffff0000u); v1[2] = __builtin_bit_cast(float, xb.w << 16); v1[3] = __builtin_bit_cast(float, xb.w & 0xffff0000u);
                    v0 = v0 + acc[ai][bj][m][0]; v1 = v1 + acc[ai][bj][m][1];
                    q += (v0[0] * v0[0] + v0[1] * v0[1]) + (v0[2] * v0[2] + v0[3] * v0[3]) + (v1[0] * v1[0] + v1[1] * v1[1]) + (v1[2] * v1[2] + v1[3] * v1[3]);
                    u32x4 w; w.x = cvt_pk_bf16(v0[0], v0[1]); w.y = cvt_pk_bf16(v0[2], v0[3]); w.z = cvt_pk_bf16(v1[0], v1[1]); w.w = cvt_pk_bf16(v1[2], v1[3]);
                    *(u32x4*)(X + off + bj * HALF) = w; }
                q += __shfl_xor(q, 16); q += __shfl_xor(q, 32);
                if (fq == 0) ss[(size_t)row * 16 + u.pn * 4 + wc] = q; }
    }
};
struct EpiBf16Rs {
    static constexpr bool PERM = true, AFTER_DRAIN = false, MIDK = false, PREFETCH = false;
    bf16_t* O; int ldc; const float* ss; float inv_n, eps;
    __device__ __forceinline__ void operator()(const f32x4 (&acc)[2][2][4][2], const Unit& u, int wr, int wc, int fr, int fq) const {
        const int row0 = u.pm * BM + wr * 64 + fr; const int col0 = u.pn * BM + wc * 32 + 8 * fq;
#pragma unroll
        for (int ai = 0; ai < 2; ++ai)
#pragma unroll
            for (int m = 0; m < 4; ++m) { const int row = row0 + ai * HALF + m * 16; const f32x4* sp = (const f32x4*)(ss + (size_t)row * 16);
                const f32x4 s4 = (sp[0] + sp[1]) + (sp[2] + sp[3]); const float rs = 1.0f / sqrtf(((s4[0] + s4[1]) + (s4[2] + s4[3])) * inv_n + eps);
                bf16_t* rowp = O + (size_t)row * ldc + col0;
#pragma unroll
                for (int bj = 0; bj < 2; ++bj) { const f32x4 v0 = acc[ai][bj][m][0] * rs, v1 = acc[ai][bj][m][1] * rs;
                    u32x4 w; w.x = cvt_pk_bf16(v0[0], v0[1]); w.y = cvt_pk_bf16(v0[2], v0[3]); w.z = cvt_pk_bf16(v1[0], v1[1]); w.w = cvt_pk_bf16(v1[2], v1[3]);
                    *(u32x4*)(rowp + bj * HALF) = w; } }
    }
};


template <int CTRL> __device__ __forceinline__ float dppk(float keep, float x) { return __builtin_bit_cast(float, __builtin_amdgcn_update_dpp(__builtin_bit_cast(int, keep), __builtin_bit_cast(int, x), CTRL, 0xf, 0xf, false)); }
template <int CTRL> __device__ __forceinline__ float dppf(float x) { return __builtin_bit_cast(float, __builtin_amdgcn_mov_dpp(__builtin_bit_cast(int, x), CTRL, 0xf, 0xf, true)); }
struct EpiConvGlu {
    static constexpr bool PERM = true, AFTER_DRAIN = false, MIDK = false, PREFETCH = true, PERMA = true;
    bf16_t* O; int ldc; const float* ss; const float* cw; const float* cb; PG8_LAS float* ex; int mrows; float* halo; const float* cw4;
    __device__ __forceinline__ void prefetch(const Unit& u, int wid, int lane) const {
        const int base = u.pm * BM; asm volatile("" : "+v"(lane));
        if (wid == 0) __builtin_amdgcn_global_load_lds((const unsigned*)(ss + base + lane * 4), (PG8_LAS unsigned*)(ex + 1024), 16, 0, 0);
        else if (wid < 4) __builtin_amdgcn_global_load_lds((const unsigned*)(cw4 + u.pn * 768 + (wid - 1) * 256 + lane * 4), (PG8_LAS unsigned*)(ex + 1024 + 4096 + (wid - 1) * 256), 16, 0, 0);
    }
    __device__ __forceinline__ void operator()(i32x4 (&iacc)[2][2][4][2], const Unit& u, int wr, int wc, int fr, int fq) const {
        f32x4 acc[2][2][4][2];
        const int kt = u.pm & 15, base = u.pm * BM;
        const int ch0 = u.pn * 128 + wc * 32 + 8 * fq;
        const bool top_open = kt != 0, bot_open = kt != 15;
        f32x4 w0[2], w1[2], w2[2], cbv[2], isv[2];
#pragma unroll
        for (int n = 0; n < 2; ++n) { const PG8_LAS float* wl = ex + 1024 + 4096 + wc * 32 + 8 * fq + 4 * n; const f32x4 sg = *(const PG8_LAS f32x4*)(wl + 512) * -1.4426950408889634f;
            w0[n] = *(const PG8_LAS f32x4*)wl * sg; w1[n] = *(const PG8_LAS f32x4*)(wl + 128) * sg; w2[n] = *(const PG8_LAS f32x4*)(wl + 256) * sg; cbv[n] = *(const PG8_LAS f32x4*)(wl + 384) * -1.4426950408889634f;
            const f32x4 svn = *(const PG8_LAS f32x4*)(wl + 640);
#pragma unroll
            for (int i = 0; i < 4; ++i) isv[n][i] = __builtin_amdgcn_rcpf(fminf(svn[i] * -0.6931471805599453f, -1e-30f)); }
#pragma unroll
        for (int ai = 0; ai < 2; ++ai) { const f32x4 rs4 = *(const PG8_LAS f32x4*)(ex + 1024 + ai * HALF + wr * 64 + fr * 4);
#pragma unroll
            for (int m = 0; m < 4; ++m) { const float rs = rs4[m];
#pragma unroll
                for (int n = 0; n < 2; ++n) { const i32x4 ig = iacc[ai][0][m][n], iv = iacc[ai][1][m][n];
                    acc[ai][0][m][n] = (f32x4){(float)ig[0], (float)ig[1], (float)ig[2], (float)ig[3]} * rs; acc[ai][1][m][n] = (f32x4){(float)iv[0], (float)iv[1], (float)iv[2], (float)iv[3]} * rs; } } }
        const int exi = (wc * 4 + fq) * 8;
        if (fr == 0) {
#pragma unroll
            for (int ai = 0; ai < 2; ++ai) { PG8_LAS f32x4* p = (PG8_LAS f32x4*)(ex + ((ai * 2 + wr) * 2 + 0) * 128 + exi); p[0] = acc[ai][0][0][0]; p[1] = acc[ai][0][0][1]; } }
        if (fr == 15) {
#pragma unroll
            for (int ai = 0; ai < 2; ++ai) { PG8_LAS f32x4* p = (PG8_LAS f32x4*)(ex + ((ai * 2 + wr) * 2 + 1) * 128 + exi); p[0] = acc[ai][0][3][0]; p[1] = acc[ai][0][3][1]; } }
        asm volatile("s_waitcnt lgkmcnt(0)\n\ts_barrier" ::: "memory");
#pragma unroll
        for (int ai = 0; ai < 2; ++ai) {
            f32x4 et[2] = {(f32x4){0.f, 0.f, 0.f, 0.f}, (f32x4){0.f, 0.f, 0.f, 0.f}}, eb[2] = {(f32x4){0.f, 0.f, 0.f, 0.f}, (f32x4){0.f, 0.f, 0.f, 0.f}};
            { const bool hz = (wr == 0 && ai == 0); const int sai = wr == 1 ? ai : 0, swr = wr == 1 ? 0 : 1; const PG8_LAS f32x4* p = (const PG8_LAS f32x4*)(ex + ((sai * 2 + swr) * 2 + 1) * 128 + exi);
              if (!hz) { et[0] = p[0]; et[1] = p[1]; } }
            { const bool hz = (wr == 1 && ai == 1); const int sai = wr == 0 ? ai : 1, swr = wr == 0 ? 1 : 0; const PG8_LAS f32x4* p = (const PG8_LAS f32x4*)(ex + ((sai * 2 + swr) * 2 + 0) * 128 + exi);
              if (!hz) { eb[0] = p[0]; eb[1] = p[1]; } }
            float a[4][8], zz[8];
#pragma unroll
            for (int n = 0; n < 2; ++n)
#pragma unroll
                for (int i = 0; i < 4; ++i) { const float g0 = acc[ai][0][0][n][i], g1 = acc[ai][0][1][n][i], g2 = acc[ai][0][2][n][i], g3 = acc[ai][0][3][n][i];
                    const float up = dppk<0x111>(et[n][i], g3), dn = dppk<0x101>(eb[n][i], g0);
                    const float c0 = w0[n][i], c1 = w1[n][i], c2 = w2[n][i], cb0 = cbv[n][i];
                    float z[4];
                    z[0] = __builtin_fmaf(c2, g1, __builtin_fmaf(c1, g0, __builtin_fmaf(c0, up, cb0)));
                    z[1] = __builtin_fmaf(c2, g2, __builtin_fmaf(c1, g1, __builtin_fmaf(c0, g0, cb0)));
                    z[2] = __builtin_fmaf(c2, g3, __builtin_fmaf(c1, g2, __builtin_fmaf(c0, g1, cb0)));
                    z[3] = __builtin_fmaf(c2, dn, __builtin_fmaf(c1, g3, __builtin_fmaf(c0, g2, cb0)));
                    zz[4 * n + i] = (ai == 0 ? z[0] : z[3]) * -0.6931471805599453f;
#pragma unroll
                    for (int m = 0; m < 4; ++m) { const float iv0 = isv[n][i]; a[m][4 * n + i] = z[m] * __builtin_amdgcn_rcpf(__builtin_fmaf(__builtin_amdgcn_exp2f(z[m]), iv0, iv0)) * acc[ai][1][m][n][i]; } }
#pragma unroll
            for (int m = 0; m < 4; ++m) { const int r = ai * HALF + wr * 64 + fr * 4 + m; u32x4 w;
                w.x = cvt_pk_bf16(a[m][0], a[m][1]); w.y = cvt_pk_bf16(a[m][2], a[m][3]); w.z = cvt_pk_bf16(a[m][4], a[m][5]); w.w = cvt_pk_bf16(a[m][6], a[m][7]);
                bool open = false;
                if (ai == 0 && m == 0) open = (r == 0) && top_open;
                if (ai == 1 && m == 3) open = (r == 255) && bot_open;
                if (!open) *(u32x4*)(O + (size_t)(base + r) * ldc + ch0) = w;
                if ((ai == 0 && m == 0) || (ai == 1 && m == 3)) { if (open) { float* hp = halo + ((size_t)(u.pm * 2 + (ai == 0 ? 0 : 1)) * 3) * ldc + ch0;
                        const PG8_LAS float* sl = ex + 1024 + 4096 + 512 + wc * 32 + 8 * fq;
                        *(f32x4*)hp = acc[ai][0][m][0] * *(const PG8_LAS f32x4*)sl; *(f32x4*)(hp + 4) = acc[ai][0][m][1] * *(const PG8_LAS f32x4*)(sl + 4);
                        *(f32x4*)(hp + ldc) = (f32x4){zz[0], zz[1], zz[2], zz[3]}; *(f32x4*)(hp + ldc + 4) = (f32x4){zz[4], zz[5], zz[6], zz[7]};
                        *(f32x4*)(hp + 2 * ldc) = acc[ai][1][m][0] * *(const PG8_LAS f32x4*)(sl + 128); *(f32x4*)(hp + 2 * ldc + 4) = acc[ai][1][m][1] * *(const PG8_LAS f32x4*)(sl + 132); } }
                asm volatile("" ::: "memory"); } }
        asm volatile("s_waitcnt lgkmcnt(0)\n\ts_barrier" ::: "memory");
    }
};


struct EpiX1N {
    static constexpr bool PERM = true, AFTER_DRAIN = false, MIDK = true, PREFETCH = true; static constexpr int MIDK_T = 12;
    const bf16_t* base; bf16_t* O; int ldc; float* ss; const float* sa; PG8_LAS float* st;
    __device__ __forceinline__ void prefetch(const Unit& u, int wid, int lane) const {
        asm volatile("" : "+v"(lane));
#pragma unroll
        for (int i = 0; i < 2; ++i) { const int piece = wid * 2 + i;
            __builtin_amdgcn_global_load_lds((const unsigned*)(sa + (size_t)u.pm * BM * 16 + piece * 256 + lane * 4), (PG8_LAS unsigned*)(st + piece * 256), 16, 0, 0); }
    }
    __device__ __forceinline__ void row_stats(int rl, int fq, float& ra, float& rf) const {
        const f32x4 s4 = *(const PG8_LAS f32x4*)(st + rl * 16 + 4 * fq); float a = fq < 3 ? (s4[0] + s4[1]) + (s4[2] + s4[3]) : 0.f, f = fq == 3 ? s4[0] : 0.f;
        a += __shfl_xor(a, 16); a += __shfl_xor(a, 32); f += __shfl_xor(f, 16); f += __shfl_xor(f, 32);
        ra = __builtin_amdgcn_rsqf(a * (1.0f / 768.0f) + 1e-6f); rf = __builtin_amdgcn_rsqf(f * (1.0f / 256.0f) + 1e-6f);
    }
    __device__ __forceinline__ void midk(f32x4 (&acc)[2][2][4][2], const Unit& u, int wr, int fr, int fq) const {
#pragma unroll
        for (int ai = 0; ai < 2; ++ai)
#pragma unroll
            for (int m = 0; m < 4; ++m) { float ra, rf; row_stats(ai * HALF + wr * 64 + m * 16 + fr, fq, ra, rf); const float ratio = ra * __builtin_amdgcn_rcpf(rf);
#pragma unroll
                for (int bj = 0; bj < 2; ++bj) { acc[ai][bj][m][0] = acc[ai][bj][m][0] * ratio; acc[ai][bj][m][1] = acc[ai][bj][m][1] * ratio; } }
    }
    __device__ __forceinline__ void operator()(const f32x4 (&acc)[2][2][4][2], const Unit& u, int wr, int wc, int fr, int fq) const {
        const int row0 = u.pm * BM + wr * 64 + fr; const int col0 = u.pn * BM + wc * 32 + 8 * fq;
#pragma unroll
        for (int ai = 0; ai < 2; ++ai)
#pragma unroll
            for (int m = 0; m < 4; ++m) { const int row = row0 + ai * HALF + m * 16; const size_t off = (size_t)row * ldc + col0; float ra, rf; row_stats(row - u.pm * BM, fq, ra, rf);
#pragma unroll
                for (int bj = 0; bj < 2; ++bj) { const u32x4 xb = *(const u32x4*)(base + off + bj * HALF); f32x4 v0, v1;
                    v0[0] = __builtin_bit_cast(float, xb.x << 16); v0[1] = __builtin_bit_cast(float, xb.x & 0xffff0000u); v0[2] = __builtin_bit_cast(float, xb.y << 16); v0[3] = __builtin_bit_cast(float, xb.y & 0xffff0000u);
                    v1[0] = __builtin_bit_cast(float, xb.z << 16); v1[1] = __builtin_bit_cast(float, xb.z & 0xffff0000u); v1[2] = __builtin_bit_cast(float, xb.w << 16); v1[3] = __builtin_bit_cast(float, xb.w & 0xffff0000u);
                    v0 = v0 + acc[ai][bj][m][0] * rf; v1 = v1 + acc[ai][bj][m][1] * rf;
                    u32x4 w; w.x = cvt_pk_bf16(v0[0], v0[1]); w.y = cvt_pk_bf16(v0[2], v0[3]); w.z = cvt_pk_bf16(v1[0], v1[1]); w.w = cvt_pk_bf16(v1[2], v1[3]);
                    *(u32x4*)(O + off + bj * HALF) = w; }
                }
        asm volatile("s_waitcnt lgkmcnt(0)\n\ts_barrier" ::: "memory");
    }
};


struct EpiFinal {
    static constexpr bool PERM = true, AFTER_DRAIN = false, MIDK = false, PREFETCH = false;
    const bf16_t* X1; float* out; int ldc; const float* gain; float* xbuf; unsigned* cnt; PG8_LAS unsigned char* lx;
    __device__ __forceinline__ void operator()(f32x4 (&acc)[2][2][4][2], const Unit& u, int wr, int wc, int fr, int fq) const {
        PG8_LAS float* P = (PG8_LAS float*)lx; PG8_LAS float* S = (PG8_LAS float*)(lx + 4096);
        int tid = (wr * 4 + wc) * 64 + fq * 16 + fr; asm volatile("" : "+v"(tid)); const int col0 = u.pn * BM + wc * 32 + 8 * fq;
#pragma unroll
        for (int ai = 0; ai < 2; ++ai)
#pragma unroll
            for (int m = 0; m < 4; ++m) { const int rl = ai * HALF + wr * 64 + m * 16 + fr; const size_t off = (size_t)(u.pm * BM + rl) * ldc + col0; float q = 0.f;
#pragma unroll
                for (int bj = 0; bj < 2; ++bj) { const u32x4 xb = *(const u32x4*)(X1 + off + bj * HALF); f32x4 v0, v1;
                    v0[0] = __builtin_bit_cast(float, xb.x << 16); v0[1] = __builtin_bit_cast(float, xb.x & 0xffff0000u); v0[2] = __builtin_bit_cast(float, xb.y << 16); v0[3] = __builtin_bit_cast(float, xb.y & 0xffff0000u);
                    v1[0] = __builtin_bit_cast(float, xb.z << 16); v1[1] = __builtin_bit_cast(float, xb.z & 0xffff0000u); v1[2] = __builtin_bit_cast(float, xb.w << 16); v1[3] = __builtin_bit_cast(float, xb.w & 0xffff0000u);
                    v0 = v0 + acc[ai][bj][m][0]; v1 = v1 + acc[ai][bj][m][1]; acc[ai][bj][m][0] = v0; acc[ai][bj][m][1] = v1;
                    q += ((v0[0] * v0[0] + v0[1] * v0[1]) + (v0[2] * v0[2] + v0[3] * v0[3])) + ((v1[0] * v1[0] + v1[1] * v1[1]) + (v1[2] * v1[2] + v1[3] * v1[3])); }
                q += __shfl_xor(q, 16); q += __shfl_xor(q, 32);
                if (fq == 0) P[rl * 4 + wc] = q; }
        asm volatile("s_waitcnt lgkmcnt(0)\n\ts_barrier" ::: "memory");
        if (tid < 256) { const float s = (P[tid * 4] + P[tid * 4 + 1]) + (P[tid * 4 + 2] + P[tid * 4 + 3]);
            __hip_atomic_store(xbuf + ((size_t)(u.pm * BM + tid) * 4 + u.pn), s, __ATOMIC_RELAXED, __HIP_MEMORY_SCOPE_AGENT);
            asm volatile("s_waitcnt vmcnt(0)" ::: "memory");
            if ((tid & 63) == 0) __hip_atomic_fetch_add(cnt + 64 * u.pm, 1u, __ATOMIC_RELAXED, __HIP_MEMORY_SCOPE_AGENT); }
        if (tid < 64) { unsigned spins = 0;
            while ((unsigned)__builtin_amdgcn_readfirstlane(__hip_atomic_load(cnt + 64 * u.pm, __ATOMIC_RELAXED, __HIP_MEMORY_SCOPE_AGENT)) < 16u) { __builtin_amdgcn_s_sleep(2); if (++spins > 400000u) break; }
            __builtin_amdgcn_fence(__ATOMIC_ACQUIRE, "agent"); }
        asm volatile("s_waitcnt vmcnt(0) lgkmcnt(0)\n\ts_barrier" ::: "memory");
        if (tid < 256) { const float* xp = xbuf + (size_t)(u.pm * BM + tid) * 4; float t = 0.f;
#pragma unroll
            for (int k = 0; k < 4; ++k) t += __hip_atomic_load(xp + k, __ATOMIC_RELAXED, __HIP_MEMORY_SCOPE_AGENT);
            S[tid] = 1.0f / sqrtf(t * (1.0f / 1024.0f) + 1e-6f); }
        asm volatile("s_waitcnt vmcnt(0) lgkmcnt(0)\n\ts_barrier" ::: "memory");
        f32x4 gv[2][2];
#pragma unroll
        for (int bj = 0; bj < 2; ++bj)
#pragma unroll
            for (int n = 0; n < 2; ++n) gv[bj][n] = *(const f32x4*)(gain + col0 + bj * HALF + n * 4);
#pragma unroll
        for (int ai = 0; ai < 2; ++ai)
#pragma unroll
            for (int m = 0; m < 4; ++m) { const int rl = ai * HALF + wr * 64 + m * 16 + fr; const float rs = S[rl]; const size_t off = (size_t)(u.pm * BM + rl) * ldc + col0;
#pragma unroll
                for (int bj = 0; bj < 2; ++bj)
#pragma unroll
                    for (int n = 0; n < 2; ++n) *(f32x4*)(out + off + bj * HALF + n * 4) = acc[ai][bj][m][n] * rs * gv[bj][n]; }
    }
};

template <class E, class = void> struct HasPermA { static constexpr bool v = false; };
template <class E> struct HasPermA<E, decltype((void)E::PERMA)> { static constexpr bool v = E::PERMA; };
template <bool I8> __device__ __forceinline__ typename AccT<I8>::type mma16(bf16x8 a, bf16x8 b, typename AccT<I8>::type c) {
    if constexpr (I8) return __builtin_amdgcn_mfma_i32_16x16x64_i8(__builtin_bit_cast(i32x4, a), __builtin_bit_cast(i32x4, b), c, 0, 0, 0);
    else return __builtin_amdgcn_mfma_f32_16x16x32_bf16(a, b, c, 0, 0, 0);
}
template <class Epi, class Sched, bool ALIGN_EPI = false, bool SP2 = false, bool I8 = false>
__device__ __forceinline__ void gemm_phase(PG8_LAS unsigned char* lds, const Gemm g, const Sched& S, const Epi& E) {
    int tid = threadIdx.x; asm volatile("" : "+v"(tid));
    const int wid = __builtin_amdgcn_readfirstlane(tid >> 6), lane = tid & 63, wr = wid >> 2, wc = wid & 3, fr = lane & 15, fq = lane >> 4;
    const int K = g.K, nt = K / BK, lda = g.lda;
    unsigned voffA[2], voffB[2];
#pragma unroll
    for (int i = 0; i < 2; ++i) { int R, C; stage_rc(tid * 16 + i * 8192, R, C); const int Rb = Epi::PERM ? ((R & ~31) + perm32(R & 31)) : R;
        const int Ra = HasPermA<Epi>::v ? ((R & ~63) + (R & 15) * 4 + ((R >> 4) & 3)) : R;
        voffA[i] = (unsigned)(Ra * lda + C) * 2u; voffB[i] = (unsigned)(Rb * K + C) * 2u; }
    const size_t kstep = (size_t)(BK * 2);
    const size_t hstepA = (size_t)HALF * lda * 2, hstepB = (size_t)HALF * K * 2;
    const size_t tstepA = 2 * hstepA, tstepB = 2 * hstepB;
    const unsigned ldsw = (unsigned)wid * 1024u;
    const int aoff = lds_byte(wr * 64 + fr, fq * 8), boff = lds_byte(wc * 32 + fr, fq * 8);
#define PG8_SA(b, h) (((b) * 2 + (h)) * HTB)
#define PG8_SB(b, h) ((4 + (b) * 2 + (h)) * HTB)
#define PG8_STAGE(bufoff, gbase, voff) do { _Pragma("unroll") for (int _i = 0; _i < 2; ++_i) \
        __builtin_amdgcn_global_load_lds((const unsigned*)((const char*)(gbase) + (voff)[_i]), (PG8_LAS unsigned*)(lds + (bufoff) + ldsw + _i * 8192), 16, 0, 0); } while (0)
#define PG8_LDA(dst, b, h) do { _Pragma("unroll") for (int m = 0; m < 4; ++m) _Pragma("unroll") for (int k = 0; k < 2; ++k) dst[m][k] = *(const PG8_LAS bf16x8*)(lds + PG8_SA(b, h) + aoff + m * 2048 + k * 1024); } while (0)
#define PG8_LDB(dst, b, h) do { _Pragma("unroll") for (int n = 0; n < 2; ++n) _Pragma("unroll") for (int k = 0; k < 2; ++k) dst[n][k] = *(const PG8_LAS bf16x8*)(lds + PG8_SB(b, h) + boff + n * 2048 + k * 1024); } while (0)
#define PG8_MMA(ai, bj, At, Bt) do { __builtin_amdgcn_s_setprio(1); _Pragma("unroll") for (int m = 0; m < 4; ++m) _Pragma("unroll") for (int n = 0; n < 2; ++n) _Pragma("unroll") for (int k = 0; k < 2; ++k) \
        acc[ai][bj][m][n] = mma16<I8>(Bt[n][k], At[m][k], acc[ai][bj][m][n]); __builtin_amdgcn_s_setprio(0); } while (0)
#define PG8_WAIT_V(n) asm volatile("s_waitcnt vmcnt(" #n ")" ::: "memory")
#define PG8_WAIT_L(n) asm volatile("s_waitcnt lgkmcnt(" #n ")" ::: "memory")
#define PG8_BAR __builtin_amdgcn_s_barrier()
#define PG8_SCHED __builtin_amdgcn_sched_barrier(0)
    Unit cur, nxt; int ui = 0;
    if (!S.next(0, cur)) return;
    typedef typename AccT<I8>::type acc_t; acc_t acc[2][2][4][2];
#pragma unroll
    for (int a = 0; a < 2; ++a)
#pragma unroll
        for (int b = 0; b < 2; ++b)
#pragma unroll
            for (int m = 0; m < 4; ++m)
#pragma unroll
                for (int n = 0; n < 2; ++n) acc[a][b][m][n] = (acc_t){0, 0, 0, 0};
    bf16x8 At[4][2], B0[2][2], B1[2][2];
    const char* cA = (const char*)g.A + (g.ovl ? (size_t)ovl_row_base(cur.pm) * lda * 2 : (size_t)cur.pm * tstepA); const char* cB = (const char*)g.Bt + (size_t)cur.pn * tstepB;
    S.a_ready(cur);
    if constexpr (Epi::PREFETCH) E.prefetch(cur, wid, lane);
    if constexpr (SP2) {
        PG8_STAGE(PG8_SB(0, 0), cB, voffB); PG8_STAGE(PG8_SB(0, 1), cB + hstepB, voffB); PG8_STAGE(PG8_SA(0, 0), cA, voffA); PG8_STAGE(PG8_SA(0, 1), cA + hstepA, voffA);
        if (wr == 1) PG8_BAR;
        PG8_WAIT_V(2); PG8_BAR;
        PG8_STAGE(PG8_SB(1, 0), cB + kstep, voffB); PG8_STAGE(PG8_SA(1, 0), cA + kstep, voffA); PG8_STAGE(PG8_SB(1, 1), cB + hstepB + kstep, voffB);
        PG8_WAIT_V(6); PG8_BAR;
    } else {
        PG8_STAGE(PG8_SB(0, 0), cB, voffB); PG8_STAGE(PG8_SA(0, 0), cA, voffA); PG8_STAGE(PG8_SB(0, 1), cB + hstepB, voffB); PG8_STAGE(PG8_SA(0, 1), cA + hstepA, voffA);
        if (wr == 1) PG8_BAR;
        PG8_WAIT_V(4); PG8_BAR;
        PG8_STAGE(PG8_SB(1, 0), cB + kstep, voffB); PG8_STAGE(PG8_SA(1, 0), cA + kstep, voffA); PG8_STAGE(PG8_SB(1, 1), cB + hstepB + kstep, voffB);
        PG8_WAIT_V(6); PG8_BAR;
    }
    for (;;) {
        const bool has_next = S.next(ui + 1, nxt);
        const char* nA = has_next ? (const char*)g.A + (g.ovl ? (size_t)ovl_row_base(nxt.pm) * lda * 2 : (size_t)nxt.pm * tstepA) : cA; const char* nB = has_next ? (const char*)g.Bt + (size_t)nxt.pn * tstepB : cB;
        for (int t = 0; t < nt; t += 2) {
            const bool last = (t == nt - 2);
            const char* a1 = cA + (size_t)(t + 1) * kstep;
            const char* a2 = last ? nA : cA + (size_t)(t + 2) * kstep; const char* b2 = last ? nB : cB + (size_t)(t + 2) * kstep;
            const char* a3 = a2 + kstep; const char* b3 = b2 + kstep;
            if (last && has_next) S.a_ready(nxt);
            if constexpr (Epi::MIDK) { if (t == Epi::MIDK_T) E.midk(acc, cur, wr, fr, fq); }
            if constexpr (SP2) {
            PG8_LDB(B0, 0, 0); PG8_LDB(B1, 0, 1); PG8_SCHED; PG8_LDA(At, 0, 0); PG8_STAGE(PG8_SA(1, 1), a1 + hstepA, voffA);
            PG8_WAIT_V(8); PG8_WAIT_L(0); PG8_BAR; PG8_MMA(0, 0, At, B0); PG8_MMA(0, 1, At, B1); PG8_BAR; PG8_SCHED;
            PG8_LDA(At, 0, 1); PG8_STAGE(PG8_SB(0, 0), b2, voffB); PG8_STAGE(PG8_SB(0, 1), b2 + hstepB, voffB); PG8_STAGE(PG8_SA(0, 0), a2, voffA);
            PG8_WAIT_V(8); PG8_WAIT_L(0); PG8_BAR; PG8_MMA(1, 0, At, B0); PG8_MMA(1, 1, At, B1); PG8_BAR; PG8_SCHED;
            PG8_LDB(B0, 1, 0); PG8_LDB(B1, 1, 1); PG8_SCHED; PG8_LDA(At, 1, 0); PG8_STAGE(PG8_SA(0, 1), a2 + hstepA, voffA);
            PG8_WAIT_V(8); PG8_WAIT_L(0); PG8_BAR; PG8_MMA(0, 0, At, B0); PG8_MMA(0, 1, At, B1); PG8_BAR; PG8_SCHED;
            PG8_LDA(At, 1, 1); PG8_STAGE(PG8_SB(1, 0), b3, voffB); PG8_STAGE(PG8_SB(1, 1), b3 + hstepB, voffB); PG8_STAGE(PG8_SA(1, 0), a3, voffA);
            PG8_WAIT_V(8); PG8_WAIT_L(0); PG8_BAR; PG8_MMA(1, 0, At, B0); PG8_MMA(1, 1, At, B1); PG8_BAR; PG8_SCHED;
            } else {
            PG8_LDB(B0, 0, 0); PG8_SCHED; PG8_LDA(At, 0, 0); PG8_STAGE(PG8_SA(1, 1), a1 + hstepA, voffA);
            PG8_WAIT_L(8); PG8_BAR; PG8_WAIT_L(0); PG8_MMA(0, 0, At, B0); PG8_BAR; PG8_SCHED;
            PG8_LDB(B1, 0, 1); PG8_STAGE(PG8_SB(0, 0), b2, voffB);
            PG8_BAR; PG8_WAIT_L(0); PG8_MMA(0, 1, At, B1); PG8_BAR;
            PG8_LDA(At, 0, 1); PG8_STAGE(PG8_SA(0, 0), a2, voffA);
            PG8_BAR; PG8_WAIT_L(0); PG8_MMA(1, 0, At, B0); PG8_BAR; PG8_SCHED;
            PG8_STAGE(PG8_SB(0, 1), b2 + hstepB, voffB);
            PG8_WAIT_V(6); PG8_BAR; PG8_MMA(1, 1, At, B1); PG8_BAR;
            PG8_LDB(B0, 1, 0); PG8_SCHED; PG8_LDA(At, 1, 0); PG8_STAGE(PG8_SA(0, 1), a2 + hstepA, voffA);
            PG8_WAIT_L(8); PG8_BAR; PG8_WAIT_L(0); PG8_MMA(0, 0, At, B0); PG8_BAR; PG8_SCHED;
            PG8_LDB(B1, 1, 1); PG8_STAGE(PG8_SB(1, 0), b3, voffB);
            PG8_BAR; PG8_WAIT_L(0); PG8_MMA(0, 1, At, B1); PG8_BAR;
            PG8_LDA(At, 1, 1); PG8_STAGE(PG8_SA(1, 0), a3, voffA);
            PG8_BAR; PG8_WAIT_L(0); PG8_MMA(1, 0, At, B0); PG8_BAR; PG8_SCHED;
            PG8_STAGE(PG8_SB(1, 1), b3 + hstepB, voffB);
            PG8_WAIT_V(6); PG8_BAR; PG8_MMA(1, 1, At, B1); PG8_BAR;
            }
        }
        if constexpr (ALIGN_EPI) { if (wr == 0) PG8_BAR; }
        if constexpr (!Epi::AFTER_DRAIN) { E(acc, cur, wr, wc, fr, fq); S.done(cur); }
        if constexpr (Epi::PREFETCH) { if (has_next) E.prefetch(nxt, wid, lane); }
        if (!has_next) break;
#pragma unroll
        for (int a = 0; a < 2; ++a)
#pragma unroll
            for (int b = 0; b < 2; ++b)
#pragma unroll
                for (int m = 0; m < 4; ++m)
#pragma unroll
                    for (int n = 0; n < 2; ++n) acc[a][b][m][n] = (acc_t){0, 0, 0, 0};
        cur = nxt; cA = nA; cB = nB; ++ui;
        if constexpr (ALIGN_EPI) { if (wr == 1) PG8_BAR; }
    }
    PG8_WAIT_V(0);
    if constexpr (!ALIGN_EPI) { if (wr == 0) PG8_BAR; }
    PG8_BAR;
#undef PG8_SA
#undef PG8_SB
#undef PG8_STAGE
#undef PG8_LDA
#undef PG8_LDB
#undef PG8_MMA
#undef PG8_WAIT_V
#undef PG8_WAIT_L
#undef PG8_BAR
#undef PG8_SCHED
}
}

constexpr int NWAVES = 8;
#ifndef MK_ONE_LAUNCH
#define MK_ONE_LAUNCH 1
#endif
constexpr int N_PHASES = 11;

constexpr int BATCH = 8, SEQ = 4096, D = 1024, NH = 12, HD = 64, AW = 768, NG = 4, GD = 64, FW = 256, MIXW = 1024, NPROJ = 2560, FF = 2816;
constexpr int M = BATCH * SEQ;
constexpr float EPS = 1e-6f;

constexpr size_t MiB = 1u << 20;
constexpr size_t WS_CTL = 0, CTL_ZERO_BYTES = 96 * 1024;
constexpr size_t WS_TAB = 1 * MiB;
constexpr size_t TAB_BIAS = 0;
constexpr size_t TAB_MG = 32 * 1024;
constexpr size_t TAB_TW = 192 * 1024;
constexpr size_t TAB_CW4 = 256 * 1024;
constexpr size_t WS_WIN = 2 * MiB;
constexpr size_t WS_WOUT = 7 * MiB;
constexpr size_t WS_WGV = 9 * MiB;
constexpr size_t WS_WD = 20 * MiB;
constexpr size_t WS_XN = 26 * MiB;
constexpr size_t WS_PROJ = 90 * MiB;
constexpr size_t WS_A2 = 250 * MiB;
constexpr size_t WS_PQ = 314 * MiB;
constexpr size_t WS_ML = 380 * MiB;
constexpr size_t WS_A8 = 314 * MiB;
constexpr size_t WS_HALO = 400 * MiB;
constexpr size_t WS_RS0 = 441 * MiB;
constexpr size_t WS_XBUF = 440 * MiB;
constexpr size_t WS_SSA = 446 * MiB;
constexpr size_t WS_SS1 = 442 * MiB;
constexpr size_t WS_SS2 = 444 * MiB;
constexpr size_t WS_GV = 90 * MiB;
constexpr size_t WS_END = 448 * MiB;
constexpr int CW_BAR = 1024, CW_PANEL = 8192, CW_CMAX = 16384;

constexpr int RING_OFF = 0, RING_BYTES = 131072;
constexpr int LDSCTL_OFF = RING_BYTES, MISC_OFF = LDSCTL_OFF + 320;
constexpr int LDS_BYTES = 163840;

#define GAS __attribute__((address_space(1)))
#define LAS __attribute__((address_space(3)))
typedef unsigned short bf16;
typedef unsigned v4u __attribute__((ext_vector_type(4)));
typedef unsigned v2u __attribute__((ext_vector_type(2)));
typedef float f32x4 __attribute__((ext_vector_type(4)));
typedef GAS unsigned gu32;
#define RLX_AGENT __ATOMIC_RELAXED, __HIP_MEMORY_SCOPE_AGENT
#define LDS_WAIT() asm volatile("s_waitcnt lgkmcnt(0)" ::: "memory")
#define VM_WAIT() asm volatile("s_waitcnt vmcnt(0)" ::: "memory")
__device__ __forceinline__ unsigned f2bf(float f) { unsigned u = __builtin_bit_cast(unsigned, f); return (u + 0x7fffu + ((u >> 16) & 1u)) >> 16; }
__device__ __forceinline__ unsigned pk2(float lo, float hi) { typedef float f2_t __attribute__((ext_vector_type(2))); typedef __bf16 b2_t __attribute__((ext_vector_type(2))); f2_t v = {lo, hi}; b2_t b = __builtin_convertvector(v, b2_t); return __builtin_bit_cast(unsigned, b); }
__device__ __forceinline__ float bflo(unsigned w) { return __builtin_bit_cast(float, w << 16); }
__device__ __forceinline__ float bfhi(unsigned w) { return __builtin_bit_cast(float, w & 0xffff0000u); }
__device__ __forceinline__ float bf2f(bf16 h) { return __builtin_bit_cast(float, (unsigned)h << 16); }

#define XB_TMO      128
#define XB_XCNT(j)  (256  + 64 * (j))
#define XB_XSUB(j)  (1280 + 64 * (j))
#define XB_XGEN(j)  (2304 + 64 * (j))
#define XB_TOP      3328
#define XB_TOPGEN   3392
#define XCD_BAR_WORDS 3456
#define XB_SPIN_CAP (1u << 18)
__device__ __forceinline__ unsigned xb_ld(unsigned* p)              { return __hip_atomic_load(p, __ATOMIC_RELAXED, __HIP_MEMORY_SCOPE_AGENT); }
__device__ __forceinline__ unsigned xb_add(unsigned* p, unsigned v) { return __hip_atomic_fetch_add(p, v, __ATOMIC_RELAXED, __HIP_MEMORY_SCOPE_AGENT); }
__device__ __forceinline__ unsigned xb_xcc_id() { return (unsigned)__builtin_amdgcn_s_getreg((3 << 11) | 20) & 0xFu; }
#define XB_SPIN(cond, bar) do { unsigned _sp = 0; while (cond) { __builtin_amdgcn_s_sleep(1); \
    if ((++_sp & 255u) == 0u) { if (xb_ld(&(bar)[XB_TMO])) break; if (_sp > XB_SPIN_CAP) { atomicAdd(&(bar)[XB_TMO], 1u); break; } } } } while (0)
struct XcdBarrier { unsigned* bar; unsigned x; volatile LAS unsigned* st; };
__device__ __forceinline__ XcdBarrier xcd_barrier_post(unsigned* bar, volatile LAS unsigned* st) {
    XcdBarrier b; b.bar = bar; b.x = xb_xcc_id(); b.st = st;
    if (threadIdx.x == 0) (void)xb_add(&bar[XB_XCNT(b.x)], 1u);
    return b;
}
__device__ __forceinline__ void xcd_barrier_complete(unsigned* bar, unsigned x, unsigned& nloc, unsigned& nx) {
    const unsigned G = gridDim.x * gridDim.y * gridDim.z;
    unsigned sum, cnt, mine, sp = 0u;
    for (;;) {
        sum = 0u; cnt = 0u; mine = 0u;
#pragma unroll
        for (unsigned j = 0; j < 16; ++j) { const unsigned c = xb_ld(&bar[XB_XCNT(j)]); sum += c; cnt += (c > 0u) ? 1u : 0u; mine = (j == x) ? c : mine; }
        if (sum == G) break;
        __builtin_amdgcn_s_sleep(1);
        if ((++sp & 255u) == 0u) { if (xb_ld(&bar[XB_TMO])) break; if (sp > XB_SPIN_CAP) { atomicAdd(&bar[XB_TMO], 1u); break; } }
    }
    nloc = mine > 0u ? mine : 1u; nx = cnt > 0u ? cnt : 1u;
}
__device__ __forceinline__ void xcd_barrier(const XcdBarrier& b) {
    asm volatile("s_waitcnt vmcnt(0)" ::: "memory");
    __syncthreads();
    if (threadIdx.x == 0) {
        unsigned* bar = b.bar;
        __builtin_amdgcn_s_waitcnt(0);
        unsigned nloc = b.st[0], nx = b.st[1];
        if (nloc == 0u) { xcd_barrier_complete(bar, b.x, nloc, nx); b.st[0] = nloc; b.st[1] = nx; }
        const unsigned old = xb_add(&bar[XB_XSUB(b.x)], 1u);
        const unsigned gen = old / nloc;
        if (old + 1u == (gen + 1u) * nloc) {
            __builtin_amdgcn_fence(__ATOMIC_RELEASE, "agent");
            asm volatile("s_waitcnt vmcnt(0)" ::: "memory");
            const unsigned og = xb_add(&bar[XB_TOP], 1u);
            const unsigned tg = og / nx;
            if (og + 1u == (tg + 1u) * nx) xb_add(&bar[XB_TOPGEN], 1u);
            else XB_SPIN(xb_ld(&bar[XB_TOPGEN]) == tg, bar);
            __builtin_amdgcn_fence(__ATOMIC_ACQUIRE, "agent");
            xb_add(&bar[XB_XGEN(b.x)], 1u);
            asm volatile("s_waitcnt vmcnt(0)" ::: "memory");
        } else {
            XB_SPIN(xb_ld(&bar[XB_XGEN(b.x)]) == gen, bar);
            __builtin_amdgcn_fence(__ATOMIC_ACQUIRE, "agent");
            asm volatile("s_waitcnt vmcnt(0)" ::: "memory");
        }
    }
    __syncthreads();
}

struct Frame {
    LAS unsigned char* lds;
    volatile LAS unsigned* MISC;
    gu32* ctl;
    int tid, lane, wave;
    int vcu, G;
    const float *x, *g_mix, *w_in, *g_attn, *rel_tab, *f_w, *f_b, *g_four, *w_out, *g_ffn, *w_gate, *w_val, *conv_w, *conv_b, *w_down, *g_fin;
    float* out;
    unsigned char* ws;
};

__device__ __forceinline__ float wave_sum(float v) {
#pragma unroll
    for (int o = 1; o < 64; o <<= 1) v += __shfl_xor(v, o);
    return v;
}
__device__ __forceinline__ void p0_transpose_item(const float* W, int K, int N, bf16* WT, int row_off, LAS float* scr, int item, int lane, const float* gain = nullptr, bool il = false) {
    const int nblk = N / 32, kb = item / nblk, nb = item % nblk, k0 = 64 * kb, n0 = 32 * nb; if (il) row_off += 128 * (n0 >> 7);
    {   f32x4 v[8]; const int c4 = 4 * (lane & 7);
#pragma unroll
        for (int i = 0; i < 8; ++i) v[i] = *(const GAS f32x4*)(W + (size_t)(k0 + (lane >> 3) + 8 * i) * N + n0 + c4);
#pragma unroll
        for (int i = 0; i < 8; ++i) { const int kk = (lane >> 3) + 8 * i; const float gsc = gain ? gain[k0 + kk] : 1.0f; LAS float* sp = scr + kk * 33 + c4;
            sp[0] = v[i].x * gsc; sp[1] = v[i].y * gsc; sp[2] = v[i].z * gsc; sp[3] = v[i].w * gsc; } }
    LDS_WAIT(); asm volatile("" ::: "memory");
    const int c = lane & 7;
#pragma unroll
    for (int j = 0; j < 4; ++j) { const int n = (lane >> 3) + 8 * j; const LAS float* s = scr + (8 * c) * 33 + n;
        v4u o; o.x = pk2(s[0 * 33], s[1 * 33]); o.y = pk2(s[2 * 33], s[3 * 33]); o.z = pk2(s[4 * 33], s[5 * 33]); o.w = pk2(s[6 * 33], s[7 * 33]);
        *(GAS v4u*)(WT + (size_t)(row_off + n0 + n) * K + k0 + 8 * c) = o; }
    LDS_WAIT(); asm volatile("" ::: "memory");
}

__device__ __forceinline__ void p0_colmax_item(const float* W, int K, int N, unsigned* cmax, int row_off, int item, int lane, const float* gain) {
    const int nblk = N / 32, kb = item / nblk, nb = item % nblk, k0 = 64 * kb, n0 = 32 * nb, c4 = 4 * (lane & 7); row_off += 128 * (n0 >> 7);
    f32x4 mx = (f32x4){0.f, 0.f, 0.f, 0.f};
#pragma unroll
    for (int i = 0; i < 8; ++i) { const int kk = (lane >> 3) + 8 * i; const f32x4 v = *(const GAS f32x4*)(W + (size_t)(k0 + kk) * N + n0 + c4) * gain[k0 + kk];
        mx[0] = fmaxf(mx[0], fabsf(v[0])); mx[1] = fmaxf(mx[1], fabsf(v[1])); mx[2] = fmaxf(mx[2], fabsf(v[2])); mx[3] = fmaxf(mx[3], fabsf(v[3])); }
#pragma unroll
    for (int j = 0; j < 4; ++j) { float t = mx[j]; t = fmaxf(t, __shfl_xor(t, 8)); t = fmaxf(t, __shfl_xor(t, 16)); t = fmaxf(t, __shfl_xor(t, 32)); mx[j] = t; }
    if (lane < 8) {
#pragma unroll
        for (int j = 0; j < 4; ++j) atomicMax(cmax + row_off + n0 + c4 + j, __float_as_uint(mx[j])); }
}
__device__ __forceinline__ void p6_quant_item(const float* W, int K, int N, unsigned char* WT, int row_off, LAS float* scr, int item, int lane, const float* gain, const unsigned* cmax) {
    const int nblk = N / 32, kb = item / nblk, nb = item % nblk, k0 = 64 * kb, n0 = 32 * nb; row_off += 128 * (n0 >> 7);
    {   f32x4 v[8]; const int c4 = 4 * (lane & 7);
#pragma unroll
        for (int i = 0; i < 8; ++i) v[i] = *(const GAS f32x4*)(W + (size_t)(k0 + (lane >> 3) + 8 * i) * N + n0 + c4);
#pragma unroll
        for (int i = 0; i < 8; ++i) { const int kk = (lane >> 3) + 8 * i; const float gsc = gain[k0 + kk]; LAS float* sp = scr + kk * 33 + c4;
            sp[0] = v[i].x * gsc; sp[1] = v[i].y * gsc; sp[2] = v[i].z * gsc; sp[3] = v[i].w * gsc; } }
    LDS_WAIT(); asm volatile("" ::: "memory");
    const int c = lane & 7;
#pragma unroll
    for (int j = 0; j < 4; ++j) { const int n = (lane >> 3) + 8 * j; const LAS float* s = scr + (8 * c) * 33 + n; const float cm = __uint_as_float(cmax[row_off + n0 + n]); const float inv = cm > 0.f ? 127.0f / cm : 0.f;
        unsigned lo = 0, hi = 0;
#pragma unroll
        for (int t = 0; t < 4; ++t) { lo |= ((unsigned)(int)__builtin_rintf(s[t * 33] * inv) & 255u) << (8 * t); hi |= ((unsigned)(int)__builtin_rintf(s[(4 + t) * 33] * inv) & 255u) << (8 * t); }
        v2u o; o.x = lo; o.y = hi; *(GAS v2u*)(WT + (size_t)(row_off + n0 + n) * K + k0 + 8 * c) = o; }
    LDS_WAIT(); asm volatile("" ::: "memory");
}
__device__ __forceinline__ void rms_row_to_bf16(const float* xrow, const float* gain, bf16* orow, int lane) {
    const GAS f32x4* xr = (const GAS f32x4*)xrow + lane; const GAS f32x4* gr = (const GAS f32x4*)gain + lane;
    f32x4 v[4]; float s = 0.f;
#pragma unroll
    for (int j = 0; j < 4; ++j) { v[j] = xr[64 * j]; s += (v[j].x * v[j].x + v[j].y * v[j].y) + (v[j].z * v[j].z + v[j].w * v[j].w); }
    const float rstd = 1.0f / sqrtf(wave_sum(s) * (1.f / D) + EPS);
    GAS unsigned long long* o8 = (GAS unsigned long long*)orow + lane;
#pragma unroll
    for (int j = 0; j < 4; ++j) { const f32x4 gg = gr[64 * j]; o8[64 * j] = (unsigned long long)pk2(v[j].x * rstd * gg.x, v[j].y * rstd * gg.y) | ((unsigned long long)pk2(v[j].z * rstd * gg.z, v[j].w * rstd * gg.w) << 32); }
}
__device__ __forceinline__ int t5_bucket(int rel) {
    const int ret = rel > 0 ? 16 : 0; const int n = rel < 0 ? -rel : rel;
    const float nf = (float)(n > 1 ? n : 1);
    int large = 8 + (int)(logf(nf / 8.0f) / logf(128.0f) * 8.0f);
    large = large < 15 ? large : 15;
    return ret + (n < 8 ? n : large);
}

__device__ __forceinline__ void p0_prologue(Frame& F) {
    LAS float* scr = (LAS float*)(F.lds + RING_OFF + F.wave * 16384);
    const int gw = F.vcu * NWAVES + F.wave, NGW = F.G * NWAVES;
    bf16* WinT = (bf16*)(F.ws + WS_WIN); bf16* WoutT = (bf16*)(F.ws + WS_WOUT); bf16* WgvT = (bf16*)(F.ws + WS_WGV); bf16* WdT = (bf16*)(F.ws + WS_WD);
    constexpr int I_IN = (D / 64) * (NPROJ / 32), I_OUT = (MIXW / 64) * (D / 32), I_G = (D / 64) * (FF / 32), I_D = (FF / 64) * (D / 32);
    constexpr int NITEMS = I_IN + I_OUT + 2 * I_G + I_D;
    for (int it = gw; it < NITEMS; it += NGW) {
        int r = it;
        if (r < I_IN) { p0_transpose_item(F.w_in, D, NPROJ, WinT, 0, scr, r, F.lane, F.g_mix); continue; } r -= I_IN;
        if (r < I_OUT) { const int k0 = 64 * (r / (D / 32)); p0_transpose_item(F.w_out, MIXW, D, WoutT, 0, scr, r, F.lane, k0 < AW ? F.g_attn : F.g_four - AW); continue; } r -= I_OUT;
        if (r < 2 * I_G) { const bool isv = r >= I_G; p0_colmax_item(isv ? F.w_val : F.w_gate, D, FF, (unsigned*)(F.ctl + CW_CMAX), isv ? 128 : 0, isv ? r - I_G : r, F.lane, F.g_ffn); continue; } r -= 2 * I_G;
        p0_transpose_item(F.w_down, FF, D, WdT, 0, scr, r, F.lane);
    }
    float* tabBias = (float*)(F.ws + WS_TAB + TAB_BIAS); float* tabMg = (float*)(F.ws + WS_TAB + TAB_MG); float* tabTw = (float*)(F.ws + WS_TAB + TAB_TW);
    const int gt = F.vcu * (NWAVES * 64) + F.tid, NGT = F.G * NWAVES * 64;
    for (int i = gt; i < 3 * 129 * 12; i += NGT) { const int h = i % 12, jj = (i / 12) % 129, br = i / (12 * 129); const int dil = br == 0 ? 1 : (br == 1 ? 4 : 16);
        tabBias[i] = F.rel_tab[t5_bucket((jj - 64) * dil) * 12 + h]; }
    for (int i = gt; i < 4 * 64 * 128; i += NGT) { const int col = i & 127, c = (i >> 7) & 63, g = i >> 13; const int e = col & 63; float acc = 0.f;
        for (int d = 0; d < 64; ++d) { const float rev = (float)((c * d) & 63) * (1.0f / 64.0f); const float t = col < 64 ? __builtin_amdgcn_cosf(rev) : -__builtin_amdgcn_sinf(rev); acc += t * F.f_w[(g * 64 + d) * 64 + e]; }
        tabMg[i] = acc; }
    for (int i = gt; i < 4096; i += NGT) { float sv, cv; sincospif((float)i * (1.0f / 2048.0f), &sv, &cv); tabTw[2 * i] = cv; tabTw[2 * i + 1] = sv; }
    bf16* XN = (bf16*)(F.ws + WS_XN);
    {   float* RS0 = (float*)(F.ws + WS_RS0);
        for (int m0 = gw; m0 < M; m0 += 4 * NGW) { f32x4 v[4][4];
#pragma unroll
            for (int r = 0; r < 4; ++r) { const int m = m0 + r * NGW; const GAS f32x4* xr = (const GAS f32x4*)(F.x + (size_t)(m < M ? m : 0) * D) + F.lane;
#pragma unroll
                for (int j = 0; j < 4; ++j) v[r][j] = xr[64 * j]; }
#pragma unroll
            for (int r = 0; r < 4; ++r) { const int m = m0 + r * NGW; float s = 0.f;
#pragma unroll
                for (int j = 0; j < 4; ++j) s += (v[r][j].x * v[r][j].x + v[r][j].y * v[r][j].y) + (v[r][j].z * v[r][j].z + v[r][j].w * v[r][j].w);
                const float rstd = 1.0f / sqrtf(wave_sum(s) * (1.f / D) + EPS);
                if (m < M) { GAS unsigned long long* o8 = (GAS unsigned long long*)(XN + (size_t)m * D) + F.lane; if (F.lane == 0) RS0[m] = rstd;
#pragma unroll
                    for (int j = 0; j < 4; ++j) { const f32x4 t = v[r][j]; o8[64 * j] = (unsigned long long)pk2(t.x, t.y) | ((unsigned long long)pk2(t.z, t.w) << 32); } } } } }
}

namespace att {
typedef short bf16x8 __attribute__((ext_vector_type(8)));
typedef short v4i16 __attribute__((ext_vector_type(4)));
constexpr float LOG2E = 1.4426950408889634f;
constexpr int TABN = 512, TPAD0 = 128;
constexpr int LDS_K = 0, LDS_V = 49152, LDS_T0 = 98304, LDS_T1 = 98304 + 8192;
struct QT { bf16x8 q[2]; f32x4 o[4]; float m, l; };
__device__ __forceinline__ v4i16 vtr(const LAS unsigned char* p) { return __builtin_amdgcn_ds_read_tr16_b64_v4i16((LAS v4i16*)p); }

__device__ __forceinline__ void build_table(Frame& F, int ldsoff, int br, int h) {
    const float* tabBias = (const float*)(F.ws + WS_TAB + TAB_BIAS);
    LAS float* T = (LAS float*)(F.lds + ldsoff);
    for (int e = F.tid; e < 4 * TABN; e += NWAVES * 64) { const int s = e / TABN, n = e % TABN; const int r64 = n + s - TPAD0;
        T[e] = (r64 >= 0 && r64 <= 128) ? tabBias[(br * 129 + r64) * 12 + h] * LOG2E : -INFINITY; }
}
__device__ __forceinline__ const LAS float* table_ptr(Frame& F, int ldsoff, int idx0) { const int s = idx0 & 3; return (const LAS float*)(F.lds + ldsoff) + s * TABN + (idx0 - s); }

__device__ __forceinline__ int pass_tok(int mode, int a, int row) {
    if (mode == 0) { const int t = a - 64 + row; return (t >= 0 && t < SEQ) ? t : -1; }
    if (mode == 3) return a + 16 * row;
    const int hi = row >= 192 ? 1 : 0, u = a + (hi ? row - 192 : row), c = 2 * (mode - 1) + hi; return (u >= 0 && u < SEQ / 4) ? c + 4 * u : -1;
}
struct Pre { v4u k[6], v[6]; };
template <int NIT> __device__ __forceinline__ void prefetch(Frame& F, Pre& R, const bf16* P, int h, int mode, int a) {
#pragma unroll
    for (int it = 0; it < NIT; ++it) { const int idx = F.tid + it * (NWAVES * 64), row = idx >> 3, ph = idx & 7; const int t = pass_tok(mode, a, row);
        const int ck = ph ^ ((row >> 1) & 7), cv = ph ^ (((row >> 1) & 3) << 1);
        R.k[it] = (v4u){0u, 0u, 0u, 0u}; R.v[it] = (v4u){0u, 0u, 0u, 0u};
        if (t >= 0) { const bf16* rp = P + (size_t)t * NPROJ + h * 64; R.k[it] = *(const GAS v4u*)(rp + AW + ck * 8); R.v[it] = *(const GAS v4u*)(rp + 2 * AW + cv * 8); } }
}
template <int NIT> __device__ __forceinline__ void commit(Frame& F, const Pre& R) {
#pragma unroll
    for (int it = 0; it < NIT; ++it) { const int idx = F.tid + it * (NWAVES * 64);
        *(LAS v4u*)(F.lds + LDS_K + idx * 16) = R.k[it]; *(LAS v4u*)(F.lds + LDS_V + idx * 16) = R.v[it]; }
}
__device__ __forceinline__ float xmax4(float v) {
    auto a = __builtin_amdgcn_permlane16_swap(__float_as_uint(v), __float_as_uint(v), false, false); v = fmaxf(__uint_as_float(a[0]), __uint_as_float(a[1]));
    auto b = __builtin_amdgcn_permlane32_swap(__float_as_uint(v), __float_as_uint(v), false, false); return fmaxf(__uint_as_float(b[0]), __uint_as_float(b[1]));
}
__device__ __forceinline__ float xsum4(float v) {
    auto a = __builtin_amdgcn_permlane16_swap(__float_as_uint(v), __float_as_uint(v), false, false); v = __uint_as_float(a[0]) + __uint_as_float(a[1]);
    auto b = __builtin_amdgcn_permlane32_swap(__float_as_uint(v), __float_as_uint(v), false, false); return __uint_as_float(b[0]) + __uint_as_float(b[1]);
}
__device__ __forceinline__ void load_q(QT& T, const bf16* qrow  , int g) {
#pragma unroll
    for (int ks = 0; ks < 2; ++ks) { const v4u w = *(const GAS v4u*)(qrow + 8 * g + 32 * ks); const float sc = 0.125f * LOG2E; v4u o;
        o.x = pk2(bflo(w.x) * sc, bfhi(w.x) * sc); o.y = pk2(bflo(w.y) * sc, bfhi(w.y) * sc); o.z = pk2(bflo(w.z) * sc, bfhi(w.z) * sc); o.w = pk2(bflo(w.w) * sc, bfhi(w.w) * sc);
        T.q[ks] = __builtin_bit_cast(bf16x8, o); }
#pragma unroll
    for (int db = 0; db < 4; ++db) T.o[db] = (f32x4){0.f, 0.f, 0.f, 0.f};
    T.m = -1e30f; T.l = 0.f;
}
typedef float f32x2_t __attribute__((ext_vector_type(2))); typedef __bf16 bf16x2_t __attribute__((ext_vector_type(2)));
__device__ __forceinline__ unsigned cvtpk(float lo, float hi) { f32x2_t v = {lo, hi}; bf16x2_t b = __builtin_convertvector(v, bf16x2_t); return __builtin_bit_cast(unsigned, b); }
constexpr float THR = 8.0f;
template <int NQ, int NP> __device__ __forceinline__ void attn_step(QT (&T)[NQ], const LAS unsigned char* kp, const LAS unsigned char* vp, const LAS float* const (&tp)[NQ], int p, int koff0, int koff1, const int (&voff)[4], int klo, int khi, bool edge, int g) {
    bf16x8 kf[NP][4]; v4i16 vlo[NP][4], vhi[NP][4];
#pragma unroll
    for (int c = 0; c < NP; ++c) { kf[c][0] = *(const LAS bf16x8*)(kp + c * 4096 + koff0); kf[c][1] = *(const LAS bf16x8*)(kp + c * 4096 + koff1); kf[c][2] = *(const LAS bf16x8*)(kp + c * 4096 + 2048 + koff0); kf[c][3] = *(const LAS bf16x8*)(kp + c * 4096 + 2048 + koff1);
#pragma unroll
        for (int db = 0; db < 4; ++db) { vlo[c][db] = vtr(vp + c * 4096 + voff[db]); vhi[c][db] = vtr(vp + c * 4096 + 2048 + voff[db]); } }
#pragma unroll
    for (int n = 0; n < NQ; ++n) {
        f32x4 s[NP][2];
#pragma unroll
        for (int c = 0; c < NP; ++c) {
            s[c][0] = *(const LAS f32x4*)(tp[n] + (p + c) * 32); s[c][1] = *(const LAS f32x4*)(tp[n] + (p + c) * 32 + 16);
            s[c][0] = __builtin_amdgcn_mfma_f32_16x16x32_bf16(kf[c][0], T[n].q[0], s[c][0], 0, 0, 0); s[c][0] = __builtin_amdgcn_mfma_f32_16x16x32_bf16(kf[c][1], T[n].q[1], s[c][0], 0, 0, 0);
            s[c][1] = __builtin_amdgcn_mfma_f32_16x16x32_bf16(kf[c][2], T[n].q[0], s[c][1], 0, 0, 0); s[c][1] = __builtin_amdgcn_mfma_f32_16x16x32_bf16(kf[c][3], T[n].q[1], s[c][1], 0, 0, 0);
            if (edge) { const int kk = (p + c) * 32 + 4 * g;
#pragma unroll
                for (int r = 0; r < 4; ++r) { if (kk + r < klo || kk + r >= khi) s[c][0][r] = -INFINITY; if (kk + 16 + r < klo || kk + 16 + r >= khi) s[c][1][r] = -INFINITY; } } }
        float tm = fmaxf(fmaxf(fmaxf(s[0][0][0], s[0][0][1]), fmaxf(s[0][0][2], s[0][0][3])), fmaxf(fmaxf(s[0][1][0], s[0][1][1]), fmaxf(s[0][1][2], s[0][1][3])));
        if (NP == 2) tm = fmaxf(tm, fmaxf(fmaxf(fmaxf(s[NP - 1][0][0], s[NP - 1][0][1]), fmaxf(s[NP - 1][0][2], s[NP - 1][0][3])), fmaxf(fmaxf(s[NP - 1][1][0], s[NP - 1][1][1]), fmaxf(s[NP - 1][1][2], s[NP - 1][1][3]))));
        tm = xmax4(tm);
        if (__any(tm > T[n].m + THR)) { const float mn = fmaxf(T[n].m, tm), al = __builtin_amdgcn_exp2f(T[n].m - mn); T[n].m = mn; T[n].l *= al;
#pragma unroll
            for (int db = 0; db < 4; ++db) T[n].o[db] = T[n].o[db] * al; }
        const float mref = T[n].m; float ls = 0.f;
#pragma unroll
        for (int c = 0; c < NP; ++c) {
#pragma unroll
            for (int r = 0; r < 4; ++r) { s[c][0][r] = __builtin_amdgcn_exp2f(s[c][0][r] - mref); s[c][1][r] = __builtin_amdgcn_exp2f(s[c][1][r] - mref); }
            ls += ((s[c][0][0] + s[c][0][1]) + (s[c][0][2] + s[c][0][3])) + ((s[c][1][0] + s[c][1][1]) + (s[c][1][2] + s[c][1][3])); }
        T[n].l += ls;
#pragma unroll
        for (int c = 0; c < NP; ++c) {
            v4u pw; pw.x = cvtpk(s[c][0][0], s[c][0][1]); pw.y = cvtpk(s[c][0][2], s[c][0][3]); pw.z = cvtpk(s[c][1][0], s[c][1][1]); pw.w = cvtpk(s[c][1][2], s[c][1][3]);
            const bf16x8 pf = __builtin_bit_cast(bf16x8, pw);
#pragma unroll
            for (int db = 0; db < 4; ++db) { const bf16x8 vf = (bf16x8){vlo[c][db][0], vlo[c][db][1], vlo[c][db][2], vlo[c][db][3], vhi[c][db][0], vhi[c][db][1], vhi[c][db][2], vhi[c][db][3]};
                T[n].o[db] = __builtin_amdgcn_mfma_f32_16x16x32_bf16(vf, pf, T[n].o[db], 0, 0, 0); } }
    }
}
template <int NQ> __device__ __forceinline__ void attn_job(QT (&T)[NQ], const LAS unsigned char* Kw, const LAS unsigned char* Vw, int npairs, const LAS float* const (&tp)[NQ], int klo, int khi, bool edge, int lane) {
    const int i = lane & 15, g = lane >> 4;
    const int koff0 = i * 128 + (((g) ^ (i >> 1)) << 4), koff1 = i * 128 + (((g + 4) ^ (i >> 1)) << 4);
    const int qq = i >> 2, pp = i & 3, vr = 4 * g + qq, fv = (vr >> 1) & 3;
    int voff[4];
#pragma unroll
    for (int db = 0; db < 4; ++db) voff[db] = vr * 128 + ((((db ^ fv) << 1) + (pp >> 1)) << 4) + (pp & 1) * 8;
    int p = 0;
    if (NQ == 1) {
#pragma unroll 1
        for (; p + 2 <= npairs; p += 2) attn_step<NQ, 2>(T, Kw + p * 4096, Vw + p * 4096, tp, p, koff0, koff1, voff, klo, khi, edge, g);
    }
#pragma unroll 1
    for (; p < npairs; ++p) attn_step<NQ, 1>(T, Kw + p * 4096, Vw + p * 4096, tp, p, koff0, koff1, voff, klo, khi, edge, g);
}
__device__ __forceinline__ void four_ssq(Frame& F) {
    const bf16* A2 = (const bf16*)(F.ws + WS_A2); float* SSA = (float*)(F.ws + WS_SSA);
    const int gw = F.vcu * NWAVES + F.wave, NGW = F.G * NWAVES;
    for (int m0 = gw; m0 < M; m0 += 4 * NGW) { v2u w[4];
#pragma unroll
        for (int r = 0; r < 4; ++r) { const int m = (m0 + r * NGW) < M ? (m0 + r * NGW) : 0; w[r] = *(const GAS v2u*)(A2 + (size_t)m * MIXW + AW + 4 * F.lane); }
#pragma unroll
        for (int r = 0; r < 4; ++r) { const int m = m0 + r * NGW; const float a = bflo(w[r].x), b2 = bfhi(w[r].x), c = bflo(w[r].y), d = bfhi(w[r].y);
            const float s = wave_sum((a * a + b2 * b2) + (c * c + d * d));
            if (m < M && F.lane == 0) *(GAS f32x4*)(SSA + (size_t)m * 16 + 12) = (f32x4){s, 0.f, 0.f, 0.f}; } }
}
__device__ __forceinline__ void phase_local(Frame& F) {
    constexpr int NU = BATCH * NH * 16; const int per = (NU + F.G - 1) / F.G, ub = F.vcu * per, ue = (ub + per) < NU ? (ub + per) : NU;
    const bf16* PROJ = (const bf16*)(F.ws + WS_PROJ); const int lane = F.lane, w = F.wave, i = lane & 15, g = lane >> 4;
    const int idx4 = w >> 1, rA = w & 1, rB = 2 + (w & 1);
    Pre R; int hprev = -1;
    __syncthreads();
    if (ub < ue) { const int bh = ub >> 4; prefetch<6>(F, R, PROJ + (size_t)(bh / NH) * SEQ * NPROJ, bh % NH, 0, (ub & 15) * 256); }
    for (int u = ub; u < ue; ++u) {
        const int bh = u >> 4, b = bh / NH, h = bh % NH, s0 = (u & 15) * 256;
        const bf16* P = PROJ + (size_t)b * SEQ * NPROJ; bf16* A2 = (bf16*)(F.ws + WS_A2) + (size_t)b * SEQ * MIXW; float* ML = (float*)(F.ws + WS_ML) + (size_t)b * SEQ * NH * 2;
        __syncthreads();
        commit<6>(F, R);
        if (h != hprev) { build_table(F, LDS_T0, 0, h); build_table(F, LDS_T1, 1, h); hprev = h; }
        __syncthreads();
        const int u0 = s0 / 4 - 64;
        QT T[2];
        const int tokA = s0 + rA + 4 * (16 * idx4 + i), tokB = s0 + rB + 4 * (16 * idx4 + i);
        load_q(T[0], P + (size_t)tokA * NPROJ + h * 64, g); load_q(T[1], P + (size_t)tokB * NPROJ + h * 64, g);
        asm volatile("" ::: "memory");
        prefetch<6>(F, R, P, h, 1, u0);
        {
            const LAS float* tp[2] = { table_ptr(F, LDS_T0, 4 * g - 4 * i - rA + TPAD0), table_ptr(F, LDS_T0, 4 * g - 4 * i - rB + TPAD0) };
            int klo = 64 - s0 - 64 * idx4; klo = klo > 0 ? klo : 0; int khi = SEQ + 64 - s0 - 64 * idx4; khi = khi < 192 ? khi : 192;
            attn_job<2>(T, F.lds + LDS_K + 64 * idx4 * 128, F.lds + LDS_V + 64 * idx4 * 128, 6, tp, klo, khi, (klo > 0 || khi < 192), lane);
        }
#pragma unroll
        for (int pass = 0; pass < 2; ++pass) {
            __syncthreads();
            commit<6>(F, R);
            __syncthreads();
            if (pass == 0) prefetch<6>(F, R, P, h, 2, u0);
            else if (u + 1 < ue) { const int bh2 = (u + 1) >> 4; prefetch<6>(F, R, PROJ + (size_t)(bh2 / NH) * SEQ * NPROJ, bh2 % NH, 0, ((u + 1) & 15) * 256); }
            const int cl = w & 1, lo = idx4 < 2 ? idx4 : 2;
            const LAS float* tp[1] = { table_ptr(F, LDS_T1, 4 * g - i + 16 * (lo - idx4) + TPAD0) };
            int klo = -(u0 + 16 * lo); klo = klo > 0 ? klo : 0; int khi = SEQ / 4 - (u0 + 16 * lo); khi = khi < 160 ? khi : 160;
            QT (&Tp)[1] = *(QT (*)[1])(&T[pass]);
            attn_job<1>(Tp, F.lds + LDS_K + (192 * cl + 16 * lo) * 128, F.lds + LDS_V + (192 * cl + 16 * lo) * 128, 5, tp, klo, khi, (klo > 0 || khi < 160), lane);
        }
#pragma unroll
        for (int n = 0; n < 2; ++n) {
            const float l = xsum4(T[n].l); const float inv = 1.0f / l; const int tok = n == 0 ? tokA : tokB;
#pragma unroll
            for (int db = 0; db < 4; ++db) { v2u o; o.x = pk2(T[n].o[db][0] * inv, T[n].o[db][1] * inv); o.y = pk2(T[n].o[db][2] * inv, T[n].o[db][3] * inv);
                *(GAS v2u*)(A2 + (size_t)tok * MIXW + h * 64 + 16 * db + 4 * g) = o; }
            if (g == 0) { float* mlp = ML + ((size_t)tok * NH + h) * 2; mlp[0] = T[n].m; mlp[1] = l; }
        }
    }
    __syncthreads();
}
__device__ __forceinline__ void phase_class(Frame& F) {
    four_ssq(F);
    constexpr int NU = BATCH * NH * 16; const int per = (NU + F.G - 1) / F.G, ub = F.vcu * per, ue = (ub + per) < NU ? (ub + per) : NU;
    const bf16* PROJ = (const bf16*)(F.ws + WS_PROJ); const int lane = F.lane, w = F.wave, i = lane & 15, g = lane >> 4; float* SSA = (float*)(F.ws + WS_SSA);
    Pre R; int hprev = -1;
    __syncthreads();
    if (ub < ue) { const int bh = ub >> 4; prefetch<4>(F, R, PROJ + (size_t)(bh / NH) * SEQ * NPROJ, bh % NH, 3, ub & 15); }
    for (int u = ub; u < ue; ++u) {
        const int bh = u >> 4, b = bh / NH, h = bh % NH, r = u & 15;
        const bf16* P = PROJ + (size_t)b * SEQ * NPROJ; bf16* A2 = (bf16*)(F.ws + WS_A2) + (size_t)b * SEQ * MIXW; const float* ML = (const float*)(F.ws + WS_ML) + (size_t)b * SEQ * NH * 2;
        __syncthreads();
        commit<4>(F, R);
        if (h != hprev) { build_table(F, LDS_T0, 2, h); hprev = h; }
        __syncthreads();
        QT T2[2]; float mlv[2], llv[2]; v2u pvv[2][4];
#pragma unroll
        for (int n = 0; n < 2; ++n) { const int qt = n == 0 ? (w < 7 ? w : 11) : (w < 4 ? w + 7 : (w < 7 ? w + 8 : 15)); const int tok = r + 16 * (16 * qt + i);
            load_q(T2[n], P + (size_t)tok * NPROJ + h * 64, g);
            const float* mlp = ML + ((size_t)tok * NH + h) * 2; mlv[n] = mlp[0]; llv[n] = mlp[1];
#pragma unroll
            for (int db = 0; db < 4; ++db) pvv[n][db] = *(const GAS v2u*)(A2 + (size_t)tok * MIXW + h * 64 + 16 * db + 4 * g); }
        asm volatile("" ::: "memory");
        if (u + 1 < ue) { const int bh2 = (u + 1) >> 4; prefetch<4>(F, R, PROJ + (size_t)(bh2 / NH) * SEQ * NPROJ, bh2 % NH, 3, (u + 1) & 15); }
#pragma unroll
        for (int n = 0; n < 2; ++n) {
            const int qt = n == 0 ? (w < 7 ? w : 11) : (w < 4 ? w + 7 : (w < 7 ? w + 8 : 15));
            int lo = qt - 4 > 0 ? qt - 4 : 0, hi = qt + 4 < 15 ? qt + 4 : 15; if (((hi - lo + 1) & 1) != 0) { if (hi < 15) ++hi; else --lo; }
            const int tok = r + 16 * (16 * qt + i);
            QT (&T)[1] = *(QT (*)[1])(&T2[n]);
            const LAS float* tp[1] = { table_ptr(F, LDS_T0, 4 * g - i + 16 * (lo - qt) + 64 + TPAD0) };
            attn_job<1>(T, F.lds + LDS_K + 16 * lo * 128, F.lds + LDS_V + 16 * lo * 128, (hi - lo + 1) >> 1, tp, 0, 1 << 20, false, lane);
            const float l16 = xsum4(T[0].l);
            const float ml = mlv[n], ll = llv[n];
            const float mm = fmaxf(ml, T[0].m), a = __builtin_amdgcn_exp2f(ml - mm) * ll, bb = __builtin_amdgcn_exp2f(T[0].m - mm), inv = 1.0f / (a + bb * l16); float sq = 0.f;
#pragma unroll
            for (int db = 0; db < 4; ++db) { GAS v2u* op = (GAS v2u*)(A2 + (size_t)tok * MIXW + h * 64 + 16 * db + 4 * g); const v2u pv = pvv[n][db]; v2u o;
                const float f0 = (bflo(pv.x) * a + T[0].o[db][0] * bb) * inv, f1 = (bfhi(pv.x) * a + T[0].o[db][1] * bb) * inv, f2 = (bflo(pv.y) * a + T[0].o[db][2] * bb) * inv, f3 = (bfhi(pv.y) * a + T[0].o[db][3] * bb) * inv;
                sq += (f0 * f0 + f1 * f1) + (f2 * f2 + f3 * f3); o.x = pk2(f0, f1); o.y = pk2(f2, f3);
                *op = o; }
            sq = xsum4(sq);
            if (g == 0) SSA[((size_t)b * SEQ + tok) * 16 + h] = sq;
        }
    }
    __syncthreads();
}
}


namespace fou {
typedef short bf16x8 __attribute__((ext_vector_type(8)));
typedef short v4i16 __attribute__((ext_vector_type(4)));
constexpr int LX = 0, LC = LDSCTL_OFF + 8192, LS = LDSCTL_OFF + 16384;
__device__ __forceinline__ int gsw(int s2) { const int pr = (s2 >> 1) & 7; return (pr & 4) | ((pr & 1) << 1) | ((pr >> 1) & 1); }
__device__ __forceinline__ int xaddr(int pe, int s2, int chunk) { return LX + pe * 8192 + s2 * 128 + (((chunk ^ gsw(s2) ^ pe) & 7) << 4); }
__device__ __forceinline__ int maddr(int base, int k, int chunk) { return base + k * 128 + (((chunk ^ (k >> 1)) & 7) << 4); }
__device__ __forceinline__ v4i16 vtr(const LAS unsigned char* p) { return __builtin_amdgcn_ds_read_tr16_b64_v4i16((LAS v4i16*)p); }
__device__ __forceinline__ bf16x8 neg8(bf16x8 v) { v4u w = __builtin_bit_cast(v4u, v); w.x ^= 0x80008000u; w.y ^= 0x80008000u; w.z ^= 0x80008000u; w.w ^= 0x80008000u; return __builtin_bit_cast(bf16x8, w); }

__device__ __forceinline__ void fourier_unit(Frame& F, int b, int g, int ec) {
    const bf16* PROJ = (const bf16*)(F.ws + WS_PROJ); bf16* A2 = (bf16*)(F.ws + WS_A2); const float* tabMg = (const float*)(F.ws + WS_TAB + TAB_MG);
    const int lane = F.lane, w = F.wave, li = lane & 15, gq = lane >> 4, e0 = 8 * ec;
    LAS unsigned char* L = F.lds;
    __syncthreads();
    bf16x8 mb[2];
#pragma unroll
    for (int ks = 0; ks < 2; ++ks) { float v[8];
#pragma unroll
        for (int j = 0; j < 8; ++j) { const int c = 8 * gq + j + 32 * ks; const int col = li < 8 ? e0 + li : 64 + e0 + (li & 7); v[j] = tabMg[(g * 64 + c) * 128 + col]; }
        v4u o; o.x = pk2(v[0], v[1]); o.y = pk2(v[2], v[3]); o.z = pk2(v[4], v[5]); o.w = pk2(v[6], v[7]); mb[ks] = __builtin_bit_cast(bf16x8, o); }
    const bf16* ub = PROJ + (size_t)(b * SEQ) * NPROJ + 3 * AW + g * 64 + 8 * gq;
#pragma unroll 8
    for (int it = 0; it < 32; ++it) { const int tile = w + 8 * it, s2 = tile & 63, tq = tile >> 6;
        const bf16* up = ub + (size_t)(64 * (16 * tq + li) + s2) * NPROJ;
        const bf16x8 a0 = __builtin_bit_cast(bf16x8, *(const GAS v4u*)up), a1 = __builtin_bit_cast(bf16x8, *(const GAS v4u*)(up + 32));
        f32x4 d = (f32x4){0.f, 0.f, 0.f, 0.f};
        d = __builtin_amdgcn_mfma_f32_16x16x32_bf16(a0, mb[0], d, 0, 0, 0); d = __builtin_amdgcn_mfma_f32_16x16x32_bf16(a1, mb[1], d, 0, 0, 0);
        v2u o; o.x = pk2(d[0], d[1]); o.y = pk2(d[2], d[3]); *(LAS v2u*)(L + xaddr(li, s2, 2 * tq + (gq >> 1)) + (gq & 1) * 8) = o; }
    __syncthreads();
    const int e = w;
#pragma unroll 1
    for (int mt = 0; mt < 4; ++mt) { const int s2 = 16 * mt + li;
        bf16x8 yr[2], yi[2], nyr[2];
#pragma unroll
        for (int kh = 0; kh < 2; ++kh) { yr[kh] = *(const LAS bf16x8*)(L + xaddr(e, s2, gq + 4 * kh)); yi[kh] = *(const LAS bf16x8*)(L + xaddr(8 + e, s2, gq + 4 * kh)); nyr[kh] = neg8(yr[kh]); }
#pragma unroll
        for (int nt = 0; nt < 4; ++nt) { const int k = 16 * nt + li;
            const bf16x8 c0 = *(const LAS bf16x8*)(L + maddr(LC, k, gq)), c1 = *(const LAS bf16x8*)(L + maddr(LC, k, gq + 4)), s0 = *(const LAS bf16x8*)(L + maddr(LS, k, gq)), s1 = *(const LAS bf16x8*)(L + maddr(LS, k, gq + 4));
            f32x4 tr = (f32x4){0.f, 0.f, 0.f, 0.f}, ti = (f32x4){0.f, 0.f, 0.f, 0.f};
            tr = __builtin_amdgcn_mfma_f32_16x16x32_bf16(c0, yr[0], tr, 0, 0, 0); tr = __builtin_amdgcn_mfma_f32_16x16x32_bf16(c1, yr[1], tr, 0, 0, 0);
            tr = __builtin_amdgcn_mfma_f32_16x16x32_bf16(s0, yi[0], tr, 0, 0, 0); tr = __builtin_amdgcn_mfma_f32_16x16x32_bf16(s1, yi[1], tr, 0, 0, 0);
            ti = __builtin_amdgcn_mfma_f32_16x16x32_bf16(c0, yi[0], ti, 0, 0, 0); ti = __builtin_amdgcn_mfma_f32_16x16x32_bf16(c1, yi[1], ti, 0, 0, 0);
            ti = __builtin_amdgcn_mfma_f32_16x16x32_bf16(s0, nyr[0], ti, 0, 0, 0); ti = __builtin_amdgcn_mfma_f32_16x16x32_bf16(s1, nyr[1], ti, 0, 0, 0);
            float orr[4], oii[4];
#pragma unroll
            for (int r = 0; r < 4; ++r) { const int k1 = 16 * nt + 4 * gq + r; const float rev = (float)((k1 * s2) & 4095) * (1.0f / 4096.0f); const float cv = __builtin_amdgcn_cosf(rev), sv = __builtin_amdgcn_sinf(rev);
                orr[r] = tr[r] * cv + ti[r] * sv; oii[r] = ti[r] * cv - tr[r] * sv; }
            v2u o; o.x = pk2(orr[0], orr[1]); o.y = pk2(orr[2], orr[3]); *(LAS v2u*)(L + xaddr(e, s2, 2 * nt + (gq >> 1)) + (gq & 1) * 8) = o;
            o.x = pk2(oii[0], oii[1]); o.y = pk2(oii[2], oii[3]); *(LAS v2u*)(L + xaddr(8 + e, s2, 2 * nt + (gq >> 1)) + (gq & 1) * 8) = o; } }
    asm volatile("s_waitcnt lgkmcnt(0)" ::: "memory");
    bf16x8 af[4][4];
    { const int q = li >> 2, p = li & 3;
#pragma unroll
      for (int mt = 0; mt < 4; ++mt)
#pragma unroll
        for (int ks = 0; ks < 4; ++ks) { const int pe = (ks >> 1) * 8 + e, s2b = 8 * gq + 32 * (ks & 1) + q;
            const v4i16 lo = vtr(L + xaddr(pe, s2b, 2 * mt + (p >> 1)) + (p & 1) * 8), hi = vtr(L + xaddr(pe, s2b + 4, 2 * mt + (p >> 1)) + (p & 1) * 8);
            af[mt][ks] = (bf16x8){lo[0], lo[1], lo[2], lo[3], hi[0], hi[1], hi[2], hi[3]}; } }
    asm volatile("s_waitcnt lgkmcnt(0)" ::: "memory");
    __syncthreads();
    const float bias = F.f_b[g * 64 + e0 + e];
#pragma unroll 1
    for (int nt = 0; nt < 4; ++nt) { const int k2 = 16 * nt + li;
        const bf16x8 c0 = *(const LAS bf16x8*)(L + maddr(LC, k2, gq)), c1 = *(const LAS bf16x8*)(L + maddr(LC, k2, gq + 4)), s0 = *(const LAS bf16x8*)(L + maddr(LS, k2, gq)), s1 = *(const LAS bf16x8*)(L + maddr(LS, k2, gq + 4));
#pragma unroll
        for (int mt = 0; mt < 4; ++mt) { f32x4 d = (f32x4){0.f, 0.f, 0.f, 0.f};
            d = __builtin_amdgcn_mfma_f32_16x16x32_bf16(af[mt][0], c0, d, 0, 0, 0); d = __builtin_amdgcn_mfma_f32_16x16x32_bf16(af[mt][1], c1, d, 0, 0, 0);
            d = __builtin_amdgcn_mfma_f32_16x16x32_bf16(af[mt][2], s0, d, 0, 0, 0); d = __builtin_amdgcn_mfma_f32_16x16x32_bf16(af[mt][3], s1, d, 0, 0, 0);
#pragma unroll
            for (int r = 0; r < 4; ++r) { const int k1 = 16 * mt + 4 * gq + r; *(LAS bf16*)(L + LX + (k1 * 64 + k2) * 16 + e * 2) = (bf16)f2bf(d[r] * (1.0f / 512.0f) + bias); } } }
    __syncthreads();
    bf16* ob = A2 + (size_t)(b * SEQ) * MIXW + AW + g * 64 + e0;
#pragma unroll
    for (int j = 0; j < 8; ++j) { const int sl = F.tid + 512 * j, k1 = sl >> 6, k2 = sl & 63; const v4u v = *(const LAS v4u*)(L + LX + sl * 16); *(GAS v4u*)(ob + (size_t)(k1 + 64 * k2) * MIXW) = v; }
}
__device__ __forceinline__ void phase_fourier(Frame& F) {
    const float* tabTw = (const float*)(F.ws + WS_TAB + TAB_TW);
    __syncthreads();
    for (int idx = F.tid; idx < 4096; idx += NWAVES * 64) { const int k = idx >> 6, s = idx & 63, n = ((k * s) & 63) * 64;
        *(LAS bf16*)(F.lds + maddr(LC, k, s >> 3) + (s & 7) * 2) = (bf16)f2bf(tabTw[2 * n]); *(LAS bf16*)(F.lds + maddr(LS, k, s >> 3) + (s & 7) * 2) = (bf16)f2bf(tabTw[2 * n + 1]); }
    __syncthreads();
    for (int u = F.vcu; u < BATCH * NG * 8; u += F.G) fourier_unit(F, u >> 5, (u >> 3) & 3, u & 7);
    __syncthreads();
}
}

__device__ __forceinline__ void p10_final(Frame& F) {
    const bf16* X2 = (const bf16*)(F.ws + WS_XN); const float* SS2 = (const float*)(F.ws + WS_SS2);
    const int gw = F.vcu * NWAVES + F.wave, NGW = F.G * NWAVES; const int lane = F.lane;
    const GAS f32x4* gr = (const GAS f32x4*)(F.g_fin + 16 * lane); const f32x4 g0 = gr[0], g1 = gr[1], g2 = gr[2], g3 = gr[3];
    for (int m0 = gw; m0 < M; m0 += 4 * NGW) { v4u w0[4], w1[4]; float part[4];
#pragma unroll
        for (int r = 0; r < 4; ++r) { const int m = (m0 + r * NGW) < M ? (m0 + r * NGW) : 0; const GAS v4u* rp = (const GAS v4u*)(X2 + (size_t)m * D + 16 * lane); w0[r] = rp[0]; w1[r] = rp[1];
            part[r] = lane < 16 ? SS2[(size_t)m * 16 + lane] : 0.f; }
#pragma unroll
        for (int r = 0; r < 4; ++r) { const int m = m0 + r * NGW; const float rstd = 1.0f / sqrtf(wave_sum(part[r]) * (1.f / D) + EPS);
            if (m < M) { GAS f32x4* op = (GAS f32x4*)(F.out + (size_t)m * D + 16 * lane);
                op[0] = (f32x4){bflo(w0[r].x), bfhi(w0[r].x), bflo(w0[r].y), bfhi(w0[r].y)} * rstd * g0; op[1] = (f32x4){bflo(w0[r].z), bfhi(w0[r].z), bflo(w0[r].w), bfhi(w0[r].w)} * rstd * g1;
                op[2] = (f32x4){bflo(w1[r].x), bfhi(w1[r].x), bflo(w1[r].y), bfhi(w1[r].y)} * rstd * g2; op[3] = (f32x4){bflo(w1[r].z), bfhi(w1[r].z), bflo(w1[r].w), bfhi(w1[r].w)} * rstd * g3; } } }
}


__device__ __forceinline__ void p8_halo_fix(Frame& F, int pm) {
    const float* H = (const float*)(F.ws + WS_HALO); bf16* ACT = (bf16*)(F.ws + WS_GV); const int kt = pm & 15;
    for (int it = F.tid; it < 2 * (FF / 4); it += NWAVES * 64) { const int c4 = (it % (FF / 4)) * 4, side = it / (FF / 4);
        if ((side == 0 && kt == 0) || (side == 1 && kt == 15)) continue;
        const float* own = H + (size_t)(pm * 2 + side) * 3 * FF + c4; const float* nb = H + (size_t)((side == 0 ? (pm - 1) * 2 + 1 : (pm + 1) * 2)) * 3 * FF + c4;
        const f32x4 gn = *(const GAS f32x4*)nb, zp = *(const GAS f32x4*)(own + FF), vv = *(const GAS f32x4*)(own + 2 * FF), wt = *(const GAS f32x4*)(F.conv_w + (side == 0 ? 0 : 2 * FF) + c4);
        float a[4];
#pragma unroll
        for (int i = 0; i < 4; ++i) { const float z = zp[i] + wt[i] * gn[i]; a[i] = z * __builtin_amdgcn_rcpf(1.0f + __builtin_amdgcn_exp2f(-1.4426950408889634f * z)) * vv[i]; }
        const unsigned long long o = (unsigned long long)pk2(a[0], a[1]) | ((unsigned long long)pk2(a[2], a[3]) << 32);
        __hip_atomic_store((unsigned long long*)(ACT + (size_t)(pm * 256 + (side ? 255 : 0)) * FF + c4), o, __ATOMIC_RELAXED, __HIP_MEMORY_SCOPE_AGENT); }
}


__device__ __forceinline__ void p6_quant(Frame& F) {
    const bf16* X1 = (const bf16*)(F.ws + WS_XN); unsigned char* A8 = F.ws + WS_A8; float* SROW = (float*)(F.ws + WS_SS1); const unsigned* cmax = (const unsigned*)(F.ctl + CW_CMAX);
    const int gw = F.vcu * NWAVES + F.wave, NGW = F.G * NWAVES, lane = F.lane;
    {   LAS float* scr = (LAS float*)(F.lds + RING_OFF + F.wave * 16384); constexpr int I_G = (D / 64) * (FF / 32);
        for (int it = gw; it < 2 * I_G; it += NGW) { const bool isv = it >= I_G; p6_quant_item(isv ? F.w_val : F.w_gate, D, FF, F.ws + WS_WGV, isv ? 128 : 0, scr, isv ? it - I_G : it, lane, F.g_ffn, cmax); } }
    {   float* cw6 = (float*)(F.ws + WS_TAB + TAB_CW4); const int gt = F.vcu * (NWAVES * 64) + F.tid, NGT = F.G * NWAVES * 64;
        for (int i = gt; i < (FF / 128) * 768; i += NGT) { const int pn = i / 768, k = (i % 768) >> 7, c = i & 127, ch = 128 * pn + c;
            cw6[i] = k < 3 ? F.conv_w[k * FF + ch] : (k == 3 ? F.conv_b[ch] : __uint_as_float(cmax[256 * pn + (k == 5 ? 128 : 0) + c]) * (1.0f / 127.0f)); } }
    for (int m0 = gw; m0 < M; m0 += 4 * NGW) { v4u w0[4], w1[4];
#pragma unroll
        for (int r = 0; r < 4; ++r) { const int m = (m0 + r * NGW) < M ? (m0 + r * NGW) : 0; const GAS v4u* rp = (const GAS v4u*)(X1 + (size_t)m * D + 16 * lane); w0[r] = rp[0]; w1[r] = rp[1]; }
#pragma unroll
        for (int r = 0; r < 4; ++r) { const int m = m0 + r * NGW; float v[16];
            v[0] = bflo(w0[r].x); v[1] = bfhi(w0[r].x); v[2] = bflo(w0[r].y); v[3] = bfhi(w0[r].y); v[4] = bflo(w0[r].z); v[5] = bfhi(w0[r].z); v[6] = bflo(w0[r].w); v[7] = bfhi(w0[r].w);
            v[8] = bflo(w1[r].x); v[9] = bfhi(w1[r].x); v[10] = bflo(w1[r].y); v[11] = bfhi(w1[r].y); v[12] = bflo(w1[r].z); v[13] = bfhi(w1[r].z); v[14] = bflo(w1[r].w); v[15] = bfhi(w1[r].w);
            float ss = 0.f, mx = 0.f;
#pragma unroll
            for (int i = 0; i < 16; ++i) { ss += v[i] * v[i]; mx = fmaxf(mx, fabsf(v[i])); }
            ss = wave_sum(ss);
#pragma unroll
            for (int o = 1; o < 64; o <<= 1) mx = fmaxf(mx, __shfl_xor(mx, o));
            const float inv = mx > 0.f ? 127.0f / mx : 0.f; unsigned q[4];
#pragma unroll
            for (int j = 0; j < 4; ++j) { q[j] = 0;
#pragma unroll
                for (int t = 0; t < 4; ++t) q[j] |= ((unsigned)(int)__builtin_rintf(v[4 * j + t] * inv) & 255u) << (8 * t); }
            if (m < M) { *(GAS v4u*)(A8 + (size_t)m * D + 16 * lane) = (v4u){q[0], q[1], q[2], q[3]};
                if (lane == 0) SROW[m] = mx * (1.0f / 127.0f) * (1.0f / sqrtf(ss * (1.f / D) + EPS)); } } }
}

struct Args { const float* in[16]; float* out; unsigned char* ws; int ph_lo, ph_hi; };
__global__ void __launch_bounds__(NWAVES * 64, 2) hymba_fwd(Args args) {
    extern __shared__ __attribute__((aligned(16))) unsigned char lds[];
    Frame F;
    F.lds = (LAS unsigned char*)lds;
    F.MISC = (volatile LAS unsigned*)(F.lds + MISC_OFF);
    F.tid = threadIdx.x; F.lane = F.tid & 63; F.wave = __builtin_amdgcn_readfirstlane(F.tid >> 6);
    F.G = gridDim.x; { const int bx = blockIdx.x; F.vcu = (F.G % 8 == 0) ? (bx % 8) * (F.G / 8) + bx / 8 : bx; }
    F.ws = args.ws; F.ctl = (gu32*)(args.ws + WS_CTL);
    F.x = args.in[0]; F.g_mix = args.in[1]; F.w_in = args.in[2]; F.g_attn = args.in[3]; F.rel_tab = args.in[4]; F.f_w = args.in[5]; F.f_b = args.in[6]; F.g_four = args.in[7];
    F.w_out = args.in[8]; F.g_ffn = args.in[9]; F.w_gate = args.in[10]; F.w_val = args.in[11]; F.conv_w = args.in[12]; F.conv_b = args.in[13]; F.w_down = args.in[14]; F.g_fin = args.in[15];
    F.out = args.out;
    for (int u = F.tid; u < (LDS_BYTES - LDSCTL_OFF) / 4; u += NWAVES * 64) ((LAS unsigned*)(F.lds + LDSCTL_OFF))[u] = 0u;
    __syncthreads();
    XcdBarrier bar; bar.bar = (unsigned*)(F.ctl + CW_BAR); bar.x = 0; bar.st = nullptr;
    if (MK_ONE_LAUNCH) bar = xcd_barrier_post((unsigned*)(F.ctl + CW_BAR), F.MISC + 8);
#define GRID_BAR() do { if (MK_ONE_LAUNCH) xcd_barrier(bar); } while (0)
    const int lo = args.ph_lo, hi = args.ph_hi;
#define IN(k) (lo <= (k) && (k) < hi)
#define BOTH(k) (IN(k) && IN((k) + 1))
    if (IN(0)) { p0_prologue(F); if (BOTH(0)) GRID_BAR(); }
    if (IN(1)) {
        pg8::Gemm g{(const bf16*)(F.ws + WS_XN), (const bf16*)(F.ws + WS_WIN), M, NPROJ, D, D, 0}; pg8::StaticOrder S; S.init(M, NPROJ, F.G, (int)blockIdx.x);
        pg8::EpiBf16Row E{(bf16*)(F.ws + WS_PROJ), NPROJ, (const float*)(F.ws + WS_RS0)};
        pg8::gemm_phase<pg8::EpiBf16Row, pg8::StaticOrder, true, true>(F.lds + RING_OFF, g, S, E);
        if (BOTH(1)) GRID_BAR();
    }
    if (IN(2)) { att::phase_local(F); fou::phase_fourier(F); if (BOTH(2)) GRID_BAR(); }
    if (IN(3)) { att::phase_class(F); if (IN(3) && IN(5)) GRID_BAR(); }
    if (IN(5)) {
        pg8::Gemm g{(const bf16*)(F.ws + WS_A2), (const bf16*)(F.ws + WS_WOUT), M, D, MIXW, MIXW, 0}; pg8::StaticOrder S; S.init(M, D, F.G, (int)blockIdx.x);
        pg8::EpiX1N E{(const bf16*)(F.ws + WS_XN), (bf16*)(F.ws + WS_XN), D, (float*)(F.ws + WS_SS1), (const float*)(F.ws + WS_SSA), (LAS float*)(F.lds + LDSCTL_OFF + 8192)};
        pg8::gemm_phase<pg8::EpiX1N, pg8::StaticOrder, true, true>(F.lds + RING_OFF, g, S, E);
        if (IN(5) && IN(6)) GRID_BAR();
    }
    if (IN(6)) { p6_quant(F); if (IN(6) && IN(7)) GRID_BAR(); }
    if (IN(7)) {
        pg8::Gemm g{(const bf16*)(F.ws + WS_A8), (const bf16*)(F.ws + WS_WGV), M, 2 * FF, D / 2, D / 2, 0}; pg8::StaticOrder S; S.init(M, 2 * FF, F.G, (int)blockIdx.x);
        pg8::EpiConvGlu E{(bf16*)(F.ws + WS_GV), FF, (const float*)(F.ws + WS_SS1), F.conv_w, F.conv_b, (LAS float*)(F.lds + LDSCTL_OFF + 4096), M, (float*)(F.ws + WS_HALO), (const float*)(F.ws + WS_TAB + TAB_CW4)};
        pg8::gemm_phase<pg8::EpiConvGlu, pg8::StaticOrder, true, true, true>(F.lds + RING_OFF, g, S, E);
        if (IN(7) && IN(9)) GRID_BAR();
    }
    if (IN(9)) {
        pg8::Gemm g{(const bf16*)(F.ws + WS_GV), (const bf16*)(F.ws + WS_WD), M, D, FF, FF, 0}; pg8::StaticOrder S; S.init(M, D, F.G, (int)blockIdx.x);
        { pg8::Unit uu; for (int i = 0; S.next(i, uu); ++i) p8_halo_fix(F, uu.pm); }
        asm volatile("s_waitcnt vmcnt(0)" ::: "memory"); __syncthreads();
        if (F.G == 256) {
            pg8::EpiFinal E{(const bf16*)(F.ws + WS_XN), F.out, D, F.g_fin, (float*)(F.ws + WS_XBUF), (unsigned*)(F.ctl + CW_PANEL), F.lds + LDSCTL_OFF + 4096};
            pg8::gemm_phase<pg8::EpiFinal, pg8::StaticOrder, true, true>(F.lds + RING_OFF, g, S, E);
        } else {
            pg8::EpiX2 E{(bf16*)(F.ws + WS_XN), D, (float*)(F.ws + WS_SS2)};
            pg8::gemm_phase<pg8::EpiX2, pg8::StaticOrder, true, true>(F.lds + RING_OFF, g, S, E);
            if (BOTH(9)) GRID_BAR();
        }
    }
    if (IN(10) && F.G != 256) { p10_final(F); }
#undef IN
#undef BOTH
}

extern "C" void kernel_launch(void* const* d_in, const int* in_sizes, int n_in, void* d_out, int out_size, void* d_ws, size_t ws_size, hipStream_t stream) {
    static int grid = 0;
    if (grid == 0) {
        if (n_in != 16 || in_sizes[0] != M * D || out_size != M * D || ws_size < WS_END) { fprintf(stderr, "kernel_launch: shape/workspace mismatch: n_in %d in0 %d out %d ws %zu (need %zu)\n", n_in, n_in > 0 ? in_sizes[0] : -1, out_size, ws_size, (size_t)WS_END); grid = -1; return; }
        int dev = 0, cus = 0, per_cu = 0;
        if (hipGetDevice(&dev) != hipSuccess || hipDeviceGetAttribute(&cus, hipDeviceAttributeMultiprocessorCount, dev) != hipSuccess) { grid = -1; return; }
        if (hipFuncSetAttribute((const void*)hymba_fwd, hipFuncAttributeMaxDynamicSharedMemorySize, LDS_BYTES) != hipSuccess) { fprintf(stderr, "kernel_launch: hipFuncSetAttribute failed\n"); grid = -1; return; }
        if (hipOccupancyMaxActiveBlocksPerMultiprocessor(&per_cu, (const void*)hymba_fwd, NWAVES * 64, LDS_BYTES) != hipSuccess || per_cu < 1) { fprintf(stderr, "kernel_launch: occupancy query says %d blocks/CU\n", per_cu); (void)hipGetLastError(); grid = -1; return; }
        grid = cus;
    }
    if (grid < 0) return;
    (void)hipMemsetAsync((char*)d_ws + WS_CTL, 0, CTL_ZERO_BYTES, stream);
    Args a{};
    for (int i = 0; i < 16; ++i) a.in[i] = (const float*)d_in[i];
    a.out = (float*)d_out; a.ws = (unsigned char*)d_ws;
#if MK_ONE_LAUNCH
    a.ph_lo = 0; a.ph_hi = N_PHASES;
    hipLaunchKernelGGL(hymba_fwd, dim3(grid), dim3(NWAVES * 64), LDS_BYTES, stream, a);
#else
    for (int p = 0; p < N_PHASES; ++p) { a.ph_lo = p; a.ph_hi = p + 1; hipLaunchKernelGGL(hymba_fwd, dim3(grid), dim3(NWAVES * 64), LDS_BYTES, stream, a); }
#endif
}
```

```cpp
#include <hip/hip_runtime.h>
#include <cstdio>
#include <cstdint>

namespace pg8 {
#define PG8_LAS __attribute__((address_space(3)))
typedef unsigned short bf16_t;
typedef short bf16x8 __attribute__((ext_vector_type(8)));
typedef float f32x4 __attribute__((ext_vector_type(4)));
typedef unsigned u32x4 __attribute__((ext_vector_type(4)));
typedef int i32x4 __attribute__((ext_vector_type(4)));
template <bool I8> struct AccT { typedef f32x4 type; };
template <> struct AccT<true> { typedef i32x4 type; };
constexpr int BM = 256, BK = 64, HALF = 128, HTB = HALF * BK * 2, STAGE_BYTES = 8 * HTB, NXCD = 8, WGM = 8;

__host__ __device__ __forceinline__ int lds_byte(int r, int c) { const int st = (r >> 4) * 2 + (c >> 5), rr = r & 15, cc = c & 31, ob = rr * 64 + cc * 2; return st * 1024 + (ob ^ (((ob >> 9) & 1) << 5)); }
__host__ __device__ __forceinline__ void stage_rc(int b, int& R, int& C) { const int st = b / 1024, sb = b % 1024, swz = sb ^ (((sb >> 9) & 1) << 5); R = (st >> 1) * 16 + swz / 64; C = (st & 1) * 32 + (swz % 64) / 2; }
__host__ __device__ __forceinline__ int perm32(int rho) { const int n = rho >> 4, i = rho & 15; return 8 * (i >> 2) + 4 * n + (i & 3); }

struct Unit { int pm, pn; };
struct Gemm { const bf16_t* A; const bf16_t* Bt; int M, N, K, lda; int ovl; };
__host__ __device__ __forceinline__ int ovl_row_base(int pm) { const int b = pm / 17, k = pm - 17 * b; return b * 4096 + (k ? 254 * k - 1 : 0); }

struct StaticOrder {
    int nM, nN, nwg, G, c;
    __host__ __device__ void init(int M, int N, int G_, int c_) { nM = M / BM; nN = N / BM; nwg = nM * nN; G = G_; c = c_; }
    __host__ __device__ bool next(int i, Unit& u) const {
        const long L = (long)i * G + c; if (L >= nwg) return false;
        int wgid = (int)L; { const int q = nwg / NXCD, r = nwg % NXCD, xcd = wgid % NXCD, off = wgid / NXCD; wgid = (xcd < r ? xcd * (q + 1) : r * (q + 1) + (xcd - r) * q) + off; }
        const int nig = WGM * nN, gid = wgid / nig, fm = gid * WGM, gsz = (nM - fm) < WGM ? (nM - fm) : WGM;
        u.pm = fm + ((wgid % nig) % gsz); u.pn = (wgid % nig) / gsz; return true;
    }
    __device__ __forceinline__ void a_ready(const Unit&) const {}
    __device__ __forceinline__ void done(const Unit&) const {}
};

typedef float f32x2v_t __attribute__((ext_vector_type(2))); typedef __bf16 bf16x2v_t __attribute__((ext_vector_type(2)));
__device__ __forceinline__ unsigned cvt_pk_bf16(float lo, float hi) { f32x2v_t v = {lo, hi}; bf16x2v_t b = __builtin_convertvector(v, bf16x2v_t); return __builtin_bit_cast(unsigned, b); }

struct EpiBf16 {
    static constexpr bool PERM = true, AFTER_DRAIN = false, MIDK = false, PREFETCH = false;
    bf16_t* O; int ldc;
    __device__ __forceinline__ void operator()(const f32x4 (&acc)[2][2][4][2], const Unit& u, int wr, int wc, int fr, int fq) const {
        const int row0 = u.pm * BM + wr * 64 + fr; const int col0 = u.pn * BM + wc * 32 + 8 * fq;
#pragma unroll
        for (int ai = 0; ai < 2; ++ai)
#pragma unroll
            for (int m = 0; m < 4; ++m) { bf16_t* rowp = O + (size_t)(row0 + ai * HALF + m * 16) * ldc + col0;
#pragma unroll
                for (int bj = 0; bj < 2; ++bj) { const f32x4 v0 = acc[ai][bj][m][0], v1 = acc[ai][bj][m][1];
                    u32x4 w; w.x = cvt_pk_bf16(v0[0], v0[1]); w.y = cvt_pk_bf16(v0[2], v0[3]); w.z = cvt_pk_bf16(v1[0], v1[1]); w.w = cvt_pk_bf16(v1[2], v1[3]);
                    *(u32x4*)(rowp + bj * HALF) = w; } }
    }
};

struct EpiBf16Row {
    static constexpr bool PERM = true, AFTER_DRAIN = false, MIDK = false, PREFETCH = false;
    bf16_t* O; int ldc; const float* rs;
    __device__ __forceinline__ void operator()(const f32x4 (&acc)[2][2][4][2], const Unit& u, int wr, int wc, int fr, int fq) const {
        const int row0 = u.pm * BM + wr * 64 + fr; const int col0 = u.pn * BM + wc * 32 + 8 * fq;
#pragma unroll
        for (int ai = 0; ai < 2; ++ai)
#pragma unroll
            for (int m = 0; m < 4; ++m) { const int row = row0 + ai * HALF + m * 16; const float r = rs[row]; bf16_t* rowp = O + (size_t)row * ldc + col0;
#pragma unroll
                for (int bj = 0; bj < 2; ++bj) { const f32x4 v0 = acc[ai][bj][m][0] * r, v1 = acc[ai][bj][m][1] * r;
                    u32x4 w; w.x = cvt_pk_bf16(v0[0], v0[1]); w.y = cvt_pk_bf16(v0[2], v0[3]); w.z = cvt_pk_bf16(v1[0], v1[1]); w.w = cvt_pk_bf16(v1[2], v1[3]);
                    *(u32x4*)(rowp + bj * HALF) = w; } }
    }
};
struct EpiResF32 {
    static constexpr bool PERM = false, AFTER_DRAIN = false, MIDK = false, PREFETCH = false;
    const float* base; float* out; int ldc;
    __device__ __forceinline__ void operator()(const f32x4 (&acc)[2][2][4][2], const Unit& u, int wr, int wc, int fr, int fq) const {
        const int col0 = u.pn * BM + wc * 32 + 4 * fq;
#pragma unroll
        for (int ai = 0; ai < 2; ++ai)
#pragma unroll
            for (int m = 0; m < 4; ++m) { const int r = u.pm * BM + ai * HALF + wr * 64 + m * 16 + fr; const size_t off = (size_t)r * ldc + col0;
#pragma unroll
                for (int bj = 0; bj < 2; ++bj)
#pragma unroll
                    for (int n = 0; n < 2; ++n) { const f32x4 bs = *(const f32x4*)(base + off + bj * HALF + n * 16); *(f32x4*)(out + off + bj * HALF + n * 16) = bs + acc[ai][bj][m][n]; } }
    }
};


struct EpiX1 {
    static constexpr bool PERM = true, AFTER_DRAIN = false, MIDK = false, PREFETCH = false;
    const float* base; bf16_t* O; int ldc; float* ss;
    __device__ __forceinline__ void operator()(const f32x4 (&acc)[2][2][4][2], const Unit& u, int wr, int wc, int fr, int fq) const {
        const int row0 = u.pm * BM + wr * 64 + fr; const int col0 = u.pn * BM + wc * 32 + 8 * fq;
#pragma unroll
        for (int ai = 0; ai < 2; ++ai)
#pragma unroll
            for (int m = 0; m < 4; ++m) { const int row = row0 + ai * HALF + m * 16; const size_t off = (size_t)row * ldc + col0; float q = 0.f;
#pragma unroll
                for (int bj = 0; bj < 2; ++bj) { const f32x4 v0 = *(const f32x4*)(base + off + bj * HALF) + acc[ai][bj][m][0], v1 = *(const f32x4*)(base + off + bj * HALF + 4) + acc[ai][bj][m][1];
                    q += (v0[0] * v0[0] + v0[1] * v0[1]) + (v0[2] * v0[2] + v0[3] * v0[3]) + (v1[0] * v1[0] + v1[1] * v1[1]) + (v1[2] * v1[2] + v1[3] * v1[3]);
                    u32x4 w; w.x = cvt_pk_bf16(v0[0], v0[1]); w.y = cvt_pk_bf16(v0[2], v0[3]); w.z = cvt_pk_bf16(v1[0], v1[1]); w.w = cvt_pk_bf16(v1[2], v1[3]);
                    *(u32x4*)(O + off + bj * HALF) = w; }
                q += __shfl_xor(q, 16); q += __shfl_xor(q, 32);
                if (fq == 0) ss[(size_t)row * 16 + u.pn * 4 + wc] = q; }
    }
};
struct EpiX2 {
    static constexpr bool PERM = true, AFTER_DRAIN = false, MIDK = false, PREFETCH = false;
    bf16_t* X; int ldc; float* ss;
    __device__ __forceinline__ void operator()(const f32x4 (&acc)[2][2][4][2], const Unit& u, int wr, int wc, int fr, int fq) const {
        const int row0 = u.pm * BM + wr * 64 + fr; const int col0 = u.pn * BM + wc * 32 + 8 * fq;
#pragma unroll
        for (int ai = 0; ai < 2; ++ai)
#pragma unroll
            for (int m = 0; m < 4; ++m) { const int row = row0 + ai * HALF + m * 16; const size_t off = (size_t)row * ldc + col0; float q = 0.f;
#pragma unroll
                for (int bj = 0; bj < 2; ++bj) { const u32x4 xb = *(const u32x4*)(X + off + bj * HALF);
                    f32x4 v0, v1; v0[0] = __builtin_bit_cast(float, xb.x << 16); v0[1] = __builtin_bit_cast(float, xb.x & 0xffff0000u); v0[2] = __builtin_bit_cast(float, xb.y << 16); v0[3] = __builtin_bit_cast(float, xb.y & 0xffff0000u);
                    v1[0] = __builtin_bit_cast(float, xb.z << 16); v1[1] = __builtin_bit_cast(float, xb.z & 0xffff0000u); v1[2] = __builtin_bit_cast(float, xb.w << 16); v1[3] = __builtin_bit_cast(float, xb.w & 0xffff0000u);
                    v0 = v0 + acc[ai][bj][m][0]; v1 = v1 + acc[ai][bj][m][1];
                    q += (v0[0] * v0[0] + v0[1] * v0[1]) + (v0[2] * v0[2] + v0[3] * v0[3]) + (v1[0] * v1[0] + v1[1] * v1[1]) + (v1[2] * v1[2] + v1[3] * v1[3]);
                    u32x4 w; w.x = cvt_pk_bf16(v0[0], v0[1]); w.y = cvt_pk_bf16(v0[2], v0[3]); w.z = cvt_pk_bf16(v1[0], v1[1]); w.w = cvt_pk_bf16(v1[2], v1[3]);
                    *(u32x4*)(X + off + bj * HALF) = w; }
                q += __shfl_xor(q, 16); q += __shfl_xor(q, 32);
                if (fq == 0) ss[(size_t)row * 16 + u.pn * 4 + wc] = q; }
    }
};
struct EpiBf16Rs {
    static constexpr bool PERM = true, AFTER_DRAIN = false, MIDK = false, PREFETCH = false;
    bf16_t* O; int ldc; const float* ss; float inv_n, eps;
    __device__ __forceinline__ void operator()(const f32x4 (&acc)[2][2][4][2], const Unit& u, int wr, int wc, int fr, int fq) const {
        const int row0 = u.pm * BM + wr * 64 + fr; const int col0 = u.pn * BM + wc * 32 + 8 * fq;
#pragma unroll
        for (int ai = 0; ai < 2; ++ai)
#pragma unroll
            for (int m = 0; m < 4; ++m) { const int row = row0 + ai * HALF + m * 16; const f32x4* sp = (const f32x4*)(ss + (size_t)row * 16);
                const f32x4 s4 = (sp[0] + sp[1]) + (sp[2] + sp[3]); const float rs = 1.0f / sqrtf(((s4[0] + s4[1]) + (s4[2] + s4[3])) * inv_n + eps);
                bf16_t* rowp = O + (size_t)row * ldc + col0;
#pragma unroll
                for (int bj = 0; bj < 2; ++bj) { const f32x4 v0 = acc[ai][bj][m][0] * rs, v1 = acc[ai][bj][m][1] * rs;
                    u32x4 w; w.x = cvt_pk_bf16(v0[0], v0[1]); w.y = cvt_pk_bf16(v0[2], v0[3]); w.z = cvt_pk_bf16(v1[0], v1[1]); w.w = cvt_pk_bf16(v1[2], v1[3]);
                    *(u32x4*)(rowp + bj * HALF) = w; } }
    }
};


template <int CTRL> __device__ __forceinline__ float dppk(float keep, float x) { return __builtin_bit_cast(float, __builtin_amdgcn_update_dpp(__builtin_bit_cast(int, keep), __builtin_bit_cast(int, x), CTRL, 0xf, 0xf, false)); }
template <int CTRL> __device__ __forceinline__ float dppf(float x) { return __builtin_bit_cast(float, __builtin_amdgcn_mov_dpp(__builtin_bit_cast(int, x), CTRL, 0xf, 0xf, true)); }
struct EpiConvGlu {
    static constexpr bool PERM = true, AFTER_DRAIN = false, MIDK = false, PREFETCH = true, PERMA = true;
    bf16_t* O; int ldc; const float* ss; const float* cw; const float* cb; PG8_LAS float* ex; int mrows; float* halo; const float* cw4;
    __device__ __forceinline__ void prefetch(const Unit& u, int wid, int lane) const {
        const int base = u.pm * BM; asm volatile("" : "+v"(lane));
        if (wid == 0) __builtin_amdgcn_global_load_lds((const unsigned*)(ss + base + lane * 4), (PG8_LAS unsigned*)(ex + 1024), 16, 0, 0);
        else if (wid < 4) __builtin_amdgcn_global_load_lds((const unsigned*)(cw4 + u.pn * 768 + (wid - 1) * 256 + lane * 4), (PG8_LAS unsigned*)(ex + 1024 + 4096 + (wid - 1) * 256), 16, 0, 0);
    }
    __device__ __forceinline__ void operator()(i32x4 (&iacc)[2][2][4][2], const Unit& u, int wr, int wc, int fr, int fq) const {
        f32x4 acc[2][2][4][2];
        const int kt = u.pm & 15, base = u.pm * BM;
        const int ch0 = u.pn * 128 + wc * 32 + 8 * fq;
        const bool top_open = kt != 0, bot_open = kt != 15;
        f32x4 w0[2], w1[2], w2[2], cbv[2], isv[2];
#pragma unroll
        for (int n = 0; n < 2; ++n) { const PG8_LAS float* wl = ex + 1024 + 4096 + wc * 32 + 8 * fq + 4 * n; const f32x4 sg = *(const PG8_LAS f32x4*)(wl + 512) * -1.4426950408889634f;
            w0[n] = *(const PG8_LAS f32x4*)wl * sg; w1[n] = *(const PG8_LAS f32x4*)(wl + 128) * sg; w2[n] = *(const PG8_LAS f32x4*)(wl + 256) * sg; cbv[n] = *(const PG8_LAS f32x4*)(wl + 384) * -1.4426950408889634f;
            const f32x4 svn = *(const PG8_LAS f32x4*)(wl + 640);
#pragma unroll
            for (int i = 0; i < 4; ++i) isv[n][i] = __builtin_amdgcn_rcpf(fminf(svn[i] * -0.6931471805599453f, -1e-30f)); }
#pragma unroll
        for (int ai = 0; ai < 2; ++ai) { const f32x4 rs4 = *(const PG8_LAS f32x4*)(ex + 1024 + ai * HALF + wr * 64 + fr * 4);
#pragma unroll
            for (int m = 0; m < 4; ++m) { const float rs = rs4[m];
#pragma unroll
                for (int n = 0; n < 2; ++n) { const i32x4 ig = iacc[ai][0][m][n], iv = iacc[ai][1][m][n];
                    acc[ai][0][m][n] = (f32x4){(float)ig[0], (float)ig[1], (float)ig[2], (float)ig[3]} * rs; acc[ai][1][m][n] = (f32x4){(float)iv[0], (float)iv[1], (float)iv[2], (float)iv[3]} * rs; } } }
        const int exi = (wc * 4 + fq) * 8;
        if (fr == 0) {
#pragma unroll
            for (int ai = 0; ai < 2; ++ai) { PG8_LAS f32x4* p = (PG8_LAS f32x4*)(ex + ((ai * 2 + wr) * 2 + 0) * 128 + exi); p[0] = acc[ai][0][0][0]; p[1] = acc[ai][0][0][1]; } }
        if (fr == 15) {
#pragma unroll
            for (int ai = 0; ai < 2; ++ai) { PG8_LAS f32x4* p = (PG8_LAS f32x4*)(ex + ((ai * 2 + wr) * 2 + 1) * 128 + exi); p[0] = acc[ai][0][3][0]; p[1] = acc[ai][0][3][1]; } }
        asm volatile("s_waitcnt lgkmcnt(0)\n\ts_barrier" ::: "memory");
#pragma unroll
        for (int ai = 0; ai < 2; ++ai) {
            f32x4 et[2] = {(f32x4){0.f, 0.f, 0.f, 0.f}, (f32x4){0.f, 0.f, 0.f, 0.f}}, eb[2] = {(f32x4){0.f, 0.f, 0.f, 0.f}, (f32x4){0.f, 0.f, 0.f, 0.f}};
            { const bool hz = (wr == 0 && ai == 0); const int sai = wr == 1 ? ai : 0, swr = wr == 1 ? 0 : 1; const PG8_LAS f32x4* p = (const PG8_LAS f32x4*)(ex + ((sai * 2 + swr) * 2 + 1) * 128 + exi);
              if (!hz) { et[0] = p[0]; et[1] = p[1]; } }
            { const bool hz = (wr == 1 && ai == 1); const int sai = wr == 0 ? ai : 1, swr = wr == 0 ? 1 : 0; const PG8_LAS f32x4* p = (const PG8_LAS f32x4*)(ex + ((sai * 2 + swr) * 2 + 0) * 128 + exi);
              if (!hz) { eb[0] = p[0]; eb[1] = p[1]; } }
            float a[4][8], zz[8];
#pragma unroll
            for (int n = 0; n < 2; ++n)
#pragma unroll
                for (int i = 0; i < 4; ++i) { const float g0 = acc[ai][0][0][n][i], g1 = acc[ai][0][1][n][i], g2 = acc[ai][0][2][n][i], g3 = acc[ai][0][3][n][i];
                    const float up = dppk<0x111>(et[n][i], g3), dn = dppk<0x101>(eb[n][i], g0);
                    const float c0 = w0[n][i], c1 = w1[n][i], c2 = w2[n][i], cb0 = cbv[n][i];
                    float z[4];
                    z[0] = __builtin_fmaf(c2, g1, __builtin_fmaf(c1, g0, __builtin_fmaf(c0, up, cb0)));
                    z[1] = __builtin_fmaf(c2, g2, __builtin_fmaf(c1, g1, __builtin_fmaf(c0, g0, cb0)));
                    z[2] = __builtin_fmaf(c2, g3, __builtin_fmaf(c1, g2, __builtin_fmaf(c0, g1, cb0)));
                    z[3] = __builtin_fmaf(c2, dn, __builtin_fmaf(c1, g3, __builtin_fmaf(c0, g2, cb0)));
                    zz[4 * n + i] = (ai == 0 ? z[0] : z[3]) * -0.6931471805599453f;
#pragma unroll
                    for (int m = 0; m < 4; ++m) { const float iv0 = isv[n][i]; a[m][4 * n + i] = z[m] * __builtin_amdgcn_rcpf(__builtin_fmaf(__builtin_amdgcn_exp2f(z[m]), iv0, iv0)) * acc[ai][1][m][n][i]; } }
#pragma unroll
            for (int m = 0; m < 4; ++m) { const int r = ai * HALF + wr * 64 + fr * 4 + m; u32x4 w;
                w.x = cvt_pk_bf16(a[m][0], a[m][1]); w.y = cvt_pk_bf16(a[m][2], a[m][3]); w.z = cvt_pk_bf16(a[m][4], a[m][5]); w.w = cvt_pk_bf16(a[m][6], a[m][7]);
                bool open = false;
                if (ai == 0 && m == 0) open = (r == 0) && top_open;
                if (ai == 1 && m == 3) open = (r == 255) && bot_open;
                if (!open) *(u32x4*)(O + (size_t)(base + r) * ldc + ch0) = w;
                if ((ai == 0 && m == 0) || (ai == 1 && m == 3)) { if (open) { float* hp = halo + ((size_t)(u.pm * 2 + (ai == 0 ? 0 : 1)) * 3) * ldc + ch0;
                        const PG8_LAS float* sl = ex + 1024 + 4096 + 512 + wc * 32 + 8 * fq;
                        *(f32x4*)hp = acc[ai][0][m][0] * *(const PG8_LAS f32x4*)sl; *(f32x4*)(hp + 4) = acc[ai][0][m][1] * *(const PG8_LAS f32x4*)(sl + 4);
                        *(f32x4*)(hp + ldc) = (f32x4){zz[0], zz[1], zz[2], zz[3]}; *(f32x4*)(hp + ldc + 4) = (f32x4){zz[4], zz[5], zz[6], zz[7]};
                        *(f32x4*)(hp + 2 * ldc) = acc[ai][1][m][0] * *(const PG8_LAS f32x4*)(sl + 128); *(f32x4*)(hp + 2 * ldc + 4) = acc[ai][1][m][1] * *(const PG8_LAS f32x4*)(sl + 132); } }
                asm volatile("" ::: "memory"); } }
        asm volatile("s_waitcnt lgkmcnt(0)\n\ts_barrier" ::: "memory");
    }
};


struct EpiX1N {
    static constexpr bool PERM = true, AFTER_DRAIN = false, MIDK = true, PREFETCH = true; static constexpr int MIDK_T = 12;
    const bf16_t* base; bf16_t* O; int ldc; float* ss; const float* sa; PG8_LAS float* st;
    __device__ __forceinline__ void prefetch(const Unit& u, int wid, int lane) const {
        asm volatile("" : "+v"(lane));
#pragma unroll
        for (int i = 0; i < 2; ++i) { const int piece = wid * 2 + i;
            __builtin_amdgcn_global_load_lds((const unsigned*)(sa + (size_t)u.pm * BM * 16 + piece * 256 + lane * 4), (PG8_LAS unsigned*)(st + piece * 256), 16, 0, 0); }
    }
    __device__ __forceinline__ void row_stats(int rl, int fq, float& ra, float& rf) const {
        const f32x4 s4 = *(const PG8_LAS f32x4*)(st + rl * 16 + 4 * fq); float a = fq < 3 ? (s4[0] + s4[1]) + (s4[2] + s4[3]) : 0.f, f = fq == 3 ? s4[0] : 0.f;
        a += __shfl_xor(a, 16); a += __shfl_xor(a, 32); f += __shfl_xor(f, 16); f += __shfl_xor(f, 32);
        ra = __builtin_amdgcn_rsqf(a * (1.0f / 768.0f) + 1e-6f); rf = __builtin_amdgcn_rsqf(f * (1.0f / 256.0f) + 1e-6f);
    }
    __device__ __forceinline__ void midk(f32x4 (&acc)[2][2][4][2], const Unit& u, int wr, int fr, int fq) const {
#pragma unroll
        for (int ai = 0; ai < 2; ++ai)
#pragma unroll
            for (int m = 0; m < 4; ++m) { float ra, rf; row_stats(ai * HALF + wr * 64 + m * 16 + fr, fq, ra, rf); const float ratio = ra * __builtin_amdgcn_rcpf(rf);
#pragma unroll
                for (int bj = 0; bj < 2; ++bj) { acc[ai][bj][m][0] = acc[ai][bj][m][0] * ratio; acc[ai][bj][m][1] = acc[ai][bj][m][1] * ratio; } }
    }
    __device__ __forceinline__ void operator()(const f32x4 (&acc)[2][2][4][2], const Unit& u, int wr, int wc, int fr, int fq) const {
        const int row0 = u.pm * BM + wr * 64 + fr; const int col0 = u.pn * BM + wc * 32 + 8 * fq;
#pragma unroll
        for (int ai = 0; ai < 2; ++ai)
#pragma unroll
            for (int m = 0; m < 4; ++m) { const int row = row0 + ai * HALF + m * 16; const size_t off = (size_t)row * ldc + col0; float ra, rf; row_stats(row - u.pm * BM, fq, ra, rf);
#pragma unroll
                for (int bj = 0; bj < 2; ++bj) { const u32x4 xb = *(const u32x4*)(base + off + bj * HALF); f32x4 v0, v1;
                    v0[0] = __builtin_bit_cast(float, xb.x << 16); v0[1] = __builtin_bit_cast(float, xb.x & 0xffff0000u); v0[2] = __builtin_bit_cast(float, xb.y << 16); v0[3] = __builtin_bit_cast(float, xb.y & 0xffff0000u);
                    v1[0] = __builtin_bit_cast(float, xb.z << 16); v1[1] = __builtin_bit_cast(float, xb.z & 0xffff0000u); v1[2] = __builtin_bit_cast(float, xb.w << 16); v1[3] = __builtin_bit_cast(float, xb.w & 0xffff0000u);
                    v0 = v0 + acc[ai][bj][m][0] * rf; v1 = v1 + acc[ai][bj][m][1] * rf;
                    u32x4 w; w.x = cvt_pk_bf16(v0[0], v0[1]); w.y = cvt_pk_bf16(v0[2], v0[3]); w.z = cvt_pk_bf16(v1[0], v1[1]); w.w = cvt_pk_bf16(v1[2], v1[3]);
                    *(u32x4*)(O + off + bj * HALF) = w; }
                }
        asm volatile("s_waitcnt lgkmcnt(0)\n\ts_barrier" ::: "memory");
    }
};


struct EpiFinal {
    static constexpr bool PERM = true, AFTER_DRAIN = false, MIDK = false, PREFETCH = false;
    const bf16_t* X1; float* out; int ldc; const float* gain; float* xbuf; unsigned* cnt; PG8_LAS unsigned char* lx;
    __device__ __forceinline__ void operator()(f32x4 (&acc)[2][2][4][2], const Unit& u, int wr, int wc, int fr, int fq) const {
        PG8_LAS float* P = (PG8_LAS float*)lx; PG8_LAS float* S = (PG8_LAS float*)(lx + 4096);
        int tid = (wr * 4 + wc) * 64 + fq * 16 + fr; asm volatile("" : "+v"(tid)); const int col0 = u.pn * BM + wc * 32 + 8 * fq;
#pragma unroll
        for (int ai = 0; ai < 2; ++ai)
#pragma unroll
            for (int m = 0; m < 4; ++m) { const int rl = ai * HALF + wr * 64 + m * 16 + fr; const size_t off = (size_t)(u.pm * BM + rl) * ldc + col0; float q = 0.f;
#pragma unroll
                for (int bj = 0; bj < 2; ++bj) { const u32x4 xb = *(const u32x4*)(X1 + off + bj * HALF); f32x4 v0, v1;
                    v0[0] = __builtin_bit_cast(float, xb.x << 16); v0[1] = __builtin_bit_cast(float, xb.x & 0xffff0000u); v0[2] = __builtin_bit_cast(float, xb.y << 16); v0[3] = __builtin_bit_cast(float, xb.y & 0xffff0000u);
                    v1[0] = __builtin_bit_cast(float, xb.z << 16); v1[1] = __builtin_bit_cast(float, xb.z & 0xffff0000u); v1[2] = __builtin_bit_cast(float, xb.w << 16); v1[3] = __builtin_bit_cast(float, xb.w & 0xffff0000u);
                    v0 = v0 + acc[ai][bj][m][0]; v1 = v1 + acc[ai][bj][m][1]; acc[ai][bj][m][0] = v0; acc[ai][bj][m][1] = v1;
                    q += ((v0[0] * v0[0] + v0[1] * v0[1]) + (v0[2] * v0[2] + v0[3] * v0[3])) + ((v1[0] * v1[0] + v1[1] * v1[1]) + (v1[2] * v1[2] + v1[3] * v1[3])); }
                q += __shfl_xor(q, 16); q += __shfl_xor(q, 32);
                if (fq == 0) P[rl * 4 + wc] = q; }
        asm volatile("s_waitcnt lgkmcnt(0)\n\ts_barrier" ::: "memory");
        if (tid < 256) { const float s = (P[tid * 4] + P[tid * 4 + 1]) + (P[tid * 4 + 2] + P[tid * 4 + 3]);
            __hip_atomic_store(xbuf + ((size_t)(u.pm * BM + tid) * 4 + u.pn), s, __ATOMIC_RELAXED, __HIP_MEMORY_SCOPE_AGENT);
            asm volatile("s_waitcnt vmcnt(0)" ::: "memory");
            if ((tid & 63) == 0) __hip_atomic_fetch_add(cnt + 64 * u.pm, 1u, __ATOMIC_RELAXED, __HIP_MEMORY_SCOPE_AGENT); }
        if (tid < 64) { unsigned spins = 0;
            while ((unsigned)__builtin_amdgcn_readfirstlane(__hip_atomic_load(cnt + 64 * u.pm, __ATOMIC_RELAXED, __HIP_MEMORY_SCOPE_AGENT)) < 16u) { __builtin_amdgcn_s_sleep(2); if (++spins > 400000u) break; }
            __builtin_amdgcn_fence(__ATOMIC_ACQUIRE, "agent"); }
        asm volatile("s_waitcnt vmcnt(0) lgkmcnt(0)\n\ts_barrier" ::: "memory");
        if (tid < 256) { const float* xp = xbuf + (size_t)(u.pm * BM + tid) * 4; float t = 0.f;
#pragma unroll
            for (int k = 0; k < 4; ++k) t += __hip_atomic_load(xp + k, __ATOMIC_RELAXED, __HIP_MEMORY_SCOPE_AGENT);
            S[tid] = 1.0f / sqrtf(t * (1.0f / 1024.0f) + 1e-6f); }
        asm volatile("s_waitcnt vmcnt(0) lgkmcnt(0)\n\ts_barrier" ::: "memory");
        f32x4 gv[2][2];
#pragma unroll
        for (int bj = 0; bj < 2; ++bj)
#pragma unroll
            for (int n = 0; n < 2; ++n) gv[bj][n] = *(const f32x4*)(gain + col0 + bj * HALF + n * 4);
#pragma unroll
        for (int ai = 0; ai < 2; ++ai)
#pragma unroll
            for (int m = 0; m < 4; ++m) { const int rl = ai * HALF + wr * 64 + m * 16 + fr; const float rs = S[rl]; const size_t off = (size_t)(u.pm * BM + rl) * ldc + col0;
#pragma unroll
                for (int bj = 0; bj < 2; ++bj)
#pragma unroll
                    for (int n = 0; n < 2; ++n) *(f32x4*)(out + off + bj * HALF + n * 4) = acc[ai][bj][m][n] * rs * gv[bj][n]; }
    }
};

template <class E, class = void> struct HasPermA { static constexpr bool v = false; };
template <class E> struct HasPermA<E, decltype((void)E::PERMA)> { static constexpr bool v = E::PERMA; };
template <bool I8> __device__ __forceinline__ typename AccT<I8>::type mma16(bf16x8 a, bf16x8 b, typename AccT<I8>::type c) {
    if constexpr (I8) return __builtin_amdgcn_mfma_i32_16x16x64_i8(__builtin_bit_cast(i32x4, a), __builtin_bit_cast(i32x4, b), c, 0, 0, 0);
    else return __builtin_amdgcn_mfma_f32_16x16x32_bf16(a, b, c, 0, 0, 0);
}
template <class Epi, class Sched, bool ALIGN_EPI = false, bool SP2 = false, bool I8 = false>
__device__ __forceinline__ void gemm_phase(PG8_LAS unsigned char* lds, const Gemm g, const Sched& S, const Epi& E) {
    int tid = threadIdx.x; asm volatile("" : "+v"(tid));
    const int wid = __builtin_amdgcn_readfirstlane(tid >> 6), lane = tid & 63, wr = wid >> 2, wc = wid & 3, fr = lane & 15, fq = lane >> 4;
    const int K = g.K, nt = K / BK, lda = g.lda;
    unsigned voffA[2], voffB[2];
#pragma unroll
    for (int i = 0; i < 2; ++i) { int R, C; stage_rc(tid * 16 + i * 8192, R, C); const int Rb = Epi::PERM ? ((R & ~31) + perm32(R & 31)) : R;
        const int Ra = HasPermA<Epi>::v ? ((R & ~63) + (R & 15) * 4 + ((R >> 4) & 3)) : R;
        voffA[i] = (unsigned)(Ra * lda + C) * 2u; voffB[i] = (unsigned)(Rb * K + C) * 2u; }
    const size_t kstep = (size_t)(BK * 2);
    const size_t hstepA = (size_t)HALF * lda * 2, hstepB = (size_t)HALF * K * 2;
    const size_t tstepA = 2 * hstepA, tstepB = 2 * hstepB;
    const unsigned ldsw = (unsigned)wid * 1024u;
    const int aoff = lds_byte(wr * 64 + fr, fq * 8), boff = lds_byte(wc * 32 + fr, fq * 8);
#define PG8_SA(b, h) (((b) * 2 + (h)) * HTB)
#define PG8_SB(b, h) ((4 + (b) * 2 + (h)) * HTB)
#define PG8_STAGE(bufoff, gbase, voff) do { _Pragma("unroll") for (int _i = 0; _i < 2; ++_i) \
        __builtin_amdgcn_global_load_lds((const unsigned*)((const char*)(gbase) + (voff)[_i]), (PG8_LAS unsigned*)(lds + (bufoff) + ldsw + _i * 8192), 16, 0, 0); } while (0)
#define PG8_LDA(dst, b, h) do { _Pragma("unroll") for (int m = 0; m < 4; ++m) _Pragma("unroll") for (int k = 0; k < 2; ++k) dst[m][k] = *(const PG8_LAS bf16x8*)(lds + PG8_SA(b, h) + aoff + m * 2048 + k * 1024); } while (0)
#define PG8_LDB(dst, b, h) do { _Pragma("unroll") for (int n = 0; n < 2; ++n) _Pragma("unroll") for (int k = 0; k < 2; ++k) dst[n][k] = *(const PG8_LAS bf16x8*)(lds + PG8_SB(b, h) + boff + n * 2048 + k * 1024); } while (0)
#define PG8_MMA(ai, bj, At, Bt) do { __builtin_amdgcn_s_setprio(1); _Pragma("unroll") for (int m = 0; m < 4; ++m) _Pragma("unroll") for (int n = 0; n < 2; ++n) _Pragma("unroll") for (int k = 0; k < 2; ++k) \
        acc[ai][bj][m][n] = mma16<I8>(Bt[n][k], At[m][k], acc[ai][bj][m][n]); __builtin_amdgcn_s_setprio(0); } while (0)
#define PG8_WAIT_V(n) asm volatile("s_waitcnt vmcnt(" #n ")" ::: "memory")
#define PG8_WAIT_L(n) asm volatile("s_waitcnt lgkmcnt(" #n ")" ::: "memory")
#define PG8_BAR __builtin_amdgcn_s_barrier()
#define PG8_SCHED __builtin_amdgcn_sched_barrier(0)
    Unit cur, nxt; int ui = 0;
    if (!S.next(0, cur)) return;
    typedef typename AccT<I8>::type acc_t; acc_t acc[2][2][4][2];
#pragma unroll
    for (int a = 0; a < 2; ++a)
#pragma unroll
        for (int b = 0; b < 2; ++b)
#pragma unroll
            for (int m = 0; m < 4; ++m)
#pragma unroll
                for (int n = 0; n < 2; ++n) acc[a][b][m][n] = (acc_t){0, 0, 0, 0};
    bf16x8 At[4][2], B0[2][2], B1[2][2];
    const char* cA = (const char*)g.A + (g.ovl ? (size_t)ovl_row_base(cur.pm) * lda * 2 : (size_t)cur.pm * tstepA); const char* cB = (const char*)g.Bt + (size_t)cur.pn * tstepB;
    S.a_ready(cur);
    if constexpr (Epi::PREFETCH) E.prefetch(cur, wid, lane);
    if constexpr (SP2) {
        PG8_STAGE(PG8_SB(0, 0), cB, voffB); PG8_STAGE(PG8_SB(0, 1), cB + hstepB, voffB); PG8_STAGE(PG8_SA(0, 0), cA, voffA); PG8_STAGE(PG8_SA(0, 1), cA + hstepA, voffA);
        if (wr == 1) PG8_BAR;
        PG8_WAIT_V(2); PG8_BAR;
        PG8_STAGE(PG8_SB(1, 0), cB + kstep, voffB); PG8_STAGE(PG8_SA(1, 0), cA + kstep, voffA); PG8_STAGE(PG8_SB(1, 1), cB + hstepB + kstep, voffB);
        PG8_WAIT_V(6); PG8_BAR;
    } else {
        PG8_STAGE(PG8_SB(0, 0), cB, voffB); PG8_STAGE(PG8_SA(0, 0), cA, voffA); PG8_STAGE(PG8_SB(0, 1), cB + hstepB, voffB); PG8_STAGE(PG8_SA(0, 1), cA + hstepA, voffA);
        if (wr == 1) PG8_BAR;
        PG8_WAIT_V(4); PG8_BAR;
        PG8_STAGE(PG8_SB(1, 0), cB + kstep, voffB); PG8_STAGE(PG8_SA(1, 0), cA + kstep, voffA); PG8_STAGE(PG8_SB(1, 1), cB + hstepB + kstep, voffB);
        PG8_WAIT_V(6); PG8_BAR;
    }
    for (;;) {
        const bool has_next = S.next(ui + 1, nxt);
        const char* nA = has_next ? (const char*)g.A + (g.ovl ? (size_t)ovl_row_base(nxt.pm) * lda * 2 : (size_t)nxt.pm * tstepA) : cA; const char* nB = has_next ? (const char*)g.Bt + (size_t)nxt.pn * tstepB : cB;
        for (int t = 0; t < nt; t += 2) {
            const bool last = (t == nt - 2);
            const char* a1 = cA + (size_t)(t + 1) * kstep;
            const char* a2 = last ? nA : cA + (size_t)(t + 2) * kstep; const char* b2 = last ? nB : cB + (size_t)(t + 2) * kstep;
            const char* a3 = a2 + kstep; const char* b3 = b2 + kstep;
            if (last && has_next) S.a_ready(nxt);
            if constexpr (Epi::MIDK) { if (t == Epi::MIDK_T) E.midk(acc, cur, wr, fr, fq); }
            if constexpr (SP2) {
            PG8_LDB(B0, 0, 0); PG8_LDB(B1, 0, 1); PG8_SCHED; PG8_LDA(At, 0, 0); PG8_STAGE(PG8_SA(1, 1), a1 + hstepA, voffA);
            PG8_WAIT_V(8); PG8_WAIT_L(0); PG8_BAR; PG8_MMA(0, 0, At, B0); PG8_MMA(0, 1, At, B1); PG8_BAR; PG8_SCHED;
            PG8_LDA(At, 0, 1); PG8_STAGE(PG8_SB(0, 0), b2, voffB); PG8_STAGE(PG8_SB(0, 1), b2 + hstepB, voffB); PG8_STAGE(PG8_SA(0, 0), a2, voffA);
            PG8_WAIT_V(8); PG8_WAIT_L(0); PG8_BAR; PG8_MMA(1, 0, At, B0); PG8_MMA(1, 1, At, B1); PG8_BAR; PG8_SCHED;
            PG8_LDB(B0, 1, 0); PG8_LDB(B1, 1, 1); PG8_SCHED; PG8_LDA(At, 1, 0); PG8_STAGE(PG8_SA(0, 1), a2 + hstepA, voffA);
            PG8_WAIT_V(8); PG8_WAIT_L(0); PG8_BAR; PG8_MMA(0, 0, At, B0); PG8_MMA(0, 1, At, B1); PG8_BAR; PG8_SCHED;
            PG8_LDA(At, 1, 1); PG8_STAGE(PG8_SB(1, 0), b3, voffB); PG8_STAGE(PG8_SB(1, 1), b3 + hstepB, voffB); PG8_STAGE(PG8_SA(1, 0), a3, voffA);
            PG8_WAIT_V(8); PG8_WAIT_L(0); PG8_BAR; PG8_MMA(1, 0, At, B0); PG8_MMA(1, 1, At, B1); PG8_BAR; PG8_SCHED;
            } else {
            PG8_LDB(B0, 0, 0); PG8_SCHED; PG8_LDA(At, 0, 0); PG8_STAGE(PG8_SA(1, 1), a1 + hstepA, voffA);
            PG8_WAIT_L(8); PG8_BAR; PG8_WAIT_L(0); PG8_MMA(0, 0, At, B0); PG8_BAR; PG8_SCHED;
            PG8_LDB(B1, 0, 1); PG8_STAGE(PG8_SB(0, 0), b2, voffB);
            PG8_BAR; PG8_WAIT_L(0); PG8_MMA(0, 1, At, B1); PG8_BAR;
            PG8_LDA(At, 0, 1); PG8_STAGE(PG8_SA(0, 0), a2, voffA);
            PG8_BAR; PG8_WAIT_L(0); PG8_MMA(1, 0, At, B0); PG8_BAR; PG8_SCHED;
            PG8_STAGE(PG8_SB(0, 1), b2 + hstepB, voffB);
            PG8_WAIT_V(6); PG8_BAR; PG8_MMA(1, 1, At, B1); PG8_BAR;
            PG8_LDB(B0, 1, 0); PG8_SCHED; PG8_LDA(At, 1, 0); PG8_STAGE(PG8_SA(0, 1), a2 + hstepA, voffA);
            PG8_WAIT_L(8); PG8_BAR; PG8_WAIT_L(0); PG8_MMA(0, 0, At, B0); PG8_BAR; PG8_SCHED;
            PG8_LDB(B1, 1, 1); PG8_STAGE(PG8_SB(1, 0), b3, voffB);
            PG8_BAR; PG8_WAIT_L(0); PG8_MMA(0, 1, At, B1); PG8_BAR;
            PG8_LDA(At, 1, 1); PG8_STAGE(PG8_SA(1, 0), a3, voffA);
            PG8_BAR; PG8_WAIT_L(0); PG8_MMA(1, 0, At, B0); PG8_BAR; PG8_SCHED;
            PG8_STAGE(PG8_SB(1, 1), b3 + hstepB, voffB);
            PG8_WAIT_V(6); PG8_BAR; PG8_MMA(1, 1, At, B1); PG8_BAR;
            }
        }
        if constexpr (ALIGN_EPI) { if (wr == 0) PG8_BAR; }
        if constexpr (!Epi::AFTER_DRAIN) { E(acc, cur, wr, wc, fr, fq); S.done(cur); }
        if constexpr (Epi::PREFETCH) { if (has_next) E.prefetch(nxt, wid, lane); }
        if (!has_next) break;
#pragma unroll
        for (int a = 0; a < 2; ++a)
#pragma unroll
            for (int b = 0; b < 2; ++b)
#pragma unroll
                for (int m = 0; m < 4; ++m)
#pragma unroll
                    for (int n = 0; n < 2; ++n) acc[a][b][m][n] = (acc_t){0, 0, 0, 0};
        cur = nxt; cA = nA; cB = nB; ++ui;
        if constexpr (ALIGN_EPI) { if (wr == 1) PG8_BAR; }
    }
    PG8_WAIT_V(0);
    if constexpr (!ALIGN_EPI) { if (wr == 0) PG8_BAR; }
    PG8_BAR;
#undef PG8_SA
#undef PG8_SB
#undef PG8_STAGE
#undef PG8_LDA
#undef PG8_LDB
#undef PG8_MMA
#undef PG8_WAIT_V
#undef PG8_WAIT_L
#undef PG8_BAR
#undef PG8_SCHED
}
}

constexpr int NWAVES = 8;
#ifndef MK_ONE_LAUNCH
#define MK_ONE_LAUNCH 1
#endif
constexpr int N_PHASES = 11;

constexpr int BATCH = 8, SEQ = 4096, D = 1024, NH = 12, HD = 64, AW = 768, NG = 4, GD = 64, FW = 256, MIXW = 1024, NPROJ = 2560, FF = 2816;
constexpr int M = BATCH * SEQ;
constexpr float EPS = 1e-6f;

constexpr size_t MiB = 1u << 20;
constexpr size_t WS_CTL = 0, CTL_ZERO_BYTES = 96 * 1024;
constexpr size_t WS_TAB = 1 * MiB;
constexpr size_t TAB_BIAS = 0;
constexpr size_t TAB_MG = 32 * 1024;
constexpr size_t TAB_TW = 192 * 1024;
constexpr size_t TAB_CW4 = 256 * 1024;
constexpr size_t WS_WIN = 2 * MiB;
constexpr size_t WS_WOUT = 7 * MiB;
constexpr size_t WS_WGV = 9 * MiB;
constexpr size_t WS_WD = 20 * MiB;
constexpr size_t WS_XN = 26 * MiB;
constexpr size_t WS_PROJ = 90 * MiB;
constexpr size_t WS_A2 = 250 * MiB;
constexpr size_t WS_PQ = 314 * MiB;
constexpr size_t WS_ML = 380 * MiB;
constexpr size_t WS_A8 = 314 * MiB;
constexpr size_t WS_HALO = 400 * MiB;
constexpr size_t WS_RS0 = 441 * MiB;
constexpr size_t WS_XBUF = 440 * MiB;
constexpr size_t WS_SSA = 446 * MiB;
constexpr size_t WS_SS1 = 442 * MiB;
constexpr size_t WS_SS2 = 444 * MiB;
constexpr size_t WS_GV = 90 * MiB;
constexpr size_t WS_END = 448 * MiB;
constexpr int CW_BAR = 1024, CW_PANEL = 8192, CW_CMAX = 16384;

constexpr int RING_OFF = 0, RING_BYTES = 131072;
constexpr int LDSCTL_OFF = RING_BYTES, MISC_OFF = LDSCTL_OFF + 320;
constexpr int LDS_BYTES = 163840;

#define GAS __attribute__((address_space(1)))
#define LAS __attribute__((address_space(3)))
typedef unsigned short bf16;
typedef unsigned v4u __attribute__((ext_vector_type(4)));
typedef unsigned v2u __attribute__((ext_vector_type(2)));
typedef float f32x4 __attribute__((ext_vector_type(4)));
typedef GAS unsigned gu32;
#define RLX_AGENT __ATOMIC_RELAXED, __HIP_MEMORY_SCOPE_AGENT
#define LDS_WAIT() asm volatile("s_waitcnt lgkmcnt(0)" ::: "memory")
#define VM_WAIT() asm volatile("s_waitcnt vmcnt(0)" ::: "memory")
__device__ __forceinline__ unsigned f2bf(float f) { unsigned u = __builtin_bit_cast(unsigned, f); return (u + 0x7fffu + ((u >> 16) & 1u)) >> 16; }
__device__ __forceinline__ unsigned pk2(float lo, float hi) { typedef float f2_t __attribute__((ext_vector_type(2))); typedef __bf16 b2_t __attribute__((ext_vector_type(2))); f2_t v = {lo, hi}; b2_t b = __builtin_convertvector(v, b2_t); return __builtin_bit_cast(unsigned, b); }
__device__ __forceinline__ float bflo(unsigned w) { return __builtin_bit_cast(float, w << 16); }
__device__ __forceinline__ float bfhi(unsigned w) { return __builtin_bit_cast(float, w & 0xffff0000u); }
__device__ __forceinline__ float bf2f(bf16 h) { return __builtin_bit_cast(float, (unsigned)h << 16); }

#define XB_TMO      128
#define XB_XCNT(j)  (256  + 64 * (j))
#define XB_XSUB(j)  (1280 + 64 * (j))
#define XB_XGEN(j)  (2304 + 64 * (j))
#define XB_TOP      3328
#define XB_TOPGEN   3392
#define XCD_BAR_WORDS 3456
#define XB_SPIN_CAP (1u << 18)
__device__ __forceinline__ unsigned xb_ld(unsigned* p)              { return __hip_atomic_load(p, __ATOMIC_RELAXED, __HIP_MEMORY_SCOPE_AGENT); }
__device__ __forceinline__ unsigned xb_add(unsigned* p, unsigned v) { return __hip_atomic_fetch_add(p, v, __ATOMIC_RELAXED, __HIP_MEMORY_SCOPE_AGENT); }
__device__ __forceinline__ unsigned xb_xcc_id() { return (unsigned)__builtin_amdgcn_s_getreg((3 << 11) | 20) & 0xFu; }
#define XB_SPIN(cond, bar) do { unsigned _sp = 0; while (cond) { __builtin_amdgcn_s_sleep(1); \
    if ((++_sp & 255u) == 0u) { if (xb_ld(&(bar)[XB_TMO])) break; if (_sp > XB_SPIN_CAP) { atomicAdd(&(bar)[XB_TMO], 1u); break; } } } } while (0)
struct XcdBarrier { unsigned* bar; unsigned x; volatile LAS unsigned* st; };
__device__ __forceinline__ XcdBarrier xcd_barrier_post(unsigned* bar, volatile LAS unsigned* st) {
    XcdBarrier b; b.bar = bar; b.x = xb_xcc_id(); b.st = st;
    if (threadIdx.x == 0) (void)xb_add(&bar[XB_XCNT(b.x)], 1u);
    return b;
}
__device__ __forceinline__ void xcd_barrier_complete(unsigned* bar, unsigned x, unsigned& nloc, unsigned& nx) {
    const unsigned G = gridDim.x * gridDim.y * gridDim.z;
    unsigned sum, cnt, mine, sp = 0u;
    for (;;) {
        sum = 0u; cnt = 0u; mine = 0u;
#pragma unroll
        for (unsigned j = 0; j < 16; ++j) { const unsigned c = xb_ld(&bar[XB_XCNT(j)]); sum += c; cnt += (c > 0u) ? 1u : 0u; mine = (j == x) ? c : mine; }
        if (sum == G) break;
        __builtin_amdgcn_s_sleep(1);
        if ((++sp & 255u) == 0u) { if (xb_ld(&bar[XB_TMO])) break; if (sp > XB_SPIN_CAP) { atomicAdd(&bar[XB_TMO], 1u); break; } }
    }
    nloc = mine > 0u ? mine : 1u; nx = cnt > 0u ? cnt : 1u;
}
__device__ __forceinline__ void xcd_barrier(const XcdBarrier& b) {
    asm volatile("s_waitcnt vmcnt(0)" ::: "memory");
    __syncthreads();
    if (threadIdx.x == 0) {
        unsigned* bar = b.bar;
        __builtin_amdgcn_s_waitcnt(0);
        unsigned nloc = b.st[0], nx = b.st[1];
        if (nloc == 0u) { xcd_barrier_complete(bar, b.x, nloc, nx); b.st[0] = nloc; b.st[1] = nx; }
        const unsigned old = xb_add(&bar[XB_XSUB(b.x)], 1u);
        const unsigned gen = old / nloc;
        if (old + 1u == (gen + 1u) * nloc) {
            __builtin_amdgcn_fence(__ATOMIC_RELEASE, "agent");
            asm volatile("s_waitcnt vmcnt(0)" ::: "memory");
            const unsigned og = xb_add(&bar[XB_TOP], 1u);
            const unsigned tg = og / nx;
            if (og + 1u == (tg + 1u) * nx) xb_add(&bar[XB_TOPGEN], 1u);
            else XB_SPIN(xb_ld(&bar[XB_TOPGEN]) == tg, bar);
            __builtin_amdgcn_fence(__ATOMIC_ACQUIRE, "agent");
            xb_add(&bar[XB_XGEN(b.x)], 1u);
            asm volatile("s_waitcnt vmcnt(0)" ::: "memory");
        } else {
            XB_SPIN(xb_ld(&bar[XB_XGEN(b.x)]) == gen, bar);
            __builtin_amdgcn_fence(__ATOMIC_ACQUIRE, "agent");
            asm volatile("s_waitcnt vmcnt(0)" ::: "memory");
        }
    }
    __syncthreads();
}

struct Frame {
    LAS unsigned char* lds;
    volatile LAS unsigned* MISC;
    gu32* ctl;
    int tid, lane, wave;
    int vcu, G;
    const float *x, *g_mix, *w_in, *g_attn, *rel_tab, *f_w, *f_b, *g_four, *w_out, *g_ffn, *w_gate, *w_val, *conv_w, *conv_b, *w_down, *g_fin;
    float* out;
    unsigned char* ws;
};

__device__ __forceinline__ float wave_sum(float v) {
#pragma unroll
    for (int o = 1; o < 64; o <<= 1) v += __shfl_xor(v, o);
    return v;
}
__device__ __forceinline__ void p0_transpose_item(const float* W, int K, int N, bf16* WT, int row_off, LAS float* scr, int item, int lane, const float* gain = nullptr, bool il = false) {
    const int nblk = N / 32, kb = item / nblk, nb = item % nblk, k0 = 64 * kb, n0 = 32 * nb; if (il) row_off += 128 * (n0 >> 7);
    {   f32x4 v[8]; const int c4 = 4 * (lane & 7);
#pragma unroll
        for (int i = 0; i < 8; ++i) v[i] = __builtin_nontemporal_load((const GAS f32x4*)(W + (size_t)(k0 + (lane >> 3) + 8 * i) * N + n0 + c4));
#pragma unroll
        for (int i = 0; i < 8; ++i) { const int kk = (lane >> 3) + 8 * i; const float gsc = gain ? gain[k0 + kk] : 1.0f; LAS float* sp = scr + kk * 33 + c4;
            sp[0] = v[i].x * gsc; sp[1] = v[i].y * gsc; sp[2] = v[i].z * gsc; sp[3] = v[i].w * gsc; } }
    LDS_WAIT(); asm volatile("" ::: "memory");
    const int c = lane & 7;
#pragma unroll
    for (int j = 0; j < 4; ++j) { const int n = (lane >> 3) + 8 * j; const LAS float* s = scr + (8 * c) * 33 + n;
        v4u o; o.x = pk2(s[0 * 33], s[1 * 33]); o.y = pk2(s[2 * 33], s[3 * 33]); o.z = pk2(s[4 * 33], s[5 * 33]); o.w = pk2(s[6 * 33], s[7 * 33]);
        *(GAS v4u*)(WT + (size_t)(row_off + n0 + n) * K + k0 + 8 * c) = o; }
    LDS_WAIT(); asm volatile("" ::: "memory");
}

__device__ __forceinline__ void p0_colmax_item(const float* W, int K, int N, unsigned* cmax, int row_off, int item, int lane, const float* gain) {
    const int nblk = N / 32, kb = item / nblk, nb = item % nblk, k0 = 64 * kb, n0 = 32 * nb, c4 = 4 * (lane & 7); row_off += 128 * (n0 >> 7);
    f32x4 mx = (f32x4){0.f, 0.f, 0.f, 0.f};
#pragma unroll
    for (int i = 0; i < 8; ++i) { const int kk = (lane >> 3) + 8 * i; const f32x4 v = *(const GAS f32x4*)(W + (size_t)(k0 + kk) * N + n0 + c4) * gain[k0 + kk];
        mx[0] = fmaxf(mx[0], fabsf(v[0])); mx[1] = fmaxf(mx[1], fabsf(v[1])); mx[2] = fmaxf(mx[2], fabsf(v[2])); mx[3] = fmaxf(mx[3], fabsf(v[3])); }
#pragma unroll
    for (int j = 0; j < 4; ++j) { float t = mx[j]; t = fmaxf(t, __shfl_xor(t, 8)); t = fmaxf(t, __shfl_xor(t, 16)); t = fmaxf(t, __shfl_xor(t, 32)); mx[j] = t; }
    if (lane < 8) {
#pragma unroll
        for (int j = 0; j < 4; ++j) atomicMax(cmax + row_off + n0 + c4 + j, __float_as_uint(mx[j])); }
}
__device__ __forceinline__ void p6_quant_item(const float* W, int K, int N, unsigned char* WT, int row_off, LAS float* scr, int item, int lane, const float* gain, const unsigned* cmax) {
    const int nblk = N / 32, kb = item / nblk, nb = item % nblk, k0 = 64 * kb, n0 = 32 * nb; row_off += 128 * (n0 >> 7);
    {   f32x4 v[8]; const int c4 = 4 * (lane & 7);
#pragma unroll
        for (int i = 0; i < 8; ++i) v[i] = *(const GAS f32x4*)(W + (size_t)(k0 + (lane >> 3) + 8 * i) * N + n0 + c4);
#pragma unroll
        for (int i = 0; i < 8; ++i) { const int kk = (lane >> 3) + 8 * i; const float gsc = gain[k0 + kk]; LAS float* sp = scr + kk * 33 + c4;
            sp[0] = v[i].x * gsc; sp[1] = v[i].y * gsc; sp[2] = v[i].z * gsc; sp[3] = v[i].w * gsc; } }
    LDS_WAIT(); asm volatile("" ::: "memory");
    const int c = lane & 7;
#pragma unroll
    for (int j = 0; j < 4; ++j) { const int n = (lane >> 3) + 8 * j; const LAS float* s = scr + (8 * c) * 33 + n; const float cm = __uint_as_float(cmax[row_off + n0 + n]); const float inv = cm > 0.f ? 127.0f / cm : 0.f;
        unsigned lo = 0, hi = 0;
#pragma unroll
        for (int t = 0; t < 4; ++t) { lo |= ((unsigned)(int)__builtin_rintf(s[t * 33] * inv) & 255u) << (8 * t); hi |= ((unsigned)(int)__builtin_rintf(s[(4 + t) * 33] * inv) & 255u) << (8 * t); }
        v2u o; o.x = lo; o.y = hi; *(GAS v2u*)(WT + (size_t)(row_off + n0 + n) * K + k0 + 8 * c) = o; }
    LDS_WAIT(); asm volatile("" ::: "memory");
}
__device__ __forceinline__ void rms_row_to_bf16(const float* xrow, const float* gain, bf16* orow, int lane) {
    const GAS f32x4* xr = (const GAS f32x4*)xrow + lane; const GAS f32x4* gr = (const GAS f32x4*)gain + lane;
    f32x4 v[4]; float s = 0.f;
#pragma unroll
    for (int j = 0; j < 4; ++j) { v[j] = xr[64 * j]; s += (v[j].x * v[j].x + v[j].y * v[j].y) + (v[j].z * v[j].z + v[j].w * v[j].w); }
    const float rstd = 1.0f / sqrtf(wave_sum(s) * (1.f / D) + EPS);
    GAS unsigned long long* o8 = (GAS unsigned long long*)orow + lane;
#pragma unroll
    for (int j = 0; j < 4; ++j) { const f32x4 gg = gr[64 * j]; o8[64 * j] = (unsigned long long)pk2(v[j].x * rstd * gg.x, v[j].y * rstd * gg.y) | ((unsigned long long)pk2(v[j].z * rstd * gg.z, v[j].w * rstd * gg.w) << 32); }
}
__device__ __forceinline__ int t5_bucket(int rel) {
    const int ret = rel > 0 ? 16 : 0; const int n = rel < 0 ? -rel : rel;
    const float nf = (float)(n > 1 ? n : 1);
    int large = 8 + (int)(logf(nf / 8.0f) / logf(128.0f) * 8.0f);
    large = large < 15 ? large : 15;
    return ret + (n < 8 ? n : large);
}

__device__ __forceinline__ void p0_prologue(Frame& F) {
    LAS float* scr = (LAS float*)(F.lds + RING_OFF + F.wave * 16384);
    const int gw = F.vcu * NWAVES + F.wave, NGW = F.G * NWAVES;
    bf16* WinT = (bf16*)(F.ws + WS_WIN); bf16* WoutT = (bf16*)(F.ws + WS_WOUT); bf16* WgvT = (bf16*)(F.ws + WS_WGV); bf16* WdT = (bf16*)(F.ws + WS_WD);
    constexpr int I_IN = (D / 64) * (NPROJ / 32), I_OUT = (MIXW / 64) * (D / 32), I_G = (D / 64) * (FF / 32), I_D = (FF / 64) * (D / 32);
    constexpr int NITEMS = I_IN + I_OUT + 2 * I_G + I_D;
    for (int it = gw; it < NITEMS; it += NGW) {
        int r = it;
        if (r < I_IN) { p0_transpose_item(F.w_in, D, NPROJ, WinT, 0, scr, r, F.lane, F.g_mix); continue; } r -= I_IN;
        if (r < I_OUT) { const int k0 = 64 * (r / (D / 32)); p0_transpose_item(F.w_out, MIXW, D, WoutT, 0, scr, r, F.lane, k0 < AW ? F.g_attn : F.g_four - AW); continue; } r -= I_OUT;
        if (r < 2 * I_G) { const bool isv = r >= I_G; p0_colmax_item(isv ? F.w_val : F.w_gate, D, FF, (unsigned*)(F.ctl + CW_CMAX), isv ? 128 : 0, isv ? r - I_G : r, F.lane, F.g_ffn); continue; } r -= 2 * I_G;
        p0_transpose_item(F.w_down, FF, D, WdT, 0, scr, r, F.lane);
    }
    float* tabBias = (float*)(F.ws + WS_TAB + TAB_BIAS); float* tabMg = (float*)(F.ws + WS_TAB + TAB_MG); float* tabTw = (float*)(F.ws + WS_TAB + TAB_TW);
    const int gt = F.vcu * (NWAVES * 64) + F.tid, NGT = F.G * NWAVES * 64;
    for (int i = gt; i < 3 * 129 * 12; i += NGT) { const int h = i % 12, jj = (i / 12) % 129, br = i / (12 * 129); const int dil = br == 0 ? 1 : (br == 1 ? 4 : 16);
        tabBias[i] = F.rel_tab[t5_bucket((jj - 64) * dil) * 12 + h]; }
    for (int i = gt; i < 4 * 64 * 128; i += NGT) { const int col = i & 127, c = (i >> 7) & 63, g = i >> 13; const int e = col & 63; float acc = 0.f;
        for (int d = 0; d < 64; ++d) { const float rev = (float)((c * d) & 63) * (1.0f / 64.0f); const float t = col < 64 ? __builtin_amdgcn_cosf(rev) : -__builtin_amdgcn_sinf(rev); acc += t * F.f_w[(g * 64 + d) * 64 + e]; }
        tabMg[i] = acc; }
    for (int i = gt; i < 4096; i += NGT) { float sv, cv; sincospif((float)i * (1.0f / 2048.0f), &sv, &cv); tabTw[2 * i] = cv; tabTw[2 * i + 1] = sv; }
    bf16* XN = (bf16*)(F.ws + WS_XN);
    {   float* RS0 = (float*)(F.ws + WS_RS0);
        for (int m0 = gw; m0 < M; m0 += 4 * NGW) { f32x4 v[4][4];
#pragma unroll
            for (int r = 0; r < 4; ++r) { const int m = m0 + r * NGW; const GAS f32x4* xr = (const GAS f32x4*)(F.x + (size_t)(m < M ? m : 0) * D) + F.lane;
#pragma unroll
                for (int j = 0; j < 4; ++j) v[r][j] = __builtin_nontemporal_load(xr + 64 * j); }
#pragma unroll
            for (int r = 0; r < 4; ++r) { const int m = m0 + r * NGW; float s = 0.f;
#pragma unroll
                for (int j = 0; j < 4; ++j) s += (v[r][j].x * v[r][j].x + v[r][j].y * v[r][j].y) + (v[r][j].z * v[r][j].z + v[r][j].w * v[r][j].w);
                const float rstd = 1.0f / sqrtf(wave_sum(s) * (1.f / D) + EPS);
                if (m < M) { GAS unsigned long long* o8 = (GAS unsigned long long*)(XN + (size_t)m * D) + F.lane; if (F.lane == 0) RS0[m] = rstd;
#pragma unroll
                    for (int j = 0; j < 4; ++j) { const f32x4 t = v[r][j]; o8[64 * j] = (unsigned long long)pk2(t.x, t.y) | ((unsigned long long)pk2(t.z, t.w) << 32); } } } } }
}

namespace att {
typedef short bf16x8 __attribute__((ext_vector_type(8)));
typedef short v4i16 __attribute__((ext_vector_type(4)));
constexpr float LOG2E = 1.4426950408889634f;
constexpr int TABN = 512, TPAD0 = 128;
constexpr int LDS_K = 0, LDS_V = 49152, LDS_T0 = 98304, LDS_T1 = 98304 + 8192;
struct QT { bf16x8 q[2]; f32x4 o[4]; float m, l; };
__device__ __forceinline__ v4i16 vtr(const LAS unsigned char* p) { return __builtin_amdgcn_ds_read_tr16_b64_v4i16((LAS v4i16*)p); }

__device__ __forceinline__ void build_table(Frame& F, int ldsoff, int br, int h) {
    const float* tabBias = (const float*)(F.ws + WS_TAB + TAB_BIAS);
    LAS float* T = (LAS float*)(F.lds + ldsoff);
    for (int e = F.tid; e < 4 * TABN; e += NWAVES * 64) { const int s = e / TABN, n = e % TABN; const int r64 = n + s - TPAD0;
        T[e] = (r64 >= 0 && r64 <= 128) ? tabBias[(br * 129 + r64) * 12 + h] * LOG2E : -INFINITY; }
}
__device__ __forceinline__ const LAS float* table_ptr(Frame& F, int ldsoff, int idx0) { const int s = idx0 & 3; return (const LAS float*)(F.lds + ldsoff) + s * TABN + (idx0 - s); }

__device__ __forceinline__ int pass_tok(int mode, int a, int row) {
    if (mode == 0) { const int t = a - 64 + row; return (t >= 0 && t < SEQ) ? t : -1; }
    if (mode == 3) return a + 16 * row;
    const int hi = row >= 192 ? 1 : 0, u = a + (hi ? row - 192 : row), c = 2 * (mode - 1) + hi; return (u >= 0 && u < SEQ / 4) ? c + 4 * u : -1;
}
struct Pre { v4u k[6], v[6]; };
template <int NIT> __device__ __forceinline__ void prefetch(Frame& F, Pre& R, const bf16* P, int h, int mode, int a) {
#pragma unroll
    for (int it = 0; it < NIT; ++it) { const int idx = F.tid + it * (NWAVES * 64), row = idx >> 3, ph = idx & 7; const int t = pass_tok(mode, a, row);
        const int ck = ph ^ ((row >> 1) & 7), cv = ph ^ (((row >> 1) & 3) << 1);
        R.k[it] = (v4u){0u, 0u, 0u, 0u}; R.v[it] = (v4u){0u, 0u, 0u, 0u};
        if (t >= 0) { const bf16* rp = P + (size_t)t * NPROJ + h * 64; R.k[it] = *(const GAS v4u*)(rp + AW + ck * 8); R.v[it] = *(const GAS v4u*)(rp + 2 * AW + cv * 8); } }
}
template <int NIT> __device__ __forceinline__ void commit(Frame& F, const Pre& R) {
#pragma unroll
    for (int it = 0; it < NIT; ++it) { const int idx = F.tid + it * (NWAVES * 64);
        *(LAS v4u*)(F.lds + LDS_K + idx * 16) = R.k[it]; *(LAS v4u*)(F.lds + LDS_V + idx * 16) = R.v[it]; }
}
__device__ __forceinline__ float xmax4(float v) {
    auto a = __builtin_amdgcn_permlane16_swap(__float_as_uint(v), __float_as_uint(v), false, false); v = fmaxf(__uint_as_float(a[0]), __uint_as_float(a[1]));
    auto b = __builtin_amdgcn_permlane32_swap(__float_as_uint(v), __float_as_uint(v), false, false); return fmaxf(__uint_as_float(b[0]), __uint_as_float(b[1]));
}
__device__ __forceinline__ float xsum4(float v) {
    auto a = __builtin_amdgcn_permlane16_swap(__float_as_uint(v), __float_as_uint(v), false, false); v = __uint_as_float(a[0]) + __uint_as_float(a[1]);
    auto b = __builtin_amdgcn_permlane32_swap(__float_as_uint(v), __float_as_uint(v), false, false); return __uint_as_float(b[0]) + __uint_as_float(b[1]);
}
__device__ __forceinline__ void load_q(QT& T, const bf16* qrow  , int g) {
#pragma unroll
    for (int ks = 0; ks < 2; ++ks) { const v4u w = *(const GAS v4u*)(qrow + 8 * g + 32 * ks); const float sc = 0.125f * LOG2E; v4u o;
        o.x = pk2(bflo(w.x) * sc, bfhi(w.x) * sc); o.y = pk2(bflo(w.y) * sc, bfhi(w.y) * sc); o.z = pk2(bflo(w.z) * sc, bfhi(w.z) * sc); o.w = pk2(bflo(w.w) * sc, bfhi(w.w) * sc);
        T.q[ks] = __builtin_bit_cast(bf16x8, o); }
#pragma unroll
    for (int db = 0; db < 4; ++db) T.o[db] = (f32x4){0.f, 0.f, 0.f, 0.f};
    T.m = -1e30f; T.l = 0.f;
}
typedef float f32x2_t __attribute__((ext_vector_type(2))); typedef __bf16 bf16x2_t __attribute__((ext_vector_type(2)));
__device__ __forceinline__ unsigned cvtpk(float lo, float hi) { f32x2_t v = {lo, hi}; bf16x2_t b = __builtin_convertvector(v, bf16x2_t); return __builtin_bit_cast(unsigned, b); }
constexpr float THR = 8.0f;
template <int NQ, int NP> __device__ __forceinline__ void attn_step(QT (&T)[NQ], const LAS unsigned char* kp, const LAS unsigned char* vp, const LAS float* const (&tp)[NQ], int p, int koff0, int koff1, const int (&voff)[4], int klo, int khi, bool edge, int g) {
    bf16x8 kf[NP][4]; v4i16 vlo[NP][4], vhi[NP][4];
#pragma unroll
    for (int c = 0; c < NP; ++c) { kf[c][0] = *(const LAS bf16x8*)(kp + c * 4096 + koff0); kf[c][1] = *(const LAS bf16x8*)(kp + c * 4096 + koff1); kf[c][2] = *(const LAS bf16x8*)(kp + c * 4096 + 2048 + koff0); kf[c][3] = *(const LAS bf16x8*)(kp + c * 4096 + 2048 + koff1);
#pragma unroll
        for (int db = 0; db < 4; ++db) { vlo[c][db] = vtr(vp + c * 4096 + voff[db]); vhi[c][db] = vtr(vp + c * 4096 + 2048 + voff[db]); } }
#pragma unroll
    for (int n = 0; n < NQ; ++n) {
        f32x4 s[NP][2];
#pragma unroll
        for (int c = 0; c < NP; ++c) {
            s[c][0] = *(const LAS f32x4*)(tp[n] + (p + c) * 32); s[c][1] = *(const LAS f32x4*)(tp[n] + (p + c) * 32 + 16);
            s[c][0] = __builtin_amdgcn_mfma_f32_16x16x32_bf16(kf[c][0], T[n].q[0], s[c][0], 0, 0, 0); s[c][0] = __builtin_amdgcn_mfma_f32_16x16x32_bf16(kf[c][1], T[n].q[1], s[c][0], 0, 0, 0);
            s[c][1] = __builtin_amdgcn_mfma_f32_16x16x32_bf16(kf[c][2], T[n].q[0], s[c][1], 0, 0, 0); s[c][1] = __builtin_amdgcn_mfma_f32_16x16x32_bf16(kf[c][3], T[n].q[1], s[c][1], 0, 0, 0);
            if (edge) { const int kk = (p + c) * 32 + 4 * g;
#pragma unroll
                for (int r = 0; r < 4; ++r) { if (kk + r < klo || kk + r >= khi) s[c][0][r] = -INFINITY; if (kk + 16 + r < klo || kk + 16 + r >= khi) s[c][1][r] = -INFINITY; } } }
        float tm = fmaxf(fmaxf(fmaxf(s[0][0][0], s[0][0][1]), fmaxf(s[0][0][2], s[0][0][3])), fmaxf(fmaxf(s[0][1][0], s[0][1][1]), fmaxf(s[0][1][2], s[0][1][3])));
        if (NP == 2) tm = fmaxf(tm, fmaxf(fmaxf(fmaxf(s[NP - 1][0][0], s[NP - 1][0][1]), fmaxf(s[NP - 1][0][2], s[NP - 1][0][3])), fmaxf(fmaxf(s[NP - 1][1][0], s[NP - 1][1][1]), fmaxf(s[NP - 1][1][2], s[NP - 1][1][3]))));
        tm = xmax4(tm);
        if (__any(tm > T[n].m + THR)) { const float mn = fmaxf(T[n].m, tm), al = __builtin_amdgcn_exp2f(T[n].m - mn); T[n].m = mn; T[n].l *= al;
#pragma unroll
            for (int db = 0; db < 4; ++db) T[n].o[db] = T[n].o[db] * al; }
        const float mref = T[n].m; float ls = 0.f;
#pragma unroll
        for (int c = 0; c < NP; ++c) {
#pragma unroll
            for (int r = 0; r < 4; ++r) { s[c][0][r] = __builtin_amdgcn_exp2f(s[c][0][r] - mref); s[c][1][r] = __builtin_amdgcn_exp2f(s[c][1][r] - mref); }
            ls += ((s[c][0][0] + s[c][0][1]) + (s[c][0][2] + s[c][0][3])) + ((s[c][1][0] + s[c][1][1]) + (s[c][1][2] + s[c][1][3])); }
        T[n].l += ls;
#pragma unroll
        for (int c = 0; c < NP; ++c) {
            v4u pw; pw.x = cvtpk(s[c][0][0], s[c][0][1]); pw.y = cvtpk(s[c][0][2], s[c][0][3]); pw.z = cvtpk(s[c][1][0], s[c][1][1]); pw.w = cvtpk(s[c][1][2], s[c][1][3]);
            const bf16x8 pf = __builtin_bit_cast(bf16x8, pw);
#pragma unroll
            for (int db = 0; db < 4; ++db) { const bf16x8 vf = (bf16x8){vlo[c][db][0], vlo[c][db][1], vlo[c][db][2], vlo[c][db][3], vhi[c][db][0], vhi[c][db][1], vhi[c][db][2], vhi[c][db][3]};
                T[n].o[db] = __builtin_amdgcn_mfma_f32_16x16x32_bf16(vf, pf, T[n].o[db], 0, 0, 0); } }
    }
}
template <int NQ> __device__ __forceinline__ void attn_job(QT (&T)[NQ], const LAS unsigned char* Kw, const LAS unsigned char* Vw, int npairs, const LAS float* const (&tp)[NQ], int klo, int khi, bool edge, int lane) {
    const int i = lane & 15, g = lane >> 4;
    const int koff0 = i * 128 + (((g) ^ (i >> 1)) << 4), koff1 = i * 128 + (((g + 4) ^ (i >> 1)) << 4);
    const int qq = i >> 2, pp = i & 3, vr = 4 * g + qq, fv = (vr >> 1) & 3;
    int voff[4];
#pragma unroll
    for (int db = 0; db < 4; ++db) voff[db] = vr * 128 + ((((db ^ fv) << 1) + (pp >> 1)) << 4) + (pp & 1) * 8;
    int p = 0;
    if (NQ == 1) {
#pragma unroll 1
        for (; p + 2 <= npairs; p += 2) attn_step<NQ, 2>(T, Kw + p * 4096, Vw + p * 4096, tp, p, koff0, koff1, voff, klo, khi, edge, g);
    }
#pragma unroll 1
    for (; p < npairs; ++p) attn_step<NQ, 1>(T, Kw + p * 4096, Vw + p * 4096, tp, p, koff0, koff1, voff, klo, khi, edge, g);
}
__device__ __forceinline__ void four_ssq(Frame& F) {
    const bf16* A2 = (const bf16*)(F.ws + WS_A2); float* SSA = (float*)(F.ws + WS_SSA);
    const int gw = F.vcu * NWAVES + F.wave, NGW = F.G * NWAVES;
    for (int m0 = gw; m0 < M; m0 += 4 * NGW) { v2u w[4];
#pragma unroll
        for (int r = 0; r < 4; ++r) { const int m = (m0 + r * NGW) < M ? (m0 + r * NGW) : 0; w[r] = *(const GAS v2u*)(A2 + (size_t)m * MIXW + AW + 4 * F.lane); }
#pragma unroll
        for (int r = 0; r < 4; ++r) { const int m = m0 + r * NGW; const float a = bflo(w[r].x), b2 = bfhi(w[r].x), c = bflo(w[r].y), d = bfhi(w[r].y);
            const float s = wave_sum((a * a + b2 * b2) + (c * c + d * d));
            if (m < M && F.lane == 0) *(GAS f32x4*)(SSA + (size_t)m * 16 + 12) = (f32x4){s, 0.f, 0.f, 0.f}; } }
}
__device__ __forceinline__ void phase_local(Frame& F) {
    constexpr int NU = BATCH * NH * 16; const int per = (NU + F.G - 1) / F.G, ub = F.vcu * per, ue = (ub + per) < NU ? (ub + per) : NU;
    const bf16* PROJ = (const bf16*)(F.ws + WS_PROJ); const int lane = F.lane, w = F.wave, i = lane & 15, g = lane >> 4;
    const int idx4 = w >> 1, rA = w & 1, rB = 2 + (w & 1);
    Pre R; int hprev = -1;
    __syncthreads();
    if (ub < ue) { const int bh = ub >> 4; prefetch<6>(F, R, PROJ + (size_t)(bh / NH) * SEQ * NPROJ, bh % NH, 0, (ub & 15) * 256); }
    for (int u = ub; u < ue; ++u) {
        const int bh = u >> 4, b = bh / NH, h = bh % NH, s0 = (u & 15) * 256;
        const bf16* P = PROJ + (size_t)b * SEQ * NPROJ; bf16* A2 = (bf16*)(F.ws + WS_A2) + (size_t)b * SEQ * MIXW; float* ML = (float*)(F.ws + WS_ML) + (size_t)b * SEQ * NH * 2;
        __syncthreads();
        commit<6>(F, R);
        if (h != hprev) { build_table(F, LDS_T0, 0, h); build_table(F, LDS_T1, 1, h); hprev = h; }
        __syncthreads();
        const int u0 = s0 / 4 - 64;
        QT T[2];
        const int tokA = s0 + rA + 4 * (16 * idx4 + i), tokB = s0 + rB + 4 * (16 * idx4 + i);
        load_q(T[0], P + (size_t)tokA * NPROJ + h * 64, g); load_q(T[1], P + (size_t)tokB * NPROJ + h * 64, g);
        asm volatile("" ::: "memory");
        prefetch<6>(F, R, P, h, 1, u0);
        {
            const LAS float* tp[2] = { table_ptr(F, LDS_T0, 4 * g - 4 * i - rA + TPAD0), table_ptr(F, LDS_T0, 4 * g - 4 * i - rB + TPAD0) };
            int klo = 64 - s0 - 64 * idx4; klo = klo > 0 ? klo : 0; int khi = SEQ + 64 - s0 - 64 * idx4; khi = khi < 192 ? khi : 192;
            attn_job<2>(T, F.lds + LDS_K + 64 * idx4 * 128, F.lds + LDS_V + 64 * idx4 * 128, 6, tp, klo, khi, (klo > 0 || khi < 192), lane);
        }
#pragma unroll
        for (int pass = 0; pass < 2; ++pass) {
            __syncthreads();
            commit<6>(F, R);
            __syncthreads();
            if (pass == 0) prefetch<6>(F, R, P, h, 2, u0);
            else if (u + 1 < ue) { const int bh2 = (u + 1) >> 4; prefetch<6>(F, R, PROJ + (size_t)(bh2 / NH) * SEQ * NPROJ, bh2 % NH, 0, ((u + 1) & 15) * 256); }
            const int cl = w & 1, lo = idx4 < 2 ? idx4 : 2;
            const LAS float* tp[1] = { table_ptr(F, LDS_T1, 4 * g - i + 16 * (lo - idx4) + TPAD0) };
            int klo = -(u0 + 16 * lo); klo = klo > 0 ? klo : 0; int khi = SEQ / 4 - (u0 + 16 * lo); khi = khi < 160 ? khi : 160;
            QT (&Tp)[1] = *(QT (*)[1])(&T[pass]);
            attn_job<1>(Tp, F.lds + LDS_K + (192 * cl + 16 * lo) * 128, F.lds + LDS_V + (192 * cl + 16 * lo) * 128, 5, tp, klo, khi, (klo > 0 || khi < 160), lane);
        }
#pragma unroll
        for (int n = 0; n < 2; ++n) {
            const float l = xsum4(T[n].l); const float inv = 1.0f / l; const int tok = n == 0 ? tokA : tokB;
#pragma unroll
            for (int db = 0; db < 4; ++db) { v2u o; o.x = pk2(T[n].o[db][0] * inv, T[n].o[db][1] * inv); o.y = pk2(T[n].o[db][2] * inv, T[n].o[db][3] * inv);
                *(GAS v2u*)(A2 + (size_t)tok * MIXW + h * 64 + 16 * db + 4 * g) = o; }
            if (g == 0) { float* mlp = ML + ((size_t)tok * NH + h) * 2; mlp[0] = T[n].m; mlp[1] = l; }
        }
    }
    __syncthreads();
}
__device__ __forceinline__ void phase_class(Frame& F) {
    four_ssq(F);
    constexpr int NU = BATCH * NH * 16; const int per = (NU + F.G - 1) / F.G, ub = F.vcu * per, ue = (ub + per) < NU ? (ub + per) : NU;
    const bf16* PROJ = (const bf16*)(F.ws + WS_PROJ); const int lane = F.lane, w = F.wave, i = lane & 15, g = lane >> 4; float* SSA = (float*)(F.ws + WS_SSA);
    Pre R; int hprev = -1;
    __syncthreads();
    if (ub < ue) { const int bh = ub >> 4; prefetch<4>(F, R, PROJ + (size_t)(bh / NH) * SEQ * NPROJ, bh % NH, 3, ub & 15); }
    for (int u = ub; u < ue; ++u) {
        const int bh = u >> 4, b = bh / NH, h = bh % NH, r = u & 15;
        const bf16* P = PROJ + (size_t)b * SEQ * NPROJ; bf16* A2 = (bf16*)(F.ws + WS_A2) + (size_t)b * SEQ * MIXW; const float* ML = (const float*)(F.ws + WS_ML) + (size_t)b * SEQ * NH * 2;
        __syncthreads();
        commit<4>(F, R);
        if (h != hprev) { build_table(F, LDS_T0, 2, h); hprev = h; }
        __syncthreads();
        QT T2[2]; float mlv[2], llv[2]; v2u pvv[2][4];
#pragma unroll
        for (int n = 0; n < 2; ++n) { const int qt = n == 0 ? (w < 7 ? w : 11) : (w < 4 ? w + 7 : (w < 7 ? w + 8 : 15)); const int tok = r + 16 * (16 * qt + i);
            load_q(T2[n], P + (size_t)tok * NPROJ + h * 64, g);
            const float* mlp = ML + ((size_t)tok * NH + h) * 2; mlv[n] = mlp[0]; llv[n] = mlp[1];
#pragma unroll
            for (int db = 0; db < 4; ++db) pvv[n][db] = *(const GAS v2u*)(A2 + (size_t)tok * MIXW + h * 64 + 16 * db + 4 * g); }
        asm volatile("" ::: "memory");
        if (u + 1 < ue) { const int bh2 = (u + 1) >> 4; prefetch<4>(F, R, PROJ + (size_t)(bh2 / NH) * SEQ * NPROJ, bh2 % NH, 3, (u + 1) & 15); }
#pragma unroll
        for (int n = 0; n < 2; ++n) {
            const int qt = n == 0 ? (w < 7 ? w : 11) : (w < 4 ? w + 7 : (w < 7 ? w + 8 : 15));
            int lo = qt - 4 > 0 ? qt - 4 : 0, hi = qt + 4 < 15 ? qt + 4 : 15; if (((hi - lo + 1) & 1) != 0) { if (hi < 15) ++hi; else --lo; }
            const int tok = r + 16 * (16 * qt + i);
            QT (&T)[1] = *(QT (*)[1])(&T2[n]);
            const LAS float* tp[1] = { table_ptr(F, LDS_T0, 4 * g - i + 16 * (lo - qt) + 64 + TPAD0) };
            attn_job<1>(T, F.lds + LDS_K + 16 * lo * 128, F.lds + LDS_V + 16 * lo * 128, (hi - lo + 1) >> 1, tp, 0, 1 << 20, false, lane);
            const float l16 = xsum4(T[0].l);
            const float ml = mlv[n], ll = llv[n];
            const float mm = fmaxf(ml, T[0].m), a = __builtin_amdgcn_exp2f(ml - mm) * ll, bb = __builtin_amdgcn_exp2f(T[0].m - mm), inv = 1.0f / (a + bb * l16); float sq = 0.f;
#pragma unroll
            for (int db = 0; db < 4; ++db) { GAS v2u* op = (GAS v2u*)(A2 + (size_t)tok * MIXW + h * 64 + 16 * db + 4 * g); const v2u pv = pvv[n][db]; v2u o;
                const float f0 = (bflo(pv.x) * a + T[0].o[db][0] * bb) * inv, f1 = (bfhi(pv.x) * a + T[0].o[db][1] * bb) * inv, f2 = (bflo(pv.y) * a + T[0].o[db][2] * bb) * inv, f3 = (bfhi(pv.y) * a + T[0].o[db][3] * bb) * inv;
                sq += (f0 * f0 + f1 * f1) + (f2 * f2 + f3 * f3); o.x = pk2(f0, f1); o.y = pk2(f2, f3);
                *op = o; }
            sq = xsum4(sq);
            if (g == 0) SSA[((size_t)b * SEQ + tok) * 16 + h] = sq;
        }
    }
    __syncthreads();
}
}


namespace fou {
typedef short bf16x8 __attribute__((ext_vector_type(8)));
typedef short v4i16 __attribute__((ext_vector_type(4)));
constexpr int LX = 0, LC = LDSCTL_OFF + 8192, LS = LDSCTL_OFF + 16384;
__device__ __forceinline__ int gsw(int s2) { const int pr = (s2 >> 1) & 7; return (pr & 4) | ((pr & 1) << 1) | ((pr >> 1) & 1); }
__device__ __forceinline__ int xaddr(int pe, int s2, int chunk) { return LX + pe * 8192 + s2 * 128 + (((chunk ^ gsw(s2) ^ pe) & 7) << 4); }
__device__ __forceinline__ int maddr(int base, int k, int chunk) { return base + k * 128 + (((chunk ^ (k >> 1)) & 7) << 4); }
__device__ __forceinline__ v4i16 vtr(const LAS unsigned char* p) { return __builtin_amdgcn_ds_read_tr16_b64_v4i16((LAS v4i16*)p); }
__device__ __forceinline__ bf16x8 neg8(bf16x8 v) { v4u w = __builtin_bit_cast(v4u, v); w.x ^= 0x80008000u; w.y ^= 0x80008000u; w.z ^= 0x80008000u; w.w ^= 0x80008000u; return __builtin_bit_cast(bf16x8, w); }

__device__ __forceinline__ void fourier_unit(Frame& F, int b, int g, int ec) {
    const bf16* PROJ = (const bf16*)(F.ws + WS_PROJ); bf16* A2 = (bf16*)(F.ws + WS_A2); const float* tabMg = (const float*)(F.ws + WS_TAB + TAB_MG);
    const int lane = F.lane, w = F.wave, li = lane & 15, gq = lane >> 4, e0 = 8 * ec;
    LAS unsigned char* L = F.lds;
    __syncthreads();
    bf16x8 mb[2];
#pragma unroll
    for (int ks = 0; ks < 2; ++ks) { float v[8];
#pragma unroll
        for (int j = 0; j < 8; ++j) { const int c = 8 * gq + j + 32 * ks; const int col = li < 8 ? e0 + li : 64 + e0 + (li & 7); v[j] = tabMg[(g * 64 + c) * 128 + col]; }
        v4u o; o.x = pk2(v[0], v[1]); o.y = pk2(v[2], v[3]); o.z = pk2(v[4], v[5]); o.w = pk2(v[6], v[7]); mb[ks] = __builtin_bit_cast(bf16x8, o); }
    const bf16* ub = PROJ + (size_t)(b * SEQ) * NPROJ + 3 * AW + g * 64 + 8 * gq;
#pragma unroll 8
    for (int it = 0; it < 32; ++it) { const int tile = w + 8 * it, s2 = tile & 63, tq = tile >> 6;
        const bf16* up = ub + (size_t)(64 * (16 * tq + li) + s2) * NPROJ;
        const bf16x8 a0 = __builtin_bit_cast(bf16x8, *(const GAS v4u*)up), a1 = __builtin_bit_cast(bf16x8, *(const GAS v4u*)(up + 32));
        f32x4 d = (f32x4){0.f, 0.f, 0.f, 0.f};
        d = __builtin_amdgcn_mfma_f32_16x16x32_bf16(a0, mb[0], d, 0, 0, 0); d = __builtin_amdgcn_mfma_f32_16x16x32_bf16(a1, mb[1], d, 0, 0, 0);
        v2u o; o.x = pk2(d[0], d[1]); o.y = pk2(d[2], d[3]); *(LAS v2u*)(L + xaddr(li, s2, 2 * tq + (gq >> 1)) + (gq & 1) * 8) = o; }
    __syncthreads();
    const int e = w;
#pragma unroll 1
    for (int mt = 0; mt < 4; ++mt) { const int s2 = 16 * mt + li;
        bf16x8 yr[2], yi[2], nyr[2];
#pragma unroll
        for (int kh = 0; kh < 2; ++kh) { yr[kh] = *(const LAS bf16x8*)(L + xaddr(e, s2, gq + 4 * kh)); yi[kh] = *(const LAS bf16x8*)(L + xaddr(8 + e, s2, gq + 4 * kh)); nyr[kh] = neg8(yr[kh]); }
#pragma unroll
        for (int nt = 0; nt < 4; ++nt) { const int k = 16 * nt + li;
            const bf16x8 c0 = *(const LAS bf16x8*)(L + maddr(LC, k, gq)), c1 = *(const LAS bf16x8*)(L + maddr(LC, k, gq + 4)), s0 = *(const LAS bf16x8*)(L + maddr(LS, k, gq)), s1 = *(const LAS bf16x8*)(L + maddr(LS, k, gq + 4));
            f32x4 tr = (f32x4){0.f, 0.f, 0.f, 0.f}, ti = (f32x4){0.f, 0.f, 0.f, 0.f};
            tr = __builtin_amdgcn_mfma_f32_16x16x32_bf16(c0, yr[0], tr, 0, 0, 0); tr = __builtin_amdgcn_mfma_f32_16x16x32_bf16(c1, yr[1], tr, 0, 0, 0);
            tr = __builtin_amdgcn_mfma_f32_16x16x32_bf16(s0, yi[0], tr, 0, 0, 0); tr = __builtin_amdgcn_mfma_f32_16x16x32_bf16(s1, yi[1], tr, 0, 0, 0);
            ti = __builtin_amdgcn_mfma_f32_16x16x32_bf16(c0, yi[0], ti, 0, 0, 0); ti = __builtin_amdgcn_mfma_f32_16x16x32_bf16(c1, yi[1], ti, 0, 0, 0);
            ti = __builtin_amdgcn_mfma_f32_16x16x32_bf16(s0, nyr[0], ti, 0, 0, 0); ti = __builtin_amdgcn_mfma_f32_16x16x32_bf16(s1, nyr[1], ti, 0, 0, 0);
            float orr[4], oii[4];
#pragma unroll
            for (int r = 0; r < 4; ++r) { const int k1 = 16 * nt + 4 * gq + r; const float rev = (float)((k1 * s2) & 4095) * (1.0f / 4096.0f); const float cv = __builtin_amdgcn_cosf(rev), sv = __builtin_amdgcn_sinf(rev);
                orr[r] = tr[r] * cv + ti[r] * sv; oii[r] = ti[r] * cv - tr[r] * sv; }
            v2u o; o.x = pk2(orr[0], orr[1]); o.y = pk2(orr[2], orr[3]); *(LAS v2u*)(L + xaddr(e, s2, 2 * nt + (gq >> 1)) + (gq & 1) * 8) = o;
            o.x = pk2(oii[0], oii[1]); o.y = pk2(oii[2], oii[3]); *(LAS v2u*)(L + xaddr(8 + e, s2, 2 * nt + (gq >> 1)) + (gq & 1) * 8) = o; } }
    asm volatile("s_waitcnt lgkmcnt(0)" ::: "memory");
    bf16x8 af[4][4];
    { const int q = li >> 2, p = li & 3;
#pragma unroll
      for (int mt = 0; mt < 4; ++mt)
#pragma unroll
        for (int ks = 0; ks < 4; ++ks) { const int pe = (ks >> 1) * 8 + e, s2b = 8 * gq + 32 * (ks & 1) + q;
            const v4i16 lo = vtr(L + xaddr(pe, s2b, 2 * mt + (p >> 1)) + (p & 1) * 8), hi = vtr(L + xaddr(pe, s2b + 4, 2 * mt + (p >> 1)) + (p & 1) * 8);
            af[mt][ks] = (bf16x8){lo[0], lo[1], lo[2], lo[3], hi[0], hi[1], hi[2], hi[3]}; } }
    asm volatile("s_waitcnt lgkmcnt(0)" ::: "memory");
    __syncthreads();
    const float bias = F.f_b[g * 64 + e0 + e];
#pragma unroll 1
    for (int nt = 0; nt < 4; ++nt) { const int k2 = 16 * nt + li;
        const bf16x8 c0 = *(const LAS bf16x8*)(L + maddr(LC, k2, gq)), c1 = *(const LAS bf16x8*)(L + maddr(LC, k2, gq + 4)), s0 = *(const LAS bf16x8*)(L + maddr(LS, k2, gq)), s1 = *(const LAS bf16x8*)(L + maddr(LS, k2, gq + 4));
#pragma unroll
        for (int mt = 0; mt < 4; ++mt) { f32x4 d = (f32x4){0.f, 0.f, 0.f, 0.f};
            d = __builtin_amdgcn_mfma_f32_16x16x32_bf16(af[mt][0], c0, d, 0, 0, 0); d = __builtin_amdgcn_mfma_f32_16x16x32_bf16(af[mt][1], c1, d, 0, 0, 0);
            d = __builtin_amdgcn_mfma_f32_16x16x32_bf16(af[mt][2], s0, d, 0, 0, 0); d = __builtin_amdgcn_mfma_f32_16x16x32_bf16(af[mt][3], s1, d, 0, 0, 0);
#pragma unroll
            for (int r = 0; r < 4; ++r) { const int k1 = 16 * mt + 4 * gq + r; *(LAS bf16*)(L + LX + (k1 * 64 + k2) * 16 + e * 2) = (bf16)f2bf(d[r] * (1.0f / 512.0f) + bias); } } }
    __syncthreads();
    bf16* ob = A2 + (size_t)(b * SEQ) * MIXW + AW + g * 64 + e0;
#pragma unroll
    for (int j = 0; j < 8; ++j) { const int sl = F.tid + 512 * j, k1 = sl >> 6, k2 = sl & 63; const v4u v = *(const LAS v4u*)(L + LX + sl * 16); *(GAS v4u*)(ob + (size_t)(k1 + 64 * k2) * MIXW) = v; }
}
__device__ __forceinline__ void phase_fourier(Frame& F) {
    const float* tabTw = (const float*)(F.ws + WS_TAB + TAB_TW);
    __syncthreads();
    for (int idx = F.tid; idx < 4096; idx += NWAVES * 64) { const int k = idx >> 6, s = idx & 63, n = ((k * s) & 63) * 64;
        *(LAS bf16*)(F.lds + maddr(LC, k, s >> 3) + (s & 7) * 2) = (bf16)f2bf(tabTw[2 * n]); *(LAS bf16*)(F.lds + maddr(LS, k, s >> 3) + (s & 7) * 2) = (bf16)f2bf(tabTw[2 * n + 1]); }
    __syncthreads();
    for (int u = F.vcu; u < BATCH * NG * 8; u += F.G) fourier_unit(F, u >> 5, (u >> 3) & 3, u & 7);
    __syncthreads();
}
}

__device__ __forceinline__ void p10_final(Frame& F) {
    const bf16* X2 = (const bf16*)(F.ws + WS_XN); const float* SS2 = (const float*)(F.ws + WS_SS2);
    const int gw = F.vcu * NWAVES + F.wave, NGW = F.G * NWAVES; const int lane = F.lane;
    const GAS f32x4* gr = (const GAS f32x4*)(F.g_fin + 16 * lane); const f32x4 g0 = gr[0], g1 = gr[1], g2 = gr[2], g3 = gr[3];
    for (int m0 = gw; m0 < M; m0 += 4 * NGW) { v4u w0[4], w1[4]; float part[4];
#pragma unroll
        for (int r = 0; r < 4; ++r) { const int m = (m0 + r * NGW) < M ? (m0 + r * NGW) : 0; const GAS v4u* rp = (const GAS v4u*)(X2 + (size_t)m * D + 16 * lane); w0[r] = rp[0]; w1[r] = rp[1];
            part[r] = lane < 16 ? SS2[(size_t)m * 16 + lane] : 0.f; }
#pragma unroll
        for (int r = 0; r < 4; ++r) { const int m = m0 + r * NGW; const float rstd = 1.0f / sqrtf(wave_sum(part[r]) * (1.f / D) + EPS);
            if (m < M) { GAS f32x4* op = (GAS f32x4*)(F.out + (size_t)m * D + 16 * lane);
                op[0] = (f32x4){bflo(w0[r].x), bfhi(w0[r].x), bflo(w0[r].y), bfhi(w0[r].y)} * rstd * g0; op[1] = (f32x4){bflo(w0[r].z), bfhi(w0[r].z), bflo(w0[r].w), bfhi(w0[r].w)} * rstd * g1;
                op[2] = (f32x4){bflo(w1[r].x), bfhi(w1[r].x), bflo(w1[r].y), bfhi(w1[r].y)} * rstd * g2; op[3] = (f32x4){bflo(w1[r].z), bfhi(w1[r].z), bflo(w1[r].w), bfhi(w1[r].w)} * rstd * g3; } } }
}


__device__ __forceinline__ void p8_halo_fix(Frame& F, int pm) {
    const float* H = (const float*)(F.ws + WS_HALO); bf16* ACT = (bf16*)(F.ws + WS_GV); const int kt = pm & 15;
    for (int it = F.tid; it < 2 * (FF / 4); it += NWAVES * 64) { const int c4 = (it % (FF / 4)) * 4, side = it / (FF / 4);
        if ((side == 0 && kt == 0) || (side == 1 && kt == 15)) continue;
        const float* own = H + (size_t)(pm * 2 + side) * 3 * FF + c4; const float* nb = H + (size_t)((side == 0 ? (pm - 1) * 2 + 1 : (pm + 1) * 2)) * 3 * FF + c4;
        const f32x4 gn = *(const GAS f32x4*)nb, zp = *(const GAS f32x4*)(own + FF), vv = *(const GAS f32x4*)(own + 2 * FF), wt = *(const GAS f32x4*)(F.conv_w + (side == 0 ? 0 : 2 * FF) + c4);
        float a[4];
#pragma unroll
        for (int i = 0; i < 4; ++i) { const float z = zp[i] + wt[i] * gn[i]; a[i] = z * __builtin_amdgcn_rcpf(1.0f + __builtin_amdgcn_exp2f(-1.4426950408889634f * z)) * vv[i]; }
        const unsigned long long o = (unsigned long long)pk2(a[0], a[1]) | ((unsigned long long)pk2(a[2], a[3]) << 32);
        __hip_atomic_store((unsigned long long*)(ACT + (size_t)(pm * 256 + (side ? 255 : 0)) * FF + c4), o, __ATOMIC_RELAXED, __HIP_MEMORY_SCOPE_AGENT); }
}


__device__ __forceinline__ void p6_quant(Frame& F) {
    const bf16* X1 = (const bf16*)(F.ws + WS_XN); unsigned char* A8 = F.ws + WS_A8; float* SROW = (float*)(F.ws + WS_SS1); const unsigned* cmax = (const unsigned*)(F.ctl + CW_CMAX);
    const int gw = F.vcu * NWAVES + F.wave, NGW = F.G * NWAVES, lane = F.lane;
    {   LAS float* scr = (LAS float*)(F.lds + RING_OFF + F.wave * 16384); constexpr int I_G = (D / 64) * (FF / 32);
        for (int it = gw; it < 2 * I_G; it += NGW) { const bool isv = it >= I_G; p6_quant_item(isv ? F.w_val : F.w_gate, D, FF, F.ws + WS_WGV, isv ? 128 : 0, scr, isv ? it - I_G : it, lane, F.g_ffn, cmax); } }
    {   float* cw6 = (float*)(F.ws + WS_TAB + TAB_CW4); const int gt = F.vcu * (NWAVES * 64) + F.tid, NGT = F.G * NWAVES * 64;
        for (int i = gt; i < (FF / 128) * 768; i += NGT) { const int pn = i / 768, k = (i % 768) >> 7, c = i & 127, ch = 128 * pn + c;
            cw6[i] = k < 3 ? F.conv_w[k * FF + ch] : (k == 3 ? F.conv_b[ch] : __uint_as_float(cmax[256 * pn + (k == 5 ? 128 : 0) + c]) * (1.0f / 127.0f)); } }
    for (int m0 = gw; m0 < M; m0 += 4 * NGW) { v4u w0[4], w1[4];
#pragma unroll
        for (int r = 0; r < 4; ++r) { const int m = (m0 + r * NGW) < M ? (m0 + r * NGW) : 0; const GAS v4u* rp = (const GAS v4u*)(X1 + (size_t)m * D + 16 * lane); w0[r] = rp[0]; w1[r] = rp[1]; }
#pragma unroll
        for (int r = 0; r < 4; ++r) { const int m = m0 + r * NGW; float v[16];
            v[0] = bflo(w0[r].x); v[1] = bfhi(w0[r].x); v[2] = bflo(w0[r].y); v[3] = bfhi(w0[r].y); v[4] = bflo(w0[r].z); v[5] = bfhi(w0[r].z); v[6] = bflo(w0[r].w); v[7] = bfhi(w0[r].w);
            v[8] = bflo(w1[r].x); v[9] = bfhi(w1[r].x); v[10] = bflo(w1[r].y); v[11] = bfhi(w1[r].y); v[12] = bflo(w1[r].z); v[13] = bfhi(w1[r].z); v[14] = bflo(w1[r].w); v[15] = bfhi(w1[r].w);
            float ss = 0.f, mx = 0.f;
#pragma unroll
            for (int i = 0; i < 16; ++i) { ss += v[i] * v[i]; mx = fmaxf(mx, fabsf(v[i])); }
            ss = wave_sum(ss);
#pragma unroll
            for (int o = 1; o < 64; o <<= 1) mx = fmaxf(mx, __shfl_xor(mx, o));
            const float inv = mx > 0.f ? 127.0f / mx : 0.f; unsigned q[4];
#pragma unroll
            for (int j = 0; j < 4; ++j) { q[j] = 0;
#pragma unroll
                for (int t = 0; t < 4; ++t) q[j] |= ((unsigned)(int)__builtin_rintf(v[4 * j + t] * inv) & 255u) << (8 * t); }
            if (m < M) { *(GAS v4u*)(A8 + (size_t)m * D + 16 * lane) = (v4u){q[0], q[1], q[2], q[3]};
                if (lane == 0) SROW[m] = mx * (1.0f / 127.0f) * (1.0f / sqrtf(ss * (1.f / D) + EPS)); } } }
}

struct Args { const float* in[16]; float* out; unsigned char* ws; int ph_lo, ph_hi; };
__global__ void __launch_bounds__(NWAVES * 64, 2) hymba_fwd(Args args) {
    extern __shared__ __attribute__((aligned(16))) unsigned char lds[];
    Frame F;
    F.lds = (LAS unsigned char*)lds;
    F.MISC = (volatile LAS unsigned*)(F.lds + MISC_OFF);
    F.tid = threadIdx.x; F.lane = F.tid & 63; F.wave = __builtin_amdgcn_readfirstlane(F.tid >> 6);
    F.G = gridDim.x; { const int bx = blockIdx.x; F.vcu = (F.G % 8 == 0) ? (bx % 8) * (F.G / 8) + bx / 8 : bx; }
    F.ws = args.ws; F.ctl = (gu32*)(args.ws + WS_CTL);
    F.x = args.in[0]; F.g_mix = args.in[1]; F.w_in = args.in[2]; F.g_attn = args.in[3]; F.rel_tab = args.in[4]; F.f_w = args.in[5]; F.f_b = args.in[6]; F.g_four = args.in[7];
    F.w_out = args.in[8]; F.g_ffn = args.in[9]; F.w_gate = args.in[10]; F.w_val = args.in[11]; F.conv_w = args.in[12]; F.conv_b = args.in[13]; F.w_down = args.in[14]; F.g_fin = args.in[15];
    F.out = args.out;
    for (int u = F.tid; u < (LDS_BYTES - LDSCTL_OFF) / 4; u += NWAVES * 64) ((LAS unsigned*)(F.lds + LDSCTL_OFF))[u] = 0u;
    __syncthreads();
    XcdBarrier bar; bar.bar = (unsigned*)(F.ctl + CW_BAR); bar.x = 0; bar.st = nullptr;
    if (MK_ONE_LAUNCH) bar = xcd_barrier_post((unsigned*)(F.ctl + CW_BAR), F.MISC + 8);
#define GRID_BAR() do { if (MK_ONE_LAUNCH) xcd_barrier(bar); } while (0)
    const int lo = args.ph_lo, hi = args.ph_hi;
#define IN(k) (lo <= (k) && (k) < hi)
#define BOTH(k) (IN(k) && IN((k) + 1))
    if (IN(0)) { p0_prologue(F); if (BOTH(0)) GRID_BAR(); }
    if (IN(1)) {
        pg8::Gemm g{(const bf16*)(F.ws + WS_XN), (const bf16*)(F.ws + WS_WIN), M, NPROJ, D, D, 0}; pg8::StaticOrder S; S.init(M, NPROJ, F.G, (int)blockIdx.x);
        pg8::EpiBf16Row E{(bf16*)(F.ws + WS_PROJ), NPROJ, (const float*)(F.ws + WS_RS0)};
        pg8::gemm_phase<pg8::EpiBf16Row, pg8::StaticOrder, true, true>(F.lds + RING_OFF, g, S, E);
        if (BOTH(1)) GRID_BAR();
    }
    if (IN(2)) { att::phase_local(F); fou::phase_fourier(F); if (BOTH(2)) GRID_BAR(); }
    if (IN(3)) { att::phase_class(F); if (IN(3) && IN(5)) GRID_BAR(); }
    if (IN(5)) {
        pg8::Gemm g{(const bf16*)(F.ws + WS_A2), (const bf16*)(F.ws + WS_WOUT), M, D, MIXW, MIXW, 0}; pg8::StaticOrder S; S.init(M, D, F.G, (int)blockIdx.x);
        pg8::EpiX1N E{(const bf16*)(F.ws + WS_XN), (bf16*)(F.ws + WS_XN), D, (float*)(F.ws + WS_SS1), (const float*)(F.ws + WS_SSA), (LAS float*)(F.lds + LDSCTL_OFF + 8192)};
        pg8::gemm_phase<pg8::EpiX1N, pg8::StaticOrder, true, true>(F.lds + RING_OFF, g, S, E);
        if (IN(5) && IN(6)) GRID_BAR();
    }
    if (IN(6)) { p6_quant(F); if (IN(6) && IN(7)) GRID_BAR(); }
    if (IN(7)) {
        pg8::Gemm g{(const bf16*)(F.ws + WS_A8), (const bf16*)(F.ws + WS_WGV), M, 2 * FF, D / 2, D / 2, 0}; pg8::StaticOrder S; S.init(M, 2 * FF, F.G, (int)blockIdx.x);
        pg8::EpiConvGlu E{(bf16*)(F.ws + WS_GV), FF, (const float*)(F.ws + WS_SS1), F.conv_w, F.conv_b, (LAS float*)(F.lds + LDSCTL_OFF + 4096), M, (float*)(F.ws + WS_HALO), (const float*)(F.ws + WS_TAB + TAB_CW4)};
        pg8::gemm_phase<pg8::EpiConvGlu, pg8::StaticOrder, true, true, true>(F.lds + RING_OFF, g, S, E);
        if (IN(7) && IN(9)) GRID_BAR();
    }
    if (IN(9)) {
        pg8::Gemm g{(const bf16*)(F.ws + WS_GV), (const bf16*)(F.ws + WS_WD), M, D, FF, FF, 0}; pg8::StaticOrder S; S.init(M, D, F.G, (int)blockIdx.x);
        { pg8::Unit uu; for (int i = 0; S.next(i, uu); ++i) p8_halo_fix(F, uu.pm); }
        asm volatile("s_waitcnt vmcnt(0)" ::: "memory"); __syncthreads();
        if (F.G == 256) {
            pg8::EpiFinal E{(const bf16*)(F.ws + WS_XN), F.out, D, F.g_fin, (float*)(F.ws + WS_XBUF), (unsigned*)(F.ctl + CW_PANEL), F.lds + LDSCTL_OFF + 4096};
            pg8::gemm_phase<pg8::EpiFinal, pg8::StaticOrder, true, true>(F.lds + RING_OFF, g, S, E);
        } else {
            pg8::EpiX2 E{(bf16*)(F.ws + WS_XN), D, (float*)(F.ws + WS_SS2)};
            pg8::gemm_phase<pg8::EpiX2, pg8::StaticOrder, true, true>(F.lds + RING_OFF, g, S, E);
            if (BOTH(9)) GRID_BAR();
        }
    }
    if (IN(10) && F.G != 256) { p10_final(F); }
#undef IN
#undef BOTH
}

extern "C" void kernel_launch(void* const* d_in, const int* in_sizes, int n_in, void* d_out, int out_size, void* d_ws, size_t ws_size, hipStream_t stream) {
    static int grid = 0;
    if (grid == 0) {
        if (n_in != 16 || in_sizes[0] != M * D || out_size != M * D || ws_size < WS_END) { fprintf(stderr, "kernel_launch: shape/workspace mismatch: n_in %d in0 %d out %d ws %zu (need %zu)\n", n_in, n_in > 0 ? in_sizes[0] : -1, out_size, ws_size, (size_t)WS_END); grid = -1; return; }
        int dev = 0, cus = 0, per_cu = 0;
        if (hipGetDevice(&dev) != hipSuccess || hipDeviceGetAttribute(&cus, hipDeviceAttributeMultiprocessorCount, dev) != hipSuccess) { grid = -1; return; }
        if (hipFuncSetAttribute((const void*)hymba_fwd, hipFuncAttributeMaxDynamicSharedMemorySize, LDS_BYTES) != hipSuccess) { fprintf(stderr, "kernel_launch: hipFuncSetAttribute failed\n"); grid = -1; return; }
        if (hipOccupancyMaxActiveBlocksPerMultiprocessor(&per_cu, (const void*)hymba_fwd, NWAVES * 64, LDS_BYTES) != hipSuccess || per_cu < 1) { fprintf(stderr, "kernel_launch: occupancy query says %d blocks/CU\n", per_cu); (void)hipGetLastError(); grid = -1; return; }
        grid = cus;
    }
    if (grid < 0) return;
    (void)hipMemsetAsync((char*)d_ws + WS_CTL, 0, CTL_ZERO_BYTES, stream);
    Args a{};
    for (int i = 0; i < 16; ++i) a.in[i] = (const float*)d_in[i];
    a.out = (float*)d_out; a.ws = (unsigned char*)d_ws;
#if MK_ONE_LAUNCH
    a.ph_lo = 0; a.ph_hi = N_PHASES;
    hipLaunchKernelGGL(hymba_fwd, dim3(grid), dim3(NWAVES * 64), LDS_BYTES, stream, a);
#else
    for (int p = 0; p < N_PHASES; ++p) { a.ph_lo = p; a.ph_hi = p + 1; hipLaunchKernelGGL(hymba_fwd, dim3(grid), dim3(NWAVES * 64), LDS_BYTES, stream, a); }
#endif
}
```

```cpp
#include <hip/hip_runtime.h>
#include <cstdio>
#include <cstdint>

namespace pg8 {
#define PG8_LAS __attribute__((address_space(3)))
typedef unsigned short bf16_t;
typedef short bf16x8 __attribute__((ext_vector_type(8)));
typedef float f32x4 __attribute__((ext_vector_type(4)));
typedef unsigned u32x4 __attribute__((ext_vector_type(4)));
typedef int i32x4 __attribute__((ext_vector_type(4)));
template <bool I8> struct AccT { typedef f32x4 type; };
template <> struct AccT<true> { typedef i32x4 type; };
constexpr int BM = 256, BK = 64, HALF = 128, HTB = HALF * BK * 2, STAGE_BYTES = 8 * HTB, NXCD = 8, WGM = 8;

__host__ __device__ __forceinline__ int lds_byte(int r, int c) { const int st = (r >> 4) * 2 + (c >> 5), rr = r & 15, cc = c & 31, ob = rr * 64 + cc * 2; return st * 1024 + (ob ^ (((ob >> 9) & 1) << 5)); }
__host__ __device__ __forceinline__ void stage_rc(int b, int& R, int& C) { const int st = b / 1024, sb = b % 1024, swz = sb ^ (((sb >> 9) & 1) << 5); R = (st >> 1) * 16 + swz / 64; C = (st & 1) * 32 + (swz % 64) / 2; }
__host__ __device__ __forceinline__ int perm32(int rho) { const int n = rho >> 4, i = rho & 15; return 8 * (i >> 2) + 4 * n + (i & 3); }

struct Unit { int pm, pn; };
struct Gemm { const bf16_t* A; const bf16_t* Bt; int M, N, K, lda; int ovl; };
__host__ __device__ __forceinline__ int ovl_row_base(int pm) { const int b = pm / 17, k = pm - 17 * b; return b * 4096 + (k ? 254 * k - 1 : 0); }

struct StaticOrder {
    int nM, nN, nwg, G, c;
    __host__ __device__ void init(int M, int N, int G_, int c_) { nM = M / BM; nN = N / BM; nwg = nM * nN; G = G_; c = c_; }
    __host__ __device__ bool next(int i, Unit& u) const {
        const long L = (long)i * G + c; if (L >= nwg) return false;
        int wgid = (int)L; { const int q = nwg / NXCD, r = nwg % NXCD, xcd = wgid % NXCD, off = wgid / NXCD; wgid = (xcd < r ? xcd * (q + 1) : r * (q + 1) + (xcd - r) * q) + off; }
        const int nig = WGM * nN, gid = wgid / nig, fm = gid * WGM, gsz = (nM - fm) < WGM ? (nM - fm) : WGM;
        u.pm = fm + ((wgid % nig) % gsz); u.pn = (wgid % nig) / gsz; return true;
    }
    __device__ __forceinline__ void a_ready(const Unit&) const {}
    __device__ __forceinline__ void done(const Unit&) const {}
};

typedef float f32x2v_t __attribute__((ext_vector_type(2))); typedef __bf16 bf16x2v_t __attribute__((ext_vector_type(2)));
__device__ __forceinline__ unsigned cvt_pk_bf16(float lo, float hi) { f32x2v_t v = {lo, hi}; bf16x2v_t b = __builtin_convertvector(v, bf16x2v_t); return __builtin_bit_cast(unsigned, b); }

struct EpiBf16 {
    static constexpr bool PERM = true, AFTER_DRAIN = false, MIDK = false, PREFETCH = false;
    bf16_t* O; int ldc;
    __device__ __forceinline__ void operator()(const f32x4 (&acc)[2][2][4][2], const Unit& u, int wr, int wc, int fr, int fq) const {
        const int row0 = u.pm * BM + wr * 64 + fr; const int col0 = u.pn * BM + wc * 32 + 8 * fq;
#pragma unroll
        for (int ai = 0; ai < 2; ++ai)
#pragma unroll
            for (int m = 0; m < 4; ++m) { bf16_t* rowp = O + (size_t)(row0 + ai * HALF + m * 16) * ldc + col0;
#pragma unroll
                for (int bj = 0; bj < 2; ++bj) { const f32x4 v0 = acc[ai][bj][m][0], v1 = acc[ai][bj][m][1];
                    u32x4 w; w.x = cvt_pk_bf16(v0[0], v0[1]); w.y = cvt_pk_bf16(v0[2], v0[3]); w.z = cvt_pk_bf16(v1[0], v1[1]); w.w = cvt_pk_bf16(v1[2], v1[3]);
                    *(u32x4*)(rowp + bj * HALF) = w; } }
    }
};

struct EpiBf16Row {
    static constexpr bool PERM = true, AFTER_DRAIN = false, MIDK = false, PREFETCH = false;
    bf16_t* O; int ldc; const float* rs;
    __device__ __forceinline__ void operator()(const f32x4 (&acc)[2][2][4][2], const Unit& u, int wr, int wc, int fr, int fq) const {
        const int row0 = u.pm * BM + wr * 64 + fr; const int col0 = u.pn * BM + wc * 32 + 8 * fq;
#pragma unroll
        for (int ai = 0; ai < 2; ++ai)
#pragma unroll
            for (int m = 0; m < 4; ++m) { const int row = row0 + ai * HALF + m * 16; const float r = rs[row]; bf16_t* rowp = O + (size_t)row * ldc + col0;
#pragma unroll
                for (int bj = 0; bj < 2; ++bj) { const f32x4 v0 = acc[ai][bj][m][0] * r, v1 = acc[ai][bj][m][1] * r;
                    u32x4 w; w.x = cvt_pk_bf16(v0[0], v0[1]); w.y = cvt_pk_bf16(v0[2], v0[3]); w.z = cvt_pk_bf16(v1[0], v1[1]); w.w = cvt_pk_bf16(v1[2], v1[3]);
                    *(u32x4*)(rowp + bj * HALF) = w; } }
    }
};
struct EpiResF32 {
    static constexpr bool PERM = false, AFTER_DRAIN = false, MIDK = false, PREFETCH = false;
    const float* base; float* out; int ldc;
    __device__ __forceinline__ void operator()(const f32x4 (&acc)[2][2][4][2], const Unit& u, int wr, int wc, int fr, int fq) const {
        const int col0 = u.pn * BM + wc * 32 + 4 * fq;
#pragma unroll
        for (int ai = 0; ai < 2; ++ai)
#pragma unroll
            for (int m = 0; m < 4; ++m) { const int r = u.pm * BM + ai * HALF + wr * 64 + m * 16 + fr; const size_t off = (size_t)r * ldc + col0;
#pragma unroll
                for (int bj = 0; bj < 2; ++bj)
#pragma unroll
                    for (int n = 0; n < 2; ++n) { const f32x4 bs = *(const f32x4*)(base + off + bj * HALF + n * 16); *(f32x4*)(out + off + bj * HALF + n * 16) = bs + acc[ai][bj][m][n]; } }
    }
};


struct EpiX1 {
    static constexpr bool PERM = true, AFTER_DRAIN = false, MIDK = false, PREFETCH = false;
    const float* base; bf16_t* O; int ldc; float* ss;
    __device__ __forceinline__ void operator()(const f32x4 (&acc)[2][2][4][2], const Unit& u, int wr, int wc, int fr, int fq) const {
        const int row0 = u.pm * BM + wr * 64 + fr; const int col0 = u.pn * BM + wc * 32 + 8 * fq;
#pragma unroll
        for (int ai = 0; ai < 2; ++ai)
#pragma unroll
            for (int m = 0; m < 4; ++m) { const int row = row0 + ai * HALF + m * 16; const size_t off = (size_t)row * ldc + col0; float q = 0.f;
#pragma unroll
                for (int bj = 0; bj < 2; ++bj) { const f32x4 v0 = *(const f32x4*)(base + off + bj * HALF) + acc[ai][bj][m][0], v1 = *(const f32x4*)(base + off + bj * HALF + 4) + acc[ai][bj][m][1];
                    q += (v0[0] * v0[0] + v0[1] * v0[1]) + (v0[2] * v0[2] + v0[3] * v0[3]) + (v1[0] * v1[0] + v1[1] * v1[1]) + (v1[2] * v1[2] + v1[3] * v1[3]);
                    u32x4 w; w.x = cvt_pk_bf16(v0[0], v0[1]); w.y = cvt_pk_bf16(v0[2], v0[3]); w.z = cvt_pk_bf16(v1[0], v1[1]); w.w = cvt_pk_bf16(v1[2], v1[3]);
                    *(u32x4*)(O + off + bj * HALF) = w; }
                q += __shfl_xor(q, 16); q += __shfl_xor(q, 32);
                if (fq == 0) ss[(size_t)row * 16 + u.pn * 4 + wc] = q; }
    }
};
struct EpiX2 {
    static constexpr bool PERM = true, AFTER_DRAIN = false, MIDK = false, PREFETCH = false;
    bf16_t* X; int ldc; float* ss;
    __device__ __forceinline__ void operator()(const f32x4 (&acc)[2][2][4][2], const Unit& u, int wr, int wc, int fr, int fq) const {
        const int row0 = u.pm * BM + wr * 64 + fr; const int col0 = u.pn * BM + wc * 32 + 8 * fq;
#pragma unroll
        for (int ai = 0; ai < 2; ++ai)
#pragma unroll
            for (int m = 0; m < 4; ++m) { const int row = row0 + ai * HALF + m * 16; const size_t off = (size_t)row * ldc + col0; float q = 0.f;
#pragma unroll
                for (int bj = 0; bj < 2; ++bj) { const u32x4 xb = *(const u32x4*)(X + off + bj * HALF);
                    f32x4 v0, v1; v0[0] = __builtin_bit_cast(float, xb.x << 16); v0[1] = __builtin_bit_cast(float, xb.x & 0xffff0000u); v0[2] = __builtin_bit_cast(float, xb.y << 16); v0[3] = __builtin_bit_cast(float, xb.y & 0xffff0000u);
                    v1[0] = __builtin_bit_cast(float, xb.z << 16); v1[1] = __builtin_bit_cast(float, xb.z & 0xffff0000u); v1[2] = __builtin_bit_cast(float, xb.w << 16); v1[3] = __builtin_bit_cast(float, xb.w & 0xffff0000u);
                    v0 = v0 + acc[ai][bj][m][0]; v1 = v1 + acc[ai][bj][m][1];
                    q += (v0[0] * v0[0] + v0[1] * v0[1]) + (v0[2] * v0[2] + v0[3] * v0[3]) + (v1[0] * v1[0] + v1[1] * v1[1]) + (v1[2] * v1[2] + v1[3] * v1[3]);
                    u32x4 w; w.x = cvt_pk_bf16(v0[0], v0[1]); w.y = cvt_pk_bf16(v0[2], v0[3]); w.z = cvt_pk_bf16(v1[0], v1[1]); w.w = cvt_pk_bf16(v1[2], v1[3]);
                    *(u32x4*)(X + off + bj * HALF) = w; }
                q += __shfl_xor(q, 16); q += __shfl_xor(q, 32);
                if (fq == 0) ss[(size_t)row * 16 + u.pn * 4 + wc] = q; }
    }
};
struct EpiBf16Rs {
    static constexpr bool PERM = true, AFTER_DRAIN = false, MIDK = false, PREFETCH = false;
    bf16_t* O; int ldc; const float* ss; float inv_n, eps;
    __device__ __forceinline__ void operator()(const f32x4 (&acc)[2][2][4][2], const Unit& u, int wr, int wc, int fr, int fq) const {
        const int row0 = u.pm * BM + wr * 64 + fr; const int col0 = u.pn * BM + wc * 32 + 8 * fq;
#pragma unroll
        for (int ai = 0; ai < 2; ++ai)
#pragma unroll
            for (int m = 0; m < 4; ++m) { const int row = row0 + ai * HALF + m * 16; const f32x4* sp = (const f32x4*)(ss + (size_t)row * 16);
                const f32x4 s4 = (sp[0] + sp[1]) + (sp[2] + sp[3]); const float rs = 1.0f / sqrtf(((s4[0] + s4[1]) + (s4[2] + s4[3])) * inv_n + eps);
                bf16_t* rowp = O + (size_t)row * ldc + col0;
#pragma unroll
                for (int bj = 0; bj < 2; ++bj) { const f32x4 v0 = acc[ai][bj][m][0] * rs, v1 = acc[ai][bj][m][1] * rs;
                    u32x4 w; w.x = cvt_pk_bf16(v0[0], v0[1]); w.y = cvt_pk_bf16(v0[2], v0[3]); w.z = cvt_pk_bf16(v1[0], v1[1]); w.w = cvt_pk_bf16(v1[2], v1[3]);
                    *(u32x4*)(rowp + bj * HALF) = w; } }
    }
};


template <int CTRL> __device__ __forceinline__ float dppk(float keep, float x) { return __builtin_bit_cast(float, __builtin_amdgcn_update_dpp(__builtin_bit_cast(int, keep), __builtin_bit_cast(int, x), CTRL, 0xf, 0xf, false)); }
template <int CTRL> __device__ __forceinline__ float dppf(float x) { return __builtin_bit_cast(float, __builtin_amdgcn_mov_dpp(__builtin_bit_cast(int, x), CTRL, 0xf, 0xf, true)); }
struct EpiConvGlu {
    static constexpr bool PERM = true, AFTER_DRAIN = false, MIDK = false, PREFETCH = true, PERMA = true;
    bf16_t* O; int ldc; const float* ss; const float* cw; const float* cb; PG8_LAS float* ex; int mrows; float* halo; const float* cw4;
    __device__ __forceinline__ void prefetch(const Unit& u, int wid, int lane) const {
        const int base = u.pm * BM; asm volatile("" : "+v"(lane));
        if (wid == 0) __builtin_amdgcn_global_load_lds((const unsigned*)(ss + base + lane * 4), (PG8_LAS unsigned*)(ex + 1024), 16, 0, 0);
        else if (wid < 4) __builtin_amdgcn_global_load_lds((const unsigned*)(cw4 + u.pn * 768 + (wid - 1) * 256 + lane * 4), (PG8_LAS unsigned*)(ex + 1024 + 4096 + (wid - 1) * 256), 16, 0, 0);
    }
    __device__ __forceinline__ void operator()(i32x4 (&iacc)[2][2][4][2], const Unit& u, int wr, int wc, int fr, int fq) const {
        f32x4 acc[2][2][4][2];
        const int kt = u.pm & 15, base = u.pm * BM;
        const int ch0 = u.pn * 128 + wc * 32 + 8 * fq;
        const bool top_open = kt != 0, bot_open = kt != 15;
        f32x4 w0[2], w1[2], w2[2], cbv[2], isv[2];
#pragma unroll
        for (int n = 0; n < 2; ++n) { const PG8_LAS float* wl = ex + 1024 + 4096 + wc * 32 + 8 * fq + 4 * n; const f32x4 sg = *(const PG8_LAS f32x4*)(wl + 512) * -1.4426950408889634f;
            w0[n] = *(const PG8_LAS f32x4*)wl * sg; w1[n] = *(const PG8_LAS f32x4*)(wl + 128) * sg; w2[n] = *(const PG8_LAS f32x4*)(wl + 256) * sg; cbv[n] = *(const PG8_LAS f32x4*)(wl + 384) * -1.4426950408889634f;
            const f32x4 svn = *(const PG8_LAS f32x4*)(wl + 640);
#pragma unroll
            for (int i = 0; i < 4; ++i) isv[n][i] = __builtin_amdgcn_rcpf(fminf(svn[i] * -0.6931471805599453f, -1e-30f)); }
#pragma unroll
        for (int ai = 0; ai < 2; ++ai) { const f32x4 rs4 = *(const PG8_LAS f32x4*)(ex + 1024 + ai * HALF + wr * 64 + fr * 4);
#pragma unroll
            for (int m = 0; m < 4; ++m) { const float rs = rs4[m];
#pragma unroll
                for (int n = 0; n < 2; ++n) { const i32x4 ig = iacc[ai][0][m][n], iv = iacc[ai][1][m][n];
                    acc[ai][0][m][n] = (f32x4){(float)ig[0], (float)ig[1], (float)ig[2], (float)ig[3]} * rs; acc[ai][1][m][n] = (f32x4){(float)iv[0], (float)iv[1], (float)iv[2], (float)iv[3]} * rs; } } }
        const int exi = (wc * 4 + fq) * 8;
        if (fr == 0) {
#pragma unroll
            for (int ai = 0; ai < 2; ++ai) { PG8_LAS f32x4* p = (PG8_LAS f32x4*)(ex + ((ai * 2 + wr) * 2 + 0) * 128 + exi); p[0] = acc[ai][0][0][0]; p[1] = acc[ai][0][0][1]; } }
        if (fr == 15) {
#pragma unroll
            for (int ai = 0; ai < 2; ++ai) { PG8_LAS f32x4* p = (PG8_LAS f32x4*)(ex + ((ai * 2 + wr) * 2 + 1) * 128 + exi); p[0] = acc[ai][0][3][0]; p[1] = acc[ai][0][3][1]; } }
        asm volatile("s_waitcnt lgkmcnt(0)\n\ts_barrier" ::: "memory");
#pragma unroll
        for (int ai = 0; ai < 2; ++ai) {
            f32x4 et[2] = {(f32x4){0.f, 0.f, 0.f, 0.f}, (f32x4){0.f, 0.f, 0.f, 0.f}}, eb[2] = {(f32x4){0.f, 0.f, 0.f, 0.f}, (f32x4){0.f, 0.f, 0.f, 0.f}};
            { const bool hz = (wr == 0 && ai == 0); const int sai = wr == 1 ? ai : 0, swr = wr == 1 ? 0 : 1; const PG8_LAS f32x4* p = (const PG8_LAS f32x4*)(ex + ((sai * 2 + swr) * 2 + 1) * 128 + exi);
              if (!hz) { et[0] = p[0]; et[1] = p[1]; } }
            { const bool hz = (wr == 1 && ai == 1); const int sai = wr == 0 ? ai : 1, swr = wr == 0 ? 1 : 0; const PG8_LAS f32x4* p = (const PG8_LAS f32x4*)(ex + ((sai * 2 + swr) * 2 + 0) * 128 + exi);
              if (!hz) { eb[0] = p[0]; eb[1] = p[1]; } }
            float a[4][8], zz[8];
#pragma unroll
            for (int n = 0; n < 2; ++n)
#pragma unroll
                for (int i = 0; i < 4; ++i) { const float g0 = acc[ai][0][0][n][i], g1 = acc[ai][0][1][n][i], g2 = acc[ai][0][2][n][i], g3 = acc[ai][0][3][n][i];
                    const float up = dppk<0x111>(et[n][i], g3), dn = dppk<0x101>(eb[n][i], g0);
                    const float c0 = w0[n][i], c1 = w1[n][i], c2 = w2[n][i], cb0 = cbv[n][i];
                    float z[4];
                    z[0] = __builtin_fmaf(c2, g1, __builtin_fmaf(c1, g0, __builtin_fmaf(c0, up, cb0)));
                    z[1] = __builtin_fmaf(c2, g2, __builtin_fmaf(c1, g1, __builtin_fmaf(c0, g0, cb0)));
                    z[2] = __builtin_fmaf(c2, g3, __builtin_fmaf(c1, g2, __builtin_fmaf(c0, g1, cb0)));
                    z[3] = __builtin_fmaf(c2, dn, __builtin_fmaf(c1, g3, __builtin_fmaf(c0, g2, cb0)));
                    zz[4 * n + i] = (ai == 0 ? z[0] : z[3]) * -0.6931471805599453f;
#pragma unroll
                    for (int m = 0; m < 4; ++m) { const float iv0 = isv[n][i]; a[m][4 * n + i] = z[m] * __builtin_amdgcn_rcpf(__builtin_fmaf(__builtin_amdgcn_exp2f(z[m]), iv0, iv0)) * acc[ai][1][m][n][i]; } }
#pragma unroll
            for (int m = 0; m < 4; ++m) { const int r = ai * HALF + wr * 64 + fr * 4 + m; u32x4 w;
                w.x = cvt_pk_bf16(a[m][0], a[m][1]); w.y = cvt_pk_bf16(a[m][2], a[m][3]); w.z = cvt_pk_bf16(a[m][4], a[m][5]); w.w = cvt_pk_bf16(a[m][6], a[m][7]);
                bool open = false;
                if (ai == 0 && m == 0) open = (r == 0) && top_open;
                if (ai == 1 && m == 3) open = (r == 255) && bot_open;
                if (!open) *(u32x4*)(O + (size_t)(base + r) * ldc + ch0) = w;
                if ((ai == 0 && m == 0) || (ai == 1 && m == 3)) { if (open) { float* hp = halo + ((size_t)(u.pm * 2 + (ai == 0 ? 0 : 1)) * 3) * ldc + ch0;
                        const PG8_LAS float* sl = ex + 1024 + 4096 + 512 + wc * 32 + 8 * fq;
                        *(f32x4*)hp = acc[ai][0][m][0] * *(const PG8_LAS f32x4*)sl; *(f32x4*)(hp + 4) = acc[ai][0][m][1] * *(const PG8_LAS f32x4*)(sl + 4);
                        *(f32x4*)(hp + ldc) = (f32x4){zz[0], zz[1], zz[2], zz[3]}; *(f32x4*)(hp + ldc + 4) = (f32x4){zz[4], zz[5], zz[6], zz[7]};
                        *(f32x4*)(hp + 2 * ldc) = acc[ai][1][m][0] * *(const PG8_LAS f32x4*)(sl + 128); *(f32x4*)(hp + 2 * ldc + 4) = acc[ai][1][m][1] * *(const PG8_LAS f32x4*)(sl + 132); } }
                asm volatile("" ::: "memory"); } }
        asm volatile("s_waitcnt lgkmcnt(0)\n\ts_barrier" ::: "memory");
    }
};


struct EpiX1N {
    static constexpr bool PERM = true, AFTER_DRAIN = false, MIDK = true, PREFETCH = true; static constexpr int MIDK_T = 12;
    const bf16_t* base; bf16_t* O; int ldc; float* ss; const float* sa; PG8_LAS float* st;
    __device__ __forceinline__ void prefetch(const Unit& u, int wid, int lane) const {
        asm volatile("" : "+v"(lane));
#pragma unroll
        for (int i = 0; i < 2; ++i) { const int piece = wid * 2 + i;
            __builtin_amdgcn_global_load_lds((const unsigned*)(sa + (size_t)u.pm * BM * 16 + piece * 256 + lane * 4), (PG8_LAS unsigned*)(st + piece * 256), 16, 0, 0); }
    }
    __device__ __forceinline__ void row_stats(int rl, int fq, float& ra, float& rf) const {
        const f32x4 s4 = *(const PG8_LAS f32x4*)(st + rl * 16 + 4 * fq); float a = fq < 3 ? (s4[0] + s4[1]) + (s4[2] + s4[3]) : 0.f, f = fq == 3 ? s4[0] : 0.f;
        a += __shfl_xor(a, 16); a += __shfl_xor(a, 32); f += __shfl_xor(f, 16); f += __shfl_xor(f, 32);
        ra = __builtin_amdgcn_rsqf(a * (1.0f / 768.0f) + 1e-6f); rf = __builtin_amdgcn_rsqf(f * (1.0f / 256.0f) + 1e-6f);
    }
    __device__ __forceinline__ void midk(f32x4 (&acc)[2][2][4][2], const Unit& u, int wr, int fr, int fq) const {
#pragma unroll
        for (int ai = 0; ai < 2; ++ai)
#pragma unroll
            for (int m = 0; m < 4; ++m) { float ra, rf; row_stats(ai * HALF + wr * 64 + m * 16 + fr, fq, ra, rf); const float ratio = ra * __builtin_amdgcn_rcpf(rf);
#pragma unroll
                for (int bj = 0; bj < 2; ++bj) { acc[ai][bj][m][0] = acc[ai][bj][m][0] * ratio; acc[ai][bj][m][1] = acc[ai][bj][m][1] * ratio; } }
    }
    __device__ __forceinline__ void operator()(const f32x4 (&acc)[2][2][4][2], const Unit& u, int wr, int wc, int fr, int fq) const {
        const int row0 = u.pm * BM + wr * 64 + fr; const int col0 = u.pn * BM + wc * 32 + 8 * fq;
#pragma unroll
        for (int ai = 0; ai < 2; ++ai)
#pragma unroll
            for (int m = 0; m < 4; ++m) { const int row = row0 + ai * HALF + m * 16; const size_t off = (size_t)row * ldc + col0; float ra, rf; row_stats(row - u.pm * BM, fq, ra, rf);
#pragma unroll
                for (int bj = 0; bj < 2; ++bj) { const u32x4 xb = *(const u32x4*)(base + off + bj * HALF); f32x4 v0, v1;
                    v0[0] = __builtin_bit_cast(float, xb.x << 16); v0[1] = __builtin_bit_cast(float, xb.x & 0xffff0000u); v0[2] = __builtin_bit_cast(float, xb.y << 16); v0[3] = __builtin_bit_cast(float, xb.y & 0xffff0000u);
                    v1[0] = __builtin_bit_cast(float, xb.z << 16); v1[1] = __builtin_bit_cast(float, xb.z & 0xffff0000u); v1[2] = __builtin_bit_cast(float, xb.w << 16); v1[3] = __builtin_bit_cast(float, xb.w & 0xffff0000u);
                    v0 = v0 + acc[ai][bj][m][0] * rf; v1 = v1 + acc[ai][bj][m][1] * rf;
                    u32x4 w; w.x = cvt_pk_bf16(v0[0], v0[1]); w.y = cvt_pk_bf16(v0[2], v0[3]); w.z = cvt_pk_bf16(v1[0], v1[1]); w.w = cvt_pk_bf16(v1[2], v1[3]);
                    *(u32x4*)(O + off + bj * HALF) = w; }
                }
        asm volatile("s_waitcnt lgkmcnt(0)\n\ts_barrier" ::: "memory");
    }
};


struct EpiX1Q {
    static constexpr bool PERM = true, AFTER_DRAIN = false, MIDK = true, PREFETCH = true; static constexpr int MIDK_T = 12;
    const bf16_t* base; bf16_t* O; int ldc; const float* sa; PG8_LAS float* st; unsigned char* A8; float* srow; float* xbuf; unsigned* cnt; PG8_LAS unsigned char* lq;
    __device__ __forceinline__ void prefetch(const Unit& u, int wid, int lane) const {
        asm volatile("" : "+v"(lane));
#pragma unroll
        for (int i = 0; i < 2; ++i) { const int piece = wid * 2 + i;
            __builtin_amdgcn_global_load_lds((const unsigned*)(sa + (size_t)u.pm * BM * 16 + piece * 256 + lane * 4), (PG8_LAS unsigned*)(st + piece * 256), 16, 0, 0); }
    }
    __device__ __forceinline__ void row_stats(int rl, int fq, float& ra, float& rf) const {
        const f32x4 s4 = *(const PG8_LAS f32x4*)(st + rl * 16 + 4 * fq); float a = fq < 3 ? (s4[0] + s4[1]) + (s4[2] + s4[3]) : 0.f, f = fq == 3 ? s4[0] : 0.f;
        a += __shfl_xor(a, 16); a += __shfl_xor(a, 32); f += __shfl_xor(f, 16); f += __shfl_xor(f, 32);
        ra = __builtin_amdgcn_rsqf(a * (1.0f / 768.0f) + 1e-6f); rf = __builtin_amdgcn_rsqf(f * (1.0f / 256.0f) + 1e-6f);
    }
    __device__ __forceinline__ void midk(f32x4 (&acc)[2][2][4][2], const Unit& u, int wr, int fr, int fq) const {
#pragma unroll
        for (int ai = 0; ai < 2; ++ai)
#pragma unroll
            for (int m = 0; m < 4; ++m) { float ra, rf; row_stats(ai * HALF + wr * 64 + m * 16 + fr, fq, ra, rf); const float ratio = ra * __builtin_amdgcn_rcpf(rf);
#pragma unroll
                for (int bj = 0; bj < 2; ++bj) { acc[ai][bj][m][0] = acc[ai][bj][m][0] * ratio; acc[ai][bj][m][1] = acc[ai][bj][m][1] * ratio; } }
    }
    __device__ __forceinline__ void operator()(f32x4 (&acc)[2][2][4][2], const Unit& u, int wr, int wc, int fr, int fq) const {
        PG8_LAS float* Pq = (PG8_LAS float*)(lq + 4096); PG8_LAS float* Pm = (PG8_LAS float*)(lq + 24576); PG8_LAS float* S = (PG8_LAS float*)(lq + 28672);
        asm volatile("" : "+v"(fr), "+v"(fq));
        int tid = (wr * 4 + wc) * 64 + fq * 16 + fr;
        const int col0 = u.pn * BM + wc * 32 + 8 * fq;
#pragma unroll
        for (int ai = 0; ai < 2; ++ai)
#pragma unroll
            for (int m = 0; m < 4; ++m) { const int rl = ai * HALF + wr * 64 + m * 16 + fr; const size_t off = (size_t)(u.pm * BM + rl) * ldc + col0; float ra, rf; row_stats(rl, fq, ra, rf); float q = 0.f, mx = 0.f;
#pragma unroll
                for (int bj = 0; bj < 2; ++bj) { const u32x4 xb = *(const u32x4*)(base + off + bj * HALF); f32x4 v0, v1;
                    v0[0] = __builtin_bit_cast(float, xb.x << 16); v0[1] = __builtin_bit_cast(float, xb.x & 0xffff0000u); v0[2] = __builtin_bit_cast(float, xb.y << 16); v0[3] = __builtin_bit_cast(float, xb.y & 0xffff0000u);
                    v1[0] = __builtin_bit_cast(float, xb.z << 16); v1[1] = __builtin_bit_cast(float, xb.z & 0xffff0000u); v1[2] = __builtin_bit_cast(float, xb.w << 16); v1[3] = __builtin_bit_cast(float, xb.w & 0xffff0000u);
                    v0 = v0 + acc[ai][bj][m][0] * rf; v1 = v1 + acc[ai][bj][m][1] * rf; acc[ai][bj][m][0] = v0; acc[ai][bj][m][1] = v1;
                    q += ((v0[0] * v0[0] + v0[1] * v0[1]) + (v0[2] * v0[2] + v0[3] * v0[3])) + ((v1[0] * v1[0] + v1[1] * v1[1]) + (v1[2] * v1[2] + v1[3] * v1[3]));
                    mx = fmaxf(mx, fmaxf(fmaxf(fmaxf(fabsf(v0[0]), fabsf(v0[1])), fmaxf(fabsf(v0[2]), fabsf(v0[3]))), fmaxf(fmaxf(fabsf(v1[0]), fabsf(v1[1])), fmaxf(fabsf(v1[2]), fabsf(v1[3])))));
                    u32x4 w; w.x = cvt_pk_bf16(v0[0], v0[1]); w.y = cvt_pk_bf16(v0[2], v0[3]); w.z = cvt_pk_bf16(v1[0], v1[1]); w.w = cvt_pk_bf16(v1[2], v1[3]);
                    *(u32x4*)(O + off + bj * HALF) = w; }
                q += __shfl_xor(q, 16); q += __shfl_xor(q, 32); mx = fmaxf(mx, __shfl_xor(mx, 16)); mx = fmaxf(mx, __shfl_xor(mx, 32));
                if (fq == 0) { Pq[rl * 4 + wc] = q; Pm[rl * 4 + wc] = mx; } }
        asm volatile("s_waitcnt lgkmcnt(0)\n\ts_barrier" ::: "memory");
        if (tid < 256) { const float sq = (Pq[tid * 4] + Pq[tid * 4 + 1]) + (Pq[tid * 4 + 2] + Pq[tid * 4 + 3]); const float mq = fmaxf(fmaxf(Pm[tid * 4], Pm[tid * 4 + 1]), fmaxf(Pm[tid * 4 + 2], Pm[tid * 4 + 3]));
            float* xp = xbuf + ((size_t)(u.pm * BM + tid) * 4 + u.pn) * 2;
            __hip_atomic_store(xp, sq, __ATOMIC_RELAXED, __HIP_MEMORY_SCOPE_AGENT); __hip_atomic_store(xp + 1, mq, __ATOMIC_RELAXED, __HIP_MEMORY_SCOPE_AGENT);
            asm volatile("s_waitcnt vmcnt(0)" ::: "memory");
            if ((tid & 63) == 0) __hip_atomic_fetch_add(cnt + 64 * u.pm, 1u, __ATOMIC_RELAXED, __HIP_MEMORY_SCOPE_AGENT); }
        if (tid < 64) { unsigned spins = 0;
            while ((unsigned)__builtin_amdgcn_readfirstlane(__hip_atomic_load(cnt + 64 * u.pm, __ATOMIC_RELAXED, __HIP_MEMORY_SCOPE_AGENT)) < 16u) { __builtin_amdgcn_s_sleep(2); if (++spins > 400000u) break; }
            __builtin_amdgcn_fence(__ATOMIC_ACQUIRE, "agent"); }
        asm volatile("s_waitcnt vmcnt(0) lgkmcnt(0)\n\ts_barrier" ::: "memory");
        if (tid < 256) { const float* xp = xbuf + (size_t)(u.pm * BM + tid) * 8; float t = 0.f, mq = 0.f;
#pragma unroll
            for (int k = 0; k < 4; ++k) { t += __hip_atomic_load(xp + 2 * k, __ATOMIC_RELAXED, __HIP_MEMORY_SCOPE_AGENT); mq = fmaxf(mq, __hip_atomic_load(xp + 2 * k + 1, __ATOMIC_RELAXED, __HIP_MEMORY_SCOPE_AGENT)); }
            S[tid] = mq > 0.f ? 127.0f / mq : 0.f;
            if (u.pn == 0) srow[u.pm * BM + tid] = mq * (1.0f / 127.0f) * (1.0f / sqrtf(t * (1.0f / 1024.0f) + 1e-6f)); }
        asm volatile("s_waitcnt vmcnt(0) lgkmcnt(0)\n\ts_barrier" ::: "memory");
        int fr5 = fr; asm volatile("" : "+v"(fr5));
#pragma unroll
        for (int ai = 0; ai < 2; ++ai)
#pragma unroll
            for (int m = 0; m < 4; ++m) { const int rl = ai * HALF + wr * 64 + m * 16 + fr5; const float inv = S[rl]; unsigned char* ap = A8 + (size_t)(u.pm * BM + rl) * ldc + col0;
#pragma unroll
                for (int bj = 0; bj < 2; ++bj) { unsigned lo = 0, hi = 0;
#pragma unroll
                    for (int t = 0; t < 4; ++t) { lo |= ((unsigned)(int)__builtin_rintf(acc[ai][bj][m][0][t] * inv) & 255u) << (8 * t); hi |= ((unsigned)(int)__builtin_rintf(acc[ai][bj][m][1][t] * inv) & 255u) << (8 * t); }
                    unsigned long long pk = (unsigned long long)lo | ((unsigned long long)hi << 32); *(unsigned long long*)(ap + bj * HALF) = pk; } }
        asm volatile("s_waitcnt lgkmcnt(0)\n\ts_barrier" ::: "memory");
    }
};

struct EpiFinal {
    static constexpr bool PERM = true, AFTER_DRAIN = false, MIDK = false, PREFETCH = false;
    const bf16_t* X1; float* out; int ldc; const float* gain; float* xbuf; unsigned* cnt; PG8_LAS unsigned char* lx;
    __device__ __forceinline__ void operator()(f32x4 (&acc)[2][2][4][2], const Unit& u, int wr, int wc, int fr, int fq) const {
        PG8_LAS float* P = (PG8_LAS float*)lx; PG8_LAS float* S = (PG8_LAS float*)(lx + 4096);
        int tid = (wr * 4 + wc) * 64 + fq * 16 + fr; asm volatile("" : "+v"(tid)); const int col0 = u.pn * BM + wc * 32 + 8 * fq;
#pragma unroll
        for (int ai = 0; ai < 2; ++ai)
#pragma unroll
            for (int m = 0; m < 4; ++m) { const int rl = ai * HALF + wr * 64 + m * 16 + fr; const size_t off = (size_t)(u.pm * BM + rl) * ldc + col0; float q = 0.f;
#pragma unroll
                for (int bj = 0; bj < 2; ++bj) { const u32x4 xb = *(const u32x4*)(X1 + off + bj * HALF); f32x4 v0, v1;
                    v0[0] = __builtin_bit_cast(float, xb.x << 16); v0[1] = __builtin_bit_cast(float, xb.x & 0xffff0000u); v0[2] = __builtin_bit_cast(float, xb.y << 16); v0[3] = __builtin_bit_cast(float, xb.y & 0xffff0000u);
                    v1[0] = __builtin_bit_cast(float, xb.z << 16); v1[1] = __builtin_bit_cast(float, xb.z & 0xffff0000u); v1[2] = __builtin_bit_cast(float, xb.w << 16); v1[3] = __builtin_bit_cast(float, xb.w & 0xffff0000u);
                    v0 = v0 + acc[ai][bj][m][0]; v1 = v1 + acc[ai][bj][m][1]; acc[ai][bj][m][0] = v0; acc[ai][bj][m][1] = v1;
                    q += ((v0[0] * v0[0] + v0[1] * v0[1]) + (v0[2] * v0[2] + v0[3] * v0[3])) + ((v1[0] * v1[0] + v1[1] * v1[1]) + (v1[2] * v1[2] + v1[3] * v1[3])); }
                q += __shfl_xor(q, 16); q += __shfl_xor(q, 32);
                if (fq == 0) P[rl * 4 + wc] = q; }
        asm volatile("s_waitcnt lgkmcnt(0)\n\ts_barrier" ::: "memory");
        if (tid < 256) { const float s = (P[tid * 4] + P[tid * 4 + 1]) + (P[tid * 4 + 2] + P[tid * 4 + 3]);
            __hip_atomic_store(xbuf + ((size_t)(u.pm * BM + tid) * 4 + u.pn), s, __ATOMIC_RELAXED, __HIP_MEMORY_SCOPE_AGENT);
            asm volatile("s_waitcnt vmcnt(0)" ::: "memory");
            if ((tid & 63) == 0) __hip_atomic_fetch_add(cnt + 64 * u.pm, 1u, __ATOMIC_RELAXED, __HIP_MEMORY_SCOPE_AGENT); }
        if (tid < 64) { unsigned spins = 0;
            while ((unsigned)__builtin_amdgcn_readfirstlane(__hip_atomic_load(cnt + 64 * u.pm, __ATOMIC_RELAXED, __HIP_MEMORY_SCOPE_AGENT)) < 16u) { __builtin_amdgcn_s_sleep(2); if (++spins > 400000u) break; }
            __builtin_amdgcn_fence(__ATOMIC_ACQUIRE, "agent"); }
        asm volatile("s_waitcnt vmcnt(0) lgkmcnt(0)\n\ts_barrier" ::: "memory");
        if (tid < 256) { const float* xp = xbuf + (size_t)(u.pm * BM + tid) * 4; float t = 0.f;
#pragma unroll
            for (int k = 0; k < 4; ++k) t += __hip_atomic_load(xp + k, __ATOMIC_RELAXED, __HIP_MEMORY_SCOPE_AGENT);
            S[tid] = 1.0f / sqrtf(t * (1.0f / 1024.0f) + 1e-6f); }
        asm volatile("s_waitcnt vmcnt(0) lgkmcnt(0)\n\ts_barrier" ::: "memory");
        f32x4 gv[2][2];
#pragma unroll
        for (int bj = 0; bj < 2; ++bj)
#pragma unroll
            for (int n = 0; n < 2; ++n) gv[bj][n] = *(const f32x4*)(gain + col0 + bj * HALF + n * 4);
#pragma unroll
        for (int ai = 0; ai < 2; ++ai)
#pragma unroll
            for (int m = 0; m < 4; ++m) { const int rl = ai * HALF + wr * 64 + m * 16 + fr; const float rs = S[rl]; const size_t off = (size_t)(u.pm * BM + rl) * ldc + col0;
#pragma unroll
                for (int bj = 0; bj < 2; ++bj)
#pragma unroll
                    for (int n = 0; n < 2; ++n) *(f32x4*)(out + off + bj * HALF + n * 4) = acc[ai][bj][m][n] * rs * gv[bj][n]; }
    }
};

template <class E, class = void> struct HasPermA { static constexpr bool v = false; };
template <class E> struct HasPermA<E, decltype((void)E::PERMA)> { static constexpr bool v = E::PERMA; };
template <bool I8> __device__ __forceinline__ typename AccT<I8>::type mma16(bf16x8 a, bf16x8 b, typename AccT<I8>::type c) {
    if constexpr (I8) return __builtin_amdgcn_mfma_i32_16x16x64_i8(__builtin_bit_cast(i32x4, a), __builtin_bit_cast(i32x4, b), c, 0, 0, 0);
    else return __builtin_amdgcn_mfma_f32_16x16x32_bf16(a, b, c, 0, 0, 0);
}
template <class Epi, class Sched, bool ALIGN_EPI = false, bool SP2 = false, bool I8 = false>
__device__ __forceinline__ void gemm_phase(PG8_LAS unsigned char* lds, const Gemm g, const Sched& S, const Epi& E) {
    int tid = threadIdx.x; asm volatile("" : "+v"(tid));
    const int wid = __builtin_amdgcn_readfirstlane(tid >> 6), lane = tid & 63, wr = wid >> 2, wc = wid & 3, fr = lane & 15, fq = lane >> 4;
    const int K = g.K, nt = K / BK, lda = g.lda;
    unsigned voffA[2], voffB[2];
#pragma unroll
    for (int i = 0; i < 2; ++i) { int R, C; stage_rc(tid * 16 + i * 8192, R, C); const int Rb = Epi::PERM ? ((R & ~31) + perm32(R & 31)) : R;
        const int Ra = HasPermA<Epi>::v ? ((R & ~63) + (R & 15) * 4 + ((R >> 4) & 3)) : R;
        voffA[i] = (unsigned)(Ra * lda + C) * 2u; voffB[i] = (unsigned)(Rb * K + C) * 2u; }
    const size_t kstep = (size_t)(BK * 2);
    const size_t hstepA = (size_t)HALF * lda * 2, hstepB = (size_t)HALF * K * 2;
    const size_t tstepA = 2 * hstepA, tstepB = 2 * hstepB;
    const unsigned ldsw = (unsigned)wid * 1024u;
    const int aoff = lds_byte(wr * 64 + fr, fq * 8), boff = lds_byte(wc * 32 + fr, fq * 8);
#define PG8_SA(b, h) (((b) * 2 + (h)) * HTB)
#define PG8_SB(b, h) ((4 + (b) * 2 + (h)) * HTB)
#define PG8_STAGE(bufoff, gbase, voff) do { _Pragma("unroll") for (int _i = 0; _i < 2; ++_i) \
        __builtin_amdgcn_global_load_lds((const unsigned*)((const char*)(gbase) + (voff)[_i]), (PG8_LAS unsigned*)(lds + (bufoff) + ldsw + _i * 8192), 16, 0, 0); } while (0)
#define PG8_LDA(dst, b, h) do { _Pragma("unroll") for (int m = 0; m < 4; ++m) _Pragma("unroll") for (int k = 0; k < 2; ++k) dst[m][k] = *(const PG8_LAS bf16x8*)(lds + PG8_SA(b, h) + aoff + m * 2048 + k * 1024); } while (0)
#define PG8_LDB(dst, b, h) do { _Pragma("unroll") for (int n = 0; n < 2; ++n) _Pragma("unroll") for (int k = 0; k < 2; ++k) dst[n][k] = *(const PG8_LAS bf16x8*)(lds + PG8_SB(b, h) + boff + n * 2048 + k * 1024); } while (0)
#define PG8_MMA(ai, bj, At, Bt) do { __builtin_amdgcn_s_setprio(1); _Pragma("unroll") for (int m = 0; m < 4; ++m) _Pragma("unroll") for (int n = 0; n < 2; ++n) _Pragma("unroll") for (int k = 0; k < 2; ++k) \
        acc[ai][bj][m][n] = mma16<I8>(Bt[n][k], At[m][k], acc[ai][bj][m][n]); __builtin_amdgcn_s_setprio(0); } while (0)
#define PG8_WAIT_V(n) asm volatile("s_waitcnt vmcnt(" #n ")" ::: "memory")
#define PG8_WAIT_L(n) asm volatile("s_waitcnt lgkmcnt(" #n ")" ::: "memory")
#define PG8_BAR __builtin_amdgcn_s_barrier()
#define PG8_SCHED __builtin_amdgcn_sched_barrier(0)
    Unit cur, nxt; int ui = 0;
    if (!S.next(0, cur)) return;
    typedef typename AccT<I8>::type acc_t; acc_t acc[2][2][4][2];
#pragma unroll
    for (int a = 0; a < 2; ++a)
#pragma unroll
        for (int b = 0; b < 2; ++b)
#pragma unroll
            for (int m = 0; m < 4; ++m)
#pragma unroll
                for (int n = 0; n < 2; ++n) acc[a][b][m][n] = (acc_t){0, 0, 0, 0};
    bf16x8 At[4][2], B0[2][2], B1[2][2];
    const char* cA = (const char*)g.A + (g.ovl ? (size_t)ovl_row_base(cur.pm) * lda * 2 : (size_t)cur.pm * tstepA); const char* cB = (const char*)g.Bt + (size_t)cur.pn * tstepB;
    S.a_ready(cur);
    if constexpr (Epi::PREFETCH) E.prefetch(cur, wid, lane);
    if constexpr (SP2) {
        PG8_STAGE(PG8_SB(0, 0), cB, voffB); PG8_STAGE(PG8_SB(0, 1), cB + hstepB, voffB); PG8_STAGE(PG8_SA(0, 0), cA, voffA); PG8_STAGE(PG8_SA(0, 1), cA + hstepA, voffA);
        if (wr == 1) PG8_BAR;
        PG8_WAIT_V(2); PG8_BAR;
        PG8_STAGE(PG8_SB(1, 0), cB + kstep, voffB); PG8_STAGE(PG8_SA(1, 0), cA + kstep, voffA); PG8_STAGE(PG8_SB(1, 1), cB + hstepB + kstep, voffB);
        PG8_WAIT_V(6); PG8_BAR;
    } else {
        PG8_STAGE(PG8_SB(0, 0), cB, voffB); PG8_STAGE(PG8_SA(0, 0), cA, voffA); PG8_STAGE(PG8_SB(0, 1), cB + hstepB, voffB); PG8_STAGE(PG8_SA(0, 1), cA + hstepA, voffA);
        if (wr == 1) PG8_BAR;
        PG8_WAIT_V(4); PG8_BAR;
        PG8_STAGE(PG8_SB(1, 0), cB + kstep, voffB); PG8_STAGE(PG8_SA(1, 0), cA + kstep, voffA); PG8_STAGE(PG8_SB(1, 1), cB + hstepB + kstep, voffB);
        PG8_WAIT_V(6); PG8_BAR;
    }
    for (;;) {
        const bool has_next = S.next(ui + 1, nxt);
        const char* nA = has_next ? (const char*)g.A + (g.ovl ? (size_t)ovl_row_base(nxt.pm) * lda * 2 : (size_t)nxt.pm * tstepA) : cA; const char* nB = has_next ? (const char*)g.Bt + (size_t)nxt.pn * tstepB : cB;
        for (int t = 0; t < nt; t += 2) {
            const bool last = (t == nt - 2);
            const char* a1 = cA + (size_t)(t + 1) * kstep;
            const char* a2 = last ? nA : cA + (size_t)(t + 2) * kstep; const char* b2 = last ? nB : cB + (size_t)(t + 2) * kstep;
            const char* a3 = a2 + kstep; const char* b3 = b2 + kstep;
            if (last && has_next) S.a_ready(nxt);
            if constexpr (Epi::MIDK) { if (t == Epi::MIDK_T) E.midk(acc, cur, wr, fr, fq); }
            if constexpr (SP2) {
            PG8_LDB(B0, 0, 0); PG8_LDB(B1, 0, 1); PG8_SCHED; PG8_LDA(At, 0, 0); PG8_STAGE(PG8_SA(1, 1), a1 + hstepA, voffA);
            PG8_WAIT_V(8); PG8_WAIT_L(0); PG8_BAR; PG8_MMA(0, 0, At, B0); PG8_MMA(0, 1, At, B1); PG8_BAR; PG8_SCHED;
            PG8_LDA(At, 0, 1); PG8_STAGE(PG8_SB(0, 0), b2, voffB); PG8_STAGE(PG8_SB(0, 1), b2 + hstepB, voffB); PG8_STAGE(PG8_SA(0, 0), a2, voffA);
            PG8_WAIT_V(8); PG8_WAIT_L(0); PG8_BAR; PG8_MMA(1, 0, At, B0); PG8_MMA(1, 1, At, B1); PG8_BAR; PG8_SCHED;
            PG8_LDB(B0, 1, 0); PG8_LDB(B1, 1, 1); PG8_SCHED; PG8_LDA(At, 1, 0); PG8_STAGE(PG8_SA(0, 1), a2 + hstepA, voffA);
            PG8_WAIT_V(8); PG8_WAIT_L(0); PG8_BAR; PG8_MMA(0, 0, At, B0); PG8_MMA(0, 1, At, B1); PG8_BAR; PG8_SCHED;
            PG8_LDA(At, 1, 1); PG8_STAGE(PG8_SB(1, 0), b3, voffB); PG8_STAGE(PG8_SB(1, 1), b3 + hstepB, voffB); PG8_STAGE(PG8_SA(1, 0), a3, voffA);
            PG8_WAIT_V(8); PG8_WAIT_L(0); PG8_BAR; PG8_MMA(1, 0, At, B0); PG8_MMA(1, 1, At, B1); PG8_BAR; PG8_SCHED;
            } else {
            PG8_LDB(B0, 0, 0); PG8_SCHED; PG8_LDA(At, 0, 0); PG8_STAGE(PG8_SA(1, 1), a1 + hstepA, voffA);
            PG8_WAIT_L(8); PG8_BAR; PG8_WAIT_L(0); PG8_MMA(0, 0, At, B0); PG8_BAR; PG8_SCHED;
            PG8_LDB(B1, 0, 1); PG8_STAGE(PG8_SB(0, 0), b2, voffB);
            PG8_BAR; PG8_WAIT_L(0); PG8_MMA(0, 1, At, B1); PG8_BAR;
            PG8_LDA(At, 0, 1); PG8_STAGE(PG8_SA(0, 0), a2, voffA);
            PG8_BAR; PG8_WAIT_L(0); PG8_MMA(1, 0, At, B0); PG8_BAR; PG8_SCHED;
            PG8_STAGE(PG8_SB(0, 1), b2 + hstepB, voffB);
            PG8_WAIT_V(6); PG8_BAR; PG8_MMA(1, 1, At, B1); PG8_BAR;
            PG8_LDB(B0, 1, 0); PG8_SCHED; PG8_LDA(At, 1, 0); PG8_STAGE(PG8_SA(0, 1), a2 + hstepA, voffA);
            PG8_WAIT_L(8); PG8_BAR; PG8_WAIT_L(0); PG8_MMA(0, 0, At, B0); PG8_BAR; PG8_SCHED;
            PG8_LDB(B1, 1, 1); PG8_STAGE(PG8_SB(1, 0), b3, voffB);
            PG8_BAR; PG8_WAIT_L(0); PG8_MMA(0, 1, At, B1); PG8_BAR;
            PG8_LDA(At, 1, 1); PG8_STAGE(PG8_SA(1, 0), a3, voffA);
            PG8_BAR; PG8_WAIT_L(0); PG8_MMA(1, 0, At, B0); PG8_BAR; PG8_SCHED;
            PG8_STAGE(PG8_SB(1, 1), b3 + hstepB, voffB);
            PG8_WAIT_V(6); PG8_BAR; PG8_MMA(1, 1, At, B1); PG8_BAR;
            }
        }
        if constexpr (ALIGN_EPI) { if (wr == 0) PG8_BAR; }
        if constexpr (!Epi::AFTER_DRAIN) { E(acc, cur, wr, wc, fr, fq); S.done(cur); }
        if constexpr (Epi::PREFETCH) { if (has_next) E.prefetch(nxt, wid, lane); }
        if (!has_next) break;
#pragma unroll
        for (int a = 0; a < 2; ++a)
#pragma unroll
            for (int b = 0; b < 2; ++b)
#pragma unroll
                for (int m = 0; m < 4; ++m)
#pragma unroll
                    for (int n = 0; n < 2; ++n) acc[a][b][m][n] = (acc_t){0, 0, 0, 0};
        cur = nxt; cA = nA; cB = nB; ++ui;
        if constexpr (ALIGN_EPI) { if (wr == 1) PG8_BAR; }
    }
    PG8_WAIT_V(0);
    if constexpr (!ALIGN_EPI) { if (wr == 0) PG8_BAR; }
    PG8_BAR;
#undef PG8_SA
#undef PG8_SB
#undef PG8_STAGE
#undef PG8_LDA
#undef PG8_LDB
#undef PG8_MMA
#undef PG8_WAIT_V
#undef PG8_WAIT_L
#undef PG8_BAR
#undef PG8_SCHED
}
}

constexpr int NWAVES = 8;
#ifndef MK_ONE_LAUNCH
#define MK_ONE_LAUNCH 1
#endif
constexpr int N_PHASES = 11;

constexpr int BATCH = 8, SEQ = 4096, D = 1024, NH = 12, HD = 64, AW = 768, NG = 4, GD = 64, FW = 256, MIXW = 1024, NPROJ = 2560, FF = 2816;
constexpr int M = BATCH * SEQ;
constexpr float EPS = 1e-6f;

constexpr size_t MiB = 1u << 20;
constexpr size_t WS_CTL = 0, CTL_ZERO_BYTES = 96 * 1024;
constexpr size_t WS_TAB = 1 * MiB;
constexpr size_t TAB_BIAS = 0;
constexpr size_t TAB_MG = 32 * 1024;
constexpr size_t TAB_TW = 192 * 1024;
constexpr size_t TAB_CW4 = 256 * 1024;
constexpr size_t WS_WIN = 2 * MiB;
constexpr size_t WS_WOUT = 7 * MiB;
constexpr size_t WS_WGV = 9 * MiB;
constexpr size_t WS_WD = 20 * MiB;
constexpr size_t WS_XN = 26 * MiB;
constexpr size_t WS_PROJ = 90 * MiB;
constexpr size_t WS_A2 = 250 * MiB;
constexpr size_t WS_PQ = 314 * MiB;
constexpr size_t WS_ML = 380 * MiB;
constexpr size_t WS_A8 = 314 * MiB;
constexpr size_t WS_HALO = 400 * MiB;
constexpr size_t WS_RS0 = 441 * MiB;
constexpr size_t WS_XBUF = 440 * MiB;
constexpr size_t WS_SSA = 446 * MiB;
constexpr size_t WS_SS1 = 442 * MiB;
constexpr size_t WS_SS2 = 444 * MiB;
constexpr size_t WS_GV = 90 * MiB;
constexpr size_t WS_END = 448 * MiB;
constexpr int CW_BAR = 1024, CW_PANEL = 8192, CW_PANEL2 = 16384;

constexpr int RING_OFF = 0, RING_BYTES = 131072;
constexpr int LDSCTL_OFF = RING_BYTES, MISC_OFF = LDSCTL_OFF + 320;
constexpr int LDS_BYTES = 163840;

#define GAS __attribute__((address_space(1)))
#define LAS __attribute__((address_space(3)))
typedef unsigned short bf16;
typedef unsigned v4u __attribute__((ext_vector_type(4)));
typedef unsigned v2u __attribute__((ext_vector_type(2)));
typedef float f32x4 __attribute__((ext_vector_type(4)));
typedef GAS unsigned gu32;
#define RLX_AGENT __ATOMIC_RELAXED, __HIP_MEMORY_SCOPE_AGENT
#define LDS_WAIT() asm volatile("s_waitcnt lgkmcnt(0)" ::: "memory")
#define VM_WAIT() asm volatile("s_waitcnt vmcnt(0)" ::: "memory")
__device__ __forceinline__ unsigned f2bf(float f) { unsigned u = __builtin_bit_cast(unsigned, f); return (u + 0x7fffu + ((u >> 16) & 1u)) >> 16; }
__device__ __forceinline__ unsigned pk2(float lo, float hi) { typedef float f2_t __attribute__((ext_vector_type(2))); typedef __bf16 b2_t __attribute__((ext_vector_type(2))); f2_t v = {lo, hi}; b2_t b = __builtin_convertvector(v, b2_t); return __builtin_bit_cast(unsigned, b); }
__device__ __forceinline__ float bflo(unsigned w) { return __builtin_bit_cast(float, w << 16); }
__device__ __forceinline__ float bfhi(unsigned w) { return __builtin_bit_cast(float, w & 0xffff0000u); }
__device__ __forceinline__ float bf2f(bf16 h) { return __builtin_bit_cast(float, (unsigned)h << 16); }

#define XB_TMO      128
#define XB_XCNT(j)  (256  + 64 * (j))
#define XB_XSUB(j)  (1280 + 64 * (j))
#define XB_XGEN(j)  (2304 + 64 * (j))
#define XB_TOP      3328
#define XB_TOPGEN   3392
#define XCD_BAR_WORDS 3456
#define XB_SPIN_CAP (1u << 18)
__device__ __forceinline__ unsigned xb_ld(unsigned* p)              { return __hip_atomic_load(p, __ATOMIC_RELAXED, __HIP_MEMORY_SCOPE_AGENT); }
__device__ __forceinline__ unsigned xb_add(unsigned* p, unsigned v) { return __hip_atomic_fetch_add(p, v, __ATOMIC_RELAXED, __HIP_MEMORY_SCOPE_AGENT); }
__device__ __forceinline__ unsigned xb_xcc_id() { return (unsigned)__builtin_amdgcn_s_getreg((3 << 11) | 20) & 0xFu; }
#define XB_SPIN(cond, bar) do { unsigned _sp = 0; while (cond) { __builtin_amdgcn_s_sleep(1); \
    if ((++_sp & 255u) == 0u) { if (xb_ld(&(bar)[XB_TMO])) break; if (_sp > XB_SPIN_CAP) { atomicAdd(&(bar)[XB_TMO], 1u); break; } } } } while (0)
struct XcdBarrier { unsigned* bar; unsigned x; volatile LAS unsigned* st; };
__device__ __forceinline__ XcdBarrier xcd_barrier_post(unsigned* bar, volatile LAS unsigned* st) {
    XcdBarrier b; b.bar = bar; b.x = xb_xcc_id(); b.st = st;
    if (threadIdx.x == 0) (void)xb_add(&bar[XB_XCNT(b.x)], 1u);
    return b;
}
__device__ __forceinline__ void xcd_barrier_complete(unsigned* bar, unsigned x, unsigned& nloc, unsigned& nx) {
    const unsigned G = gridDim.x * gridDim.y * gridDim.z;
    unsigned sum, cnt, mine, sp = 0u;
    for (;;) {
        sum = 0u; cnt = 0u; mine = 0u;
#pragma unroll
        for (unsigned j = 0; j < 16; ++j) { const unsigned c = xb_ld(&bar[XB_XCNT(j)]); sum += c; cnt += (c > 0u) ? 1u : 0u; mine = (j == x) ? c : mine; }
        if (sum == G) break;
        __builtin_amdgcn_s_sleep(1);
        if ((++sp & 255u) == 0u) { if (xb_ld(&bar[XB_TMO])) break; if (sp > XB_SPIN_CAP) { atomicAdd(&bar[XB_TMO], 1u); break; } }
    }
    nloc = mine > 0u ? mine : 1u; nx = cnt > 0u ? cnt : 1u;
}
__device__ __forceinline__ void xcd_barrier(const XcdBarrier& b) {
    asm volatile("s_waitcnt vmcnt(0)" ::: "memory");
    __syncthreads();
    if (threadIdx.x == 0) {
        unsigned* bar = b.bar;
        __builtin_amdgcn_s_waitcnt(0);
        unsigned nloc = b.st[0], nx = b.st[1];
        if (nloc == 0u) { xcd_barrier_complete(bar, b.x, nloc, nx); b.st[0] = nloc; b.st[1] = nx; }
        const unsigned old = xb_add(&bar[XB_XSUB(b.x)], 1u);
        const unsigned gen = old / nloc;
        if (old + 1u == (gen + 1u) * nloc) {
            __builtin_amdgcn_fence(__ATOMIC_RELEASE, "agent");
            asm volatile("s_waitcnt vmcnt(0)" ::: "memory");
            const unsigned og = xb_add(&bar[XB_TOP], 1u);
            const unsigned tg = og / nx;
            if (og + 1u == (tg + 1u) * nx) xb_add(&bar[XB_TOPGEN], 1u);
            else XB_SPIN(xb_ld(&bar[XB_TOPGEN]) == tg, bar);
            __builtin_amdgcn_fence(__ATOMIC_ACQUIRE, "agent");
            xb_add(&bar[XB_XGEN(b.x)], 1u);
            asm volatile("s_waitcnt vmcnt(0)" ::: "memory");
        } else {
            XB_SPIN(xb_ld(&bar[XB_XGEN(b.x)]) == gen, bar);
            __builtin_amdgcn_fence(__ATOMIC_ACQUIRE, "agent");
            asm volatile("s_waitcnt vmcnt(0)" ::: "memory");
        }
    }
    __syncthreads();
}

struct Frame {
    LAS unsigned char* lds;
    volatile LAS unsigned* MISC;
    gu32* ctl;
    int tid, lane, wave;
    int vcu, G;
    const float *x, *g_mix, *w_in, *g_attn, *rel_tab, *f_w, *f_b, *g_four, *w_out, *g_ffn, *w_gate, *w_val, *conv_w, *conv_b, *w_down, *g_fin;
    float* out;
    unsigned char* ws;
};

__device__ __forceinline__ float wave_sum(float v) {
#pragma unroll
    for (int o = 1; o < 64; o <<= 1) v += __shfl_xor(v, o);
    return v;
}
__device__ __forceinline__ void p0_transpose_item(const float* W, int K, int N, bf16* WT, int row_off, LAS float* scr, int item, int lane, const float* gain = nullptr, bool il = false) {
    const int nblk = N / 32, kb = item / nblk, nb = item % nblk, k0 = 64 * kb, n0 = 32 * nb; if (il) row_off += 128 * (n0 >> 7);
    {   f32x4 v[8]; const int c4 = 4 * (lane & 7);
#pragma unroll
        for (int i = 0; i < 8; ++i) v[i] = __builtin_nontemporal_load((const GAS f32x4*)(W + (size_t)(k0 + (lane >> 3) + 8 * i) * N + n0 + c4));
#pragma unroll
        for (int i = 0; i < 8; ++i) { const int kk = (lane >> 3) + 8 * i; const float gsc = gain ? gain[k0 + kk] : 1.0f; LAS float* sp = scr + kk * 33 + c4;
            sp[0] = v[i].x * gsc; sp[1] = v[i].y * gsc; sp[2] = v[i].z * gsc; sp[3] = v[i].w * gsc; } }
    LDS_WAIT(); asm volatile("" ::: "memory");
    const int c = lane & 7;
#pragma unroll
    for (int j = 0; j < 4; ++j) { const int n = (lane >> 3) + 8 * j; const LAS float* s = scr + (8 * c) * 33 + n;
        v4u o; o.x = pk2(s[0 * 33], s[1 * 33]); o.y = pk2(s[2 * 33], s[3 * 33]); o.z = pk2(s[4 * 33], s[5 * 33]); o.w = pk2(s[6 * 33], s[7 * 33]);
        *(GAS v4u*)(WT + (size_t)(row_off + n0 + n) * K + k0 + 8 * c) = o; }
    LDS_WAIT(); asm volatile("" ::: "memory");
}

__device__ __forceinline__ void p0_quant_strip(Frame& F, const float* W, int N, unsigned char* WT, bool isv, int nb, const float* gain, float* cw6) {
    const int lane = F.lane, w = F.wave, n0 = 32 * nb, c4 = 4 * (lane & 7), K = D; const int row_off = (isv ? 128 : 0) + 128 * (n0 >> 7);
    LAS float* scr = (LAS float*)(F.lds + RING_OFF + w * 16384); LAS float* cmw = (LAS float*)(F.lds + RING_OFF + 8 * 16384 - 2048); LAS float* cmf = cmw + 256;
    f32x4 v[2][8]; f32x4 mx = (f32x4){0.f, 0.f, 0.f, 0.f};
#pragma unroll
    for (int blk = 0; blk < 2; ++blk)
#pragma unroll
        for (int i = 0; i < 8; ++i) v[blk][i] = __builtin_nontemporal_load((const GAS f32x4*)(W + (size_t)(128 * w + 64 * blk + (lane >> 3) + 8 * i) * N + n0 + c4));
#pragma unroll
    for (int blk = 0; blk < 2; ++blk)
#pragma unroll
        for (int i = 0; i < 8; ++i) { v[blk][i] = v[blk][i] * gain[128 * w + 64 * blk + (lane >> 3) + 8 * i];
            mx[0] = fmaxf(mx[0], fabsf(v[blk][i][0])); mx[1] = fmaxf(mx[1], fabsf(v[blk][i][1])); mx[2] = fmaxf(mx[2], fabsf(v[blk][i][2])); mx[3] = fmaxf(mx[3], fabsf(v[blk][i][3])); }
#pragma unroll
    for (int j = 0; j < 4; ++j) { float t = mx[j]; t = fmaxf(t, __shfl_xor(t, 8)); t = fmaxf(t, __shfl_xor(t, 16)); t = fmaxf(t, __shfl_xor(t, 32)); mx[j] = t; }
    if (lane < 8) *(LAS f32x4*)(cmw + w * 32 + c4) = mx;
    __syncthreads();
    if (F.tid < 32) { float t = cmw[F.tid];
#pragma unroll
        for (int ww = 1; ww < 8; ++ww) t = fmaxf(t, cmw[ww * 32 + F.tid]);
        cmf[F.tid] = t; const int nn = n0 + F.tid; cw6[(nn >> 7) * 768 + (isv ? 5 : 4) * 128 + (nn & 127)] = t * (1.0f / 127.0f); }
    __syncthreads();
#pragma unroll
    for (int blk = 0; blk < 2; ++blk) { const int k0 = 128 * w + 64 * blk;
#pragma unroll
        for (int i = 0; i < 8; ++i) { const int kk = (lane >> 3) + 8 * i; LAS float* sp = scr + kk * 33 + c4; sp[0] = v[blk][i][0]; sp[1] = v[blk][i][1]; sp[2] = v[blk][i][2]; sp[3] = v[blk][i][3]; }
        LDS_WAIT(); asm volatile("" ::: "memory");
        const int c = lane & 7;
#pragma unroll
        for (int j = 0; j < 4; ++j) { const int n = (lane >> 3) + 8 * j; const LAS float* sq = scr + (8 * c) * 33 + n; const float cm = cmf[n]; const float inv = cm > 0.f ? 127.0f / cm : 0.f;
            unsigned lo = 0, hi = 0;
#pragma unroll
            for (int t = 0; t < 4; ++t) { lo |= ((unsigned)(int)__builtin_rintf(sq[t * 33] * inv) & 255u) << (8 * t); hi |= ((unsigned)(int)__builtin_rintf(sq[(4 + t) * 33] * inv) & 255u) << (8 * t); }
            v2u o; o.x = lo; o.y = hi; *(GAS v2u*)(WT + (size_t)(row_off + n0 + n) * K + k0 + 8 * c) = o; }
        LDS_WAIT(); asm volatile("" ::: "memory"); }
    __syncthreads();
}
__device__ __forceinline__ void rms_row_to_bf16(const float* xrow, const float* gain, bf16* orow, int lane) {
    const GAS f32x4* xr = (const GAS f32x4*)xrow + lane; const GAS f32x4* gr = (const GAS f32x4*)gain + lane;
    f32x4 v[4]; float s = 0.f;
#pragma unroll
    for (int j = 0; j < 4; ++j) { v[j] = xr[64 * j]; s += (v[j].x * v[j].x + v[j].y * v[j].y) + (v[j].z * v[j].z + v[j].w * v[j].w); }
    const float rstd = 1.0f / sqrtf(wave_sum(s) * (1.f / D) + EPS);
    GAS unsigned long long* o8 = (GAS unsigned long long*)orow + lane;
#pragma unroll
    for (int j = 0; j < 4; ++j) { const f32x4 gg = gr[64 * j]; o8[64 * j] = (unsigned long long)pk2(v[j].x * rstd * gg.x, v[j].y * rstd * gg.y) | ((unsigned long long)pk2(v[j].z * rstd * gg.z, v[j].w * rstd * gg.w) << 32); }
}
__device__ __forceinline__ int t5_bucket(int rel) {
    const int ret = rel > 0 ? 16 : 0; const int n = rel < 0 ? -rel : rel;
    const float nf = (float)(n > 1 ? n : 1);
    int large = 8 + (int)(logf(nf / 8.0f) / logf(128.0f) * 8.0f);
    large = large < 15 ? large : 15;
    return ret + (n < 8 ? n : large);
}

__device__ __forceinline__ void p0_prologue(Frame& F) {
    LAS float* scr = (LAS float*)(F.lds + RING_OFF + F.wave * 16384);
    const int gw = F.vcu * NWAVES + F.wave, NGW = F.G * NWAVES;
    bf16* WinT = (bf16*)(F.ws + WS_WIN); bf16* WoutT = (bf16*)(F.ws + WS_WOUT); bf16* WgvT = (bf16*)(F.ws + WS_WGV); bf16* WdT = (bf16*)(F.ws + WS_WD);
    constexpr int I_IN = (D / 64) * (NPROJ / 32), I_OUT = (MIXW / 64) * (D / 32), I_D = (FF / 64) * (D / 32), NSTRIP = FF / 32;
    constexpr int NITEMS = I_IN + I_OUT + I_D;
    float* cw6 = (float*)(F.ws + WS_TAB + TAB_CW4);
    for (int sj = F.vcu; sj < 2 * NSTRIP; sj += F.G) { const bool isv = sj >= NSTRIP; p0_quant_strip(F, isv ? F.w_val : F.w_gate, FF, F.ws + WS_WGV, isv, isv ? sj - NSTRIP : sj, F.g_ffn, cw6); }
    for (int it = gw; it < NITEMS; it += NGW) {
        int r = it;
        if (r < I_IN) { p0_transpose_item(F.w_in, D, NPROJ, WinT, 0, scr, r, F.lane, F.g_mix); continue; } r -= I_IN;
        if (r < I_OUT) { const int k0 = 64 * (r / (D / 32)); p0_transpose_item(F.w_out, MIXW, D, WoutT, 0, scr, r, F.lane, k0 < AW ? F.g_attn : F.g_four - AW); continue; } r -= I_OUT;
        p0_transpose_item(F.w_down, FF, D, WdT, 0, scr, r, F.lane);
    }
    float* tabBias = (float*)(F.ws + WS_TAB + TAB_BIAS); float* tabMg = (float*)(F.ws + WS_TAB + TAB_MG); float* tabTw = (float*)(F.ws + WS_TAB + TAB_TW);
    const int gt = F.vcu * (NWAVES * 64) + F.tid, NGT = F.G * NWAVES * 64;
    for (int i = gt; i < 3 * 129 * 12; i += NGT) { const int h = i % 12, jj = (i / 12) % 129, br = i / (12 * 129); const int dil = br == 0 ? 1 : (br == 1 ? 4 : 16);
        tabBias[i] = F.rel_tab[t5_bucket((jj - 64) * dil) * 12 + h]; }
    for (int i = gt; i < 4 * 64 * 128; i += NGT) { const int col = i & 127, c = (i >> 7) & 63, g = i >> 13; const int e = col & 63; float acc = 0.f;
        for (int d = 0; d < 64; ++d) { const float rev = (float)((c * d) & 63) * (1.0f / 64.0f); const float t = col < 64 ? __builtin_amdgcn_cosf(rev) : -__builtin_amdgcn_sinf(rev); acc += t * F.f_w[(g * 64 + d) * 64 + e]; }
        tabMg[i] = acc; }
    for (int i = gt; i < (FF / 128) * 512; i += NGT) { const int pn = i >> 9, k = (i >> 7) & 3, c = i & 127, ch = 128 * pn + c; cw6[pn * 768 + k * 128 + c] = k < 3 ? F.conv_w[k * FF + ch] : F.conv_b[ch]; }
    for (int i = gt; i < 4096; i += NGT) { float sv, cv; sincospif((float)i * (1.0f / 2048.0f), &sv, &cv); tabTw[2 * i] = cv; tabTw[2 * i + 1] = sv; }
    bf16* XN = (bf16*)(F.ws + WS_XN);
    {   float* RS0 = (float*)(F.ws + WS_RS0);
        for (int m0 = gw; m0 < M; m0 += 4 * NGW) { f32x4 v[4][4];
#pragma unroll
            for (int r = 0; r < 4; ++r) { const int m = m0 + r * NGW; const GAS f32x4* xr = (const GAS f32x4*)(F.x + (size_t)(m < M ? m : 0) * D) + F.lane;
#pragma unroll
                for (int j = 0; j < 4; ++j) v[r][j] = __builtin_nontemporal_load(xr + 64 * j); }
#pragma unroll
            for (int r = 0; r < 4; ++r) { const int m = m0 + r * NGW; float s = 0.f;
#pragma unroll
                for (int j = 0; j < 4; ++j) s += (v[r][j].x * v[r][j].x + v[r][j].y * v[r][j].y) + (v[r][j].z * v[r][j].z + v[r][j].w * v[r][j].w);
                const float rstd = 1.0f / sqrtf(wave_sum(s) * (1.f / D) + EPS);
                if (m < M) { GAS unsigned long long* o8 = (GAS unsigned long long*)(XN + (size_t)m * D) + F.lane; if (F.lane == 0) RS0[m] = rstd;
#pragma unroll
                    for (int j = 0; j < 4; ++j) { const f32x4 t = v[r][j]; o8[64 * j] = (unsigned long long)pk2(t.x, t.y) | ((unsigned long long)pk2(t.z, t.w) << 32); } } } } }
}

namespace att {
typedef short bf16x8 __attribute__((ext_vector_type(8)));
typedef short v4i16 __attribute__((ext_vector_type(4)));
constexpr float LOG2E = 1.4426950408889634f;
constexpr int TABN = 512, TPAD0 = 128;
constexpr int LDS_K = 0, LDS_V = 49152, LDS_T0 = 98304, LDS_T1 = 98304 + 8192;
struct QT { bf16x8 q[2]; f32x4 o[4]; float m, l; };
__device__ __forceinline__ v4i16 vtr(const LAS unsigned char* p) { return __builtin_amdgcn_ds_read_tr16_b64_v4i16((LAS v4i16*)p); }

__device__ __forceinline__ void build_table(Frame& F, int ldsoff, int br, int h) {
    const float* tabBias = (const float*)(F.ws + WS_TAB + TAB_BIAS);
    LAS float* T = (LAS float*)(F.lds + ldsoff);
    for (int e = F.tid; e < 4 * TABN; e += NWAVES * 64) { const int s = e / TABN, n = e % TABN; const int r64 = n + s - TPAD0;
        T[e] = (r64 >= 0 && r64 <= 128) ? tabBias[(br * 129 + r64) * 12 + h] * LOG2E : -INFINITY; }
}
__device__ __forceinline__ const LAS float* table_ptr(Frame& F, int ldsoff, int idx0) { const int s = idx0 & 3; return (const LAS float*)(F.lds + ldsoff) + s * TABN + (idx0 - s); }

__device__ __forceinline__ int pass_tok(int mode, int a, int row) {
    if (mode == 0) { const int t = a - 64 + row; return (t >= 0 && t < SEQ) ? t : -1; }
    if (mode == 3) return a + 16 * row;
    const int hi = row >= 192 ? 1 : 0, u = a + (hi ? row - 192 : row), c = 2 * (mode - 1) + hi; return (u >= 0 && u < SEQ / 4) ? c + 4 * u : -1;
}
struct Pre { v4u k[6], v[6]; };
template <int NIT> __device__ __forceinline__ void prefetch(Frame& F, Pre& R, const bf16* P, int h, int mode, int a) {
#pragma unroll
    for (int it = 0; it < NIT; ++it) { const int idx = F.tid + it * (NWAVES * 64), row = idx >> 3, ph = idx & 7; const int t = pass_tok(mode, a, row);
        const int ck = ph ^ ((row >> 1) & 7), cv = ph ^ (((row >> 1) & 3) << 1);
        R.k[it] = (v4u){0u, 0u, 0u, 0u}; R.v[it] = (v4u){0u, 0u, 0u, 0u};
        if (t >= 0) { const bf16* rp = P + (size_t)t * NPROJ + h * 64; R.k[it] = *(const GAS v4u*)(rp + AW + ck * 8); R.v[it] = *(const GAS v4u*)(rp + 2 * AW + cv * 8); } }
}
template <int NIT> __device__ __forceinline__ void commit(Frame& F, const Pre& R) {
#pragma unroll
    for (int it = 0; it < NIT; ++it) { const int idx = F.tid + it * (NWAVES * 64);
        *(LAS v4u*)(F.lds + LDS_K + idx * 16) = R.k[it]; *(LAS v4u*)(F.lds + LDS_V + idx * 16) = R.v[it]; }
}
__device__ __forceinline__ float xmax4(float v) {
    auto a = __builtin_amdgcn_permlane16_swap(__float_as_uint(v), __float_as_uint(v), false, false); v = fmaxf(__uint_as_float(a[0]), __uint_as_float(a[1]));
    auto b = __builtin_amdgcn_permlane32_swap(__float_as_uint(v), __float_as_uint(v), false, false); return fmaxf(__uint_as_float(b[0]), __uint_as_float(b[1]));
}
__device__ __forceinline__ float xsum4(float v) {
    auto a = __builtin_amdgcn_permlane16_swap(__float_as_uint(v), __float_as_uint(v), false, false); v = __uint_as_float(a[0]) + __uint_as_float(a[1]);
    auto b = __builtin_amdgcn_permlane32_swap(__float_as_uint(v), __float_as_uint(v), false, false); return __uint_as_float(b[0]) + __uint_as_float(b[1]);
}
__device__ __forceinline__ void load_q(QT& T, const bf16* qrow  , int g) {
#pragma unroll
    for (int ks = 0; ks < 2; ++ks) { const v4u w = *(const GAS v4u*)(qrow + 8 * g + 32 * ks); const float sc = 0.125f * LOG2E; v4u o;
        o.x = pk2(bflo(w.x) * sc, bfhi(w.x) * sc); o.y = pk2(bflo(w.y) * sc, bfhi(w.y) * sc); o.z = pk2(bflo(w.z) * sc, bfhi(w.z) * sc); o.w = pk2(bflo(w.w) * sc, bfhi(w.w) * sc);
        T.q[ks] = __builtin_bit_cast(bf16x8, o); }
#pragma unroll
    for (int db = 0; db < 4; ++db) T.o[db] = (f32x4){0.f, 0.f, 0.f, 0.f};
    T.m = -1e30f; T.l = 0.f;
}
typedef float f32x2_t __attribute__((ext_vector_type(2))); typedef __bf16 bf16x2_t __attribute__((ext_vector_type(2)));
__device__ __forceinline__ unsigned cvtpk(float lo, float hi) { f32x2_t v = {lo, hi}; bf16x2_t b = __builtin_convertvector(v, bf16x2_t); return __builtin_bit_cast(unsigned, b); }
constexpr float THR = 8.0f;
template <int NQ, int NP> __device__ __forceinline__ void attn_step(QT (&T)[NQ], const LAS unsigned char* kp, const LAS unsigned char* vp, const LAS float* const (&tp)[NQ], int p, int koff0, int koff1, const int (&voff)[4], int klo, int khi, bool edge, int g) {
    bf16x8 kf[NP][4]; v4i16 vlo[NP][4], vhi[NP][4];
#pragma unroll
    for (int c = 0; c < NP; ++c) { kf[c][0] = *(const LAS bf16x8*)(kp + c * 4096 + koff0); kf[c][1] = *(const LAS bf16x8*)(kp + c * 4096 + koff1); kf[c][2] = *(const LAS bf16x8*)(kp + c * 4096 + 2048 + koff0); kf[c][3] = *(const LAS bf16x8*)(kp + c * 4096 + 2048 + koff1);
#pragma unroll
        for (int db = 0; db < 4; ++db) { vlo[c][db] = vtr(vp + c * 4096 + voff[db]); vhi[c][db] = vtr(vp + c * 4096 + 2048 + voff[db]); } }
#pragma unroll
    for (int n = 0; n < NQ; ++n) {
        f32x4 s[NP][2];
#pragma unroll
        for (int c = 0; c < NP; ++c) {
            s[c][0] = *(const LAS f32x4*)(tp[n] + (p + c) * 32); s[c][1] = *(const LAS f32x4*)(tp[n] + (p + c) * 32 + 16);
            s[c][0] = __builtin_amdgcn_mfma_f32_16x16x32_bf16(kf[c][0], T[n].q[0], s[c][0], 0, 0, 0); s[c][0] = __builtin_amdgcn_mfma_f32_16x16x32_bf16(kf[c][1], T[n].q[1], s[c][0], 0, 0, 0);
            s[c][1] = __builtin_amdgcn_mfma_f32_16x16x32_bf16(kf[c][2], T[n].q[0], s[c][1], 0, 0, 0); s[c][1] = __builtin_amdgcn_mfma_f32_16x16x32_bf16(kf[c][3], T[n].q[1], s[c][1], 0, 0, 0);
            if (edge) { const int kk = (p + c) * 32 + 4 * g;
#pragma unroll
                for (int r = 0; r < 4; ++r) { if (kk + r < klo || kk + r >= khi) s[c][0][r] = -INFINITY; if (kk + 16 + r < klo || kk + 16 + r >= khi) s[c][1][r] = -INFINITY; } } }
        float tm = fmaxf(fmaxf(fmaxf(s[0][0][0], s[0][0][1]), fmaxf(s[0][0][2], s[0][0][3])), fmaxf(fmaxf(s[0][1][0], s[0][1][1]), fmaxf(s[0][1][2], s[0][1][3])));
        if (NP == 2) tm = fmaxf(tm, fmaxf(fmaxf(fmaxf(s[NP - 1][0][0], s[NP - 1][0][1]), fmaxf(s[NP - 1][0][2], s[NP - 1][0][3])), fmaxf(fmaxf(s[NP - 1][1][0], s[NP - 1][1][1]), fmaxf(s[NP - 1][1][2], s[NP - 1][1][3]))));
        tm = xmax4(tm);
        if (__any(tm > T[n].m + THR)) { const float mn = fmaxf(T[n].m, tm), al = __builtin_amdgcn_exp2f(T[n].m - mn); T[n].m = mn; T[n].l *= al;
#pragma unroll
            for (int db = 0; db < 4; ++db) T[n].o[db] = T[n].o[db] * al; }
        const float mref = T[n].m; float ls = 0.f;
#pragma unroll
        for (int c = 0; c < NP; ++c) {
#pragma unroll
            for (int r = 0; r < 4; ++r) { s[c][0][r] = __builtin_amdgcn_exp2f(s[c][0][r] - mref); s[c][1][r] = __builtin_amdgcn_exp2f(s[c][1][r] - mref); }
            ls += ((s[c][0][0] + s[c][0][1]) + (s[c][0][2] + s[c][0][3])) + ((s[c][1][0] + s[c][1][1]) + (s[c][1][2] + s[c][1][3])); }
        T[n].l += ls;
#pragma unroll
        for (int c = 0; c < NP; ++c) {
            v4u pw; pw.x = cvtpk(s[c][0][0], s[c][0][1]); pw.y = cvtpk(s[c][0][2], s[c][0][3]); pw.z = cvtpk(s[c][1][0], s[c][1][1]); pw.w = cvtpk(s[c][1][2], s[c][1][3]);
            const bf16x8 pf = __builtin_bit_cast(bf16x8, pw);
#pragma unroll
            for (int db = 0; db < 4; ++db) { const bf16x8 vf = (bf16x8){vlo[c][db][0], vlo[c][db][1], vlo[c][db][2], vlo[c][db][3], vhi[c][db][0], vhi[c][db][1], vhi[c][db][2], vhi[c][db][3]};
                T[n].o[db] = __builtin_amdgcn_mfma_f32_16x16x32_bf16(vf, pf, T[n].o[db], 0, 0, 0); } }
    }
}
template <int NQ> __device__ __forceinline__ void attn_job(QT (&T)[NQ], const LAS unsigned char* Kw, const LAS unsigned char* Vw, int npairs, const LAS float* const (&tp)[NQ], int klo, int khi, bool edge, int lane) {
    const int i = lane & 15, g = lane >> 4;
    const int koff0 = i * 128 + (((g) ^ (i >> 1)) << 4), koff1 = i * 128 + (((g + 4) ^ (i >> 1)) << 4);
    const int qq = i >> 2, pp = i & 3, vr = 4 * g + qq, fv = (vr >> 1) & 3;
    int voff[4];
#pragma unroll
    for (int db = 0; db < 4; ++db) voff[db] = vr * 128 + ((((db ^ fv) << 1) + (pp >> 1)) << 4) + (pp & 1) * 8;
    int p = 0;
    if (NQ == 1) {
#pragma unroll 1
        for (; p + 2 <= npairs; p += 2) attn_step<NQ, 2>(T, Kw + p * 4096, Vw + p * 4096, tp, p, koff0, koff1, voff, klo, khi, edge, g);
    }
#pragma unroll 1
    for (; p < npairs; ++p) attn_step<NQ, 1>(T, Kw + p * 4096, Vw + p * 4096, tp, p, koff0, koff1, voff, klo, khi, edge, g);
}
__device__ __forceinline__ void four_ssq(Frame& F) {
    const bf16* A2 = (const bf16*)(F.ws + WS_A2); float* SSA = (float*)(F.ws + WS_SSA);
    const int gw = F.vcu * NWAVES + F.wave, NGW = F.G * NWAVES;
    for (int m0 = gw; m0 < M; m0 += 4 * NGW) { v2u w[4];
#pragma unroll
        for (int r = 0; r < 4; ++r) { const int m = (m0 + r * NGW) < M ? (m0 + r * NGW) : 0; w[r] = *(const GAS v2u*)(A2 + (size_t)m * MIXW + AW + 4 * F.lane); }
#pragma unroll
        for (int r = 0; r < 4; ++r) { const int m = m0 + r * NGW; const float a = bflo(w[r].x), b2 = bfhi(w[r].x), c = bflo(w[r].y), d = bfhi(w[r].y);
            const float s = wave_sum((a * a + b2 * b2) + (c * c + d * d));
            if (m < M && F.lane == 0) *(GAS f32x4*)(SSA + (size_t)m * 16 + 12) = (f32x4){s, 0.f, 0.f, 0.f}; } }
}
__device__ __forceinline__ void phase_local(Frame& F) {
    constexpr int NU = BATCH * NH * 16; const int per = (NU + F.G - 1) / F.G, ub = F.vcu * per, ue = (ub + per) < NU ? (ub + per) : NU;
    const bf16* PROJ = (const bf16*)(F.ws + WS_PROJ); const int lane = F.lane, w = F.wave, i = lane & 15, g = lane >> 4;
    const int idx4 = w >> 1, rA = w & 1, rB = 2 + (w & 1);
    Pre R; int hprev = -1;
    __syncthreads();
    if (ub < ue) { const int bh = ub >> 4; prefetch<6>(F, R, PROJ + (size_t)(bh / NH) * SEQ * NPROJ, bh % NH, 0, (ub & 15) * 256); }
    for (int u = ub; u < ue; ++u) {
        const int bh = u >> 4, b = bh / NH, h = bh % NH, s0 = (u & 15) * 256;
        const bf16* P = PROJ + (size_t)b * SEQ * NPROJ; bf16* A2 = (bf16*)(F.ws + WS_A2) + (size_t)b * SEQ * MIXW; float* ML = (float*)(F.ws + WS_ML) + (size_t)b * SEQ * NH * 2;
        __syncthreads();
        commit<6>(F, R);
        if (h != hprev) { build_table(F, LDS_T0, 0, h); build_table(F, LDS_T1, 1, h); hprev = h; }
        __syncthreads();
        const int u0 = s0 / 4 - 64;
        QT T[2];
        const int tokA = s0 + rA + 4 * (16 * idx4 + i), tokB = s0 + rB + 4 * (16 * idx4 + i);
        load_q(T[0], P + (size_t)tokA * NPROJ + h * 64, g); load_q(T[1], P + (size_t)tokB * NPROJ + h * 64, g);
        asm volatile("" ::: "memory");
        prefetch<6>(F, R, P, h, 1, u0);
        {
            const LAS float* tp[2] = { table_ptr(F, LDS_T0, 4 * g - 4 * i - rA + TPAD0), table_ptr(F, LDS_T0, 4 * g - 4 * i - rB + TPAD0) };
            int klo = 64 - s0 - 64 * idx4; klo = klo > 0 ? klo : 0; int khi = SEQ + 64 - s0 - 64 * idx4; khi = khi < 192 ? khi : 192;
            attn_job<2>(T, F.lds + LDS_K + 64 * idx4 * 128, F.lds + LDS_V + 64 * idx4 * 128, 6, tp, klo, khi, (klo > 0 || khi < 192), lane);
        }
#pragma unroll
        for (int pass = 0; pass < 2; ++pass) {
            __syncthreads();
            commit<6>(F, R);
            __syncthreads();
            if (pass == 0) prefetch<6>(F, R, P, h, 2, u0);
            else if (u + 1 < ue) { const int bh2 = (u + 1) >> 4; prefetch<6>(F, R, PROJ + (size_t)(bh2 / NH) * SEQ * NPROJ, bh2 % NH, 0, ((u + 1) & 15) * 256); }
            const int cl = w & 1, lo = idx4 < 2 ? idx4 : 2;
            const LAS float* tp[1] = { table_ptr(F, LDS_T1, 4 * g - i + 16 * (lo - idx4) + TPAD0) };
            int klo = -(u0 + 16 * lo); klo = klo > 0 ? klo : 0; int khi = SEQ / 4 - (u0 + 16 * lo); khi = khi < 160 ? khi : 160;
            QT (&Tp)[1] = *(QT (*)[1])(&T[pass]);
            attn_job<1>(Tp, F.lds + LDS_K + (192 * cl + 16 * lo) * 128, F.lds + LDS_V + (192 * cl + 16 * lo) * 128, 5, tp, klo, khi, (klo > 0 || khi < 160), lane);
        }
#pragma unroll
        for (int n = 0; n < 2; ++n) {
            const float l = xsum4(T[n].l); const float inv = 1.0f / l; const int tok = n == 0 ? tokA : tokB;
#pragma unroll
            for (int db = 0; db < 4; ++db) { v2u o; o.x = pk2(T[n].o[db][0] * inv, T[n].o[db][1] * inv); o.y = pk2(T[n].o[db][2] * inv, T[n].o[db][3] * inv);
                *(GAS v2u*)(A2 + (size_t)tok * MIXW + h * 64 + 16 * db + 4 * g) = o; }
            if (g == 0) { float* mlp = ML + ((size_t)tok * NH + h) * 2; mlp[0] = T[n].m; mlp[1] = l; }
        }
    }
    __syncthreads();
}
__device__ __forceinline__ void phase_class(Frame& F) {
    four_ssq(F);
    constexpr int NU = BATCH * NH * 16; const int per = (NU + F.G - 1) / F.G, ub = F.vcu * per, ue = (ub + per) < NU ? (ub + per) : NU;
    const bf16* PROJ = (const bf16*)(F.ws + WS_PROJ); const int lane = F.lane, w = F.wave, i = lane & 15, g = lane >> 4; float* SSA = (float*)(F.ws + WS_SSA);
    Pre R; int hprev = -1;
    __syncthreads();
    if (ub < ue) { const int bh = ub >> 4; prefetch<4>(F, R, PROJ + (size_t)(bh / NH) * SEQ * NPROJ, bh % NH, 3, ub & 15); }
    for (int u = ub; u < ue; ++u) {
        const int bh = u >> 4, b = bh / NH, h = bh % NH, r = u & 15;
        const bf16* P = PROJ + (size_t)b * SEQ * NPROJ; bf16* A2 = (bf16*)(F.ws + WS_A2) + (size_t)b * SEQ * MIXW; const float* ML = (const float*)(F.ws + WS_ML) + (size_t)b * SEQ * NH * 2;
        __syncthreads();
        commit<4>(F, R);
        if (h != hprev) { build_table(F, LDS_T0, 2, h); hprev = h; }
        __syncthreads();
        QT T2[2]; float mlv[2], llv[2]; v2u pvv[2][4];
#pragma unroll
        for (int n = 0; n < 2; ++n) { const int qt = n == 0 ? (w < 7 ? w : 11) : (w < 4 ? w + 7 : (w < 7 ? w + 8 : 15)); const int tok = r + 16 * (16 * qt + i);
            load_q(T2[n], P + (size_t)tok * NPROJ + h * 64, g);
            const float* mlp = ML + ((size_t)tok * NH + h) * 2; mlv[n] = mlp[0]; llv[n] = mlp[1];
#pragma unroll
            for (int db = 0; db < 4; ++db) pvv[n][db] = *(const GAS v2u*)(A2 + (size_t)tok * MIXW + h * 64 + 16 * db + 4 * g); }
        asm volatile("" ::: "memory");
        if (u + 1 < ue) { const int bh2 = (u + 1) >> 4; prefetch<4>(F, R, PROJ + (size_t)(bh2 / NH) * SEQ * NPROJ, bh2 % NH, 3, (u + 1) & 15); }
#pragma unroll
        for (int n = 0; n < 2; ++n) {
            const int qt = n == 0 ? (w < 7 ? w : 11) : (w < 4 ? w + 7 : (w < 7 ? w + 8 : 15));
            int lo = qt - 4 > 0 ? qt - 4 : 0, hi = qt + 4 < 15 ? qt + 4 : 15; if (((hi - lo + 1) & 1) != 0) { if (hi < 15) ++hi; else --lo; }
            const int tok = r + 16 * (16 * qt + i);
            QT (&T)[1] = *(QT (*)[1])(&T2[n]);
            const LAS float* tp[1] = { table_ptr(F, LDS_T0, 4 * g - i + 16 * (lo - qt) + 64 + TPAD0) };
            attn_job<1>(T, F.lds + LDS_K + 16 * lo * 128, F.lds + LDS_V + 16 * lo * 128, (hi - lo + 1) >> 1, tp, 0, 1 << 20, false, lane);
            const float l16 = xsum4(T[0].l);
            const float ml = mlv[n], ll = llv[n];
            const float mm = fmaxf(ml, T[0].m), a = __builtin_amdgcn_exp2f(ml - mm) * ll, bb = __builtin_amdgcn_exp2f(T[0].m - mm), inv = 1.0f / (a + bb * l16); float sq = 0.f;
#pragma unroll
            for (int db = 0; db < 4; ++db) { GAS v2u* op = (GAS v2u*)(A2 + (size_t)tok * MIXW + h * 64 + 16 * db + 4 * g); const v2u pv = pvv[n][db]; v2u o;
                const float f0 = (bflo(pv.x) * a + T[0].o[db][0] * bb) * inv, f1 = (bfhi(pv.x) * a + T[0].o[db][1] * bb) * inv, f2 = (bflo(pv.y) * a + T[0].o[db][2] * bb) * inv, f3 = (bfhi(pv.y) * a + T[0].o[db][3] * bb) * inv;
                sq += (f0 * f0 + f1 * f1) + (f2 * f2 + f3 * f3); o.x = pk2(f0, f1); o.y = pk2(f2, f3);
                *op = o; }
            sq = xsum4(sq);
            if (g == 0) SSA[((size_t)b * SEQ + tok) * 16 + h] = sq;
        }
    }
    __syncthreads();
}
}


namespace fou {
typedef short bf16x8 __attribute__((ext_vector_type(8)));
typedef short v4i16 __attribute__((ext_vector_type(4)));
constexpr int LX = 0, LC = LDSCTL_OFF + 8192, LS = LDSCTL_OFF + 16384;
__device__ __forceinline__ int gsw(int s2) { const int pr = (s2 >> 1) & 7; return (pr & 4) | ((pr & 1) << 1) | ((pr >> 1) & 1); }
__device__ __forceinline__ int xaddr(int pe, int s2, int chunk) { return LX + pe * 8192 + s2 * 128 + (((chunk ^ gsw(s2) ^ pe) & 7) << 4); }
__device__ __forceinline__ int maddr(int base, int k, int chunk) { return base + k * 128 + (((chunk ^ (k >> 1)) & 7) << 4); }
__device__ __forceinline__ v4i16 vtr(const LAS unsigned char* p) { return __builtin_amdgcn_ds_read_tr16_b64_v4i16((LAS v4i16*)p); }
__device__ __forceinline__ bf16x8 neg8(bf16x8 v) { v4u w = __builtin_bit_cast(v4u, v); w.x ^= 0x80008000u; w.y ^= 0x80008000u; w.z ^= 0x80008000u; w.w ^= 0x80008000u; return __builtin_bit_cast(bf16x8, w); }

__device__ __forceinline__ void fourier_unit(Frame& F, int b, int g, int ec) {
    const bf16* PROJ = (const bf16*)(F.ws + WS_PROJ); bf16* A2 = (bf16*)(F.ws + WS_A2); const float* tabMg = (const float*)(F.ws + WS_TAB + TAB_MG);
    const int lane = F.lane, w = F.wave, li = lane & 15, gq = lane >> 4, e0 = 8 * ec;
    LAS unsigned char* L = F.lds;
    __syncthreads();
    bf16x8 mb[2];
#pragma unroll
    for (int ks = 0; ks < 2; ++ks) { float v[8];
#pragma unroll
        for (int j = 0; j < 8; ++j) { const int c = 8 * gq + j + 32 * ks; const int col = li < 8 ? e0 + li : 64 + e0 + (li & 7); v[j] = tabMg[(g * 64 + c) * 128 + col]; }
        v4u o; o.x = pk2(v[0], v[1]); o.y = pk2(v[2], v[3]); o.z = pk2(v[4], v[5]); o.w = pk2(v[6], v[7]); mb[ks] = __builtin_bit_cast(bf16x8, o); }
    const bf16* ub = PROJ + (size_t)(b * SEQ) * NPROJ + 3 * AW + g * 64 + 8 * gq;
#pragma unroll 8
    for (int it = 0; it < 32; ++it) { const int tile = w + 8 * it, s2 = tile & 63, tq = tile >> 6;
        const bf16* up = ub + (size_t)(64 * (16 * tq + li) + s2) * NPROJ;
        const bf16x8 a0 = __builtin_bit_cast(bf16x8, *(const GAS v4u*)up), a1 = __builtin_bit_cast(bf16x8, *(const GAS v4u*)(up + 32));
        f32x4 d = (f32x4){0.f, 0.f, 0.f, 0.f};
        d = __builtin_amdgcn_mfma_f32_16x16x32_bf16(a0, mb[0], d, 0, 0, 0); d = __builtin_amdgcn_mfma_f32_16x16x32_bf16(a1, mb[1], d, 0, 0, 0);
        v2u o; o.x = pk2(d[0], d[1]); o.y = pk2(d[2], d[3]); *(LAS v2u*)(L + xaddr(li, s2, 2 * tq + (gq >> 1)) + (gq & 1) * 8) = o; }
    __syncthreads();
    const int e = w;
#pragma unroll 1
    for (int mt = 0; mt < 4; ++mt) { const int s2 = 16 * mt + li;
        bf16x8 yr[2], yi[2], nyr[2];
#pragma unroll
        for (int kh = 0; kh < 2; ++kh) { yr[kh] = *(const LAS bf16x8*)(L + xaddr(e, s2, gq + 4 * kh)); yi[kh] = *(const LAS bf16x8*)(L + xaddr(8 + e, s2, gq + 4 * kh)); nyr[kh] = neg8(yr[kh]); }
#pragma unroll
        for (int nt = 0; nt < 4; ++nt) { const int k = 16 * nt + li;
            const bf16x8 c0 = *(const LAS bf16x8*)(L + maddr(LC, k, gq)), c1 = *(const LAS bf16x8*)(L + maddr(LC, k, gq + 4)), s0 = *(const LAS bf16x8*)(L + maddr(LS, k, gq)), s1 = *(const LAS bf16x8*)(L + maddr(LS, k, gq + 4));
            f32x4 tr = (f32x4){0.f, 0.f, 0.f, 0.f}, ti = (f32x4){0.f, 0.f, 0.f, 0.f};
            tr = __builtin_amdgcn_mfma_f32_16x16x32_bf16(c0, yr[0], tr, 0, 0, 0); tr = __builtin_amdgcn_mfma_f32_16x16x32_bf16(c1, yr[1], tr, 0, 0, 0);
            tr = __builtin_amdgcn_mfma_f32_16x16x32_bf16(s0, yi[0], tr, 0, 0, 0); tr = __builtin_amdgcn_mfma_f32_16x16x32_bf16(s1, yi[1], tr, 0, 0, 0);
            ti = __builtin_amdgcn_mfma_f32_16x16x32_bf16(c0, yi[0], ti, 0, 0, 0); ti = __builtin_amdgcn_mfma_f32_16x16x32_bf16(c1, yi[1], ti, 0, 0, 0);
            ti = __builtin_amdgcn_mfma_f32_16x16x32_bf16(s0, nyr[0], ti, 0, 0, 0); ti = __builtin_amdgcn_mfma_f32_16x16x32_bf16(s1, nyr[1], ti, 0, 0, 0);
            float orr[4], oii[4];
#pragma unroll
            for (int r = 0; r < 4; ++r) { const int k1 = 16 * nt + 4 * gq + r; const float rev = (float)((k1 * s2) & 4095) * (1.0f / 4096.0f); const float cv = __builtin_amdgcn_cosf(rev), sv = __builtin_amdgcn_sinf(rev);
                orr[r] = tr[r] * cv + ti[r] * sv; oii[r] = ti[r] * cv - tr[r] * sv; }
            v2u o; o.x = pk2(orr[0], orr[1]); o.y = pk2(orr[2], orr[3]); *(LAS v2u*)(L + xaddr(e, s2, 2 * nt + (gq >> 1)) + (gq & 1) * 8) = o;
            o.x = pk2(oii[0], oii[1]); o.y = pk2(oii[2], oii[3]); *(LAS v2u*)(L + xaddr(8 + e, s2, 2 * nt + (gq >> 1)) + (gq & 1) * 8) = o; } }
    asm volatile("s_waitcnt lgkmcnt(0)" ::: "memory");
    bf16x8 af[4][4];
    { const int q = li >> 2, p = li & 3;
#pragma unroll
      for (int mt = 0; mt < 4; ++mt)
#pragma unroll
        for (int ks = 0; ks < 4; ++ks) { const int pe = (ks >> 1) * 8 + e, s2b = 8 * gq + 32 * (ks & 1) + q;
            const v4i16 lo = vtr(L + xaddr(pe, s2b, 2 * mt + (p >> 1)) + (p & 1) * 8), hi = vtr(L + xaddr(pe, s2b + 4, 2 * mt + (p >> 1)) + (p & 1) * 8);
            af[mt][ks] = (bf16x8){lo[0], lo[1], lo[2], lo[3], hi[0], hi[1], hi[2], hi[3]}; } }
    asm volatile("s_waitcnt lgkmcnt(0)" ::: "memory");
    __syncthreads();
    const float bias = F.f_b[g * 64 + e0 + e];
#pragma unroll 1
    for (int nt = 0; nt < 4; ++nt) { const int k2 = 16 * nt + li;
        const bf16x8 c0 = *(const LAS bf16x8*)(L + maddr(LC, k2, gq)), c1 = *(const LAS bf16x8*)(L + maddr(LC, k2, gq + 4)), s0 = *(const LAS bf16x8*)(L + maddr(LS, k2, gq)), s1 = *(const LAS bf16x8*)(L + maddr(LS, k2, gq + 4));
#pragma unroll
        for (int mt = 0; mt < 4; ++mt) { f32x4 d = (f32x4){0.f, 0.f, 0.f, 0.f};
            d = __builtin_amdgcn_mfma_f32_16x16x32_bf16(af[mt][0], c0, d, 0, 0, 0); d = __builtin_amdgcn_mfma_f32_16x16x32_bf16(af[mt][1], c1, d, 0, 0, 0);
            d = __builtin_amdgcn_mfma_f32_16x16x32_bf16(af[mt][2], s0, d, 0, 0, 0); d = __builtin_amdgcn_mfma_f32_16x16x32_bf16(af[mt][3], s1, d, 0, 0, 0);
#pragma unroll
            for (int r = 0; r < 4; ++r) { const int k1 = 16 * mt + 4 * gq + r; *(LAS bf16*)(L + LX + (k1 * 64 + k2) * 16 + e * 2) = (bf16)f2bf(d[r] * (1.0f / 512.0f) + bias); } } }
    __syncthreads();
    bf16* ob = A2 + (size_t)(b * SEQ) * MIXW + AW + g * 64 + e0;
#pragma unroll
    for (int j = 0; j < 8; ++j) { const int sl = F.tid + 512 * j, k1 = sl >> 6, k2 = sl & 63; const v4u v = *(const LAS v4u*)(L + LX + sl * 16); *(GAS v4u*)(ob + (size_t)(k1 + 64 * k2) * MIXW) = v; }
}
__device__ __forceinline__ void phase_fourier(Frame& F) {
    const float* tabTw = (const float*)(F.ws + WS_TAB + TAB_TW);
    __syncthreads();
    for (int idx = F.tid; idx < 4096; idx += NWAVES * 64) { const int k = idx >> 6, s = idx & 63, n = ((k * s) & 63) * 64;
        *(LAS bf16*)(F.lds + maddr(LC, k, s >> 3) + (s & 7) * 2) = (bf16)f2bf(tabTw[2 * n]); *(LAS bf16*)(F.lds + maddr(LS, k, s >> 3) + (s & 7) * 2) = (bf16)f2bf(tabTw[2 * n + 1]); }
    __syncthreads();
    for (int u = F.vcu; u < BATCH * NG * 8; u += F.G) fourier_unit(F, u >> 5, (u >> 3) & 3, u & 7);
    __syncthreads();
}
}

__device__ __forceinline__ void p10_final(Frame& F) {
    const bf16* X2 = (const bf16*)(F.ws + WS_XN); const float* SS2 = (const float*)(F.ws + WS_SS2);
    const int gw = F.vcu * NWAVES + F.wave, NGW = F.G * NWAVES; const int lane = F.lane;
    const GAS f32x4* gr = (const GAS f32x4*)(F.g_fin + 16 * lane); const f32x4 g0 = gr[0], g1 = gr[1], g2 = gr[2], g3 = gr[3];
    for (int m0 = gw; m0 < M; m0 += 4 * NGW) { v4u w0[4], w1[4]; float part[4];
#pragma unroll
        for (int r = 0; r < 4; ++r) { const int m = (m0 + r * NGW) < M ? (m0 + r * NGW) : 0; const GAS v4u* rp = (const GAS v4u*)(X2 + (size_t)m * D + 16 * lane); w0[r] = rp[0]; w1[r] = rp[1];
            part[r] = lane < 16 ? SS2[(size_t)m * 16 + lane] : 0.f; }
#pragma unroll
        for (int r = 0; r < 4; ++r) { const int m = m0 + r * NGW; const float rstd = 1.0f / sqrtf(wave_sum(part[r]) * (1.f / D) + EPS);
            if (m < M) { GAS f32x4* op = (GAS f32x4*)(F.out + (size_t)m * D + 16 * lane);
                op[0] = (f32x4){bflo(w0[r].x), bfhi(w0[r].x), bflo(w0[r].y), bfhi(w0[r].y)} * rstd * g0; op[1] = (f32x4){bflo(w0[r].z), bfhi(w0[r].z), bflo(w0[r].w), bfhi(w0[r].w)} * rstd * g1;
                op[2] = (f32x4){bflo(w1[r].x), bfhi(w1[r].x), bflo(w1[r].y), bfhi(w1[r].y)} * rstd * g2; op[3] = (f32x4){bflo(w1[r].z), bfhi(w1[r].z), bflo(w1[r].w), bfhi(w1[r].w)} * rstd * g3; } } }
}


__device__ __forceinline__ void p8_halo_fix(Frame& F, int pm) {
    const float* H = (const float*)(F.ws + WS_HALO); bf16* ACT = (bf16*)(F.ws + WS_GV); const int kt = pm & 15;
    for (int it = F.tid; it < 2 * (FF / 4); it += NWAVES * 64) { const int c4 = (it % (FF / 4)) * 4, side = it / (FF / 4);
        if ((side == 0 && kt == 0) || (side == 1 && kt == 15)) continue;
        const float* own = H + (size_t)(pm * 2 + side) * 3 * FF + c4; const float* nb = H + (size_t)((side == 0 ? (pm - 1) * 2 + 1 : (pm + 1) * 2)) * 3 * FF + c4;
        const f32x4 gn = *(const GAS f32x4*)nb, zp = *(const GAS f32x4*)(own + FF), vv = *(const GAS f32x4*)(own + 2 * FF), wt = *(const GAS f32x4*)(F.conv_w + (side == 0 ? 0 : 2 * FF) + c4);
        float a[4];
#pragma unroll
        for (int i = 0; i < 4; ++i) { const float z = zp[i] + wt[i] * gn[i]; a[i] = z * __builtin_amdgcn_rcpf(1.0f + __builtin_amdgcn_exp2f(-1.4426950408889634f * z)) * vv[i]; }
        const unsigned long long o = (unsigned long long)pk2(a[0], a[1]) | ((unsigned long long)pk2(a[2], a[3]) << 32);
        __hip_atomic_store((unsigned long long*)(ACT + (size_t)(pm * 256 + (side ? 255 : 0)) * FF + c4), o, __ATOMIC_RELAXED, __HIP_MEMORY_SCOPE_AGENT); }
}


__device__ __forceinline__ void p6_quant(Frame& F) {
    const bf16* X1 = (const bf16*)(F.ws + WS_XN); unsigned char* A8 = F.ws + WS_A8; float* SROW = (float*)(F.ws + WS_SS1);
    const int gw = F.vcu * NWAVES + F.wave, NGW = F.G * NWAVES, lane = F.lane;
    for (int m0 = gw; m0 < M; m0 += 4 * NGW) { v4u w0[4], w1[4];
#pragma unroll
        for (int r = 0; r < 4; ++r) { const int m = (m0 + r * NGW) < M ? (m0 + r * NGW) : 0; const GAS v4u* rp = (const GAS v4u*)(X1 + (size_t)m * D + 16 * lane); w0[r] = rp[0]; w1[r] = rp[1]; }
#pragma unroll
        for (int r = 0; r < 4; ++r) { const int m = m0 + r * NGW; float v[16];
            v[0] = bflo(w0[r].x); v[1] = bfhi(w0[r].x); v[2] = bflo(w0[r].y); v[3] = bfhi(w0[r].y); v[4] = bflo(w0[r].z); v[5] = bfhi(w0[r].z); v[6] = bflo(w0[r].w); v[7] = bfhi(w0[r].w);
            v[8] = bflo(w1[r].x); v[9] = bfhi(w1[r].x); v[10] = bflo(w1[r].y); v[11] = bfhi(w1[r].y); v[12] = bflo(w1[r].z); v[13] = bfhi(w1[r].z); v[14] = bflo(w1[r].w); v[15] = bfhi(w1[r].w);
            float ss = 0.f, mx = 0.f;
#pragma unroll
            for (int i = 0; i < 16; ++i) { ss += v[i] * v[i]; mx = fmaxf(mx, fabsf(v[i])); }
            ss = wave_sum(ss);
#pragma unroll
            for (int o = 1; o < 64; o <<= 1) mx = fmaxf(mx, __shfl_xor(mx, o));
            const float inv = mx > 0.f ? 127.0f / mx : 0.f; unsigned q[4];
#pragma unroll
            for (int j = 0; j < 4; ++j) { q[j] = 0;
#pragma unroll
                for (int t = 0; t < 4; ++t) q[j] |= ((unsigned)(int)__builtin_rintf(v[4 * j + t] * inv) & 255u) << (8 * t); }
            if (m < M) { *(GAS v4u*)(A8 + (size_t)m * D + 16 * lane) = (v4u){q[0], q[1], q[2], q[3]};
                if (lane == 0) SROW[m] = mx * (1.0f / 127.0f) * (1.0f / sqrtf(ss * (1.f / D) + EPS)); } } }
}

struct Args { const float* in[16]; float* out; unsigned char* ws; int ph_lo, ph_hi; };
__global__ void __launch_bounds__(NWAVES * 64, 2) hymba_fwd(Args args) {
    extern __shared__ __attribute__((aligned(16))) unsigned char lds[];
    Frame F;
    F.lds = (LAS unsigned char*)lds;
    F.MISC = (volatile LAS unsigned*)(F.lds + MISC_OFF);
    F.tid = threadIdx.x; F.lane = F.tid & 63; F.wave = __builtin_amdgcn_readfirstlane(F.tid >> 6);
    F.G = gridDim.x; { const int bx = blockIdx.x; F.vcu = (F.G % 8 == 0) ? (bx % 8) * (F.G / 8) + bx / 8 : bx; }
    F.ws = args.ws; F.ctl = (gu32*)(args.ws + WS_CTL);
    F.x = args.in[0]; F.g_mix = args.in[1]; F.w_in = args.in[2]; F.g_attn = args.in[3]; F.rel_tab = args.in[4]; F.f_w = args.in[5]; F.f_b = args.in[6]; F.g_four = args.in[7];
    F.w_out = args.in[8]; F.g_ffn = args.in[9]; F.w_gate = args.in[10]; F.w_val = args.in[11]; F.conv_w = args.in[12]; F.conv_b = args.in[13]; F.w_down = args.in[14]; F.g_fin = args.in[15];
    F.out = args.out;
    for (int u = F.tid; u < (LDS_BYTES - LDSCTL_OFF) / 4; u += NWAVES * 64) ((LAS unsigned*)(F.lds + LDSCTL_OFF))[u] = 0u;
    if (blockIdx.x < 16 && F.wave == 7) {
        const unsigned long long pc = __builtin_amdgcn_s_getpc();
        const GAS unsigned* cb = (const GAS unsigned*)(pc & ~127ull); unsigned v[17], acc = 0u;
#pragma unroll
        for (int i = 0; i < 17; ++i) v[i] = cb[(size_t)(F.lane + 64 * i) * 32];
#pragma unroll
        for (int i = 0; i < 17; ++i) acc ^= v[i];
        if (acc == 0x9e3779b9u) F.MISC[20] = acc;
    }
    __syncthreads();
    XcdBarrier bar; bar.bar = (unsigned*)(F.ctl + CW_BAR); bar.x = 0; bar.st = nullptr;
    if (MK_ONE_LAUNCH) bar = xcd_barrier_post((unsigned*)(F.ctl + CW_BAR), F.MISC + 8);
#define GRID_BAR() do { if (MK_ONE_LAUNCH) xcd_barrier(bar); } while (0)
    const int lo = args.ph_lo, hi = args.ph_hi;
#define IN(k) (lo <= (k) && (k) < hi)
#define BOTH(k) (IN(k) && IN((k) + 1))
    if (IN(0)) { p0_prologue(F); if (BOTH(0)) GRID_BAR(); }
    if (IN(1)) {
        pg8::Gemm g{(const bf16*)(F.ws + WS_XN), (const bf16*)(F.ws + WS_WIN), M, NPROJ, D, D, 0}; pg8::StaticOrder S; S.init(M, NPROJ, F.G, (int)blockIdx.x);
        pg8::EpiBf16Row E{(bf16*)(F.ws + WS_PROJ), NPROJ, (const float*)(F.ws + WS_RS0)};
        pg8::gemm_phase<pg8::EpiBf16Row, pg8::StaticOrder, true, true>(F.lds + RING_OFF, g, S, E);
        if (BOTH(1)) GRID_BAR();
    }
    if (IN(2)) { att::phase_local(F); fou::phase_fourier(F); if (BOTH(2)) GRID_BAR(); }
    if (IN(3)) { att::phase_class(F); if (IN(3) && IN(5)) GRID_BAR(); }
    if (IN(5)) {
        pg8::Gemm g{(const bf16*)(F.ws + WS_A2), (const bf16*)(F.ws + WS_WOUT), M, D, MIXW, MIXW, 0}; pg8::StaticOrder S; S.init(M, D, F.G, (int)blockIdx.x);
        if (F.G == 256) {
            pg8::EpiX1Q E{(const bf16*)(F.ws + WS_XN), (bf16*)(F.ws + WS_XN), D, (const float*)(F.ws + WS_SSA), (LAS float*)(F.lds + LDSCTL_OFF + 8192), F.ws + WS_A8, (float*)(F.ws + WS_SS1), (float*)(F.ws + WS_XBUF), (unsigned*)(F.ctl + CW_PANEL2), F.lds + LDSCTL_OFF};
            pg8::gemm_phase<pg8::EpiX1Q, pg8::StaticOrder, true, true>(F.lds + RING_OFF, g, S, E);
        } else {
            pg8::EpiX1N E{(const bf16*)(F.ws + WS_XN), (bf16*)(F.ws + WS_XN), D, (float*)(F.ws + WS_SS1), (const float*)(F.ws + WS_SSA), (LAS float*)(F.lds + LDSCTL_OFF + 8192)};
            pg8::gemm_phase<pg8::EpiX1N, pg8::StaticOrder, true, true>(F.lds + RING_OFF, g, S, E);
        }
        if (IN(5) && IN(6)) GRID_BAR();
    }
    if (IN(6) && F.G != 256) { p6_quant(F); if (IN(6) && IN(7)) GRID_BAR(); }
    if (IN(7)) {
        pg8::Gemm g{(const bf16*)(F.ws + WS_A8), (const bf16*)(F.ws + WS_WGV), M, 2 * FF, D / 2, D / 2, 0}; pg8::StaticOrder S; S.init(M, 2 * FF, F.G, (int)blockIdx.x);
        pg8::EpiConvGlu E{(bf16*)(F.ws + WS_GV), FF, (const float*)(F.ws + WS_SS1), F.conv_w, F.conv_b, (LAS float*)(F.lds + LDSCTL_OFF + 4096), M, (float*)(F.ws + WS_HALO), (const float*)(F.ws + WS_TAB + TAB_CW4)};
        pg8::gemm_phase<pg8::EpiConvGlu, pg8::StaticOrder, true, true, true>(F.lds + RING_OFF, g, S, E);
        if (IN(7) && IN(9)) GRID_BAR();
    }
    if (IN(9)) {
        pg8::Gemm g{(const bf16*)(F.ws + WS_GV), (const bf16*)(F.ws + WS_WD), M, D, FF, FF, 0}; pg8::StaticOrder S; S.init(M, D, F.G, (int)blockIdx.x);
        { pg8::Unit uu; for (int i = 0; S.next(i, uu); ++i) p8_halo_fix(F, uu.pm); }
        asm volatile("s_waitcnt vmcnt(0)" ::: "memory"); __syncthreads();
        if (F.G == 256) {
            pg8::EpiFinal E{(const bf16*)(F.ws + WS_XN), F.out, D, F.g_fin, (float*)(F.ws + WS_XBUF), (unsigned*)(F.ctl + CW_PANEL), F.lds + LDSCTL_OFF + 4096};
            pg8::gemm_phase<pg8::EpiFinal, pg8::StaticOrder, true, true>(F.lds + RING_OFF, g, S, E);
        } else {
            pg8::EpiX2 E{(bf16*)(F.ws + WS_XN), D, (float*)(F.ws + WS_SS2)};
            pg8::gemm_phase<pg8::EpiX2, pg8::StaticOrder, true, true>(F.lds + RING_OFF, g, S, E);
            if (BOTH(9)) GRID_BAR();
        }
    }
    if (IN(10) && F.G != 256) { p10_final(F); }
#undef IN
#undef BOTH
}

extern "C" void kernel_launch(void* const* d_in, const int* in_sizes, int n_in, void* d_out, int out_size, void* d_ws, size_t ws_size, hipStream_t stream) {
    static int grid = 0;
    if (grid == 0) {
        if (n_in != 16 || in_sizes[0] != M * D || out_size != M * D || ws_size < WS_END) { fprintf(stderr, "kernel_launch: shape/workspace mismatch: n_in %d in0 %d out %d ws %zu (need %zu)\n", n_in, n_in > 0 ? in_sizes[0] : -1, out_size, ws_size, (size_t)WS_END); grid = -1; return; }
        int dev = 0, cus = 0, per_cu = 0;
        if (hipGetDevice(&dev) != hipSuccess || hipDeviceGetAttribute(&cus, hipDeviceAttributeMultiprocessorCount, dev) != hipSuccess) { grid = -1; return; }
        if (hipFuncSetAttribute((const void*)hymba_fwd, hipFuncAttributeMaxDynamicSharedMemorySize, LDS_BYTES) != hipSuccess) { fprintf(stderr, "kernel_launch: hipFuncSetAttribute failed\n"); grid = -1; return; }
        if (hipOccupancyMaxActiveBlocksPerMultiprocessor(&per_cu, (const void*)hymba_fwd, NWAVES * 64, LDS_BYTES) != hipSuccess || per_cu < 1) { fprintf(stderr, "kernel_launch: occupancy query says %d blocks/CU\n", per_cu); (void)hipGetLastError(); grid = -1; return; }
        grid = cus;
    }
    if (grid < 0) return;
    (void)hipMemsetAsync((char*)d_ws + WS_CTL, 0, CTL_ZERO_BYTES, stream);
    Args a{};
    for (int i = 0; i < 16; ++i) a.in[i] = (const float*)d_in[i];
    a.out = (float*)d_out; a.ws = (unsigned char*)d_ws;
#if MK_ONE_LAUNCH
    a.ph_lo = 0; a.ph_hi = N_PHASES;
    hipLaunchKernelGGL(hymba_fwd, dim3(grid), dim3(NWAVES * 64), LDS_BYTES, stream, a);
#else
    for (int p = 0; p < N_PHASES; ++p) { a.ph_lo = p; a.ph_hi = p + 1; hipLaunchKernelGGL(hymba_fwd, dim3(grid), dim3(NWAVES * 64), LDS_BYTES, stream, a); }
#endif
}
```

```cpp
#include <hip/hip_runtime.h>
#include <cstdio>
#include <cstdint>

namespace pg8 {
#define PG8_LAS __attribute__((address_space(3)))
typedef unsigned short bf16_t;
typedef short bf16x8 __attribute__((ext_vector_type(8)));
typedef float f32x4 __attribute__((ext_vector_type(4)));
typedef unsigned u32x4 __attribute__((ext_vector_type(4)));
typedef int i32x4 __attribute__((ext_vector_type(4)));
template <bool I8> struct AccT { typedef f32x4 type; };
template <> struct AccT<true> { typedef i32x4 type; };
constexpr int BM = 256, BK = 64, HALF = 128, HTB = HALF * BK * 2, STAGE_BYTES = 8 * HTB, NXCD = 8, WGM = 8;

__host__ __device__ __forceinline__ int lds_byte(int r, int c) { const int st = (r >> 4) * 2 + (c >> 5), rr = r & 15, cc = c & 31, ob = rr * 64 + cc * 2; return st * 1024 + (ob ^ (((ob >> 9) & 1) << 5)); }
__host__ __device__ __forceinline__ void stage_rc(int b, int& R, int& C) { const int st = b / 1024, sb = b % 1024, swz = sb ^ (((sb >> 9) & 1) << 5); R = (st >> 1) * 16 + swz / 64; C = (st & 1) * 32 + (swz % 64) / 2; }
__host__ __device__ __forceinline__ int perm32(int rho) { const int n = rho >> 4, i = rho & 15; return 8 * (i >> 2) + 4 * n + (i & 3); }

struct Unit { int pm, pn; };
struct Gemm { const bf16_t* A; const bf16_t* Bt; int M, N, K, lda; int ovl; };
__host__ __device__ __forceinline__ int ovl_row_base(int pm) { const int b = pm / 17, k = pm - 17 * b; return b * 4096 + (k ? 254 * k - 1 : 0); }

struct StaticOrder {
    int nM, nN, nwg, G, c;
    __host__ __device__ void init(int M, int N, int G_, int c_) { nM = M / BM; nN = N / BM; nwg = nM * nN; G = G_; c = c_; }
    __host__ __device__ bool next(int i, Unit& u) const {
        const long L = (long)i * G + c; if (L >= nwg) return false;
        int wgid = (int)L; { const int q = nwg / NXCD, r = nwg % NXCD, xcd = wgid % NXCD, off = wgid / NXCD; wgid = (xcd < r ? xcd * (q + 1) : r * (q + 1) + (xcd - r) * q) + off; }
        const int nig = WGM * nN, gid = wgid / nig, fm = gid * WGM, gsz = (nM - fm) < WGM ? (nM - fm) : WGM;
        u.pm = fm + ((wgid % nig) % gsz); u.pn = (wgid % nig) / gsz; return true;
    }
    __device__ __forceinline__ void a_ready(const Unit&) const {}
    __device__ __forceinline__ void done(const Unit&) const {}
};

typedef float f32x2v_t __attribute__((ext_vector_type(2))); typedef __bf16 bf16x2v_t __attribute__((ext_vector_type(2)));
__device__ __forceinline__ unsigned cvt_pk_bf16(float lo, float hi) { f32x2v_t v = {lo, hi}; bf16x2v_t b = __builtin_convertvector(v, bf16x2v_t); return __builtin_bit_cast(unsigned, b); }

__device__ __forceinline__ void st_wt8(void* p, unsigned long long v) { asm volatile("global_store_dwordx2 %0, %1, off sc1" :: "v"(p), "v"(v)); }
__device__ __forceinline__ void st_wt(void* p, u32x4 v) { asm volatile("global_store_dwordx4 %0, %1, off sc1\n\ts_nop 2" :: "v"(p), "v"(v));        }
struct EpiBf16 {
    static constexpr bool PERM = true, AFTER_DRAIN = false, MIDK = false, PREFETCH = false;
    bf16_t* O; int ldc;
    __device__ __forceinline__ void operator()(const f32x4 (&acc)[2][2][4][2], const Unit& u, int wr, int wc, int fr, int fq) const {
        const int row0 = u.pm * BM + wr * 64 + fr; const int col0 = u.pn * BM + wc * 32 + 8 * fq;
#pragma unroll
        for (int ai = 0; ai < 2; ++ai)
#pragma unroll
            for (int m = 0; m < 4; ++m) { bf16_t* rowp = O + (size_t)(row0 + ai * HALF + m * 16) * ldc + col0;
#pragma unroll
                for (int bj = 0; bj < 2; ++bj) { const f32x4 v0 = acc[ai][bj][m][0], v1 = acc[ai][bj][m][1];
                    u32x4 w; w.x = cvt_pk_bf16(v0[0], v0[1]); w.y = cvt_pk_bf16(v0[2], v0[3]); w.z = cvt_pk_bf16(v1[0], v1[1]); w.w = cvt_pk_bf16(v1[2], v1[3]);
                    *(u32x4*)(rowp + bj * HALF) = w; } }
    }
};

struct EpiBf16Row {
    static constexpr bool PERM = true, AFTER_DRAIN = false, MIDK = false, PREFETCH = false;
    bf16_t* O; int ldc; const float* rs;
    __device__ __forceinline__ void operator()(const f32x4 (&acc)[2][2][4][2], const Unit& u, int wr, int wc, int fr, int fq) const {
        const int row0 = u.pm * BM + wr * 64 + fr; const int col0 = u.pn * BM + wc * 32 + 8 * fq;
#pragma unroll
        for (int ai = 0; ai < 2; ++ai)
#pragma unroll
            for (int m = 0; m < 4; ++m) { const int row = row0 + ai * HALF + m * 16; const float r = rs[row]; bf16_t* rowp = O + (size_t)row * ldc + col0;
#pragma unroll
                for (int bj = 0; bj < 2; ++bj) { const f32x4 v0 = acc[ai][bj][m][0] * r, v1 = acc[ai][bj][m][1] * r;
                    u32x4 w; w.x = cvt_pk_bf16(v0[0], v0[1]); w.y = cvt_pk_bf16(v0[2], v0[3]); w.z = cvt_pk_bf16(v1[0], v1[1]); w.w = cvt_pk_bf16(v1[2], v1[3]);
                    st_wt(rowp + bj * HALF, w); } }
    }
};
struct EpiResF32 {
    static constexpr bool PERM = false, AFTER_DRAIN = false, MIDK = false, PREFETCH = false;
    const float* base; float* out; int ldc;
    __device__ __forceinline__ void operator()(const f32x4 (&acc)[2][2][4][2], const Unit& u, int wr, int wc, int fr, int fq) const {
        const int col0 = u.pn * BM + wc * 32 + 4 * fq;
#pragma unroll
        for (int ai = 0; ai < 2; ++ai)
#pragma unroll
            for (int m = 0; m < 4; ++m) { const int r = u.pm * BM + ai * HALF + wr * 64 + m * 16 + fr; const size_t off = (size_t)r * ldc + col0;
#pragma unroll
                for (int bj = 0; bj < 2; ++bj)
#pragma unroll
                    for (int n = 0; n < 2; ++n) { const f32x4 bs = *(const f32x4*)(base + off + bj * HALF + n * 16); *(f32x4*)(out + off + bj * HALF + n * 16) = bs + acc[ai][bj][m][n]; } }
    }
};


struct EpiX1 {
    static constexpr bool PERM = true, AFTER_DRAIN = false, MIDK = false, PREFETCH = false;
    const float* base; bf16_t* O; int ldc; float* ss;
    __device__ __forceinline__ void operator()(const f32x4 (&acc)[2][2][4][2], const Unit& u, int wr, int wc, int fr, int fq) const {
        const int row0 = u.pm * BM + wr * 64 + fr; const int col0 = u.pn * BM + wc * 32 + 8 * fq;
#pragma unroll
        for (int ai = 0; ai < 2; ++ai)
#pragma unroll
            for (int m = 0; m < 4; ++m) { const int row = row0 + ai * HALF + m * 16; const size_t off = (size_t)row * ldc + col0; float q = 0.f;
#pragma unroll
                for (int bj = 0; bj < 2; ++bj) { const f32x4 v0 = *(const f32x4*)(base + off + bj * HALF) + acc[ai][bj][m][0], v1 = *(const f32x4*)(base + off + bj * HALF + 4) + acc[ai][bj][m][1];
                    q += (v0[0] * v0[0] + v0[1] * v0[1]) + (v0[2] * v0[2] + v0[3] * v0[3]) + (v1[0] * v1[0] + v1[1] * v1[1]) + (v1[2] * v1[2] + v1[3] * v1[3]);
                    u32x4 w; w.x = cvt_pk_bf16(v0[0], v0[1]); w.y = cvt_pk_bf16(v0[2], v0[3]); w.z = cvt_pk_bf16(v1[0], v1[1]); w.w = cvt_pk_bf16(v1[2], v1[3]);
                    *(u32x4*)(O + off + bj * HALF) = w; }
                q += __shfl_xor(q, 16); q += __shfl_xor(q, 32);
                if (fq == 0) ss[(size_t)row * 16 + u.pn * 4 + wc] = q; }
    }
};
struct EpiX2 {
    static constexpr bool PERM = true, AFTER_DRAIN = false, MIDK = false, PREFETCH = false;
    bf16_t* X; int ldc; float* ss;
    __device__ __forceinline__ void operator()(const f32x4 (&acc)[2][2][4][2], const Unit& u, int wr, int wc, int fr, int fq) const {
        const int row0 = u.pm * BM + wr * 64 + fr; const int col0 = u.pn * BM + wc * 32 + 8 * fq;
#pragma unroll
        for (int ai = 0; ai < 2; ++ai)
#pragma unroll
            for (int m = 0; m < 4; ++m) { const int row = row0 + ai * HALF + m * 16; const size_t off = (size_t)row * ldc + col0; float q = 0.f;
#pragma unroll
                for (int bj = 0; bj < 2; ++bj) { const u32x4 xb = *(const u32x4*)(X + off + bj * HALF);
                    f32x4 v0, v1; v0[0] = __builtin_bit_cast(float, xb.x << 16); v0[1] = __builtin_bit_cast(float, xb.x & 0xffff0000u); v0[2] = __builtin_bit_cast(float, xb.y << 16); v0[3] = __builtin_bit_cast(float, xb.y & 0xffff0000u);
                    v1[0] = __builtin_bit_cast(float, xb.z << 16); v1[1] = __builtin_bit_cast(float, xb.z & 0xffff0000u); v1[2] = __builtin_bit_cast(float, xb.w << 16); v1[3] = __builtin_bit_cast(float, xb.w & 0xffff0000u);
                    v0 = v0 + acc[ai][bj][m][0]; v1 = v1 + acc[ai][bj][m][1];
                    q += (v0[0] * v0[0] + v0[1] * v0[1]) + (v0[2] * v0[2] + v0[3] * v0[3]) + (v1[0] * v1[0] + v1[1] * v1[1]) + (v1[2] * v1[2] + v1[3] * v1[3]);
                    u32x4 w; w.x = cvt_pk_bf16(v0[0], v0[1]); w.y = cvt_pk_bf16(v0[2], v0[3]); w.z = cvt_pk_bf16(v1[0], v1[1]); w.w = cvt_pk_bf16(v1[2], v1[3]);
                    *(u32x4*)(X + off + bj * HALF) = w; }
                q += __shfl_xor(q, 16); q += __shfl_xor(q, 32);
                if (fq == 0) ss[(size_t)row * 16 + u.pn * 4 + wc] = q; }
    }
};
struct EpiBf16Rs {
    static constexpr bool PERM = true, AFTER_DRAIN = false, MIDK = false, PREFETCH = false;
    bf16_t* O; int ldc; const float* ss; float inv_n, eps;
    __device__ __forceinline__ void operator()(const f32x4 (&acc)[2][2][4][2], const Unit& u, int wr, int wc, int fr, int fq) const {
        const int row0 = u.pm * BM + wr * 64 + fr; const int col0 = u.pn * BM + wc * 32 + 8 * fq;
#pragma unroll
        for (int ai = 0; ai < 2; ++ai)
#pragma unroll
            for (int m = 0; m < 4; ++m) { const int row = row0 + ai * HALF + m * 16; const f32x4* sp = (const f32x4*)(ss + (size_t)row * 16);
                const f32x4 s4 = (sp[0] + sp[1]) + (sp[2] + sp[3]); const float rs = 1.0f / sqrtf(((s4[0] + s4[1]) + (s4[2] + s4[3])) * inv_n + eps);
                bf16_t* rowp = O + (size_t)row * ldc + col0;
#pragma unroll
                for (int bj = 0; bj < 2; ++bj) { const f32x4 v0 = acc[ai][bj][m][0] * rs, v1 = acc[ai][bj][m][1] * rs;
                    u32x4 w; w.x = cvt_pk_bf16(v0[0], v0[1]); w.y = cvt_pk_bf16(v0[2], v0[3]); w.z = cvt_pk_bf16(v1[0], v1[1]); w.w = cvt_pk_bf16(v1[2], v1[3]);
                    *(u32x4*)(rowp + bj * HALF) = w; } }
    }
};


template <int CTRL> __device__ __forceinline__ float dppk(float keep, float x) { return __builtin_bit_cast(float, __builtin_amdgcn_update_dpp(__builtin_bit_cast(int, keep), __builtin_bit_cast(int, x), CTRL, 0xf, 0xf, false)); }
template <int CTRL> __device__ __forceinline__ float dppf(float x) { return __builtin_bit_cast(float, __builtin_amdgcn_mov_dpp(__builtin_bit_cast(int, x), CTRL, 0xf, 0xf, true)); }
struct EpiConvGlu {
    static constexpr bool PERM = true, AFTER_DRAIN = false, MIDK = false, PREFETCH = true, PERMA = true;
    bf16_t* O; int ldc; const float* ss; const float* cw; const float* cb; PG8_LAS float* ex; int mrows; float* halo; const float* cw4;
    __device__ __forceinline__ void prefetch(const Unit& u, int wid, int lane) const {
        const int base = u.pm * BM; asm volatile("" : "+v"(lane));
        if (wid == 0) __builtin_amdgcn_global_load_lds((const unsigned*)(ss + base + lane * 4), (PG8_LAS unsigned*)(ex + 1024), 16, 0, 0);
        else if (wid < 4) __builtin_amdgcn_global_load_lds((const unsigned*)(cw4 + u.pn * 768 + (wid - 1) * 256 + lane * 4), (PG8_LAS unsigned*)(ex + 1024 + 4096 + (wid - 1) * 256), 16, 0, 0);
    }
    __device__ __forceinline__ void operator()(i32x4 (&iacc)[2][2][4][2], const Unit& u, int wr, int wc, int fr, int fq) const {
        f32x4 acc[2][2][4][2];
        const int kt = u.pm & 15, base = u.pm * BM;
        const int ch0 = u.pn * 128 + wc * 32 + 8 * fq;
        const bool top_open = kt != 0, bot_open = kt != 15;
        f32x4 w0[2], w1[2], w2[2], cbv[2], isv[2];
#pragma unroll
        for (int n = 0; n < 2; ++n) { const PG8_LAS float* wl = ex + 1024 + 4096 + wc * 32 + 8 * fq + 4 * n; const f32x4 sg = *(const PG8_LAS f32x4*)(wl + 512) * -1.4426950408889634f;
            w0[n] = *(const PG8_LAS f32x4*)wl * sg; w1[n] = *(const PG8_LAS f32x4*)(wl + 128) * sg; w2[n] = *(const PG8_LAS f32x4*)(wl + 256) * sg; cbv[n] = *(const PG8_LAS f32x4*)(wl + 384) * -1.4426950408889634f;
            const f32x4 svn = *(const PG8_LAS f32x4*)(wl + 640);
#pragma unroll
            for (int i = 0; i < 4; ++i) isv[n][i] = __builtin_amdgcn_rcpf(fminf(svn[i] * -0.6931471805599453f, -1e-30f)); }
#pragma unroll
        for (int ai = 0; ai < 2; ++ai) { const f32x4 rs4 = *(const PG8_LAS f32x4*)(ex + 1024 + ai * HALF + wr * 64 + fr * 4);
#pragma unroll
            for (int m = 0; m < 4; ++m) { const float rs = rs4[m];
#pragma unroll
                for (int n = 0; n < 2; ++n) { const i32x4 ig = iacc[ai][0][m][n], iv = iacc[ai][1][m][n];
                    acc[ai][0][m][n] = (f32x4){(float)ig[0], (float)ig[1], (float)ig[2], (float)ig[3]} * rs; acc[ai][1][m][n] = (f32x4){(float)iv[0], (float)iv[1], (float)iv[2], (float)iv[3]} * rs; } } }
        const int exi = (wc * 4 + fq) * 8;
        if (fr == 0) {
#pragma unroll
            for (int ai = 0; ai < 2; ++ai) { PG8_LAS f32x4* p = (PG8_LAS f32x4*)(ex + ((ai * 2 + wr) * 2 + 0) * 128 + exi); p[0] = acc[ai][0][0][0]; p[1] = acc[ai][0][0][1]; } }
        if (fr == 15) {
#pragma unroll
            for (int ai = 0; ai < 2; ++ai) { PG8_LAS f32x4* p = (PG8_LAS f32x4*)(ex + ((ai * 2 + wr) * 2 + 1) * 128 + exi); p[0] = acc[ai][0][3][0]; p[1] = acc[ai][0][3][1]; } }
        asm volatile("s_waitcnt lgkmcnt(0)\n\ts_barrier" ::: "memory");
#pragma unroll
        for (int ai = 0; ai < 2; ++ai) {
            f32x4 et[2] = {(f32x4){0.f, 0.f, 0.f, 0.f}, (f32x4){0.f, 0.f, 0.f, 0.f}}, eb[2] = {(f32x4){0.f, 0.f, 0.f, 0.f}, (f32x4){0.f, 0.f, 0.f, 0.f}};
            { const bool hz = (wr == 0 && ai == 0); const int sai = wr == 1 ? ai : 0, swr = wr == 1 ? 0 : 1; const PG8_LAS f32x4* p = (const PG8_LAS f32x4*)(ex + ((sai * 2 + swr) * 2 + 1) * 128 + exi);
              if (!hz) { et[0] = p[0]; et[1] = p[1]; } }
            { const bool hz = (wr == 1 && ai == 1); const int sai = wr == 0 ? ai : 1, swr = wr == 0 ? 1 : 0; const PG8_LAS f32x4* p = (const PG8_LAS f32x4*)(ex + ((sai * 2 + swr) * 2 + 0) * 128 + exi);
              if (!hz) { eb[0] = p[0]; eb[1] = p[1]; } }
            float a[4][8], zz[8];
#pragma unroll
            for (int n = 0; n < 2; ++n)
#pragma unroll
                for (int i = 0; i < 4; ++i) { const float g0 = acc[ai][0][0][n][i], g1 = acc[ai][0][1][n][i], g2 = acc[ai][0][2][n][i], g3 = acc[ai][0][3][n][i];
                    const float up = dppk<0x111>(et[n][i], g3), dn = dppk<0x101>(eb[n][i], g0);
                    const float c0 = w0[n][i], c1 = w1[n][i], c2 = w2[n][i], cb0 = cbv[n][i];
                    float z[4];
                    z[0] = __builtin_fmaf(c2, g1, __builtin_fmaf(c1, g0, __builtin_fmaf(c0, up, cb0)));
                    z[1] = __builtin_fmaf(c2, g2, __builtin_fmaf(c1, g1, __builtin_fmaf(c0, g0, cb0)));
                    z[2] = __builtin_fmaf(c2, g3, __builtin_fmaf(c1, g2, __builtin_fmaf(c0, g1, cb0)));
                    z[3] = __builtin_fmaf(c2, dn, __builtin_fmaf(c1, g3, __builtin_fmaf(c0, g2, cb0)));
                    zz[4 * n + i] = (ai == 0 ? z[0] : z[3]) * -0.6931471805599453f;
#pragma unroll
                    for (int m = 0; m < 4; ++m) { const float iv0 = isv[n][i]; a[m][4 * n + i] = z[m] * __builtin_amdgcn_rcpf(__builtin_fmaf(__builtin_amdgcn_exp2f(z[m]), iv0, iv0)) * acc[ai][1][m][n][i]; } }
#pragma unroll
            for (int m = 0; m < 4; ++m) { const int r = ai * HALF + wr * 64 + fr * 4 + m; u32x4 w;
                w.x = cvt_pk_bf16(a[m][0], a[m][1]); w.y = cvt_pk_bf16(a[m][2], a[m][3]); w.z = cvt_pk_bf16(a[m][4], a[m][5]); w.w = cvt_pk_bf16(a[m][6], a[m][7]);
                bool open = false;
                if (ai == 0 && m == 0) open = (r == 0) && top_open;
                if (ai == 1 && m == 3) open = (r == 255) && bot_open;
                if (!open) st_wt(O + (size_t)(base + r) * ldc + ch0, w);
                if ((ai == 0 && m == 0) || (ai == 1 && m == 3)) { if (open) { float* hp = halo + ((size_t)(u.pm * 2 + (ai == 0 ? 0 : 1)) * 3) * ldc + ch0;
                        const PG8_LAS float* sl = ex + 1024 + 4096 + 512 + wc * 32 + 8 * fq;
                        *(f32x4*)hp = acc[ai][0][m][0] * *(const PG8_LAS f32x4*)sl; *(f32x4*)(hp + 4) = acc[ai][0][m][1] * *(const PG8_LAS f32x4*)(sl + 4);
                        *(f32x4*)(hp + ldc) = (f32x4){zz[0], zz[1], zz[2], zz[3]}; *(f32x4*)(hp + ldc + 4) = (f32x4){zz[4], zz[5], zz[6], zz[7]};
                        *(f32x4*)(hp + 2 * ldc) = acc[ai][1][m][0] * *(const PG8_LAS f32x4*)(sl + 128); *(f32x4*)(hp + 2 * ldc + 4) = acc[ai][1][m][1] * *(const PG8_LAS f32x4*)(sl + 132); } }
                asm volatile("" ::: "memory"); } }
        asm volatile("s_waitcnt lgkmcnt(0)\n\ts_barrier" ::: "memory");
    }
};


struct EpiX1N {
    static constexpr bool PERM = true, AFTER_DRAIN = false, MIDK = true, PREFETCH = true; static constexpr int MIDK_T = 12;
    const bf16_t* base; bf16_t* O; int ldc; float* ss; const float* sa; PG8_LAS float* st;
    __device__ __forceinline__ void prefetch(const Unit& u, int wid, int lane) const {
        asm volatile("" : "+v"(lane));
#pragma unroll
        for (int i = 0; i < 2; ++i) { const int piece = wid * 2 + i;
            __builtin_amdgcn_global_load_lds((const unsigned*)(sa + (size_t)u.pm * BM * 16 + piece * 256 + lane * 4), (PG8_LAS unsigned*)(st + piece * 256), 16, 0, 0); }
    }
    __device__ __forceinline__ void row_stats(int rl, int fq, float& ra, float& rf) const {
        const f32x4 s4 = *(const PG8_LAS f32x4*)(st + rl * 16 + 4 * fq); float a = fq < 3 ? (s4[0] + s4[1]) + (s4[2] + s4[3]) : 0.f, f = fq == 3 ? s4[0] : 0.f;
        a += __shfl_xor(a, 16); a += __shfl_xor(a, 32); f += __shfl_xor(f, 16); f += __shfl_xor(f, 32);
        ra = __builtin_amdgcn_rsqf(a * (1.0f / 768.0f) + 1e-6f); rf = __builtin_amdgcn_rsqf(f * (1.0f / 256.0f) + 1e-6f);
    }
    __device__ __forceinline__ void midk(f32x4 (&acc)[2][2][4][2], const Unit& u, int wr, int fr, int fq) const {
#pragma unroll
        for (int ai = 0; ai < 2; ++ai)
#pragma unroll
            for (int m = 0; m < 4; ++m) { float ra, rf; row_stats(ai * HALF + wr * 64 + m * 16 + fr, fq, ra, rf); const float ratio = ra * __builtin_amdgcn_rcpf(rf);
#pragma unroll
                for (int bj = 0; bj < 2; ++bj) { acc[ai][bj][m][0] = acc[ai][bj][m][0] * ratio; acc[ai][bj][m][1] = acc[ai][bj][m][1] * ratio; } }
    }
    __device__ __forceinline__ void operator()(const f32x4 (&acc)[2][2][4][2], const Unit& u, int wr, int wc, int fr, int fq) const {
        const int row0 = u.pm * BM + wr * 64 + fr; const int col0 = u.pn * BM + wc * 32 + 8 * fq;
#pragma unroll
        for (int ai = 0; ai < 2; ++ai)
#pragma unroll
            for (int m = 0; m < 4; ++m) { const int row = row0 + ai * HALF + m * 16; const size_t off = (size_t)row * ldc + col0; float ra, rf; row_stats(row - u.pm * BM, fq, ra, rf);
#pragma unroll
                for (int bj = 0; bj < 2; ++bj) { const u32x4 xb = *(const u32x4*)(base + off + bj * HALF); f32x4 v0, v1;
                    v0[0] = __builtin_bit_cast(float, xb.x << 16); v0[1] = __builtin_bit_cast(float, xb.x & 0xffff0000u); v0[2] = __builtin_bit_cast(float, xb.y << 16); v0[3] = __builtin_bit_cast(float, xb.y & 0xffff0000u);
                    v1[0] = __builtin_bit_cast(float, xb.z << 16); v1[1] = __builtin_bit_cast(float, xb.z & 0xffff0000u); v1[2] = __builtin_bit_cast(float, xb.w << 16); v1[3] = __builtin_bit_cast(float, xb.w & 0xffff0000u);
                    v0 = v0 + acc[ai][bj][m][0] * rf; v1 = v1 + acc[ai][bj][m][1] * rf;
                    u32x4 w; w.x = cvt_pk_bf16(v0[0], v0[1]); w.y = cvt_pk_bf16(v0[2], v0[3]); w.z = cvt_pk_bf16(v1[0], v1[1]); w.w = cvt_pk_bf16(v1[2], v1[3]);
                    *(u32x4*)(O + off + bj * HALF) = w; }
                }
        asm volatile("s_waitcnt lgkmcnt(0)\n\ts_barrier" ::: "memory");
    }
};


struct EpiX1Q {
    static constexpr bool PERM = true, AFTER_DRAIN = false, MIDK = true, PREFETCH = true; static constexpr int MIDK_T = 12;
    const bf16_t* base; bf16_t* O; int ldc; const float* sa; PG8_LAS float* st; unsigned char* A8; float* srow; float* xbuf; unsigned* cnt; PG8_LAS unsigned char* lq;
    __device__ __forceinline__ void prefetch(const Unit& u, int wid, int lane) const {
        asm volatile("" : "+v"(lane));
#pragma unroll
        for (int i = 0; i < 2; ++i) { const int piece = wid * 2 + i;
            __builtin_amdgcn_global_load_lds((const unsigned*)(sa + (size_t)u.pm * BM * 16 + piece * 256 + lane * 4), (PG8_LAS unsigned*)(st + piece * 256), 16, 0, 0); }
    }
    __device__ __forceinline__ void row_stats(int rl, int fq, float& ra, float& rf) const {
        const f32x4 s4 = *(const PG8_LAS f32x4*)(st + rl * 16 + 4 * fq); float a = fq < 3 ? (s4[0] + s4[1]) + (s4[2] + s4[3]) : 0.f, f = fq == 3 ? s4[0] : 0.f;
        a += __shfl_xor(a, 16); a += __shfl_xor(a, 32); f += __shfl_xor(f, 16); f += __shfl_xor(f, 32);
        ra = __builtin_amdgcn_rsqf(a * (1.0f / 768.0f) + 1e-6f); rf = __builtin_amdgcn_rsqf(f * (1.0f / 256.0f) + 1e-6f);
    }
    __device__ __forceinline__ void midk(f32x4 (&acc)[2][2][4][2], const Unit& u, int wr, int fr, int fq) const {
#pragma unroll
        for (int ai = 0; ai < 2; ++ai)
#pragma unroll
            for (int m = 0; m < 4; ++m) { float ra, rf; row_stats(ai * HALF + wr * 64 + m * 16 + fr, fq, ra, rf); const float ratio = ra * __builtin_amdgcn_rcpf(rf);
#pragma unroll
                for (int bj = 0; bj < 2; ++bj) { acc[ai][bj][m][0] = acc[ai][bj][m][0] * ratio; acc[ai][bj][m][1] = acc[ai][bj][m][1] * ratio; } }
    }
    __device__ __forceinline__ void operator()(f32x4 (&acc)[2][2][4][2], const Unit& u, int wr, int wc, int fr, int fq) const {
        PG8_LAS float* Pq = (PG8_LAS float*)(lq + 4096); PG8_LAS float* Pm = (PG8_LAS float*)(lq + 24576); PG8_LAS float* S = (PG8_LAS float*)(lq + 28672);
        asm volatile("" : "+v"(fr), "+v"(fq));
        int tid = (wr * 4 + wc) * 64 + fq * 16 + fr;
        const int col0 = u.pn * BM + wc * 32 + 8 * fq;
#pragma unroll
        for (int ai = 0; ai < 2; ++ai)
#pragma unroll
            for (int m = 0; m < 4; ++m) { const int rl = ai * HALF + wr * 64 + m * 16 + fr; const size_t off = (size_t)(u.pm * BM + rl) * ldc + col0; float ra, rf; row_stats(rl, fq, ra, rf); float q = 0.f, mx = 0.f;
#pragma unroll
                for (int bj = 0; bj < 2; ++bj) { const u32x4 xb = *(const u32x4*)(base + off + bj * HALF); f32x4 v0, v1;
                    v0[0] = __builtin_bit_cast(float, xb.x << 16); v0[1] = __builtin_bit_cast(float, xb.x & 0xffff0000u); v0[2] = __builtin_bit_cast(float, xb.y << 16); v0[3] = __builtin_bit_cast(float, xb.y & 0xffff0000u);
                    v1[0] = __builtin_bit_cast(float, xb.z << 16); v1[1] = __builtin_bit_cast(float, xb.z & 0xffff0000u); v1[2] = __builtin_bit_cast(float, xb.w << 16); v1[3] = __builtin_bit_cast(float, xb.w & 0xffff0000u);
                    v0 = v0 + acc[ai][bj][m][0] * rf; v1 = v1 + acc[ai][bj][m][1] * rf; acc[ai][bj][m][0] = v0; acc[ai][bj][m][1] = v1;
                    q += ((v0[0] * v0[0] + v0[1] * v0[1]) + (v0[2] * v0[2] + v0[3] * v0[3])) + ((v1[0] * v1[0] + v1[1] * v1[1]) + (v1[2] * v1[2] + v1[3] * v1[3]));
                    mx = fmaxf(mx, fmaxf(fmaxf(fmaxf(fabsf(v0[0]), fabsf(v0[1])), fmaxf(fabsf(v0[2]), fabsf(v0[3]))), fmaxf(fmaxf(fabsf(v1[0]), fabsf(v1[1])), fmaxf(fabsf(v1[2]), fabsf(v1[3])))));
                    u32x4 w; w.x = cvt_pk_bf16(v0[0], v0[1]); w.y = cvt_pk_bf16(v0[2], v0[3]); w.z = cvt_pk_bf16(v1[0], v1[1]); w.w = cvt_pk_bf16(v1[2], v1[3]);
                    *(u32x4*)(O + off + bj * HALF) = w; }
                q += __shfl_xor(q, 16); q += __shfl_xor(q, 32); mx = fmaxf(mx, __shfl_xor(mx, 16)); mx = fmaxf(mx, __shfl_xor(mx, 32));
                if (fq == 0) { Pq[rl * 4 + wc] = q; Pm[rl * 4 + wc] = mx; } }
        asm volatile("s_waitcnt lgkmcnt(0)\n\ts_barrier" ::: "memory");
        if (tid < 256) { const float sq = (Pq[tid * 4] + Pq[tid * 4 + 1]) + (Pq[tid * 4 + 2] + Pq[tid * 4 + 3]); const float mq = fmaxf(fmaxf(Pm[tid * 4], Pm[tid * 4 + 1]), fmaxf(Pm[tid * 4 + 2], Pm[tid * 4 + 3]));
            float* xp = xbuf + ((size_t)(u.pm * BM + tid) * 4 + u.pn) * 2;
            __hip_atomic_store(xp, sq, __ATOMIC_RELAXED, __HIP_MEMORY_SCOPE_AGENT); __hip_atomic_store(xp + 1, mq, __ATOMIC_RELAXED, __HIP_MEMORY_SCOPE_AGENT);
            asm volatile("s_waitcnt vmcnt(0)" ::: "memory");
            if ((tid & 63) == 0) __hip_atomic_fetch_add(cnt + 64 * u.pm, 1u, __ATOMIC_RELAXED, __HIP_MEMORY_SCOPE_AGENT); }
        if (tid < 64) { unsigned spins = 0;
            while ((unsigned)__builtin_amdgcn_readfirstlane(__hip_atomic_load(cnt + 64 * u.pm, __ATOMIC_RELAXED, __HIP_MEMORY_SCOPE_AGENT)) < 16u) { __builtin_amdgcn_s_sleep(2); if (++spins > 400000u) break; }
            __builtin_amdgcn_fence(__ATOMIC_ACQUIRE, "agent"); }
        asm volatile("s_waitcnt vmcnt(0) lgkmcnt(0)\n\ts_barrier" ::: "memory");
        if (tid < 256) { const float* xp = xbuf + (size_t)(u.pm * BM + tid) * 8; float t = 0.f, mq = 0.f;
#pragma unroll
            for (int k = 0; k < 4; ++k) { t += __hip_atomic_load(xp + 2 * k, __ATOMIC_RELAXED, __HIP_MEMORY_SCOPE_AGENT); mq = fmaxf(mq, __hip_atomic_load(xp + 2 * k + 1, __ATOMIC_RELAXED, __HIP_MEMORY_SCOPE_AGENT)); }
            S[tid] = mq > 0.f ? 127.0f / mq : 0.f;
            if (u.pn == 0) srow[u.pm * BM + tid] = mq * (1.0f / 127.0f) * (1.0f / sqrtf(t * (1.0f / 1024.0f) + 1e-6f)); }
        asm volatile("s_waitcnt vmcnt(0) lgkmcnt(0)\n\ts_barrier" ::: "memory");
        int fr5 = fr; asm volatile("" : "+v"(fr5));
#pragma unroll
        for (int ai = 0; ai < 2; ++ai)
#pragma unroll
            for (int m = 0; m < 4; ++m) { const int rl = ai * HALF + wr * 64 + m * 16 + fr5; const float inv = S[rl]; unsigned char* ap = A8 + (size_t)(u.pm * BM + rl) * ldc + col0;
#pragma unroll
                for (int bj = 0; bj < 2; ++bj) { unsigned lo = 0, hi = 0;
#pragma unroll
                    for (int t = 0; t < 4; ++t) { lo |= ((unsigned)(int)__builtin_rintf(acc[ai][bj][m][0][t] * inv) & 255u) << (8 * t); hi |= ((unsigned)(int)__builtin_rintf(acc[ai][bj][m][1][t] * inv) & 255u) << (8 * t); }
                    unsigned long long pk = (unsigned long long)lo | ((unsigned long long)hi << 32); *(unsigned long long*)(ap + bj * HALF) = pk; } }
        asm volatile("s_waitcnt lgkmcnt(0)\n\ts_barrier" ::: "memory");
    }
};

struct EpiFinal {
    static constexpr bool PERM = true, AFTER_DRAIN = false, MIDK = false, PREFETCH = false;
    const bf16_t* X1; float* out; int ldc; const float* gain; float* xbuf; unsigned* cnt; PG8_LAS unsigned char* lx;
    __device__ __forceinline__ void operator()(f32x4 (&acc)[2][2][4][2], const Unit& u, int wr, int wc, int fr, int fq) const {
        PG8_LAS float* P = (PG8_LAS float*)lx; PG8_LAS float* S = (PG8_LAS float*)(lx + 4096);
        int tid = (wr * 4 + wc) * 64 + fq * 16 + fr; asm volatile("" : "+v"(tid)); const int col0 = u.pn * BM + wc * 32 + 8 * fq;
#pragma unroll
        for (int ai = 0; ai < 2; ++ai)
#pragma unroll
            for (int m = 0; m < 4; ++m) { const int rl = ai * HALF + wr * 64 + m * 16 + fr; const size_t off = (size_t)(u.pm * BM + rl) * ldc + col0; float q = 0.f;
#pragma unroll
                for (int bj = 0; bj < 2; ++bj) { const u32x4 xb = *(const u32x4*)(X1 + off + bj * HALF); f32x4 v0, v1;
                    v0[0] = __builtin_bit_cast(float, xb.x << 16); v0[1] = __builtin_bit_cast(float, xb.x & 0xffff0000u); v0[2] = __builtin_bit_cast(float, xb.y << 16); v0[3] = __builtin_bit_cast(float, xb.y & 0xffff0000u);
                    v1[0] = __builtin_bit_cast(float, xb.z << 16); v1[1] = __builtin_bit_cast(float, xb.z & 0xffff0000u); v1[2] = __builtin_bit_cast(float, xb.w << 16); v1[3] = __builtin_bit_cast(float, xb.w & 0xffff0000u);
                    v0 = v0 + acc[ai][bj][m][0]; v1 = v1 + acc[ai][bj][m][1]; acc[ai][bj][m][0] = v0; acc[ai][bj][m][1] = v1;
                    q += ((v0[0] * v0[0] + v0[1] * v0[1]) + (v0[2] * v0[2] + v0[3] * v0[3])) + ((v1[0] * v1[0] + v1[1] * v1[1]) + (v1[2] * v1[2] + v1[3] * v1[3])); }
                q += __shfl_xor(q, 16); q += __shfl_xor(q, 32);
                if (fq == 0) P[rl * 4 + wc] = q; }
        asm volatile("s_waitcnt lgkmcnt(0)\n\ts_barrier" ::: "memory");
        if (tid < 256) { const float s = (P[tid * 4] + P[tid * 4 + 1]) + (P[tid * 4 + 2] + P[tid * 4 + 3]);
            __hip_atomic_store(xbuf + ((size_t)(u.pm * BM + tid) * 4 + u.pn), s, __ATOMIC_RELAXED, __HIP_MEMORY_SCOPE_AGENT);
            asm volatile("s_waitcnt vmcnt(0)" ::: "memory");
            if ((tid & 63) == 0) __hip_atomic_fetch_add(cnt + 64 * u.pm, 1u, __ATOMIC_RELAXED, __HIP_MEMORY_SCOPE_AGENT); }
        if (tid < 64) { unsigned spins = 0;
            while ((unsigned)__builtin_amdgcn_readfirstlane(__hip_atomic_load(cnt + 64 * u.pm, __ATOMIC_RELAXED, __HIP_MEMORY_SCOPE_AGENT)) < 16u) { __builtin_amdgcn_s_sleep(2); if (++spins > 400000u) break; }
            __builtin_amdgcn_fence(__ATOMIC_ACQUIRE, "agent"); }
        asm volatile("s_waitcnt vmcnt(0) lgkmcnt(0)\n\ts_barrier" ::: "memory");
        if (tid < 256) { const float* xp = xbuf + (size_t)(u.pm * BM + tid) * 4; float t = 0.f;
#pragma unroll
            for (int k = 0; k < 4; ++k) t += __hip_atomic_load(xp + k, __ATOMIC_RELAXED, __HIP_MEMORY_SCOPE_AGENT);
            S[tid] = 1.0f / sqrtf(t * (1.0f / 1024.0f) + 1e-6f); }
        asm volatile("s_waitcnt vmcnt(0) lgkmcnt(0)\n\ts_barrier" ::: "memory");
        f32x4 gv[2][2];
#pragma unroll
        for (int bj = 0; bj < 2; ++bj)
#pragma unroll
            for (int n = 0; n < 2; ++n) gv[bj][n] = *(const f32x4*)(gain + col0 + bj * HALF + n * 4);
#pragma unroll
        for (int ai = 0; ai < 2; ++ai)
#pragma unroll
            for (int m = 0; m < 4; ++m) { const int rl = ai * HALF + wr * 64 + m * 16 + fr; const float rs = S[rl]; const size_t off = (size_t)(u.pm * BM + rl) * ldc + col0;
#pragma unroll
                for (int bj = 0; bj < 2; ++bj)
#pragma unroll
                    for (int n = 0; n < 2; ++n) *(f32x4*)(out + off + bj * HALF + n * 4) = acc[ai][bj][m][n] * rs * gv[bj][n]; }
    }
};

template <class E, class = void> struct HasPermA { static constexpr bool v = false; };
template <class E> struct HasPermA<E, decltype((void)E::PERMA)> { static constexpr bool v = E::PERMA; };
template <bool I8> __device__ __forceinline__ typename AccT<I8>::type mma16(bf16x8 a, bf16x8 b, typename AccT<I8>::type c) {
    if constexpr (I8) return __builtin_amdgcn_mfma_i32_16x16x64_i8(__builtin_bit_cast(i32x4, a), __builtin_bit_cast(i32x4, b), c, 0, 0, 0);
    else return __builtin_amdgcn_mfma_f32_16x16x32_bf16(a, b, c, 0, 0, 0);
}
template <class Epi, class Sched, bool ALIGN_EPI = false, bool SP2 = false, bool I8 = false>
__device__ __forceinline__ void gemm_phase(PG8_LAS unsigned char* lds, const Gemm g, const Sched& S, const Epi& E) {
    int tid = threadIdx.x; asm volatile("" : "+v"(tid));
    const int wid = __builtin_amdgcn_readfirstlane(tid >> 6), lane = tid & 63, wr = wid >> 2, wc = wid & 3, fr = lane & 15, fq = lane >> 4;
    const int K = g.K, nt = K / BK, lda = g.lda;
    unsigned voffA[2], voffB[2];
#pragma unroll
    for (int i = 0; i < 2; ++i) { int R, C; stage_rc(tid * 16 + i * 8192, R, C); const int Rb = Epi::PERM ? ((R & ~31) + perm32(R & 31)) : R;
        const int Ra = HasPermA<Epi>::v ? ((R & ~63) + (R & 15) * 4 + ((R >> 4) & 3)) : R;
        voffA[i] = (unsigned)(Ra * lda + C) * 2u; voffB[i] = (unsigned)(Rb * K + C) * 2u; }
    const size_t kstep = (size_t)(BK * 2);
    const size_t hstepA = (size_t)HALF * lda * 2, hstepB = (size_t)HALF * K * 2;
    const size_t tstepA = 2 * hstepA, tstepB = 2 * hstepB;
    const unsigned ldsw = (unsigned)wid * 1024u;
    const int aoff = lds_byte(wr * 64 + fr, fq * 8), boff = lds_byte(wc * 32 + fr, fq * 8);
#define PG8_SA(b, h) (((b) * 2 + (h)) * HTB)
#define PG8_SB(b, h) ((4 + (b) * 2 + (h)) * HTB)
#define PG8_STAGE(bufoff, gbase, voff) do { _Pragma("unroll") for (int _i = 0; _i < 2; ++_i) \
        __builtin_amdgcn_global_load_lds((const unsigned*)((const char*)(gbase) + (voff)[_i]), (PG8_LAS unsigned*)(lds + (bufoff) + ldsw + _i * 8192), 16, 0, 0); } while (0)
#define PG8_LDA(dst, b, h) do { _Pragma("unroll") for (int m = 0; m < 4; ++m) _Pragma("unroll") for (int k = 0; k < 2; ++k) dst[m][k] = *(const PG8_LAS bf16x8*)(lds + PG8_SA(b, h) + aoff + m * 2048 + k * 1024); } while (0)
#define PG8_LDB(dst, b, h) do { _Pragma("unroll") for (int n = 0; n < 2; ++n) _Pragma("unroll") for (int k = 0; k < 2; ++k) dst[n][k] = *(const PG8_LAS bf16x8*)(lds + PG8_SB(b, h) + boff + n * 2048 + k * 1024); } while (0)
#define PG8_MMA(ai, bj, At, Bt) do { __builtin_amdgcn_s_setprio(1); _Pragma("unroll") for (int m = 0; m < 4; ++m) _Pragma("unroll") for (int n = 0; n < 2; ++n) _Pragma("unroll") for (int k = 0; k < 2; ++k) \
        acc[ai][bj][m][n] = mma16<I8>(Bt[n][k], At[m][k], acc[ai][bj][m][n]); __builtin_amdgcn_s_setprio(0); } while (0)
#define PG8_WAIT_V(n) asm volatile("s_waitcnt vmcnt(" #n ")" ::: "memory")
#define PG8_WAIT_L(n) asm volatile("s_waitcnt lgkmcnt(" #n ")" ::: "memory")
#define PG8_BAR __builtin_amdgcn_s_barrier()
#define PG8_SCHED __builtin_amdgcn_sched_barrier(0)
    Unit cur, nxt; int ui = 0;
    if (!S.next(0, cur)) return;
    typedef typename AccT<I8>::type acc_t; acc_t acc[2][2][4][2];
#pragma unroll
    for (int a = 0; a < 2; ++a)
#pragma unroll
        for (int b = 0; b < 2; ++b)
#pragma unroll
            for (int m = 0; m < 4; ++m)
#pragma unroll
                for (int n = 0; n < 2; ++n) acc[a][b][m][n] = (acc_t){0, 0, 0, 0};
    bf16x8 At[4][2], B0[2][2], B1[2][2];
    const char* cA = (const char*)g.A + (g.ovl ? (size_t)ovl_row_base(cur.pm) * lda * 2 : (size_t)cur.pm * tstepA); const char* cB = (const char*)g.Bt + (size_t)cur.pn * tstepB;
    S.a_ready(cur);
    if constexpr (Epi::PREFETCH) E.prefetch(cur, wid, lane);
    if constexpr (SP2) {
        PG8_STAGE(PG8_SB(0, 0), cB, voffB); PG8_STAGE(PG8_SB(0, 1), cB + hstepB, voffB); PG8_STAGE(PG8_SA(0, 0), cA, voffA); PG8_STAGE(PG8_SA(0, 1), cA + hstepA, voffA);
        if (wr == 1) PG8_BAR;
        PG8_WAIT_V(2); PG8_BAR;
        PG8_STAGE(PG8_SB(1, 0), cB + kstep, voffB); PG8_STAGE(PG8_SA(1, 0), cA + kstep, voffA); PG8_STAGE(PG8_SB(1, 1), cB + hstepB + kstep, voffB);
        PG8_WAIT_V(6); PG8_BAR;
    } else {
        PG8_STAGE(PG8_SB(0, 0), cB, voffB); PG8_STAGE(PG8_SA(0, 0), cA, voffA); PG8_STAGE(PG8_SB(0, 1), cB + hstepB, voffB); PG8_STAGE(PG8_SA(0, 1), cA + hstepA, voffA);
        if (wr == 1) PG8_BAR;
        PG8_WAIT_V(4); PG8_BAR;
        PG8_STAGE(PG8_SB(1, 0), cB + kstep, voffB); PG8_STAGE(PG8_SA(1, 0), cA + kstep, voffA); PG8_STAGE(PG8_SB(1, 1), cB + hstepB + kstep, voffB);
        PG8_WAIT_V(6); PG8_BAR;
    }
    for (;;) {
        const bool has_next = S.next(ui + 1, nxt);
        const char* nA = has_next ? (const char*)g.A + (g.ovl ? (size_t)ovl_row_base(nxt.pm) * lda * 2 : (size_t)nxt.pm * tstepA) : cA; const char* nB = has_next ? (const char*)g.Bt + (size_t)nxt.pn * tstepB : cB;
        for (int t = 0; t < nt; t += 2) {
            const bool last = (t == nt - 2);
            const char* a1 = cA + (size_t)(t + 1) * kstep;
            const char* a2 = last ? nA : cA + (size_t)(t + 2) * kstep; const char* b2 = last ? nB : cB + (size_t)(t + 2) * kstep;
            const char* a3 = a2 + kstep; const char* b3 = b2 + kstep;
            if (last && has_next) S.a_ready(nxt);
            if constexpr (Epi::MIDK) { if (t == Epi::MIDK_T) E.midk(acc, cur, wr, fr, fq); }
            if constexpr (SP2) {
            PG8_LDB(B0, 0, 0); PG8_LDB(B1, 0, 1); PG8_SCHED; PG8_LDA(At, 0, 0); PG8_STAGE(PG8_SA(1, 1), a1 + hstepA, voffA);
            PG8_WAIT_V(8); PG8_WAIT_L(0); PG8_BAR; PG8_MMA(0, 0, At, B0); PG8_MMA(0, 1, At, B1); PG8_BAR; PG8_SCHED;
            PG8_LDA(At, 0, 1); PG8_STAGE(PG8_SB(0, 0), b2, voffB); PG8_STAGE(PG8_SB(0, 1), b2 + hstepB, voffB); PG8_STAGE(PG8_SA(0, 0), a2, voffA);
            PG8_WAIT_V(8); PG8_WAIT_L(0); PG8_BAR; PG8_MMA(1, 0, At, B0); PG8_MMA(1, 1, At, B1); PG8_BAR; PG8_SCHED;
            PG8_LDB(B0, 1, 0); PG8_LDB(B1, 1, 1); PG8_SCHED; PG8_LDA(At, 1, 0); PG8_STAGE(PG8_SA(0, 1), a2 + hstepA, voffA);
            PG8_WAIT_V(8); PG8_WAIT_L(0); PG8_BAR; PG8_MMA(0, 0, At, B0); PG8_MMA(0, 1, At, B1); PG8_BAR; PG8_SCHED;
            PG8_LDA(At, 1, 1); PG8_STAGE(PG8_SB(1, 0), b3, voffB); PG8_STAGE(PG8_SB(1, 1), b3 + hstepB, voffB); PG8_STAGE(PG8_SA(1, 0), a3, voffA);
            PG8_WAIT_V(8); PG8_WAIT_L(0); PG8_BAR; PG8_MMA(1, 0, At, B0); PG8_MMA(1, 1, At, B1); PG8_BAR; PG8_SCHED;
            } else {
            PG8_LDB(B0, 0, 0); PG8_SCHED; PG8_LDA(At, 0, 0); PG8_STAGE(PG8_SA(1, 1), a1 + hstepA, voffA);
            PG8_WAIT_L(8); PG8_BAR; PG8_WAIT_L(0); PG8_MMA(0, 0, At, B0); PG8_BAR; PG8_SCHED;
            PG8_LDB(B1, 0, 1); PG8_STAGE(PG8_SB(0, 0), b2, voffB);
            PG8_BAR; PG8_WAIT_L(0); PG8_MMA(0, 1, At, B1); PG8_BAR;
            PG8_LDA(At, 0, 1); PG8_STAGE(PG8_SA(0, 0), a2, voffA);
            PG8_BAR; PG8_WAIT_L(0); PG8_MMA(1, 0, At, B0); PG8_BAR; PG8_SCHED;
            PG8_STAGE(PG8_SB(0, 1), b2 + hstepB, voffB);
            PG8_WAIT_V(6); PG8_BAR; PG8_MMA(1, 1, At, B1); PG8_BAR;
            PG8_LDB(B0, 1, 0); PG8_SCHED; PG8_LDA(At, 1, 0); PG8_STAGE(PG8_SA(0, 1), a2 + hstepA, voffA);
            PG8_WAIT_L(8); PG8_BAR; PG8_WAIT_L(0); PG8_MMA(0, 0, At, B0); PG8_BAR; PG8_SCHED;
            PG8_LDB(B1, 1, 1); PG8_STAGE(PG8_SB(1, 0), b3, voffB);
            PG8_BAR; PG8_WAIT_L(0); PG8_MMA(0, 1, At, B1); PG8_BAR;
            PG8_LDA(At, 1, 1); PG8_STAGE(PG8_SA(1, 0), a3, voffA);
            PG8_BAR; PG8_WAIT_L(0); PG8_MMA(1, 0, At, B0); PG8_BAR; PG8_SCHED;
            PG8_STAGE(PG8_SB(1, 1), b3 + hstepB, voffB);
            PG8_WAIT_V(6); PG8_BAR; PG8_MMA(1, 1, At, B1); PG8_BAR;
            }
        }
        if constexpr (ALIGN_EPI) { if (wr == 0) PG8_BAR; }
        if constexpr (!Epi::AFTER_DRAIN) { E(acc, cur, wr, wc, fr, fq); S.done(cur); }
        if constexpr (Epi::PREFETCH) { if (has_next) E.prefetch(nxt, wid, lane); }
        if (!has_next) break;
#pragma unroll
        for (int a = 0; a < 2; ++a)
#pragma unroll
            for (int b = 0; b < 2; ++b)
#pragma unroll
                for (int m = 0; m < 4; ++m)
#pragma unroll
                    for (int n = 0; n < 2; ++n) acc[a][b][m][n] = (acc_t){0, 0, 0, 0};
        cur = nxt; cA = nA; cB = nB; ++ui;
        if constexpr (ALIGN_EPI) { if (wr == 1) PG8_BAR; }
    }
    PG8_WAIT_V(0);
    if constexpr (!ALIGN_EPI) { if (wr == 0) PG8_BAR; }
    PG8_BAR;
#undef PG8_SA
#undef PG8_SB
#undef PG8_STAGE
#undef PG8_LDA
#undef PG8_LDB
#undef PG8_MMA
#undef PG8_WAIT_V
#undef PG8_WAIT_L
#undef PG8_BAR
#undef PG8_SCHED
}
}

constexpr int NWAVES = 8;
#ifndef MK_ONE_LAUNCH
#define MK_ONE_LAUNCH 1
#endif
constexpr int N_PHASES = 11;

constexpr int BATCH = 8, SEQ = 4096, D = 1024, NH = 12, HD = 64, AW = 768, NG = 4, GD = 64, FW = 256, MIXW = 1024, NPROJ = 2560, FF = 2816;
constexpr int M = BATCH * SEQ;
constexpr float EPS = 1e-6f;

constexpr size_t MiB = 1u << 20;
constexpr size_t WS_CTL = 0, CTL_ZERO_BYTES = 96 * 1024;
constexpr size_t WS_TAB = 1 * MiB;
constexpr size_t TAB_BIAS = 0;
constexpr size_t TAB_MG = 32 * 1024;
constexpr size_t TAB_TW = 192 * 1024;
constexpr size_t TAB_CW4 = 256 * 1024;
constexpr size_t WS_WIN = 2 * MiB;
constexpr size_t WS_WOUT = 7 * MiB;
constexpr size_t WS_WGV = 9 * MiB;
constexpr size_t WS_WD = 20 * MiB;
constexpr size_t WS_XN = 26 * MiB;
constexpr size_t WS_PROJ = 90 * MiB;
constexpr size_t WS_A2 = 250 * MiB;
constexpr size_t WS_PQ = 314 * MiB;
constexpr size_t WS_ML = 380 * MiB;
constexpr size_t WS_A8 = 314 * MiB;
constexpr size_t WS_HALO = 400 * MiB;
constexpr size_t WS_RS0 = 441 * MiB;
constexpr size_t WS_XBUF = 440 * MiB;
constexpr size_t WS_SSA = 446 * MiB;
constexpr size_t WS_SS1 = 442 * MiB;
constexpr size_t WS_SS2 = 444 * MiB;
constexpr size_t WS_GV = 90 * MiB;
constexpr size_t WS_END = 448 * MiB;
constexpr int CW_BAR = 1024, CW_PANEL = 8192, CW_PANEL2 = 16384;

constexpr int RING_OFF = 0, RING_BYTES = 131072;
constexpr int LDSCTL_OFF = RING_BYTES, MISC_OFF = LDSCTL_OFF + 320;
constexpr int LDS_BYTES = 163840;

#define GAS __attribute__((address_space(1)))
#define LAS __attribute__((address_space(3)))
typedef unsigned short bf16;
typedef unsigned v4u __attribute__((ext_vector_type(4)));
typedef unsigned v2u __attribute__((ext_vector_type(2)));
typedef float f32x4 __attribute__((ext_vector_type(4)));
typedef GAS unsigned gu32;
#define RLX_AGENT __ATOMIC_RELAXED, __HIP_MEMORY_SCOPE_AGENT
#define LDS_WAIT() asm volatile("s_waitcnt lgkmcnt(0)" ::: "memory")
#define VM_WAIT() asm volatile("s_waitcnt vmcnt(0)" ::: "memory")
__device__ __forceinline__ unsigned f2bf(float f) { unsigned u = __builtin_bit_cast(unsigned, f); return (u + 0x7fffu + ((u >> 16) & 1u)) >> 16; }
__device__ __forceinline__ unsigned pk2(float lo, float hi) { typedef float f2_t __attribute__((ext_vector_type(2))); typedef __bf16 b2_t __attribute__((ext_vector_type(2))); f2_t v = {lo, hi}; b2_t b = __builtin_convertvector(v, b2_t); return __builtin_bit_cast(unsigned, b); }
__device__ __forceinline__ void st_wt16(void* p, v4u v) { asm volatile("global_store_dwordx4 %0, %1, off sc1\n\ts_nop 2" :: "v"(p), "v"(v));        }
__device__ __forceinline__ void st_wt8(void* p, v2u v) { asm volatile("global_store_dwordx2 %0, %1, off sc1" :: "v"(p), "v"(v)); }
__device__ __forceinline__ float bflo(unsigned w) { return __builtin_bit_cast(float, w << 16); }
__device__ __forceinline__ float bfhi(unsigned w) { return __builtin_bit_cast(float, w & 0xffff0000u); }
__device__ __forceinline__ float bf2f(bf16 h) { return __builtin_bit_cast(float, (unsigned)h << 16); }

#define XB_TMO      128
#define XB_XCNT(j)  (256  + 64 * (j))
#define XB_XSUB(j)  (1280 + 64 * (j))
#define XB_XGEN(j)  (2304 + 64 * (j))
#define XB_TOP      3328
#define XB_TOPGEN   3392
#define XCD_BAR_WORDS 3456
#define XB_SPIN_CAP (1u << 18)
__device__ __forceinline__ unsigned xb_ld(unsigned* p)              { return __hip_atomic_load(p, __ATOMIC_RELAXED, __HIP_MEMORY_SCOPE_AGENT); }
__device__ __forceinline__ unsigned xb_add(unsigned* p, unsigned v) { return __hip_atomic_fetch_add(p, v, __ATOMIC_RELAXED, __HIP_MEMORY_SCOPE_AGENT); }
__device__ __forceinline__ unsigned xb_xcc_id() { return (unsigned)__builtin_amdgcn_s_getreg((3 << 11) | 20) & 0xFu; }
#define XB_SPIN(cond, bar) do { unsigned _sp = 0; while (cond) { __builtin_amdgcn_s_sleep(1); \
    if ((++_sp & 255u) == 0u) { if (xb_ld(&(bar)[XB_TMO])) break; if (_sp > XB_SPIN_CAP) { atomicAdd(&(bar)[XB_TMO], 1u); break; } } } } while (0)
struct XcdBarrier { unsigned* bar; unsigned x; volatile LAS unsigned* st; };
__device__ __forceinline__ XcdBarrier xcd_barrier_post(unsigned* bar, volatile LAS unsigned* st) {
    XcdBarrier b; b.bar = bar; b.x = xb_xcc_id(); b.st = st;
    if (threadIdx.x == 0) (void)xb_add(&bar[XB_XCNT(b.x)], 1u);
    return b;
}
__device__ __forceinline__ void xcd_barrier_complete(unsigned* bar, unsigned x, unsigned& nloc, unsigned& nx) {
    const unsigned G = gridDim.x * gridDim.y * gridDim.z;
    unsigned sum, cnt, mine, sp = 0u;
    for (;;) {
        sum = 0u; cnt = 0u; mine = 0u;
#pragma unroll
        for (unsigned j = 0; j < 16; ++j) { const unsigned c = xb_ld(&bar[XB_XCNT(j)]); sum += c; cnt += (c > 0u) ? 1u : 0u; mine = (j == x) ? c : mine; }
        if (sum == G) break;
        __builtin_amdgcn_s_sleep(1);
        if ((++sp & 255u) == 0u) { if (xb_ld(&bar[XB_TMO])) break; if (sp > XB_SPIN_CAP) { atomicAdd(&bar[XB_TMO], 1u); break; } }
    }
    nloc = mine > 0u ? mine : 1u; nx = cnt > 0u ? cnt : 1u;
}
__device__ __forceinline__ void xcd_barrier(const XcdBarrier& b) {
    asm volatile("s_waitcnt vmcnt(0)" ::: "memory");
    __syncthreads();
    if (threadIdx.x == 0) {
        unsigned* bar = b.bar;
        __builtin_amdgcn_s_waitcnt(0);
        unsigned nloc = b.st[0], nx = b.st[1];
        if (nloc == 0u) { xcd_barrier_complete(bar, b.x, nloc, nx); b.st[0] = nloc; b.st[1] = nx; }
        const unsigned old = xb_add(&bar[XB_XSUB(b.x)], 1u);
        const unsigned gen = old / nloc;
        if (old + 1u == (gen + 1u) * nloc) {
            __builtin_amdgcn_fence(__ATOMIC_RELEASE, "agent");
            asm volatile("s_waitcnt vmcnt(0)" ::: "memory");
            const unsigned og = xb_add(&bar[XB_TOP], 1u);
            const unsigned tg = og / nx;
            if (og + 1u == (tg + 1u) * nx) xb_add(&bar[XB_TOPGEN], 1u);
            else XB_SPIN(xb_ld(&bar[XB_TOPGEN]) == tg, bar);
            __builtin_amdgcn_fence(__ATOMIC_ACQUIRE, "agent");
            xb_add(&bar[XB_XGEN(b.x)], 1u);
            asm volatile("s_waitcnt vmcnt(0)" ::: "memory");
        } else {
            XB_SPIN(xb_ld(&bar[XB_XGEN(b.x)]) == gen, bar);
            __builtin_amdgcn_fence(__ATOMIC_ACQUIRE, "agent");
            asm volatile("s_waitcnt vmcnt(0)" ::: "memory");
        }
    }
    __syncthreads();
}

struct Frame {
    LAS unsigned char* lds;
    volatile LAS unsigned* MISC;
    gu32* ctl;
    int tid, lane, wave;
    int vcu, G;
    const float *x, *g_mix, *w_in, *g_attn, *rel_tab, *f_w, *f_b, *g_four, *w_out, *g_ffn, *w_gate, *w_val, *conv_w, *conv_b, *w_down, *g_fin;
    float* out;
    unsigned char* ws;
};

__device__ __forceinline__ float wave_sum(float v) {
#pragma unroll
    for (int o = 1; o < 64; o <<= 1) v += __shfl_xor(v, o);
    return v;
}
__device__ __forceinline__ void p0_transpose_item(const float* W, int K, int N, bf16* WT, int row_off, LAS float* scr, int item, int lane, const float* gain = nullptr, bool il = false) {
    const int nblk = N / 32, kb = item / nblk, nb = item % nblk, k0 = 64 * kb, n0 = 32 * nb; if (il) row_off += 128 * (n0 >> 7);
    {   f32x4 v[8]; const int c4 = 4 * (lane & 7);
#pragma unroll
        for (int i = 0; i < 8; ++i) v[i] = __builtin_nontemporal_load((const GAS f32x4*)(W + (size_t)(k0 + (lane >> 3) + 8 * i) * N + n0 + c4));
#pragma unroll
        for (int i = 0; i < 8; ++i) { const int kk = (lane >> 3) + 8 * i; const float gsc = gain ? gain[k0 + kk] : 1.0f; LAS float* sp = scr + kk * 33 + c4;
            sp[0] = v[i].x * gsc; sp[1] = v[i].y * gsc; sp[2] = v[i].z * gsc; sp[3] = v[i].w * gsc; } }
    LDS_WAIT(); asm volatile("" ::: "memory");
    const int c = lane & 7;
#pragma unroll
    for (int j = 0; j < 4; ++j) { const int n = (lane >> 3) + 8 * j; const LAS float* s = scr + (8 * c) * 33 + n;
        v4u o; o.x = pk2(s[0 * 33], s[1 * 33]); o.y = pk2(s[2 * 33], s[3 * 33]); o.z = pk2(s[4 * 33], s[5 * 33]); o.w = pk2(s[6 * 33], s[7 * 33]);
        *(GAS v4u*)(WT + (size_t)(row_off + n0 + n) * K + k0 + 8 * c) = o; }
    LDS_WAIT(); asm volatile("" ::: "memory");
}

__device__ __forceinline__ void p0_quant_strip(Frame& F, const float* W, int N, unsigned char* WT, bool isv, int nb, const float* gain, float* cw6) {
    const int lane = F.lane, w = F.wave, n0 = 32 * nb, c4 = 4 * (lane & 7), K = D; const int row_off = (isv ? 128 : 0) + 128 * (n0 >> 7);
    LAS float* scr = (LAS float*)(F.lds + RING_OFF + w * 16384); LAS float* cmw = (LAS float*)(F.lds + RING_OFF + 8 * 16384 - 2048); LAS float* cmf = cmw + 256;
    f32x4 v[2][8]; f32x4 mx = (f32x4){0.f, 0.f, 0.f, 0.f};
#pragma unroll
    for (int blk = 0; blk < 2; ++blk)
#pragma unroll
        for (int i = 0; i < 8; ++i) v[blk][i] = __builtin_nontemporal_load((const GAS f32x4*)(W + (size_t)(128 * w + 64 * blk + (lane >> 3) + 8 * i) * N + n0 + c4));
#pragma unroll
    for (int blk = 0; blk < 2; ++blk)
#pragma unroll
        for (int i = 0; i < 8; ++i) { v[blk][i] = v[blk][i] * gain[128 * w + 64 * blk + (lane >> 3) + 8 * i];
            mx[0] = fmaxf(mx[0], fabsf(v[blk][i][0])); mx[1] = fmaxf(mx[1], fabsf(v[blk][i][1])); mx[2] = fmaxf(mx[2], fabsf(v[blk][i][2])); mx[3] = fmaxf(mx[3], fabsf(v[blk][i][3])); }
#pragma unroll
    for (int j = 0; j < 4; ++j) { float t = mx[j]; t = fmaxf(t, __shfl_xor(t, 8)); t = fmaxf(t, __shfl_xor(t, 16)); t = fmaxf(t, __shfl_xor(t, 32)); mx[j] = t; }
    if (lane < 8) *(LAS f32x4*)(cmw + w * 32 + c4) = mx;
    __syncthreads();
    if (F.tid < 32) { float t = cmw[F.tid];
#pragma unroll
        for (int ww = 1; ww < 8; ++ww) t = fmaxf(t, cmw[ww * 32 + F.tid]);
        cmf[F.tid] = t; const int nn = n0 + F.tid; cw6[(nn >> 7) * 768 + (isv ? 5 : 4) * 128 + (nn & 127)] = t * (1.0f / 127.0f); }
    __syncthreads();
#pragma unroll
    for (int blk = 0; blk < 2; ++blk) { const int k0 = 128 * w + 64 * blk;
#pragma unroll
        for (int i = 0; i < 8; ++i) { const int kk = (lane >> 3) + 8 * i; LAS float* sp = scr + kk * 33 + c4; sp[0] = v[blk][i][0]; sp[1] = v[blk][i][1]; sp[2] = v[blk][i][2]; sp[3] = v[blk][i][3]; }
        LDS_WAIT(); asm volatile("" ::: "memory");
        const int c = lane & 7;
#pragma unroll
        for (int j = 0; j < 4; ++j) { const int n = (lane >> 3) + 8 * j; const LAS float* sq = scr + (8 * c) * 33 + n; const float cm = cmf[n]; const float inv = cm > 0.f ? 127.0f / cm : 0.f;
            unsigned lo = 0, hi = 0;
#pragma unroll
            for (int t = 0; t < 4; ++t) { lo |= ((unsigned)(int)__builtin_rintf(sq[t * 33] * inv) & 255u) << (8 * t); hi |= ((unsigned)(int)__builtin_rintf(sq[(4 + t) * 33] * inv) & 255u) << (8 * t); }
            v2u o; o.x = lo; o.y = hi; *(GAS v2u*)(WT + (size_t)(row_off + n0 + n) * K + k0 + 8 * c) = o; }
        LDS_WAIT(); asm volatile("" ::: "memory"); }
    __syncthreads();
}
__device__ __forceinline__ void rms_row_to_bf16(const float* xrow, const float* gain, bf16* orow, int lane) {
    const GAS f32x4* xr = (const GAS f32x4*)xrow + lane; const GAS f32x4* gr = (const GAS f32x4*)gain + lane;
    f32x4 v[4]; float s = 0.f;
#pragma unroll
    for (int j = 0; j < 4; ++j) { v[j] = xr[64 * j]; s += (v[j].x * v[j].x + v[j].y * v[j].y) + (v[j].z * v[j].z + v[j].w * v[j].w); }
    const float rstd = 1.0f / sqrtf(wave_sum(s) * (1.f / D) + EPS);
    GAS unsigned long long* o8 = (GAS unsigned long long*)orow + lane;
#pragma unroll
    for (int j = 0; j < 4; ++j) { const f32x4 gg = gr[64 * j]; o8[64 * j] = (unsigned long long)pk2(v[j].x * rstd * gg.x, v[j].y * rstd * gg.y) | ((unsigned long long)pk2(v[j].z * rstd * gg.z, v[j].w * rstd * gg.w) << 32); }
}
__device__ __forceinline__ int t5_bucket(int rel) {
    const int ret = rel > 0 ? 16 : 0; const int n = rel < 0 ? -rel : rel;
    const float nf = (float)(n > 1 ? n : 1);
    int large = 8 + (int)(logf(nf / 8.0f) / logf(128.0f) * 8.0f);
    large = large < 15 ? large : 15;
    return ret + (n < 8 ? n : large);
}

__device__ __forceinline__ void p0_prologue(Frame& F) {
    LAS float* scr = (LAS float*)(F.lds + RING_OFF + F.wave * 16384);
    const int gw = F.vcu * NWAVES + F.wave, NGW = F.G * NWAVES;
    bf16* WinT = (bf16*)(F.ws + WS_WIN); bf16* WoutT = (bf16*)(F.ws + WS_WOUT); bf16* WgvT = (bf16*)(F.ws + WS_WGV); bf16* WdT = (bf16*)(F.ws + WS_WD);
    constexpr int I_IN = (D / 64) * (NPROJ / 32), I_OUT = (MIXW / 64) * (D / 32), I_D = (FF / 64) * (D / 32), NSTRIP = FF / 32;
    constexpr int NITEMS = I_IN + I_OUT + I_D;
    float* cw6 = (float*)(F.ws + WS_TAB + TAB_CW4);
    for (int sj = F.vcu; sj < 2 * NSTRIP; sj += F.G) { const bool isv = sj >= NSTRIP; p0_quant_strip(F, isv ? F.w_val : F.w_gate, FF, F.ws + WS_WGV, isv, isv ? sj - NSTRIP : sj, F.g_ffn, cw6); }
    for (int it = gw; it < NITEMS; it += NGW) {
        int r = it;
        if (r < I_IN) { p0_transpose_item(F.w_in, D, NPROJ, WinT, 0, scr, r, F.lane, F.g_mix); continue; } r -= I_IN;
        if (r < I_OUT) { const int k0 = 64 * (r / (D / 32)); p0_transpose_item(F.w_out, MIXW, D, WoutT, 0, scr, r, F.lane, k0 < AW ? F.g_attn : F.g_four - AW); continue; } r -= I_OUT;
        p0_transpose_item(F.w_down, FF, D, WdT, 0, scr, r, F.lane);
    }
    float* tabBias = (float*)(F.ws + WS_TAB + TAB_BIAS); float* tabMg = (float*)(F.ws + WS_TAB + TAB_MG); float* tabTw = (float*)(F.ws + WS_TAB + TAB_TW);
    const int gt = F.vcu * (NWAVES * 64) + F.tid, NGT = F.G * NWAVES * 64;
    for (int i = gt; i < 3 * 129 * 12; i += NGT) { const int h = i % 12, jj = (i / 12) % 129, br = i / (12 * 129); const int dil = br == 0 ? 1 : (br == 1 ? 4 : 16);
        tabBias[i] = F.rel_tab[t5_bucket((jj - 64) * dil) * 12 + h]; }
    for (int i = gt; i < 4 * 64 * 128; i += NGT) { const int col = i & 127, c = (i >> 7) & 63, g = i >> 13; const int e = col & 63; float acc = 0.f;
        for (int d = 0; d < 64; ++d) { const float rev = (float)((c * d) & 63) * (1.0f / 64.0f); const float t = col < 64 ? __builtin_amdgcn_cosf(rev) : -__builtin_amdgcn_sinf(rev); acc += t * F.f_w[(g * 64 + d) * 64 + e]; }
        tabMg[i] = acc; }
    for (int i = gt; i < (FF / 128) * 512; i += NGT) { const int pn = i >> 9, k = (i >> 7) & 3, c = i & 127, ch = 128 * pn + c; cw6[pn * 768 + k * 128 + c] = k < 3 ? F.conv_w[k * FF + ch] : F.conv_b[ch]; }
    for (int i = gt; i < 4096; i += NGT) { float sv, cv; sincospif((float)i * (1.0f / 2048.0f), &sv, &cv); tabTw[2 * i] = cv; tabTw[2 * i + 1] = sv; }
    bf16* XN = (bf16*)(F.ws + WS_XN);
    {   float* RS0 = (float*)(F.ws + WS_RS0);
        for (int m0 = gw; m0 < M; m0 += 4 * NGW) { f32x4 v[4][4];
#pragma unroll
            for (int r = 0; r < 4; ++r) { const int m = m0 + r * NGW; const GAS f32x4* xr = (const GAS f32x4*)(F.x + (size_t)(m < M ? m : 0) * D) + F.lane;
#pragma unroll
                for (int j = 0; j < 4; ++j) v[r][j] = __builtin_nontemporal_load(xr + 64 * j); }
#pragma unroll
            for (int r = 0; r < 4; ++r) { const int m = m0 + r * NGW; float s = 0.f;
#pragma unroll
                for (int j = 0; j < 4; ++j) s += (v[r][j].x * v[r][j].x + v[r][j].y * v[r][j].y) + (v[r][j].z * v[r][j].z + v[r][j].w * v[r][j].w);
                const float rstd = 1.0f / sqrtf(wave_sum(s) * (1.f / D) + EPS);
                if (m < M) { GAS unsigned long long* o8 = (GAS unsigned long long*)(XN + (size_t)m * D) + F.lane; if (F.lane == 0) RS0[m] = rstd;
#pragma unroll
                    for (int j = 0; j < 4; ++j) { const f32x4 t = v[r][j]; v2u o2; o2.x = pk2(t.x, t.y); o2.y = pk2(t.z, t.w); st_wt8((void*)(o8 + 64 * j), o2); } } } } }
}

namespace att {
typedef short bf16x8 __attribute__((ext_vector_type(8)));
typedef short v4i16 __attribute__((ext_vector_type(4)));
constexpr float LOG2E = 1.4426950408889634f;
constexpr int TABN = 512, TPAD0 = 128;
constexpr int LDS_K = 0, LDS_V = 49152, LDS_T0 = 98304, LDS_T1 = 98304 + 8192;
struct QT { bf16x8 q[2]; f32x4 o[4]; float m, l; };
__device__ __forceinline__ v4i16 vtr(const LAS unsigned char* p) { return __builtin_amdgcn_ds_read_tr16_b64_v4i16((LAS v4i16*)p); }

__device__ __forceinline__ void build_table(Frame& F, int ldsoff, int br, int h) {
    const float* tabBias = (const float*)(F.ws + WS_TAB + TAB_BIAS);
    LAS float* T = (LAS float*)(F.lds + ldsoff);
    for (int e = F.tid; e < 4 * TABN; e += NWAVES * 64) { const int s = e / TABN, n = e % TABN; const int r64 = n + s - TPAD0;
        T[e] = (r64 >= 0 && r64 <= 128) ? tabBias[(br * 129 + r64) * 12 + h] * LOG2E : -INFINITY; }
}
__device__ __forceinline__ const LAS float* table_ptr(Frame& F, int ldsoff, int idx0) { const int s = idx0 & 3; return (const LAS float*)(F.lds + ldsoff) + s * TABN + (idx0 - s); }

__device__ __forceinline__ int pass_tok(int mode, int a, int row) {
    if (mode == 0) { const int t = a - 64 + row; return (t >= 0 && t < SEQ) ? t : -1; }
    if (mode == 3) return a + 16 * row;
    const int hi = row >= 192 ? 1 : 0, u = a + (hi ? row - 192 : row), c = 2 * (mode - 1) + hi; return (u >= 0 && u < SEQ / 4) ? c + 4 * u : -1;
}
struct Pre { v4u k[6], v[6]; };
template <int NIT> __device__ __forceinline__ void prefetch(Frame& F, Pre& R, const bf16* P, int h, int mode, int a) {
#pragma unroll
    for (int it = 0; it < NIT; ++it) { const int idx = F.tid + it * (NWAVES * 64), row = idx >> 3, ph = idx & 7; const int t = pass_tok(mode, a, row);
        const int ck = ph ^ ((row >> 1) & 7), cv = ph ^ (((row >> 1) & 3) << 1);
        R.k[it] = (v4u){0u, 0u, 0u, 0u}; R.v[it] = (v4u){0u, 0u, 0u, 0u};
        if (t >= 0) { const bf16* rp = P + (size_t)t * NPROJ + h * 64; R.k[it] = *(const GAS v4u*)(rp + AW + ck * 8); R.v[it] = *(const GAS v4u*)(rp + 2 * AW + cv * 8); } }
}
template <int NIT> __device__ __forceinline__ void commit(Frame& F, const Pre& R) {
#pragma unroll
    for (int it = 0; it < NIT; ++it) { const int idx = F.tid + it * (NWAVES * 64);
        *(LAS v4u*)(F.lds + LDS_K + idx * 16) = R.k[it]; *(LAS v4u*)(F.lds + LDS_V + idx * 16) = R.v[it]; }
}
__device__ __forceinline__ float xmax4(float v) {
    auto a = __builtin_amdgcn_permlane16_swap(__float_as_uint(v), __float_as_uint(v), false, false); v = fmaxf(__uint_as_float(a[0]), __uint_as_float(a[1]));
    auto b = __builtin_amdgcn_permlane32_swap(__float_as_uint(v), __float_as_uint(v), false, false); return fmaxf(__uint_as_float(b[0]), __uint_as_float(b[1]));
}
__device__ __forceinline__ float xsum4(float v) {
    auto a = __builtin_amdgcn_permlane16_swap(__float_as_uint(v), __float_as_uint(v), false, false); v = __uint_as_float(a[0]) + __uint_as_float(a[1]);
    auto b = __builtin_amdgcn_permlane32_swap(__float_as_uint(v), __float_as_uint(v), false, false); return __uint_as_float(b[0]) + __uint_as_float(b[1]);
}
__device__ __forceinline__ void load_q(QT& T, const bf16* qrow  , int g) {
#pragma unroll
    for (int ks = 0; ks < 2; ++ks) { const v4u w = *(const GAS v4u*)(qrow + 8 * g + 32 * ks); const float sc = 0.125f * LOG2E; v4u o;
        o.x = pk2(bflo(w.x) * sc, bfhi(w.x) * sc); o.y = pk2(bflo(w.y) * sc, bfhi(w.y) * sc); o.z = pk2(bflo(w.z) * sc, bfhi(w.z) * sc); o.w = pk2(bflo(w.w) * sc, bfhi(w.w) * sc);
        T.q[ks] = __builtin_bit_cast(bf16x8, o); }
#pragma unroll
    for (int db = 0; db < 4; ++db) T.o[db] = (f32x4){0.f, 0.f, 0.f, 0.f};
    T.m = -1e30f; T.l = 0.f;
}
typedef float f32x2_t __attribute__((ext_vector_type(2))); typedef __bf16 bf16x2_t __attribute__((ext_vector_type(2)));
__device__ __forceinline__ unsigned cvtpk(float lo, float hi) { f32x2_t v = {lo, hi}; bf16x2_t b = __builtin_convertvector(v, bf16x2_t); return __builtin_bit_cast(unsigned, b); }
constexpr float THR = 8.0f;
template <int NQ, int NP> __device__ __forceinline__ void attn_step(QT (&T)[NQ], const LAS unsigned char* kp, const LAS unsigned char* vp, const LAS float* const (&tp)[NQ], int p, int koff0, int koff1, const int (&voff)[4], int klo, int khi, bool edge, int g) {
    bf16x8 kf[NP][4]; v4i16 vlo[NP][4], vhi[NP][4];
#pragma unroll
    for (int c = 0; c < NP; ++c) { kf[c][0] = *(const LAS bf16x8*)(kp + c * 4096 + koff0); kf[c][1] = *(const LAS bf16x8*)(kp + c * 4096 + koff1); kf[c][2] = *(const LAS bf16x8*)(kp + c * 4096 + 2048 + koff0); kf[c][3] = *(const LAS bf16x8*)(kp + c * 4096 + 2048 + koff1);
#pragma unroll
        for (int db = 0; db < 4; ++db) { vlo[c][db] = vtr(vp + c * 4096 + voff[db]); vhi[c][db] = vtr(vp + c * 4096 + 2048 + voff[db]); } }
#pragma unroll
    for (int n = 0; n < NQ; ++n) {
        f32x4 s[NP][2];
#pragma unroll
        for (int c = 0; c < NP; ++c) {
            s[c][0] = *(const LAS f32x4*)(tp[n] + (p + c) * 32); s[c][1] = *(const LAS f32x4*)(tp[n] + (p + c) * 32 + 16);
            s[c][0] = __builtin_amdgcn_mfma_f32_16x16x32_bf16(kf[c][0], T[n].q[0], s[c][0], 0, 0, 0); s[c][0] = __builtin_amdgcn_mfma_f32_16x16x32_bf16(kf[c][1], T[n].q[1], s[c][0], 0, 0, 0);
            s[c][1] = __builtin_amdgcn_mfma_f32_16x16x32_bf16(kf[c][2], T[n].q[0], s[c][1], 0, 0, 0); s[c][1] = __builtin_amdgcn_mfma_f32_16x16x32_bf16(kf[c][3], T[n].q[1], s[c][1], 0, 0, 0);
            if (edge) { const int kk = (p + c) * 32 + 4 * g;
#pragma unroll
                for (int r = 0; r < 4; ++r) { if (kk + r < klo || kk + r >= khi) s[c][0][r] = -INFINITY; if (kk + 16 + r < klo || kk + 16 + r >= khi) s[c][1][r] = -INFINITY; } } }
        float tm = fmaxf(fmaxf(fmaxf(s[0][0][0], s[0][0][1]), fmaxf(s[0][0][2], s[0][0][3])), fmaxf(fmaxf(s[0][1][0], s[0][1][1]), fmaxf(s[0][1][2], s[0][1][3])));
        if (NP == 2) tm = fmaxf(tm, fmaxf(fmaxf(fmaxf(s[NP - 1][0][0], s[NP - 1][0][1]), fmaxf(s[NP - 1][0][2], s[NP - 1][0][3])), fmaxf(fmaxf(s[NP - 1][1][0], s[NP - 1][1][1]), fmaxf(s[NP - 1][1][2], s[NP - 1][1][3]))));
        tm = xmax4(tm);
        if (__any(tm > T[n].m + THR)) { const float mn = fmaxf(T[n].m, tm), al = __builtin_amdgcn_exp2f(T[n].m - mn); T[n].m = mn; T[n].l *= al;
#pragma unroll
            for (int db = 0; db < 4; ++db) T[n].o[db] = T[n].o[db] * al; }
        const float mref = T[n].m; float ls = 0.f;
#pragma unroll
        for (int c = 0; c < NP; ++c) {
#pragma unroll
            for (int r = 0; r < 4; ++r) { s[c][0][r] = __builtin_amdgcn_exp2f(s[c][0][r] - mref); s[c][1][r] = __builtin_amdgcn_exp2f(s[c][1][r] - mref); }
            ls += ((s[c][0][0] + s[c][0][1]) + (s[c][0][2] + s[c][0][3])) + ((s[c][1][0] + s[c][1][1]) + (s[c][1][2] + s[c][1][3])); }
        T[n].l += ls;
#pragma unroll
        for (int c = 0; c < NP; ++c) {
            v4u pw; pw.x = cvtpk(s[c][0][0], s[c][0][1]); pw.y = cvtpk(s[c][0][2], s[c][0][3]); pw.z = cvtpk(s[c][1][0], s[c][1][1]); pw.w = cvtpk(s[c][1][2], s[c][1][3]);
            const bf16x8 pf = __builtin_bit_cast(bf16x8, pw);
#pragma unroll
            for (int db = 0; db < 4; ++db) { const bf16x8 vf = (bf16x8){vlo[c][db][0], vlo[c][db][1], vlo[c][db][2], vlo[c][db][3], vhi[c][db][0], vhi[c][db][1], vhi[c][db][2], vhi[c][db][3]};
                T[n].o[db] = __builtin_amdgcn_mfma_f32_16x16x32_bf16(vf, pf, T[n].o[db], 0, 0, 0); } }
    }
}
template <int NQ> __device__ __forceinline__ void attn_job(QT (&T)[NQ], const LAS unsigned char* Kw, const LAS unsigned char* Vw, int npairs, const LAS float* const (&tp)[NQ], int klo, int khi, bool edge, int lane) {
    const int i = lane & 15, g = lane >> 4;
    const int koff0 = i * 128 + (((g) ^ (i >> 1)) << 4), koff1 = i * 128 + (((g + 4) ^ (i >> 1)) << 4);
    const int qq = i >> 2, pp = i & 3, vr = 4 * g + qq, fv = (vr >> 1) & 3;
    int voff[4];
#pragma unroll
    for (int db = 0; db < 4; ++db) voff[db] = vr * 128 + ((((db ^ fv) << 1) + (pp >> 1)) << 4) + (pp & 1) * 8;
    int p = 0;
    if (NQ == 1) {
#pragma unroll 1
        for (; p + 2 <= npairs; p += 2) attn_step<NQ, 2>(T, Kw + p * 4096, Vw + p * 4096, tp, p, koff0, koff1, voff, klo, khi, edge, g);
    }
#pragma unroll 1
    for (; p < npairs; ++p) attn_step<NQ, 1>(T, Kw + p * 4096, Vw + p * 4096, tp, p, koff0, koff1, voff, klo, khi, edge, g);
}
__device__ __forceinline__ void four_ssq(Frame& F) {
    const bf16* A2 = (const bf16*)(F.ws + WS_A2); float* SSA = (float*)(F.ws + WS_SSA);
    const int gw = F.vcu * NWAVES + F.wave, NGW = F.G * NWAVES;
    for (int m0 = gw; m0 < M; m0 += 4 * NGW) { v2u w[4];
#pragma unroll
        for (int r = 0; r < 4; ++r) { const int m = (m0 + r * NGW) < M ? (m0 + r * NGW) : 0; w[r] = *(const GAS v2u*)(A2 + (size_t)m * MIXW + AW + 4 * F.lane); }
#pragma unroll
        for (int r = 0; r < 4; ++r) { const int m = m0 + r * NGW; const float a = bflo(w[r].x), b2 = bfhi(w[r].x), c = bflo(w[r].y), d = bfhi(w[r].y);
            const float s = wave_sum((a * a + b2 * b2) + (c * c + d * d));
            if (m < M && F.lane == 0) *(GAS f32x4*)(SSA + (size_t)m * 16 + 12) = (f32x4){s, 0.f, 0.f, 0.f}; } }
}
__device__ __forceinline__ void phase_local(Frame& F) {
    constexpr int NU = BATCH * NH * 16; const int per = (NU + F.G - 1) / F.G, ub = F.vcu * per, ue = (ub + per) < NU ? (ub + per) : NU;
    const bf16* PROJ = (const bf16*)(F.ws + WS_PROJ); const int lane = F.lane, w = F.wave, i = lane & 15, g = lane >> 4;
    const int idx4 = w >> 1, rA = w & 1, rB = 2 + (w & 1);
    Pre R; int hprev = -1;
    __syncthreads();
    if (ub < ue) { const int bh = ub >> 4; prefetch<6>(F, R, PROJ + (size_t)(bh / NH) * SEQ * NPROJ, bh % NH, 0, (ub & 15) * 256); }
    for (int u = ub; u < ue; ++u) {
        const int bh = u >> 4, b = bh / NH, h = bh % NH, s0 = (u & 15) * 256;
        const bf16* P = PROJ + (size_t)b * SEQ * NPROJ; bf16* A2 = (bf16*)(F.ws + WS_A2) + (size_t)b * SEQ * MIXW; float* ML = (float*)(F.ws + WS_ML) + (size_t)b * SEQ * NH * 2;
        __syncthreads();
        commit<6>(F, R);
        if (h != hprev) { build_table(F, LDS_T0, 0, h); build_table(F, LDS_T1, 1, h); hprev = h; }
        __syncthreads();
        const int u0 = s0 / 4 - 64;
        QT T[2];
        const int tokA = s0 + rA + 4 * (16 * idx4 + i), tokB = s0 + rB + 4 * (16 * idx4 + i);
        load_q(T[0], P + (size_t)tokA * NPROJ + h * 64, g); load_q(T[1], P + (size_t)tokB * NPROJ + h * 64, g);
        asm volatile("" ::: "memory");
        prefetch<6>(F, R, P, h, 1, u0);
        {
            const LAS float* tp[2] = { table_ptr(F, LDS_T0, 4 * g - 4 * i - rA + TPAD0), table_ptr(F, LDS_T0, 4 * g - 4 * i - rB + TPAD0) };
            int klo = 64 - s0 - 64 * idx4; klo = klo > 0 ? klo : 0; int khi = SEQ + 64 - s0 - 64 * idx4; khi = khi < 192 ? khi : 192;
            attn_job<2>(T, F.lds + LDS_K + 64 * idx4 * 128, F.lds + LDS_V + 64 * idx4 * 128, 6, tp, klo, khi, (klo > 0 || khi < 192), lane);
        }
#pragma unroll
        for (int pass = 0; pass < 2; ++pass) {
            __syncthreads();
            commit<6>(F, R);
            __syncthreads();
            if (pass == 0) prefetch<6>(F, R, P, h, 2, u0);
            else if (u + 1 < ue) { const int bh2 = (u + 1) >> 4; prefetch<6>(F, R, PROJ + (size_t)(bh2 / NH) * SEQ * NPROJ, bh2 % NH, 0, ((u + 1) & 15) * 256); }
            const int cl = w & 1, lo = idx4 < 2 ? idx4 : 2;
            const LAS float* tp[1] = { table_ptr(F, LDS_T1, 4 * g - i + 16 * (lo - idx4) + TPAD0) };
            int klo = -(u0 + 16 * lo); klo = klo > 0 ? klo : 0; int khi = SEQ / 4 - (u0 + 16 * lo); khi = khi < 160 ? khi : 160;
            QT (&Tp)[1] = *(QT (*)[1])(&T[pass]);
            attn_job<1>(Tp, F.lds + LDS_K + (192 * cl + 16 * lo) * 128, F.lds + LDS_V + (192 * cl + 16 * lo) * 128, 5, tp, klo, khi, (klo > 0 || khi < 160), lane);
        }
#pragma unroll
        for (int n = 0; n < 2; ++n) {
            const float l = xsum4(T[n].l); const float inv = 1.0f / l; const int tok = n == 0 ? tokA : tokB;
#pragma unroll
            for (int db = 0; db < 4; ++db) { v2u o; o.x = pk2(T[n].o[db][0] * inv, T[n].o[db][1] * inv); o.y = pk2(T[n].o[db][2] * inv, T[n].o[db][3] * inv);
                *(GAS v2u*)(A2 + (size_t)tok * MIXW + h * 64 + 16 * db + 4 * g) = o; }
            if (g == 0) { float* mlp = ML + ((size_t)tok * NH + h) * 2; mlp[0] = T[n].m; mlp[1] = l; }
        }
    }
    __syncthreads();
}
__device__ __forceinline__ void phase_class(Frame& F) {
    four_ssq(F);
    constexpr int NU = BATCH * NH * 16; const int per = (NU + F.G - 1) / F.G, ub = F.vcu * per, ue = (ub + per) < NU ? (ub + per) : NU;
    const bf16* PROJ = (const bf16*)(F.ws + WS_PROJ); const int lane = F.lane, w = F.wave, i = lane & 15, g = lane >> 4; float* SSA = (float*)(F.ws + WS_SSA);
    Pre R; int hprev = -1;
    __syncthreads();
    if (ub < ue) { const int bh = ub >> 4; prefetch<4>(F, R, PROJ + (size_t)(bh / NH) * SEQ * NPROJ, bh % NH, 3, ub & 15); }
    for (int u = ub; u < ue; ++u) {
        const int bh = u >> 4, b = bh / NH, h = bh % NH, r = u & 15;
        const bf16* P = PROJ + (size_t)b * SEQ * NPROJ; bf16* A2 = (bf16*)(F.ws + WS_A2) + (size_t)b * SEQ * MIXW; const float* ML = (const float*)(F.ws + WS_ML) + (size_t)b * SEQ * NH * 2;
        __syncthreads();
        commit<4>(F, R);
        if (h != hprev) { build_table(F, LDS_T0, 2, h); hprev = h; }
        __syncthreads();
        QT T2[2]; float mlv[2], llv[2]; v2u pvv[2][4];
#pragma unroll
        for (int n = 0; n < 2; ++n) { const int qt = n == 0 ? (w < 7 ? w : 11) : (w < 4 ? w + 7 : (w < 7 ? w + 8 : 15)); const int tok = r + 16 * (16 * qt + i);
            load_q(T2[n], P + (size_t)tok * NPROJ + h * 64, g);
            const float* mlp = ML + ((size_t)tok * NH + h) * 2; mlv[n] = mlp[0]; llv[n] = mlp[1];
#pragma unroll
            for (int db = 0; db < 4; ++db) pvv[n][db] = *(const GAS v2u*)(A2 + (size_t)tok * MIXW + h * 64 + 16 * db + 4 * g); }
        asm volatile("" ::: "memory");
        if (u + 1 < ue) { const int bh2 = (u + 1) >> 4; prefetch<4>(F, R, PROJ + (size_t)(bh2 / NH) * SEQ * NPROJ, bh2 % NH, 3, (u + 1) & 15); }
#pragma unroll
        for (int n = 0; n < 2; ++n) {
            const int qt = n == 0 ? (w < 7 ? w : 11) : (w < 4 ? w + 7 : (w < 7 ? w + 8 : 15));
            int lo = qt - 4 > 0 ? qt - 4 : 0, hi = qt + 4 < 15 ? qt + 4 : 15; if (((hi - lo + 1) & 1) != 0) { if (hi < 15) ++hi; else --lo; }
            const int tok = r + 16 * (16 * qt + i);
            QT (&T)[1] = *(QT (*)[1])(&T2[n]);
            const LAS float* tp[1] = { table_ptr(F, LDS_T0, 4 * g - i + 16 * (lo - qt) + 64 + TPAD0) };
            attn_job<1>(T, F.lds + LDS_K + 16 * lo * 128, F.lds + LDS_V + 16 * lo * 128, (hi - lo + 1) >> 1, tp, 0, 1 << 20, false, lane);
            const float l16 = xsum4(T[0].l);
            const float ml = mlv[n], ll = llv[n];
            const float mm = fmaxf(ml, T[0].m), a = __builtin_amdgcn_exp2f(ml - mm) * ll, bb = __builtin_amdgcn_exp2f(T[0].m - mm), inv = 1.0f / (a + bb * l16); float sq = 0.f;
#pragma unroll
            for (int db = 0; db < 4; ++db) { GAS v2u* op = (GAS v2u*)(A2 + (size_t)tok * MIXW + h * 64 + 16 * db + 4 * g); const v2u pv = pvv[n][db]; v2u o;
                const float f0 = (bflo(pv.x) * a + T[0].o[db][0] * bb) * inv, f1 = (bfhi(pv.x) * a + T[0].o[db][1] * bb) * inv, f2 = (bflo(pv.y) * a + T[0].o[db][2] * bb) * inv, f3 = (bfhi(pv.y) * a + T[0].o[db][3] * bb) * inv;
                sq += (f0 * f0 + f1 * f1) + (f2 * f2 + f3 * f3); o.x = pk2(f0, f1); o.y = pk2(f2, f3);
                *op = o; }
            sq = xsum4(sq);
            if (g == 0) SSA[((size_t)b * SEQ + tok) * 16 + h] = sq;
        }
    }
    __syncthreads();
}
}


namespace fou {
typedef short bf16x8 __attribute__((ext_vector_type(8)));
typedef short v4i16 __attribute__((ext_vector_type(4)));
constexpr int LX = 0, LC = LDSCTL_OFF + 8192, LS = LDSCTL_OFF + 16384;
__device__ __forceinline__ int gsw(int s2) { const int pr = (s2 >> 1) & 7; return (pr & 4) | ((pr & 1) << 1) | ((pr >> 1) & 1); }
__device__ __forceinline__ int xaddr(int pe, int s2, int chunk) { return LX + pe * 8192 + s2 * 128 + (((chunk ^ gsw(s2) ^ pe) & 7) << 4); }
__device__ __forceinline__ int maddr(int base, int k, int chunk) { return base + k * 128 + (((chunk ^ (k >> 1)) & 7) << 4); }
__device__ __forceinline__ v4i16 vtr(const LAS unsigned char* p) { return __builtin_amdgcn_ds_read_tr16_b64_v4i16((LAS v4i16*)p); }
__device__ __forceinline__ bf16x8 neg8(bf16x8 v) { v4u w = __builtin_bit_cast(v4u, v); w.x ^= 0x80008000u; w.y ^= 0x80008000u; w.z ^= 0x80008000u; w.w ^= 0x80008000u; return __builtin_bit_cast(bf16x8, w); }

__device__ __forceinline__ void fourier_unit(Frame& F, int b, int g, int ec) {
    const bf16* PROJ = (const bf16*)(F.ws + WS_PROJ); bf16* A2 = (bf16*)(F.ws + WS_A2); const float* tabMg = (const float*)(F.ws + WS_TAB + TAB_MG);
    const int lane = F.lane, w = F.wave, li = lane & 15, gq = lane >> 4, e0 = 8 * ec;
    LAS unsigned char* L = F.lds;
    __syncthreads();
    bf16x8 mb[2];
#pragma unroll
    for (int ks = 0; ks < 2; ++ks) { float v[8];
#pragma unroll
        for (int j = 0; j < 8; ++j) { const int c = 8 * gq + j + 32 * ks; const int col = li < 8 ? e0 + li : 64 + e0 + (li & 7); v[j] = tabMg[(g * 64 + c) * 128 + col]; }
        v4u o; o.x = pk2(v[0], v[1]); o.y = pk2(v[2], v[3]); o.z = pk2(v[4], v[5]); o.w = pk2(v[6], v[7]); mb[ks] = __builtin_bit_cast(bf16x8, o); }
    const bf16* ub = PROJ + (size_t)(b * SEQ) * NPROJ + 3 * AW + g * 64 + 8 * gq;
#pragma unroll 8
    for (int it = 0; it < 32; ++it) { const int tile = w + 8 * it, s2 = tile & 63, tq = tile >> 6;
        const bf16* up = ub + (size_t)(64 * (16 * tq + li) + s2) * NPROJ;
        const bf16x8 a0 = __builtin_bit_cast(bf16x8, *(const GAS v4u*)up), a1 = __builtin_bit_cast(bf16x8, *(const GAS v4u*)(up + 32));
        f32x4 d = (f32x4){0.f, 0.f, 0.f, 0.f};
        d = __builtin_amdgcn_mfma_f32_16x16x32_bf16(a0, mb[0], d, 0, 0, 0); d = __builtin_amdgcn_mfma_f32_16x16x32_bf16(a1, mb[1], d, 0, 0, 0);
        v2u o; o.x = pk2(d[0], d[1]); o.y = pk2(d[2], d[3]); *(LAS v2u*)(L + xaddr(li, s2, 2 * tq + (gq >> 1)) + (gq & 1) * 8) = o; }
    __syncthreads();
    const int e = w;
#pragma unroll 1
    for (int mt = 0; mt < 4; ++mt) { const int s2 = 16 * mt + li;
        bf16x8 yr[2], yi[2], nyr[2];
#pragma unroll
        for (int kh = 0; kh < 2; ++kh) { yr[kh] = *(const LAS bf16x8*)(L + xaddr(e, s2, gq + 4 * kh)); yi[kh] = *(const LAS bf16x8*)(L + xaddr(8 + e, s2, gq + 4 * kh)); nyr[kh] = neg8(yr[kh]); }
#pragma unroll
        for (int nt = 0; nt < 4; ++nt) { const int k = 16 * nt + li;
            const bf16x8 c0 = *(const LAS bf16x8*)(L + maddr(LC, k, gq)), c1 = *(const LAS bf16x8*)(L + maddr(LC, k, gq + 4)), s0 = *(const LAS bf16x8*)(L + maddr(LS, k, gq)), s1 = *(const LAS bf16x8*)(L + maddr(LS, k, gq + 4));
            f32x4 tr = (f32x4){0.f, 0.f, 0.f, 0.f}, ti = (f32x4){0.f, 0.f, 0.f, 0.f};
            tr = __builtin_amdgcn_mfma_f32_16x16x32_bf16(c0, yr[0], tr, 0, 0, 0); tr = __builtin_amdgcn_mfma_f32_16x16x32_bf16(c1, yr[1], tr, 0, 0, 0);
            tr = __builtin_amdgcn_mfma_f32_16x16x32_bf16(s0, yi[0], tr, 0, 0, 0); tr = __builtin_amdgcn_mfma_f32_16x16x32_bf16(s1, yi[1], tr, 0, 0, 0);
            ti = __builtin_amdgcn_mfma_f32_16x16x32_bf16(c0, yi[0], ti, 0, 0, 0); ti = __builtin_amdgcn_mfma_f32_16x16x32_bf16(c1, yi[1], ti, 0, 0, 0);
            ti = __builtin_amdgcn_mfma_f32_16x16x32_bf16(s0, nyr[0], ti, 0, 0, 0); ti = __builtin_amdgcn_mfma_f32_16x16x32_bf16(s1, nyr[1], ti, 0, 0, 0);
            float orr[4], oii[4];
#pragma unroll
            for (int r = 0; r < 4; ++r) { const int k1 = 16 * nt + 4 * gq + r; const float rev = (float)((k1 * s2) & 4095) * (1.0f / 4096.0f); const float cv = __builtin_amdgcn_cosf(rev), sv = __builtin_amdgcn_sinf(rev);
                orr[r] = tr[r] * cv + ti[r] * sv; oii[r] = ti[r] * cv - tr[r] * sv; }
            v2u o; o.x = pk2(orr[0], orr[1]); o.y = pk2(orr[2], orr[3]); *(LAS v2u*)(L + xaddr(e, s2, 2 * nt + (gq >> 1)) + (gq & 1) * 8) = o;
            o.x = pk2(oii[0], oii[1]); o.y = pk2(oii[2], oii[3]); *(LAS v2u*)(L + xaddr(8 + e, s2, 2 * nt + (gq >> 1)) + (gq & 1) * 8) = o; } }
    asm volatile("s_waitcnt lgkmcnt(0)" ::: "memory");
    bf16x8 af[4][4];
    { const int q = li >> 2, p = li & 3;
#pragma unroll
      for (int mt = 0; mt < 4; ++mt)
#pragma unroll
        for (int ks = 0; ks < 4; ++ks) { const int pe = (ks >> 1) * 8 + e, s2b = 8 * gq + 32 * (ks & 1) + q;
            const v4i16 lo = vtr(L + xaddr(pe, s2b, 2 * mt + (p >> 1)) + (p & 1) * 8), hi = vtr(L + xaddr(pe, s2b + 4, 2 * mt + (p >> 1)) + (p & 1) * 8);
            af[mt][ks] = (bf16x8){lo[0], lo[1], lo[2], lo[3], hi[0], hi[1], hi[2], hi[3]}; } }
    asm volatile("s_waitcnt lgkmcnt(0)" ::: "memory");
    __syncthreads();
    const float bias = F.f_b[g * 64 + e0 + e];
#pragma unroll 1
    for (int nt = 0; nt < 4; ++nt) { const int k2 = 16 * nt + li;
        const bf16x8 c0 = *(const LAS bf16x8*)(L + maddr(LC, k2, gq)), c1 = *(const LAS bf16x8*)(L + maddr(LC, k2, gq + 4)), s0 = *(const LAS bf16x8*)(L + maddr(LS, k2, gq)), s1 = *(const LAS bf16x8*)(L + maddr(LS, k2, gq + 4));
#pragma unroll
        for (int mt = 0; mt < 4; ++mt) { f32x4 d = (f32x4){0.f, 0.f, 0.f, 0.f};
            d = __builtin_amdgcn_mfma_f32_16x16x32_bf16(af[mt][0], c0, d, 0, 0, 0); d = __builtin_amdgcn_mfma_f32_16x16x32_bf16(af[mt][1], c1, d, 0, 0, 0);
            d = __builtin_amdgcn_mfma_f32_16x16x32_bf16(af[mt][2], s0, d, 0, 0, 0); d = __builtin_amdgcn_mfma_f32_16x16x32_bf16(af[mt][3], s1, d, 0, 0, 0);
#pragma unroll
            for (int r = 0; r < 4; ++r) { const int k1 = 16 * mt + 4 * gq + r; *(LAS bf16*)(L + LX + (k1 * 64 + k2) * 16 + e * 2) = (bf16)f2bf(d[r] * (1.0f / 512.0f) + bias); } } }
    __syncthreads();
    bf16* ob = A2 + (size_t)(b * SEQ) * MIXW + AW + g * 64 + e0;
#pragma unroll
    for (int j = 0; j < 8; ++j) { const int sl = F.tid + 512 * j, k1 = sl >> 6, k2 = sl & 63; const v4u v = *(const LAS v4u*)(L + LX + sl * 16); *(GAS v4u*)(ob + (size_t)(k1 + 64 * k2) * MIXW) = v; }
}
__device__ __forceinline__ void phase_fourier(Frame& F) {
    const float* tabTw = (const float*)(F.ws + WS_TAB + TAB_TW);
    __syncthreads();
    for (int idx = F.tid; idx < 4096; idx += NWAVES * 64) { const int k = idx >> 6, s = idx & 63, n = ((k * s) & 63) * 64;
        *(LAS bf16*)(F.lds + maddr(LC, k, s >> 3) + (s & 7) * 2) = (bf16)f2bf(tabTw[2 * n]); *(LAS bf16*)(F.lds + maddr(LS, k, s >> 3) + (s & 7) * 2) = (bf16)f2bf(tabTw[2 * n + 1]); }
    __syncthreads();
    for (int u = F.vcu; u < BATCH * NG * 8; u += F.G) fourier_unit(F, u >> 5, (u >> 3) & 3, u & 7);
    __syncthreads();
}
}

__device__ __forceinline__ void p10_final(Frame& F) {
    const bf16* X2 = (const bf16*)(F.ws + WS_XN); const float* SS2 = (const float*)(F.ws + WS_SS2);
    const int gw = F.vcu * NWAVES + F.wave, NGW = F.G * NWAVES; const int lane = F.lane;
    const GAS f32x4* gr = (const GAS f32x4*)(F.g_fin + 16 * lane); const f32x4 g0 = gr[0], g1 = gr[1], g2 = gr[2], g3 = gr[3];
    for (int m0 = gw; m0 < M; m0 += 4 * NGW) { v4u w0[4], w1[4]; float part[4];
#pragma unroll
        for (int r = 0; r < 4; ++r) { const int m = (m0 + r * NGW) < M ? (m0 + r * NGW) : 0; const GAS v4u* rp = (const GAS v4u*)(X2 + (size_t)m * D + 16 * lane); w0[r] = rp[0]; w1[r] = rp[1];
            part[r] = lane < 16 ? SS2[(size_t)m * 16 + lane] : 0.f; }
#pragma unroll
        for (int r = 0; r < 4; ++r) { const int m = m0 + r * NGW; const float rstd = 1.0f / sqrtf(wave_sum(part[r]) * (1.f / D) + EPS);
            if (m < M) { GAS f32x4* op = (GAS f32x4*)(F.out + (size_t)m * D + 16 * lane);
                op[0] = (f32x4){bflo(w0[r].x), bfhi(w0[r].x), bflo(w0[r].y), bfhi(w0[r].y)} * rstd * g0; op[1] = (f32x4){bflo(w0[r].z), bfhi(w0[r].z), bflo(w0[r].w), bfhi(w0[r].w)} * rstd * g1;
                op[2] = (f32x4){bflo(w1[r].x), bfhi(w1[r].x), bflo(w1[r].y), bfhi(w1[r].y)} * rstd * g2; op[3] = (f32x4){bflo(w1[r].z), bfhi(w1[r].z), bflo(w1[r].w), bfhi(w1[r].w)} * rstd * g3; } } }
}


__device__ __forceinline__ void p8_halo_fix(Frame& F, int pm) {
    const float* H = (const float*)(F.ws + WS_HALO); bf16* ACT = (bf16*)(F.ws + WS_GV); const int kt = pm & 15;
    for (int it = F.tid; it < 2 * (FF / 4); it += NWAVES * 64) { const int c4 = (it % (FF / 4)) * 4, side = it / (FF / 4);
        if ((side == 0 && kt == 0) || (side == 1 && kt == 15)) continue;
        const float* own = H + (size_t)(pm * 2 + side) * 3 * FF + c4; const float* nb = H + (size_t)((side == 0 ? (pm - 1) * 2 + 1 : (pm + 1) * 2)) * 3 * FF + c4;
        const f32x4 gn = *(const GAS f32x4*)nb, zp = *(const GAS f32x4*)(own + FF), vv = *(const GAS f32x4*)(own + 2 * FF), wt = *(const GAS f32x4*)(F.conv_w + (side == 0 ? 0 : 2 * FF) + c4);
        float a[4];
#pragma unroll
        for (int i = 0; i < 4; ++i) { const float z = zp[i] + wt[i] * gn[i]; a[i] = z * __builtin_amdgcn_rcpf(1.0f + __builtin_amdgcn_exp2f(-1.4426950408889634f * z)) * vv[i]; }
        const unsigned long long o = (unsigned long long)pk2(a[0], a[1]) | ((unsigned long long)pk2(a[2], a[3]) << 32);
        __hip_atomic_store((unsigned long long*)(ACT + (size_t)(pm * 256 + (side ? 255 : 0)) * FF + c4), o, __ATOMIC_RELAXED, __HIP_MEMORY_SCOPE_AGENT); }
}


__device__ __forceinline__ void p6_quant(Frame& F) {
    const bf16* X1 = (const bf16*)(F.ws + WS_XN); unsigned char* A8 = F.ws + WS_A8; float* SROW = (float*)(F.ws + WS_SS1);
    const int gw = F.vcu * NWAVES + F.wave, NGW = F.G * NWAVES, lane = F.lane;
    for (int m0 = gw; m0 < M; m0 += 4 * NGW) { v4u w0[4], w1[4];
#pragma unroll
        for (int r = 0; r < 4; ++r) { const int m = (m0 + r * NGW) < M ? (m0 + r * NGW) : 0; const GAS v4u* rp = (const GAS v4u*)(X1 + (size_t)m * D + 16 * lane); w0[r] = rp[0]; w1[r] = rp[1]; }
#pragma unroll
        for (int r = 0; r < 4; ++r) { const int m = m0 + r * NGW; float v[16];
            v[0] = bflo(w0[r].x); v[1] = bfhi(w0[r].x); v[2] = bflo(w0[r].y); v[3] = bfhi(w0[r].y); v[4] = bflo(w0[r].z); v[5] = bfhi(w0[r].z); v[6] = bflo(w0[r].w); v[7] = bfhi(w0[r].w);
            v[8] = bflo(w1[r].x); v[9] = bfhi(w1[r].x); v[10] = bflo(w1[r].y); v[11] = bfhi(w1[r].y); v[12] = bflo(w1[r].z); v[13] = bfhi(w1[r].z); v[14] = bflo(w1[r].w); v[15] = bfhi(w1[r].w);
            float ss = 0.f, mx = 0.f;
#pragma unroll
            for (int i = 0; i < 16; ++i) { ss += v[i] * v[i]; mx = fmaxf(mx, fabsf(v[i])); }
            ss = wave_sum(ss);
#pragma unroll
            for (int o = 1; o < 64; o <<= 1) mx = fmaxf(mx, __shfl_xor(mx, o));
            const float inv = mx > 0.f ? 127.0f / mx : 0.f; unsigned q[4];
#pragma unroll
            for (int j = 0; j < 4; ++j) { q[j] = 0;
#pragma unroll
                for (int t = 0; t < 4; ++t) q[j] |= ((unsigned)(int)__builtin_rintf(v[4 * j + t] * inv) & 255u) << (8 * t); }
            if (m < M) { *(GAS v4u*)(A8 + (size_t)m * D + 16 * lane) = (v4u){q[0], q[1], q[2], q[3]};
                if (lane == 0) SROW[m] = mx * (1.0f / 127.0f) * (1.0f / sqrtf(ss * (1.f / D) + EPS)); } } }
}

struct Args { const float* in[16]; float* out; unsigned char* ws; int ph_lo, ph_hi; };
__global__ void __launch_bounds__(NWAVES * 64, 2) hymba_fwd(Args args) {
    extern __shared__ __attribute__((aligned(16))) unsigned char lds[];
    Frame F;
    F.lds = (LAS unsigned char*)lds;
    F.MISC = (volatile LAS unsigned*)(F.lds + MISC_OFF);
    F.tid = threadIdx.x; F.lane = F.tid & 63; F.wave = __builtin_amdgcn_readfirstlane(F.tid >> 6);
    F.G = gridDim.x; { const int bx = blockIdx.x; F.vcu = (F.G % 8 == 0) ? (bx % 8) * (F.G / 8) + bx / 8 : bx; }
    F.ws = args.ws; F.ctl = (gu32*)(args.ws + WS_CTL);
    F.x = args.in[0]; F.g_mix = args.in[1]; F.w_in = args.in[2]; F.g_attn = args.in[3]; F.rel_tab = args.in[4]; F.f_w = args.in[5]; F.f_b = args.in[6]; F.g_four = args.in[7];
    F.w_out = args.in[8]; F.g_ffn = args.in[9]; F.w_gate = args.in[10]; F.w_val = args.in[11]; F.conv_w = args.in[12]; F.conv_b = args.in[13]; F.w_down = args.in[14]; F.g_fin = args.in[15];
    F.out = args.out;
    for (int u = F.tid; u < (LDS_BYTES - LDSCTL_OFF) / 4; u += NWAVES * 64) ((LAS unsigned*)(F.lds + LDSCTL_OFF))[u] = 0u;
    const unsigned long long pc0 = __builtin_amdgcn_s_getpc() & ~127ull;
#define CODE_PREFETCH() do { if (blockIdx.x < 16 && F.wave == 7) { const GAS unsigned* cb = (const GAS unsigned*)pc0; unsigned v[18], acc = 0u; \
        _Pragma("unroll") for (int i = 0; i < 18; ++i) v[i] = cb[(size_t)(F.lane + 64 * i) * 32]; \
        _Pragma("unroll") for (int i = 0; i < 18; ++i) acc ^= v[i]; \
        if (acc == 0x9e3779b9u) F.MISC[20] = acc; } } while (0)
    CODE_PREFETCH();
    __syncthreads();
    XcdBarrier bar; bar.bar = (unsigned*)(F.ctl + CW_BAR); bar.x = 0; bar.st = nullptr;
    if (MK_ONE_LAUNCH) bar = xcd_barrier_post((unsigned*)(F.ctl + CW_BAR), F.MISC + 8);
#define GRID_BAR() do { if (MK_ONE_LAUNCH) { xcd_barrier(bar); CODE_PREFETCH(); } } while (0)
    const int lo = args.ph_lo, hi = args.ph_hi;
#define IN(k) (lo <= (k) && (k) < hi)
#define BOTH(k) (IN(k) && IN((k) + 1))
    if (IN(0)) { p0_prologue(F); if (BOTH(0)) GRID_BAR(); }
    if (IN(1)) {
        pg8::Gemm g{(const bf16*)(F.ws + WS_XN), (const bf16*)(F.ws + WS_WIN), M, NPROJ, D, D, 0}; pg8::StaticOrder S; S.init(M, NPROJ, F.G, (int)blockIdx.x);
        pg8::EpiBf16Row E{(bf16*)(F.ws + WS_PROJ), NPROJ, (const float*)(F.ws + WS_RS0)};
        pg8::gemm_phase<pg8::EpiBf16Row, pg8::StaticOrder, true, true>(F.lds + RING_OFF, g, S, E);
        if (BOTH(1)) GRID_BAR();
    }
    if (IN(2)) { att::phase_local(F); fou::phase_fourier(F); if (BOTH(2)) GRID_BAR(); }
    if (IN(3)) { att::phase_class(F); if (IN(3) && IN(5)) GRID_BAR(); }
    if (IN(5)) {
        pg8::Gemm g{(const bf16*)(F.ws + WS_A2), (const bf16*)(F.ws + WS_WOUT), M, D, MIXW, MIXW, 0}; pg8::StaticOrder S; S.init(M, D, F.G, (int)blockIdx.x);
        if (F.G == 256) {
            pg8::EpiX1Q E{(const bf16*)(F.ws + WS_XN), (bf16*)(F.ws + WS_XN), D, (const float*)(F.ws + WS_SSA), (LAS float*)(F.lds + LDSCTL_OFF + 8192), F.ws + WS_A8, (float*)(F.ws + WS_SS1), (float*)(F.ws + WS_XBUF), (unsigned*)(F.ctl + CW_PANEL2), F.lds + LDSCTL_OFF};
            pg8::gemm_phase<pg8::EpiX1Q, pg8::StaticOrder, true, true>(F.lds + RING_OFF, g, S, E);
        } else {
            pg8::EpiX1N E{(const bf16*)(F.ws + WS_XN), (bf16*)(F.ws + WS_XN), D, (float*)(F.ws + WS_SS1), (const float*)(F.ws + WS_SSA), (LAS float*)(F.lds + LDSCTL_OFF + 8192)};
            pg8::gemm_phase<pg8::EpiX1N, pg8::StaticOrder, true, true>(F.lds + RING_OFF, g, S, E);
        }
        if (IN(5) && IN(6)) GRID_BAR();
    }
    if (IN(6) && F.G != 256) { p6_quant(F); if (IN(6) && IN(7)) GRID_BAR(); }
    if (IN(7)) {
        pg8::Gemm g{(const bf16*)(F.ws + WS_A8), (const bf16*)(F.ws + WS_WGV), M, 2 * FF, D / 2, D / 2, 0}; pg8::StaticOrder S; S.init(M, 2 * FF, F.G, (int)blockIdx.x);
        pg8::EpiConvGlu E{(bf16*)(F.ws + WS_GV), FF, (const float*)(F.ws + WS_SS1), F.conv_w, F.conv_b, (LAS float*)(F.lds + LDSCTL_OFF + 4096), M, (float*)(F.ws + WS_HALO), (const float*)(F.ws + WS_TAB + TAB_CW4)};
        pg8::gemm_phase<pg8::EpiConvGlu, pg8::StaticOrder, true, true, true>(F.lds + RING_OFF, g, S, E);
        if (IN(7) && IN(9)) GRID_BAR();
    }
    if (IN(9)) {
        pg8::Gemm g{(const bf16*)(F.ws + WS_GV), (const bf16*)(F.ws + WS_WD), M, D, FF, FF, 0}; pg8::StaticOrder S; S.init(M, D, F.G, (int)blockIdx.x);
        { pg8::Unit uu; for (int i = 0; S.next(i, uu); ++i) p8_halo_fix(F, uu.pm); }
        asm volatile("s_waitcnt vmcnt(0)" ::: "memory"); __syncthreads();
        if (F.G == 256) {
            pg8::EpiFinal E{(const bf16*)(F.ws + WS_XN), F.out, D, F.g_fin, (float*)(F.ws + WS_XBUF), (unsigned*)(F.ctl + CW_PANEL), F.lds + LDSCTL_OFF + 4096};
            pg8::gemm_phase<pg8::EpiFinal, pg8::StaticOrder, true, true>(F.lds + RING_OFF, g, S, E);
        } else {
            pg8::EpiX2 E{(bf16*)(F.ws + WS_XN), D, (float*)(F.ws + WS_SS2)};
            pg8::gemm_phase<pg8::EpiX2, pg8::StaticOrder, true, true>(F.lds + RING_OFF, g, S, E);
            if (BOTH(9)) GRID_BAR();
        }
    }
    if (IN(10) && F.G != 256) { p10_final(F); }
#undef IN
#undef BOTH
}

extern "C" void kernel_launch(void* const* d_in, const int* in_sizes, int n_in, void* d_out, int out_size, void* d_ws, size_t ws_size, hipStream_t stream) {
    static int grid = 0;
    if (grid == 0) {
        if (n_in != 16 || in_sizes[0] != M * D || out_size != M * D || ws_size < WS_END) { fprintf(stderr, "kernel_launch: shape/workspace mismatch: n_in %d in0 %d out %d ws %zu (need %zu)\n", n_in, n_in > 0 ? in_sizes[0] : -1, out_size, ws_size, (size_t)WS_END); grid = -1; return; }
        int dev = 0, cus = 0, per_cu = 0;
        if (hipGetDevice(&dev) != hipSuccess || hipDeviceGetAttribute(&cus, hipDeviceAttributeMultiprocessorCount, dev) != hipSuccess) { grid = -1; return; }
        if (hipFuncSetAttribute((const void*)hymba_fwd, hipFuncAttributeMaxDynamicSharedMemorySize, LDS_BYTES) != hipSuccess) { fprintf(stderr, "kernel_launch: hipFuncSetAttribute failed\n"); grid = -1; return; }
        if (hipOccupancyMaxActiveBlocksPerMultiprocessor(&per_cu, (const void*)hymba_fwd, NWAVES * 64, LDS_BYTES) != hipSuccess || per_cu < 1) { fprintf(stderr, "kernel_launch: occupancy query says %d blocks/CU\n", per_cu); (void)hipGetLastError(); grid = -1; return; }
        grid = cus;
    }
    if (grid < 0) return;
    (void)hipMemsetAsync((char*)d_ws + WS_CTL, 0, CTL_ZERO_BYTES, stream);
    Args a{};
    for (int i = 0; i < 16; ++i) a.in[i] = (const float*)d_in[i];
    a.out = (float*)d_out; a.ws = (unsigned char*)d_ws;
#if MK_ONE_LAUNCH
    a.ph_lo = 0; a.ph_hi = N_PHASES;
    hipLaunchKernelGGL(hymba_fwd, dim3(grid), dim3(NWAVES * 64), LDS_BYTES, stream, a);
#else
    for (int p = 0; p < N_PHASES; ++p) { a.ph_lo = p; a.ph_hi = p + 1; hipLaunchKernelGGL(hymba_fwd, dim3(grid), dim3(NWAVES * 64), LDS_BYTES, stream, a); }
#endif
}
```

```cpp
#include <hip/hip_runtime.h>
#include <cstdio>
#include <cstdint>

namespace pg8 {
#define PG8_LAS __attribute__((address_space(3)))
typedef unsigned short bf16_t;
typedef short bf16x8 __attribute__((ext_vector_type(8)));
typedef float f32x4 __attribute__((ext_vector_type(4)));
typedef unsigned u32x4 __attribute__((ext_vector_type(4)));
typedef int i32x4 __attribute__((ext_vector_type(4)));
template <bool I8> struct AccT { typedef f32x4 type; };
template <> struct AccT<true> { typedef i32x4 type; };
constexpr int BM = 256, BK = 64, HALF = 128, HTB = HALF * BK * 2, STAGE_BYTES = 8 * HTB, NXCD = 8, WGM = 8;

__host__ __device__ __forceinline__ int lds_byte(int r, int c) { const int st = (r >> 4) * 2 + (c >> 5), rr = r & 15, cc = c & 31, ob = rr * 64 + cc * 2; return st * 1024 + (ob ^ (((ob >> 9) & 1) << 5)); }
__host__ __device__ __forceinline__ void stage_rc(int b, int& R, int& C) { const int st = b / 1024, sb = b % 1024, swz = sb ^ (((sb >> 9) & 1) << 5); R = (st >> 1) * 16 + swz / 64; C = (st & 1) * 32 + (swz % 64) / 2; }
__host__ __device__ __forceinline__ int perm32(int rho) { const int n = rho >> 4, i = rho & 15; return 8 * (i >> 2) + 4 * n + (i & 3); }

struct Unit { int pm, pn; };
struct Gemm { const bf16_t* A; const bf16_t* Bt; int M, N, K, lda; int ovl; };
__host__ __device__ __forceinline__ int ovl_row_base(int pm) { const int b = pm / 17, k = pm - 17 * b; return b * 4096 + (k ? 254 * k - 1 : 0); }

struct StaticOrder {
    int nM, nN, nwg, G, c;
    __host__ __device__ void init(int M, int N, int G_, int c_) { nM = M / BM; nN = N / BM; nwg = nM * nN; G = G_; c = c_; }
    __host__ __device__ bool next(int i, Unit& u) const {
        const long L = (long)i * G + c; if (L >= nwg) return false;
        int wgid = (int)L; { const int q = nwg / NXCD, r = nwg % NXCD, xcd = wgid % NXCD, off = wgid / NXCD; wgid = (xcd < r ? xcd * (q + 1) : r * (q + 1) + (xcd - r) * q) + off; }
        const int nig = WGM * nN, gid = wgid / nig, fm = gid * WGM, gsz = (nM - fm) < WGM ? (nM - fm) : WGM;
        u.pm = fm + ((wgid % nig) % gsz); u.pn = (wgid % nig) / gsz; return true;
    }
    __device__ __forceinline__ void a_ready(const Unit&) const {}
    __device__ __forceinline__ void done(const Unit&) const {}
};

typedef float f32x2v_t __attribute__((ext_vector_type(2))); typedef __bf16 bf16x2v_t __attribute__((ext_vector_type(2)));
__device__ __forceinline__ unsigned cvt_pk_bf16(float lo, float hi) { f32x2v_t v = {lo, hi}; bf16x2v_t b = __builtin_convertvector(v, bf16x2v_t); return __builtin_bit_cast(unsigned, b); }

__device__ __forceinline__ void st_wt8(void* p, unsigned long long v) { asm volatile("global_store_dwordx2 %0, %1, off sc1" :: "v"(p), "v"(v)); }
__device__ __forceinline__ void st_wt(void* p, u32x4 v) { asm volatile("global_store_dwordx4 %0, %1, off sc1\n\ts_nop 2" :: "v"(p), "v"(v));        }
struct EpiBf16 {
    static constexpr bool PERM = true, AFTER_DRAIN = false, MIDK = false, PREFETCH = false;
    bf16_t* O; int ldc;
    __device__ __forceinline__ void operator()(const f32x4 (&acc)[2][2][4][2], const Unit& u, int wr, int wc, int fr, int fq) const {
        const int row0 = u.pm * BM + wr * 64 + fr; const int col0 = u.pn * BM + wc * 32 + 8 * fq;
#pragma unroll
        for (int ai = 0; ai < 2; ++ai)
#pragma unroll
            for (int m = 0; m < 4; ++m) { bf16_t* rowp = O + (size_t)(row0 + ai * HALF + m * 16) * ldc + col0;
#pragma unroll
                for (int bj = 0; bj < 2; ++bj) { const f32x4 v0 = acc[ai][bj][m][0], v1 = acc[ai][bj][m][1];
                    u32x4 w; w.x = cvt_pk_bf16(v0[0], v0[1]); w.y = cvt_pk_bf16(v0[2], v0[3]); w.z = cvt_pk_bf16(v1[0], v1[1]); w.w = cvt_pk_bf16(v1[2], v1[3]);
                    *(u32x4*)(rowp + bj * HALF) = w; } }
    }
};

struct EpiBf16Row {
    static constexpr bool PERM = true, AFTER_DRAIN = false, MIDK = false, PREFETCH = false;
    bf16_t* O; int ldc; const float* rs;
    __device__ __forceinline__ void operator()(const f32x4 (&acc)[2][2][4][2], const Unit& u, int wr, int wc, int fr, int fq) const {
        const int row0 = u.pm * BM + wr * 64 + fr; const int col0 = u.pn * BM + wc * 32 + 8 * fq;
#pragma unroll
        for (int ai = 0; ai < 2; ++ai)
#pragma unroll
            for (int m = 0; m < 4; ++m) { const int row = row0 + ai * HALF + m * 16; const float r = rs[row]; bf16_t* rowp = O + (size_t)row * ldc + col0;
#pragma unroll
                for (int bj = 0; bj < 2; ++bj) { const f32x4 v0 = acc[ai][bj][m][0] * r, v1 = acc[ai][bj][m][1] * r;
                    u32x4 w; w.x = cvt_pk_bf16(v0[0], v0[1]); w.y = cvt_pk_bf16(v0[2], v0[3]); w.z = cvt_pk_bf16(v1[0], v1[1]); w.w = cvt_pk_bf16(v1[2], v1[3]);
                    st_wt(rowp + bj * HALF, w); } }
    }
};
struct EpiResF32 {
    static constexpr bool PERM = false, AFTER_DRAIN = false, MIDK = false, PREFETCH = false;
    const float* base; float* out; int ldc;
    __device__ __forceinline__ void operator()(const f32x4 (&acc)[2][2][4][2], const Unit& u, int wr, int wc, int fr, int fq) const {
        const int col0 = u.pn * BM + wc * 32 + 4 * fq;
#pragma unroll
        for (int ai = 0; ai < 2; ++ai)
#pragma unroll
            for (int m = 0; m < 4; ++m) { const int r = u.pm * BM + ai * HALF + wr * 64 + m * 16 + fr; const size_t off = (size_t)r * ldc + col0;
#pragma unroll
                for (int bj = 0; bj < 2; ++bj)
#pragma unroll
                    for (int n = 0; n < 2; ++n) { const f32x4 bs = *(const f32x4*)(base + off + bj * HALF + n * 16); *(f32x4*)(out + off + bj * HALF + n * 16) = bs + acc[ai][bj][m][n]; } }
    }
};


struct EpiX1 {
    static constexpr bool PERM = true, AFTER_DRAIN = false, MIDK = false, PREFETCH = false;
    const float* base; bf16_t* O; int ldc; float* ss;
    __device__ __forceinline__ void operator()(const f32x4 (&acc)[2][2][4][2], const Unit& u, int wr, int wc, int fr, int fq) const {
        const int row0 = u.pm * BM + wr * 64 + fr; const int col0 = u.pn * BM + wc * 32 + 8 * fq;
#pragma unroll
        for (int ai = 0; ai < 2; ++ai)
#pragma unroll
            for (int m = 0; m < 4; ++m) { const int row = row0 + ai * HALF + m * 16; const size_t off = (size_t)row * ldc + col0; float q = 0.f;
#pragma unroll
                for (int bj = 0; bj < 2; ++bj) { const f32x4 v0 = *(const f32x4*)(base + off + bj * HALF) + acc[ai][bj][m][0], v1 = *(const f32x4*)(base + off + bj * HALF + 4) + acc[ai][bj][m][1];
                    q += (v0[0] * v0[0] + v0[1] * v0[1]) + (v0[2] * v0[2] + v0[3] * v0[3]) + (v1[0] * v1[0] + v1[1] * v1[1]) + (v1[2] * v1[2] + v1[3] * v1[3]);
                    u32x4 w; w.x = cvt_pk_bf16(v0[0], v0[1]); w.y = cvt_pk_bf16(v0[2], v0[3]); w.z = cvt_pk_bf16(v1[0], v1[1]); w.w = cvt_pk_bf16(v1[2], v1[3]);
                    *(u32x4*)(O + off + bj * HALF) = w; }
                q += __shfl_xor(q, 16); q += __shfl_xor(q, 32);
                if (fq == 0) ss[(size_t)row * 16 + u.pn * 4 + wc] = q; }
    }
};
struct EpiX2 {
    static constexpr bool PERM = true, AFTER_DRAIN = false, MIDK = false, PREFETCH = false;
    bf16_t* X; int ldc; float* ss;
    __device__ __forceinline__ void operator()(const f32x4 (&acc)[2][2][4][2], const Unit& u, int wr, int wc, int fr, int fq) const {
        const int row0 = u.pm * BM + wr * 64 + fr; const int col0 = u.pn * BM + wc * 32 + 8 * fq;
#pragma unroll
        for (int ai = 0; ai < 2; ++ai)
#pragma unroll
            for (int m = 0; m < 4; ++m) { const int row = row0 + ai * HALF + m * 16; const size_t off = (size_t)row * ldc + col0; float q = 0.f;
#pragma unroll
                for (int bj = 0; bj < 2; ++bj) { const u32x4 xb = *(const u32x4*)(X + off + bj * HALF);
                    f32x4 v0, v1; v0[0] = __builtin_bit_cast(float, xb.x << 16); v0[1] = __builtin_bit_cast(float, xb.x & 0xffff0000u); v0[2] = __builtin_bit_cast(float, xb.y << 16); v0[3] = __builtin_bit_cast(float, xb.y & 0xffff0000u);
                    v1[0] = __builtin_bit_cast(float, xb.z << 16); v1[1] = __builtin_bit_cast(float, xb.z & 0xffff0000u); v1[2] = __builtin_bit_cast(float, xb.w << 16); v1[3] = __builtin_bit_cast(float, xb.w & 0xffff0000u);
                    v0 = v0 + acc[ai][bj][m][0]; v1 = v1 + acc[ai][bj][m][1];
                    q += (v0[0] * v0[0] + v0[1] * v0[1]) + (v0[2] * v0[2] + v0[3] * v0[3]) + (v1[0] * v1[0] + v1[1] * v1[1]) + (v1[2] * v1[2] + v1[3] * v1[3]);
                    u32x4 w; w.x = cvt_pk_bf16(v0[0], v0[1]); w.y = cvt_pk_bf16(v0[2], v0[3]); w.z = cvt_pk_bf16(v1[0], v1[1]); w.w = cvt_pk_bf16(v1[2], v1[3]);
                    *(u32x4*)(X + off + bj * HALF) = w; }
                q += __shfl_xor(q, 16); q += __shfl_xor(q, 32);
                if (fq == 0) ss[(size_t)row * 16 + u.pn * 4 + wc] = q; }
    }
};
struct EpiBf16Rs {
    static constexpr bool PERM = true, AFTER_DRAIN = false, MIDK = false, PREFETCH = false;
    bf16_t* O; int ldc; const float* ss; float inv_n, eps;
    __device__ __forceinline__ void operator()(const f32x4 (&acc)[2][2][4][2], const Unit& u, int wr, int wc, int fr, int fq) const {
        const int row0 = u.pm * BM + wr * 64 + fr; const int col0 = u.pn * BM + wc * 32 + 8 * fq;
#pragma unroll
        for (int ai = 0; ai < 2; ++ai)
#pragma unroll
            for (int m = 0; m < 4; ++m) { const int row = row0 + ai * HALF + m * 16; const f32x4* sp = (const f32x4*)(ss + (size_t)row * 16);
                const f32x4 s4 = (sp[0] + sp[1]) + (sp[2] + sp[3]); const float rs = 1.0f / sqrtf(((s4[0] + s4[1]) + (s4[2] + s4[3])) * inv_n + eps);
                bf16_t* rowp = O + (size_t)row * ldc + col0;
#pragma unroll
                for (int bj = 0; bj < 2; ++bj) { const f32x4 v0 = acc[ai][bj][m][0] * rs, v1 = acc[ai][bj][m][1] * rs;
                    u32x4 w; w.x = cvt_pk_bf16(v0[0], v0[1]); w.y = cvt_pk_bf16(v0[2], v0[3]); w.z = cvt_pk_bf16(v1[0], v1[1]); w.w = cvt_pk_bf16(v1[2], v1[3]);
                    *(u32x4*)(rowp + bj * HALF) = w; } }
    }
};


template <int CTRL> __device__ __forceinline__ float dppk(float keep, float x) { return __builtin_bit_cast(float, __builtin_amdgcn_update_dpp(__builtin_bit_cast(int, keep), __builtin_bit_cast(int, x), CTRL, 0xf, 0xf, false)); }
template <int CTRL> __device__ __forceinline__ float dppf(float x) { return __builtin_bit_cast(float, __builtin_amdgcn_mov_dpp(__builtin_bit_cast(int, x), CTRL, 0xf, 0xf, true)); }
struct EpiConvGlu {
    static constexpr bool PERM = true, AFTER_DRAIN = false, MIDK = false, PREFETCH = true, PERMA = true;
    bf16_t* O; int ldc; const float* ss; const float* cw; const float* cb; PG8_LAS float* ex; int mrows; float* halo; const float* cw4;
    __device__ __forceinline__ void prefetch(const Unit& u, int wid, int lane) const {
        const int base = u.pm * BM; asm volatile("" : "+v"(lane));
        if (wid == 0) __builtin_amdgcn_global_load_lds((const unsigned*)(ss + base + lane * 4), (PG8_LAS unsigned*)(ex + 1024), 16, 0, 0);
        else if (wid < 4) __builtin_amdgcn_global_load_lds((const unsigned*)(cw4 + u.pn * 768 + (wid - 1) * 256 + lane * 4), (PG8_LAS unsigned*)(ex + 1024 + 4096 + (wid - 1) * 256), 16, 0, 0);
    }
    __device__ __forceinline__ void operator()(i32x4 (&iacc)[2][2][4][2], const Unit& u, int wr, int wc, int fr, int fq) const {
        f32x4 acc[2][2][4][2];
        const int kt = u.pm & 15, base = u.pm * BM;
        const int ch0 = u.pn * 128 + wc * 32 + 8 * fq;
        const bool top_open = kt != 0, bot_open = kt != 15;
        f32x4 w0[2], w1[2], w2[2], cbv[2], isv[2];
#pragma unroll
        for (int n = 0; n < 2; ++n) { const PG8_LAS float* wl = ex + 1024 + 4096 + wc * 32 + 8 * fq + 4 * n; const f32x4 sg = *(const PG8_LAS f32x4*)(wl + 512) * -1.4426950408889634f;
            w0[n] = *(const PG8_LAS f32x4*)wl * sg; w1[n] = *(const PG8_LAS f32x4*)(wl + 128) * sg; w2[n] = *(const PG8_LAS f32x4*)(wl + 256) * sg; cbv[n] = *(const PG8_LAS f32x4*)(wl + 384) * -1.4426950408889634f;
            const f32x4 svn = *(const PG8_LAS f32x4*)(wl + 640);
#pragma unroll
            for (int i = 0; i < 4; ++i) isv[n][i] = __builtin_amdgcn_rcpf(fminf(svn[i] * -0.6931471805599453f, -1e-30f)); }
#pragma unroll
        for (int ai = 0; ai < 2; ++ai) { const f32x4 rs4 = *(const PG8_LAS f32x4*)(ex + 1024 + ai * HALF + wr * 64 + fr * 4);
#pragma unroll
            for (int m = 0; m < 4; ++m) { const float rs = rs4[m];
#pragma unroll
                for (int n = 0; n < 2; ++n) { const i32x4 ig = iacc[ai][0][m][n], iv = iacc[ai][1][m][n];
                    acc[ai][0][m][n] = (f32x4){(float)ig[0], (float)ig[1], (float)ig[2], (float)ig[3]} * rs; acc[ai][1][m][n] = (f32x4){(float)iv[0], (float)iv[1], (float)iv[2], (float)iv[3]} * rs; } } }
        const int exi = (wc * 4 + fq) * 8;
        if (fr == 0) {
#pragma unroll
            for (int ai = 0; ai < 2; ++ai) { PG8_LAS f32x4* p = (PG8_LAS f32x4*)(ex + ((ai * 2 + wr) * 2 + 0) * 128 + exi); p[0] = acc[ai][0][0][0]; p[1] = acc[ai][0][0][1]; } }
        if (fr == 15) {
#pragma unroll
            for (int ai = 0; ai < 2; ++ai) { PG8_LAS f32x4* p = (PG8_LAS f32x4*)(ex + ((ai * 2 + wr) * 2 + 1) * 128 + exi); p[0] = acc[ai][0][3][0]; p[1] = acc[ai][0][3][1]; } }
        asm volatile("s_waitcnt lgkmcnt(0)\n\ts_barrier" ::: "memory");
#pragma unroll
        for (int ai = 0; ai < 2; ++ai) {
            f32x4 et[2] = {(f32x4){0.f, 0.f, 0.f, 0.f}, (f32x4){0.f, 0.f, 0.f, 0.f}}, eb[2] = {(f32x4){0.f, 0.f, 0.f, 0.f}, (f32x4){0.f, 0.f, 0.f, 0.f}};
            { const bool hz = (wr == 0 && ai == 0); const int sai = wr == 1 ? ai : 0, swr = wr == 1 ? 0 : 1; const PG8_LAS f32x4* p = (const PG8_LAS f32x4*)(ex + ((sai * 2 + swr) * 2 + 1) * 128 + exi);
              if (!hz) { et[0] = p[0]; et[1] = p[1]; } }
            { const bool hz = (wr == 1 && ai == 1); const int sai = wr == 0 ? ai : 1, swr = wr == 0 ? 1 : 0; const PG8_LAS f32x4* p = (const PG8_LAS f32x4*)(ex + ((sai * 2 + swr) * 2 + 0) * 128 + exi);
              if (!hz) { eb[0] = p[0]; eb[1] = p[1]; } }
            float a[4][8], zz[8];
#pragma unroll
            for (int n = 0; n < 2; ++n)
#pragma unroll
                for (int i = 0; i < 4; ++i) { const float g0 = acc[ai][0][0][n][i], g1 = acc[ai][0][1][n][i], g2 = acc[ai][0][2][n][i], g3 = acc[ai][0][3][n][i];
                    const float up = dppk<0x111>(et[n][i], g3), dn = dppk<0x101>(eb[n][i], g0);
                    const float c0 = w0[n][i], c1 = w1[n][i], c2 = w2[n][i], cb0 = cbv[n][i];
                    float z[4];
                    z[0] = __builtin_fmaf(c2, g1, __builtin_fmaf(c1, g0, __builtin_fmaf(c0, up, cb0)));
                    z[1] = __builtin_fmaf(c2, g2, __builtin_fmaf(c1, g1, __builtin_fmaf(c0, g0, cb0)));
                    z[2] = __builtin_fmaf(c2, g3, __builtin_fmaf(c1, g2, __builtin_fmaf(c0, g1, cb0)));
                    z[3] = __builtin_fmaf(c2, dn, __builtin_fmaf(c1, g3, __builtin_fmaf(c0, g2, cb0)));
                    zz[4 * n + i] = (ai == 0 ? z[0] : z[3]) * -0.6931471805599453f;
#pragma unroll
                    for (int m = 0; m < 4; ++m) { const float iv0 = isv[n][i]; a[m][4 * n + i] = z[m] * __builtin_amdgcn_rcpf(__builtin_fmaf(__builtin_amdgcn_exp2f(z[m]), iv0, iv0)) * acc[ai][1][m][n][i]; } }
#pragma unroll
            for (int m = 0; m < 4; ++m) { const int r = ai * HALF + wr * 64 + fr * 4 + m; u32x4 w;
                w.x = cvt_pk_bf16(a[m][0], a[m][1]); w.y = cvt_pk_bf16(a[m][2], a[m][3]); w.z = cvt_pk_bf16(a[m][4], a[m][5]); w.w = cvt_pk_bf16(a[m][6], a[m][7]);
                bool open = false;
                if (ai == 0 && m == 0) open = (r == 0) && top_open;
                if (ai == 1 && m == 3) open = (r == 255) && bot_open;
                if (!open) st_wt(O + (size_t)(base + r) * ldc + ch0, w);
                if ((ai == 0 && m == 0) || (ai == 1 && m == 3)) { if (open) { float* hp = halo + ((size_t)(u.pm * 2 + (ai == 0 ? 0 : 1)) * 3) * ldc + ch0;
                        const PG8_LAS float* sl = ex + 1024 + 4096 + 512 + wc * 32 + 8 * fq;
                        *(f32x4*)hp = acc[ai][0][m][0] * *(const PG8_LAS f32x4*)sl; *(f32x4*)(hp + 4) = acc[ai][0][m][1] * *(const PG8_LAS f32x4*)(sl + 4);
                        *(f32x4*)(hp + ldc) = (f32x4){zz[0], zz[1], zz[2], zz[3]}; *(f32x4*)(hp + ldc + 4) = (f32x4){zz[4], zz[5], zz[6], zz[7]};
                        *(f32x4*)(hp + 2 * ldc) = acc[ai][1][m][0] * *(const PG8_LAS f32x4*)(sl + 128); *(f32x4*)(hp + 2 * ldc + 4) = acc[ai][1][m][1] * *(const PG8_LAS f32x4*)(sl + 132); } }
                asm volatile("" ::: "memory"); } }
        asm volatile("s_waitcnt lgkmcnt(0)\n\ts_barrier" ::: "memory");
    }
};


struct EpiX1N {
    static constexpr bool PERM = true, AFTER_DRAIN = false, MIDK = true, PREFETCH = true; static constexpr int MIDK_T = 12;
    const bf16_t* base; bf16_t* O; int ldc; float* ss; const float* sa; PG8_LAS float* st;
    __device__ __forceinline__ void prefetch(const Unit& u, int wid, int lane) const {
        asm volatile("" : "+v"(lane));
#pragma unroll
        for (int i = 0; i < 2; ++i) { const int piece = wid * 2 + i;
            __builtin_amdgcn_global_load_lds((const unsigned*)(sa + (size_t)u.pm * BM * 16 + piece * 256 + lane * 4), (PG8_LAS unsigned*)(st + piece * 256), 16, 0, 0); }
    }
    __device__ __forceinline__ void row_stats(int rl, int fq, float& ra, float& rf) const {
        const f32x4 s4 = *(const PG8_LAS f32x4*)(st + rl * 16 + 4 * fq); float a = fq < 3 ? (s4[0] + s4[1]) + (s4[2] + s4[3]) : 0.f, f = fq == 3 ? s4[0] : 0.f;
        a += __shfl_xor(a, 16); a += __shfl_xor(a, 32); f += __shfl_xor(f, 16); f += __shfl_xor(f, 32);
        ra = __builtin_amdgcn_rsqf(a * (1.0f / 768.0f) + 1e-6f); rf = __builtin_amdgcn_rsqf(f * (1.0f / 256.0f) + 1e-6f);
    }
    __device__ __forceinline__ void midk(f32x4 (&acc)[2][2][4][2], const Unit& u, int wr, int fr, int fq) const {
#pragma unroll
        for (int ai = 0; ai < 2; ++ai)
#pragma unroll
            for (int m = 0; m < 4; ++m) { float ra, rf; row_stats(ai * HALF + wr * 64 + m * 16 + fr, fq, ra, rf); const float ratio = ra * __builtin_amdgcn_rcpf(rf);
#pragma unroll
                for (int bj = 0; bj < 2; ++bj) { acc[ai][bj][m][0] = acc[ai][bj][m][0] * ratio; acc[ai][bj][m][1] = acc[ai][bj][m][1] * ratio; } }
    }
    __device__ __forceinline__ void operator()(const f32x4 (&acc)[2][2][4][2], const Unit& u, int wr, int wc, int fr, int fq) const {
        const int row0 = u.pm * BM + wr * 64 + fr; const int col0 = u.pn * BM + wc * 32 + 8 * fq;
#pragma unroll
        for (int ai = 0; ai < 2; ++ai)
#pragma unroll
            for (int m = 0; m < 4; ++m) { const int row = row0 + ai * HALF + m * 16; const size_t off = (size_t)row * ldc + col0; float ra, rf; row_stats(row - u.pm * BM, fq, ra, rf);
#pragma unroll
                for (int bj = 0; bj < 2; ++bj) { const u32x4 xb = *(const u32x4*)(base + off + bj * HALF); f32x4 v0, v1;
                    v0[0] = __builtin_bit_cast(float, xb.x << 16); v0[1] = __builtin_bit_cast(float, xb.x & 0xffff0000u); v0[2] = __builtin_bit_cast(float, xb.y << 16); v0[3] = __builtin_bit_cast(float, xb.y & 0xffff0000u);
                    v1[0] = __builtin_bit_cast(float, xb.z << 16); v1[1] = __builtin_bit_cast(float, xb.z & 0xffff0000u); v1[2] = __builtin_bit_cast(float, xb.w << 16); v1[3] = __builtin_bit_cast(float, xb.w & 0xffff0000u);
                    v0 = v0 + acc[ai][bj][m][0] * rf; v1 = v1 + acc[ai][bj][m][1] * rf;
                    u32x4 w; w.x = cvt_pk_bf16(v0[0], v0[1]); w.y = cvt_pk_bf16(v0[2], v0[3]); w.z = cvt_pk_bf16(v1[0], v1[1]); w.w = cvt_pk_bf16(v1[2], v1[3]);
                    *(u32x4*)(O + off + bj * HALF) = w; }
                }
        asm volatile("s_waitcnt lgkmcnt(0)\n\ts_barrier" ::: "memory");
    }
};


struct EpiX1Q {
    static constexpr bool PERM = true, AFTER_DRAIN = false, MIDK = true, PREFETCH = true; static constexpr int MIDK_T = 12;
    const bf16_t* base; bf16_t* O; int ldc; const float* sa; PG8_LAS float* st; unsigned char* A8; float* srow; float* xbuf; unsigned* cnt; PG8_LAS unsigned char* lq;
    __device__ __forceinline__ void prefetch(const Unit& u, int wid, int lane) const {
        asm volatile("" : "+v"(lane));
#pragma unroll
        for (int i = 0; i < 2; ++i) { const int piece = wid * 2 + i;
            __builtin_amdgcn_global_load_lds((const unsigned*)(sa + (size_t)u.pm * BM * 16 + piece * 256 + lane * 4), (PG8_LAS unsigned*)(st + piece * 256), 16, 0, 0); }
    }
    __device__ __forceinline__ void row_stats(int rl, int fq, float& ra, float& rf) const {
        const f32x4 s4 = *(const PG8_LAS f32x4*)(st + rl * 16 + 4 * fq); float a = fq < 3 ? (s4[0] + s4[1]) + (s4[2] + s4[3]) : 0.f, f = fq == 3 ? s4[0] : 0.f;
        a += __shfl_xor(a, 16); a += __shfl_xor(a, 32); f += __shfl_xor(f, 16); f += __shfl_xor(f, 32);
        ra = __builtin_amdgcn_rsqf(a * (1.0f / 768.0f) + 1e-6f); rf = __builtin_amdgcn_rsqf(f * (1.0f / 256.0f) + 1e-6f);
    }
    __device__ __forceinline__ void midk(f32x4 (&acc)[2][2][4][2], const Unit& u, int wr, int fr, int fq) const {
#pragma unroll
        for (int ai = 0; ai < 2; ++ai)
#pragma unroll
            for (int m = 0; m < 4; ++m) { float ra, rf; row_stats(ai * HALF + wr * 64 + m * 16 + fr, fq, ra, rf); const float ratio = ra * __builtin_amdgcn_rcpf(rf);
#pragma unroll
                for (int bj = 0; bj < 2; ++bj) { acc[ai][bj][m][0] = acc[ai][bj][m][0] * ratio; acc[ai][bj][m][1] = acc[ai][bj][m][1] * ratio; } }
    }
    __device__ __forceinline__ void operator()(f32x4 (&acc)[2][2][4][2], const Unit& u, int wr, int wc, int fr, int fq) const {
        PG8_LAS float* Pq = (PG8_LAS float*)(lq + 4096); PG8_LAS float* Pm = (PG8_LAS float*)(lq + 24576); PG8_LAS float* S = (PG8_LAS float*)(lq + 28672);
        asm volatile("" : "+v"(fr), "+v"(fq));
        int tid = (wr * 4 + wc) * 64 + fq * 16 + fr;
        const int col0 = u.pn * BM + wc * 32 + 8 * fq;
#pragma unroll
        for (int ai = 0; ai < 2; ++ai)
#pragma unroll
            for (int m = 0; m < 4; ++m) { const int rl = ai * HALF + wr * 64 + m * 16 + fr; const size_t off = (size_t)(u.pm * BM + rl) * ldc + col0; float ra, rf; row_stats(rl, fq, ra, rf); float q = 0.f, mx = 0.f;
#pragma unroll
                for (int bj = 0; bj < 2; ++bj) { const u32x4 xb = *(const u32x4*)(base + off + bj * HALF); f32x4 v0, v1;
                    v0[0] = __builtin_bit_cast(float, xb.x << 16); v0[1] = __builtin_bit_cast(float, xb.x & 0xffff0000u); v0[2] = __builtin_bit_cast(float, xb.y << 16); v0[3] = __builtin_bit_cast(float, xb.y & 0xffff0000u);
                    v1[0] = __builtin_bit_cast(float, xb.z << 16); v1[1] = __builtin_bit_cast(float, xb.z & 0xffff0000u); v1[2] = __builtin_bit_cast(float, xb.w << 16); v1[3] = __builtin_bit_cast(float, xb.w & 0xffff0000u);
                    v0 = v0 + acc[ai][bj][m][0] * rf; v1 = v1 + acc[ai][bj][m][1] * rf; acc[ai][bj][m][0] = v0; acc[ai][bj][m][1] = v1;
                    q += ((v0[0] * v0[0] + v0[1] * v0[1]) + (v0[2] * v0[2] + v0[3] * v0[3])) + ((v1[0] * v1[0] + v1[1] * v1[1]) + (v1[2] * v1[2] + v1[3] * v1[3]));
                    mx = fmaxf(mx, fmaxf(fmaxf(fmaxf(fabsf(v0[0]), fabsf(v0[1])), fmaxf(fabsf(v0[2]), fabsf(v0[3]))), fmaxf(fmaxf(fabsf(v1[0]), fabsf(v1[1])), fmaxf(fabsf(v1[2]), fabsf(v1[3])))));
                    u32x4 w; w.x = cvt_pk_bf16(v0[0], v0[1]); w.y = cvt_pk_bf16(v0[2], v0[3]); w.z = cvt_pk_bf16(v1[0], v1[1]); w.w = cvt_pk_bf16(v1[2], v1[3]);
                    *(u32x4*)(O + off + bj * HALF) = w; }
                q += __shfl_xor(q, 16); q += __shfl_xor(q, 32); mx = fmaxf(mx, __shfl_xor(mx, 16)); mx = fmaxf(mx, __shfl_xor(mx, 32));
                if (fq == 0) { Pq[rl * 4 + wc] = q; Pm[rl * 4 + wc] = mx; } }
        asm volatile("s_waitcnt lgkmcnt(0)\n\ts_barrier" ::: "memory");
        if (tid < 256) { const float sq = (Pq[tid * 4] + Pq[tid * 4 + 1]) + (Pq[tid * 4 + 2] + Pq[tid * 4 + 3]); const float mq = fmaxf(fmaxf(Pm[tid * 4], Pm[tid * 4 + 1]), fmaxf(Pm[tid * 4 + 2], Pm[tid * 4 + 3]));
            float* xp = xbuf + ((size_t)(u.pm * BM + tid) * 4 + u.pn) * 2;
            __hip_atomic_store(xp, sq, __ATOMIC_RELAXED, __HIP_MEMORY_SCOPE_AGENT); __hip_atomic_store(xp + 1, mq, __ATOMIC_RELAXED, __HIP_MEMORY_SCOPE_AGENT);
            asm volatile("s_waitcnt vmcnt(0)" ::: "memory");
            if ((tid & 63) == 0) __hip_atomic_fetch_add(cnt + 64 * u.pm, 1u, __ATOMIC_RELAXED, __HIP_MEMORY_SCOPE_AGENT); }
        if (tid < 64) { unsigned spins = 0;
            while ((unsigned)__builtin_amdgcn_readfirstlane(__hip_atomic_load(cnt + 64 * u.pm, __ATOMIC_RELAXED, __HIP_MEMORY_SCOPE_AGENT)) < 16u) { __builtin_amdgcn_s_sleep(2); if (++spins > 400000u) break; }
            __builtin_amdgcn_fence(__ATOMIC_ACQUIRE, "agent"); }
        asm volatile("s_waitcnt vmcnt(0) lgkmcnt(0)\n\ts_barrier" ::: "memory");
        if (tid < 256) { const float* xp = xbuf + (size_t)(u.pm * BM + tid) * 8; float t = 0.f, mq = 0.f;
#pragma unroll
            for (int k = 0; k < 4; ++k) { t += __hip_atomic_load(xp + 2 * k, __ATOMIC_RELAXED, __HIP_MEMORY_SCOPE_AGENT); mq = fmaxf(mq, __hip_atomic_load(xp + 2 * k + 1, __ATOMIC_RELAXED, __HIP_MEMORY_SCOPE_AGENT)); }
            S[tid] = mq > 0.f ? 127.0f / mq : 0.f;
            if (u.pn == 0) srow[u.pm * BM + tid] = mq * (1.0f / 127.0f) * (1.0f / sqrtf(t * (1.0f / 1024.0f) + 1e-6f)); }
        asm volatile("s_waitcnt vmcnt(0) lgkmcnt(0)\n\ts_barrier" ::: "memory");
        int fr5 = fr; asm volatile("" : "+v"(fr5));
#pragma unroll
        for (int ai = 0; ai < 2; ++ai)
#pragma unroll
            for (int m = 0; m < 4; ++m) { const int rl = ai * HALF + wr * 64 + m * 16 + fr5; const float inv = S[rl]; unsigned char* ap = A8 + (size_t)(u.pm * BM + rl) * ldc + col0;
#pragma unroll
                for (int bj = 0; bj < 2; ++bj) { unsigned lo = 0, hi = 0;
#pragma unroll
                    for (int t = 0; t < 4; ++t) { lo |= ((unsigned)(int)__builtin_rintf(acc[ai][bj][m][0][t] * inv) & 255u) << (8 * t); hi |= ((unsigned)(int)__builtin_rintf(acc[ai][bj][m][1][t] * inv) & 255u) << (8 * t); }
                    unsigned long long pk = (unsigned long long)lo | ((unsigned long long)hi << 32); *(unsigned long long*)(ap + bj * HALF) = pk; } }
        asm volatile("s_waitcnt lgkmcnt(0)\n\ts_barrier" ::: "memory");
    }
};

struct EpiFinal {
    static constexpr bool PERM = true, AFTER_DRAIN = false, MIDK = false, PREFETCH = false;
    const bf16_t* X1; float* out; int ldc; const float* gain; float* xbuf; unsigned* cnt; PG8_LAS unsigned char* lx;
    __device__ __forceinline__ void operator()(f32x4 (&acc)[2][2][4][2], const Unit& u, int wr, int wc, int fr, int fq) const {
        PG8_LAS float* P = (PG8_LAS float*)lx; PG8_LAS float* S = (PG8_LAS float*)(lx + 4096);
        int tid = (wr * 4 + wc) * 64 + fq * 16 + fr; asm volatile("" : "+v"(tid)); const int col0 = u.pn * BM + wc * 32 + 8 * fq;
#pragma unroll
        for (int ai = 0; ai < 2; ++ai)
#pragma unroll
            for (int m = 0; m < 4; ++m) { const int rl = ai * HALF + wr * 64 + m * 16 + fr; const size_t off = (size_t)(u.pm * BM + rl) * ldc + col0; float q = 0.f;
#pragma unroll
                for (int bj = 0; bj < 2; ++bj) { const u32x4 xb = *(const u32x4*)(X1 + off + bj * HALF); f32x4 v0, v1;
                    v0[0] = __builtin_bit_cast(float, xb.x << 16); v0[1] = __builtin_bit_cast(float, xb.x & 0xffff0000u); v0[2] = __builtin_bit_cast(float, xb.y << 16); v0[3] = __builtin_bit_cast(float, xb.y & 0xffff0000u);
                    v1[0] = __builtin_bit_cast(float, xb.z << 16); v1[1] = __builtin_bit_cast(float, xb.z & 0xffff0000u); v1[2] = __builtin_bit_cast(float, xb.w << 16); v1[3] = __builtin_bit_cast(float, xb.w & 0xffff0000u);
                    v0 = v0 + acc[ai][bj][m][0]; v1 = v1 + acc[ai][bj][m][1]; acc[ai][bj][m][0] = v0; acc[ai][bj][m][1] = v1;
                    q += ((v0[0] * v0[0] + v0[1] * v0[1]) + (v0[2] * v0[2] + v0[3] * v0[3])) + ((v1[0] * v1[0] + v1[1] * v1[1]) + (v1[2] * v1[2] + v1[3] * v1[3])); }
                q += __shfl_xor(q, 16); q += __shfl_xor(q, 32);
                if (fq == 0) P[rl * 4 + wc] = q; }
        asm volatile("s_waitcnt lgkmcnt(0)\n\ts_barrier" ::: "memory");
        if (tid < 256) { const float s = (P[tid * 4] + P[tid * 4 + 1]) + (P[tid * 4 + 2] + P[tid * 4 + 3]);
            __hip_atomic_store(xbuf + ((size_t)(u.pm * BM + tid) * 4 + u.pn), s, __ATOMIC_RELAXED, __HIP_MEMORY_SCOPE_AGENT);
            asm volatile("s_waitcnt vmcnt(0)" ::: "memory");
            if ((tid & 63) == 0) __hip_atomic_fetch_add(cnt + 64 * u.pm, 1u, __ATOMIC_RELAXED, __HIP_MEMORY_SCOPE_AGENT); }
        if (tid < 64) { unsigned spins = 0;
            while ((unsigned)__builtin_amdgcn_readfirstlane(__hip_atomic_load(cnt + 64 * u.pm, __ATOMIC_RELAXED, __HIP_MEMORY_SCOPE_AGENT)) < 16u) { __builtin_amdgcn_s_sleep(2); if (++spins > 400000u) break; }
            __builtin_amdgcn_fence(__ATOMIC_ACQUIRE, "agent"); }
        asm volatile("s_waitcnt vmcnt(0) lgkmcnt(0)\n\ts_barrier" ::: "memory");
        if (tid < 256) { const float* xp = xbuf + (size_t)(u.pm * BM + tid) * 4; float t = 0.f;
#pragma unroll
            for (int k = 0; k < 4; ++k) t += __hip_atomic_load(xp + k, __ATOMIC_RELAXED, __HIP_MEMORY_SCOPE_AGENT);
            S[tid] = 1.0f / sqrtf(t * (1.0f / 1024.0f) + 1e-6f); }
        asm volatile("s_waitcnt vmcnt(0) lgkmcnt(0)\n\ts_barrier" ::: "memory");
        f32x4 gv[2][2];
#pragma unroll
        for (int bj = 0; bj < 2; ++bj)
#pragma unroll
            for (int n = 0; n < 2; ++n) gv[bj][n] = *(const f32x4*)(gain + col0 + bj * HALF + n * 4);
#pragma unroll
        for (int ai = 0; ai < 2; ++ai)
#pragma unroll
            for (int m = 0; m < 4; ++m) { const int rl = ai * HALF + wr * 64 + m * 16 + fr; const float rs = S[rl]; const size_t off = (size_t)(u.pm * BM + rl) * ldc + col0;
#pragma unroll
                for (int bj = 0; bj < 2; ++bj)
#pragma unroll
                    for (int n = 0; n < 2; ++n) *(f32x4*)(out + off + bj * HALF + n * 4) = acc[ai][bj][m][n] * rs * gv[bj][n]; }
    }
};

template <class E, class = void> struct HasPermA { static constexpr bool v = false; };
template <class E> struct HasPermA<E, decltype((void)E::PERMA)> { static constexpr bool v = E::PERMA; };
template <bool I8> __device__ __forceinline__ typename AccT<I8>::type mma16(bf16x8 a, bf16x8 b, typename AccT<I8>::type c) {
    if constexpr (I8) return __builtin_amdgcn_mfma_i32_16x16x64_i8(__builtin_bit_cast(i32x4, a), __builtin_bit_cast(i32x4, b), c, 0, 0, 0);
    else return __builtin_amdgcn_mfma_f32_16x16x32_bf16(a, b, c, 0, 0, 0);
}
template <class Epi, class Sched, bool ALIGN_EPI = false, bool SP2 = false, bool I8 = false>
__device__ __forceinline__ void gemm_phase(PG8_LAS unsigned char* lds, const Gemm g, const Sched& S, const Epi& E) {
    int tid = threadIdx.x; asm volatile("" : "+v"(tid));
    const int wid = __builtin_amdgcn_readfirstlane(tid >> 6), lane = tid & 63, wr = wid >> 2, wc = wid & 3, fr = lane & 15, fq = lane >> 4;
    const int K = g.K, nt = K / BK, lda = g.lda;
    unsigned voffA[2], voffB[2];
#pragma unroll
    for (int i = 0; i < 2; ++i) { int R, C; stage_rc(tid * 16 + i * 8192, R, C); const int Rb = Epi::PERM ? ((R & ~31) + perm32(R & 31)) : R;
        const int Ra = HasPermA<Epi>::v ? ((R & ~63) + (R & 15) * 4 + ((R >> 4) & 3)) : R;
        voffA[i] = (unsigned)(Ra * lda + C) * 2u; voffB[i] = (unsigned)(Rb * K + C) * 2u; }
    const size_t kstep = (size_t)(BK * 2);
    const size_t hstepA = (size_t)HALF * lda * 2, hstepB = (size_t)HALF * K * 2;
    const size_t tstepA = 2 * hstepA, tstepB = 2 * hstepB;
    const unsigned ldsw = (unsigned)wid * 1024u;
    const int aoff = lds_byte(wr * 64 + fr, fq * 8), boff = lds_byte(wc * 32 + fr, fq * 8);
#define PG8_SA(b, h) (((b) * 2 + (h)) * HTB)
#define PG8_SB(b, h) ((4 + (b) * 2 + (h)) * HTB)
#define PG8_STAGE(bufoff, gbase, voff) do { _Pragma("unroll") for (int _i = 0; _i < 2; ++_i) \
        __builtin_amdgcn_global_load_lds((const unsigned*)((const char*)(gbase) + (voff)[_i]), (PG8_LAS unsigned*)(lds + (bufoff) + ldsw + _i * 8192), 16, 0, 0); } while (0)
#define PG8_LDA(dst, b, h) do { _Pragma("unroll") for (int m = 0; m < 4; ++m) _Pragma("unroll") for (int k = 0; k < 2; ++k) dst[m][k] = *(const PG8_LAS bf16x8*)(lds + PG8_SA(b, h) + aoff + m * 2048 + k * 1024); } while (0)
#define PG8_LDB(dst, b, h) do { _Pragma("unroll") for (int n = 0; n < 2; ++n) _Pragma("unroll") for (int k = 0; k < 2; ++k) dst[n][k] = *(const PG8_LAS bf16x8*)(lds + PG8_SB(b, h) + boff + n * 2048 + k * 1024); } while (0)
#define PG8_MMA(ai, bj, At, Bt) do { __builtin_amdgcn_s_setprio(1); _Pragma("unroll") for (int m = 0; m < 4; ++m) _Pragma("unroll") for (int n = 0; n < 2; ++n) _Pragma("unroll") for (int k = 0; k < 2; ++k) \
        acc[ai][bj][m][n] = mma16<I8>(Bt[n][k], At[m][k], acc[ai][bj][m][n]); __builtin_amdgcn_s_setprio(0); } while (0)
#define PG8_WAIT_V(n) asm volatile("s_waitcnt vmcnt(" #n ")" ::: "memory")
#define PG8_WAIT_L(n) asm volatile("s_waitcnt lgkmcnt(" #n ")" ::: "memory")
#define PG8_BAR __builtin_amdgcn_s_barrier()
#define PG8_SCHED __builtin_amdgcn_sched_barrier(0)
    Unit cur, nxt; int ui = 0;
    if (!S.next(0, cur)) return;
    typedef typename AccT<I8>::type acc_t; acc_t acc[2][2][4][2];
#pragma unroll
    for (int a = 0; a < 2; ++a)
#pragma unroll
        for (int b = 0; b < 2; ++b)
#pragma unroll
            for (int m = 0; m < 4; ++m)
#pragma unroll
                for (int n = 0; n < 2; ++n) acc[a][b][m][n] = (acc_t){0, 0, 0, 0};
    bf16x8 At[4][2], B0[2][2], B1[2][2];
    const char* cA = (const char*)g.A + (g.ovl ? (size_t)ovl_row_base(cur.pm) * lda * 2 : (size_t)cur.pm * tstepA); const char* cB = (const char*)g.Bt + (size_t)cur.pn * tstepB;
    S.a_ready(cur);
    if constexpr (Epi::PREFETCH) E.prefetch(cur, wid, lane);
    if constexpr (SP2) {
        PG8_STAGE(PG8_SB(0, 0), cB, voffB); PG8_STAGE(PG8_SB(0, 1), cB + hstepB, voffB); PG8_STAGE(PG8_SA(0, 0), cA, voffA); PG8_STAGE(PG8_SA(0, 1), cA + hstepA, voffA);
        if (wr == 1) PG8_BAR;
        PG8_WAIT_V(2); PG8_BAR;
        PG8_STAGE(PG8_SB(1, 0), cB + kstep, voffB); PG8_STAGE(PG8_SA(1, 0), cA + kstep, voffA); PG8_STAGE(PG8_SB(1, 1), cB + hstepB + kstep, voffB);
        PG8_WAIT_V(6); PG8_BAR;
    } else {
        PG8_STAGE(PG8_SB(0, 0), cB, voffB); PG8_STAGE(PG8_SA(0, 0), cA, voffA); PG8_STAGE(PG8_SB(0, 1), cB + hstepB, voffB); PG8_STAGE(PG8_SA(0, 1), cA + hstepA, voffA);
        if (wr == 1) PG8_BAR;
        PG8_WAIT_V(4); PG8_BAR;
        PG8_STAGE(PG8_SB(1, 0), cB + kstep, voffB); PG8_STAGE(PG8_SA(1, 0), cA + kstep, voffA); PG8_STAGE(PG8_SB(1, 1), cB + hstepB + kstep, voffB);
        PG8_WAIT_V(6); PG8_BAR;
    }
    for (;;) {
        const bool has_next = S.next(ui + 1, nxt);
        const char* nA = has_next ? (const char*)g.A + (g.ovl ? (size_t)ovl_row_base(nxt.pm) * lda * 2 : (size_t)nxt.pm * tstepA) : cA; const char* nB = has_next ? (const char*)g.Bt + (size_t)nxt.pn * tstepB : cB;
        for (int t = 0; t < nt; t += 2) {
            const bool last = (t == nt - 2);
            const char* a1 = cA + (size_t)(t + 1) * kstep;
            const char* a2 = last ? nA : cA + (size_t)(t + 2) * kstep; const char* b2 = last ? nB : cB + (size_t)(t + 2) * kstep;
            const char* a3 = a2 + kstep; const char* b3 = b2 + kstep;
            if (last && has_next) S.a_ready(nxt);
            if constexpr (Epi::MIDK) { if (t == Epi::MIDK_T) E.midk(acc, cur, wr, fr, fq); }
            if constexpr (SP2) {
            PG8_LDB(B0, 0, 0); PG8_LDB(B1, 0, 1); PG8_SCHED; PG8_LDA(At, 0, 0); PG8_STAGE(PG8_SA(1, 1), a1 + hstepA, voffA);
            PG8_WAIT_V(8); PG8_WAIT_L(0); PG8_BAR; PG8_MMA(0, 0, At, B0); PG8_MMA(0, 1, At, B1); PG8_BAR; PG8_SCHED;
            PG8_LDA(At, 0, 1); PG8_STAGE(PG8_SB(0, 0), b2, voffB); PG8_STAGE(PG8_SB(0, 1), b2 + hstepB, voffB); PG8_STAGE(PG8_SA(0, 0), a2, voffA);
            PG8_WAIT_V(8); PG8_WAIT_L(0); PG8_BAR; PG8_MMA(1, 0, At, B0); PG8_MMA(1, 1, At, B1); PG8_BAR; PG8_SCHED;
            PG8_LDB(B0, 1, 0); PG8_LDB(B1, 1, 1); PG8_SCHED; PG8_LDA(At, 1, 0); PG8_STAGE(PG8_SA(0, 1), a2 + hstepA, voffA);
            PG8_WAIT_V(8); PG8_WAIT_L(0); PG8_BAR; PG8_MMA(0, 0, At, B0); PG8_MMA(0, 1, At, B1); PG8_BAR; PG8_SCHED;
            PG8_LDA(At, 1, 1); PG8_STAGE(PG8_SB(1, 0), b3, voffB); PG8_STAGE(PG8_SB(1, 1), b3 + hstepB, voffB); PG8_STAGE(PG8_SA(1, 0), a3, voffA);
            PG8_WAIT_V(8); PG8_WAIT_L(0); PG8_BAR; PG8_MMA(1, 0, At, B0); PG8_MMA(1, 1, At, B1); PG8_BAR; PG8_SCHED;
            } else {
            PG8_LDB(B0, 0, 0); PG8_SCHED; PG8_LDA(At, 0, 0); PG8_STAGE(PG8_SA(1, 1), a1 + hstepA, voffA);
            PG8_WAIT_L(8); PG8_BAR; PG8_WAIT_L(0); PG8_MMA(0, 0, At, B0); PG8_BAR; PG8_SCHED;
            PG8_LDB(B1, 0, 1); PG8_STAGE(PG8_SB(0, 0), b2, voffB);
            PG8_BAR; PG8_WAIT_L(0); PG8_MMA(0, 1, At, B1); PG8_BAR;
            PG8_LDA(At, 0, 1); PG8_STAGE(PG8_SA(0, 0), a2, voffA);
            PG8_BAR; PG8_WAIT_L(0); PG8_MMA(1, 0, At, B0); PG8_BAR; PG8_SCHED;
            PG8_STAGE(PG8_SB(0, 1), b2 + hstepB, voffB);
            PG8_WAIT_V(6); PG8_BAR; PG8_MMA(1, 1, At, B1); PG8_BAR;
            PG8_LDB(B0, 1, 0); PG8_SCHED; PG8_LDA(At, 1, 0); PG8_STAGE(PG8_SA(0, 1), a2 + hstepA, voffA);
            PG8_WAIT_L(8); PG8_BAR; PG8_WAIT_L(0); PG8_MMA(0, 0, At, B0); PG8_BAR; PG8_SCHED;
            PG8_LDB(B1, 1, 1); PG8_STAGE(PG8_SB(1, 0), b3, voffB);
            PG8_BAR; PG8_WAIT_L(0); PG8_MMA(0, 1, At, B1); PG8_BAR;
            PG8_LDA(At, 1, 1); PG8_STAGE(PG8_SA(1, 0), a3, voffA);
            PG8_BAR; PG8_WAIT_L(0); PG8_MMA(1, 0, At, B0); PG8_BAR; PG8_SCHED;
            PG8_STAGE(PG8_SB(1, 1), b3 + hstepB, voffB);
            PG8_WAIT_V(6); PG8_BAR; PG8_MMA(1, 1, At, B1); PG8_BAR;
            }
        }
        if constexpr (ALIGN_EPI) { if (wr == 0) PG8_BAR; }
        if constexpr (!Epi::AFTER_DRAIN) { E(acc, cur, wr, wc, fr, fq); S.done(cur); }
        if constexpr (Epi::PREFETCH) { if (has_next) E.prefetch(nxt, wid, lane); }
        if (!has_next) break;
#pragma unroll
        for (int a = 0; a < 2; ++a)
#pragma unroll
            for (int b = 0; b < 2; ++b)
#pragma unroll
                for (int m = 0; m < 4; ++m)
#pragma unroll
                    for (int n = 0; n < 2; ++n) acc[a][b][m][n] = (acc_t){0, 0, 0, 0};
        cur = nxt; cA = nA; cB = nB; ++ui;
        if constexpr (ALIGN_EPI) { if (wr == 1) PG8_BAR; }
    }
    PG8_WAIT_V(0);
    if constexpr (!ALIGN_EPI) { if (wr == 0) PG8_BAR; }
    PG8_BAR;
#undef PG8_SA
#undef PG8_SB
#undef PG8_STAGE
#undef PG8_LDA
#undef PG8_LDB
#undef PG8_MMA
#undef PG8_WAIT_V
#undef PG8_WAIT_L
#undef PG8_BAR
#undef PG8_SCHED
}
}

constexpr int NWAVES = 8;
#ifndef MK_ONE_LAUNCH
#define MK_ONE_LAUNCH 1
#endif
constexpr int N_PHASES = 11;

constexpr int BATCH = 8, SEQ = 4096, D = 1024, NH = 12, HD = 64, AW = 768, NG = 4, GD = 64, FW = 256, MIXW = 1024, NPROJ = 2560, FF = 2816;
constexpr int M = BATCH * SEQ;
constexpr float EPS = 1e-6f;

constexpr size_t MiB = 1u << 20;
constexpr size_t WS_CTL = 0, CTL_ZERO_BYTES = 96 * 1024;
constexpr size_t WS_TAB = 1 * MiB;
constexpr size_t TAB_BIAS = 0;
constexpr size_t TAB_MG = 32 * 1024;
constexpr size_t TAB_TW = 192 * 1024;
constexpr size_t TAB_CW4 = 256 * 1024;
constexpr size_t WS_WIN = 2 * MiB;
constexpr size_t WS_WOUT = 7 * MiB;
constexpr size_t WS_WGV = 9 * MiB;
constexpr size_t WS_WD = 20 * MiB;
constexpr size_t WS_XN = 26 * MiB;
constexpr size_t WS_PROJ = 90 * MiB;
constexpr size_t WS_A2 = 250 * MiB;
constexpr size_t WS_PQ = 314 * MiB;
constexpr size_t WS_ML = 380 * MiB;
constexpr size_t WS_A8 = 314 * MiB;
constexpr size_t WS_HALO = 400 * MiB;
constexpr size_t WS_RS0 = 441 * MiB;
constexpr size_t WS_XBUF = 440 * MiB;
constexpr size_t WS_SSA = 446 * MiB;
constexpr size_t WS_SS1 = 442 * MiB;
constexpr size_t WS_SS2 = 444 * MiB;
constexpr size_t WS_GV = 90 * MiB;
constexpr size_t WS_END = 448 * MiB;
constexpr int CW_BAR = 1024, CW_PANEL = 8192, CW_PANEL2 = 16384;

constexpr int RING_OFF = 0, RING_BYTES = 131072;
constexpr int LDSCTL_OFF = RING_BYTES, MISC_OFF = LDSCTL_OFF + 320;
constexpr int LDS_BYTES = 163840;

#define GAS __attribute__((address_space(1)))
#define LAS __attribute__((address_space(3)))
typedef unsigned short bf16;
typedef unsigned v4u __attribute__((ext_vector_type(4)));
typedef unsigned v2u __attribute__((ext_vector_type(2)));
typedef float f32x4 __attribute__((ext_vector_type(4)));
typedef GAS unsigned gu32;
#define RLX_AGENT __ATOMIC_RELAXED, __HIP_MEMORY_SCOPE_AGENT
#define LDS_WAIT() asm volatile("s_waitcnt lgkmcnt(0)" ::: "memory")
#define VM_WAIT() asm volatile("s_waitcnt vmcnt(0)" ::: "memory")
__device__ __forceinline__ unsigned f2bf(float f) { unsigned u = __builtin_bit_cast(unsigned, f); return (u + 0x7fffu + ((u >> 16) & 1u)) >> 16; }
__device__ __forceinline__ unsigned pk2(float lo, float hi) { typedef float f2_t __attribute__((ext_vector_type(2))); typedef __bf16 b2_t __attribute__((ext_vector_type(2))); f2_t v = {lo, hi}; b2_t b = __builtin_convertvector(v, b2_t); return __builtin_bit_cast(unsigned, b); }
__device__ __forceinline__ void st_wt16(void* p, v4u v) { asm volatile("global_store_dwordx4 %0, %1, off sc1\n\ts_nop 2" :: "v"(p), "v"(v));        }
__device__ __forceinline__ void st_wt8(void* p, v2u v) { asm volatile("global_store_dwordx2 %0, %1, off sc1" :: "v"(p), "v"(v)); }
__device__ __forceinline__ float bflo(unsigned w) { return __builtin_bit_cast(float, w << 16); }
__device__ __forceinline__ float bfhi(unsigned w) { return __builtin_bit_cast(float, w & 0xffff0000u); }
__device__ __forceinline__ float bf2f(bf16 h) { return __builtin_bit_cast(float, (unsigned)h << 16); }

#define XB_TMO      128
#define XB_XCNT(j)  (256  + 64 * (j))
#define XB_XSUB(j)  (1280 + 64 * (j))
#define XB_XGEN(j)  (2304 + 64 * (j))
#define XB_TOP      3328
#define XB_TOPGEN   3392
#define XCD_BAR_WORDS 3456
#define XB_SPIN_CAP (1u << 18)
__device__ __forceinline__ unsigned xb_ld(unsigned* p)              { return __hip_atomic_load(p, __ATOMIC_RELAXED, __HIP_MEMORY_SCOPE_AGENT); }
__device__ __forceinline__ unsigned xb_add(unsigned* p, unsigned v) { return __hip_atomic_fetch_add(p, v, __ATOMIC_RELAXED, __HIP_MEMORY_SCOPE_AGENT); }
__device__ __forceinline__ unsigned xb_xcc_id() { return (unsigned)__builtin_amdgcn_s_getreg((3 << 11) | 20) & 0xFu; }
#define XB_SPIN(cond, bar) do { unsigned _sp = 0; while (cond) { __builtin_amdgcn_s_sleep(1); \
    if ((++_sp & 255u) == 0u) { if (xb_ld(&(bar)[XB_TMO])) break; if (_sp > XB_SPIN_CAP) { atomicAdd(&(bar)[XB_TMO], 1u); break; } } } } while (0)
struct XcdBarrier { unsigned* bar; unsigned x; volatile LAS unsigned* st; };
__device__ __forceinline__ XcdBarrier xcd_barrier_post(unsigned* bar, volatile LAS unsigned* st) {
    XcdBarrier b; b.bar = bar; b.x = xb_xcc_id(); b.st = st;
    if (threadIdx.x == 0) (void)xb_add(&bar[XB_XCNT(b.x)], 1u);
    return b;
}
__device__ __forceinline__ void xcd_barrier_complete(unsigned* bar, unsigned x, unsigned& nloc, unsigned& nx) {
    const unsigned G = gridDim.x * gridDim.y * gridDim.z;
    unsigned sum, cnt, mine, sp = 0u;
    for (;;) {
        sum = 0u; cnt = 0u; mine = 0u;
#pragma unroll
        for (unsigned j = 0; j < 16; ++j) { const unsigned c = xb_ld(&bar[XB_XCNT(j)]); sum += c; cnt += (c > 0u) ? 1u : 0u; mine = (j == x) ? c : mine; }
        if (sum == G) break;
        __builtin_amdgcn_s_sleep(1);
        if ((++sp & 255u) == 0u) { if (xb_ld(&bar[XB_TMO])) break; if (sp > XB_SPIN_CAP) { atomicAdd(&bar[XB_TMO], 1u); break; } }
    }
    nloc = mine > 0u ? mine : 1u; nx = cnt > 0u ? cnt : 1u;
}
__device__ __forceinline__ void xcd_barrier(const XcdBarrier& b) {
    asm volatile("s_waitcnt vmcnt(0)" ::: "memory");
    __syncthreads();
    if (threadIdx.x == 0) {
        unsigned* bar = b.bar;
        __builtin_amdgcn_s_waitcnt(0);
        unsigned nloc = b.st[0], nx = b.st[1];
        if (nloc == 0u) { xcd_barrier_complete(bar, b.x, nloc, nx); b.st[0] = nloc; b.st[1] = nx; }
        const unsigned old = xb_add(&bar[XB_XSUB(b.x)], 1u);
        const unsigned gen = old / nloc;
        if (old + 1u == (gen + 1u) * nloc) {
            __builtin_amdgcn_fence(__ATOMIC_RELEASE, "agent");
            asm volatile("s_waitcnt vmcnt(0)" ::: "memory");
            const unsigned og = xb_add(&bar[XB_TOP], 1u);
            const unsigned tg = og / nx;
            if (og + 1u == (tg + 1u) * nx) xb_add(&bar[XB_TOPGEN], 1u);
            else XB_SPIN(xb_ld(&bar[XB_TOPGEN]) == tg, bar);
            __builtin_amdgcn_fence(__ATOMIC_ACQUIRE, "agent");
            xb_add(&bar[XB_XGEN(b.x)], 1u);
            asm volatile("s_waitcnt vmcnt(0)" ::: "memory");
        } else {
            XB_SPIN(xb_ld(&bar[XB_XGEN(b.x)]) == gen, bar);
            __builtin_amdgcn_fence(__ATOMIC_ACQUIRE, "agent");
            asm volatile("s_waitcnt vmcnt(0)" ::: "memory");
        }
    }
    __syncthreads();
}

struct Frame {
    LAS unsigned char* lds;
    volatile LAS unsigned* MISC;
    gu32* ctl;
    int tid, lane, wave;
    int vcu, G;
    const float *x, *g_mix, *w_in, *g_attn, *rel_tab, *f_w, *f_b, *g_four, *w_out, *g_ffn, *w_gate, *w_val, *conv_w, *conv_b, *w_down, *g_fin;
    float* out;
    unsigned char* ws;
};

__device__ __forceinline__ float wave_sum(float v) {
#pragma unroll
    for (int o = 1; o < 64; o <<= 1) v += __shfl_xor(v, o);
    return v;
}
__device__ __forceinline__ void p0_transpose_item(const float* W, int K, int N, bf16* WT, int row_off, LAS float* scr, int item, int lane, const float* gain = nullptr, bool il = false) {
    const int nblk = N / 32, kb = item / nblk, nb = item % nblk, k0 = 64 * kb, n0 = 32 * nb; if (il) row_off += 128 * (n0 >> 7);
    {   f32x4 v[8]; const int c4 = 4 * (lane & 7);
#pragma unroll
        for (int i = 0; i < 8; ++i) v[i] = __builtin_nontemporal_load((const GAS f32x4*)(W + (size_t)(k0 + (lane >> 3) + 8 * i) * N + n0 + c4));
#pragma unroll
        for (int i = 0; i < 8; ++i) { const int kk = (lane >> 3) + 8 * i; const float gsc = gain ? gain[k0 + kk] : 1.0f; LAS float* sp = scr + kk * 33 + c4;
            sp[0] = v[i].x * gsc; sp[1] = v[i].y * gsc; sp[2] = v[i].z * gsc; sp[3] = v[i].w * gsc; } }
    LDS_WAIT(); asm volatile("" ::: "memory");
    const int c = lane & 7;
#pragma unroll
    for (int j = 0; j < 4; ++j) { const int n = (lane >> 3) + 8 * j; const LAS float* s = scr + (8 * c) * 33 + n;
        v4u o; o.x = pk2(s[0 * 33], s[1 * 33]); o.y = pk2(s[2 * 33], s[3 * 33]); o.z = pk2(s[4 * 33], s[5 * 33]); o.w = pk2(s[6 * 33], s[7 * 33]);
        st_wt16(WT + (size_t)(row_off + n0 + n) * K + k0 + 8 * c, o); }
    LDS_WAIT(); asm volatile("" ::: "memory");
}

__device__ __forceinline__ void p0_quant_strip(Frame& F, const float* W, int N, unsigned char* WT, bool isv, int nb, const float* gain, float* cw6) {
    const int lane = F.lane, w = F.wave, n0 = 32 * nb, c4 = 4 * (lane & 7), K = D; const int row_off = (isv ? 128 : 0) + 128 * (n0 >> 7);
    LAS float* scr = (LAS float*)(F.lds + RING_OFF + w * 16384); LAS float* cmw = (LAS float*)(F.lds + RING_OFF + 8 * 16384 - 2048); LAS float* cmf = cmw + 256;
    f32x4 v[2][8]; f32x4 mx = (f32x4){0.f, 0.f, 0.f, 0.f};
#pragma unroll
    for (int blk = 0; blk < 2; ++blk)
#pragma unroll
        for (int i = 0; i < 8; ++i) v[blk][i] = __builtin_nontemporal_load((const GAS f32x4*)(W + (size_t)(128 * w + 64 * blk + (lane >> 3) + 8 * i) * N + n0 + c4));
#pragma unroll
    for (int blk = 0; blk < 2; ++blk)
#pragma unroll
        for (int i = 0; i < 8; ++i) { v[blk][i] = v[blk][i] * gain[128 * w + 64 * blk + (lane >> 3) + 8 * i];
            mx[0] = fmaxf(mx[0], fabsf(v[blk][i][0])); mx[1] = fmaxf(mx[1], fabsf(v[blk][i][1])); mx[2] = fmaxf(mx[2], fabsf(v[blk][i][2])); mx[3] = fmaxf(mx[3], fabsf(v[blk][i][3])); }
#pragma unroll
    for (int j = 0; j < 4; ++j) { float t = mx[j]; t = fmaxf(t, __shfl_xor(t, 8)); t = fmaxf(t, __shfl_xor(t, 16)); t = fmaxf(t, __shfl_xor(t, 32)); mx[j] = t; }
    if (lane < 8) *(LAS f32x4*)(cmw + w * 32 + c4) = mx;
    __syncthreads();
    if (F.tid < 32) { float t = cmw[F.tid];
#pragma unroll
        for (int ww = 1; ww < 8; ++ww) t = fmaxf(t, cmw[ww * 32 + F.tid]);
        cmf[F.tid] = t; const int nn = n0 + F.tid; cw6[(nn >> 7) * 768 + (isv ? 5 : 4) * 128 + (nn & 127)] = t * (1.0f / 127.0f); }
    __syncthreads();
#pragma unroll
    for (int blk = 0; blk < 2; ++blk) { const int k0 = 128 * w + 64 * blk;
#pragma unroll
        for (int i = 0; i < 8; ++i) { const int kk = (lane >> 3) + 8 * i; LAS float* sp = scr + kk * 33 + c4; sp[0] = v[blk][i][0]; sp[1] = v[blk][i][1]; sp[2] = v[blk][i][2]; sp[3] = v[blk][i][3]; }
        LDS_WAIT(); asm volatile("" ::: "memory");
        const int c = lane & 7;
#pragma unroll
        for (int j = 0; j < 4; ++j) { const int n = (lane >> 3) + 8 * j; const LAS float* sq = scr + (8 * c) * 33 + n; const float cm = cmf[n]; const float inv = cm > 0.f ? 127.0f / cm : 0.f;
            unsigned lo = 0, hi = 0;
#pragma unroll
            for (int t = 0; t < 4; ++t) { lo |= ((unsigned)(int)__builtin_rintf(sq[t * 33] * inv) & 255u) << (8 * t); hi |= ((unsigned)(int)__builtin_rintf(sq[(4 + t) * 33] * inv) & 255u) << (8 * t); }
            v2u o; o.x = lo; o.y = hi; *(GAS v2u*)(WT + (size_t)(row_off + n0 + n) * K + k0 + 8 * c) = o; }
        LDS_WAIT(); asm volatile("" ::: "memory"); }
    __syncthreads();
}
__device__ __forceinline__ void rms_row_to_bf16(const float* xrow, const float* gain, bf16* orow, int lane) {
    const GAS f32x4* xr = (const GAS f32x4*)xrow + lane; const GAS f32x4* gr = (const GAS f32x4*)gain + lane;
    f32x4 v[4]; float s = 0.f;
#pragma unroll
    for (int j = 0; j < 4; ++j) { v[j] = xr[64 * j]; s += (v[j].x * v[j].x + v[j].y * v[j].y) + (v[j].z * v[j].z + v[j].w * v[j].w); }
    const float rstd = 1.0f / sqrtf(wave_sum(s) * (1.f / D) + EPS);
    GAS unsigned long long* o8 = (GAS unsigned long long*)orow + lane;
#pragma unroll
    for (int j = 0; j < 4; ++j) { const f32x4 gg = gr[64 * j]; o8[64 * j] = (unsigned long long)pk2(v[j].x * rstd * gg.x, v[j].y * rstd * gg.y) | ((unsigned long long)pk2(v[j].z * rstd * gg.z, v[j].w * rstd * gg.w) << 32); }
}
__device__ __forceinline__ int t5_bucket(int rel) {
    const int ret = rel > 0 ? 16 : 0; const int n = rel < 0 ? -rel : rel;
    const float nf = (float)(n > 1 ? n : 1);
    int large = 8 + (int)(logf(nf / 8.0f) / logf(128.0f) * 8.0f);
    large = large < 15 ? large : 15;
    return ret + (n < 8 ? n : large);
}

__device__ __forceinline__ void p0_prologue(Frame& F) {
    LAS float* scr = (LAS float*)(F.lds + RING_OFF + F.wave * 16384);
    const int gw = F.vcu * NWAVES + F.wave, NGW = F.G * NWAVES;
    bf16* WinT = (bf16*)(F.ws + WS_WIN); bf16* WoutT = (bf16*)(F.ws + WS_WOUT); bf16* WgvT = (bf16*)(F.ws + WS_WGV); bf16* WdT = (bf16*)(F.ws + WS_WD);
    constexpr int I_IN = (D / 64) * (NPROJ / 32), I_OUT = (MIXW / 64) * (D / 32), I_D = (FF / 64) * (D / 32), NSTRIP = FF / 32;
    constexpr int NITEMS = I_IN + I_OUT + I_D;
    float* cw6 = (float*)(F.ws + WS_TAB + TAB_CW4);
    for (int sj = F.vcu; sj < 2 * NSTRIP; sj += F.G) { const bool isv = sj >= NSTRIP; p0_quant_strip(F, isv ? F.w_val : F.w_gate, FF, F.ws + WS_WGV, isv, isv ? sj - NSTRIP : sj, F.g_ffn, cw6); }
    for (int it = gw; it < NITEMS; it += NGW) {
        int r = it;
        if (r < I_IN) { p0_transpose_item(F.w_in, D, NPROJ, WinT, 0, scr, r, F.lane, F.g_mix); continue; } r -= I_IN;
        if (r < I_OUT) { const int k0 = 64 * (r / (D / 32)); p0_transpose_item(F.w_out, MIXW, D, WoutT, 0, scr, r, F.lane, k0 < AW ? F.g_attn : F.g_four - AW); continue; } r -= I_OUT;
        p0_transpose_item(F.w_down, FF, D, WdT, 0, scr, r, F.lane);
    }
    float* tabBias = (float*)(F.ws + WS_TAB + TAB_BIAS); float* tabMg = (float*)(F.ws + WS_TAB + TAB_MG); float* tabTw = (float*)(F.ws + WS_TAB + TAB_TW);
    const int gt = F.vcu * (NWAVES * 64) + F.tid, NGT = F.G * NWAVES * 64;
    for (int i = gt; i < 3 * 129 * 12; i += NGT) { const int h = i % 12, jj = (i / 12) % 129, br = i / (12 * 129); const int dil = br == 0 ? 1 : (br == 1 ? 4 : 16);
        tabBias[i] = F.rel_tab[t5_bucket((jj - 64) * dil) * 12 + h]; }
    for (int i = gt; i < 4 * 64 * 128; i += NGT) { const int col = i & 127, c = (i >> 7) & 63, g = i >> 13; const int e = col & 63; float acc = 0.f;
        for (int d = 0; d < 64; ++d) { const float rev = (float)((c * d) & 63) * (1.0f / 64.0f); const float t = col < 64 ? __builtin_amdgcn_cosf(rev) : -__builtin_amdgcn_sinf(rev); acc += t * F.f_w[(g * 64 + d) * 64 + e]; }
        tabMg[i] = acc; }
    for (int i = gt; i < (FF / 128) * 512; i += NGT) { const int pn = i >> 9, k = (i >> 7) & 3, c = i & 127, ch = 128 * pn + c; cw6[pn * 768 + k * 128 + c] = k < 3 ? F.conv_w[k * FF + ch] : F.conv_b[ch]; }
    for (int i = gt; i < 4096; i += NGT) { float sv, cv; sincospif((float)i * (1.0f / 2048.0f), &sv, &cv); tabTw[2 * i] = cv; tabTw[2 * i + 1] = sv; }
    bf16* XN = (bf16*)(F.ws + WS_XN);
    {   float* RS0 = (float*)(F.ws + WS_RS0);
        for (int m0 = gw; m0 < M; m0 += 4 * NGW) { f32x4 v[4][4];
#pragma unroll
            for (int r = 0; r < 4; ++r) { const int m = m0 + r * NGW; const GAS f32x4* xr = (const GAS f32x4*)(F.x + (size_t)(m < M ? m : 0) * D) + F.lane;
#pragma unroll
                for (int j = 0; j < 4; ++j) v[r][j] = __builtin_nontemporal_load(xr + 64 * j); }
#pragma unroll
            for (int r = 0; r < 4; ++r) { const int m = m0 + r * NGW; float s = 0.f;
#pragma unroll
                for (int j = 0; j < 4; ++j) s += (v[r][j].x * v[r][j].x + v[r][j].y * v[r][j].y) + (v[r][j].z * v[r][j].z + v[r][j].w * v[r][j].w);
                const float rstd = 1.0f / sqrtf(wave_sum(s) * (1.f / D) + EPS);
                if (m < M) { GAS unsigned long long* o8 = (GAS unsigned long long*)(XN + (size_t)m * D) + F.lane; if (F.lane == 0) RS0[m] = rstd;
#pragma unroll
                    for (int j = 0; j < 4; ++j) { const f32x4 t = v[r][j]; v2u o2; o2.x = pk2(t.x, t.y); o2.y = pk2(t.z, t.w); st_wt8((void*)(o8 + 64 * j), o2); } } } } }
}

namespace att {
typedef short bf16x8 __attribute__((ext_vector_type(8)));
typedef short v4i16 __attribute__((ext_vector_type(4)));
constexpr float LOG2E = 1.4426950408889634f;
constexpr int TABN = 512, TPAD0 = 128;
constexpr int LDS_K = 0, LDS_V = 49152, LDS_T0 = 98304, LDS_T1 = 98304 + 8192;
struct QT { bf16x8 q[2]; f32x4 o[4]; float m, l; };
__device__ __forceinline__ v4i16 vtr(const LAS unsigned char* p) { return __builtin_amdgcn_ds_read_tr16_b64_v4i16((LAS v4i16*)p); }

__device__ __forceinline__ void build_table(Frame& F, int ldsoff, int br, int h) {
    const float* tabBias = (const float*)(F.ws + WS_TAB + TAB_BIAS);
    LAS float* T = (LAS float*)(F.lds + ldsoff);
    for (int e = F.tid; e < 4 * TABN; e += NWAVES * 64) { const int s = e / TABN, n = e % TABN; const int r64 = n + s - TPAD0;
        T[e] = (r64 >= 0 && r64 <= 128) ? tabBias[(br * 129 + r64) * 12 + h] * LOG2E : -INFINITY; }
}
__device__ __forceinline__ const LAS float* table_ptr(Frame& F, int ldsoff, int idx0) { const int s = idx0 & 3; return (const LAS float*)(F.lds + ldsoff) + s * TABN + (idx0 - s); }

__device__ __forceinline__ int pass_tok(int mode, int a, int row) {
    if (mode == 0) { const int t = a - 64 + row; return (t >= 0 && t < SEQ) ? t : -1; }
    if (mode == 3) return a + 16 * row;
    const int hi = row >= 192 ? 1 : 0, u = a + (hi ? row - 192 : row), c = 2 * (mode - 1) + hi; return (u >= 0 && u < SEQ / 4) ? c + 4 * u : -1;
}
struct Pre { v4u k[6], v[6]; };
template <int NIT> __device__ __forceinline__ void prefetch(Frame& F, Pre& R, const bf16* P, int h, int mode, int a) {
#pragma unroll
    for (int it = 0; it < NIT; ++it) { const int idx = F.tid + it * (NWAVES * 64), row = idx >> 3, ph = idx & 7; const int t = pass_tok(mode, a, row);
        const int ck = ph ^ ((row >> 1) & 7), cv = ph ^ (((row >> 1) & 3) << 1);
        R.k[it] = (v4u){0u, 0u, 0u, 0u}; R.v[it] = (v4u){0u, 0u, 0u, 0u};
        if (t >= 0) { const bf16* rp = P + (size_t)t * NPROJ + h * 64; R.k[it] = *(const GAS v4u*)(rp + AW + ck * 8); R.v[it] = *(const GAS v4u*)(rp + 2 * AW + cv * 8); } }
}
template <int NIT> __device__ __forceinline__ void commit(Frame& F, const Pre& R) {
#pragma unroll
    for (int it = 0; it < NIT; ++it) { const int idx = F.tid + it * (NWAVES * 64);
        *(LAS v4u*)(F.lds + LDS_K + idx * 16) = R.k[it]; *(LAS v4u*)(F.lds + LDS_V + idx * 16) = R.v[it]; }
}
__device__ __forceinline__ float xmax4(float v) {
    auto a = __builtin_amdgcn_permlane16_swap(__float_as_uint(v), __float_as_uint(v), false, false); v = fmaxf(__uint_as_float(a[0]), __uint_as_float(a[1]));
    auto b = __builtin_amdgcn_permlane32_swap(__float_as_uint(v), __float_as_uint(v), false, false); return fmaxf(__uint_as_float(b[0]), __uint_as_float(b[1]));
}
__device__ __forceinline__ float xsum4(float v) {
    auto a = __builtin_amdgcn_permlane16_swap(__float_as_uint(v), __float_as_uint(v), false, false); v = __uint_as_float(a[0]) + __uint_as_float(a[1]);
    auto b = __builtin_amdgcn_permlane32_swap(__float_as_uint(v), __float_as_uint(v), false, false); return __uint_as_float(b[0]) + __uint_as_float(b[1]);
}
__device__ __forceinline__ void load_q(QT& T, const bf16* qrow  , int g) {
#pragma unroll
    for (int ks = 0; ks < 2; ++ks) { const v4u w = *(const GAS v4u*)(qrow + 8 * g + 32 * ks); const float sc = 0.125f * LOG2E; v4u o;
        o.x = pk2(bflo(w.x) * sc, bfhi(w.x) * sc); o.y = pk2(bflo(w.y) * sc, bfhi(w.y) * sc); o.z = pk2(bflo(w.z) * sc, bfhi(w.z) * sc); o.w = pk2(bflo(w.w) * sc, bfhi(w.w) * sc);
        T.q[ks] = __builtin_bit_cast(bf16x8, o); }
#pragma unroll
    for (int db = 0; db < 4; ++db) T.o[db] = (f32x4){0.f, 0.f, 0.f, 0.f};
    T.m = -1e30f; T.l = 0.f;
}
typedef float f32x2_t __attribute__((ext_vector_type(2))); typedef __bf16 bf16x2_t __attribute__((ext_vector_type(2)));
__device__ __forceinline__ unsigned cvtpk(float lo, float hi) { f32x2_t v = {lo, hi}; bf16x2_t b = __builtin_convertvector(v, bf16x2_t); return __builtin_bit_cast(unsigned, b); }
constexpr float THR = 8.0f;
template <bool WT> __device__ __forceinline__ void store_row64(bf16* rowp, const v2u (&w)[4], int g) {
#pragma unroll
    for (int k = 0; k < 2; ++k) {
        const auto sx = __builtin_amdgcn_permlane16_swap(w[2 * k].x, w[2 * k + 1].x, false, false); const auto sy = __builtin_amdgcn_permlane16_swap(w[2 * k].y, w[2 * k + 1].y, false, false);
        v4u o; o.x = sx[0]; o.y = sy[0]; o.z = sx[1]; o.w = sy[1];
        if constexpr (WT) st_wt16(rowp + 32 * k + (g & 1) * 16 + (g >> 1) * 8, o); else *(GAS v4u*)(rowp + 32 * k + (g & 1) * 16 + (g >> 1) * 8) = o; }
}
template <int NQ, int NP> __device__ __forceinline__ void attn_step(QT (&T)[NQ], const LAS unsigned char* kp, const LAS unsigned char* vp, const LAS float* const (&tp)[NQ], int p, int koff0, int koff1, const int (&voff)[4], int klo, int khi, bool edge, int g) {
    bf16x8 kf[NP][4]; v4i16 vlo[NP][4], vhi[NP][4];
#pragma unroll
    for (int c = 0; c < NP; ++c) { kf[c][0] = *(const LAS bf16x8*)(kp + c * 4096 + koff0); kf[c][1] = *(const LAS bf16x8*)(kp + c * 4096 + koff1); kf[c][2] = *(const LAS bf16x8*)(kp + c * 4096 + 2048 + koff0); kf[c][3] = *(const LAS bf16x8*)(kp + c * 4096 + 2048 + koff1);
#pragma unroll
        for (int db = 0; db < 4; ++db) { vlo[c][db] = vtr(vp + c * 4096 + voff[db]); vhi[c][db] = vtr(vp + c * 4096 + 2048 + voff[db]); } }
#pragma unroll
    for (int n = 0; n < NQ; ++n) {
        f32x4 s[NP][2];
#pragma unroll
        for (int c = 0; c < NP; ++c) {
            s[c][0] = *(const LAS f32x4*)(tp[n] + (p + c) * 32); s[c][1] = *(const LAS f32x4*)(tp[n] + (p + c) * 32 + 16);
            s[c][0] = __builtin_amdgcn_mfma_f32_16x16x32_bf16(kf[c][0], T[n].q[0], s[c][0], 0, 0, 0); s[c][0] = __builtin_amdgcn_mfma_f32_16x16x32_bf16(kf[c][1], T[n].q[1], s[c][0], 0, 0, 0);
            s[c][1] = __builtin_amdgcn_mfma_f32_16x16x32_bf16(kf[c][2], T[n].q[0], s[c][1], 0, 0, 0); s[c][1] = __builtin_amdgcn_mfma_f32_16x16x32_bf16(kf[c][3], T[n].q[1], s[c][1], 0, 0, 0);
            if (edge) { const int kk = (p + c) * 32 + 4 * g;
#pragma unroll
                for (int r = 0; r < 4; ++r) { if (kk + r < klo || kk + r >= khi) s[c][0][r] = -INFINITY; if (kk + 16 + r < klo || kk + 16 + r >= khi) s[c][1][r] = -INFINITY; } } }
        float tm = fmaxf(fmaxf(fmaxf(s[0][0][0], s[0][0][1]), fmaxf(s[0][0][2], s[0][0][3])), fmaxf(fmaxf(s[0][1][0], s[0][1][1]), fmaxf(s[0][1][2], s[0][1][3])));
        if (NP == 2) tm = fmaxf(tm, fmaxf(fmaxf(fmaxf(s[NP - 1][0][0], s[NP - 1][0][1]), fmaxf(s[NP - 1][0][2], s[NP - 1][0][3])), fmaxf(fmaxf(s[NP - 1][1][0], s[NP - 1][1][1]), fmaxf(s[NP - 1][1][2], s[NP - 1][1][3]))));
        tm = xmax4(tm);
        if (__any(tm > T[n].m + THR)) { const float mn = fmaxf(T[n].m, tm), al = __builtin_amdgcn_exp2f(T[n].m - mn); T[n].m = mn; T[n].l *= al;
#pragma unroll
            for (int db = 0; db < 4; ++db) T[n].o[db] = T[n].o[db] * al; }
        const float mref = T[n].m; float ls = 0.f;
#pragma unroll
        for (int c = 0; c < NP; ++c) {
#pragma unroll
            for (int r = 0; r < 4; ++r) { s[c][0][r] = __builtin_amdgcn_exp2f(s[c][0][r] - mref); s[c][1][r] = __builtin_amdgcn_exp2f(s[c][1][r] - mref); }
            ls += ((s[c][0][0] + s[c][0][1]) + (s[c][0][2] + s[c][0][3])) + ((s[c][1][0] + s[c][1][1]) + (s[c][1][2] + s[c][1][3])); }
        T[n].l += ls;
#pragma unroll
        for (int c = 0; c < NP; ++c) {
            v4u pw; pw.x = cvtpk(s[c][0][0], s[c][0][1]); pw.y = cvtpk(s[c][0][2], s[c][0][3]); pw.z = cvtpk(s[c][1][0], s[c][1][1]); pw.w = cvtpk(s[c][1][2], s[c][1][3]);
            const bf16x8 pf = __builtin_bit_cast(bf16x8, pw);
#pragma unroll
            for (int db = 0; db < 4; ++db) { const bf16x8 vf = (bf16x8){vlo[c][db][0], vlo[c][db][1], vlo[c][db][2], vlo[c][db][3], vhi[c][db][0], vhi[c][db][1], vhi[c][db][2], vhi[c][db][3]};
                T[n].o[db] = __builtin_amdgcn_mfma_f32_16x16x32_bf16(vf, pf, T[n].o[db], 0, 0, 0); } }
    }
}
template <int NQ> __device__ __forceinline__ void attn_job(QT (&T)[NQ], const LAS unsigned char* Kw, const LAS unsigned char* Vw, int npairs, const LAS float* const (&tp)[NQ], int klo, int khi, bool edge, int lane) {
    const int i = lane & 15, g = lane >> 4;
    const int koff0 = i * 128 + (((g) ^ (i >> 1)) << 4), koff1 = i * 128 + (((g + 4) ^ (i >> 1)) << 4);
    const int qq = i >> 2, pp = i & 3, vr = 4 * g + qq, fv = (vr >> 1) & 3;
    int voff[4];
#pragma unroll
    for (int db = 0; db < 4; ++db) voff[db] = vr * 128 + ((((db ^ fv) << 1) + (pp >> 1)) << 4) + (pp & 1) * 8;
    int p = 0;
    if (NQ == 1) {
#pragma unroll 1
        for (; p + 2 <= npairs; p += 2) attn_step<NQ, 2>(T, Kw + p * 4096, Vw + p * 4096, tp, p, koff0, koff1, voff, klo, khi, edge, g);
    }
#pragma unroll 1
    for (; p < npairs; ++p) attn_step<NQ, 1>(T, Kw + p * 4096, Vw + p * 4096, tp, p, koff0, koff1, voff, klo, khi, edge, g);
}
__device__ __forceinline__ void four_ssq(Frame& F) {
    const bf16* A2 = (const bf16*)(F.ws + WS_A2); float* SSA = (float*)(F.ws + WS_SSA);
    const int gw = F.vcu * NWAVES + F.wave, NGW = F.G * NWAVES;
    for (int m0 = gw; m0 < M; m0 += 4 * NGW) { v2u w[4];
#pragma unroll
        for (int r = 0; r < 4; ++r) { const int m = (m0 + r * NGW) < M ? (m0 + r * NGW) : 0; w[r] = *(const GAS v2u*)(A2 + (size_t)m * MIXW + AW + 4 * F.lane); }
#pragma unroll
        for (int r = 0; r < 4; ++r) { const int m = m0 + r * NGW; const float a = bflo(w[r].x), b2 = bfhi(w[r].x), c = bflo(w[r].y), d = bfhi(w[r].y);
            const float s = wave_sum((a * a + b2 * b2) + (c * c + d * d));
            if (m < M && F.lane == 0) *(GAS f32x4*)(SSA + (size_t)m * 16 + 12) = (f32x4){s, 0.f, 0.f, 0.f}; } }
}
__device__ __forceinline__ void phase_local(Frame& F) {
    constexpr int NU = BATCH * NH * 16; const int per = (NU + F.G - 1) / F.G, ub = F.vcu * per, ue = (ub + per) < NU ? (ub + per) : NU;
    const bf16* PROJ = (const bf16*)(F.ws + WS_PROJ); const int lane = F.lane, w = F.wave, i = lane & 15, g = lane >> 4;
    const int idx4 = w >> 1, rA = w & 1, rB = 2 + (w & 1);
    Pre R; int hprev = -1;
    __syncthreads();
    if (ub < ue) { const int bh = ub >> 4; prefetch<6>(F, R, PROJ + (size_t)(bh / NH) * SEQ * NPROJ, bh % NH, 0, (ub & 15) * 256); }
    for (int u = ub; u < ue; ++u) {
        const int bh = u >> 4, b = bh / NH, h = bh % NH, s0 = (u & 15) * 256;
        const bf16* P = PROJ + (size_t)b * SEQ * NPROJ; bf16* A2 = (bf16*)(F.ws + WS_A2) + (size_t)b * SEQ * MIXW; float* ML = (float*)(F.ws + WS_ML) + (size_t)b * SEQ * NH * 2;
        __syncthreads();
        commit<6>(F, R);
        if (h != hprev) { build_table(F, LDS_T0, 0, h); build_table(F, LDS_T1, 1, h); hprev = h; }
        __syncthreads();
        const int u0 = s0 / 4 - 64;
        QT T[2];
        const int tokA = s0 + rA + 4 * (16 * idx4 + i), tokB = s0 + rB + 4 * (16 * idx4 + i);
        load_q(T[0], P + (size_t)tokA * NPROJ + h * 64, g); load_q(T[1], P + (size_t)tokB * NPROJ + h * 64, g);
        asm volatile("" ::: "memory");
        prefetch<6>(F, R, P, h, 1, u0);
        {
            const LAS float* tp[2] = { table_ptr(F, LDS_T0, 4 * g - 4 * i - rA + TPAD0), table_ptr(F, LDS_T0, 4 * g - 4 * i - rB + TPAD0) };
            int klo = 64 - s0 - 64 * idx4; klo = klo > 0 ? klo : 0; int khi = SEQ + 64 - s0 - 64 * idx4; khi = khi < 192 ? khi : 192;
            attn_job<2>(T, F.lds + LDS_K + 64 * idx4 * 128, F.lds + LDS_V + 64 * idx4 * 128, 6, tp, klo, khi, (klo > 0 || khi < 192), lane);
        }
#pragma unroll
        for (int pass = 0; pass < 2; ++pass) {
            __syncthreads();
            commit<6>(F, R);
            __syncthreads();
            if (pass == 0) prefetch<6>(F, R, P, h, 2, u0);
            else if (u + 1 < ue) { const int bh2 = (u + 1) >> 4; prefetch<6>(F, R, PROJ + (size_t)(bh2 / NH) * SEQ * NPROJ, bh2 % NH, 0, ((u + 1) & 15) * 256); }
            const int cl = w & 1, lo = idx4 < 2 ? idx4 : 2;
            const LAS float* tp[1] = { table_ptr(F, LDS_T1, 4 * g - i + 16 * (lo - idx4) + TPAD0) };
            int klo = -(u0 + 16 * lo); klo = klo > 0 ? klo : 0; int khi = SEQ / 4 - (u0 + 16 * lo); khi = khi < 160 ? khi : 160;
            QT (&Tp)[1] = *(QT (*)[1])(&T[pass]);
            attn_job<1>(Tp, F.lds + LDS_K + (192 * cl + 16 * lo) * 128, F.lds + LDS_V + (192 * cl + 16 * lo) * 128, 5, tp, klo, khi, (klo > 0 || khi < 160), lane);
        }
#pragma unroll
        for (int n = 0; n < 2; ++n) {
            const float l = xsum4(T[n].l); const float inv = 1.0f / l; const int tok = n == 0 ? tokA : tokB;
            v2u ow[4];
#pragma unroll
            for (int db = 0; db < 4; ++db) { ow[db].x = pk2(T[n].o[db][0] * inv, T[n].o[db][1] * inv); ow[db].y = pk2(T[n].o[db][2] * inv, T[n].o[db][3] * inv); }
            store_row64<true>(A2 + (size_t)tok * MIXW + h * 64, ow, g);
            if (g == 0) { float* mlp = ML + ((size_t)tok * NH + h) * 2; mlp[0] = T[n].m; mlp[1] = l; }
        }
    }
    __syncthreads();
}
__device__ __forceinline__ void phase_class(Frame& F) {
    four_ssq(F);
    constexpr int NU = BATCH * NH * 16; const int per = (NU + F.G - 1) / F.G, ub = F.vcu * per, ue = (ub + per) < NU ? (ub + per) : NU;
    const bf16* PROJ = (const bf16*)(F.ws + WS_PROJ); const int lane = F.lane, w = F.wave, i = lane & 15, g = lane >> 4; float* SSA = (float*)(F.ws + WS_SSA);
    Pre R; int hprev = -1;
    __syncthreads();
    if (ub < ue) { const int bh = ub >> 4; prefetch<4>(F, R, PROJ + (size_t)(bh / NH) * SEQ * NPROJ, bh % NH, 3, ub & 15); }
    for (int u = ub; u < ue; ++u) {
        const int bh = u >> 4, b = bh / NH, h = bh % NH, r = u & 15;
        const bf16* P = PROJ + (size_t)b * SEQ * NPROJ; bf16* A2 = (bf16*)(F.ws + WS_A2) + (size_t)b * SEQ * MIXW; const float* ML = (const float*)(F.ws + WS_ML) + (size_t)b * SEQ * NH * 2;
        __syncthreads();
        commit<4>(F, R);
        if (h != hprev) { build_table(F, LDS_T0, 2, h); hprev = h; }
        __syncthreads();
        QT T2[2]; float mlv[2], llv[2]; v2u pvv[2][4];
#pragma unroll
        for (int n = 0; n < 2; ++n) { const int qt = n == 0 ? (w < 7 ? w : 11) : (w < 4 ? w + 7 : (w < 7 ? w + 8 : 15)); const int tok = r + 16 * (16 * qt + i);
            load_q(T2[n], P + (size_t)tok * NPROJ + h * 64, g);
            const float* mlp = ML + ((size_t)tok * NH + h) * 2; mlv[n] = mlp[0]; llv[n] = mlp[1];
#pragma unroll
            for (int db = 0; db < 4; ++db) pvv[n][db] = *(const GAS v2u*)(A2 + (size_t)tok * MIXW + h * 64 + 16 * db + 4 * g); }
        asm volatile("" ::: "memory");
        if (u + 1 < ue) { const int bh2 = (u + 1) >> 4; prefetch<4>(F, R, PROJ + (size_t)(bh2 / NH) * SEQ * NPROJ, bh2 % NH, 3, (u + 1) & 15); }
#pragma unroll
        for (int n = 0; n < 2; ++n) {
            const int qt = n == 0 ? (w < 7 ? w : 11) : (w < 4 ? w + 7 : (w < 7 ? w + 8 : 15));
            int lo = qt - 4 > 0 ? qt - 4 : 0, hi = qt + 4 < 15 ? qt + 4 : 15; if (((hi - lo + 1) & 1) != 0) { if (hi < 15) ++hi; else --lo; }
            const int tok = r + 16 * (16 * qt + i);
            QT (&T)[1] = *(QT (*)[1])(&T2[n]);
            const LAS float* tp[1] = { table_ptr(F, LDS_T0, 4 * g - i + 16 * (lo - qt) + 64 + TPAD0) };
            attn_job<1>(T, F.lds + LDS_K + 16 * lo * 128, F.lds + LDS_V + 16 * lo * 128, (hi - lo + 1) >> 1, tp, 0, 1 << 20, false, lane);
            const float l16 = xsum4(T[0].l);
            const float ml = mlv[n], ll = llv[n];
            const float mm = fmaxf(ml, T[0].m), a = __builtin_amdgcn_exp2f(ml - mm) * ll, bb = __builtin_amdgcn_exp2f(T[0].m - mm), inv = 1.0f / (a + bb * l16); float sq = 0.f;
            v2u ow[4];
#pragma unroll
            for (int db = 0; db < 4; ++db) { const v2u pv = pvv[n][db];
                const float f0 = (bflo(pv.x) * a + T[0].o[db][0] * bb) * inv, f1 = (bfhi(pv.x) * a + T[0].o[db][1] * bb) * inv, f2 = (bflo(pv.y) * a + T[0].o[db][2] * bb) * inv, f3 = (bfhi(pv.y) * a + T[0].o[db][3] * bb) * inv;
                sq += (f0 * f0 + f1 * f1) + (f2 * f2 + f3 * f3); ow[db].x = pk2(f0, f1); ow[db].y = pk2(f2, f3); }
            store_row64<false>(A2 + (size_t)tok * MIXW + h * 64, ow, g);
            sq = xsum4(sq);
            if (g == 0) SSA[((size_t)b * SEQ + tok) * 16 + h] = sq;
        }
    }
    __syncthreads();
}
}


namespace fou {
typedef short bf16x8 __attribute__((ext_vector_type(8)));
typedef short v4i16 __attribute__((ext_vector_type(4)));
constexpr int LX = 0, LC = LDSCTL_OFF + 8192, LS = LDSCTL_OFF + 16384;
__device__ __forceinline__ int gsw(int s2) { const int pr = (s2 >> 1) & 7; return (pr & 4) | ((pr & 1) << 1) | ((pr >> 1) & 1); }
__device__ __forceinline__ int xaddr(int pe, int s2, int chunk) { return LX + pe * 8192 + s2 * 128 + (((chunk ^ gsw(s2) ^ pe) & 7) << 4); }
__device__ __forceinline__ int maddr(int base, int k, int chunk) { return base + k * 128 + (((chunk ^ (k >> 1)) & 7) << 4); }
__device__ __forceinline__ v4i16 vtr(const LAS unsigned char* p) { return __builtin_amdgcn_ds_read_tr16_b64_v4i16((LAS v4i16*)p); }
__device__ __forceinline__ bf16x8 neg8(bf16x8 v) { v4u w = __builtin_bit_cast(v4u, v); w.x ^= 0x80008000u; w.y ^= 0x80008000u; w.z ^= 0x80008000u; w.w ^= 0x80008000u; return __builtin_bit_cast(bf16x8, w); }

__device__ __forceinline__ void fourier_unit(Frame& F, int b, int g, int ec) {
    const bf16* PROJ = (const bf16*)(F.ws + WS_PROJ); bf16* A2 = (bf16*)(F.ws + WS_A2); const float* tabMg = (const float*)(F.ws + WS_TAB + TAB_MG);
    const int lane = F.lane, w = F.wave, li = lane & 15, gq = lane >> 4, e0 = 8 * ec;
    LAS unsigned char* L = F.lds;
    __syncthreads();
    bf16x8 mb[2];
#pragma unroll
    for (int ks = 0; ks < 2; ++ks) { float v[8];
#pragma unroll
        for (int j = 0; j < 8; ++j) { const int c = 8 * gq + j + 32 * ks; const int col = li < 8 ? e0 + li : 64 + e0 + (li & 7); v[j] = tabMg[(g * 64 + c) * 128 + col]; }
        v4u o; o.x = pk2(v[0], v[1]); o.y = pk2(v[2], v[3]); o.z = pk2(v[4], v[5]); o.w = pk2(v[6], v[7]); mb[ks] = __builtin_bit_cast(bf16x8, o); }
    const bf16* ub = PROJ + (size_t)(b * SEQ) * NPROJ + 3 * AW + g * 64 + 8 * gq;
#pragma unroll 8
    for (int it = 0; it < 32; ++it) { const int tile = w + 8 * it, s2 = tile & 63, tq = tile >> 6;
        const bf16* up = ub + (size_t)(64 * (16 * tq + li) + s2) * NPROJ;
        const bf16x8 a0 = __builtin_bit_cast(bf16x8, *(const GAS v4u*)up), a1 = __builtin_bit_cast(bf16x8, *(const GAS v4u*)(up + 32));
        f32x4 d = (f32x4){0.f, 0.f, 0.f, 0.f};
        d = __builtin_amdgcn_mfma_f32_16x16x32_bf16(a0, mb[0], d, 0, 0, 0); d = __builtin_amdgcn_mfma_f32_16x16x32_bf16(a1, mb[1], d, 0, 0, 0);
        v2u o; o.x = pk2(d[0], d[1]); o.y = pk2(d[2], d[3]); *(LAS v2u*)(L + xaddr(li, s2, 2 * tq + (gq >> 1)) + (gq & 1) * 8) = o; }
    __syncthreads();
    const int e = w;
#pragma unroll 1
    for (int mt = 0; mt < 4; ++mt) { const int s2 = 16 * mt + li;
        bf16x8 yr[2], yi[2], nyr[2];
#pragma unroll
        for (int kh = 0; kh < 2; ++kh) { yr[kh] = *(const LAS bf16x8*)(L + xaddr(e, s2, gq + 4 * kh)); yi[kh] = *(const LAS bf16x8*)(L + xaddr(8 + e, s2, gq + 4 * kh)); nyr[kh] = neg8(yr[kh]); }
#pragma unroll
        for (int nt = 0; nt < 4; ++nt) { const int k = 16 * nt + li;
            const bf16x8 c0 = *(const LAS bf16x8*)(L + maddr(LC, k, gq)), c1 = *(const LAS bf16x8*)(L + maddr(LC, k, gq + 4)), s0 = *(const LAS bf16x8*)(L + maddr(LS, k, gq)), s1 = *(const LAS bf16x8*)(L + maddr(LS, k, gq + 4));
            f32x4 tr = (f32x4){0.f, 0.f, 0.f, 0.f}, ti = (f32x4){0.f, 0.f, 0.f, 0.f};
            tr = __builtin_amdgcn_mfma_f32_16x16x32_bf16(c0, yr[0], tr, 0, 0, 0); tr = __builtin_amdgcn_mfma_f32_16x16x32_bf16(c1, yr[1], tr, 0, 0, 0);
            tr = __builtin_amdgcn_mfma_f32_16x16x32_bf16(s0, yi[0], tr, 0, 0, 0); tr = __builtin_amdgcn_mfma_f32_16x16x32_bf16(s1, yi[1], tr, 0, 0, 0);
            ti = __builtin_amdgcn_mfma_f32_16x16x32_bf16(c0, yi[0], ti, 0, 0, 0); ti = __builtin_amdgcn_mfma_f32_16x16x32_bf16(c1, yi[1], ti, 0, 0, 0);
            ti = __builtin_amdgcn_mfma_f32_16x16x32_bf16(s0, nyr[0], ti, 0, 0, 0); ti = __builtin_amdgcn_mfma_f32_16x16x32_bf16(s1, nyr[1], ti, 0, 0, 0);
            float orr[4], oii[4];
#pragma unroll
            for (int r = 0; r < 4; ++r) { const int k1 = 16 * nt + 4 * gq + r; const float rev = (float)((k1 * s2) & 4095) * (1.0f / 4096.0f); const float cv = __builtin_amdgcn_cosf(rev), sv = __builtin_amdgcn_sinf(rev);
                orr[r] = tr[r] * cv + ti[r] * sv; oii[r] = ti[r] * cv - tr[r] * sv; }
            v2u o; o.x = pk2(orr[0], orr[1]); o.y = pk2(orr[2], orr[3]); *(LAS v2u*)(L + xaddr(e, s2, 2 * nt + (gq >> 1)) + (gq & 1) * 8) = o;
            o.x = pk2(oii[0], oii[1]); o.y = pk2(oii[2], oii[3]); *(LAS v2u*)(L + xaddr(8 + e, s2, 2 * nt + (gq >> 1)) + (gq & 1) * 8) = o; } }
    asm volatile("s_waitcnt lgkmcnt(0)" ::: "memory");
    bf16x8 af[4][4];
    { const int q = li >> 2, p = li & 3;
#pragma unroll
      for (int mt = 0; mt < 4; ++mt)
#pragma unroll
        for (int ks = 0; ks < 4; ++ks) { const int pe = (ks >> 1) * 8 + e, s2b = 8 * gq + 32 * (ks & 1) + q;
            const v4i16 lo = vtr(L + xaddr(pe, s2b, 2 * mt + (p >> 1)) + (p & 1) * 8), hi = vtr(L + xaddr(pe, s2b + 4, 2 * mt + (p >> 1)) + (p & 1) * 8);
            af[mt][ks] = (bf16x8){lo[0], lo[1], lo[2], lo[3], hi[0], hi[1], hi[2], hi[3]}; } }
    asm volatile("s_waitcnt lgkmcnt(0)" ::: "memory");
    __syncthreads();
    const float bias = F.f_b[g * 64 + e0 + e];
#pragma unroll 1
    for (int nt = 0; nt < 4; ++nt) { const int k2 = 16 * nt + li;
        const bf16x8 c0 = *(const LAS bf16x8*)(L + maddr(LC, k2, gq)), c1 = *(const LAS bf16x8*)(L + maddr(LC, k2, gq + 4)), s0 = *(const LAS bf16x8*)(L + maddr(LS, k2, gq)), s1 = *(const LAS bf16x8*)(L + maddr(LS, k2, gq + 4));
#pragma unroll
        for (int mt = 0; mt < 4; ++mt) { f32x4 d = (f32x4){0.f, 0.f, 0.f, 0.f};
            d = __builtin_amdgcn_mfma_f32_16x16x32_bf16(af[mt][0], c0, d, 0, 0, 0); d = __builtin_amdgcn_mfma_f32_16x16x32_bf16(af[mt][1], c1, d, 0, 0, 0);
            d = __builtin_amdgcn_mfma_f32_16x16x32_bf16(af[mt][2], s0, d, 0, 0, 0); d = __builtin_amdgcn_mfma_f32_16x16x32_bf16(af[mt][3], s1, d, 0, 0, 0);
#pragma unroll
            for (int r = 0; r < 4; ++r) { const int k1 = 16 * mt + 4 * gq + r; *(LAS bf16*)(L + LX + (k1 * 64 + k2) * 16 + e * 2) = (bf16)f2bf(d[r] * (1.0f / 512.0f) + bias); } } }
    __syncthreads();
    bf16* ob = A2 + (size_t)(b * SEQ) * MIXW + AW + g * 64 + e0;
#pragma unroll
    for (int j = 0; j < 8; ++j) { const int sl = F.tid + 512 * j, k1 = sl >> 6, k2 = sl & 63; const v4u v = *(const LAS v4u*)(L + LX + sl * 16); *(GAS v4u*)(ob + (size_t)(k1 + 64 * k2) * MIXW) = v; }
}
__device__ __forceinline__ void phase_fourier(Frame& F) {
    const float* tabTw = (const float*)(F.ws + WS_TAB + TAB_TW);
    __syncthreads();
    for (int idx = F.tid; idx < 4096; idx += NWAVES * 64) { const int k = idx >> 6, s = idx & 63, n = ((k * s) & 63) * 64;
        *(LAS bf16*)(F.lds + maddr(LC, k, s >> 3) + (s & 7) * 2) = (bf16)f2bf(tabTw[2 * n]); *(LAS bf16*)(F.lds + maddr(LS, k, s >> 3) + (s & 7) * 2) = (bf16)f2bf(tabTw[2 * n + 1]); }
    __syncthreads();
    for (int u = F.vcu; u < BATCH * NG * 8; u += F.G) fourier_unit(F, u >> 5, (u >> 3) & 3, u & 7);
    __syncthreads();
}
}

__device__ __forceinline__ void p10_final(Frame& F) {
    const bf16* X2 = (const bf16*)(F.ws + WS_XN); const float* SS2 = (const float*)(F.ws + WS_SS2);
    const int gw = F.vcu * NWAVES + F.wave, NGW = F.G * NWAVES; const int lane = F.lane;
    const GAS f32x4* gr = (const GAS f32x4*)(F.g_fin + 16 * lane); const f32x4 g0 = gr[0], g1 = gr[1], g2 = gr[2], g3 = gr[3];
    for (int m0 = gw; m0 < M; m0 += 4 * NGW) { v4u w0[4], w1[4]; float part[4];
#pragma unroll
        for (int r = 0; r < 4; ++r) { const int m = (m0 + r * NGW) < M ? (m0 + r * NGW) : 0; const GAS v4u* rp = (const GAS v4u*)(X2 + (size_t)m * D + 16 * lane); w0[r] = rp[0]; w1[r] = rp[1];
            part[r] = lane < 16 ? SS2[(size_t)m * 16 + lane] : 0.f; }
#pragma unroll
        for (int r = 0; r < 4; ++r) { const int m = m0 + r * NGW; const float rstd = 1.0f / sqrtf(wave_sum(part[r]) * (1.f / D) + EPS);
            if (m < M) { GAS f32x4* op = (GAS f32x4*)(F.out + (size_t)m * D + 16 * lane);
                op[0] = (f32x4){bflo(w0[r].x), bfhi(w0[r].x), bflo(w0[r].y), bfhi(w0[r].y)} * rstd * g0; op[1] = (f32x4){bflo(w0[r].z), bfhi(w0[r].z), bflo(w0[r].w), bfhi(w0[r].w)} * rstd * g1;
                op[2] = (f32x4){bflo(w1[r].x), bfhi(w1[r].x), bflo(w1[r].y), bfhi(w1[r].y)} * rstd * g2; op[3] = (f32x4){bflo(w1[r].z), bfhi(w1[r].z), bflo(w1[r].w), bfhi(w1[r].w)} * rstd * g3; } } }
}


__device__ __forceinline__ void p8_halo_fix(Frame& F, int pm) {
    const float* H = (const float*)(F.ws + WS_HALO); bf16* ACT = (bf16*)(F.ws + WS_GV); const int kt = pm & 15;
    for (int it = F.tid; it < 2 * (FF / 4); it += NWAVES * 64) { const int c4 = (it % (FF / 4)) * 4, side = it / (FF / 4);
        if ((side == 0 && kt == 0) || (side == 1 && kt == 15)) continue;
        const float* own = H + (size_t)(pm * 2 + side) * 3 * FF + c4; const float* nb = H + (size_t)((side == 0 ? (pm - 1) * 2 + 1 : (pm + 1) * 2)) * 3 * FF + c4;
        const f32x4 gn = *(const GAS f32x4*)nb, zp = *(const GAS f32x4*)(own + FF), vv = *(const GAS f32x4*)(own + 2 * FF), wt = *(const GAS f32x4*)(F.conv_w + (side == 0 ? 0 : 2 * FF) + c4);
        float a[4];
#pragma unroll
        for (int i = 0; i < 4; ++i) { const float z = zp[i] + wt[i] * gn[i]; a[i] = z * __builtin_amdgcn_rcpf(1.0f + __builtin_amdgcn_exp2f(-1.4426950408889634f * z)) * vv[i]; }
        const unsigned long long o = (unsigned long long)pk2(a[0], a[1]) | ((unsigned long long)pk2(a[2], a[3]) << 32);
        __hip_atomic_store((unsigned long long*)(ACT + (size_t)(pm * 256 + (side ? 255 : 0)) * FF + c4), o, __ATOMIC_RELAXED, __HIP_MEMORY_SCOPE_AGENT); }
}


__device__ __forceinline__ void p6_quant(Frame& F) {
    const bf16* X1 = (const bf16*)(F.ws + WS_XN); unsigned char* A8 = F.ws + WS_A8; float* SROW = (float*)(F.ws + WS_SS1);
    const int gw = F.vcu * NWAVES + F.wave, NGW = F.G * NWAVES, lane = F.lane;
    for (int m0 = gw; m0 < M; m0 += 4 * NGW) { v4u w0[4], w1[4];
#pragma unroll
        for (int r = 0; r < 4; ++r) { const int m = (m0 + r * NGW) < M ? (m0 + r * NGW) : 0; const GAS v4u* rp = (const GAS v4u*)(X1 + (size_t)m * D + 16 * lane); w0[r] = rp[0]; w1[r] = rp[1]; }
#pragma unroll
        for (int r = 0; r < 4; ++r) { const int m = m0 + r * NGW; float v[16];
            v[0] = bflo(w0[r].x); v[1] = bfhi(w0[r].x); v[2] = bflo(w0[r].y); v[3] = bfhi(w0[r].y); v[4] = bflo(w0[r].z); v[5] = bfhi(w0[r].z); v[6] = bflo(w0[r].w); v[7] = bfhi(w0[r].w);
            v[8] = bflo(w1[r].x); v[9] = bfhi(w1[r].x); v[10] = bflo(w1[r].y); v[11] = bfhi(w1[r].y); v[12] = bflo(w1[r].z); v[13] = bfhi(w1[r].z); v[14] = bflo(w1[r].w); v[15] = bfhi(w1[r].w);
            float ss = 0.f, mx = 0.f;
#pragma unroll
            for (int i = 0; i < 16; ++i) { ss += v[i] * v[i]; mx = fmaxf(mx, fabsf(v[i])); }
            ss = wave_sum(ss);
#pragma unroll
            for (int o = 1; o < 64; o <<= 1) mx = fmaxf(mx, __shfl_xor(mx, o));
            const float inv = mx > 0.f ? 127.0f / mx : 0.f; unsigned q[4];
#pragma unroll
            for (int j = 0; j < 4; ++j) { q[j] = 0;
#pragma unroll
                for (int t = 0; t < 4; ++t) q[j] |= ((unsigned)(int)__builtin_rintf(v[4 * j + t] * inv) & 255u) << (8 * t); }
            if (m < M) { *(GAS v4u*)(A8 + (size_t)m * D + 16 * lane) = (v4u){q[0], q[1], q[2], q[3]};
                if (lane == 0) SROW[m] = mx * (1.0f / 127.0f) * (1.0f / sqrtf(ss * (1.f / D) + EPS)); } } }
}

struct Args { const float* in[16]; float* out; unsigned char* ws; int ph_lo, ph_hi; };
__global__ void __launch_bounds__(NWAVES * 64, 2) hymba_fwd(Args args) {
    extern __shared__ __attribute__((aligned(16))) unsigned char lds[];
    Frame F;
    F.lds = (LAS unsigned char*)lds;
    F.MISC = (volatile LAS unsigned*)(F.lds + MISC_OFF);
    F.tid = threadIdx.x; F.lane = F.tid & 63; F.wave = __builtin_amdgcn_readfirstlane(F.tid >> 6);
    F.G = gridDim.x; { const int bx = blockIdx.x; F.vcu = (F.G % 8 == 0) ? (bx % 8) * (F.G / 8) + bx / 8 : bx; }
    F.ws = args.ws; F.ctl = (gu32*)(args.ws + WS_CTL);
    F.x = args.in[0]; F.g_mix = args.in[1]; F.w_in = args.in[2]; F.g_attn = args.in[3]; F.rel_tab = args.in[4]; F.f_w = args.in[5]; F.f_b = args.in[6]; F.g_four = args.in[7];
    F.w_out = args.in[8]; F.g_ffn = args.in[9]; F.w_gate = args.in[10]; F.w_val = args.in[11]; F.conv_w = args.in[12]; F.conv_b = args.in[13]; F.w_down = args.in[14]; F.g_fin = args.in[15];
    F.out = args.out;
    for (int u = F.tid; u < (LDS_BYTES - LDSCTL_OFF) / 4; u += NWAVES * 64) ((LAS unsigned*)(F.lds + LDSCTL_OFF))[u] = 0u;
    const unsigned long long pc0 = __builtin_amdgcn_s_getpc() & ~127ull;
#define CODE_PREFETCH() do { if (blockIdx.x < 16 && F.wave == 7) { const GAS unsigned* cb = (const GAS unsigned*)pc0; unsigned v[18], acc = 0u; \
        _Pragma("unroll") for (int i = 0; i < 18; ++i) v[i] = cb[(size_t)(F.lane + 64 * i) * 32]; \
        _Pragma("unroll") for (int i = 0; i < 18; ++i) acc ^= v[i]; \
        if (acc == 0x9e3779b9u) F.MISC[20] = acc; } } while (0)
    CODE_PREFETCH();
    __syncthreads();
    XcdBarrier bar; bar.bar = (unsigned*)(F.ctl + CW_BAR); bar.x = 0; bar.st = nullptr;
    if (MK_ONE_LAUNCH) bar = xcd_barrier_post((unsigned*)(F.ctl + CW_BAR), F.MISC + 8);
#define GRID_BAR() do { if (MK_ONE_LAUNCH) { xcd_barrier(bar); CODE_PREFETCH(); } } while (0)
    const int lo = args.ph_lo, hi = args.ph_hi;
#define IN(k) (lo <= (k) && (k) < hi)
#define BOTH(k) (IN(k) && IN((k) + 1))
    if (IN(0)) { p0_prologue(F); if (BOTH(0)) GRID_BAR(); }
    if (IN(1)) {
        pg8::Gemm g{(const bf16*)(F.ws + WS_XN), (const bf16*)(F.ws + WS_WIN), M, NPROJ, D, D, 0}; pg8::StaticOrder S; S.init(M, NPROJ, F.G, (int)blockIdx.x);
        pg8::EpiBf16Row E{(bf16*)(F.ws + WS_PROJ), NPROJ, (const float*)(F.ws + WS_RS0)};
        pg8::gemm_phase<pg8::EpiBf16Row, pg8::StaticOrder, true, true>(F.lds + RING_OFF, g, S, E);
        if (BOTH(1)) GRID_BAR();
    }
    if (IN(2)) { att::phase_local(F); fou::phase_fourier(F); if (BOTH(2)) GRID_BAR(); }
    if (IN(3)) { att::phase_class(F); if (IN(3) && IN(5)) GRID_BAR(); }
    if (IN(5)) {
        pg8::Gemm g{(const bf16*)(F.ws + WS_A2), (const bf16*)(F.ws + WS_WOUT), M, D, MIXW, MIXW, 0}; pg8::StaticOrder S; S.init(M, D, F.G, (int)blockIdx.x);
        if (F.G == 256) {
            pg8::EpiX1Q E{(const bf16*)(F.ws + WS_XN), (bf16*)(F.ws + WS_XN), D, (const float*)(F.ws + WS_SSA), (LAS float*)(F.lds + LDSCTL_OFF + 8192), F.ws + WS_A8, (float*)(F.ws + WS_SS1), (float*)(F.ws + WS_XBUF), (unsigned*)(F.ctl + CW_PANEL2), F.lds + LDSCTL_OFF};
            pg8::gemm_phase<pg8::EpiX1Q, pg8::StaticOrder, true, true>(F.lds + RING_OFF, g, S, E);
        } else {
            pg8::EpiX1N E{(const bf16*)(F.ws + WS_XN), (bf16*)(F.ws + WS_XN), D, (float*)(F.ws + WS_SS1), (const float*)(F.ws + WS_SSA), (LAS float*)(F.lds + LDSCTL_OFF + 8192)};
            pg8::gemm_phase<pg8::EpiX1N, pg8::StaticOrder, true, true>(F.lds + RING_OFF, g, S, E);
        }
        if (IN(5) && IN(6)) GRID_BAR();
    }
    if (IN(6) && F.G != 256) { p6_quant(F); if (IN(6) && IN(7)) GRID_BAR(); }
    if (IN(7)) {
        pg8::Gemm g{(const bf16*)(F.ws + WS_A8), (const bf16*)(F.ws + WS_WGV), M, 2 * FF, D / 2, D / 2, 0}; pg8::StaticOrder S; S.init(M, 2 * FF, F.G, (int)blockIdx.x);
        pg8::EpiConvGlu E{(bf16*)(F.ws + WS_GV), FF, (const float*)(F.ws + WS_SS1), F.conv_w, F.conv_b, (LAS float*)(F.lds + LDSCTL_OFF + 4096), M, (float*)(F.ws + WS_HALO), (const float*)(F.ws + WS_TAB + TAB_CW4)};
        pg8::gemm_phase<pg8::EpiConvGlu, pg8::StaticOrder, true, true, true>(F.lds + RING_OFF, g, S, E);
        if (IN(7) && IN(9)) GRID_BAR();
    }
    if (IN(9)) {
        pg8::Gemm g{(const bf16*)(F.ws + WS_GV), (const bf16*)(F.ws + WS_WD), M, D, FF, FF, 0}; pg8::StaticOrder S; S.init(M, D, F.G, (int)blockIdx.x);
        { pg8::Unit uu; for (int i = 0; S.next(i, uu); ++i) p8_halo_fix(F, uu.pm); }
        asm volatile("s_waitcnt vmcnt(0)" ::: "memory"); __syncthreads();
        if (F.G == 256) {
            pg8::EpiFinal E{(const bf16*)(F.ws + WS_XN), F.out, D, F.g_fin, (float*)(F.ws + WS_XBUF), (unsigned*)(F.ctl + CW_PANEL), F.lds + LDSCTL_OFF + 4096};
            pg8::gemm_phase<pg8::EpiFinal, pg8::StaticOrder, true, true>(F.lds + RING_OFF, g, S, E);
        } else {
            pg8::EpiX2 E{(bf16*)(F.ws + WS_XN), D, (float*)(F.ws + WS_SS2)};
            pg8::gemm_phase<pg8::EpiX2, pg8::StaticOrder, true, true>(F.lds + RING_OFF, g, S, E);
            if (BOTH(9)) GRID_BAR();
        }
    }
    if (IN(10) && F.G != 256) { p10_final(F); }
#undef IN
#undef BOTH
}

extern "C" void kernel_launch(void* const* d_in, const int* in_sizes, int n_in, void* d_out, int out_size, void* d_ws, size_t ws_size, hipStream_t stream) {
    static int grid = 0;
    if (grid == 0) {
        if (n_in != 16 || in_sizes[0] != M * D || out_size != M * D || ws_size < WS_END) { fprintf(stderr, "kernel_launch: shape/workspace mismatch: n_in %d in0 %d out %d ws %zu (need %zu)\n", n_in, n_in > 0 ? in_sizes[0] : -1, out_size, ws_size, (size_t)WS_END); grid = -1; return; }
        int dev = 0, cus = 0, per_cu = 0;
        if (hipGetDevice(&dev) != hipSuccess || hipDeviceGetAttribute(&cus, hipDeviceAttributeMultiprocessorCount, dev) != hipSuccess) { grid = -1; return; }
        if (hipFuncSetAttribute((const void*)hymba_fwd, hipFuncAttributeMaxDynamicSharedMemorySize, LDS_BYTES) != hipSuccess) { fprintf(stderr, "kernel_launch: hipFuncSetAttribute failed\n"); grid = -1; return; }
        if (hipOccupancyMaxActiveBlocksPerMultiprocessor(&per_cu, (const void*)hymba_fwd, NWAVES * 64, LDS_BYTES) != hipSuccess || per_cu < 1) { fprintf(stderr, "kernel_launch: occupancy query says %d blocks/CU\n", per_cu); (void)hipGetLastError(); grid = -1; return; }
        grid = cus;
    }
    if (grid < 0) return;
    (void)hipMemsetAsync((char*)d_ws + WS_CTL, 0, CTL_ZERO_BYTES, stream);
    Args a{};
    for (int i = 0; i < 16; ++i) a.in[i] = (const float*)d_in[i];
    a.out = (float*)d_out; a.ws = (unsigned char*)d_ws;
#if MK_ONE_LAUNCH
    a.ph_lo = 0; a.ph_hi = N_PHASES;
    hipLaunchKernelGGL(hymba_fwd, dim3(grid), dim3(NWAVES * 64), LDS_BYTES, stream, a);
#else
    for (int p = 0; p < N_PHASES; ++p) { a.ph_lo = p; a.ph_hi = p + 1; hipLaunchKernelGGL(hymba_fwd, dim3(grid), dim3(NWAVES * 64), LDS_BYTES, stream, a); }
#endif
}
```

```cpp
#include <hip/hip_runtime.h>
#include <cstdio>
#include <cstdint>

namespace pg8 {
#define PG8_LAS __attribute__((address_space(3)))
typedef unsigned short bf16_t;
typedef short bf16x8 __attribute__((ext_vector_type(8)));
typedef float f32x4 __attribute__((ext_vector_type(4)));
typedef unsigned u32x4 __attribute__((ext_vector_type(4)));
typedef int i32x4 __attribute__((ext_vector_type(4)));
template <bool I8> struct AccT { typedef f32x4 type; };
template <> struct AccT<true> { typedef i32x4 type; };
constexpr int BM = 256, BK = 64, HALF = 128, HTB = HALF * BK * 2, STAGE_BYTES = 8 * HTB, NXCD = 8, WGM = 8;

__host__ __device__ __forceinline__ int lds_byte(int r, int c) { const int st = (r >> 4) * 2 + (c >> 5), rr = r & 15, cc = c & 31, ob = rr * 64 + cc * 2; return st * 1024 + (ob ^ (((ob >> 9) & 1) << 5)); }
__host__ __device__ __forceinline__ void stage_rc(int b, int& R, int& C) { const int st = b / 1024, sb = b % 1024, swz = sb ^ (((sb >> 9) & 1) << 5); R = (st >> 1) * 16 + swz / 64; C = (st & 1) * 32 + (swz % 64) / 2; }
__host__ __device__ __forceinline__ int perm32(int rho) { const int n = rho >> 4, i = rho & 15; return 8 * (i >> 2) + 4 * n + (i & 3); }

struct Unit { int pm, pn; };
struct Gemm { const bf16_t* A; const bf16_t* Bt; int M, N, K, lda; int ovl; };
__host__ __device__ __forceinline__ int ovl_row_base(int pm) { const int b = pm / 17, k = pm - 17 * b; return b * 4096 + (k ? 254 * k - 1 : 0); }

struct StaticOrder {
    int nM, nN, nwg, G, c;
    __host__ __device__ void init(int M, int N, int G_, int c_) { nM = M / BM; nN = N / BM; nwg = nM * nN; G = G_; c = c_; }
    __host__ __device__ bool next(int i, Unit& u) const {
        const long L = (long)i * G + c; if (L >= nwg) return false;
        int wgid = (int)L; { const int q = nwg / NXCD, r = nwg % NXCD, xcd = wgid % NXCD, off = wgid / NXCD; wgid = (xcd < r ? xcd * (q + 1) : r * (q + 1) + (xcd - r) * q) + off; }
        const int nig = WGM * nN, gid = wgid / nig, fm = gid * WGM, gsz = (nM - fm) < WGM ? (nM - fm) : WGM;
        u.pm = fm + ((wgid % nig) % gsz); u.pn = (wgid % nig) / gsz; return true;
    }
    __device__ __forceinline__ void a_ready(const Unit&) const {}
    __device__ __forceinline__ void done(const Unit&) const {}
};

typedef float f32x2v_t __attribute__((ext_vector_type(2))); typedef __bf16 bf16x2v_t __attribute__((ext_vector_type(2)));
__device__ __forceinline__ unsigned cvt_pk_bf16(float lo, float hi) { f32x2v_t v = {lo, hi}; bf16x2v_t b = __builtin_convertvector(v, bf16x2v_t); return __builtin_bit_cast(unsigned, b); }

__device__ __forceinline__ void st_wt8(void* p, unsigned long long v) { asm volatile("global_store_dwordx2 %0, %1, off sc1" :: "v"(p), "v"(v)); }
__device__ __forceinline__ void st_wt(void* p, u32x4 v) { asm volatile("global_store_dwordx4 %0, %1, off sc1\n\ts_nop 2" :: "v"(p), "v"(v));        }
struct EpiBf16 {
    static constexpr bool PERM = true, AFTER_DRAIN = false, MIDK = false, PREFETCH = false;
    bf16_t* O; int ldc;
    __device__ __forceinline__ void operator()(const f32x4 (&acc)[2][2][4][2], const Unit& u, int wr, int wc, int fr, int fq) const {
        const int row0 = u.pm * BM + wr * 64 + fr; const int col0 = u.pn * BM + wc * 32 + 8 * fq;
#pragma unroll
        for (int ai = 0; ai < 2; ++ai)
#pragma unroll
            for (int m = 0; m < 4; ++m) { bf16_t* rowp = O + (size_t)(row0 + ai * HALF + m * 16) * ldc + col0;
#pragma unroll
                for (int bj = 0; bj < 2; ++bj) { const f32x4 v0 = acc[ai][bj][m][0], v1 = acc[ai][bj][m][1];
                    u32x4 w; w.x = cvt_pk_bf16(v0[0], v0[1]); w.y = cvt_pk_bf16(v0[2], v0[3]); w.z = cvt_pk_bf16(v1[0], v1[1]); w.w = cvt_pk_bf16(v1[2], v1[3]);
                    *(u32x4*)(rowp + bj * HALF) = w; } }
    }
};

struct EpiBf16Row {
    static constexpr bool PERM = true, AFTER_DRAIN = false, MIDK = false, PREFETCH = false;
    bf16_t* O; int ldc; const float* rs;
    __device__ __forceinline__ void operator()(const f32x4 (&acc)[2][2][4][2], const Unit& u, int wr, int wc, int fr, int fq) const {
        const int row0 = u.pm * BM + wr * 64 + fr; const int col0 = u.pn * BM + wc * 32 + 8 * fq;
#pragma unroll
        for (int ai = 0; ai < 2; ++ai)
#pragma unroll
            for (int m = 0; m < 4; ++m) { const int row = row0 + ai * HALF + m * 16; const float r = rs[row]; bf16_t* rowp = O + (size_t)row * ldc + col0;
#pragma unroll
                for (int bj = 0; bj < 2; ++bj) { const f32x4 v0 = acc[ai][bj][m][0] * r, v1 = acc[ai][bj][m][1] * r;
                    u32x4 w; w.x = cvt_pk_bf16(v0[0], v0[1]); w.y = cvt_pk_bf16(v0[2], v0[3]); w.z = cvt_pk_bf16(v1[0], v1[1]); w.w = cvt_pk_bf16(v1[2], v1[3]);
                    st_wt(rowp + bj * HALF, w); } }
    }
};
struct EpiResF32 {
    static constexpr bool PERM = false, AFTER_DRAIN = false, MIDK = false, PREFETCH = false;
    const float* base; float* out; int ldc;
    __device__ __forceinline__ void operator()(const f32x4 (&acc)[2][2][4][2], const Unit& u, int wr, int wc, int fr, int fq) const {
        const int col0 = u.pn * BM + wc * 32 + 4 * fq;
#pragma unroll
        for (int ai = 0; ai < 2; ++ai)
#pragma unroll
            for (int m = 0; m < 4; ++m) { const int r = u.pm * BM + ai * HALF + wr * 64 + m * 16 + fr; const size_t off = (size_t)r * ldc + col0;
#pragma unroll
                for (int bj = 0; bj < 2; ++bj)
#pragma unroll
                    for (int n = 0; n < 2; ++n) { const f32x4 bs = *(const f32x4*)(base + off + bj * HALF + n * 16); *(f32x4*)(out + off + bj * HALF + n * 16) = bs + acc[ai][bj][m][n]; } }
    }
};


struct EpiX1 {
    static constexpr bool PERM = true, AFTER_DRAIN = false, MIDK = false, PREFETCH = false;
    const float* base; bf16_t* O; int ldc; float* ss;
    __device__ __forceinline__ void operator()(const f32x4 (&acc)[2][2][4][2], const Unit& u, int wr, int wc, int fr, int fq) const {
        const int row0 = u.pm * BM + wr * 64 + fr; const int col0 = u.pn * BM + wc * 32 + 8 * fq;
#pragma unroll
        for (int ai = 0; ai < 2; ++ai)
#pragma unroll
            for (int m = 0; m < 4; ++m) { const int row = row0 + ai * HALF + m * 16; const size_t off = (size_t)row * ldc + col0; float q = 0.f;
#pragma unroll
                for (int bj = 0; bj < 2; ++bj) { const f32x4 v0 = *(const f32x4*)(base + off + bj * HALF) + acc[ai][bj][m][0], v1 = *(const f32x4*)(base + off + bj * HALF + 4) + acc[ai][bj][m][1];
                    q += (v0[0] * v0[0] + v0[1] * v0[1]) + (v0[2] * v0[2] + v0[3] * v0[3]) + (v1[0] * v1[0] + v1[1] * v1[1]) + (v1[2] * v1[2] + v1[3] * v1[3]);
                    u32x4 w; w.x = cvt_pk_bf16(v0[0], v0[1]); w.y = cvt_pk_bf16(v0[2], v0[3]); w.z = cvt_pk_bf16(v1[0], v1[1]); w.w = cvt_pk_bf16(v1[2], v1[3]);
                    *(u32x4*)(O + off + bj * HALF) = w; }
                q += __shfl_xor(q, 16); q += __shfl_xor(q, 32);
                if (fq == 0) ss[(size_t)row * 16 + u.pn * 4 + wc] = q; }
    }
};
struct EpiX2 {
    static constexpr bool PERM = true, AFTER_DRAIN = false, MIDK = false, PREFETCH = false;
    bf16_t* X; int ldc; float* ss;
    __device__ __forceinline__ void operator()(const f32x4 (&acc)[2][2][4][2], const Unit& u, int wr, int wc, int fr, int fq) const {
        const int row0 = u.pm * BM + wr * 64 + fr; const int col0 = u.pn * BM + wc * 32 + 8 * fq;
#pragma unroll
        for (int ai = 0; ai < 2; ++ai)
#pragma unroll
            for (int m = 0; m < 4; ++m) { const int row = row0 + ai * HALF + m * 16; const size_t off = (size_t)row * ldc + col0; float q = 0.f;
#pragma unroll
                for (int bj = 0; bj < 2; ++bj) { const u32x4 xb = *(const u32x4*)(X + off + bj * HALF);
                    f32x4 v0, v1; v0[0] = __builtin_bit_cast(float, xb.x << 16); v0[1] = __builtin_bit_cast(float, xb.x & 0xffff0000u); v0[2] = __builtin_bit_cast(float, xb.y << 16); v0[3] = __builtin_bit_cast(float, xb.y & 0xffff0000u);
                    v1[0] = __builtin_bit_cast(float, xb.z << 16); v1[1] = __builtin_bit_cast(float, xb.z & 0xffff0000u); v1[2] = __builtin_bit_cast(float, xb.w << 16); v1[3] = __builtin_bit_cast(float, xb.w & 0xffff0000u);
                    v0 = v0 + acc[ai][bj][m][0]; v1 = v1 + acc[ai][bj][m][1];
                    q += (v0[0] * v0[0] + v0[1] * v0[1]) + (v0[2] * v0[2] + v0[3] * v0[3]) + (v1[0] * v1[0] + v1[1] * v1[1]) + (v1[2] * v1[2] + v1[3] * v1[3]);
                    u32x4 w; w.x = cvt_pk_bf16(v0[0], v0[1]); w.y = cvt_pk_bf16(v0[2], v0[3]); w.z = cvt_pk_bf16(v1[0], v1[1]); w.w = cvt_pk_bf16(v1[2], v1[3]);
                    *(u32x4*)(X + off + bj * HALF) = w; }
                q += __shfl_xor(q, 16); q += __shfl_xor(q, 32);
                if (fq == 0) ss[(size_t)row * 16 + u.pn * 4 + wc] = q; }
    }
};
struct EpiBf16Rs {
    static constexpr bool PERM = true, AFTER_DRAIN = false, MIDK = false, PREFETCH = false;
    bf16_t* O; int ldc; const float* ss; float inv_n, eps;
    __device__ __forceinline__ void operator()(const f32x4 (&acc)[2][2][4][2], const Unit& u, int wr, int wc, int fr, int fq) const {
        const int row0 = u.pm * BM + wr * 64 + fr; const int col0 = u.pn * BM + wc * 32 + 8 * fq;
#pragma unroll
        for (int ai = 0; ai < 2; ++ai)
#pragma unroll
            for (int m = 0; m < 4; ++m) { const int row = row0 + ai * HALF + m * 16; const f32x4* sp = (const f32x4*)(ss + (size_t)row * 16);
                const f32x4 s4 = (sp[0] + sp[1]) + (sp[2] + sp[3]); const float rs = 1.0f / sqrtf(((s4[0] + s4[1]) + (s4[2] + s4[3])) * inv_n + eps);
                bf16_t* rowp = O + (size_t)row * ldc + col0;
#pragma unroll
                for (int bj = 0; bj < 2; ++bj) { const f32x4 v0 = acc[ai][bj][m][0] * rs, v1 = acc[ai][bj][m][1] * rs;
                    u32x4 w; w.x = cvt_pk_bf16(v0[0], v0[1]); w.y = cvt_pk_bf16(v0[2], v0[3]); w.z = cvt_pk_bf16(v1[0], v1[1]); w.w = cvt_pk_bf16(v1[2], v1[3]);
                    *(u32x4*)(rowp + bj * HALF) = w; } }
    }
};


template <int CTRL> __device__ __forceinline__ float dppk(float keep, float x) { return __builtin_bit_cast(float, __builtin_amdgcn_update_dpp(__builtin_bit_cast(int, keep), __builtin_bit_cast(int, x), CTRL, 0xf, 0xf, false)); }
template <int CTRL> __device__ __forceinline__ float dppf(float x) { return __builtin_bit_cast(float, __builtin_amdgcn_mov_dpp(__builtin_bit_cast(int, x), CTRL, 0xf, 0xf, true)); }
struct EpiConvGlu {
    static constexpr bool PERM = true, AFTER_DRAIN = false, MIDK = false, PREFETCH = true, PERMA = true;
    bf16_t* O; int ldc; const float* ss; const float* cw; const float* cb; PG8_LAS float* ex; int mrows; float* halo; const float* cw4;
    __device__ __forceinline__ void prefetch(const Unit& u, int wid, int lane) const {
        const int base = u.pm * BM; asm volatile("" : "+v"(lane));
        if (wid == 0) __builtin_amdgcn_global_load_lds((const unsigned*)(ss + base + lane * 4), (PG8_LAS unsigned*)(ex + 1024), 16, 0, 0);
        else if (wid < 4) __builtin_amdgcn_global_load_lds((const unsigned*)(cw4 + u.pn * 768 + (wid - 1) * 256 + lane * 4), (PG8_LAS unsigned*)(ex + 1024 + 4096 + (wid - 1) * 256), 16, 0, 0);
    }
    __device__ __forceinline__ void operator()(i32x4 (&iacc)[2][2][4][2], const Unit& u, int wr, int wc, int fr, int fq) const {
        f32x4 acc[2][2][4][2];
        const int kt = u.pm & 15, base = u.pm * BM;
        const int ch0 = u.pn * 128 + wc * 32 + 8 * fq;
        const bool top_open = kt != 0, bot_open = kt != 15;
        f32x4 w0[2], w1[2], w2[2], cbv[2], isv[2];
#pragma unroll
        for (int n = 0; n < 2; ++n) { const PG8_LAS float* wl = ex + 1024 + 4096 + wc * 32 + 8 * fq + 4 * n; const f32x4 sg = *(const PG8_LAS f32x4*)(wl + 512) * -1.4426950408889634f;
            w0[n] = *(const PG8_LAS f32x4*)wl * sg; w1[n] = *(const PG8_LAS f32x4*)(wl + 128) * sg; w2[n] = *(const PG8_LAS f32x4*)(wl + 256) * sg; cbv[n] = *(const PG8_LAS f32x4*)(wl + 384) * -1.4426950408889634f;
            const f32x4 svn = *(const PG8_LAS f32x4*)(wl + 640);
#pragma unroll
            for (int i = 0; i < 4; ++i) isv[n][i] = __builtin_amdgcn_rcpf(fminf(svn[i] * -0.6931471805599453f, -1e-30f)); }
#pragma unroll
        for (int ai = 0; ai < 2; ++ai) { const f32x4 rs4 = *(const PG8_LAS f32x4*)(ex + 1024 + ai * HALF + wr * 64 + fr * 4);
#pragma unroll
            for (int m = 0; m < 4; ++m) { const float rs = rs4[m];
#pragma unroll
                for (int n = 0; n < 2; ++n) { const i32x4 ig = iacc[ai][0][m][n], iv = iacc[ai][1][m][n];
                    acc[ai][0][m][n] = (f32x4){(float)ig[0], (float)ig[1], (float)ig[2], (float)ig[3]} * rs; acc[ai][1][m][n] = (f32x4){(float)iv[0], (float)iv[1], (float)iv[2], (float)iv[3]} * rs; } } }
        const int exi = (wc * 4 + fq) * 8;
        if (fr == 0) {
#pragma unroll
            for (int ai = 0; ai < 2; ++ai) { PG8_LAS f32x4* p = (PG8_LAS f32x4*)(ex + ((ai * 2 + wr) * 2 + 0) * 128 + exi); p[0] = acc[ai][0][0][0]; p[1] = acc[ai][0][0][1]; } }
        if (fr == 15) {
#pragma unroll
            for (int ai = 0; ai < 2; ++ai) { PG8_LAS f32x4* p = (PG8_LAS f32x4*)(ex + ((ai * 2 + wr) * 2 + 1) * 128 + exi); p[0] = acc[ai][0][3][0]; p[1] = acc[ai][0][3][1]; } }
        asm volatile("s_waitcnt lgkmcnt(0)\n\ts_barrier" ::: "memory");
#pragma unroll
        for (int ai = 0; ai < 2; ++ai) {
            f32x4 et[2] = {(f32x4){0.f, 0.f, 0.f, 0.f}, (f32x4){0.f, 0.f, 0.f, 0.f}}, eb[2] = {(f32x4){0.f, 0.f, 0.f, 0.f}, (f32x4){0.f, 0.f, 0.f, 0.f}};
            { const bool hz = (wr == 0 && ai == 0); const int sai = wr == 1 ? ai : 0, swr = wr == 1 ? 0 : 1; const PG8_LAS f32x4* p = (const PG8_LAS f32x4*)(ex + ((sai * 2 + swr) * 2 + 1) * 128 + exi);
              if (!hz) { et[0] = p[0]; et[1] = p[1]; } }
            { const bool hz = (wr == 1 && ai == 1); const int sai = wr == 0 ? ai : 1, swr = wr == 0 ? 1 : 0; const PG8_LAS f32x4* p = (const PG8_LAS f32x4*)(ex + ((sai * 2 + swr) * 2 + 0) * 128 + exi);
              if (!hz) { eb[0] = p[0]; eb[1] = p[1]; } }
            float a[4][8], zz[8];
#pragma unroll
            for (int n = 0; n < 2; ++n)
#pragma unroll
                for (int i = 0; i < 4; ++i) { const float g0 = acc[ai][0][0][n][i], g1 = acc[ai][0][1][n][i], g2 = acc[ai][0][2][n][i], g3 = acc[ai][0][3][n][i];
                    const float up = dppk<0x111>(et[n][i], g3), dn = dppk<0x101>(eb[n][i], g0);
                    const float c0 = w0[n][i], c1 = w1[n][i], c2 = w2[n][i], cb0 = cbv[n][i];
                    float z[4];
                    z[0] = __builtin_fmaf(c2, g1, __builtin_fmaf(c1, g0, __builtin_fmaf(c0, up, cb0)));
                    z[1] = __builtin_fmaf(c2, g2, __builtin_fmaf(c1, g1, __builtin_fmaf(c0, g0, cb0)));
                    z[2] = __builtin_fmaf(c2, g3, __builtin_fmaf(c1, g2, __builtin_fmaf(c0, g1, cb0)));
                    z[3] = __builtin_fmaf(c2, dn, __builtin_fmaf(c1, g3, __builtin_fmaf(c0, g2, cb0)));
                    zz[4 * n + i] = (ai == 0 ? z[0] : z[3]) * -0.6931471805599453f;
#pragma unroll
                    for (int m = 0; m < 4; ++m) { const float iv0 = isv[n][i]; a[m][4 * n + i] = z[m] * __builtin_amdgcn_rcpf(__builtin_fmaf(__builtin_amdgcn_exp2f(z[m]), iv0, iv0)) * acc[ai][1][m][n][i]; } }
#pragma unroll
            for (int m = 0; m < 4; ++m) { const int r = ai * HALF + wr * 64 + fr * 4 + m; u32x4 w;
                w.x = cvt_pk_bf16(a[m][0], a[m][1]); w.y = cvt_pk_bf16(a[m][2], a[m][3]); w.z = cvt_pk_bf16(a[m][4], a[m][5]); w.w = cvt_pk_bf16(a[m][6], a[m][7]);
                bool open = false;
                if (ai == 0 && m == 0) open = (r == 0) && top_open;
                if (ai == 1 && m == 3) open = (r == 255) && bot_open;
                if (!open) st_wt(O + (size_t)(base + r) * ldc + ch0, w);
                if ((ai == 0 && m == 0) || (ai == 1 && m == 3)) { if (open) { float* hp = halo + ((size_t)(u.pm * 2 + (ai == 0 ? 0 : 1)) * 3) * ldc + ch0;
                        const PG8_LAS float* sl = ex + 1024 + 4096 + 512 + wc * 32 + 8 * fq;
                        *(f32x4*)hp = acc[ai][0][m][0] * *(const PG8_LAS f32x4*)sl; *(f32x4*)(hp + 4) = acc[ai][0][m][1] * *(const PG8_LAS f32x4*)(sl + 4);
                        *(f32x4*)(hp + ldc) = (f32x4){zz[0], zz[1], zz[2], zz[3]}; *(f32x4*)(hp + ldc + 4) = (f32x4){zz[4], zz[5], zz[6], zz[7]};
                        *(f32x4*)(hp + 2 * ldc) = acc[ai][1][m][0] * *(const PG8_LAS f32x4*)(sl + 128); *(f32x4*)(hp + 2 * ldc + 4) = acc[ai][1][m][1] * *(const PG8_LAS f32x4*)(sl + 132); } }
                asm volatile("" ::: "memory"); } }
        asm volatile("s_waitcnt lgkmcnt(0)\n\ts_barrier" ::: "memory");
    }
};


struct EpiX1N {
    static constexpr bool PERM = true, AFTER_DRAIN = false, MIDK = true, PREFETCH = true; static constexpr int MIDK_T = 12;
    const bf16_t* base; bf16_t* O; int ldc; float* ss; const float* sa; PG8_LAS float* st;
    __device__ __forceinline__ void prefetch(const Unit& u, int wid, int lane) const {
        asm volatile("" : "+v"(lane));
#pragma unroll
        for (int i = 0; i < 2; ++i) { const int piece = wid * 2 + i;
            __builtin_amdgcn_global_load_lds((const unsigned*)(sa + (size_t)u.pm * BM * 16 + piece * 256 + lane * 4), (PG8_LAS unsigned*)(st + piece * 256), 16, 0, 0); }
    }
    __device__ __forceinline__ void row_stats(int rl, int fq, float& ra, float& rf) const {
        const f32x4 s4 = *(const PG8_LAS f32x4*)(st + rl * 16 + 4 * fq); float a = fq < 3 ? (s4[0] + s4[1]) + (s4[2] + s4[3]) : 0.f, f = fq == 3 ? s4[0] : 0.f;
        a += __shfl_xor(a, 16); a += __shfl_xor(a, 32); f += __shfl_xor(f, 16); f += __shfl_xor(f, 32);
        ra = __builtin_amdgcn_rsqf(a * (1.0f / 768.0f) + 1e-6f); rf = __builtin_amdgcn_rsqf(f * (1.0f / 256.0f) + 1e-6f);
    }
    __device__ __forceinline__ void midk(f32x4 (&acc)[2][2][4][2], const Unit& u, int wr, int fr, int fq) const {
#pragma unroll
        for (int ai = 0; ai < 2; ++ai)
#pragma unroll
            for (int m = 0; m < 4; ++m) { float ra, rf; row_stats(ai * HALF + wr * 64 + m * 16 + fr, fq, ra, rf); const float ratio = ra * __builtin_amdgcn_rcpf(rf);
#pragma unroll
                for (int bj = 0; bj < 2; ++bj) { acc[ai][bj][m][0] = acc[ai][bj][m][0] * ratio; acc[ai][bj][m][1] = acc[ai][bj][m][1] * ratio; } }
    }
    __device__ __forceinline__ void operator()(const f32x4 (&acc)[2][2][4][2], const Unit& u, int wr, int wc, int fr, int fq) const {
        const int row0 = u.pm * BM + wr * 64 + fr; const int col0 = u.pn * BM + wc * 32 + 8 * fq;
#pragma unroll
        for (int ai = 0; ai < 2; ++ai)
#pragma unroll
            for (int m = 0; m < 4; ++m) { const int row = row0 + ai * HALF + m * 16; const size_t off = (size_t)row * ldc + col0; float ra, rf; row_stats(row - u.pm * BM, fq, ra, rf);
#pragma unroll
                for (int bj = 0; bj < 2; ++bj) { const u32x4 xb = *(const u32x4*)(base + off + bj * HALF); f32x4 v0, v1;
                    v0[0] = __builtin_bit_cast(float, xb.x << 16); v0[1] = __builtin_bit_cast(float, xb.x & 0xffff0000u); v0[2] = __builtin_bit_cast(float, xb.y << 16); v0[3] = __builtin_bit_cast(float, xb.y & 0xffff0000u);
                    v1[0] = __builtin_bit_cast(float, xb.z << 16); v1[1] = __builtin_bit_cast(float, xb.z & 0xffff0000u); v1[2] = __builtin_bit_cast(float, xb.w << 16); v1[3] = __builtin_bit_cast(float, xb.w & 0xffff0000u);
                    v0 = v0 + acc[ai][bj][m][0] * rf; v1 = v1 + acc[ai][bj][m][1] * rf;
                    u32x4 w; w.x = cvt_pk_bf16(v0[0], v0[1]); w.y = cvt_pk_bf16(v0[2], v0[3]); w.z = cvt_pk_bf16(v1[0], v1[1]); w.w = cvt_pk_bf16(v1[2], v1[3]);
                    *(u32x4*)(O + off + bj * HALF) = w; }
                }
        asm volatile("s_waitcnt lgkmcnt(0)\n\ts_barrier" ::: "memory");
    }
};


struct EpiX1Q {
    static constexpr bool PERM = true, AFTER_DRAIN = false, MIDK = true, PREFETCH = true; static constexpr int MIDK_T = 12;
    const bf16_t* base; bf16_t* O; int ldc; const float* sa; PG8_LAS float* st; unsigned char* A8; float* srow; float* xbuf; unsigned* cnt; PG8_LAS unsigned char* lq;
    __device__ __forceinline__ void prefetch(const Unit& u, int wid, int lane) const {
        asm volatile("" : "+v"(lane));
#pragma unroll
        for (int i = 0; i < 2; ++i) { const int piece = wid * 2 + i;
            __builtin_amdgcn_global_load_lds((const unsigned*)(sa + (size_t)u.pm * BM * 16 + piece * 256 + lane * 4), (PG8_LAS unsigned*)(st + piece * 256), 16, 0, 0); }
    }
    __device__ __forceinline__ void row_stats(int rl, int fq, float& ra, float& rf) const {
        const f32x4 s4 = *(const PG8_LAS f32x4*)(st + rl * 16 + 4 * fq); float a = fq < 3 ? (s4[0] + s4[1]) + (s4[2] + s4[3]) : 0.f, f = fq == 3 ? s4[0] : 0.f;
        a += __shfl_xor(a, 16); a += __shfl_xor(a, 32); f += __shfl_xor(f, 16); f += __shfl_xor(f, 32);
        ra = __builtin_amdgcn_rsqf(a * (1.0f / 768.0f) + 1e-6f); rf = __builtin_amdgcn_rsqf(f * (1.0f / 256.0f) + 1e-6f);
    }
    __device__ __forceinline__ void midk(f32x4 (&acc)[2][2][4][2], const Unit& u, int wr, int fr, int fq) const {
#pragma unroll
        for (int ai = 0; ai < 2; ++ai)
#pragma unroll
            for (int m = 0; m < 4; ++m) { float ra, rf; row_stats(ai * HALF + wr * 64 + m * 16 + fr, fq, ra, rf); const float ratio = ra * __builtin_amdgcn_rcpf(rf);
#pragma unroll
                for (int bj = 0; bj < 2; ++bj) { acc[ai][bj][m][0] = acc[ai][bj][m][0] * ratio; acc[ai][bj][m][1] = acc[ai][bj][m][1] * ratio; } }
    }
    __device__ __forceinline__ void operator()(f32x4 (&acc)[2][2][4][2], const Unit& u, int wr, int wc, int fr, int fq) const {
        PG8_LAS float* Pq = (PG8_LAS float*)(lq + 4096); PG8_LAS float* Pm = (PG8_LAS float*)(lq + 24576); PG8_LAS float* S = (PG8_LAS float*)(lq + 28672);
        asm volatile("" : "+v"(fr), "+v"(fq));
        int tid = (wr * 4 + wc) * 64 + fq * 16 + fr;
        const int col0 = u.pn * BM + wc * 32 + 8 * fq;
#pragma unroll
        for (int ai = 0; ai < 2; ++ai) {
            u32x4 xbv[4][2];
#pragma unroll
            for (int m = 0; m < 4; ++m)
#pragma unroll
                for (int bj = 0; bj < 2; ++bj) xbv[m][bj] = *(const u32x4*)(base + (size_t)(u.pm * BM + ai * HALF + wr * 64 + m * 16 + fr) * ldc + col0 + bj * HALF);
#pragma unroll
            for (int m = 0; m < 4; ++m) { const int rl = ai * HALF + wr * 64 + m * 16 + fr; const size_t off = (size_t)(u.pm * BM + rl) * ldc + col0; float ra, rf; row_stats(rl, fq, ra, rf); float q = 0.f, mx = 0.f;
#pragma unroll
                for (int bj = 0; bj < 2; ++bj) { const u32x4 xb = xbv[m][bj]; f32x4 v0, v1;
                    v0[0] = __builtin_bit_cast(float, xb.x << 16); v0[1] = __builtin_bit_cast(float, xb.x & 0xffff0000u); v0[2] = __builtin_bit_cast(float, xb.y << 16); v0[3] = __builtin_bit_cast(float, xb.y & 0xffff0000u);
                    v1[0] = __builtin_bit_cast(float, xb.z << 16); v1[1] = __builtin_bit_cast(float, xb.z & 0xffff0000u); v1[2] = __builtin_bit_cast(float, xb.w << 16); v1[3] = __builtin_bit_cast(float, xb.w & 0xffff0000u);
                    v0 = v0 + acc[ai][bj][m][0] * rf; v1 = v1 + acc[ai][bj][m][1] * rf; acc[ai][bj][m][0] = v0; acc[ai][bj][m][1] = v1;
                    q += ((v0[0] * v0[0] + v0[1] * v0[1]) + (v0[2] * v0[2] + v0[3] * v0[3])) + ((v1[0] * v1[0] + v1[1] * v1[1]) + (v1[2] * v1[2] + v1[3] * v1[3]));
                    mx = fmaxf(mx, fmaxf(fmaxf(fmaxf(fabsf(v0[0]), fabsf(v0[1])), fmaxf(fabsf(v0[2]), fabsf(v0[3]))), fmaxf(fmaxf(fabsf(v1[0]), fabsf(v1[1])), fmaxf(fabsf(v1[2]), fabsf(v1[3])))));
                    u32x4 w; w.x = cvt_pk_bf16(v0[0], v0[1]); w.y = cvt_pk_bf16(v0[2], v0[3]); w.z = cvt_pk_bf16(v1[0], v1[1]); w.w = cvt_pk_bf16(v1[2], v1[3]);
                    *(u32x4*)(O + off + bj * HALF) = w; }
                q += __shfl_xor(q, 16); q += __shfl_xor(q, 32); mx = fmaxf(mx, __shfl_xor(mx, 16)); mx = fmaxf(mx, __shfl_xor(mx, 32));
                if (fq == 0) { Pq[rl * 4 + wc] = q; Pm[rl * 4 + wc] = mx; } } }
        asm volatile("s_waitcnt lgkmcnt(0)\n\ts_barrier" ::: "memory");
        if (tid < 256) { const float sq = (Pq[tid * 4] + Pq[tid * 4 + 1]) + (Pq[tid * 4 + 2] + Pq[tid * 4 + 3]); const float mq = fmaxf(fmaxf(Pm[tid * 4], Pm[tid * 4 + 1]), fmaxf(Pm[tid * 4 + 2], Pm[tid * 4 + 3]));
            float* xp = xbuf + ((size_t)(u.pm * BM + tid) * 4 + u.pn) * 2;
            __hip_atomic_store(xp, sq, __ATOMIC_RELAXED, __HIP_MEMORY_SCOPE_AGENT); __hip_atomic_store(xp + 1, mq, __ATOMIC_RELAXED, __HIP_MEMORY_SCOPE_AGENT);
            asm volatile("s_waitcnt vmcnt(0)" ::: "memory");
            if ((tid & 63) == 0) __hip_atomic_fetch_add(cnt + 64 * u.pm, 1u, __ATOMIC_RELAXED, __HIP_MEMORY_SCOPE_AGENT); }
        if (tid < 64) { unsigned spins = 0;
            while ((unsigned)__builtin_amdgcn_readfirstlane(__hip_atomic_load(cnt + 64 * u.pm, __ATOMIC_RELAXED, __HIP_MEMORY_SCOPE_AGENT)) < 16u) { __builtin_amdgcn_s_sleep(2); if (++spins > 400000u) break; }
            __builtin_amdgcn_fence(__ATOMIC_ACQUIRE, "agent"); }
        asm volatile("s_waitcnt vmcnt(0) lgkmcnt(0)\n\ts_barrier" ::: "memory");
        if (tid < 256) { const float* xp = xbuf + (size_t)(u.pm * BM + tid) * 8; float t = 0.f, mq = 0.f;
#pragma unroll
            for (int k = 0; k < 4; ++k) { t += __hip_atomic_load(xp + 2 * k, __ATOMIC_RELAXED, __HIP_MEMORY_SCOPE_AGENT); mq = fmaxf(mq, __hip_atomic_load(xp + 2 * k + 1, __ATOMIC_RELAXED, __HIP_MEMORY_SCOPE_AGENT)); }
            S[tid] = mq > 0.f ? 127.0f / mq : 0.f;
            if (u.pn == 0) srow[u.pm * BM + tid] = mq * (1.0f / 127.0f) * (1.0f / sqrtf(t * (1.0f / 1024.0f) + 1e-6f)); }
        asm volatile("s_waitcnt vmcnt(0) lgkmcnt(0)\n\ts_barrier" ::: "memory");
        int fr5 = fr; asm volatile("" : "+v"(fr5));
#pragma unroll
        for (int ai = 0; ai < 2; ++ai)
#pragma unroll
            for (int m = 0; m < 4; ++m) { const int rl = ai * HALF + wr * 64 + m * 16 + fr5; const float inv = S[rl]; unsigned char* ap = A8 + (size_t)(u.pm * BM + rl) * ldc + col0;
#pragma unroll
                for (int bj = 0; bj < 2; ++bj) { unsigned lo = 0, hi = 0;
#pragma unroll
                    for (int t = 0; t < 4; ++t) { lo |= ((unsigned)(int)__builtin_rintf(acc[ai][bj][m][0][t] * inv) & 255u) << (8 * t); hi |= ((unsigned)(int)__builtin_rintf(acc[ai][bj][m][1][t] * inv) & 255u) << (8 * t); }
                    unsigned long long pk = (unsigned long long)lo | ((unsigned long long)hi << 32); *(unsigned long long*)(ap + bj * HALF) = pk; } }
        asm volatile("s_waitcnt lgkmcnt(0)\n\ts_barrier" ::: "memory");
    }
};

struct EpiFinal {
    static constexpr bool PERM = true, AFTER_DRAIN = false, MIDK = false, PREFETCH = false;
    const bf16_t* X1; float* out; int ldc; const float* gain; float* xbuf; unsigned* cnt; PG8_LAS unsigned char* lx;
    __device__ __forceinline__ void operator()(f32x4 (&acc)[2][2][4][2], const Unit& u, int wr, int wc, int fr, int fq) const {
        PG8_LAS float* P = (PG8_LAS float*)lx; PG8_LAS float* S = (PG8_LAS float*)(lx + 4096);
        int tid = (wr * 4 + wc) * 64 + fq * 16 + fr; asm volatile("" : "+v"(tid)); const int col0 = u.pn * BM + wc * 32 + 8 * fq;
#pragma unroll
        for (int ai = 0; ai < 2; ++ai)
#pragma unroll
            for (int m = 0; m < 4; ++m) { const int rl = ai * HALF + wr * 64 + m * 16 + fr; const size_t off = (size_t)(u.pm * BM + rl) * ldc + col0; float q = 0.f;
#pragma unroll
                for (int bj = 0; bj < 2; ++bj) { const u32x4 xb = *(const u32x4*)(X1 + off + bj * HALF); f32x4 v0, v1;
                    v0[0] = __builtin_bit_cast(float, xb.x << 16); v0[1] = __builtin_bit_cast(float, xb.x & 0xffff0000u); v0[2] = __builtin_bit_cast(float, xb.y << 16); v0[3] = __builtin_bit_cast(float, xb.y & 0xffff0000u);
                    v1[0] = __builtin_bit_cast(float, xb.z << 16); v1[1] = __builtin_bit_cast(float, xb.z & 0xffff0000u); v1[2] = __builtin_bit_cast(float, xb.w << 16); v1[3] = __builtin_bit_cast(float, xb.w & 0xffff0000u);
                    v0 = v0 + acc[ai][bj][m][0]; v1 = v1 + acc[ai][bj][m][1]; acc[ai][bj][m][0] = v0; acc[ai][bj][m][1] = v1;
                    q += ((v0[0] * v0[0] + v0[1] * v0[1]) + (v0[2] * v0[2] + v0[3] * v0[3])) + ((v1[0] * v1[0] + v1[1] * v1[1]) + (v1[2] * v1[2] + v1[3] * v1[3])); }
                q += __shfl_xor(q, 16); q += __shfl_xor(q, 32);
                if (fq == 0) P[rl * 4 + wc] = q; }
        asm volatile("s_waitcnt lgkmcnt(0)\n\ts_barrier" ::: "memory");
        if (tid < 256) { const float s = (P[tid * 4] + P[tid * 4 + 1]) + (P[tid * 4 + 2] + P[tid * 4 + 3]);
            __hip_atomic_store(xbuf + ((size_t)(u.pm * BM + tid) * 4 + u.pn), s, __ATOMIC_RELAXED, __HIP_MEMORY_SCOPE_AGENT);
            asm volatile("s_waitcnt vmcnt(0)" ::: "memory");
            if ((tid & 63) == 0) __hip_atomic_fetch_add(cnt + 64 * u.pm, 1u, __ATOMIC_RELAXED, __HIP_MEMORY_SCOPE_AGENT); }
        if (tid < 64) { unsigned spins = 0;
            while ((unsigned)__builtin_amdgcn_readfirstlane(__hip_atomic_load(cnt + 64 * u.pm, __ATOMIC_RELAXED, __HIP_MEMORY_SCOPE_AGENT)) < 16u) { __builtin_amdgcn_s_sleep(2); if (++spins > 400000u) break; }
            __builtin_amdgcn_fence(__ATOMIC_ACQUIRE, "agent"); }
        asm volatile("s_waitcnt vmcnt(0) lgkmcnt(0)\n\ts_barrier" ::: "memory");
        if (tid < 256) { const float* xp = xbuf + (size_t)(u.pm * BM + tid) * 4; float t = 0.f;
#pragma unroll
            for (int k = 0; k < 4; ++k) t += __hip_atomic_load(xp + k, __ATOMIC_RELAXED, __HIP_MEMORY_SCOPE_AGENT);
            S[tid] = 1.0f / sqrtf(t * (1.0f / 1024.0f) + 1e-6f); }
        asm volatile("s_waitcnt vmcnt(0) lgkmcnt(0)\n\ts_barrier" ::: "memory");
        f32x4 gv[2][2];
#pragma unroll
        for (int bj = 0; bj < 2; ++bj)
#pragma unroll
            for (int n = 0; n < 2; ++n) gv[bj][n] = *(const f32x4*)(gain + col0 + bj * HALF + n * 4);
#pragma unroll
        for (int ai = 0; ai < 2; ++ai)
#pragma unroll
            for (int m = 0; m < 4; ++m) { const int rl = ai * HALF + wr * 64 + m * 16 + fr; const float rs = S[rl]; const size_t off = (size_t)(u.pm * BM + rl) * ldc + col0;
#pragma unroll
                for (int bj = 0; bj < 2; ++bj)
#pragma unroll
                    for (int n = 0; n < 2; ++n) *(f32x4*)(out + off + bj * HALF + n * 4) = acc[ai][bj][m][n] * rs * gv[bj][n]; }
    }
};

template <class E, class = void> struct HasPermA { static constexpr bool v = false; };
template <class E> struct HasPermA<E, decltype((void)E::PERMA)> { static constexpr bool v = E::PERMA; };
template <bool I8> __device__ __forceinline__ typename AccT<I8>::type mma16(bf16x8 a, bf16x8 b, typename AccT<I8>::type c) {
    if constexpr (I8) return __builtin_amdgcn_mfma_i32_16x16x64_i8(__builtin_bit_cast(i32x4, a), __builtin_bit_cast(i32x4, b), c, 0, 0, 0);
    else return __builtin_amdgcn_mfma_f32_16x16x32_bf16(a, b, c, 0, 0, 0);
}
template <class Epi, class Sched, bool ALIGN_EPI = false, bool SP2 = false, bool I8 = false>
__device__ __forceinline__ void gemm_phase(PG8_LAS unsigned char* lds, const Gemm g, const Sched& S, const Epi& E) {
    int tid = threadIdx.x; asm volatile("" : "+v"(tid));
    const int wid = __builtin_amdgcn_readfirstlane(tid >> 6), lane = tid & 63, wr = wid >> 2, wc = wid & 3, fr = lane & 15, fq = lane >> 4;
    const int K = g.K, nt = K / BK, lda = g.lda;
    unsigned voffA[2], voffB[2];
#pragma unroll
    for (int i = 0; i < 2; ++i) { int R, C; stage_rc(tid * 16 + i * 8192, R, C); const int Rb = Epi::PERM ? ((R & ~31) + perm32(R & 31)) : R;
        const int Ra = HasPermA<Epi>::v ? ((R & ~63) + (R & 15) * 4 + ((R >> 4) & 3)) : R;
        voffA[i] = (unsigned)(Ra * lda + C) * 2u; voffB[i] = (unsigned)(Rb * K + C) * 2u; }
    const size_t kstep = (size_t)(BK * 2);
    const size_t hstepA = (size_t)HALF * lda * 2, hstepB = (size_t)HALF * K * 2;
    const size_t tstepA = 2 * hstepA, tstepB = 2 * hstepB;
    const unsigned ldsw = (unsigned)wid * 1024u;
    const int aoff = lds_byte(wr * 64 + fr, fq * 8), boff = lds_byte(wc * 32 + fr, fq * 8);
#define PG8_SA(b, h) (((b) * 2 + (h)) * HTB)
#define PG8_SB(b, h) ((4 + (b) * 2 + (h)) * HTB)
#define PG8_STAGE(bufoff, gbase, voff) do { _Pragma("unroll") for (int _i = 0; _i < 2; ++_i) \
        __builtin_amdgcn_global_load_lds((const unsigned*)((const char*)(gbase) + (voff)[_i]), (PG8_LAS unsigned*)(lds + (bufoff) + ldsw + _i * 8192), 16, 0, 0); } while (0)
#define PG8_LDA(dst, b, h) do { _Pragma("unroll") for (int m = 0; m < 4; ++m) _Pragma("unroll") for (int k = 0; k < 2; ++k) dst[m][k] = *(const PG8_LAS bf16x8*)(lds + PG8_SA(b, h) + aoff + m * 2048 + k * 1024); } while (0)
#define PG8_LDB(dst, b, h) do { _Pragma("unroll") for (int n = 0; n < 2; ++n) _Pragma("unroll") for (int k = 0; k < 2; ++k) dst[n][k] = *(const PG8_LAS bf16x8*)(lds + PG8_SB(b, h) + boff + n * 2048 + k * 1024); } while (0)
#define PG8_MMA(ai, bj, At, Bt) do { __builtin_amdgcn_s_setprio(1); _Pragma("unroll") for (int m = 0; m < 4; ++m) _Pragma("unroll") for (int n = 0; n < 2; ++n) _Pragma("unroll") for (int k = 0; k < 2; ++k) \
        acc[ai][bj][m][n] = mma16<I8>(Bt[n][k], At[m][k], acc[ai][bj][m][n]); __builtin_amdgcn_s_setprio(0); } while (0)
#define PG8_WAIT_V(n) asm volatile("s_waitcnt vmcnt(" #n ")" ::: "memory")
#define PG8_WAIT_L(n) asm volatile("s_waitcnt lgkmcnt(" #n ")" ::: "memory")
#define PG8_BAR __builtin_amdgcn_s_barrier()
#define PG8_SCHED __builtin_amdgcn_sched_barrier(0)
    Unit cur, nxt; int ui = 0;
    if (!S.next(0, cur)) return;
    typedef typename AccT<I8>::type acc_t; acc_t acc[2][2][4][2];
#pragma unroll
    for (int a = 0; a < 2; ++a)
#pragma unroll
        for (int b = 0; b < 2; ++b)
#pragma unroll
            for (int m = 0; m < 4; ++m)
#pragma unroll
                for (int n = 0; n < 2; ++n) acc[a][b][m][n] = (acc_t){0, 0, 0, 0};
    bf16x8 At[4][2], B0[2][2], B1[2][2];
    const char* cA = (const char*)g.A + (g.ovl ? (size_t)ovl_row_base(cur.pm) * lda * 2 : (size_t)cur.pm * tstepA); const char* cB = (const char*)g.Bt + (size_t)cur.pn * tstepB;
    S.a_ready(cur);
    if constexpr (Epi::PREFETCH) E.prefetch(cur, wid, lane);
    if constexpr (SP2) {
        PG8_STAGE(PG8_SB(0, 0), cB, voffB); PG8_STAGE(PG8_SB(0, 1), cB + hstepB, voffB); PG8_STAGE(PG8_SA(0, 0), cA, voffA); PG8_STAGE(PG8_SA(0, 1), cA + hstepA, voffA);
        if (wr == 1) PG8_BAR;
        PG8_WAIT_V(2); PG8_BAR;
        PG8_STAGE(PG8_SB(1, 0), cB + kstep, voffB); PG8_STAGE(PG8_SA(1, 0), cA + kstep, voffA); PG8_STAGE(PG8_SB(1, 1), cB + hstepB + kstep, voffB);
        PG8_WAIT_V(6); PG8_BAR;
    } else {
        PG8_STAGE(PG8_SB(0, 0), cB, voffB); PG8_STAGE(PG8_SA(0, 0), cA, voffA); PG8_STAGE(PG8_SB(0, 1), cB + hstepB, voffB); PG8_STAGE(PG8_SA(0, 1), cA + hstepA, voffA);
        if (wr == 1) PG8_BAR;
        PG8_WAIT_V(4); PG8_BAR;
        PG8_STAGE(PG8_SB(1, 0), cB + kstep, voffB); PG8_STAGE(PG8_SA(1, 0), cA + kstep, voffA); PG8_STAGE(PG8_SB(1, 1), cB + hstepB + kstep, voffB);
        PG8_WAIT_V(6); PG8_BAR;
    }
    for (;;) {
        const bool has_next = S.next(ui + 1, nxt);
        const char* nA = has_next ? (const char*)g.A + (g.ovl ? (size_t)ovl_row_base(nxt.pm) * lda * 2 : (size_t)nxt.pm * tstepA) : cA; const char* nB = has_next ? (const char*)g.Bt + (size_t)nxt.pn * tstepB : cB;
        for (int t = 0; t < nt; t += 2) {
            const bool last = (t == nt - 2);
            const char* a1 = cA + (size_t)(t + 1) * kstep;
            const char* a2 = last ? nA : cA + (size_t)(t + 2) * kstep; const char* b2 = last ? nB : cB + (size_t)(t + 2) * kstep;
            const char* a3 = a2 + kstep; const char* b3 = b2 + kstep;
            if (last && has_next) S.a_ready(nxt);
            if constexpr (Epi::MIDK) { if (t == Epi::MIDK_T) E.midk(acc, cur, wr, fr, fq); }
            if constexpr (SP2) {
            PG8_LDB(B0, 0, 0); PG8_LDB(B1, 0, 1); PG8_SCHED; PG8_LDA(At, 0, 0); PG8_STAGE(PG8_SA(1, 1), a1 + hstepA, voffA);
            PG8_WAIT_V(8); PG8_WAIT_L(0); PG8_BAR; PG8_MMA(0, 0, At, B0); PG8_MMA(0, 1, At, B1); PG8_BAR; PG8_SCHED;
            PG8_LDA(At, 0, 1); PG8_STAGE(PG8_SB(0, 0), b2, voffB); PG8_STAGE(PG8_SB(0, 1), b2 + hstepB, voffB); PG8_STAGE(PG8_SA(0, 0), a2, voffA);
            PG8_WAIT_V(8); PG8_WAIT_L(0); PG8_BAR; PG8_MMA(1, 0, At, B0); PG8_MMA(1, 1, At, B1); PG8_BAR; PG8_SCHED;
            PG8_LDB(B0, 1, 0); PG8_LDB(B1, 1, 1); PG8_SCHED; PG8_LDA(At, 1, 0); PG8_STAGE(PG8_SA(0, 1), a2 + hstepA, voffA);
            PG8_WAIT_V(8); PG8_WAIT_L(0); PG8_BAR; PG8_MMA(0, 0, At, B0); PG8_MMA(0, 1, At, B1); PG8_BAR; PG8_SCHED;
            PG8_LDA(At, 1, 1); PG8_STAGE(PG8_SB(1, 0), b3, voffB); PG8_STAGE(PG8_SB(1, 1), b3 + hstepB, voffB); PG8_STAGE(PG8_SA(1, 0), a3, voffA);
            PG8_WAIT_V(8); PG8_WAIT_L(0); PG8_BAR; PG8_MMA(1, 0, At, B0); PG8_MMA(1, 1, At, B1); PG8_BAR; PG8_SCHED;
            } else {
            PG8_LDB(B0, 0, 0); PG8_SCHED; PG8_LDA(At, 0, 0); PG8_STAGE(PG8_SA(1, 1), a1 + hstepA, voffA);
            PG8_WAIT_L(8); PG8_BAR; PG8_WAIT_L(0); PG8_MMA(0, 0, At, B0); PG8_BAR; PG8_SCHED;
            PG8_LDB(B1, 0, 1); PG8_STAGE(PG8_SB(0, 0), b2, voffB);
            PG8_BAR; PG8_WAIT_L(0); PG8_MMA(0, 1, At, B1); PG8_BAR;
            PG8_LDA(At, 0, 1); PG8_STAGE(PG8_SA(0, 0), a2, voffA);
            PG8_BAR; PG8_WAIT_L(0); PG8_MMA(1, 0, At, B0); PG8_BAR; PG8_SCHED;
            PG8_STAGE(PG8_SB(0, 1), b2 + hstepB, voffB);
            PG8_WAIT_V(6); PG8_BAR; PG8_MMA(1, 1, At, B1); PG8_BAR;
            PG8_LDB(B0, 1, 0); PG8_SCHED; PG8_LDA(At, 1, 0); PG8_STAGE(PG8_SA(0, 1), a2 + hstepA, voffA);
            PG8_WAIT_L(8); PG8_BAR; PG8_WAIT_L(0); PG8_MMA(0, 0, At, B0); PG8_BAR; PG8_SCHED;
            PG8_LDB(B1, 1, 1); PG8_STAGE(PG8_SB(1, 0), b3, voffB);
            PG8_BAR; PG8_WAIT_L(0); PG8_MMA(0, 1, At, B1); PG8_BAR;
            PG8_LDA(At, 1, 1); PG8_STAGE(PG8_SA(1, 0), a3, voffA);
            PG8_BAR; PG8_WAIT_L(0); PG8_MMA(1, 0, At, B0); PG8_BAR; PG8_SCHED;
            PG8_STAGE(PG8_SB(1, 1), b3 + hstepB, voffB);
            PG8_WAIT_V(6); PG8_BAR; PG8_MMA(1, 1, At, B1); PG8_BAR;
            }
        }
        if constexpr (ALIGN_EPI) { if (wr == 0) PG8_BAR; }
        if constexpr (!Epi::AFTER_DRAIN) { E(acc, cur, wr, wc, fr, fq); S.done(cur); }
        if constexpr (Epi::PREFETCH) { if (has_next) E.prefetch(nxt, wid, lane); }
        if (!has_next) break;
#pragma unroll
        for (int a = 0; a < 2; ++a)
#pragma unroll
            for (int b = 0; b < 2; ++b)
#pragma unroll
                for (int m = 0; m < 4; ++m)
#pragma unroll
                    for (int n = 0; n < 2; ++n) acc[a][b][m][n] = (acc_t){0, 0, 0, 0};
        cur = nxt; cA = nA; cB = nB; ++ui;
        if constexpr (ALIGN_EPI) { if (wr == 1) PG8_BAR; }
    }
    PG8_WAIT_V(0);
    if constexpr (!ALIGN_EPI) { if (wr == 0) PG8_BAR; }
    PG8_BAR;
#undef PG8_SA
#undef PG8_SB
#undef PG8_STAGE
#undef PG8_LDA
#undef PG8_LDB
#undef PG8_MMA
#undef PG8_WAIT_V
#undef PG8_WAIT_L
#undef PG8_BAR
#undef PG8_SCHED
}
}

constexpr int NWAVES = 8;
#ifndef MK_ONE_LAUNCH
#define MK_ONE_LAUNCH 1
#endif
constexpr int N_PHASES = 11;

constexpr int BATCH = 8, SEQ = 4096, D = 1024, NH = 12, HD = 64, AW = 768, NG = 4, GD = 64, FW = 256, MIXW = 1024, NPROJ = 2560, FF = 2816;
constexpr int M = BATCH * SEQ;
constexpr float EPS = 1e-6f;

constexpr size_t MiB = 1u << 20;
constexpr size_t WS_CTL = 0, CTL_ZERO_BYTES = 96 * 1024;
constexpr size_t WS_TAB = 1 * MiB;
constexpr size_t TAB_BIAS = 0;
constexpr size_t TAB_MG = 32 * 1024;
constexpr size_t TAB_TW = 192 * 1024;
constexpr size_t TAB_CW4 = 256 * 1024;
constexpr size_t WS_WIN = 2 * MiB;
constexpr size_t WS_WOUT = 7 * MiB;
constexpr size_t WS_WGV = 9 * MiB;
constexpr size_t WS_WD = 20 * MiB;
constexpr size_t WS_XN = 26 * MiB;
constexpr size_t WS_PROJ = 90 * MiB;
constexpr size_t WS_A2 = 250 * MiB;
constexpr size_t WS_PQ = 314 * MiB;
constexpr size_t WS_ML = 380 * MiB;
constexpr size_t WS_A8 = 314 * MiB;
constexpr size_t WS_HALO = 400 * MiB;
constexpr size_t WS_RS0 = 441 * MiB;
constexpr size_t WS_XBUF = 440 * MiB;
constexpr size_t WS_SSA = 446 * MiB;
constexpr size_t WS_SS1 = 442 * MiB;
constexpr size_t WS_SS2 = 444 * MiB;
constexpr size_t WS_GV = 90 * MiB;
constexpr size_t WS_END = 448 * MiB;
constexpr int CW_BAR = 1024, CW_PANEL = 8192, CW_PANEL2 = 16384;

constexpr int RING_OFF = 0, RING_BYTES = 131072;
constexpr int LDSCTL_OFF = RING_BYTES, MISC_OFF = LDSCTL_OFF + 320;
constexpr int LDS_BYTES = 163840;

#define GAS __attribute__((address_space(1)))
#define LAS __attribute__((address_space(3)))
typedef unsigned short bf16;
typedef unsigned v4u __attribute__((ext_vector_type(4)));
typedef unsigned v2u __attribute__((ext_vector_type(2)));
typedef float f32x4 __attribute__((ext_vector_type(4)));
typedef GAS unsigned gu32;
#define RLX_AGENT __ATOMIC_RELAXED, __HIP_MEMORY_SCOPE_AGENT
#define LDS_WAIT() asm volatile("s_waitcnt lgkmcnt(0)" ::: "memory")
#define VM_WAIT() asm volatile("s_waitcnt vmcnt(0)" ::: "memory")
__device__ __forceinline__ unsigned f2bf(float f) { unsigned u = __builtin_bit_cast(unsigned, f); return (u + 0x7fffu + ((u >> 16) & 1u)) >> 16; }
__device__ __forceinline__ unsigned pk2(float lo, float hi) { typedef float f2_t __attribute__((ext_vector_type(2))); typedef __bf16 b2_t __attribute__((ext_vector_type(2))); f2_t v = {lo, hi}; b2_t b = __builtin_convertvector(v, b2_t); return __builtin_bit_cast(unsigned, b); }
__device__ __forceinline__ void st_wt16(void* p, v4u v) { asm volatile("global_store_dwordx4 %0, %1, off sc1\n\ts_nop 2" :: "v"(p), "v"(v));        }
__device__ __forceinline__ void st_wt8(void* p, v2u v) { asm volatile("global_store_dwordx2 %0, %1, off sc1" :: "v"(p), "v"(v)); }
__device__ __forceinline__ float bflo(unsigned w) { return __builtin_bit_cast(float, w << 16); }
__device__ __forceinline__ float bfhi(unsigned w) { return __builtin_bit_cast(float, w & 0xffff0000u); }
__device__ __forceinline__ float bf2f(bf16 h) { return __builtin_bit_cast(float, (unsigned)h << 16); }

#define XB_TMO      128
#define XB_XCNT(j)  (256  + 64 * (j))
#define XB_XSUB(j)  (1280 + 64 * (j))
#define XB_XGEN(j)  (2304 + 64 * (j))
#define XB_TOP      3328
#define XB_TOPGEN   3392
#define XCD_BAR_WORDS 3456
#define XB_SPIN_CAP (1u << 18)
__device__ __forceinline__ unsigned xb_ld(unsigned* p)              { return __hip_atomic_load(p, __ATOMIC_RELAXED, __HIP_MEMORY_SCOPE_AGENT); }
__device__ __forceinline__ unsigned xb_add(unsigned* p, unsigned v) { return __hip_atomic_fetch_add(p, v, __ATOMIC_RELAXED, __HIP_MEMORY_SCOPE_AGENT); }
__device__ __forceinline__ unsigned xb_xcc_id() { return (unsigned)__builtin_amdgcn_s_getreg((3 << 11) | 20) & 0xFu; }
#define XB_SPIN(cond, bar) do { unsigned _sp = 0; while (cond) { __builtin_amdgcn_s_sleep(1); \
    if ((++_sp & 255u) == 0u) { if (xb_ld(&(bar)[XB_TMO])) break; if (_sp > XB_SPIN_CAP) { atomicAdd(&(bar)[XB_TMO], 1u); break; } } } } while (0)
struct XcdBarrier { unsigned* bar; unsigned x; volatile LAS unsigned* st; };
__device__ __forceinline__ XcdBarrier xcd_barrier_post(unsigned* bar, volatile LAS unsigned* st) {
    XcdBarrier b; b.bar = bar; b.x = xb_xcc_id(); b.st = st;
    if (threadIdx.x == 0) (void)xb_add(&bar[XB_XCNT(b.x)], 1u);
    return b;
}
__device__ __forceinline__ void xcd_barrier_complete(unsigned* bar, unsigned x, unsigned& nloc, unsigned& nx) {
    const unsigned G = gridDim.x * gridDim.y * gridDim.z;
    unsigned sum, cnt, mine, sp = 0u;
    for (;;) {
        sum = 0u; cnt = 0u; mine = 0u;
#pragma unroll
        for (unsigned j = 0; j < 16; ++j) { const unsigned c = xb_ld(&bar[XB_XCNT(j)]); sum += c; cnt += (c > 0u) ? 1u : 0u; mine = (j == x) ? c : mine; }
        if (sum == G) break;
        __builtin_amdgcn_s_sleep(1);
        if ((++sp & 255u) == 0u) { if (xb_ld(&bar[XB_TMO])) break; if (sp > XB_SPIN_CAP) { atomicAdd(&bar[XB_TMO], 1u); break; } }
    }
    nloc = mine > 0u ? mine : 1u; nx = cnt > 0u ? cnt : 1u;
}
__device__ __forceinline__ void xcd_barrier(const XcdBarrier& b) {
    asm volatile("s_waitcnt vmcnt(0)" ::: "memory");
    __syncthreads();
    if (threadIdx.x == 0) {
        unsigned* bar = b.bar;
        __builtin_amdgcn_s_waitcnt(0);
        unsigned nloc = b.st[0], nx = b.st[1];
        if (nloc == 0u) { xcd_barrier_complete(bar, b.x, nloc, nx); b.st[0] = nloc; b.st[1] = nx; }
        const unsigned old = xb_add(&bar[XB_XSUB(b.x)], 1u);
        const unsigned gen = old / nloc;
        if (old + 1u == (gen + 1u) * nloc) {
            __builtin_amdgcn_fence(__ATOMIC_RELEASE, "agent");
            asm volatile("s_waitcnt vmcnt(0)" ::: "memory");
            const unsigned og = xb_add(&bar[XB_TOP], 1u);
            const unsigned tg = og / nx;
            if (og + 1u == (tg + 1u) * nx) xb_add(&bar[XB_TOPGEN], 1u);
            else XB_SPIN(xb_ld(&bar[XB_TOPGEN]) == tg, bar);
            __builtin_amdgcn_fence(__ATOMIC_ACQUIRE, "agent");
            xb_add(&bar[XB_XGEN(b.x)], 1u);
            asm volatile("s_waitcnt vmcnt(0)" ::: "memory");
        } else {
            XB_SPIN(xb_ld(&bar[XB_XGEN(b.x)]) == gen, bar);
            __builtin_amdgcn_fence(__ATOMIC_ACQUIRE, "agent");
            asm volatile("s_waitcnt vmcnt(0)" ::: "memory");
        }
    }
    __syncthreads();
}

struct Frame {
    LAS unsigned char* lds;
    volatile LAS unsigned* MISC;
    gu32* ctl;
    int tid, lane, wave;
    int vcu, G;
    const float *x, *g_mix, *w_in, *g_attn, *rel_tab, *f_w, *f_b, *g_four, *w_out, *g_ffn, *w_gate, *w_val, *conv_w, *conv_b, *w_down, *g_fin;
    float* out;
    unsigned char* ws;
};

__device__ __forceinline__ float wave_sum(float v) {
#pragma unroll
    for (int o = 1; o < 64; o <<= 1) v += __shfl_xor(v, o);
    return v;
}
__device__ __forceinline__ void p0_transpose_item(const float* W, int K, int N, bf16* WT, int row_off, LAS float* scr, int item, int lane, const float* gain = nullptr, bool il = false) {
    const int nblk = N / 32, kb = item / nblk, nb = item % nblk, k0 = 64 * kb, n0 = 32 * nb; if (il) row_off += 128 * (n0 >> 7);
    {   f32x4 v[8]; const int c4 = 4 * (lane & 7);
#pragma unroll
        for (int i = 0; i < 8; ++i) v[i] = __builtin_nontemporal_load((const GAS f32x4*)(W + (size_t)(k0 + (lane >> 3) + 8 * i) * N + n0 + c4));
#pragma unroll
        for (int i = 0; i < 8; ++i) { const int kk = (lane >> 3) + 8 * i; const float gsc = gain ? gain[k0 + kk] : 1.0f; LAS float* sp = scr + kk * 33 + c4;
            sp[0] = v[i].x * gsc; sp[1] = v[i].y * gsc; sp[2] = v[i].z * gsc; sp[3] = v[i].w * gsc; } }
    LDS_WAIT(); asm volatile("" ::: "memory");
    const int c = lane & 7;
#pragma unroll
    for (int j = 0; j < 4; ++j) { const int n = (lane >> 3) + 8 * j; const LAS float* s = scr + (8 * c) * 33 + n;
        v4u o; o.x = pk2(s[0 * 33], s[1 * 33]); o.y = pk2(s[2 * 33], s[3 * 33]); o.z = pk2(s[4 * 33], s[5 * 33]); o.w = pk2(s[6 * 33], s[7 * 33]);
        st_wt16(WT + (size_t)(row_off + n0 + n) * K + k0 + 8 * c, o); }
    LDS_WAIT(); asm volatile("" ::: "memory");
}

__device__ __forceinline__ void p0_quant_strip(Frame& F, const float* W, int N, unsigned char* WT, bool isv, int nb, const float* gain, float* cw6) {
    const int lane = F.lane, w = F.wave, n0 = 32 * nb, c4 = 4 * (lane & 7), K = D; const int row_off = (isv ? 128 : 0) + 128 * (n0 >> 7);
    LAS float* scr = (LAS float*)(F.lds + RING_OFF + w * 16384); LAS float* cmw = (LAS float*)(F.lds + RING_OFF + 8 * 16384 - 2048); LAS float* cmf = cmw + 256;
    f32x4 v[2][8]; f32x4 mx = (f32x4){0.f, 0.f, 0.f, 0.f};
#pragma unroll
    for (int blk = 0; blk < 2; ++blk)
#pragma unroll
        for (int i = 0; i < 8; ++i) v[blk][i] = __builtin_nontemporal_load((const GAS f32x4*)(W + (size_t)(128 * w + 64 * blk + (lane >> 3) + 8 * i) * N + n0 + c4));
#pragma unroll
    for (int blk = 0; blk < 2; ++blk)
#pragma unroll
        for (int i = 0; i < 8; ++i) { v[blk][i] = v[blk][i] * gain[128 * w + 64 * blk + (lane >> 3) + 8 * i];
            mx[0] = fmaxf(mx[0], fabsf(v[blk][i][0])); mx[1] = fmaxf(mx[1], fabsf(v[blk][i][1])); mx[2] = fmaxf(mx[2], fabsf(v[blk][i][2])); mx[3] = fmaxf(mx[3], fabsf(v[blk][i][3])); }
#pragma unroll
    for (int j = 0; j < 4; ++j) { float t = mx[j]; t = fmaxf(t, __shfl_xor(t, 8)); t = fmaxf(t, __shfl_xor(t, 16)); t = fmaxf(t, __shfl_xor(t, 32)); mx[j] = t; }
    if (lane < 8) *(LAS f32x4*)(cmw + w * 32 + c4) = mx;
    __syncthreads();
    if (F.tid < 32) { float t = cmw[F.tid];
#pragma unroll
        for (int ww = 1; ww < 8; ++ww) t = fmaxf(t, cmw[ww * 32 + F.tid]);
        cmf[F.tid] = t; const int nn = n0 + F.tid; cw6[(nn >> 7) * 768 + (isv ? 5 : 4) * 128 + (nn & 127)] = t * (1.0f / 127.0f); }
    __syncthreads();
#pragma unroll
    for (int blk = 0; blk < 2; ++blk) { const int k0 = 128 * w + 64 * blk;
#pragma unroll
        for (int i = 0; i < 8; ++i) { const int kk = (lane >> 3) + 8 * i; LAS float* sp = scr + kk * 33 + c4; sp[0] = v[blk][i][0]; sp[1] = v[blk][i][1]; sp[2] = v[blk][i][2]; sp[3] = v[blk][i][3]; }
        LDS_WAIT(); asm volatile("" ::: "memory");
        const int c = lane & 7;
#pragma unroll
        for (int j = 0; j < 4; ++j) { const int n = (lane >> 3) + 8 * j; const LAS float* sq = scr + (8 * c) * 33 + n; const float cm = cmf[n]; const float inv = cm > 0.f ? 127.0f / cm : 0.f;
            unsigned lo = 0, hi = 0;
#pragma unroll
            for (int t = 0; t < 4; ++t) { lo |= ((unsigned)(int)__builtin_rintf(sq[t * 33] * inv) & 255u) << (8 * t); hi |= ((unsigned)(int)__builtin_rintf(sq[(4 + t) * 33] * inv) & 255u) << (8 * t); }
            v2u o; o.x = lo; o.y = hi; *(GAS v2u*)(WT + (size_t)(row_off + n0 + n) * K + k0 + 8 * c) = o; }
        LDS_WAIT(); asm volatile("" ::: "memory"); }
    __syncthreads();
}
__device__ __forceinline__ void rms_row_to_bf16(const float* xrow, const float* gain, bf16* orow, int lane) {
    const GAS f32x4* xr = (const GAS f32x4*)xrow + lane; const GAS f32x4* gr = (const GAS f32x4*)gain + lane;
    f32x4 v[4]; float s = 0.f;
#pragma unroll
    for (int j = 0; j < 4; ++j) { v[j] = xr[64 * j]; s += (v[j].x * v[j].x + v[j].y * v[j].y) + (v[j].z * v[j].z + v[j].w * v[j].w); }
    const float rstd = 1.0f / sqrtf(wave_sum(s) * (1.f / D) + EPS);
    GAS unsigned long long* o8 = (GAS unsigned long long*)orow + lane;
#pragma unroll
    for (int j = 0; j < 4; ++j) { const f32x4 gg = gr[64 * j]; o8[64 * j] = (unsigned long long)pk2(v[j].x * rstd * gg.x, v[j].y * rstd * gg.y) | ((unsigned long long)pk2(v[j].z * rstd * gg.z, v[j].w * rstd * gg.w) << 32); }
}
__device__ __forceinline__ int t5_bucket(int rel) {
    const int ret = rel > 0 ? 16 : 0; const int n = rel < 0 ? -rel : rel;
    const float nf = (float)(n > 1 ? n : 1);
    int large = 8 + (int)(logf(nf / 8.0f) / logf(128.0f) * 8.0f);
    large = large < 15 ? large : 15;
    return ret + (n < 8 ? n : large);
}

__device__ __forceinline__ void p0_prologue(Frame& F) {
    LAS float* scr = (LAS float*)(F.lds + RING_OFF + F.wave * 16384);
    const int gw = F.vcu * NWAVES + F.wave, NGW = F.G * NWAVES;
    bf16* WinT = (bf16*)(F.ws + WS_WIN); bf16* WoutT = (bf16*)(F.ws + WS_WOUT); bf16* WgvT = (bf16*)(F.ws + WS_WGV); bf16* WdT = (bf16*)(F.ws + WS_WD);
    constexpr int I_IN = (D / 64) * (NPROJ / 32), I_OUT = (MIXW / 64) * (D / 32), I_D = (FF / 64) * (D / 32), NSTRIP = FF / 32;
    constexpr int NITEMS = I_IN + I_OUT + I_D;
    float* cw6 = (float*)(F.ws + WS_TAB + TAB_CW4);
    for (int sj = F.vcu; sj < 2 * NSTRIP; sj += F.G) { const bool isv = sj >= NSTRIP; p0_quant_strip(F, isv ? F.w_val : F.w_gate, FF, F.ws + WS_WGV, isv, isv ? sj - NSTRIP : sj, F.g_ffn, cw6); }
    for (int it = gw; it < NITEMS; it += NGW) {
        int r = it;
        if (r < I_IN) { p0_transpose_item(F.w_in, D, NPROJ, WinT, 0, scr, r, F.lane, F.g_mix); continue; } r -= I_IN;
        if (r < I_OUT) { const int k0 = 64 * (r / (D / 32)); p0_transpose_item(F.w_out, MIXW, D, WoutT, 0, scr, r, F.lane, k0 < AW ? F.g_attn : F.g_four - AW); continue; } r -= I_OUT;
        p0_transpose_item(F.w_down, FF, D, WdT, 0, scr, r, F.lane);
    }
    float* tabBias = (float*)(F.ws + WS_TAB + TAB_BIAS); float* tabMg = (float*)(F.ws + WS_TAB + TAB_MG); float* tabTw = (float*)(F.ws + WS_TAB + TAB_TW);
    const int gt = F.vcu * (NWAVES * 64) + F.tid, NGT = F.G * NWAVES * 64;
    for (int i = gt; i < 3 * 129 * 12; i += NGT) { const int h = i % 12, jj = (i / 12) % 129, br = i / (12 * 129); const int dil = br == 0 ? 1 : (br == 1 ? 4 : 16);
        tabBias[i] = F.rel_tab[t5_bucket((jj - 64) * dil) * 12 + h]; }
    for (int i = gt; i < 4 * 64 * 128; i += NGT) { const int col = i & 127, c = (i >> 7) & 63, g = i >> 13; const int e = col & 63; float acc = 0.f;
        for (int d = 0; d < 64; ++d) { const float rev = (float)((c * d) & 63) * (1.0f / 64.0f); const float t = col < 64 ? __builtin_amdgcn_cosf(rev) : -__builtin_amdgcn_sinf(rev); acc += t * F.f_w[(g * 64 + d) * 64 + e]; }
        tabMg[i] = acc; }
    for (int i = gt; i < (FF / 128) * 512; i += NGT) { const int pn = i >> 9, k = (i >> 7) & 3, c = i & 127, ch = 128 * pn + c; cw6[pn * 768 + k * 128 + c] = k < 3 ? F.conv_w[k * FF + ch] : F.conv_b[ch]; }
    for (int i = gt; i < 4096; i += NGT) { float sv, cv; sincospif((float)i * (1.0f / 2048.0f), &sv, &cv); tabTw[2 * i] = cv; tabTw[2 * i + 1] = sv; }
    bf16* XN = (bf16*)(F.ws + WS_XN);
    {   float* RS0 = (float*)(F.ws + WS_RS0);
        for (int m0 = gw; m0 < M; m0 += 4 * NGW) { f32x4 v[4][4];
#pragma unroll
            for (int r = 0; r < 4; ++r) { const int m = m0 + r * NGW; const GAS f32x4* xr = (const GAS f32x4*)(F.x + (size_t)(m < M ? m : 0) * D) + F.lane;
#pragma unroll
                for (int j = 0; j < 4; ++j) v[r][j] = __builtin_nontemporal_load(xr + 64 * j); }
#pragma unroll
            for (int r = 0; r < 4; ++r) { const int m = m0 + r * NGW; float s = 0.f;
#pragma unroll
                for (int j = 0; j < 4; ++j) s += (v[r][j].x * v[r][j].x + v[r][j].y * v[r][j].y) + (v[r][j].z * v[r][j].z + v[r][j].w * v[r][j].w);
                const float rstd = 1.0f / sqrtf(wave_sum(s) * (1.f / D) + EPS);
                if (m < M) { GAS unsigned long long* o8 = (GAS unsigned long long*)(XN + (size_t)m * D) + F.lane; if (F.lane == 0) RS0[m] = rstd;
#pragma unroll
                    for (int j = 0; j < 4; ++j) { const f32x4 t = v[r][j]; v2u o2; o2.x = pk2(t.x, t.y); o2.y = pk2(t.z, t.w); st_wt8((void*)(o8 + 64 * j), o2); } } } } }
}

namespace att {
typedef short bf16x8 __attribute__((ext_vector_type(8)));
typedef short v4i16 __attribute__((ext_vector_type(4)));
constexpr float LOG2E = 1.4426950408889634f;
constexpr int TABN = 512, TPAD0 = 128;
constexpr int LDS_K = 0, LDS_V = 49152, LDS_T0 = 98304, LDS_T1 = 98304 + 8192;
struct QT { bf16x8 q[2]; f32x4 o[4]; float m, l; };
__device__ __forceinline__ v4i16 vtr(const LAS unsigned char* p) { return __builtin_amdgcn_ds_read_tr16_b64_v4i16((LAS v4i16*)p); }

__device__ __forceinline__ void build_table(Frame& F, int ldsoff, int br, int h) {
    const float* tabBias = (const float*)(F.ws + WS_TAB + TAB_BIAS);
    LAS float* T = (LAS float*)(F.lds + ldsoff);
    for (int e = F.tid; e < 4 * TABN; e += NWAVES * 64) { const int s = e / TABN, n = e % TABN; const int r64 = n + s - TPAD0;
        T[e] = (r64 >= 0 && r64 <= 128) ? tabBias[(br * 129 + r64) * 12 + h] * LOG2E : -INFINITY; }
}
__device__ __forceinline__ const LAS float* table_ptr(Frame& F, int ldsoff, int idx0) { const int s = idx0 & 3; return (const LAS float*)(F.lds + ldsoff) + s * TABN + (idx0 - s); }

__device__ __forceinline__ int pass_tok(int mode, int a, int row) {
    if (mode == 0) { const int t = a - 64 + row; return (t >= 0 && t < SEQ) ? t : -1; }
    if (mode == 3) return a + 16 * row;
    const int hi = row >= 192 ? 1 : 0, u = a + (hi ? row - 192 : row), c = 2 * (mode - 1) + hi; return (u >= 0 && u < SEQ / 4) ? c + 4 * u : -1;
}
struct Pre { v4u k[6], v[6]; };
template <int NIT> __device__ __forceinline__ void prefetch(Frame& F, Pre& R, const bf16* P, int h, int mode, int a) {
#pragma unroll
    for (int it = 0; it < NIT; ++it) { const int idx = F.tid + it * (NWAVES * 64), row = idx >> 3, ph = idx & 7; const int t = pass_tok(mode, a, row);
        const int ck = ph ^ ((row >> 1) & 7), cv = ph ^ (((row >> 1) & 3) << 1);
        R.k[it] = (v4u){0u, 0u, 0u, 0u}; R.v[it] = (v4u){0u, 0u, 0u, 0u};
        if (t >= 0) { const bf16* rp = P + (size_t)t * NPROJ + h * 64; R.k[it] = *(const GAS v4u*)(rp + AW + ck * 8); R.v[it] = *(const GAS v4u*)(rp + 2 * AW + cv * 8); } }
}
template <int NIT> __device__ __forceinline__ void commit(Frame& F, const Pre& R) {
#pragma unroll
    for (int it = 0; it < NIT; ++it) { const int idx = F.tid + it * (NWAVES * 64);
        *(LAS v4u*)(F.lds + LDS_K + idx * 16) = R.k[it]; *(LAS v4u*)(F.lds + LDS_V + idx * 16) = R.v[it]; }
}
__device__ __forceinline__ float xmax4(float v) {
    auto a = __builtin_amdgcn_permlane16_swap(__float_as_uint(v), __float_as_uint(v), false, false); v = fmaxf(__uint_as_float(a[0]), __uint_as_float(a[1]));
    auto b = __builtin_amdgcn_permlane32_swap(__float_as_uint(v), __float_as_uint(v), false, false); return fmaxf(__uint_as_float(b[0]), __uint_as_float(b[1]));
}
__device__ __forceinline__ float xsum4(float v) {
    auto a = __builtin_amdgcn_permlane16_swap(__float_as_uint(v), __float_as_uint(v), false, false); v = __uint_as_float(a[0]) + __uint_as_float(a[1]);
    auto b = __builtin_amdgcn_permlane32_swap(__float_as_uint(v), __float_as_uint(v), false, false); return __uint_as_float(b[0]) + __uint_as_float(b[1]);
}
__device__ __forceinline__ void load_q(QT& T, const bf16* qrow  , int g) {
#pragma unroll
    for (int ks = 0; ks < 2; ++ks) { const v4u w = *(const GAS v4u*)(qrow + 8 * g + 32 * ks); const float sc = 0.125f * LOG2E; v4u o;
        o.x = pk2(bflo(w.x) * sc, bfhi(w.x) * sc); o.y = pk2(bflo(w.y) * sc, bfhi(w.y) * sc); o.z = pk2(bflo(w.z) * sc, bfhi(w.z) * sc); o.w = pk2(bflo(w.w) * sc, bfhi(w.w) * sc);
        T.q[ks] = __builtin_bit_cast(bf16x8, o); }
#pragma unroll
    for (int db = 0; db < 4; ++db) T.o[db] = (f32x4){0.f, 0.f, 0.f, 0.f};
    T.m = -1e30f; T.l = 0.f;
}
typedef float f32x2_t __attribute__((ext_vector_type(2))); typedef __bf16 bf16x2_t __attribute__((ext_vector_type(2)));
__device__ __forceinline__ unsigned cvtpk(float lo, float hi) { f32x2_t v = {lo, hi}; bf16x2_t b = __builtin_convertvector(v, bf16x2_t); return __builtin_bit_cast(unsigned, b); }
constexpr float THR = 8.0f;
template <bool WT> __device__ __forceinline__ void store_row64(bf16* rowp, const v2u (&w)[4], int g) {
#pragma unroll
    for (int k = 0; k < 2; ++k) {
        const auto sx = __builtin_amdgcn_permlane16_swap(w[2 * k].x, w[2 * k + 1].x, false, false); const auto sy = __builtin_amdgcn_permlane16_swap(w[2 * k].y, w[2 * k + 1].y, false, false);
        v4u o; o.x = sx[0]; o.y = sy[0]; o.z = sx[1]; o.w = sy[1];
        if constexpr (WT) st_wt16(rowp + 32 * k + (g & 1) * 16 + (g >> 1) * 8, o); else *(GAS v4u*)(rowp + 32 * k + (g & 1) * 16 + (g >> 1) * 8) = o; }
}
template <int NQ, int NP> __device__ __forceinline__ void attn_step(QT (&T)[NQ], const LAS unsigned char* kp, const LAS unsigned char* vp, const LAS float* const (&tp)[NQ], int p, int koff0, int koff1, const int (&voff)[4], int klo, int khi, bool edge, int g) {
    bf16x8 kf[NP][4]; v4i16 vlo[NP][4], vhi[NP][4];
#pragma unroll
    for (int c = 0; c < NP; ++c) { kf[c][0] = *(const LAS bf16x8*)(kp + c * 4096 + koff0); kf[c][1] = *(const LAS bf16x8*)(kp + c * 4096 + koff1); kf[c][2] = *(const LAS bf16x8*)(kp + c * 4096 + 2048 + koff0); kf[c][3] = *(const LAS bf16x8*)(kp + c * 4096 + 2048 + koff1);
#pragma unroll
        for (int db = 0; db < 4; ++db) { vlo[c][db] = vtr(vp + c * 4096 + voff[db]); vhi[c][db] = vtr(vp + c * 4096 + 2048 + voff[db]); } }
#pragma unroll
    for (int n = 0; n < NQ; ++n) {
        f32x4 s[NP][2];
#pragma unroll
        for (int c = 0; c < NP; ++c) {
            s[c][0] = *(const LAS f32x4*)(tp[n] + (p + c) * 32); s[c][1] = *(const LAS f32x4*)(tp[n] + (p + c) * 32 + 16);
            s[c][0] = __builtin_amdgcn_mfma_f32_16x16x32_bf16(kf[c][0], T[n].q[0], s[c][0], 0, 0, 0); s[c][0] = __builtin_amdgcn_mfma_f32_16x16x32_bf16(kf[c][1], T[n].q[1], s[c][0], 0, 0, 0);
            s[c][1] = __builtin_amdgcn_mfma_f32_16x16x32_bf16(kf[c][2], T[n].q[0], s[c][1], 0, 0, 0); s[c][1] = __builtin_amdgcn_mfma_f32_16x16x32_bf16(kf[c][3], T[n].q[1], s[c][1], 0, 0, 0);
            if (edge) { const int kk = (p + c) * 32 + 4 * g;
#pragma unroll
                for (int r = 0; r < 4; ++r) { if (kk + r < klo || kk + r >= khi) s[c][0][r] = -INFINITY; if (kk + 16 + r < klo || kk + 16 + r >= khi) s[c][1][r] = -INFINITY; } } }
        float tm = fmaxf(fmaxf(fmaxf(s[0][0][0], s[0][0][1]), fmaxf(s[0][0][2], s[0][0][3])), fmaxf(fmaxf(s[0][1][0], s[0][1][1]), fmaxf(s[0][1][2], s[0][1][3])));
        if (NP == 2) tm = fmaxf(tm, fmaxf(fmaxf(fmaxf(s[NP - 1][0][0], s[NP - 1][0][1]), fmaxf(s[NP - 1][0][2], s[NP - 1][0][3])), fmaxf(fmaxf(s[NP - 1][1][0], s[NP - 1][1][1]), fmaxf(s[NP - 1][1][2], s[NP - 1][1][3]))));
        tm = xmax4(tm);
        if (__any(tm > T[n].m + THR)) { const float mn = fmaxf(T[n].m, tm), al = __builtin_amdgcn_exp2f(T[n].m - mn); T[n].m = mn; T[n].l *= al;
#pragma unroll
            for (int db = 0; db < 4; ++db) T[n].o[db] = T[n].o[db] * al; }
        const float mref = T[n].m; float ls = 0.f;
#pragma unroll
        for (int c = 0; c < NP; ++c) {
#pragma unroll
            for (int r = 0; r < 4; ++r) { s[c][0][r] = __builtin_amdgcn_exp2f(s[c][0][r] - mref); s[c][1][r] = __builtin_amdgcn_exp2f(s[c][1][r] - mref); }
            ls += ((s[c][0][0] + s[c][0][1]) + (s[c][0][2] + s[c][0][3])) + ((s[c][1][0] + s[c][1][1]) + (s[c][1][2] + s[c][1][3])); }
        T[n].l += ls;
#pragma unroll
        for (int c = 0; c < NP; ++c) {
            v4u pw; pw.x = cvtpk(s[c][0][0], s[c][0][1]); pw.y = cvtpk(s[c][0][2], s[c][0][3]); pw.z = cvtpk(s[c][1][0], s[c][1][1]); pw.w = cvtpk(s[c][1][2], s[c][1][3]);
            const bf16x8 pf = __builtin_bit_cast(bf16x8, pw);
#pragma unroll
            for (int db = 0; db < 4; ++db) { const bf16x8 vf = (bf16x8){vlo[c][db][0], vlo[c][db][1], vlo[c][db][2], vlo[c][db][3], vhi[c][db][0], vhi[c][db][1], vhi[c][db][2], vhi[c][db][3]};
                T[n].o[db] = __builtin_amdgcn_mfma_f32_16x16x32_bf16(vf, pf, T[n].o[db], 0, 0, 0); } }
    }
}
template <int NQ> __device__ __forceinline__ void attn_job(QT (&T)[NQ], const LAS unsigned char* Kw, const LAS unsigned char* Vw, int npairs, const LAS float* const (&tp)[NQ], int klo, int khi, bool edge, int lane) {
    const int i = lane & 15, g = lane >> 4;
    const int koff0 = i * 128 + (((g) ^ (i >> 1)) << 4), koff1 = i * 128 + (((g + 4) ^ (i >> 1)) << 4);
    const int qq = i >> 2, pp = i & 3, vr = 4 * g + qq, fv = (vr >> 1) & 3;
    int voff[4];
#pragma unroll
    for (int db = 0; db < 4; ++db) voff[db] = vr * 128 + ((((db ^ fv) << 1) + (pp >> 1)) << 4) + (pp & 1) * 8;
    int p = 0;
    if (NQ == 1) {
#pragma unroll 1
        for (; p + 2 <= npairs; p += 2) attn_step<NQ, 2>(T, Kw + p * 4096, Vw + p * 4096, tp, p, koff0, koff1, voff, klo, khi, edge, g);
    }
#pragma unroll 1
    for (; p < npairs; ++p) attn_step<NQ, 1>(T, Kw + p * 4096, Vw + p * 4096, tp, p, koff0, koff1, voff, klo, khi, edge, g);
}
__device__ __forceinline__ void four_ssq(Frame& F) {
    const bf16* A2 = (const bf16*)(F.ws + WS_A2); float* SSA = (float*)(F.ws + WS_SSA);
    const int gw = F.vcu * NWAVES + F.wave, NGW = F.G * NWAVES;
    for (int m0 = gw; m0 < M; m0 += 4 * NGW) { v2u w[4];
#pragma unroll
        for (int r = 0; r < 4; ++r) { const int m = (m0 + r * NGW) < M ? (m0 + r * NGW) : 0; w[r] = *(const GAS v2u*)(A2 + (size_t)m * MIXW + AW + 4 * F.lane); }
#pragma unroll
        for (int r = 0; r < 4; ++r) { const int m = m0 + r * NGW; const float a = bflo(w[r].x), b2 = bfhi(w[r].x), c = bflo(w[r].y), d = bfhi(w[r].y);
            const float s = wave_sum((a * a + b2 * b2) + (c * c + d * d));
            if (m < M && F.lane == 0) *(GAS f32x4*)(SSA + (size_t)m * 16 + 12) = (f32x4){s, 0.f, 0.f, 0.f}; } }
}
__device__ __forceinline__ void phase_local(Frame& F) {
    constexpr int NU = BATCH * NH * 16; const int per = (NU + F.G - 1) / F.G, ub = F.vcu * per, ue = (ub + per) < NU ? (ub + per) : NU;
    const bf16* PROJ = (const bf16*)(F.ws + WS_PROJ); const int lane = F.lane, w = F.wave, i = lane & 15, g = lane >> 4;
    const int idx4 = w >> 1, rA = w & 1, rB = 2 + (w & 1);
    Pre R; int hprev = -1;
    __syncthreads();
    if (ub < ue) { const int bh = ub >> 4; prefetch<6>(F, R, PROJ + (size_t)(bh / NH) * SEQ * NPROJ, bh % NH, 0, (ub & 15) * 256); }
    for (int u = ub; u < ue; ++u) {
        const int bh = u >> 4, b = bh / NH, h = bh % NH, s0 = (u & 15) * 256;
        const bf16* P = PROJ + (size_t)b * SEQ * NPROJ; bf16* A2 = (bf16*)(F.ws + WS_A2) + (size_t)b * SEQ * MIXW; float* ML = (float*)(F.ws + WS_ML) + (size_t)b * SEQ * NH * 2;
        __syncthreads();
        commit<6>(F, R);
        if (h != hprev) { build_table(F, LDS_T0, 0, h); build_table(F, LDS_T1, 1, h); hprev = h; }
        __syncthreads();
        const int u0 = s0 / 4 - 64;
        QT T[2];
        const int tokA = s0 + rA + 4 * (16 * idx4 + i), tokB = s0 + rB + 4 * (16 * idx4 + i);
        load_q(T[0], P + (size_t)tokA * NPROJ + h * 64, g); load_q(T[1], P + (size_t)tokB * NPROJ + h * 64, g);
        asm volatile("" ::: "memory");
        prefetch<6>(F, R, P, h, 1, u0);
        {
            const LAS float* tp[2] = { table_ptr(F, LDS_T0, 4 * g - 4 * i - rA + TPAD0), table_ptr(F, LDS_T0, 4 * g - 4 * i - rB + TPAD0) };
            int klo = 64 - s0 - 64 * idx4; klo = klo > 0 ? klo : 0; int khi = SEQ + 64 - s0 - 64 * idx4; khi = khi < 192 ? khi : 192;
            attn_job<2>(T, F.lds + LDS_K + 64 * idx4 * 128, F.lds + LDS_V + 64 * idx4 * 128, 6, tp, klo, khi, (klo > 0 || khi < 192), lane);
        }
#pragma unroll
        for (int pass = 0; pass < 2; ++pass) {
            __syncthreads();
            commit<6>(F, R);
            __syncthreads();
            if (pass == 0) prefetch<6>(F, R, P, h, 2, u0);
            else if (u + 1 < ue) { const int bh2 = (u + 1) >> 4; prefetch<6>(F, R, PROJ + (size_t)(bh2 / NH) * SEQ * NPROJ, bh2 % NH, 0, ((u + 1) & 15) * 256); }
            const int cl = w & 1, lo = idx4 < 2 ? idx4 : 2;
            const LAS float* tp[1] = { table_ptr(F, LDS_T1, 4 * g - i + 16 * (lo - idx4) + TPAD0) };
            int klo = -(u0 + 16 * lo); klo = klo > 0 ? klo : 0; int khi = SEQ / 4 - (u0 + 16 * lo); khi = khi < 160 ? khi : 160;
            QT (&Tp)[1] = *(QT (*)[1])(&T[pass]);
            attn_job<1>(Tp, F.lds + LDS_K + (192 * cl + 16 * lo) * 128, F.lds + LDS_V + (192 * cl + 16 * lo) * 128, 5, tp, klo, khi, (klo > 0 || khi < 160), lane);
        }
#pragma unroll
        for (int n = 0; n < 2; ++n) {
            const float l = xsum4(T[n].l); const float inv = 1.0f / l; const int tok = n == 0 ? tokA : tokB;
            v2u ow[4];
#pragma unroll
            for (int db = 0; db < 4; ++db) { ow[db].x = pk2(T[n].o[db][0] * inv, T[n].o[db][1] * inv); ow[db].y = pk2(T[n].o[db][2] * inv, T[n].o[db][3] * inv); }
            store_row64<true>(A2 + (size_t)tok * MIXW + h * 64, ow, g);
            if (g == 0) { float* mlp = ML + ((size_t)tok * NH + h) * 2; mlp[0] = T[n].m; mlp[1] = l; }
        }
    }
    __syncthreads();
}
__device__ __forceinline__ void phase_class(Frame& F) {
    four_ssq(F);
    constexpr int NU = BATCH * NH * 16; const int per = (NU + F.G - 1) / F.G, ub = F.vcu * per, ue = (ub + per) < NU ? (ub + per) : NU;
    const bf16* PROJ = (const bf16*)(F.ws + WS_PROJ); const int lane = F.lane, w = F.wave, i = lane & 15, g = lane >> 4; float* SSA = (float*)(F.ws + WS_SSA);
    Pre R; int hprev = -1;
    __syncthreads();
    if (ub < ue) { const int bh = ub >> 4; prefetch<4>(F, R, PROJ + (size_t)(bh / NH) * SEQ * NPROJ, bh % NH, 3, ub & 15); }
    for (int u = ub; u < ue; ++u) {
        const int bh = u >> 4, b = bh / NH, h = bh % NH, r = u & 15;
        const bf16* P = PROJ + (size_t)b * SEQ * NPROJ; bf16* A2 = (bf16*)(F.ws + WS_A2) + (size_t)b * SEQ * MIXW; const float* ML = (const float*)(F.ws + WS_ML) + (size_t)b * SEQ * NH * 2;
        __syncthreads();
        commit<4>(F, R);
        if (h != hprev) { build_table(F, LDS_T0, 2, h); hprev = h; }
        __syncthreads();
        QT T2[2]; float mlv[2], llv[2]; v2u pvv[2][4];
#pragma unroll
        for (int n = 0; n < 2; ++n) { const int qt = n == 0 ? (w < 7 ? w : 11) : (w < 4 ? w + 7 : (w < 7 ? w + 8 : 15)); const int tok = r + 16 * (16 * qt + i);
            load_q(T2[n], P + (size_t)tok * NPROJ + h * 64, g);
            const float* mlp = ML + ((size_t)tok * NH + h) * 2; mlv[n] = mlp[0]; llv[n] = mlp[1];
#pragma unroll
            for (int db = 0; db < 4; ++db) pvv[n][db] = *(const GAS v2u*)(A2 + (size_t)tok * MIXW + h * 64 + 16 * db + 4 * g); }
        asm volatile("" ::: "memory");
        if (u + 1 < ue) { const int bh2 = (u + 1) >> 4; prefetch<4>(F, R, PROJ + (size_t)(bh2 / NH) * SEQ * NPROJ, bh2 % NH, 3, (u + 1) & 15); }
#pragma unroll
        for (int n = 0; n < 2; ++n) {
            const int qt = n == 0 ? (w < 7 ? w : 11) : (w < 4 ? w + 7 : (w < 7 ? w + 8 : 15));
            int lo = qt - 4 > 0 ? qt - 4 : 0, hi = qt + 4 < 15 ? qt + 4 : 15; if (((hi - lo + 1) & 1) != 0) { if (hi < 15) ++hi; else --lo; }
            const int tok = r + 16 * (16 * qt + i);
            QT (&T)[1] = *(QT (*)[1])(&T2[n]);
            const LAS float* tp[1] = { table_ptr(F, LDS_T0, 4 * g - i + 16 * (lo - qt) + 64 + TPAD0) };
            attn_job<1>(T, F.lds + LDS_K + 16 * lo * 128, F.lds + LDS_V + 16 * lo * 128, (hi - lo + 1) >> 1, tp, 0, 1 << 20, false, lane);
            const float l16 = xsum4(T[0].l);
            const float ml = mlv[n], ll = llv[n];
            const float mm = fmaxf(ml, T[0].m), a = __builtin_amdgcn_exp2f(ml - mm) * ll, bb = __builtin_amdgcn_exp2f(T[0].m - mm), inv = 1.0f / (a + bb * l16); float sq = 0.f;
            v2u ow[4];
#pragma unroll
            for (int db = 0; db < 4; ++db) { const v2u pv = pvv[n][db];
                const float f0 = (bflo(pv.x) * a + T[0].o[db][0] * bb) * inv, f1 = (bfhi(pv.x) * a + T[0].o[db][1] * bb) * inv, f2 = (bflo(pv.y) * a + T[0].o[db][2] * bb) * inv, f3 = (bfhi(pv.y) * a + T[0].o[db][3] * bb) * inv;
                sq += (f0 * f0 + f1 * f1) + (f2 * f2 + f3 * f3); ow[db].x = pk2(f0, f1); ow[db].y = pk2(f2, f3); }
            store_row64<false>(A2 + (size_t)tok * MIXW + h * 64, ow, g);
            sq = xsum4(sq);
            if (g == 0) SSA[((size_t)b * SEQ + tok) * 16 + h] = sq;
        }
    }
    __syncthreads();
}
}


namespace fou {
typedef short bf16x8 __attribute__((ext_vector_type(8)));
typedef short v4i16 __attribute__((ext_vector_type(4)));
constexpr int LX = 0, LC = LDSCTL_OFF + 8192, LS = LDSCTL_OFF + 16384;
__device__ __forceinline__ int gsw(int s2) { const int pr = (s2 >> 1) & 7; return (pr & 4) | ((pr & 1) << 1) | ((pr >> 1) & 1); }
__device__ __forceinline__ int xaddr(int pe, int s2, int chunk) { return LX + pe * 8192 + s2 * 128 + (((chunk ^ gsw(s2) ^ pe) & 7) << 4); }
__device__ __forceinline__ int maddr(int base, int k, int chunk) { return base + k * 128 + (((chunk ^ (k >> 1)) & 7) << 4); }
__device__ __forceinline__ v4i16 vtr(const LAS unsigned char* p) { return __builtin_amdgcn_ds_read_tr16_b64_v4i16((LAS v4i16*)p); }
__device__ __forceinline__ bf16x8 neg8(bf16x8 v) { v4u w = __builtin_bit_cast(v4u, v); w.x ^= 0x80008000u; w.y ^= 0x80008000u; w.z ^= 0x80008000u; w.w ^= 0x80008000u; return __builtin_bit_cast(bf16x8, w); }

__device__ __forceinline__ void fourier_unit(Frame& F, int b, int g, int ec) {
    const bf16* PROJ = (const bf16*)(F.ws + WS_PROJ); bf16* A2 = (bf16*)(F.ws + WS_A2); const float* tabMg = (const float*)(F.ws + WS_TAB + TAB_MG);
    const int lane = F.lane, w = F.wave, li = lane & 15, gq = lane >> 4, e0 = 8 * ec;
    LAS unsigned char* L = F.lds;
    __syncthreads();
    bf16x8 mb[2];
#pragma unroll
    for (int ks = 0; ks < 2; ++ks) { float v[8];
#pragma unroll
        for (int j = 0; j < 8; ++j) { const int c = 8 * gq + j + 32 * ks; const int col = li < 8 ? e0 + li : 64 + e0 + (li & 7); v[j] = tabMg[(g * 64 + c) * 128 + col]; }
        v4u o; o.x = pk2(v[0], v[1]); o.y = pk2(v[2], v[3]); o.z = pk2(v[4], v[5]); o.w = pk2(v[6], v[7]); mb[ks] = __builtin_bit_cast(bf16x8, o); }
    const bf16* ub = PROJ + (size_t)(b * SEQ) * NPROJ + 3 * AW + g * 64 + 8 * gq;
#pragma unroll 8
    for (int it = 0; it < 32; ++it) { const int tile = w + 8 * it, s2 = tile & 63, tq = tile >> 6;
        const bf16* up = ub + (size_t)(64 * (16 * tq + li) + s2) * NPROJ;
        const bf16x8 a0 = __builtin_bit_cast(bf16x8, *(const GAS v4u*)up), a1 = __builtin_bit_cast(bf16x8, *(const GAS v4u*)(up + 32));
        f32x4 d = (f32x4){0.f, 0.f, 0.f, 0.f};
        d = __builtin_amdgcn_mfma_f32_16x16x32_bf16(a0, mb[0], d, 0, 0, 0); d = __builtin_amdgcn_mfma_f32_16x16x32_bf16(a1, mb[1], d, 0, 0, 0);
        v2u o; o.x = pk2(d[0], d[1]); o.y = pk2(d[2], d[3]); *(LAS v2u*)(L + xaddr(li, s2, 2 * tq + (gq >> 1)) + (gq & 1) * 8) = o; }
    __syncthreads();
    const int e = w;
#pragma unroll 1
    for (int mt = 0; mt < 4; ++mt) { const int s2 = 16 * mt + li;
        bf16x8 yr[2], yi[2], nyr[2];
#pragma unroll
        for (int kh = 0; kh < 2; ++kh) { yr[kh] = *(const LAS bf16x8*)(L + xaddr(e, s2, gq + 4 * kh)); yi[kh] = *(const LAS bf16x8*)(L + xaddr(8 + e, s2, gq + 4 * kh)); nyr[kh] = neg8(yr[kh]); }
#pragma unroll
        for (int nt = 0; nt < 4; ++nt) { const int k = 16 * nt + li;
            const bf16x8 c0 = *(const LAS bf16x8*)(L + maddr(LC, k, gq)), c1 = *(const LAS bf16x8*)(L + maddr(LC, k, gq + 4)), s0 = *(const LAS bf16x8*)(L + maddr(LS, k, gq)), s1 = *(const LAS bf16x8*)(L + maddr(LS, k, gq + 4));
            f32x4 tr = (f32x4){0.f, 0.f, 0.f, 0.f}, ti = (f32x4){0.f, 0.f, 0.f, 0.f};
            tr = __builtin_amdgcn_mfma_f32_16x16x32_bf16(c0, yr[0], tr, 0, 0, 0); tr = __builtin_amdgcn_mfma_f32_16x16x32_bf16(c1, yr[1], tr, 0, 0, 0);
            tr = __builtin_amdgcn_mfma_f32_16x16x32_bf16(s0, yi[0], tr, 0, 0, 0); tr = __builtin_amdgcn_mfma_f32_16x16x32_bf16(s1, yi[1], tr, 0, 0, 0);
            ti = __builtin_amdgcn_mfma_f32_16x16x32_bf16(c0, yi[0], ti, 0, 0, 0); ti = __builtin_amdgcn_mfma_f32_16x16x32_bf16(c1, yi[1], ti, 0, 0, 0);
            ti = __builtin_amdgcn_mfma_f32_16x16x32_bf16(s0, nyr[0], ti, 0, 0, 0); ti = __builtin_amdgcn_mfma_f32_16x16x32_bf16(s1, nyr[1], ti, 0, 0, 0);
            float orr[4], oii[4];
#pragma unroll
            for (int r = 0; r < 4; ++r) { const int k1 = 16 * nt + 4 * gq + r; const float rev = (float)((k1 * s2) & 4095) * (1.0f / 4096.0f); const float cv = __builtin_amdgcn_cosf(rev), sv = __builtin_amdgcn_sinf(rev);
                orr[r] = tr[r] * cv + ti[r] * sv; oii[r] = ti[r] * cv - tr[r] * sv; }
            v2u o; o.x = pk2(orr[0], orr[1]); o.y = pk2(orr[2], orr[3]); *(LAS v2u*)(L + xaddr(e, s2, 2 * nt + (gq >> 1)) + (gq & 1) * 8) = o;
            o.x = pk2(oii[0], oii[1]); o.y = pk2(oii[2], oii[3]); *(LAS v2u*)(L + xaddr(8 + e, s2, 2 * nt + (gq >> 1)) + (gq & 1) * 8) = o; } }
    asm volatile("s_waitcnt lgkmcnt(0)" ::: "memory");
    bf16x8 af[4][4];
    { const int q = li >> 2, p = li & 3;
#pragma unroll
      for (int mt = 0; mt < 4; ++mt)
#pragma unroll
        for (int ks = 0; ks < 4; ++ks) { const int pe = (ks >> 1) * 8 + e, s2b = 8 * gq + 32 * (ks & 1) + q;
            const v4i16 lo = vtr(L + xaddr(pe, s2b, 2 * mt + (p >> 1)) + (p & 1) * 8), hi = vtr(L + xaddr(pe, s2b + 4, 2 * mt + (p >> 1)) + (p & 1) * 8);
            af[mt][ks] = (bf16x8){lo[0], lo[1], lo[2], lo[3], hi[0], hi[1], hi[2], hi[3]}; } }
    asm volatile("s_waitcnt lgkmcnt(0)" ::: "memory");
    __syncthreads();
    const float bias = F.f_b[g * 64 + e0 + e];
#pragma unroll 1
    for (int nt = 0; nt < 4; ++nt) { const int k2 = 16 * nt + li;
        const bf16x8 c0 = *(const LAS bf16x8*)(L + maddr(LC, k2, gq)), c1 = *(const LAS bf16x8*)(L + maddr(LC, k2, gq + 4)), s0 = *(const LAS bf16x8*)(L + maddr(LS, k2, gq)), s1 = *(const LAS bf16x8*)(L + maddr(LS, k2, gq + 4));
#pragma unroll
        for (int mt = 0; mt < 4; ++mt) { f32x4 d = (f32x4){0.f, 0.f, 0.f, 0.f};
            d = __builtin_amdgcn_mfma_f32_16x16x32_bf16(af[mt][0], c0, d, 0, 0, 0); d = __builtin_amdgcn_mfma_f32_16x16x32_bf16(af[mt][1], c1, d, 0, 0, 0);
            d = __builtin_amdgcn_mfma_f32_16x16x32_bf16(af[mt][2], s0, d, 0, 0, 0); d = __builtin_amdgcn_mfma_f32_16x16x32_bf16(af[mt][3], s1, d, 0, 0, 0);
#pragma unroll
            for (int r = 0; r < 4; ++r) { const int k1 = 16 * mt + 4 * gq + r; *(LAS bf16*)(L + LX + (k1 * 64 + k2) * 16 + e * 2) = (bf16)f2bf(d[r] * (1.0f / 512.0f) + bias); } } }
    __syncthreads();
    bf16* ob = A2 + (size_t)(b * SEQ) * MIXW + AW + g * 64 + e0;
#pragma unroll
    for (int j = 0; j < 8; ++j) { const int sl = F.tid + 512 * j, k1 = sl >> 6, k2 = sl & 63; const v4u v = *(const LAS v4u*)(L + LX + sl * 16); *(GAS v4u*)(ob + (size_t)(k1 + 64 * k2) * MIXW) = v; }
}
__device__ __forceinline__ void phase_fourier(Frame& F) {
    const float* tabTw = (const float*)(F.ws + WS_TAB + TAB_TW);
    __syncthreads();
    for (int idx = F.tid; idx < 4096; idx += NWAVES * 64) { const int k = idx >> 6, s = idx & 63, n = ((k * s) & 63) * 64;
        *(LAS bf16*)(F.lds + maddr(LC, k, s >> 3) + (s & 7) * 2) = (bf16)f2bf(tabTw[2 * n]); *(LAS bf16*)(F.lds + maddr(LS, k, s >> 3) + (s & 7) * 2) = (bf16)f2bf(tabTw[2 * n + 1]); }
    __syncthreads();
    for (int u = F.vcu; u < BATCH * NG * 8; u += F.G) fourier_unit(F, u >> 5, (u >> 3) & 3, u & 7);
    __syncthreads();
}
}

__device__ __forceinline__ void p10_final(Frame& F) {
    const bf16* X2 = (const bf16*)(F.ws + WS_XN); const float* SS2 = (const float*)(F.ws + WS_SS2);
    const int gw = F.vcu * NWAVES + F.wave, NGW = F.G * NWAVES; const int lane = F.lane;
    const GAS f32x4* gr = (const GAS f32x4*)(F.g_fin + 16 * lane); const f32x4 g0 = gr[0], g1 = gr[1], g2 = gr[2], g3 = gr[3];
    for (int m0 = gw; m0 < M; m0 += 4 * NGW) { v4u w0[4], w1[4]; float part[4];
#pragma unroll
        for (int r = 0; r < 4; ++r) { const int m = (m0 + r * NGW) < M ? (m0 + r * NGW) : 0; const GAS v4u* rp = (const GAS v4u*)(X2 + (size_t)m * D + 16 * lane); w0[r] = rp[0]; w1[r] = rp[1];
            part[r] = lane < 16 ? SS2[(size_t)m * 16 + lane] : 0.f; }
#pragma unroll
        for (int r = 0; r < 4; ++r) { const int m = m0 + r * NGW; const float rstd = 1.0f / sqrtf(wave_sum(part[r]) * (1.f / D) + EPS);
            if (m < M) { GAS f32x4* op = (GAS f32x4*)(F.out + (size_t)m * D + 16 * lane);
                op[0] = (f32x4){bflo(w0[r].x), bfhi(w0[r].x), bflo(w0[r].y), bfhi(w0[r].y)} * rstd * g0; op[1] = (f32x4){bflo(w0[r].z), bfhi(w0[r].z), bflo(w0[r].w), bfhi(w0[r].w)} * rstd * g1;
                op[2] = (f32x4){bflo(w1[r].x), bfhi(w1[r].x), bflo(w1[r].y), bfhi(w1[r].y)} * rstd * g2; op[3] = (f32x4){bflo(w1[r].z), bfhi(w1[r].z), bflo(w1[r].w), bfhi(w1[r].w)} * rstd * g3; } } }
}


__device__ __forceinline__ void p8_halo_fix(Frame& F, int pm) {
    const float* H = (const float*)(F.ws + WS_HALO); bf16* ACT = (bf16*)(F.ws + WS_GV); const int kt = pm & 15;
    for (int it = F.tid; it < 2 * (FF / 4); it += NWAVES * 64) { const int c4 = (it % (FF / 4)) * 4, side = it / (FF / 4);
        if ((side == 0 && kt == 0) || (side == 1 && kt == 15)) continue;
        const float* own = H + (size_t)(pm * 2 + side) * 3 * FF + c4; const float* nb = H + (size_t)((side == 0 ? (pm - 1) * 2 + 1 : (pm + 1) * 2)) * 3 * FF + c4;
        const f32x4 gn = *(const GAS f32x4*)nb, zp = *(const GAS f32x4*)(own + FF), vv = *(const GAS f32x4*)(own + 2 * FF), wt = *(const GAS f32x4*)(F.conv_w + (side == 0 ? 0 : 2 * FF) + c4);
        float a[4];
#pragma unroll
        for (int i = 0; i < 4; ++i) { const float z = zp[i] + wt[i] * gn[i]; a[i] = z * __builtin_amdgcn_rcpf(1.0f + __builtin_amdgcn_exp2f(-1.4426950408889634f * z)) * vv[i]; }
        const unsigned long long o = (unsigned long long)pk2(a[0], a[1]) | ((unsigned long long)pk2(a[2], a[3]) << 32);
        __hip_atomic_store((unsigned long long*)(ACT + (size_t)(pm * 256 + (side ? 255 : 0)) * FF + c4), o, __ATOMIC_RELAXED, __HIP_MEMORY_SCOPE_AGENT); }
}


__device__ __forceinline__ void p6_quant(Frame& F) {
    const bf16* X1 = (const bf16*)(F.ws + WS_XN); unsigned char* A8 = F.ws + WS_A8; float* SROW = (float*)(F.ws + WS_SS1);
    const int gw = F.vcu * NWAVES + F.wave, NGW = F.G * NWAVES, lane = F.lane;
    for (int m0 = gw; m0 < M; m0 += 4 * NGW) { v4u w0[4], w1[4];
#pragma unroll
        for (int r = 0; r < 4; ++r) { const int m = (m0 + r * NGW) < M ? (m0 + r * NGW) : 0; const GAS v4u* rp = (const GAS v4u*)(X1 + (size_t)m * D + 16 * lane); w0[r] = rp[0]; w1[r] = rp[1]; }
#pragma unroll
        for (int r = 0; r < 4; ++r) { const int m = m0 + r * NGW; float v[16];
            v[0] = bflo(w0[r].x); v[1] = bfhi(w0[r].x); v[2] = bflo(w0[r].y); v[3] = bfhi(w0[r].y); v[4] = bflo(w0[r].z); v[5] = bfhi(w0[r].z); v[6] = bflo(w0[r].w); v[7] = bfhi(w0[r].w);
            v[8] = bflo(w1[r].x); v[9] = bfhi(w1[r].x); v[10] = bflo(w1[r].y); v[11] = bfhi(w1[r].y); v[12] = bflo(w1[r].z); v[13] = bfhi(w1[r].z); v[14] = bflo(w1[r].w); v[15] = bfhi(w1[r].w);
            float ss = 0.f, mx = 0.f;
#pragma unroll
            for (int i = 0; i < 16; ++i) { ss += v[i] * v[i]; mx = fmaxf(mx, fabsf(v[i])); }
            ss = wave_sum(ss);
#pragma unroll
            for (int o = 1; o < 64; o <<= 1) mx = fmaxf(mx, __shfl_xor(mx, o));
            const float inv = mx > 0.f ? 127.0f / mx : 0.f; unsigned q[4];
#pragma unroll
            for (int j = 0; j < 4; ++j) { q[j] = 0;
#pragma unroll
                for (int t = 0; t < 4; ++t) q[j] |= ((unsigned)(int)__builtin_rintf(v[4 * j + t] * inv) & 255u) << (8 * t); }
            if (m < M) { *(GAS v4u*)(A8 + (size_t)m * D + 16 * lane) = (v4u){q[0], q[1], q[2], q[3]};
                if (lane == 0) SROW[m] = mx * (1.0f / 127.0f) * (1.0f / sqrtf(ss * (1.f / D) + EPS)); } } }
}

struct Args { const float* in[16]; float* out; unsigned char* ws; int ph_lo, ph_hi; };
__global__ void __launch_bounds__(NWAVES * 64, 2) hymba_fwd(Args args) {
    extern __shared__ __attribute__((aligned(16))) unsigned char lds[];
    Frame F;
    F.lds = (LAS unsigned char*)lds;
    F.MISC = (volatile LAS unsigned*)(F.lds + MISC_OFF);
    F.tid = threadIdx.x; F.lane = F.tid & 63; F.wave = __builtin_amdgcn_readfirstlane(F.tid >> 6);
    F.G = gridDim.x; { const int bx = blockIdx.x; F.vcu = (F.G % 8 == 0) ? (bx % 8) * (F.G / 8) + bx / 8 : bx; }
    F.ws = args.ws; F.ctl = (gu32*)(args.ws + WS_CTL);
    F.x = args.in[0]; F.g_mix = args.in[1]; F.w_in = args.in[2]; F.g_attn = args.in[3]; F.rel_tab = args.in[4]; F.f_w = args.in[5]; F.f_b = args.in[6]; F.g_four = args.in[7];
    F.w_out = args.in[8]; F.g_ffn = args.in[9]; F.w_gate = args.in[10]; F.w_val = args.in[11]; F.conv_w = args.in[12]; F.conv_b = args.in[13]; F.w_down = args.in[14]; F.g_fin = args.in[15];
    F.out = args.out;
    for (int u = F.tid; u < (LDS_BYTES - LDSCTL_OFF) / 4; u += NWAVES * 64) ((LAS unsigned*)(F.lds + LDSCTL_OFF))[u] = 0u;
    const unsigned long long pc0 = __builtin_amdgcn_s_getpc() & ~127ull;
#define CODE_PREFETCH() do { if (blockIdx.x < 16 && F.wave == 7) { const GAS unsigned* cb = (const GAS unsigned*)pc0; unsigned v[18], acc = 0u; \
        _Pragma("unroll") for (int i = 0; i < 18; ++i) v[i] = cb[(size_t)(F.lane + 64 * i) * 32]; \
        _Pragma("unroll") for (int i = 0; i < 18; ++i) acc ^= v[i]; \
        if (acc == 0x9e3779b9u) F.MISC[20] = acc; } } while (0)
    CODE_PREFETCH();
    __syncthreads();
    XcdBarrier bar; bar.bar = (unsigned*)(F.ctl + CW_BAR); bar.x = 0; bar.st = nullptr;
    if (MK_ONE_LAUNCH) bar = xcd_barrier_post((unsigned*)(F.ctl + CW_BAR), F.MISC + 8);
#define GRID_BAR() do { if (MK_ONE_LAUNCH) { xcd_barrier(bar); CODE_PREFETCH(); } } while (0)
    const int lo = args.ph_lo, hi = args.ph_hi;
#define IN(k) (lo <= (k) && (k) < hi)
#define BOTH(k) (IN(k) && IN((k) + 1))
    if (IN(0)) { p0_prologue(F); if (BOTH(0)) GRID_BAR(); }
    if (IN(1)) {
        pg8::Gemm g{(const bf16*)(F.ws + WS_XN), (const bf16*)(F.ws + WS_WIN), M, NPROJ, D, D, 0}; pg8::StaticOrder S; S.init(M, NPROJ, F.G, (int)blockIdx.x);
        pg8::EpiBf16Row E{(bf16*)(F.ws + WS_PROJ), NPROJ, (const float*)(F.ws + WS_RS0)};
        pg8::gemm_phase<pg8::EpiBf16Row, pg8::StaticOrder, true, true>(F.lds + RING_OFF, g, S, E);
        if (BOTH(1)) GRID_BAR();
    }
    if (IN(2)) { att::phase_local(F); fou::phase_fourier(F); if (BOTH(2)) GRID_BAR(); }
    if (IN(3)) { att::phase_class(F); if (IN(3) && IN(5)) GRID_BAR(); }
    if (IN(5)) {
        pg8::Gemm g{(const bf16*)(F.ws + WS_A2), (const bf16*)(F.ws + WS_WOUT), M, D, MIXW, MIXW, 0}; pg8::StaticOrder S; S.init(M, D, F.G, (int)blockIdx.x);
        if (F.G == 256) {
            pg8::EpiX1Q E{(const bf16*)(F.ws + WS_XN), (bf16*)(F.ws + WS_XN), D, (const float*)(F.ws + WS_SSA), (LAS float*)(F.lds + LDSCTL_OFF + 8192), F.ws + WS_A8, (float*)(F.ws + WS_SS1), (float*)(F.ws + WS_XBUF), (unsigned*)(F.ctl + CW_PANEL2), F.lds + LDSCTL_OFF};
            pg8::gemm_phase<pg8::EpiX1Q, pg8::StaticOrder, true, true>(F.lds + RING_OFF, g, S, E);
        } else {
            pg8::EpiX1N E{(const bf16*)(F.ws + WS_XN), (bf16*)(F.ws + WS_XN), D, (float*)(F.ws + WS_SS1), (const float*)(F.ws + WS_SSA), (LAS float*)(F.lds + LDSCTL_OFF + 8192)};
            pg8::gemm_phase<pg8::EpiX1N, pg8::StaticOrder, true, true>(F.lds + RING_OFF, g, S, E);
        }
        if (IN(5) && IN(6)) GRID_BAR();
    }
    if (IN(6) && F.G != 256) { p6_quant(F); if (IN(6) && IN(7)) GRID_BAR(); }
    if (IN(7)) {
        pg8::Gemm g{(const bf16*)(F.ws + WS_A8), (const bf16*)(F.ws + WS_WGV), M, 2 * FF, D / 2, D / 2, 0}; pg8::StaticOrder S; S.init(M, 2 * FF, F.G, (int)blockIdx.x);
        pg8::EpiConvGlu E{(bf16*)(F.ws + WS_GV), FF, (const float*)(F.ws + WS_SS1), F.conv_w, F.conv_b, (LAS float*)(F.lds + LDSCTL_OFF + 4096), M, (float*)(F.ws + WS_HALO), (const float*)(F.ws + WS_TAB + TAB_CW4)};
        pg8::gemm_phase<pg8::EpiConvGlu, pg8::StaticOrder, true, true, true>(F.lds + RING_OFF, g, S, E);
        if (IN(7) && IN(9)) GRID_BAR();
    }
    if (IN(9)) {
        pg8::Gemm g{(const bf16*)(F.ws + WS_GV), (const bf16*)(F.ws + WS_WD), M, D, FF, FF, 0}; pg8::StaticOrder S; S.init(M, D, F.G, (int)blockIdx.x);
        { pg8::Unit uu; for (int i = 0; S.next(i, uu); ++i) p8_halo_fix(F, uu.pm); }
        asm volatile("s_waitcnt vmcnt(0)" ::: "memory"); __syncthreads();
        if (F.G == 256) {
            pg8::EpiFinal E{(const bf16*)(F.ws + WS_XN), F.out, D, F.g_fin, (float*)(F.ws + WS_XBUF), (unsigned*)(F.ctl + CW_PANEL), F.lds + LDSCTL_OFF + 4096};
            pg8::gemm_phase<pg8::EpiFinal, pg8::StaticOrder, true, true>(F.lds + RING_OFF, g, S, E);
        } else {
            pg8::EpiX2 E{(bf16*)(F.ws + WS_XN), D, (float*)(F.ws + WS_SS2)};
            pg8::gemm_phase<pg8::EpiX2, pg8::StaticOrder, true, true>(F.lds + RING_OFF, g, S, E);
            if (BOTH(9)) GRID_BAR();
        }
    }
    if (IN(10) && F.G != 256) { p10_final(F); }
#undef IN
#undef BOTH
}

extern "C" void kernel_launch(void* const* d_in, const int* in_sizes, int n_in, void* d_out, int out_size, void* d_ws, size_t ws_size, hipStream_t stream) {
    static int grid = 0;
    if (grid == 0) {
        if (n_in != 16 || in_sizes[0] != M * D || out_size != M * D || ws_size < WS_END) { fprintf(stderr, "kernel_launch: shape/workspace mismatch: n_in %d in0 %d out %d ws %zu (need %zu)\n", n_in, n_in > 0 ? in_sizes[0] : -1, out_size, ws_size, (size_t)WS_END); grid = -1; return; }
        int dev = 0, cus = 0, per_cu = 0;
        if (hipGetDevice(&dev) != hipSuccess || hipDeviceGetAttribute(&cus, hipDeviceAttributeMultiprocessorCount, dev) != hipSuccess) { grid = -1; return; }
        if (hipFuncSetAttribute((const void*)hymba_fwd, hipFuncAttributeMaxDynamicSharedMemorySize, LDS_BYTES) != hipSuccess) { fprintf(stderr, "kernel_launch: hipFuncSetAttribute failed\n"); grid = -1; return; }
        if (hipOccupancyMaxActiveBlocksPerMultiprocessor(&per_cu, (const void*)hymba_fwd, NWAVES * 64, LDS_BYTES) != hipSuccess || per_cu < 1) { fprintf(stderr, "kernel_launch: occupancy query says %d blocks/CU\n", per_cu); (void)hipGetLastError(); grid = -1; return; }
        grid = cus;
    }
    if (grid < 0) return;
    (void)hipMemsetAsync((char*)d_ws + WS_CTL, 0, CTL_ZERO_BYTES, stream);
    Args a{};
    for (int i = 0; i < 16; ++i) a.in[i] = (const float*)d_in[i];
    a.out = (float*)d_out; a.ws = (unsigned char*)d_ws;
#if MK_ONE_LAUNCH
    a.ph_lo = 0; a.ph_hi = N_PHASES;
    hipLaunchKernelGGL(hymba_fwd, dim3(grid), dim3(NWAVES * 64), LDS_BYTES, stream, a);
#else
    for (int p = 0; p < N_PHASES; ++p) { a.ph_lo = p; a.ph_hi = p + 1; hipLaunchKernelGGL(hymba_fwd, dim3(grid), dim3(NWAVES * 64), LDS_BYTES, stream, a); }
#endif
}
```
